# Optimizing an MI355X kernel written in HIP

```python
import jax, jax.numpy as jnp
from jax import lax
import numpy as np

D_MODEL = 1024
BATCH = 2
SEQ = 8192
DEPTH = 1

CHUNK = 64
EPS = 1e-6
MLA_HEADS = 8
Q_RANK = 256
KV_RANK = 128
QK_NOPE = 64
QK_ROPE = 32
V_HEAD = 64
MLA_WIDTH = MLA_HEADS * V_HEAD
ROPE_THETA = 10000.0
Q_BLOCK = 128
SGU_GROUPS = 8
SGU_GROUP_DIM = 64
SGU_WIDTH = SGU_GROUPS * SGU_GROUP_DIM
SGU_LEN = 128
N_BRANCH = 2
N_GROUPS = 4
EXPERTS_PER_GROUP = 8
N_EXPERTS = N_GROUPS * EXPERTS_PER_GROUP
TOP_K = 2
D_EXPERT = 256
MOE_BLOCK = 128
SPLIT_POINTS = [Q_RANK, Q_RANK + KV_RANK, Q_RANK + KV_RANK + QK_ROPE,
                Q_RANK + KV_RANK + QK_ROPE + 2 * SGU_WIDTH]
IN_COLS = Q_RANK + KV_RANK + QK_ROPE + 2 * SGU_WIDTH + N_BRANCH * D_MODEL

kernel_name = "hybrid_mla_gmlp_hiermoe_block"


def _rmsnorm(x, g):
    xf = x.astype(jnp.float32)
    y = xf * lax.rsqrt(jnp.mean(xf * xf, axis=-1, keepdims=True) + EPS)
    return (y * g.astype(jnp.float32)).astype(x.dtype)


def _layernorm(x, g, b):
    xf = x.astype(jnp.float32)
    mu = jnp.mean(xf, axis=-1, keepdims=True)
    var = jnp.mean(jnp.square(xf - mu), axis=-1, keepdims=True)
    y = (xf - mu) * lax.rsqrt(var + EPS)
    return (y * g.astype(jnp.float32) + b.astype(jnp.float32)).astype(x.dtype)


def _rope(x, positions):
    r = x.shape[-1]
    freqs = ROPE_THETA ** (-jnp.arange(0, r, 2, dtype=jnp.float32) / r)
    ang = positions.astype(jnp.float32)[..., None] * freqs
    cos = jnp.cos(ang)[:, :, None, :]
    sin = jnp.sin(ang)[:, :, None, :]
    xf = x.astype(jnp.float32)
    x1, x2 = xf[..., : r // 2], xf[..., r // 2:]
    out = jnp.concatenate([x1 * cos - x2 * sin, x1 * sin + x2 * cos], axis=-1)
    return out.astype(x.dtype)


def _mla(c_q, c_kv, k_r, positions, g_cq, w_uq, g_ckv, w_uk, w_uv):
    b, s, _ = c_q.shape
    c_q = _rmsnorm(c_q, g_cq)
    q = (c_q @ w_uq).reshape(b, s, MLA_HEADS, QK_NOPE + QK_ROPE)
    q_nope = q[..., :QK_NOPE]
    q_rope = _rope(q[..., QK_NOPE:], positions)
    c_kv = _rmsnorm(c_kv, g_ckv)
    k_nope = (c_kv @ w_uk).reshape(b, s, MLA_HEADS, QK_NOPE)
    v = (c_kv @ w_uv).reshape(b, s, MLA_HEADS, V_HEAD)
    k_rope = _rope(k_r[:, :, None, :], positions)[:, :, 0, :]
    scale = (QK_NOPE + QK_ROPE) ** -0.5
    n_blk = s // Q_BLOCK
    qn_b = q_nope.reshape(b, n_blk, Q_BLOCK, MLA_HEADS, QK_NOPE).transpose(1, 0, 2, 3, 4)
    qr_b = q_rope.reshape(b, n_blk, Q_BLOCK, MLA_HEADS, QK_ROPE).transpose(1, 0, 2, 3, 4)
    key_chunk = jnp.arange(s) // CHUNK
    neg = jnp.finfo(jnp.float32).min

    def q_block(args):
        qn_i, qr_i, i = args
        sc = (jnp.einsum('bqhd,bkhd->bhqk', qn_i, k_nope)
              + jnp.einsum('bqhr,bkr->bhqk', qr_i, k_rope)).astype(jnp.float32) * scale
        q_chunk = (i * Q_BLOCK + jnp.arange(Q_BLOCK)) // CHUNK
        mask = key_chunk[None, :] <= q_chunk[:, None]
        sc = jnp.where(mask[None, None], sc, neg)
        p = jax.nn.softmax(sc, axis=-1).astype(v.dtype)
        return jnp.einsum('bhqk,bkhd->bqhd', p, v)

    o = lax.map(q_block, (qn_b, qr_b, jnp.arange(n_blk)))
    return o.transpose(1, 0, 2, 3, 4).reshape(b, s, MLA_WIDTH)


def _sgu(u, v, sgu_gain, sgu_bias, w_spatial, b_spatial):
    b, s, _ = v.shape
    v = _layernorm(v, sgu_gain, sgu_bias)
    v = v.reshape(b, s // SGU_LEN, SGU_LEN, SGU_GROUPS, SGU_GROUP_DIM)
    idx = jnp.arange(SGU_LEN) // CHUNK
    mask = idx[:, None] >= idx[None, :]
    w = jnp.where(mask[None], w_spatial, jnp.zeros_like(w_spatial))
    sv = jnp.einsum('gij,bnjgc->bnigc', w, v) + b_spatial.T[None, None, :, :, None]
    return u * sv.reshape(b, s, SGU_WIDTH)


def _hier_moe(h, w_rg, b_rg, w_re, b_re, w_eg, w_eu, w_ed):
    b, s, d = h.shape
    n = b * s
    xf = h.reshape(n, d)
    p_group = jax.nn.softmax((xf @ w_rg + b_rg).astype(jnp.float32), axis=-1)
    p_top, g_idx = lax.top_k(p_group, 1)
    le = (jnp.einsum('nd,gde->nge', xf, w_re) + b_re[None]).astype(jnp.float32)
    le_sel = jnp.take_along_axis(le, g_idx[:, :, None], axis=1)[:, 0, :]
    top_l, e_loc = lax.top_k(le_sel, TOP_K)
    gate = (jax.nn.softmax(top_l, axis=-1) * p_top).astype(h.dtype)
    e_glob = g_idx * EXPERTS_PER_GROUP + e_loc
    a = n * TOP_K
    e_flat = e_glob.reshape(a)
    tok_flat = jnp.repeat(jnp.arange(n, dtype=jnp.int32), TOP_K)
    w_flat = gate.reshape(a)
    order = jnp.argsort(e_flat)
    e_sorted = e_flat[order]
    tok_sorted = tok_flat[order]
    w_sorted = w_flat[order]
    counts = jnp.zeros((N_EXPERTS,), jnp.int32).at[e_flat].add(1)
    starts = jnp.cumsum(counts) - counts
    pcounts = (counts + MOE_BLOCK - 1) // MOE_BLOCK * MOE_BLOCK
    pends = jnp.cumsum(pcounts)
    pstarts = pends - pcounts
    rank = jnp.arange(a, dtype=jnp.int32) - starts[e_sorted]
    dest = pstarts[e_sorted] + rank
    p_rows = a + N_EXPERTS * MOE_BLOCK
    buf_tok = jnp.zeros((p_rows,), jnp.int32).at[dest].set(tok_sorted)
    buf_w = jnp.zeros((p_rows,), h.dtype).at[dest].set(w_sorted)
    n_blk = p_rows // MOE_BLOCK
    blk_e = jnp.clip(jnp.searchsorted(pends, jnp.arange(n_blk, dtype=jnp.int32) * MOE_BLOCK,
                                      side='right'), 0, N_EXPERTS - 1)
    xs = xf[buf_tok].reshape(n_blk, MOE_BLOCK, d)

    def expert_block(args):
        xb, e = args
        hid = jax.nn.silu(xb @ w_eg[e]) * (xb @ w_eu[e])
        return hid @ w_ed[e]

    ys = lax.map(expert_block, (xs, blk_e)).reshape(p_rows, d)
    out = jnp.zeros((n, d), h.dtype).at[buf_tok].add(ys * buf_w[:, None])
    return out.reshape(b, s, d)


def setup_inputs(seed: int = 0) -> dict:
    key = jax.random.key(seed)
    ks = jax.random.split(key, 26)
    f32 = jnp.float32

    def nrm(k, shape, fan_in):
        return jax.random.normal(k, shape, f32) * (fan_in ** -0.5)

    def gain(k, shape):
        return 1.0 + 0.02 * jax.random.normal(k, shape, f32)

    L = DEPTH
    x = jax.random.normal(ks[0], (BATCH, SEQ, D_MODEL), f32)
    offset = jax.random.randint(ks[1], (BATCH, 1), 0, 1024, dtype=jnp.int32)
    positions = offset + jnp.arange(SEQ, dtype=jnp.int32)[None, :]
    return {
        "x": x,
        "positions": positions,
        "g_attn_norm": gain(ks[2], (L, D_MODEL)),
        "w_in": nrm(ks[3], (L, D_MODEL, IN_COLS), D_MODEL),
        "g_cq": gain(ks[4], (L, Q_RANK)),
        "w_uq": nrm(ks[5], (L, Q_RANK, MLA_HEADS * (QK_NOPE + QK_ROPE)), Q_RANK),
        "g_ckv": gain(ks[6], (L, KV_RANK)),
        "w_uk": nrm(ks[7], (L, KV_RANK, MLA_HEADS * QK_NOPE), KV_RANK),
        "w_uv": nrm(ks[8], (L, KV_RANK, MLA_WIDTH), KV_RANK),
        "w_o_attn": nrm(ks[9], (L, MLA_WIDTH, D_MODEL), MLA_WIDTH),
        "sgu_gain": gain(ks[10], (L, SGU_WIDTH)),
        "sgu_bias": 0.02 * jax.random.normal(ks[11], (L, SGU_WIDTH), f32),
        "w_spatial": nrm(ks[12], (L, SGU_GROUPS, SGU_LEN, SGU_LEN), SGU_LEN),
        "b_spatial": gain(ks[13], (L, SGU_GROUPS, SGU_LEN)),
        "w_o_sgu": nrm(ks[14], (L, SGU_WIDTH, D_MODEL), SGU_WIDTH),
        "w_out": nrm(ks[15], (L, D_MODEL, D_MODEL), D_MODEL),
        "g_ffn_norm": gain(ks[16], (L, D_MODEL)),
        "w_router_group": nrm(ks[17], (L, D_MODEL, N_GROUPS), D_MODEL),
        "b_router_group": 0.01 * jax.random.normal(ks[18], (L, N_GROUPS), f32),
        "w_router_expert": nrm(ks[19], (L, N_GROUPS, D_MODEL, EXPERTS_PER_GROUP), D_MODEL),
        "b_router_expert": 0.01 * jax.random.normal(ks[20], (L, N_GROUPS, EXPERTS_PER_GROUP), f32),
        "w_exp_gate": nrm(ks[21], (L, N_EXPERTS, D_MODEL, D_EXPERT), D_MODEL),
        "w_exp_up": nrm(ks[22], (L, N_EXPERTS, D_MODEL, D_EXPERT), D_MODEL),
        "w_exp_down": nrm(ks[23], (L, N_EXPERTS, D_EXPERT, D_MODEL), D_EXPERT),
        "g_final": gain(ks[24], (D_MODEL,)),
    }


def reference(x, positions, g_attn_norm, w_in, g_cq, w_uq, g_ckv, w_uk, w_uv, w_o_attn,
              sgu_gain, sgu_bias, w_spatial, b_spatial, w_o_sgu, w_out, g_ffn_norm,
              w_router_group, b_router_group, w_router_expert, b_router_expert,
              w_exp_gate, w_exp_up, w_exp_down, g_final):
    for l in range(DEPTH):
        h = _rmsnorm(x, g_attn_norm[l])
        z = h @ w_in[l]
        c_q, c_kv, k_r, uv, gate_logits = jnp.split(z, SPLIT_POINTS, axis=-1)
        attn = _mla(c_q, c_kv, k_r, positions, g_cq[l], w_uq[l], g_ckv[l], w_uk[l], w_uv[l])
        attn = attn @ w_o_attn[l]
        uv = jax.nn.gelu(uv)
        u, v = uv[..., :SGU_WIDTH], uv[..., SGU_WIDTH:]
        sgu = _sgu(u, v, sgu_gain[l], sgu_bias[l], w_spatial[l], b_spatial[l]) @ w_o_sgu[l]
        gates = jax.nn.sigmoid(gate_logits.astype(jnp.float32)).astype(x.dtype)
        g_a, g_b = gates[..., :D_MODEL], gates[..., D_MODEL:]
        x = x + (g_a * attn + g_b * sgu) @ w_out[l]
        x = x + _hier_moe(_rmsnorm(x, g_ffn_norm[l]), w_router_group[l], b_router_group[l],
                          w_router_expert[l], b_router_expert[l],
                          w_exp_gate[l], w_exp_up[l], w_exp_down[l])
    return _rmsnorm(x, g_final)
```

```cpp
#include <hip/hip_runtime.h>
#include <hip/hip_cooperative_groups.h>
#include <cstdint>
#include <cstdio>
namespace cg = cooperative_groups;

#ifndef MK_LAUNCHES
#define MK_LAUNCHES 0
#endif

typedef unsigned short bf16_t;
constexpr int NT = 16384, SEQ = 8192, DM = 1024, NBATCH = 2;
constexpr int ZC = 3488;
constexpr int ZP = 3584;
constexpr int NH = 8;
constexpr float EPS = 1e-6f;
constexpr int NE = 32;

struct P {
    const float* x; const int* pos; const float* g_attn; const float* w_in; const float* g_cq; const float* w_uq;
    const float* g_ckv; const float* w_uk; const float* w_uv; const float* w_o_attn; const float* sgu_gain; const float* sgu_bias;
    const float* w_sp; const float* b_sp; const float* w_o_sgu; const float* w_out; const float* g_ffn; const float* w_rg;
    const float* b_rg; const float* w_re; const float* b_re; const float* w_eg; const float* w_eu; const float* w_ed; const float* g_final;
    float* out;
    int* cnt;
    bf16_t* WinT;
    bf16_t* WuqT;
    bf16_t* WukT;
    bf16_t* WuvT;
    bf16_t* WoaT;
    bf16_t* WosT;
    bf16_t* WoutT;
    bf16_t* Wsp;
    float* cs;
    bf16_t* cqn;
    bf16_t* ckvn;
    int* list;
    float* aw;
    int* aexp;
    bf16_t* slotA;
    unsigned char* slotB;
    bf16_t* slotC;
    bf16_t* slotD;
    bf16_t* slotE;
    bf16_t* slotF;
    bf16_t* slotG;
};

__device__ __forceinline__ float bf2f(bf16_t v) { return __uint_as_float(((unsigned)v) << 16); }
__device__ __forceinline__ bf16_t f2bf(float f) { unsigned u = __float_as_uint(f); u += 0x7fffu + ((u >> 16) & 1u); return (bf16_t)(u >> 16); }
__device__ __forceinline__ float dot8(const uint4 a, const uint4 b) {
    float s = 0.f;
    s += __uint_as_float(a.x << 16) * __uint_as_float(b.x << 16) + __uint_as_float(a.x & 0xffff0000u) * __uint_as_float(b.x & 0xffff0000u);
    s += __uint_as_float(a.y << 16) * __uint_as_float(b.y << 16) + __uint_as_float(a.y & 0xffff0000u) * __uint_as_float(b.y & 0xffff0000u);
    s += __uint_as_float(a.z << 16) * __uint_as_float(b.z << 16) + __uint_as_float(a.z & 0xffff0000u) * __uint_as_float(b.z & 0xffff0000u);
    s += __uint_as_float(a.w << 16) * __uint_as_float(b.w << 16) + __uint_as_float(a.w & 0xffff0000u) * __uint_as_float(b.w & 0xffff0000u);
    return s;
}
__device__ __forceinline__ float wsum(float v) { for (int o = 32; o > 0; o >>= 1) v += __shfl_xor(v, o); return v; }
__device__ __forceinline__ float wmax(float v) { for (int o = 32; o > 0; o >>= 1) v = fmaxf(v, __shfl_xor(v, o)); return v; }
__device__ __forceinline__ float gelu_tanh(float v) { const float u = 0.7978845608028654f * (v + 0.044715f * v * v * v); const float t = 1.f - 2.f / (__expf(2.f * u) + 1.f); return 0.5f * v * (1.f + t); }
__device__ __forceinline__ float sigmoidf_(float v) { return 1.f / (1.f + __expf(-v)); }

__device__ void phase0(const P& p, int bid, int nb) {
    const int tid = threadIdx.x, lane = tid & 63, wid = tid >> 6;
    const size_t gtid = (size_t)bid * 256 + tid, gsz = (size_t)nb * 256;
    if (bid == 0 && tid < NE) p.cnt[tid] = 0;
    for (int t = bid * 4 + wid; t < NT; t += nb * 4) {
        const float* xr = p.x + (size_t)t * DM; float v[16]; float ss = 0.f;
#pragma unroll
        for (int i = 0; i < 16; ++i) { v[i] = xr[lane + 64 * i]; ss += v[i] * v[i]; }
        ss = wsum(ss); const float r = rsqrtf(ss * (1.f / DM) + EPS);
        bf16_t* hr = p.slotA + (size_t)t * DM;
#pragma unroll
        for (int i = 0; i < 16; ++i) hr[lane + 64 * i] = f2bf(v[i] * r);
    }
    for (size_t i = gtid; i < (size_t)ZP * DM; i += gsz) { const int k = (int)(i / ZP), rho = (int)(i % ZP); float v = 0.f;
        if (rho < 416) v = p.w_in[(size_t)k * ZC + rho]; else if (rho >= 512) v = p.w_in[(size_t)k * ZC + rho - 96];
        p.WinT[(size_t)rho * DM + k] = f2bf(v * p.g_attn[k]); }
    const float qscale = 0.10206207261596575f * 1.4426950408889634f;
    for (size_t i = gtid; i < (size_t)768 * 256; i += gsz) { const int k = (int)(i / 768), rho = (int)(i % 768); int col;
        if (rho < 512) col = (rho >> 6) * 96 + (rho & 63); else { const int hh = (rho - 512) >> 5, w = (rho - 512) & 31; col = hh * 96 + 64 + (w >> 1) + 16 * (w & 1); }
        p.WuqT[(size_t)rho * 256 + k] = f2bf(p.w_uq[(size_t)k * 768 + col] * p.g_cq[k] * qscale); }
    for (size_t i = gtid; i < (size_t)512 * 128; i += gsz) { const int k = (int)(i / 512), c = (int)(i % 512);
        p.WukT[(size_t)c * 128 + k] = f2bf(p.w_uk[(size_t)k * 512 + c] * p.g_ckv[k]);
        p.WuvT[(size_t)c * 128 + k] = f2bf(p.w_uv[(size_t)k * 512 + c] * p.g_ckv[k]); }
    for (size_t i = gtid; i < (size_t)1024 * 512; i += gsz) { const int k = (int)(i / 1024), n = (int)(i % 1024);
        p.WoaT[(size_t)n * 512 + k] = f2bf(p.w_o_attn[(size_t)k * 1024 + n]);
        p.WosT[(size_t)n * 512 + k] = f2bf(p.w_o_sgu[(size_t)k * 1024 + n]); }
    for (size_t i = gtid; i < (size_t)1024 * 1024; i += gsz) { const int k = (int)(i / 1024), n = (int)(i % 1024);
        p.WoutT[(size_t)n * 1024 + k] = f2bf(p.w_out[(size_t)k * 1024 + n]); }
    for (size_t i = gtid; i < (size_t)8 * 128 * 128; i += gsz) { const int j = (int)(i & 127), ii = (int)((i >> 7) & 127);
        p.Wsp[i] = ((j >> 6) <= (ii >> 6)) ? f2bf(p.w_sp[i]) : (bf16_t)0; }
}

template <class Epi>
__device__ void ngemm(const bf16_t* A, int lda, const bf16_t* Bt, int ldb, int M, int N, int K, Epi epi, int bid, int nb, float* sm) {
    float* As = sm; float* Bs = sm + 16 * 68;
    const int tid = threadIdx.x, ty = tid >> 4, tx = tid & 15; const int tn = N / 64, ntile = (M / 64) * tn;
    for (int tile = bid; tile < ntile; tile += nb) {
        const int row0 = (tile / tn) * 64, col0 = (tile % tn) * 64;
        float acc[4][4];
#pragma unroll
        for (int i = 0; i < 4; ++i)
#pragma unroll
            for (int j = 0; j < 4; ++j) acc[i][j] = 0.f;
        for (int k0 = 0; k0 < K; k0 += 16) {
#pragma unroll
            for (int i = 0; i < 4; ++i) { const int idx = tid + i * 256, r = idx >> 4, kk = idx & 15;
                As[kk * 68 + r] = bf2f(A[(size_t)(row0 + r) * lda + k0 + kk]);
                Bs[kk * 68 + r] = bf2f(Bt[(size_t)(col0 + r) * ldb + k0 + kk]); }
            __syncthreads();
#pragma unroll
            for (int kk = 0; kk < 16; ++kk) { float a[4], b[4];
#pragma unroll
                for (int i = 0; i < 4; ++i) { a[i] = As[kk * 68 + ty * 4 + i]; b[i] = Bs[kk * 68 + tx * 4 + i]; }
#pragma unroll
                for (int i = 0; i < 4; ++i)
#pragma unroll
                    for (int j = 0; j < 4; ++j) acc[i][j] += a[i] * b[j]; }
            __syncthreads();
        }
#pragma unroll
        for (int i = 0; i < 4; ++i) epi(row0 + ty * 4 + i, col0 + tx * 4, acc[i]);
    }
}

__device__ void phase1(const P& p, int bid, int nb, float* sm) {
    float* zs = (float*)p.slotB; bf16_t* uvg = p.slotC; bf16_t* gates = p.slotD;
    ngemm(p.slotA, DM, p.WinT, DM, NT, ZP, DM, [=](int t, int c, const float* v) {
#pragma unroll
        for (int j = 0; j < 4; ++j) { const int cc = c + j;
            if (cc < 512) zs[(size_t)t * 512 + cc] = v[j];
            else if (cc < 1536) uvg[(size_t)t * 1024 + cc - 512] = f2bf(gelu_tanh(v[j]));
            else gates[(size_t)t * 2048 + cc - 1536] = f2bf(sigmoidf_(v[j])); }
    }, bid, nb, sm);
}

__device__ void phase2a(const P& p, int bid, int nb) {
    const int tid = threadIdx.x, lane = tid & 63, wid = tid >> 6;
    const float* zs = (const float*)p.slotB; bf16_t* K = p.slotE; bf16_t* uvg = p.slotC;
    for (int t = bid * 4 + wid; t < NT; t += nb * 4) {
        const float* z = zs + (size_t)t * 512;
        { float v[4]; float ss = 0.f;
#pragma unroll
          for (int i = 0; i < 4; ++i) { v[i] = z[lane + 64 * i]; ss += v[i] * v[i]; }
          ss = wsum(ss); const float r = rsqrtf(ss * (1.f / 256.f) + EPS);
#pragma unroll
          for (int i = 0; i < 4; ++i) p.cqn[(size_t)t * 256 + lane + 64 * i] = f2bf(v[i] * r); }
        { float v[2]; float ss = 0.f;
#pragma unroll
          for (int i = 0; i < 2; ++i) { v[i] = z[256 + lane + 64 * i]; ss += v[i] * v[i]; }
          ss = wsum(ss); const float r = rsqrtf(ss * (1.f / 128.f) + EPS);
#pragma unroll
          for (int i = 0; i < 2; ++i) p.ckvn[(size_t)t * 128 + lane + 64 * i] = f2bf(v[i] * r); }
        const int b = t >> 13, s = t & 8191;
        if (lane < 16) {
            const float fr4[4] = {1.0f, 0.5623413251903491f, 0.31622776601683794f, 0.1778279410038923f};
            float f = (lane & 3) == 0 ? fr4[0] : (lane & 3) == 1 ? fr4[1] : (lane & 3) == 2 ? fr4[2] : fr4[3];
            const int q4 = lane >> 2; f *= (q4 == 0 ? 1.0f : q4 == 1 ? 0.1f : q4 == 2 ? 0.01f : 0.001f);
            const float ang = (float)p.pos[t] * f;
            const double rev = (double)ang * 0.15915494309189535; const float fr = (float)(rev - floor(rev));
            const float sn = __builtin_amdgcn_sinf(fr), cn = __builtin_amdgcn_cosf(fr);
            p.cs[(size_t)t * 32 + lane] = cn; p.cs[(size_t)t * 32 + 16 + lane] = sn;
            const float k1 = z[384 + lane], k2 = z[400 + lane];
            const bf16_t o1 = f2bf(k1 * cn - k2 * sn), o2 = f2bf(k1 * sn + k2 * cn);
#pragma unroll
            for (int h = 0; h < NH; ++h) { bf16_t* kr = K + ((size_t)(b * NH + h) * SEQ + s) * 96; kr[64 + lane] = o1; kr[80 + lane] = o2; }
        }
        { bf16_t* vr = uvg + (size_t)t * 1024 + 512; float v[8]; float sm_ = 0.f;
#pragma unroll
          for (int i = 0; i < 8; ++i) { v[i] = bf2f(vr[lane + 64 * i]); sm_ += v[i]; }
          sm_ = wsum(sm_); const float mu = sm_ * (1.f / 512.f); float q = 0.f;
#pragma unroll
          for (int i = 0; i < 8; ++i) { const float d = v[i] - mu; q += d * d; }
          q = wsum(q); const float r = rsqrtf(q * (1.f / 512.f) + EPS);
#pragma unroll
          for (int i = 0; i < 8; ++i) { const int c = lane + 64 * i; vr[c] = f2bf((v[i] - mu) * r * p.sgu_gain[c] + p.sgu_bias[c]); } }
    }
}

__device__ void phase2b(const P& p, int bid, int nb, float* sm) {
    bf16_t* Q = p.slotA; bf16_t* K = p.slotE; bf16_t* VT = p.slotF; const float* cs = p.cs;
    ngemm(p.cqn, 256, p.WuqT, 256, NT, 768, 256, [=](int t, int c, const float* v) {
        const int b = t >> 13, s = t & 8191;
        if (c < 512) { const int h = c >> 6, d = c & 63; bf16_t* q = Q + ((size_t)(b * NH + h) * SEQ + s) * 96 + d;
#pragma unroll
            for (int j = 0; j < 4; ++j) q[j] = f2bf(v[j]); }
        else { const int h = (c - 512) >> 5, i0 = ((c - 512) & 31) >> 1; bf16_t* q = Q + ((size_t)(b * NH + h) * SEQ + s) * 96;
#pragma unroll
            for (int e = 0; e < 2; ++e) { const int i = i0 + e; const float cn = cs[(size_t)t * 32 + i], sn = cs[(size_t)t * 32 + 16 + i]; const float x1 = v[2 * e], x2 = v[2 * e + 1];
                q[64 + i] = f2bf(x1 * cn - x2 * sn); q[80 + i] = f2bf(x1 * sn + x2 * cn); } }
    }, bid, nb, sm);
    ngemm(p.ckvn, 128, p.WukT, 128, NT, 512, 128, [=](int t, int c, const float* v) {
        const int b = t >> 13, s = t & 8191, h = c >> 6, d = c & 63; bf16_t* k = K + ((size_t)(b * NH + h) * SEQ + s) * 96 + d;
#pragma unroll
        for (int j = 0; j < 4; ++j) k[j] = f2bf(v[j]);
    }, bid, nb, sm);
    ngemm(p.WuvT, 128, p.ckvn, 128, 512, NT, 128, [=](int r, int t, const float* v) {
#pragma unroll
        for (int j = 0; j < 4; ++j) VT[(size_t)r * NT + t + j] = f2bf(v[j]);
    }, bid, nb, sm);
}

__device__ void phase2c(const P& p, int bid, int nb) {
    const bf16_t* uvg = p.slotC; bf16_t* su = p.slotG;
    for (size_t i = (size_t)bid * 256 + threadIdx.x; i < (size_t)NT * 512; i += (size_t)nb * 256) {
        const int t = (int)(i >> 9), c = (int)(i & 511), g = c >> 6, ii = t & 127, t0 = t - ii;
        const bf16_t* w = p.Wsp + ((size_t)g * 128 + ii) * 128; float s = 0.f;
        for (int j = 0; j < 128; ++j) s += bf2f(w[j]) * bf2f(uvg[(size_t)(t0 + j) * 1024 + 512 + c]);
        s += p.b_sp[g * 128 + ii];
        su[i] = f2bf(bf2f(uvg[(size_t)t * 1024 + c]) * s);
    }
}

__device__ void phase3(const P& p, int bid, int nb, float* sm) {
    float* sc = sm; float* qs = sm + 8192; float* red = qs + 96;
    const bf16_t* Q = p.slotA; const bf16_t* K = p.slotE; const bf16_t* VT = p.slotF; bf16_t* O = (bf16_t*)p.slotB;
    const int tid = threadIdx.x;
    for (int row = bid; row < NBATCH * NH * SEQ; row += nb) {
        const int q = row % SEQ, bh = row / SEQ, nk = ((q >> 6) + 1) * 64;
        if (tid < 12) ((uint4*)qs)[tid] = ((const uint4*)(Q + ((size_t)bh * SEQ + q) * 96))[tid];
        __syncthreads();
        float mx = -1e30f;
        for (int k = tid; k < nk; k += 256) { const uint4* kp = (const uint4*)(K + ((size_t)bh * SEQ + k) * 96); float s = 0.f;
#pragma unroll
            for (int d = 0; d < 12; ++d) s += dot8(((const uint4*)qs)[d], kp[d]);
            sc[k] = s; mx = fmaxf(mx, s); }
        mx = wmax(mx); if ((tid & 63) == 0) red[tid >> 6] = mx; __syncthreads();
        mx = fmaxf(fmaxf(red[0], red[1]), fmaxf(red[2], red[3])); __syncthreads();
        float sum = 0.f;
        for (int k = tid; k < nk; k += 256) { const float e = exp2f(sc[k] - mx); sc[k] = e; sum += e; }
        sum = wsum(sum); if ((tid & 63) == 0) red[tid >> 6] = sum; __syncthreads();
        sum = (red[0] + red[1]) + (red[2] + red[3]);
        const int dv = tid >> 2, part = tid & 3, h = bh & 7, b = bh >> 3;
        const bf16_t* vp = VT + (size_t)(h * 64 + dv) * NT + (size_t)b * SEQ; float o = 0.f;
        for (int k = part; k < nk; k += 4) o += sc[k] * bf2f(vp[k]);
        o += __shfl_xor(o, 1); o += __shfl_xor(o, 2);
        if (part == 0) O[(size_t)(b * SEQ + q) * 512 + h * 64 + dv] = f2bf(o / sum);
        __syncthreads();
    }
}

__device__ void phase4(const P& p, int bid, int nb, float* sm) {
    float* As = sm; float* Bs = sm + 16 * 68;
    const bf16_t* O = (const bf16_t*)p.slotB; const bf16_t* su = p.slotG; const bf16_t* gates = p.slotD; bf16_t* m = p.slotA;
    const int tid = threadIdx.x, ty = tid >> 4, tx = tid & 15; const int tn = DM / 64, ntile = (NT / 64) * tn;
    for (int tile = bid; tile < ntile; tile += nb) {
        const int row0 = (tile / tn) * 64, col0 = (tile % tn) * 64;
        float acc[2][4][4];
#pragma unroll
        for (int w = 0; w < 2; ++w)
#pragma unroll
            for (int i = 0; i < 4; ++i)
#pragma unroll
                for (int j = 0; j < 4; ++j) acc[w][i][j] = 0.f;
#pragma unroll
        for (int w = 0; w < 2; ++w) {
            const bf16_t* A = w ? su : O; const bf16_t* Bt = w ? p.WosT : p.WoaT;
            for (int k0 = 0; k0 < 512; k0 += 16) {
#pragma unroll
                for (int i = 0; i < 4; ++i) { const int idx = tid + i * 256, r = idx >> 4, kk = idx & 15;
                    As[kk * 68 + r] = bf2f(A[(size_t)(row0 + r) * 512 + k0 + kk]);
                    Bs[kk * 68 + r] = bf2f(Bt[(size_t)(col0 + r) * 512 + k0 + kk]); }
                __syncthreads();
#pragma unroll
                for (int kk = 0; kk < 16; ++kk) { float a[4], b[4];
#pragma unroll
                    for (int i = 0; i < 4; ++i) { a[i] = As[kk * 68 + ty * 4 + i]; b[i] = Bs[kk * 68 + tx * 4 + i]; }
#pragma unroll
                    for (int i = 0; i < 4; ++i)
#pragma unroll
                        for (int j = 0; j < 4; ++j) acc[w][i][j] += a[i] * b[j]; }
                __syncthreads();
            }
        }
#pragma unroll
        for (int i = 0; i < 4; ++i)
#pragma unroll
            for (int j = 0; j < 4; ++j) { const int t = row0 + ty * 4 + i, c = col0 + tx * 4 + j;
                const float ga = bf2f(gates[(size_t)t * 2048 + c]), gb = bf2f(gates[(size_t)t * 2048 + 1024 + c]);
                m[(size_t)t * DM + c] = f2bf(ga * acc[0][i][j] + gb * acc[1][i][j]); }
    }
}

__device__ void phase5(const P& p, int bid, int nb, float* sm) {
    const float* x = p.x; float* xm = p.out;
    ngemm(p.slotA, DM, p.WoutT, DM, NT, DM, DM, [=](int t, int c, const float* v) {
#pragma unroll
        for (int j = 0; j < 4; ++j) xm[(size_t)t * DM + c + j] = x[(size_t)t * DM + c + j] + v[j];
    }, bid, nb, sm);
}

__device__ __forceinline__ int gu_src_col(int rho, int& isup) {
    const int tt = rho >> 7, w = rho & 127, wc = w >> 6, n = (w >> 4) & 3, i = w & 15; isup = n >> 1; return tt * 64 + wc * 32 + (n & 1) * 16 + i;
}
__device__ void phase6(const P& p, int bid, int nb) {
    const int tid = threadIdx.x, lane = tid & 63, wid = tid >> 6;
    bf16_t* h2 = p.slotA; const float* xm = p.out;
    for (int t = bid * 4 + wid; t < NT; t += nb * 4) {
        float v[16]; float ss = 0.f;
#pragma unroll
        for (int i = 0; i < 16; ++i) { v[i] = xm[(size_t)t * DM + lane + 64 * i]; ss += v[i] * v[i]; }
        ss = wsum(ss); const float r = rsqrtf(ss * (1.f / DM) + EPS);
#pragma unroll
        for (int i = 0; i < 16; ++i) { v[i] = v[i] * r * p.g_ffn[lane + 64 * i]; h2[(size_t)t * DM + lane + 64 * i] = f2bf(v[i]); }
        float lg[4] = {0.f, 0.f, 0.f, 0.f};
#pragma unroll
        for (int i = 0; i < 16; ++i) { const float* w = p.w_rg + (size_t)(lane + 64 * i) * 4;
#pragma unroll
            for (int g = 0; g < 4; ++g) lg[g] += v[i] * w[g]; }
#pragma unroll
        for (int g = 0; g < 4; ++g) lg[g] = wsum(lg[g]) + p.b_rg[g];
        int gs = 0; float gm = lg[0];
#pragma unroll
        for (int g = 1; g < 4; ++g) if (lg[g] > gm) { gm = lg[g]; gs = g; }
        float den = 0.f;
#pragma unroll
        for (int g = 0; g < 4; ++g) den += __expf(lg[g] - gm);
        const float ptop = 1.f / den;
        float le[8] = {0.f, 0.f, 0.f, 0.f, 0.f, 0.f, 0.f, 0.f};
#pragma unroll
        for (int i = 0; i < 16; ++i) { const float* w = p.w_re + ((size_t)gs * DM + lane + 64 * i) * 8;
#pragma unroll
            for (int e = 0; e < 8; ++e) le[e] += v[i] * w[e]; }
#pragma unroll
        for (int e = 0; e < 8; ++e) le[e] = wsum(le[e]) + p.b_re[gs * 8 + e];
        int e1 = 0; float l1 = le[0];
#pragma unroll
        for (int e = 1; e < 8; ++e) if (le[e] > l1) { l1 = le[e]; e1 = e; }
        int e2 = -1; float l2 = -3.0e38f;
#pragma unroll
        for (int e = 0; e < 8; ++e) if (e != e1 && le[e] > l2) { l2 = le[e]; e2 = e; }
        const float s1 = 1.f / (1.f + __expf(l2 - l1)), s2 = 1.f - s1;
        if (lane == 0) {
            const int ea = gs * 8 + e1, eb = gs * 8 + e2;
            const int ra = atomicAdd(&p.cnt[ea], 1); p.list[(size_t)ea * NT + ra] = 2 * t;
            const int rb = atomicAdd(&p.cnt[eb], 1); p.list[(size_t)eb * NT + rb] = 2 * t + 1;
            p.aw[2 * t] = s1 * ptop; p.aw[2 * t + 1] = s2 * ptop; p.aexp[2 * t] = ea; p.aexp[2 * t + 1] = eb;
        }
    }
    bf16_t* WguT = (bf16_t*)p.slotB; bf16_t* WdT = WguT + (size_t)NE * 512 * 1024;
    const size_t gtid = (size_t)bid * 256 + tid, gsz = (size_t)nb * 256;
    for (size_t i = gtid; i < (size_t)NE * 1024 * 512; i += gsz) { const int rho = (int)(i & 511), k = (int)((i >> 9) & 1023), e = (int)(i >> 19);
        int isup; const int col = gu_src_col(rho, isup); const float* src = isup ? p.w_eu : p.w_eg;
        WguT[((size_t)e * 512 + rho) * 1024 + k] = f2bf(src[((size_t)e * 1024 + k) * 256 + col]); }
    for (size_t i = gtid; i < (size_t)NE * 256 * 1024; i += gsz) { const int n = (int)(i & 1023), c = (int)((i >> 10) & 255), e = (int)(i >> 18);
        WdT[((size_t)e * 1024 + n) * 256 + c] = f2bf(p.w_ed[((size_t)e * 256 + c) * 1024 + n]); }
}

__device__ void phase7a(const P& p, int bid, int nb) {
    const bf16_t* h2 = p.slotA; const bf16_t* WguT = (const bf16_t*)p.slotB; bf16_t* hid = p.slotE;
    for (size_t i = (size_t)bid * 256 + threadIdx.x; i < (size_t)2 * NT * 256; i += (size_t)nb * 256) {
        const int a = (int)(i >> 8), c = (int)(i & 255), t = a >> 1, e = p.aexp[a];
        const int tt = c >> 6, wc = (c >> 5) & 1, nn = (c >> 4) & 1, ii = c & 15; const int rg = tt * 128 + wc * 64 + nn * 16 + ii, ru = rg + 32;
        const bf16_t* wg = WguT + ((size_t)e * 512 + rg) * 1024; const bf16_t* wu = WguT + ((size_t)e * 512 + ru) * 1024; const bf16_t* hr = h2 + (size_t)t * DM;
        float G = 0.f, U = 0.f;
        for (int k = 0; k < DM / 8; ++k) { const uint4 hv = ((const uint4*)hr)[k]; G += dot8(hv, ((const uint4*)wg)[k]); U += dot8(hv, ((const uint4*)wu)[k]); }
        hid[i] = f2bf(G * sigmoidf_(G) * U);
    }
}
__device__ void phase7b(const P& p, int bid, int nb) {
    const bf16_t* hid = p.slotE; const bf16_t* WdT = (const bf16_t*)p.slotB + (size_t)NE * 512 * 1024; bf16_t* Y = p.slotD;
    for (size_t i = (size_t)bid * 256 + threadIdx.x; i < (size_t)2 * NT * DM; i += (size_t)nb * 256) {
        const int a = (int)(i >> 10), n = (int)(i & 1023), e = p.aexp[a];
        const bf16_t* w = WdT + ((size_t)e * 1024 + n) * 256; const bf16_t* hr = hid + (size_t)a * 256; float s = 0.f;
        for (int k = 0; k < 32; ++k) s += dot8(((const uint4*)hr)[k], ((const uint4*)w)[k]);
        Y[i] = f2bf(s * p.aw[a]);
    }
}

__device__ void phase8(const P& p, int bid, int nb) {
    const int tid = threadIdx.x, lane = tid & 63, wid = tid >> 6; const bf16_t* Y = p.slotD;
    for (int t = bid * 4 + wid; t < NT; t += nb * 4) {
        float v[16]; float ss = 0.f;
#pragma unroll
        for (int i = 0; i < 16; ++i) { const int c = lane + 64 * i; v[i] = p.out[(size_t)t * DM + c] + bf2f(Y[(size_t)(2 * t) * DM + c]) + bf2f(Y[(size_t)(2 * t + 1) * DM + c]); ss += v[i] * v[i]; }
        ss = wsum(ss); const float r = rsqrtf(ss * (1.f / DM) + EPS);
#pragma unroll
        for (int i = 0; i < 16; ++i) { const int c = lane + 64 * i; p.out[(size_t)t * DM + c] = v[i] * r * p.g_final[c]; }
    }
}

constexpr int LDS_BYTES = 36 * 1024;
extern __shared__ __attribute__((aligned(16))) unsigned char smem_raw[];

__global__ void __launch_bounds__(256) k_phase(P p, int ph) {
    float* sm = (float*)smem_raw; const int bid = blockIdx.x, nb = gridDim.x;
    switch (ph) {
        case 0: phase0(p, bid, nb); break;
        case 1: phase1(p, bid, nb, sm); break;
        case 2: phase2a(p, bid, nb); break;
        case 3: phase2b(p, bid, nb, sm); break;
        case 4: phase2c(p, bid, nb); break;
        case 5: phase3(p, bid, nb, sm); break;
        case 6: phase4(p, bid, nb, sm); break;
        case 7: phase5(p, bid, nb, sm); break;
        case 8: phase6(p, bid, nb); break;
        case 9: phase7a(p, bid, nb); break;
        case 10: phase7b(p, bid, nb); break;
        case 11: phase8(p, bid, nb); break;
    }
}

__global__ void __launch_bounds__(256) k_mega(P p) {
    cg::grid_group grid = cg::this_grid();
    float* sm = (float*)smem_raw; const int bid = blockIdx.x, nb = gridDim.x;
    phase0(p, bid, nb); grid.sync();
    phase1(p, bid, nb, sm); grid.sync();
    phase2a(p, bid, nb); grid.sync();
    phase2b(p, bid, nb, sm); phase2c(p, bid, nb); grid.sync();
    phase3(p, bid, nb, sm); grid.sync();
    phase4(p, bid, nb, sm); grid.sync();
    phase5(p, bid, nb, sm); grid.sync();
    phase6(p, bid, nb); grid.sync();
    phase7a(p, bid, nb); grid.sync();
    phase7b(p, bid, nb); grid.sync();
    phase8(p, bid, nb);
}

extern "C" void kernel_launch(void* const* d_in, const int* in_sizes, int n_in, void* d_out, int out_size, void* d_ws, size_t ws_size, hipStream_t stream) {
    P p{};
    p.x = (const float*)d_in[0]; p.pos = (const int*)d_in[1]; p.g_attn = (const float*)d_in[2]; p.w_in = (const float*)d_in[3]; p.g_cq = (const float*)d_in[4];
    p.w_uq = (const float*)d_in[5]; p.g_ckv = (const float*)d_in[6]; p.w_uk = (const float*)d_in[7]; p.w_uv = (const float*)d_in[8]; p.w_o_attn = (const float*)d_in[9];
    p.sgu_gain = (const float*)d_in[10]; p.sgu_bias = (const float*)d_in[11]; p.w_sp = (const float*)d_in[12]; p.b_sp = (const float*)d_in[13]; p.w_o_sgu = (const float*)d_in[14];
    p.w_out = (const float*)d_in[15]; p.g_ffn = (const float*)d_in[16]; p.w_rg = (const float*)d_in[17]; p.b_rg = (const float*)d_in[18]; p.w_re = (const float*)d_in[19];
    p.b_re = (const float*)d_in[20]; p.w_eg = (const float*)d_in[21]; p.w_eu = (const float*)d_in[22]; p.w_ed = (const float*)d_in[23]; p.g_final = (const float*)d_in[24];
    p.out = (float*)d_out;
    unsigned char* w = (unsigned char*)d_ws; size_t off = 0;
    auto take = [&](size_t bytes) { unsigned char* r = w + off; off += (bytes + 255) & ~(size_t)255; return r; };
    p.cnt = (int*)take(4096);
    p.WinT = (bf16_t*)take((size_t)ZP * DM * 2); p.WuqT = (bf16_t*)take(768 * 256 * 2); p.WukT = (bf16_t*)take(512 * 128 * 2); p.WuvT = (bf16_t*)take(512 * 128 * 2);
    p.WoaT = (bf16_t*)take(1024 * 512 * 2); p.WosT = (bf16_t*)take(1024 * 512 * 2); p.WoutT = (bf16_t*)take(1024 * 1024 * 2); p.Wsp = (bf16_t*)take(8 * 128 * 128 * 2);
    p.cs = (float*)take((size_t)NT * 32 * 4); p.cqn = (bf16_t*)take((size_t)NT * 256 * 2); p.ckvn = (bf16_t*)take((size_t)NT * 128 * 2);
    p.list = (int*)take((size_t)NE * NT * 4); p.aw = (float*)take((size_t)2 * NT * 4); p.aexp = (int*)take((size_t)2 * NT * 4);
    p.slotA = (bf16_t*)take((size_t)NT * DM * 2);
    p.slotB = take((size_t)NT * 512 * 4);
    p.slotC = (bf16_t*)take((size_t)NT * 1024 * 2);
    p.slotD = (bf16_t*)take((size_t)NT * 2048 * 2);
    p.slotE = (bf16_t*)take((size_t)NT * NH * 96 * 2);
    p.slotF = (bf16_t*)take((size_t)512 * NT * 2);
    p.slotG = (bf16_t*)take((size_t)NT * 512 * 2);
    if (off > ws_size) { fprintf(stderr, "workspace too small: need %zu have %zu\n", off, ws_size); return; }
#if MK_LAUNCHES == 1
    static int grid_blocks = 0;
    if (!grid_blocks) { int dev = 0, cus = 0, per_cu = 0; hipGetDevice(&dev); hipDeviceGetAttribute(&cus, hipDeviceAttributeMultiprocessorCount, dev);
        hipOccupancyMaxActiveBlocksPerMultiprocessor(&per_cu, k_mega, 256, LDS_BYTES); if (per_cu > 2) per_cu = 2; grid_blocks = cus * per_cu; }
    void* args[] = {&p};
    hipError_t e = hipLaunchCooperativeKernel((void*)k_mega, dim3(grid_blocks), dim3(256), args, LDS_BYTES, stream);
    if (e != hipSuccess) fprintf(stderr, "cooperative launch failed: %s (grid %d)\n", hipGetErrorString(e), grid_blocks);
#else
    for (int ph = 0; ph < 12; ++ph) k_phase<<<2048, 256, LDS_BYTES, stream>>>(p, ph);
#endif
}
```

```cpp
#include <hip/hip_runtime.h>
#include <hip/hip_cooperative_groups.h>
#include <cstdint>
#include <cstdio>
namespace cg = cooperative_groups;

#ifndef MK_LAUNCHES
#define MK_LAUNCHES 1
#endif

typedef unsigned short bf16_t;
constexpr int NT = 16384, SEQ = 8192, DM = 1024, NBATCH = 2;
constexpr int ZC = 3488;
constexpr int ZP = 3584;
constexpr int NH = 8;
constexpr float EPS = 1e-6f;
constexpr int NE = 32;

struct P {
    const float* x; const int* pos; const float* g_attn; const float* w_in; const float* g_cq; const float* w_uq;
    const float* g_ckv; const float* w_uk; const float* w_uv; const float* w_o_attn; const float* sgu_gain; const float* sgu_bias;
    const float* w_sp; const float* b_sp; const float* w_o_sgu; const float* w_out; const float* g_ffn; const float* w_rg;
    const float* b_rg; const float* w_re; const float* b_re; const float* w_eg; const float* w_eu; const float* w_ed; const float* g_final;
    float* out;
    int* cnt;
    bf16_t* WinT;
    bf16_t* WuqT;
    bf16_t* WukT;
    bf16_t* WuvT;
    bf16_t* WoaT;
    bf16_t* WosT;
    bf16_t* WoutT;
    bf16_t* Wsp;
    float* cs;
    bf16_t* cqn;
    bf16_t* ckvn;
    int* list;
    float* aw;
    int* aexp;
    bf16_t* slotA;
    unsigned char* slotB;
    bf16_t* slotC;
    bf16_t* slotD;
    bf16_t* slotE;
    bf16_t* slotF;
    bf16_t* slotG;
};

__device__ __forceinline__ float bf2f(bf16_t v) { return __uint_as_float(((unsigned)v) << 16); }
__device__ __forceinline__ bf16_t f2bf(float f) { unsigned u = __float_as_uint(f); u += 0x7fffu + ((u >> 16) & 1u); return (bf16_t)(u >> 16); }
__device__ __forceinline__ float dot8(const uint4 a, const uint4 b) {
    float s = 0.f;
    s += __uint_as_float(a.x << 16) * __uint_as_float(b.x << 16) + __uint_as_float(a.x & 0xffff0000u) * __uint_as_float(b.x & 0xffff0000u);
    s += __uint_as_float(a.y << 16) * __uint_as_float(b.y << 16) + __uint_as_float(a.y & 0xffff0000u) * __uint_as_float(b.y & 0xffff0000u);
    s += __uint_as_float(a.z << 16) * __uint_as_float(b.z << 16) + __uint_as_float(a.z & 0xffff0000u) * __uint_as_float(b.z & 0xffff0000u);
    s += __uint_as_float(a.w << 16) * __uint_as_float(b.w << 16) + __uint_as_float(a.w & 0xffff0000u) * __uint_as_float(b.w & 0xffff0000u);
    return s;
}
__device__ __forceinline__ float wsum(float v) { for (int o = 32; o > 0; o >>= 1) v += __shfl_xor(v, o); return v; }
__device__ __forceinline__ float wmax(float v) { for (int o = 32; o > 0; o >>= 1) v = fmaxf(v, __shfl_xor(v, o)); return v; }
__device__ __forceinline__ float gelu_tanh(float v) { const float u = 0.7978845608028654f * (v + 0.044715f * v * v * v); const float t = 1.f - 2.f / (__expf(2.f * u) + 1.f); return 0.5f * v * (1.f + t); }
__device__ __forceinline__ float sigmoidf_(float v) { return 1.f / (1.f + __expf(-v)); }

__device__ void phase0(const P& p, int bid, int nb) {
    const int tid = threadIdx.x, lane = tid & 63, wid = tid >> 6;
    const size_t gtid = (size_t)bid * 256 + tid, gsz = (size_t)nb * 256;
    if (bid == 0 && tid < NE) p.cnt[tid] = 0;
    for (int t = bid * 4 + wid; t < NT; t += nb * 4) {
        const float* xr = p.x + (size_t)t * DM; float v[16]; float ss = 0.f;
#pragma unroll
        for (int i = 0; i < 16; ++i) { v[i] = xr[lane + 64 * i]; ss += v[i] * v[i]; }
        ss = wsum(ss); const float r = rsqrtf(ss * (1.f / DM) + EPS);
        bf16_t* hr = p.slotA + (size_t)t * DM;
#pragma unroll
        for (int i = 0; i < 16; ++i) hr[lane + 64 * i] = f2bf(v[i] * r);
    }
    for (size_t i = gtid; i < (size_t)ZP * DM; i += gsz) { const int k = (int)(i / ZP), rho = (int)(i % ZP); float v = 0.f;
        if (rho < 416) v = p.w_in[(size_t)k * ZC + rho]; else if (rho >= 512) v = p.w_in[(size_t)k * ZC + rho - 96];
        p.WinT[(size_t)rho * DM + k] = f2bf(v * p.g_attn[k]); }
    const float qscale = 0.10206207261596575f * 1.4426950408889634f;
    for (size_t i = gtid; i < (size_t)768 * 256; i += gsz) { const int k = (int)(i / 768), rho = (int)(i % 768); int col;
        if (rho < 512) col = (rho >> 6) * 96 + (rho & 63); else { const int hh = (rho - 512) >> 5, w = (rho - 512) & 31; col = hh * 96 + 64 + (w >> 1) + 16 * (w & 1); }
        p.WuqT[(size_t)rho * 256 + k] = f2bf(p.w_uq[(size_t)k * 768 + col] * p.g_cq[k] * qscale); }
    for (size_t i = gtid; i < (size_t)512 * 128; i += gsz) { const int k = (int)(i / 512), c = (int)(i % 512);
        p.WukT[(size_t)c * 128 + k] = f2bf(p.w_uk[(size_t)k * 512 + c] * p.g_ckv[k]);
        p.WuvT[(size_t)c * 128 + k] = f2bf(p.w_uv[(size_t)k * 512 + c] * p.g_ckv[k]); }
    for (size_t i = gtid; i < (size_t)1024 * 512; i += gsz) { const int k = (int)(i / 1024), n = (int)(i % 1024);
        p.WoaT[(size_t)n * 512 + k] = f2bf(p.w_o_attn[(size_t)k * 1024 + n]);
        p.WosT[(size_t)n * 512 + k] = f2bf(p.w_o_sgu[(size_t)k * 1024 + n]); }
    for (size_t i = gtid; i < (size_t)1024 * 1024; i += gsz) { const int k = (int)(i / 1024), n = (int)(i % 1024);
        p.WoutT[(size_t)n * 1024 + k] = f2bf(p.w_out[(size_t)k * 1024 + n]); }
    for (size_t i = gtid; i < (size_t)8 * 128 * 128; i += gsz) { const int j = (int)(i & 127), ii = (int)((i >> 7) & 127);
        p.Wsp[i] = ((j >> 6) <= (ii >> 6)) ? f2bf(p.w_sp[i]) : (bf16_t)0; }
}

template <class Epi>
__device__ void ngemm(const bf16_t* A, int lda, const bf16_t* Bt, int ldb, int M, int N, int K, Epi epi, int bid, int nb, float* sm) {
    float* As = sm; float* Bs = sm + 16 * 68;
    const int tid = threadIdx.x, ty = tid >> 4, tx = tid & 15; const int tn = N / 64, ntile = (M / 64) * tn;
    for (int tile = bid; tile < ntile; tile += nb) {
        const int row0 = (tile / tn) * 64, col0 = (tile % tn) * 64;
        float acc[4][4];
#pragma unroll
        for (int i = 0; i < 4; ++i)
#pragma unroll
            for (int j = 0; j < 4; ++j) acc[i][j] = 0.f;
        for (int k0 = 0; k0 < K; k0 += 16) {
#pragma unroll
            for (int i = 0; i < 4; ++i) { const int idx = tid + i * 256, r = idx >> 4, kk = idx & 15;
                As[kk * 68 + r] = bf2f(A[(size_t)(row0 + r) * lda + k0 + kk]);
                Bs[kk * 68 + r] = bf2f(Bt[(size_t)(col0 + r) * ldb + k0 + kk]); }
            __syncthreads();
#pragma unroll
            for (int kk = 0; kk < 16; ++kk) { float a[4], b[4];
#pragma unroll
                for (int i = 0; i < 4; ++i) { a[i] = As[kk * 68 + ty * 4 + i]; b[i] = Bs[kk * 68 + tx * 4 + i]; }
#pragma unroll
                for (int i = 0; i < 4; ++i)
#pragma unroll
                    for (int j = 0; j < 4; ++j) acc[i][j] += a[i] * b[j]; }
            __syncthreads();
        }
#pragma unroll
        for (int i = 0; i < 4; ++i) epi(row0 + ty * 4 + i, col0 + tx * 4, acc[i]);
    }
}

__device__ void phase1(const P& p, int bid, int nb, float* sm) {
    float* zs = (float*)p.slotB; bf16_t* uvg = p.slotC; bf16_t* gates = p.slotD;
    ngemm(p.slotA, DM, p.WinT, DM, NT, ZP, DM, [=](int t, int c, const float* v) {
#pragma unroll
        for (int j = 0; j < 4; ++j) { const int cc = c + j;
            if (cc < 512) zs[(size_t)t * 512 + cc] = v[j];
            else if (cc < 1536) uvg[(size_t)t * 1024 + cc - 512] = f2bf(gelu_tanh(v[j]));
            else gates[(size_t)t * 2048 + cc - 1536] = f2bf(sigmoidf_(v[j])); }
    }, bid, nb, sm);
}

__device__ void phase2a(const P& p, int bid, int nb) {
    const int tid = threadIdx.x, lane = tid & 63, wid = tid >> 6;
    const float* zs = (const float*)p.slotB; bf16_t* K = p.slotE; bf16_t* uvg = p.slotC;
    for (int t = bid * 4 + wid; t < NT; t += nb * 4) {
        const float* z = zs + (size_t)t * 512;
        { float v[4]; float ss = 0.f;
#pragma unroll
          for (int i = 0; i < 4; ++i) { v[i] = z[lane + 64 * i]; ss += v[i] * v[i]; }
          ss = wsum(ss); const float r = rsqrtf(ss * (1.f / 256.f) + EPS);
#pragma unroll
          for (int i = 0; i < 4; ++i) p.cqn[(size_t)t * 256 + lane + 64 * i] = f2bf(v[i] * r); }
        { float v[2]; float ss = 0.f;
#pragma unroll
          for (int i = 0; i < 2; ++i) { v[i] = z[256 + lane + 64 * i]; ss += v[i] * v[i]; }
          ss = wsum(ss); const float r = rsqrtf(ss * (1.f / 128.f) + EPS);
#pragma unroll
          for (int i = 0; i < 2; ++i) p.ckvn[(size_t)t * 128 + lane + 64 * i] = f2bf(v[i] * r); }
        const int b = t >> 13, s = t & 8191;
        if (lane < 16) {
            const float fr4[4] = {1.0f, 0.5623413251903491f, 0.31622776601683794f, 0.1778279410038923f};
            float f = (lane & 3) == 0 ? fr4[0] : (lane & 3) == 1 ? fr4[1] : (lane & 3) == 2 ? fr4[2] : fr4[3];
            const int q4 = lane >> 2; f *= (q4 == 0 ? 1.0f : q4 == 1 ? 0.1f : q4 == 2 ? 0.01f : 0.001f);
            const float ang = (float)p.pos[t] * f;
            const double rev = (double)ang * 0.15915494309189535; const float fr = (float)(rev - floor(rev));
            const float sn = __builtin_amdgcn_sinf(fr), cn = __builtin_amdgcn_cosf(fr);
            p.cs[(size_t)t * 32 + lane] = cn; p.cs[(size_t)t * 32 + 16 + lane] = sn;
            const float k1 = z[384 + lane], k2 = z[400 + lane];
            const bf16_t o1 = f2bf(k1 * cn - k2 * sn), o2 = f2bf(k1 * sn + k2 * cn);
#pragma unroll
            for (int h = 0; h < NH; ++h) { bf16_t* kr = K + ((size_t)(b * NH + h) * SEQ + s) * 96; kr[64 + lane] = o1; kr[80 + lane] = o2; }
        }
        { bf16_t* vr = uvg + (size_t)t * 1024 + 512; float v[8]; float sm_ = 0.f;
#pragma unroll
          for (int i = 0; i < 8; ++i) { v[i] = bf2f(vr[lane + 64 * i]); sm_ += v[i]; }
          sm_ = wsum(sm_); const float mu = sm_ * (1.f / 512.f); float q = 0.f;
#pragma unroll
          for (int i = 0; i < 8; ++i) { const float d = v[i] - mu; q += d * d; }
          q = wsum(q); const float r = rsqrtf(q * (1.f / 512.f) + EPS);
#pragma unroll
          for (int i = 0; i < 8; ++i) { const int c = lane + 64 * i; vr[c] = f2bf((v[i] - mu) * r * p.sgu_gain[c] + p.sgu_bias[c]); } }
    }
}

__device__ void phase2b(const P& p, int bid, int nb, float* sm) {
    bf16_t* Q = p.slotA; bf16_t* K = p.slotE; bf16_t* VT = p.slotF; const float* cs = p.cs;
    ngemm(p.cqn, 256, p.WuqT, 256, NT, 768, 256, [=](int t, int c, const float* v) {
        const int b = t >> 13, s = t & 8191;
        if (c < 512) { const int h = c >> 6, d = c & 63; bf16_t* q = Q + ((size_t)(b * NH + h) * SEQ + s) * 96 + d;
#pragma unroll
            for (int j = 0; j < 4; ++j) q[j] = f2bf(v[j]); }
        else { const int h = (c - 512) >> 5, i0 = ((c - 512) & 31) >> 1; bf16_t* q = Q + ((size_t)(b * NH + h) * SEQ + s) * 96;
#pragma unroll
            for (int e = 0; e < 2; ++e) { const int i = i0 + e; const float cn = cs[(size_t)t * 32 + i], sn = cs[(size_t)t * 32 + 16 + i]; const float x1 = v[2 * e], x2 = v[2 * e + 1];
                q[64 + i] = f2bf(x1 * cn - x2 * sn); q[80 + i] = f2bf(x1 * sn + x2 * cn); } }
    }, bid, nb, sm);
    ngemm(p.ckvn, 128, p.WukT, 128, NT, 512, 128, [=](int t, int c, const float* v) {
        const int b = t >> 13, s = t & 8191, h = c >> 6, d = c & 63; bf16_t* k = K + ((size_t)(b * NH + h) * SEQ + s) * 96 + d;
#pragma unroll
        for (int j = 0; j < 4; ++j) k[j] = f2bf(v[j]);
    }, bid, nb, sm);
    ngemm(p.WuvT, 128, p.ckvn, 128, 512, NT, 128, [=](int r, int t, const float* v) {
#pragma unroll
        for (int j = 0; j < 4; ++j) VT[(size_t)r * NT + t + j] = f2bf(v[j]);
    }, bid, nb, sm);
}

__device__ void phase2c(const P& p, int bid, int nb) {
    const bf16_t* uvg = p.slotC; bf16_t* su = p.slotG;
    for (size_t i = (size_t)bid * 256 + threadIdx.x; i < (size_t)NT * 512; i += (size_t)nb * 256) {
        const int t = (int)(i >> 9), c = (int)(i & 511), g = c >> 6, ii = t & 127, t0 = t - ii;
        const bf16_t* w = p.Wsp + ((size_t)g * 128 + ii) * 128; float s = 0.f;
        for (int j = 0; j < 128; ++j) s += bf2f(w[j]) * bf2f(uvg[(size_t)(t0 + j) * 1024 + 512 + c]);
        s += p.b_sp[g * 128 + ii];
        su[i] = f2bf(bf2f(uvg[(size_t)t * 1024 + c]) * s);
    }
}

__device__ void phase3(const P& p, int bid, int nb, float* sm) {
    float* sc = sm; float* qs = sm + 8192; float* red = qs + 96;
    const bf16_t* Q = p.slotA; const bf16_t* K = p.slotE; const bf16_t* VT = p.slotF; bf16_t* O = (bf16_t*)p.slotB;
    const int tid = threadIdx.x;
    for (int row = bid; row < NBATCH * NH * SEQ; row += nb) {
        const int q = row % SEQ, bh = row / SEQ, nk = ((q >> 6) + 1) * 64;
        if (tid < 12) ((uint4*)qs)[tid] = ((const uint4*)(Q + ((size_t)bh * SEQ + q) * 96))[tid];
        __syncthreads();
        float mx = -1e30f;
        for (int k = tid; k < nk; k += 256) { const uint4* kp = (const uint4*)(K + ((size_t)bh * SEQ + k) * 96); float s = 0.f;
#pragma unroll
            for (int d = 0; d < 12; ++d) s += dot8(((const uint4*)qs)[d], kp[d]);
            sc[k] = s; mx = fmaxf(mx, s); }
        mx = wmax(mx); if ((tid & 63) == 0) red[tid >> 6] = mx; __syncthreads();
        mx = fmaxf(fmaxf(red[0], red[1]), fmaxf(red[2], red[3])); __syncthreads();
        float sum = 0.f;
        for (int k = tid; k < nk; k += 256) { const float e = exp2f(sc[k] - mx); sc[k] = e; sum += e; }
        sum = wsum(sum); if ((tid & 63) == 0) red[tid >> 6] = sum; __syncthreads();
        sum = (red[0] + red[1]) + (red[2] + red[3]);
        const int dv = tid >> 2, part = tid & 3, h = bh & 7, b = bh >> 3;
        const bf16_t* vp = VT + (size_t)(h * 64 + dv) * NT + (size_t)b * SEQ; float o = 0.f;
        for (int k = part; k < nk; k += 4) o += sc[k] * bf2f(vp[k]);
        o += __shfl_xor(o, 1); o += __shfl_xor(o, 2);
        if (part == 0) O[(size_t)(b * SEQ + q) * 512 + h * 64 + dv] = f2bf(o / sum);
        __syncthreads();
    }
}

__device__ void phase4(const P& p, int bid, int nb, float* sm) {
    float* As = sm; float* Bs = sm + 16 * 68;
    const bf16_t* O = (const bf16_t*)p.slotB; const bf16_t* su = p.slotG; const bf16_t* gates = p.slotD; bf16_t* m = p.slotA;
    const int tid = threadIdx.x, ty = tid >> 4, tx = tid & 15; const int tn = DM / 64, ntile = (NT / 64) * tn;
    for (int tile = bid; tile < ntile; tile += nb) {
        const int row0 = (tile / tn) * 64, col0 = (tile % tn) * 64;
        float acc[2][4][4];
#pragma unroll
        for (int w = 0; w < 2; ++w)
#pragma unroll
            for (int i = 0; i < 4; ++i)
#pragma unroll
                for (int j = 0; j < 4; ++j) acc[w][i][j] = 0.f;
#pragma unroll
        for (int w = 0; w < 2; ++w) {
            const bf16_t* A = w ? su : O; const bf16_t* Bt = w ? p.WosT : p.WoaT;
            for (int k0 = 0; k0 < 512; k0 += 16) {
#pragma unroll
                for (int i = 0; i < 4; ++i) { const int idx = tid + i * 256, r = idx >> 4, kk = idx & 15;
                    As[kk * 68 + r] = bf2f(A[(size_t)(row0 + r) * 512 + k0 + kk]);
                    Bs[kk * 68 + r] = bf2f(Bt[(size_t)(col0 + r) * 512 + k0 + kk]); }
                __syncthreads();
#pragma unroll
                for (int kk = 0; kk < 16; ++kk) { float a[4], b[4];
#pragma unroll
                    for (int i = 0; i < 4; ++i) { a[i] = As[kk * 68 + ty * 4 + i]; b[i] = Bs[kk * 68 + tx * 4 + i]; }
#pragma unroll
                    for (int i = 0; i < 4; ++i)
#pragma unroll
                        for (int j = 0; j < 4; ++j) acc[w][i][j] += a[i] * b[j]; }
                __syncthreads();
            }
        }
#pragma unroll
        for (int i = 0; i < 4; ++i)
#pragma unroll
            for (int j = 0; j < 4; ++j) { const int t = row0 + ty * 4 + i, c = col0 + tx * 4 + j;
                const float ga = bf2f(gates[(size_t)t * 2048 + c]), gb = bf2f(gates[(size_t)t * 2048 + 1024 + c]);
                m[(size_t)t * DM + c] = f2bf(ga * acc[0][i][j] + gb * acc[1][i][j]); }
    }
}

__device__ void phase5(const P& p, int bid, int nb, float* sm) {
    const float* x = p.x; float* xm = p.out;
    ngemm(p.slotA, DM, p.WoutT, DM, NT, DM, DM, [=](int t, int c, const float* v) {
#pragma unroll
        for (int j = 0; j < 4; ++j) xm[(size_t)t * DM + c + j] = x[(size_t)t * DM + c + j] + v[j];
    }, bid, nb, sm);
}

__device__ __forceinline__ int gu_src_col(int rho, int& isup) {
    const int tt = rho >> 7, w = rho & 127, wc = w >> 6, n = (w >> 4) & 3, i = w & 15; isup = n >> 1; return tt * 64 + wc * 32 + (n & 1) * 16 + i;
}
__device__ void phase6(const P& p, int bid, int nb) {
    const int tid = threadIdx.x, lane = tid & 63, wid = tid >> 6;
    bf16_t* h2 = p.slotA; const float* xm = p.out;
    for (int t = bid * 4 + wid; t < NT; t += nb * 4) {
        float v[16]; float ss = 0.f;
#pragma unroll
        for (int i = 0; i < 16; ++i) { v[i] = xm[(size_t)t * DM + lane + 64 * i]; ss += v[i] * v[i]; }
        ss = wsum(ss); const float r = rsqrtf(ss * (1.f / DM) + EPS);
#pragma unroll
        for (int i = 0; i < 16; ++i) { v[i] = v[i] * r * p.g_ffn[lane + 64 * i]; h2[(size_t)t * DM + lane + 64 * i] = f2bf(v[i]); }
        float lg[4] = {0.f, 0.f, 0.f, 0.f};
#pragma unroll
        for (int i = 0; i < 16; ++i) { const float* w = p.w_rg + (size_t)(lane + 64 * i) * 4;
#pragma unroll
            for (int g = 0; g < 4; ++g) lg[g] += v[i] * w[g]; }
#pragma unroll
        for (int g = 0; g < 4; ++g) lg[g] = wsum(lg[g]) + p.b_rg[g];
        int gs = 0; float gm = lg[0];
#pragma unroll
        for (int g = 1; g < 4; ++g) if (lg[g] > gm) { gm = lg[g]; gs = g; }
        float den = 0.f;
#pragma unroll
        for (int g = 0; g < 4; ++g) den += __expf(lg[g] - gm);
        const float ptop = 1.f / den;
        float le[8] = {0.f, 0.f, 0.f, 0.f, 0.f, 0.f, 0.f, 0.f};
#pragma unroll
        for (int i = 0; i < 16; ++i) { const float* w = p.w_re + ((size_t)gs * DM + lane + 64 * i) * 8;
#pragma unroll
            for (int e = 0; e < 8; ++e) le[e] += v[i] * w[e]; }
#pragma unroll
        for (int e = 0; e < 8; ++e) le[e] = wsum(le[e]) + p.b_re[gs * 8 + e];
        int e1 = 0; float l1 = le[0];
#pragma unroll
        for (int e = 1; e < 8; ++e) if (le[e] > l1) { l1 = le[e]; e1 = e; }
        int e2 = -1; float l2 = -3.0e38f;
#pragma unroll
        for (int e = 0; e < 8; ++e) if (e != e1 && le[e] > l2) { l2 = le[e]; e2 = e; }
        const float s1 = 1.f / (1.f + __expf(l2 - l1)), s2 = 1.f - s1;
        if (lane == 0) {
            const int ea = gs * 8 + e1, eb = gs * 8 + e2;
            const int ra = atomicAdd(&p.cnt[ea], 1); p.list[(size_t)ea * NT + ra] = 2 * t;
            const int rb = atomicAdd(&p.cnt[eb], 1); p.list[(size_t)eb * NT + rb] = 2 * t + 1;
            p.aw[2 * t] = s1 * ptop; p.aw[2 * t + 1] = s2 * ptop; p.aexp[2 * t] = ea; p.aexp[2 * t + 1] = eb;
        }
    }
    bf16_t* WguT = (bf16_t*)p.slotB; bf16_t* WdT = WguT + (size_t)NE * 512 * 1024;
    const size_t gtid = (size_t)bid * 256 + tid, gsz = (size_t)nb * 256;
    for (size_t i = gtid; i < (size_t)NE * 1024 * 512; i += gsz) { const int rho = (int)(i & 511), k = (int)((i >> 9) & 1023), e = (int)(i >> 19);
        int isup; const int col = gu_src_col(rho, isup); const float* src = isup ? p.w_eu : p.w_eg;
        WguT[((size_t)e * 512 + rho) * 1024 + k] = f2bf(src[((size_t)e * 1024 + k) * 256 + col]); }
    for (size_t i = gtid; i < (size_t)NE * 256 * 1024; i += gsz) { const int n = (int)(i & 1023), c = (int)((i >> 10) & 255), e = (int)(i >> 18);
        WdT[((size_t)e * 1024 + n) * 256 + c] = f2bf(p.w_ed[((size_t)e * 256 + c) * 1024 + n]); }
}

__device__ void phase7a(const P& p, int bid, int nb) {
    const bf16_t* h2 = p.slotA; const bf16_t* WguT = (const bf16_t*)p.slotB; bf16_t* hid = p.slotE;
    for (size_t i = (size_t)bid * 256 + threadIdx.x; i < (size_t)2 * NT * 256; i += (size_t)nb * 256) {
        const int a = (int)(i >> 8), c = (int)(i & 255), t = a >> 1, e = p.aexp[a];
        const int tt = c >> 6, wc = (c >> 5) & 1, nn = (c >> 4) & 1, ii = c & 15; const int rg = tt * 128 + wc * 64 + nn * 16 + ii, ru = rg + 32;
        const bf16_t* wg = WguT + ((size_t)e * 512 + rg) * 1024; const bf16_t* wu = WguT + ((size_t)e * 512 + ru) * 1024; const bf16_t* hr = h2 + (size_t)t * DM;
        float G = 0.f, U = 0.f;
        for (int k = 0; k < DM / 8; ++k) { const uint4 hv = ((const uint4*)hr)[k]; G += dot8(hv, ((const uint4*)wg)[k]); U += dot8(hv, ((const uint4*)wu)[k]); }
        hid[i] = f2bf(G * sigmoidf_(G) * U);
    }
}
__device__ void phase7b(const P& p, int bid, int nb) {
    const bf16_t* hid = p.slotE; const bf16_t* WdT = (const bf16_t*)p.slotB + (size_t)NE * 512 * 1024; bf16_t* Y = p.slotD;
    for (size_t i = (size_t)bid * 256 + threadIdx.x; i < (size_t)2 * NT * DM; i += (size_t)nb * 256) {
        const int a = (int)(i >> 10), n = (int)(i & 1023), e = p.aexp[a];
        const bf16_t* w = WdT + ((size_t)e * 1024 + n) * 256; const bf16_t* hr = hid + (size_t)a * 256; float s = 0.f;
        for (int k = 0; k < 32; ++k) s += dot8(((const uint4*)hr)[k], ((const uint4*)w)[k]);
        Y[i] = f2bf(s * p.aw[a]);
    }
}

__device__ void phase8(const P& p, int bid, int nb) {
    const int tid = threadIdx.x, lane = tid & 63, wid = tid >> 6; const bf16_t* Y = p.slotD;
    for (int t = bid * 4 + wid; t < NT; t += nb * 4) {
        float v[16]; float ss = 0.f;
#pragma unroll
        for (int i = 0; i < 16; ++i) { const int c = lane + 64 * i; v[i] = p.out[(size_t)t * DM + c] + bf2f(Y[(size_t)(2 * t) * DM + c]) + bf2f(Y[(size_t)(2 * t + 1) * DM + c]); ss += v[i] * v[i]; }
        ss = wsum(ss); const float r = rsqrtf(ss * (1.f / DM) + EPS);
#pragma unroll
        for (int i = 0; i < 16; ++i) { const int c = lane + 64 * i; p.out[(size_t)t * DM + c] = v[i] * r * p.g_final[c]; }
    }
}

constexpr int LDS_BYTES = 36 * 1024;
extern __shared__ __attribute__((aligned(16))) unsigned char smem_raw[];

__global__ void __launch_bounds__(256) k_phase(P p, int ph) {
    float* sm = (float*)smem_raw; const int bid = blockIdx.x, nb = gridDim.x;
    switch (ph) {
        case 0: phase0(p, bid, nb); break;
        case 1: phase1(p, bid, nb, sm); break;
        case 2: phase2a(p, bid, nb); break;
        case 3: phase2b(p, bid, nb, sm); break;
        case 4: phase2c(p, bid, nb); break;
        case 5: phase3(p, bid, nb, sm); break;
        case 6: phase4(p, bid, nb, sm); break;
        case 7: phase5(p, bid, nb, sm); break;
        case 8: phase6(p, bid, nb); break;
        case 9: phase7a(p, bid, nb); break;
        case 10: phase7b(p, bid, nb); break;
        case 11: phase8(p, bid, nb); break;
    }
}

__global__ void __launch_bounds__(256) k_mega(P p) {
    cg::grid_group grid = cg::this_grid();
    float* sm = (float*)smem_raw; const int bid = blockIdx.x, nb = gridDim.x;
    phase0(p, bid, nb); grid.sync();
    phase1(p, bid, nb, sm); grid.sync();
    phase2a(p, bid, nb); grid.sync();
    phase2b(p, bid, nb, sm); phase2c(p, bid, nb); grid.sync();
    phase3(p, bid, nb, sm); grid.sync();
    phase4(p, bid, nb, sm); grid.sync();
    phase5(p, bid, nb, sm); grid.sync();
    phase6(p, bid, nb); grid.sync();
    phase7a(p, bid, nb); grid.sync();
    phase7b(p, bid, nb); grid.sync();
    phase8(p, bid, nb);
}

extern "C" void kernel_launch(void* const* d_in, const int* in_sizes, int n_in, void* d_out, int out_size, void* d_ws, size_t ws_size, hipStream_t stream) {
    P p{};
    p.x = (const float*)d_in[0]; p.pos = (const int*)d_in[1]; p.g_attn = (const float*)d_in[2]; p.w_in = (const float*)d_in[3]; p.g_cq = (const float*)d_in[4];
    p.w_uq = (const float*)d_in[5]; p.g_ckv = (const float*)d_in[6]; p.w_uk = (const float*)d_in[7]; p.w_uv = (const float*)d_in[8]; p.w_o_attn = (const float*)d_in[9];
    p.sgu_gain = (const float*)d_in[10]; p.sgu_bias = (const float*)d_in[11]; p.w_sp = (const float*)d_in[12]; p.b_sp = (const float*)d_in[13]; p.w_o_sgu = (const float*)d_in[14];
    p.w_out = (const float*)d_in[15]; p.g_ffn = (const float*)d_in[16]; p.w_rg = (const float*)d_in[17]; p.b_rg = (const float*)d_in[18]; p.w_re = (const float*)d_in[19];
    p.b_re = (const float*)d_in[20]; p.w_eg = (const float*)d_in[21]; p.w_eu = (const float*)d_in[22]; p.w_ed = (const float*)d_in[23]; p.g_final = (const float*)d_in[24];
    p.out = (float*)d_out;
    unsigned char* w = (unsigned char*)d_ws; size_t off = 0;
    auto take = [&](size_t bytes) { unsigned char* r = w + off; off += (bytes + 255) & ~(size_t)255; return r; };
    p.cnt = (int*)take(4096);
    p.WinT = (bf16_t*)take((size_t)ZP * DM * 2); p.WuqT = (bf16_t*)take(768 * 256 * 2); p.WukT = (bf16_t*)take(512 * 128 * 2); p.WuvT = (bf16_t*)take(512 * 128 * 2);
    p.WoaT = (bf16_t*)take(1024 * 512 * 2); p.WosT = (bf16_t*)take(1024 * 512 * 2); p.WoutT = (bf16_t*)take(1024 * 1024 * 2); p.Wsp = (bf16_t*)take(8 * 128 * 128 * 2);
    p.cs = (float*)take((size_t)NT * 32 * 4); p.cqn = (bf16_t*)take((size_t)NT * 256 * 2); p.ckvn = (bf16_t*)take((size_t)NT * 128 * 2);
    p.list = (int*)take((size_t)NE * NT * 4); p.aw = (float*)take((size_t)2 * NT * 4); p.aexp = (int*)take((size_t)2 * NT * 4);
    p.slotA = (bf16_t*)take((size_t)NT * DM * 2);
    p.slotB = take((size_t)NT * 512 * 4);
    p.slotC = (bf16_t*)take((size_t)NT * 1024 * 2);
    p.slotD = (bf16_t*)take((size_t)NT * 2048 * 2);
    p.slotE = (bf16_t*)take((size_t)NT * NH * 96 * 2);
    p.slotF = (bf16_t*)take((size_t)512 * NT * 2);
    p.slotG = (bf16_t*)take((size_t)NT * 512 * 2);
    if (off > ws_size) { fprintf(stderr, "workspace too small: need %zu have %zu\n", off, ws_size); return; }
#if MK_LAUNCHES == 1
    static int grid_blocks = 0;
    if (!grid_blocks) { int dev = 0, cus = 0, per_cu = 0; hipGetDevice(&dev); hipDeviceGetAttribute(&cus, hipDeviceAttributeMultiprocessorCount, dev);
        hipOccupancyMaxActiveBlocksPerMultiprocessor(&per_cu, k_mega, 256, LDS_BYTES); if (per_cu > 2) per_cu = 2; grid_blocks = cus * per_cu; }
    void* args[] = {&p};
    hipError_t e = hipLaunchCooperativeKernel((void*)k_mega, dim3(grid_blocks), dim3(256), args, LDS_BYTES, stream);
    if (e != hipSuccess) fprintf(stderr, "cooperative launch failed: %s (grid %d)\n", hipGetErrorString(e), grid_blocks);
#else
    for (int ph = 0; ph < 12; ++ph) k_phase<<<2048, 256, LDS_BYTES, stream>>>(p, ph);
#endif
}
```

```cpp
#include <hip/hip_runtime.h>
#include <hip/hip_cooperative_groups.h>
#include <cstdint>
#include <cstdio>
namespace cg = cooperative_groups;

#ifndef MK_LAUNCHES
#define MK_LAUNCHES 1
#endif

typedef unsigned short bf16_t;
constexpr int NT = 16384, SEQ = 8192, DM = 1024, NBATCH = 2;
constexpr int ZC = 3488;
constexpr int ZP = 3584;
constexpr int NH = 8;
constexpr float EPS = 1e-6f;
constexpr int NE = 32;

struct P {
    const float* x; const int* pos; const float* g_attn; const float* w_in; const float* g_cq; const float* w_uq;
    const float* g_ckv; const float* w_uk; const float* w_uv; const float* w_o_attn; const float* sgu_gain; const float* sgu_bias;
    const float* w_sp; const float* b_sp; const float* w_o_sgu; const float* w_out; const float* g_ffn; const float* w_rg;
    const float* b_rg; const float* w_re; const float* b_re; const float* w_eg; const float* w_eu; const float* w_ed; const float* g_final;
    float* out;
    int* cnt;
    bf16_t* WinT;
    bf16_t* WuqT;
    bf16_t* WukT;
    bf16_t* WuvT;
    bf16_t* WoaT;
    bf16_t* WosT;
    bf16_t* WoutT;
    bf16_t* Wsp;
    float* cs;
    bf16_t* cqn;
    bf16_t* ckvn;
    int* list;
    float* aw;
    int* aexp;
    bf16_t* slotA;
    unsigned char* slotB;
    bf16_t* slotC;
    bf16_t* slotD;
    bf16_t* slotE;
    bf16_t* slotF;
    bf16_t* slotG;
};

__device__ __forceinline__ float bf2f(bf16_t v) { return __uint_as_float(((unsigned)v) << 16); }
__device__ __forceinline__ bf16_t f2bf(float f) { unsigned u = __float_as_uint(f); u += 0x7fffu + ((u >> 16) & 1u); return (bf16_t)(u >> 16); }
__device__ __forceinline__ float dot8(const uint4 a, const uint4 b) {
    float s = 0.f;
    s += __uint_as_float(a.x << 16) * __uint_as_float(b.x << 16) + __uint_as_float(a.x & 0xffff0000u) * __uint_as_float(b.x & 0xffff0000u);
    s += __uint_as_float(a.y << 16) * __uint_as_float(b.y << 16) + __uint_as_float(a.y & 0xffff0000u) * __uint_as_float(b.y & 0xffff0000u);
    s += __uint_as_float(a.z << 16) * __uint_as_float(b.z << 16) + __uint_as_float(a.z & 0xffff0000u) * __uint_as_float(b.z & 0xffff0000u);
    s += __uint_as_float(a.w << 16) * __uint_as_float(b.w << 16) + __uint_as_float(a.w & 0xffff0000u) * __uint_as_float(b.w & 0xffff0000u);
    return s;
}
__device__ __forceinline__ float wsum(float v) { for (int o = 32; o > 0; o >>= 1) v += __shfl_xor(v, o); return v; }
__device__ __forceinline__ float wmax(float v) { for (int o = 32; o > 0; o >>= 1) v = fmaxf(v, __shfl_xor(v, o)); return v; }
__device__ __forceinline__ float gelu_tanh(float v) { const float u = 0.7978845608028654f * (v + 0.044715f * v * v * v); const float t = 1.f - 2.f / (__expf(2.f * u) + 1.f); return 0.5f * v * (1.f + t); }
__device__ __forceinline__ float sigmoidf_(float v) { return 1.f / (1.f + __expf(-v)); }

__device__ void phase0(const P& p, int bid, int nb) {
    const int tid = threadIdx.x, lane = tid & 63, wid = tid >> 6;
    const size_t gtid = (size_t)bid * 256 + tid, gsz = (size_t)nb * 256;
    if (bid == 0 && tid < NE) p.cnt[tid] = 0;
    for (int t = bid * 4 + wid; t < NT; t += nb * 4) {
        const float* xr = p.x + (size_t)t * DM; float v[16]; float ss = 0.f;
#pragma unroll
        for (int i = 0; i < 16; ++i) { v[i] = xr[lane + 64 * i]; ss += v[i] * v[i]; }
        ss = wsum(ss); const float r = rsqrtf(ss * (1.f / DM) + EPS);
        bf16_t* hr = p.slotA + (size_t)t * DM;
#pragma unroll
        for (int i = 0; i < 16; ++i) hr[lane + 64 * i] = f2bf(v[i] * r);
    }
    for (size_t i = gtid; i < (size_t)ZP * DM; i += gsz) { const int k = (int)(i / ZP), rho = (int)(i % ZP); float v = 0.f;
        if (rho < 416) v = p.w_in[(size_t)k * ZC + rho]; else if (rho >= 512) v = p.w_in[(size_t)k * ZC + rho - 96];
        p.WinT[(size_t)rho * DM + k] = f2bf(v * p.g_attn[k]); }
    const float qscale = 0.10206207261596575f * 1.4426950408889634f;
    for (size_t i = gtid; i < (size_t)768 * 256; i += gsz) { const int k = (int)(i / 768), rho = (int)(i % 768); int col;
        if (rho < 512) col = (rho >> 6) * 96 + (rho & 63); else { const int hh = (rho - 512) >> 5, w = (rho - 512) & 31; col = hh * 96 + 64 + (w >> 1) + 16 * (w & 1); }
        p.WuqT[(size_t)rho * 256 + k] = f2bf(p.w_uq[(size_t)k * 768 + col] * p.g_cq[k] * qscale); }
    for (size_t i = gtid; i < (size_t)512 * 128; i += gsz) { const int k = (int)(i / 512), c = (int)(i % 512);
        p.WukT[(size_t)c * 128 + k] = f2bf(p.w_uk[(size_t)k * 512 + c] * p.g_ckv[k]);
        p.WuvT[(size_t)c * 128 + k] = f2bf(p.w_uv[(size_t)k * 512 + c] * p.g_ckv[k]); }
    for (size_t i = gtid; i < (size_t)1024 * 512; i += gsz) { const int k = (int)(i / 1024), n = (int)(i % 1024);
        p.WoaT[(size_t)n * 512 + k] = f2bf(p.w_o_attn[(size_t)k * 1024 + n]);
        p.WosT[(size_t)n * 512 + k] = f2bf(p.w_o_sgu[(size_t)k * 1024 + n]); }
    for (size_t i = gtid; i < (size_t)1024 * 1024; i += gsz) { const int k = (int)(i / 1024), n = (int)(i % 1024);
        p.WoutT[(size_t)n * 1024 + k] = f2bf(p.w_out[(size_t)k * 1024 + n]); }
    for (size_t i = gtid; i < (size_t)8 * 128 * 128; i += gsz) { const int j = (int)(i & 127), ii = (int)((i >> 7) & 127);
        p.Wsp[i] = ((j >> 6) <= (ii >> 6)) ? f2bf(p.w_sp[i]) : (bf16_t)0; }
}

template <class Epi>
__device__ void ngemm(const bf16_t* A, int lda, const bf16_t* Bt, int ldb, int M, int N, int K, Epi epi, int bid, int nb, float* sm) {
    float* As = sm; float* Bs = sm + 16 * 68;
    const int tid = threadIdx.x, ty = tid >> 4, tx = tid & 15; const int tn = N / 64, ntile = (M / 64) * tn;
    for (int tile = bid; tile < ntile; tile += nb) {
        const int row0 = (tile / tn) * 64, col0 = (tile % tn) * 64;
        float acc[4][4];
#pragma unroll
        for (int i = 0; i < 4; ++i)
#pragma unroll
            for (int j = 0; j < 4; ++j) acc[i][j] = 0.f;
        for (int k0 = 0; k0 < K; k0 += 16) {
#pragma unroll
            for (int i = 0; i < 4; ++i) { const int idx = tid + i * 256, r = idx >> 4, kk = idx & 15;
                As[kk * 68 + r] = bf2f(A[(size_t)(row0 + r) * lda + k0 + kk]);
                Bs[kk * 68 + r] = bf2f(Bt[(size_t)(col0 + r) * ldb + k0 + kk]); }
            __syncthreads();
#pragma unroll
            for (int kk = 0; kk < 16; ++kk) { float a[4], b[4];
#pragma unroll
                for (int i = 0; i < 4; ++i) { a[i] = As[kk * 68 + ty * 4 + i]; b[i] = Bs[kk * 68 + tx * 4 + i]; }
#pragma unroll
                for (int i = 0; i < 4; ++i)
#pragma unroll
                    for (int j = 0; j < 4; ++j) acc[i][j] += a[i] * b[j]; }
            __syncthreads();
        }
#pragma unroll
        for (int i = 0; i < 4; ++i) epi(row0 + ty * 4 + i, col0 + tx * 4, acc[i]);
    }
}


#define LAS __attribute__((address_space(3)))
typedef short bf16x8 __attribute__((ext_vector_type(8)));
typedef float f32x4 __attribute__((ext_vector_type(4)));
constexpr int GEMM_LDS = 65536;

__device__ __forceinline__ bool tile_of(int it, int bid, int nb, int RT, int CT, int& rt, int& ct) {
    if ((RT & 31) == 0 && (nb & 7) == 0) {
        const int x = bid & 7, l = bid >> 3, nl = nb >> 3, rpx = RT >> 3; const int lt = l + it * nl; if (lt >= rpx * CT) return false;
        const int rg = lt / (4 * CT), w = lt % (4 * CT); rt = x * rpx + rg * 4 + (w & 3); ct = w >> 2; return true;
    }
    const int tile = bid + it * nb; if (tile >= RT * CT) return false; rt = tile / CT; ct = tile % CT; return true;
}
__device__ __forceinline__ void mg_kloop4(f32x4 (&acc)[4][4], const bf16_t* a0, const bf16_t* a1, const bf16_t* a2, const bf16_t* a3, const bf16_t* bp, size_t bstep, int nk, LAS unsigned char* lds) {
    const int tid = threadIdx.x, lane = tid & 63, wid = tid >> 6, wr = wid >> 1, wc = wid & 1, fr = lane & 15, fq = lane >> 4;
    auto stage = [&](int t) { LAS unsigned char* d = lds + (t & 1) * 32768 + tid * 16; const int k0 = t * 64;
        __builtin_amdgcn_global_load_lds((const unsigned*)(a0 + k0), (LAS unsigned*)(d), 16, 0, 0);
        __builtin_amdgcn_global_load_lds((const unsigned*)(a1 + k0), (LAS unsigned*)(d + 4096), 16, 0, 0);
        __builtin_amdgcn_global_load_lds((const unsigned*)(a2 + k0), (LAS unsigned*)(d + 8192), 16, 0, 0);
        __builtin_amdgcn_global_load_lds((const unsigned*)(a3 + k0), (LAS unsigned*)(d + 12288), 16, 0, 0);
#pragma unroll
        for (int i = 0; i < 4; ++i) __builtin_amdgcn_global_load_lds((const unsigned*)(bp + i * bstep + k0), (LAS unsigned*)(d + 16384 + i * 4096), 16, 0, 0); };
    stage(0);
    for (int t = 0; t < nk; ++t) {
        asm volatile("s_waitcnt vmcnt(0)" ::: "memory");
        __syncthreads();
        if (t + 1 < nk) stage(t + 1);
        const LAS unsigned char* ab = lds + (t & 1) * 32768 + (wr * 64 + fr) * 128; const LAS unsigned char* bb = lds + (t & 1) * 32768 + 16384 + (wc * 64 + fr) * 128;
#pragma unroll
        for (int ks = 0; ks < 2; ++ks) { const int pc = ((ks * 4 + fq) ^ (fr & 7)) * 16; bf16x8 af[4], bfr[4];
#pragma unroll
            for (int m = 0; m < 4; ++m) { af[m] = *(const LAS bf16x8*)(ab + m * 2048 + pc); bfr[m] = *(const LAS bf16x8*)(bb + m * 2048 + pc); }
#pragma unroll
            for (int m = 0; m < 4; ++m)
#pragma unroll
                for (int n = 0; n < 4; ++n) acc[m][n] = __builtin_amdgcn_mfma_f32_16x16x32_bf16(bfr[n], af[m], acc[m][n], 0, 0, 0); }
    }
    __syncthreads();
}
__device__ __forceinline__ void mg_kloop(f32x4 (&acc)[4][4], const bf16_t* ap, size_t astep  , const bf16_t* bp, size_t bstep, int nk, LAS unsigned char* lds) {
    mg_kloop4(acc, ap, ap + astep, ap + 2 * astep, ap + 3 * astep, bp, bstep, nk, lds);
}
template <class Epi>
__device__ void mgemm(const bf16_t* A, int lda, const bf16_t* Bt, int ldb, int M, int N, int K, Epi epi, int bid, int nb, LAS unsigned char* lds) {
    const int tid = threadIdx.x, lane = tid & 63, wid = tid >> 6, wr = wid >> 1, wc = wid & 1, fr = lane & 15, fq = lane >> 4;
    const int RT = M / 128, CT = N / 128; const int c8 = ((tid & 7) ^ ((tid >> 3) & 7)) * 8;
    int rt, ct;
    for (int it = 0; tile_of(it, bid, nb, RT, CT, rt, ct); ++it) {
        const int row0 = rt * 128, col0 = ct * 128;
        f32x4 acc[4][4];
#pragma unroll
        for (int m = 0; m < 4; ++m)
#pragma unroll
            for (int n = 0; n < 4; ++n) acc[m][n] = (f32x4){0.f, 0.f, 0.f, 0.f};
        mg_kloop(acc, A + (size_t)(row0 + (tid >> 3)) * lda + c8, (size_t)32 * lda, Bt + (size_t)(col0 + (tid >> 3)) * ldb + c8, (size_t)32 * ldb, K / 64, lds);
#pragma unroll
        for (int m = 0; m < 4; ++m)
#pragma unroll
            for (int n = 0; n < 4; ++n) { const float v[4] = {acc[m][n][0], acc[m][n][1], acc[m][n][2], acc[m][n][3]}; epi(row0 + wr * 64 + m * 16 + fr, col0 + wc * 64 + n * 16 + fq * 4, v); }
    }
}

__device__ void phase1(const P& p, int bid, int nb, LAS unsigned char* sm) {
    float* zs = (float*)p.slotB; bf16_t* uvg = p.slotC; bf16_t* gates = p.slotD;
    mgemm(p.slotA, DM, p.WinT, DM, NT, ZP, DM, [=](int t, int c, const float* v) {
#pragma unroll
        for (int j = 0; j < 4; ++j) { const int cc = c + j;
            if (cc < 512) zs[(size_t)t * 512 + cc] = v[j];
            else if (cc < 1536) uvg[(size_t)t * 1024 + cc - 512] = f2bf(gelu_tanh(v[j]));
            else gates[(size_t)t * 2048 + cc - 1536] = f2bf(sigmoidf_(v[j])); }
    }, bid, nb, sm);
}

__device__ void phase2a(const P& p, int bid, int nb) {
    const int tid = threadIdx.x, lane = tid & 63, wid = tid >> 6;
    const float* zs = (const float*)p.slotB; bf16_t* K = p.slotE; bf16_t* uvg = p.slotC;
    for (int t = bid * 4 + wid; t < NT; t += nb * 4) {
        const float* z = zs + (size_t)t * 512;
        { float v[4]; float ss = 0.f;
#pragma unroll
          for (int i = 0; i < 4; ++i) { v[i] = z[lane + 64 * i]; ss += v[i] * v[i]; }
          ss = wsum(ss); const float r = rsqrtf(ss * (1.f / 256.f) + EPS);
#pragma unroll
          for (int i = 0; i < 4; ++i) p.cqn[(size_t)t * 256 + lane + 64 * i] = f2bf(v[i] * r); }
        { float v[2]; float ss = 0.f;
#pragma unroll
          for (int i = 0; i < 2; ++i) { v[i] = z[256 + lane + 64 * i]; ss += v[i] * v[i]; }
          ss = wsum(ss); const float r = rsqrtf(ss * (1.f / 128.f) + EPS);
#pragma unroll
          for (int i = 0; i < 2; ++i) p.ckvn[(size_t)t * 128 + lane + 64 * i] = f2bf(v[i] * r); }
        const int b = t >> 13, s = t & 8191;
        if (lane < 16) {
            const float fr4[4] = {1.0f, 0.5623413251903491f, 0.31622776601683794f, 0.1778279410038923f};
            float f = (lane & 3) == 0 ? fr4[0] : (lane & 3) == 1 ? fr4[1] : (lane & 3) == 2 ? fr4[2] : fr4[3];
            const int q4 = lane >> 2; f *= (q4 == 0 ? 1.0f : q4 == 1 ? 0.1f : q4 == 2 ? 0.01f : 0.001f);
            const float ang = (float)p.pos[t] * f;
            const double rev = (double)ang * 0.15915494309189535; const float fr = (float)(rev - floor(rev));
            const float sn = __builtin_amdgcn_sinf(fr), cn = __builtin_amdgcn_cosf(fr);
            p.cs[(size_t)t * 32 + lane] = cn; p.cs[(size_t)t * 32 + 16 + lane] = sn;
            const float k1 = z[384 + lane], k2 = z[400 + lane];
            const bf16_t o1 = f2bf(k1 * cn - k2 * sn), o2 = f2bf(k1 * sn + k2 * cn);
#pragma unroll
            for (int h = 0; h < NH; ++h) { bf16_t* kr = K + ((size_t)(b * NH + h) * SEQ + s) * 96; kr[64 + lane] = o1; kr[80 + lane] = o2; }
        }
        { bf16_t* vr = uvg + (size_t)t * 1024 + 512; float v[8]; float sm_ = 0.f;
#pragma unroll
          for (int i = 0; i < 8; ++i) { v[i] = bf2f(vr[lane + 64 * i]); sm_ += v[i]; }
          sm_ = wsum(sm_); const float mu = sm_ * (1.f / 512.f); float q = 0.f;
#pragma unroll
          for (int i = 0; i < 8; ++i) { const float d = v[i] - mu; q += d * d; }
          q = wsum(q); const float r = rsqrtf(q * (1.f / 512.f) + EPS);
#pragma unroll
          for (int i = 0; i < 8; ++i) { const int c = lane + 64 * i; vr[c] = f2bf((v[i] - mu) * r * p.sgu_gain[c] + p.sgu_bias[c]); } }
    }
}

__device__ void phase2b(const P& p, int bid, int nb, LAS unsigned char* sm) {
    bf16_t* Q = p.slotA; bf16_t* K = p.slotE; bf16_t* VT = p.slotF; const float* cs = p.cs;
    mgemm(p.cqn, 256, p.WuqT, 256, NT, 768, 256, [=](int t, int c, const float* v) {
        const int b = t >> 13, s = t & 8191;
        if (c < 512) { const int h = c >> 6, d = c & 63; bf16_t* q = Q + ((size_t)(b * NH + h) * SEQ + s) * 96 + d;
#pragma unroll
            for (int j = 0; j < 4; ++j) q[j] = f2bf(v[j]); }
        else { const int h = (c - 512) >> 5, i0 = ((c - 512) & 31) >> 1; bf16_t* q = Q + ((size_t)(b * NH + h) * SEQ + s) * 96;
#pragma unroll
            for (int e = 0; e < 2; ++e) { const int i = i0 + e; const float cn = cs[(size_t)t * 32 + i], sn = cs[(size_t)t * 32 + 16 + i]; const float x1 = v[2 * e], x2 = v[2 * e + 1];
                q[64 + i] = f2bf(x1 * cn - x2 * sn); q[80 + i] = f2bf(x1 * sn + x2 * cn); } }
    }, bid, nb, sm);
    mgemm(p.ckvn, 128, p.WukT, 128, NT, 512, 128, [=](int t, int c, const float* v) {
        const int b = t >> 13, s = t & 8191, h = c >> 6, d = c & 63; bf16_t* k = K + ((size_t)(b * NH + h) * SEQ + s) * 96 + d;
#pragma unroll
        for (int j = 0; j < 4; ++j) k[j] = f2bf(v[j]);
    }, bid, nb, sm);
    mgemm(p.WuvT, 128, p.ckvn, 128, 512, NT, 128, [=](int r, int t, const float* v) {
#pragma unroll
        for (int j = 0; j < 4; ++j) VT[(size_t)r * NT + t + j] = f2bf(v[j]);
    }, bid, nb, sm);
}

__device__ void phase2c(const P& p, int bid, int nb) {
    const bf16_t* uvg = p.slotC; bf16_t* su = p.slotG;
    for (size_t i = (size_t)bid * 256 + threadIdx.x; i < (size_t)NT * 512; i += (size_t)nb * 256) {
        const int t = (int)(i >> 9), c = (int)(i & 511), g = c >> 6, ii = t & 127, t0 = t - ii;
        const bf16_t* w = p.Wsp + ((size_t)g * 128 + ii) * 128; float s = 0.f;
        for (int j = 0; j < 128; ++j) s += bf2f(w[j]) * bf2f(uvg[(size_t)(t0 + j) * 1024 + 512 + c]);
        s += p.b_sp[g * 128 + ii];
        su[i] = f2bf(bf2f(uvg[(size_t)t * 1024 + c]) * s);
    }
}

__device__ void phase3(const P& p, int bid, int nb, float* sm) {
    float* sc = sm; float* qs = sm + 8192; float* red = qs + 96;
    const bf16_t* Q = p.slotA; const bf16_t* K = p.slotE; const bf16_t* VT = p.slotF; bf16_t* O = (bf16_t*)p.slotB;
    const int tid = threadIdx.x;
    for (int row = bid; row < NBATCH * NH * SEQ; row += nb) {
        const int q = row % SEQ, bh = row / SEQ, nk = ((q >> 6) + 1) * 64;
        if (tid < 12) ((uint4*)qs)[tid] = ((const uint4*)(Q + ((size_t)bh * SEQ + q) * 96))[tid];
        __syncthreads();
        float mx = -1e30f;
        for (int k = tid; k < nk; k += 256) { const uint4* kp = (const uint4*)(K + ((size_t)bh * SEQ + k) * 96); float s = 0.f;
#pragma unroll
            for (int d = 0; d < 12; ++d) s += dot8(((const uint4*)qs)[d], kp[d]);
            sc[k] = s; mx = fmaxf(mx, s); }
        mx = wmax(mx); if ((tid & 63) == 0) red[tid >> 6] = mx; __syncthreads();
        mx = fmaxf(fmaxf(red[0], red[1]), fmaxf(red[2], red[3])); __syncthreads();
        float sum = 0.f;
        for (int k = tid; k < nk; k += 256) { const float e = exp2f(sc[k] - mx); sc[k] = e; sum += e; }
        sum = wsum(sum); if ((tid & 63) == 0) red[tid >> 6] = sum; __syncthreads();
        sum = (red[0] + red[1]) + (red[2] + red[3]);
        const int dv = tid >> 2, part = tid & 3, h = bh & 7, b = bh >> 3;
        const bf16_t* vp = VT + (size_t)(h * 64 + dv) * NT + (size_t)b * SEQ; float o = 0.f;
        for (int k = part; k < nk; k += 4) o += sc[k] * bf2f(vp[k]);
        o += __shfl_xor(o, 1); o += __shfl_xor(o, 2);
        if (part == 0) O[(size_t)(b * SEQ + q) * 512 + h * 64 + dv] = f2bf(o / sum);
        __syncthreads();
    }
}


typedef float f32x16 __attribute__((ext_vector_type(16)));
typedef unsigned u32x2 __attribute__((ext_vector_type(2)));
typedef unsigned u32x4 __attribute__((ext_vector_type(4)));
typedef __bf16 bf16v2 __attribute__((ext_vector_type(2)));
typedef float f32v2 __attribute__((ext_vector_type(2)));
__device__ __forceinline__ unsigned pk2(float lo, float hi) { const f32v2 v = {lo, hi}; return __builtin_bit_cast(unsigned, __builtin_convertvector(v, bf16v2)); }
constexpr int ATT_BUF = 20480;
__device__ void phase3m(const P& p, int bid, int nb, LAS unsigned char* lds) {
    const bf16_t* Q = p.slotA; const bf16_t* K = p.slotE; const bf16_t* VT = p.slotF; bf16_t* O = (bf16_t*)p.slotB;
    const int tid = threadIdx.x, lane = tid & 63, wid = tid >> 6, l31 = lane & 31, hh = lane >> 5;
    int koff[3]; size_t voff[2];
#pragma unroll
    for (int i = 0; i < 3; ++i) { const int s = tid + 256 * i, r = s / 12, pc = s % 12, c = (pc + 12 - ((r >> 2) & 3)) % 12; koff[i] = r * 96 + c * 8; }
#pragma unroll
    for (int i = 0; i < 2; ++i) { const int s = tid + 256 * i, dv = s >> 3, pc = s & 7, cl = pc ^ ((dv >> 1) & 7); voff[i] = (size_t)dv * NT + cl * 8; }
    int kro[6];
#pragma unroll
    for (int ks = 0; ks < 6; ++ks) { const int v = 2 * ks + hh + ((lane >> 2) & 3); kro[ks] = (v >= 12 ? v - 12 : v) * 16; }
    const int krow = l31 * 192, vsw = (lane >> 1) & 7, vrow = l31 * 128 + 8 * hh;
    for (int iu = 0;; ++iu) {
        const int r = iu * nb + ((iu & 1) ? nb - 1 - bid : bid); if (r >= 1024) break;
        const int qb = 63 - (r >> 4), bh = r & 15, b = bh >> 3, h = bh & 7;
        const int q0 = qb * 128 + wid * 32, ntw = (q0 >> 6) + 1, nt = 2 * qb + 2;
        const bf16_t* Kb = K + (size_t)bh * SEQ * 96; const bf16_t* Vb = VT + (size_t)(h * 64) * NT + (size_t)b * SEQ;
        bf16x8 qf[6]; { const bf16_t* qp = Q + ((size_t)bh * SEQ + q0 + l31) * 96 + hh * 8;
#pragma unroll
            for (int ks = 0; ks < 6; ++ks) qf[ks] = *(const bf16x8*)(qp + ks * 16); }
        f32x16 o0, o1;
#pragma unroll
        for (int e = 0; e < 16; ++e) { o0[e] = 0.f; o1[e] = 0.f; }
        float mrun = -1e30f, lsum = 0.f;
        auto stage = [&](int j) { LAS unsigned char* d = lds + (j & 1) * ATT_BUF + tid * 16; const bf16_t* kt = Kb + (size_t)j * 64 * 96; const bf16_t* vt = Vb + j * 64;
#pragma unroll
            for (int i = 0; i < 3; ++i) __builtin_amdgcn_global_load_lds((const unsigned*)(kt + koff[i]), (LAS unsigned*)(d + i * 4096), 16, 0, 0);
#pragma unroll
            for (int i = 0; i < 2; ++i) __builtin_amdgcn_global_load_lds((const unsigned*)(vt + voff[i]), (LAS unsigned*)(d + 12288 + i * 4096), 16, 0, 0); };
        stage(0);
        for (int j = 0; j < nt; ++j) {
            asm volatile("s_waitcnt vmcnt(0)" ::: "memory");
            __syncthreads();
            if (j + 1 < nt) stage(j + 1);
            if (j < ntw) {
                const LAS unsigned char* kb_ = lds + (j & 1) * ATT_BUF + krow; const LAS unsigned char* vb_ = lds + (j & 1) * ATT_BUF + 12288 + vrow;
                f32x16 s0, s1;
#pragma unroll
                for (int e = 0; e < 16; ++e) { s0[e] = 0.f; s1[e] = 0.f; }
#pragma unroll
                for (int ks = 0; ks < 6; ++ks) { const bf16x8 k0 = *(const LAS bf16x8*)(kb_ + kro[ks]); const bf16x8 k1 = *(const LAS bf16x8*)(kb_ + 32 * 192 + kro[ks]);
                    s0 = __builtin_amdgcn_mfma_f32_32x32x16_bf16(k0, qf[ks], s0, 0, 0, 0); s1 = __builtin_amdgcn_mfma_f32_32x32x16_bf16(k1, qf[ks], s1, 0, 0, 0); }
                float mx = fmaxf(s0[0], s1[0]);
#pragma unroll
                for (int e = 1; e < 16; ++e) mx = fmaxf(mx, fmaxf(s0[e], s1[e]));
                mx = fmaxf(mx, __shfl_xor(mx, 32));
                const float mn = fmaxf(mrun, mx), alpha = __builtin_amdgcn_exp2f(mrun - mn); mrun = mn;
                float ps = 0.f;
#pragma unroll
                for (int e = 0; e < 16; ++e) { s0[e] = __builtin_amdgcn_exp2f(s0[e] - mn); s1[e] = __builtin_amdgcn_exp2f(s1[e] - mn); ps += s0[e] + s1[e]; }
                lsum = lsum * alpha + ps;
#pragma unroll
                for (int e = 0; e < 16; ++e) { o0[e] *= alpha; o1[e] *= alpha; }
                unsigned pw[16];
#pragma unroll
                for (int e = 0; e < 8; ++e) { pw[e] = pk2(s0[2 * e], s0[2 * e + 1]); pw[8 + e] = pk2(s1[2 * e], s1[2 * e + 1]); }
#pragma unroll
                for (int s = 0; s < 4; ++s) {
                    const u32x4 pbu = {pw[4 * s], pw[4 * s + 1], pw[4 * s + 2], pw[4 * s + 3]}; const bf16x8 pb = __builtin_bit_cast(bf16x8, pbu);
                    const int c0 = ((2 * s) ^ vsw) * 16, c1 = ((2 * s + 1) ^ vsw) * 16;
                    const u32x2 a0 = *(const LAS u32x2*)(vb_ + c0), a1 = *(const LAS u32x2*)(vb_ + c1);
                    const u32x2 b0 = *(const LAS u32x2*)(vb_ + 32 * 128 + c0), b1 = *(const LAS u32x2*)(vb_ + 32 * 128 + c1);
                    const u32x4 va = {a0.x, a0.y, a1.x, a1.y}, vb = {b0.x, b0.y, b1.x, b1.y};
                    o0 = __builtin_amdgcn_mfma_f32_32x32x16_bf16(__builtin_bit_cast(bf16x8, va), pb, o0, 0, 0, 0);
                    o1 = __builtin_amdgcn_mfma_f32_32x32x16_bf16(__builtin_bit_cast(bf16x8, vb), pb, o1, 0, 0, 0);
                }
            }
        }
        const float inv = 1.f / (lsum + __shfl_xor(lsum, 32));
        bf16_t* op = O + (size_t)(b * SEQ + q0 + l31) * 512 + h * 64 + 4 * hh;
#pragma unroll
        for (int g = 0; g < 4; ++g) { uint2 w0, w1;
            w0.x = pk2(o0[4 * g] * inv, o0[4 * g + 1] * inv); w0.y = pk2(o0[4 * g + 2] * inv, o0[4 * g + 3] * inv);
            w1.x = pk2(o1[4 * g] * inv, o1[4 * g + 1] * inv); w1.y = pk2(o1[4 * g + 2] * inv, o1[4 * g + 3] * inv);
            *(uint2*)(op + 8 * g) = w0; *(uint2*)(op + 32 + 8 * g) = w1; }
        __syncthreads();
    }
}

__device__ __forceinline__ unsigned pack2bf(float lo, float hi) { return (unsigned)f2bf(lo) | ((unsigned)f2bf(hi) << 16); }
__device__ void phase4(const P& p, int bid, int nb, LAS unsigned char* lds) {
    const bf16_t* O = (const bf16_t*)p.slotB; const bf16_t* su = p.slotG; const bf16_t* gates = p.slotD; bf16_t* mo = p.slotA;
    const int tid = threadIdx.x, lane = tid & 63, wid = tid >> 6, wr = wid >> 1, wc = wid & 1, fr = lane & 15, fq = lane >> 4;
    const int c8 = ((tid & 7) ^ ((tid >> 3) & 7)) * 8;
    int rt, ct;
    for (int it = 0; tile_of(it, bid, nb, NT / 128, DM / 128, rt, ct); ++it) {
        const int row0 = rt * 128, col0 = ct * 128;
        f32x4 acc0[4][4], acc1[4][4];
#pragma unroll
        for (int m = 0; m < 4; ++m)
#pragma unroll
            for (int n = 0; n < 4; ++n) { acc0[m][n] = (f32x4){0.f, 0.f, 0.f, 0.f}; acc1[m][n] = (f32x4){0.f, 0.f, 0.f, 0.f}; }
        mg_kloop(acc0, O + (size_t)(row0 + (tid >> 3)) * 512 + c8, (size_t)32 * 512, p.WoaT + (size_t)(col0 + (tid >> 3)) * 512 + c8, (size_t)32 * 512, 8, lds);
        mg_kloop(acc1, su + (size_t)(row0 + (tid >> 3)) * 512 + c8, (size_t)32 * 512, p.WosT + (size_t)(col0 + (tid >> 3)) * 512 + c8, (size_t)32 * 512, 8, lds);
#pragma unroll
        for (int m = 0; m < 4; ++m)
#pragma unroll
            for (int n = 0; n < 4; ++n) { const int t = row0 + wr * 64 + m * 16 + fr, c = col0 + wc * 64 + n * 16 + fq * 4;
                const uint2 ga = *(const uint2*)(gates + (size_t)t * 2048 + c), gb = *(const uint2*)(gates + (size_t)t * 2048 + 1024 + c);
                const float r0 = __uint_as_float(ga.x << 16) * acc0[m][n][0] + __uint_as_float(gb.x << 16) * acc1[m][n][0];
                const float r1 = __uint_as_float(ga.x & 0xffff0000u) * acc0[m][n][1] + __uint_as_float(gb.x & 0xffff0000u) * acc1[m][n][1];
                const float r2 = __uint_as_float(ga.y << 16) * acc0[m][n][2] + __uint_as_float(gb.y << 16) * acc1[m][n][2];
                const float r3 = __uint_as_float(ga.y & 0xffff0000u) * acc0[m][n][3] + __uint_as_float(gb.y & 0xffff0000u) * acc1[m][n][3];
                uint2 o; o.x = pack2bf(r0, r1); o.y = pack2bf(r2, r3); *(uint2*)(mo + (size_t)t * DM + c) = o; }
    }
}

__device__ void phase5(const P& p, int bid, int nb, LAS unsigned char* sm) {
    const float* x = p.x; float* xm = p.out;
    mgemm(p.slotA, DM, p.WoutT, DM, NT, DM, DM, [=](int t, int c, const float* v) {
#pragma unroll
        for (int j = 0; j < 4; ++j) xm[(size_t)t * DM + c + j] = x[(size_t)t * DM + c + j] + v[j];
    }, bid, nb, sm);
}

__device__ __forceinline__ int gu_src_col(int rho, int& isup) {
    const int tt = rho >> 7, w = rho & 127, wc = w >> 6, n = (w >> 4) & 3, i = w & 15; isup = n >> 1; return tt * 64 + wc * 32 + (n & 1) * 16 + i;
}
__device__ void phase6(const P& p, int bid, int nb) {
    const int tid = threadIdx.x, lane = tid & 63, wid = tid >> 6;
    bf16_t* h2 = p.slotA; const float* xm = p.out;
    for (int t = bid * 4 + wid; t < NT; t += nb * 4) {
        float v[16]; float ss = 0.f;
#pragma unroll
        for (int i = 0; i < 16; ++i) { v[i] = xm[(size_t)t * DM + lane + 64 * i]; ss += v[i] * v[i]; }
        ss = wsum(ss); const float r = rsqrtf(ss * (1.f / DM) + EPS);
#pragma unroll
        for (int i = 0; i < 16; ++i) { v[i] = v[i] * r * p.g_ffn[lane + 64 * i]; h2[(size_t)t * DM + lane + 64 * i] = f2bf(v[i]); }
        float lg[4] = {0.f, 0.f, 0.f, 0.f};
#pragma unroll
        for (int i = 0; i < 16; ++i) { const float* w = p.w_rg + (size_t)(lane + 64 * i) * 4;
#pragma unroll
            for (int g = 0; g < 4; ++g) lg[g] += v[i] * w[g]; }
#pragma unroll
        for (int g = 0; g < 4; ++g) lg[g] = wsum(lg[g]) + p.b_rg[g];
        int gs = 0; float gm = lg[0];
#pragma unroll
        for (int g = 1; g < 4; ++g) if (lg[g] > gm) { gm = lg[g]; gs = g; }
        float den = 0.f;
#pragma unroll
        for (int g = 0; g < 4; ++g) den += __expf(lg[g] - gm);
        const float ptop = 1.f / den;
        float le[8] = {0.f, 0.f, 0.f, 0.f, 0.f, 0.f, 0.f, 0.f};
#pragma unroll
        for (int i = 0; i < 16; ++i) { const float* w = p.w_re + ((size_t)gs * DM + lane + 64 * i) * 8;
#pragma unroll
            for (int e = 0; e < 8; ++e) le[e] += v[i] * w[e]; }
#pragma unroll
        for (int e = 0; e < 8; ++e) le[e] = wsum(le[e]) + p.b_re[gs * 8 + e];
        int e1 = 0; float l1 = le[0];
#pragma unroll
        for (int e = 1; e < 8; ++e) if (le[e] > l1) { l1 = le[e]; e1 = e; }
        int e2 = -1; float l2 = -3.0e38f;
#pragma unroll
        for (int e = 0; e < 8; ++e) if (e != e1 && le[e] > l2) { l2 = le[e]; e2 = e; }
        const float s1 = 1.f / (1.f + __expf(l2 - l1)), s2 = 1.f - s1;
        if (lane == 0) {
            const int ea = gs * 8 + e1, eb = gs * 8 + e2;
            const int ra = atomicAdd(&p.cnt[ea], 1); p.list[(size_t)ea * NT + ra] = 2 * t;
            const int rb = atomicAdd(&p.cnt[eb], 1); p.list[(size_t)eb * NT + rb] = 2 * t + 1;
            p.aw[2 * t] = s1 * ptop; p.aw[2 * t + 1] = s2 * ptop; p.aexp[2 * t] = ea; p.aexp[2 * t + 1] = eb;
        }
    }
    bf16_t* WguT = (bf16_t*)p.slotB; bf16_t* WdT = WguT + (size_t)NE * 512 * 1024;
    const size_t gtid = (size_t)bid * 256 + tid, gsz = (size_t)nb * 256;
    for (size_t i = gtid; i < (size_t)NE * 1024 * 512; i += gsz) { const int rho = (int)(i & 511), k = (int)((i >> 9) & 1023), e = (int)(i >> 19);
        int isup; const int col = gu_src_col(rho, isup); const float* src = isup ? p.w_eu : p.w_eg;
        WguT[((size_t)e * 512 + rho) * 1024 + k] = f2bf(src[((size_t)e * 1024 + k) * 256 + col]); }
    for (size_t i = gtid; i < (size_t)NE * 256 * 1024; i += gsz) { const int n = (int)(i & 1023), c = (int)((i >> 10) & 255), e = (int)(i >> 18);
        WdT[((size_t)e * 1024 + n) * 256 + c] = f2bf(p.w_ed[((size_t)e * 256 + c) * 1024 + n]); }
}

__device__ void phase7a(const P& p, int bid, int nb) {
    const bf16_t* h2 = p.slotA; const bf16_t* WguT = (const bf16_t*)p.slotB; bf16_t* hid = p.slotE;
    for (size_t i = (size_t)bid * 256 + threadIdx.x; i < (size_t)2 * NT * 256; i += (size_t)nb * 256) {
        const int a = (int)(i >> 8), c = (int)(i & 255), t = a >> 1, e = p.aexp[a];
        const int tt = c >> 6, wc = (c >> 5) & 1, nn = (c >> 4) & 1, ii = c & 15; const int rg = tt * 128 + wc * 64 + nn * 16 + ii, ru = rg + 32;
        const bf16_t* wg = WguT + ((size_t)e * 512 + rg) * 1024; const bf16_t* wu = WguT + ((size_t)e * 512 + ru) * 1024; const bf16_t* hr = h2 + (size_t)t * DM;
        float G = 0.f, U = 0.f;
        for (int k = 0; k < DM / 8; ++k) { const uint4 hv = ((const uint4*)hr)[k]; G += dot8(hv, ((const uint4*)wg)[k]); U += dot8(hv, ((const uint4*)wu)[k]); }
        hid[i] = f2bf(G * sigmoidf_(G) * U);
    }
}
__device__ void phase7b(const P& p, int bid, int nb) {
    const bf16_t* hid = p.slotE; const bf16_t* WdT = (const bf16_t*)p.slotB + (size_t)NE * 512 * 1024; bf16_t* Y = p.slotD;
    for (size_t i = (size_t)bid * 256 + threadIdx.x; i < (size_t)2 * NT * DM; i += (size_t)nb * 256) {
        const int a = (int)(i >> 10), n = (int)(i & 1023), e = p.aexp[a];
        const bf16_t* w = WdT + ((size_t)e * 1024 + n) * 256; const bf16_t* hr = hid + (size_t)a * 256; float s = 0.f;
        for (int k = 0; k < 32; ++k) s += dot8(((const uint4*)hr)[k], ((const uint4*)w)[k]);
        Y[i] = f2bf(s * p.aw[a]);
    }
}


__device__ __forceinline__ bool find_expert(const int* cnt, int ub, int& e, int& blk, int& ce) {
    int acc = 0;
    for (int i = 0; i < NE; ++i) { const int c = cnt[i], n = (c + 127) >> 7; if (ub < acc + n) { e = i; blk = ub - acc; ce = c; return true; } acc += n; }
    return false;
}
__device__ void phase7a_m(const P& p, int bid, int nb, LAS unsigned char* lds) {
    const bf16_t* h2 = p.slotA; const bf16_t* WguT = (const bf16_t*)p.slotB; bf16_t* hid = p.slotE;
    const int tid = threadIdx.x, lane = tid & 63, wid = tid >> 6, wr = wid >> 1, wc = wid & 1, fr = lane & 15, fq = lane >> 4;
    const int c8 = ((tid & 7) ^ ((tid >> 3) & 7)) * 8;
    for (int u = bid;; u += nb) {
        int e, blk, ce; if (!find_expert(p.cnt, u >> 2, e, blk, ce)) break;
        const int ct = u & 3; const int* lst = p.list + (size_t)e * NT;
        const bf16_t* ap[4];
#pragma unroll
        for (int i = 0; i < 4; ++i) { int r = blk * 128 + (tid >> 3) + 32 * i; r = r < ce ? r : ce - 1; ap[i] = h2 + (size_t)(lst[r] >> 1) * DM + c8; }
        f32x4 acc[4][4];
#pragma unroll
        for (int m = 0; m < 4; ++m)
#pragma unroll
            for (int n = 0; n < 4; ++n) acc[m][n] = (f32x4){0.f, 0.f, 0.f, 0.f};
        mg_kloop4(acc, ap[0], ap[1], ap[2], ap[3], WguT + ((size_t)e * 512 + ct * 128 + (tid >> 3)) * 1024 + c8, (size_t)32 * 1024, 16, lds);
        bf16_t* hb = hid + ((size_t)(u >> 2) * 128 + wr * 64 + fr) * 256 + ct * 64 + wc * 32 + fq * 4;
#pragma unroll
        for (int m = 0; m < 4; ++m)
#pragma unroll
            for (int n = 0; n < 2; ++n) { float v[4];
#pragma unroll
                for (int j = 0; j < 4; ++j) { const float g = acc[m][n][j]; v[j] = g * sigmoidf_(g) * acc[m][n + 2][j]; }
                uint2 o; o.x = pk2(v[0], v[1]); o.y = pk2(v[2], v[3]); *(uint2*)(hb + (size_t)(m * 16) * 256 + n * 16) = o; }
    }
}
__device__ void phase7b_m(const P& p, int bid, int nb, LAS unsigned char* lds) {
    const bf16_t* hid = p.slotE; const bf16_t* WdT = (const bf16_t*)p.slotB + (size_t)NE * 512 * 1024; bf16_t* Y = p.slotD;
    const int tid = threadIdx.x, lane = tid & 63, wid = tid >> 6, wr = wid >> 1, wc = wid & 1, fr = lane & 15, fq = lane >> 4;
    const int c8 = ((tid & 7) ^ ((tid >> 3) & 7)) * 8;
    for (int u = bid;; u += nb) {
        int e, blk, ce; if (!find_expert(p.cnt, u >> 3, e, blk, ce)) break;
        const int ct = u & 7; const int* lst = p.list + (size_t)e * NT;
        f32x4 acc[4][4];
#pragma unroll
        for (int m = 0; m < 4; ++m)
#pragma unroll
            for (int n = 0; n < 4; ++n) acc[m][n] = (f32x4){0.f, 0.f, 0.f, 0.f};
        mg_kloop(acc, hid + ((size_t)(u >> 3) * 128 + (tid >> 3)) * 256 + c8, (size_t)32 * 256, WdT + ((size_t)e * 1024 + ct * 128 + (tid >> 3)) * 256 + c8, (size_t)32 * 256, 4, lds);
#pragma unroll
        for (int m = 0; m < 4; ++m) { const int r = blk * 128 + wr * 64 + m * 16 + fr;
            if (r < ce) { const int a = lst[r]; const float w = p.aw[a]; bf16_t* yp = Y + (size_t)a * DM + ct * 128 + wc * 64 + fq * 4;
#pragma unroll
                for (int n = 0; n < 4; ++n) { uint2 o; o.x = pk2(acc[m][n][0] * w, acc[m][n][1] * w); o.y = pk2(acc[m][n][2] * w, acc[m][n][3] * w); *(uint2*)(yp + n * 16) = o; } } }
    }
}

__device__ void phase8(const P& p, int bid, int nb) {
    const int tid = threadIdx.x, lane = tid & 63, wid = tid >> 6; const bf16_t* Y = p.slotD;
    for (int t = bid * 4 + wid; t < NT; t += nb * 4) {
        float v[16]; float ss = 0.f;
#pragma unroll
        for (int i = 0; i < 16; ++i) { const int c = lane + 64 * i; v[i] = p.out[(size_t)t * DM + c] + bf2f(Y[(size_t)(2 * t) * DM + c]) + bf2f(Y[(size_t)(2 * t + 1) * DM + c]); ss += v[i] * v[i]; }
        ss = wsum(ss); const float r = rsqrtf(ss * (1.f / DM) + EPS);
#pragma unroll
        for (int i = 0; i < 16; ++i) { const int c = lane + 64 * i; p.out[(size_t)t * DM + c] = v[i] * r * p.g_final[c]; }
    }
}

constexpr int LDS_BYTES = 64 * 1024;
extern __shared__ __attribute__((aligned(16))) unsigned char smem_raw[];

__global__ void __launch_bounds__(256, 2) k_phase(P p, int ph) {
    float* sm = (float*)smem_raw; LAS unsigned char* lds = (LAS unsigned char*)smem_raw; const int bid = blockIdx.x, nb = gridDim.x;
    switch (ph) {
        case 0: phase0(p, bid, nb); break;
        case 1: phase1(p, bid, nb, lds); break;
        case 2: phase2a(p, bid, nb); break;
        case 3: phase2b(p, bid, nb, lds); break;
        case 4: phase2c(p, bid, nb); break;
        case 5: phase3m(p, bid, nb, lds); break;
        case 6: phase4(p, bid, nb, lds); break;
        case 7: phase5(p, bid, nb, lds); break;
        case 8: phase6(p, bid, nb); break;
        case 9: phase7a_m(p, bid, nb, lds); break;
        case 10: phase7b_m(p, bid, nb, lds); break;
        case 11: phase8(p, bid, nb); break;
    }
}

__global__ void __launch_bounds__(256, 2) k_mega(P p) {
    cg::grid_group grid = cg::this_grid();
    float* sm = (float*)smem_raw; LAS unsigned char* lds = (LAS unsigned char*)smem_raw; const int bid = blockIdx.x, nb = gridDim.x;
    phase0(p, bid, nb); grid.sync();
    phase1(p, bid, nb, lds); grid.sync();
    phase2a(p, bid, nb); grid.sync();
    phase2b(p, bid, nb, lds); phase2c(p, bid, nb); grid.sync();
    phase3m(p, bid, nb, lds); grid.sync();
    phase4(p, bid, nb, lds); grid.sync();
    phase5(p, bid, nb, lds); grid.sync();
    phase6(p, bid, nb); grid.sync();
    phase7a_m(p, bid, nb, lds); grid.sync();
    phase7b_m(p, bid, nb, lds); grid.sync();
    phase8(p, bid, nb);
}

extern "C" void kernel_launch(void* const* d_in, const int* in_sizes, int n_in, void* d_out, int out_size, void* d_ws, size_t ws_size, hipStream_t stream) {
    P p{};
    p.x = (const float*)d_in[0]; p.pos = (const int*)d_in[1]; p.g_attn = (const float*)d_in[2]; p.w_in = (const float*)d_in[3]; p.g_cq = (const float*)d_in[4];
    p.w_uq = (const float*)d_in[5]; p.g_ckv = (const float*)d_in[6]; p.w_uk = (const float*)d_in[7]; p.w_uv = (const float*)d_in[8]; p.w_o_attn = (const float*)d_in[9];
    p.sgu_gain = (const float*)d_in[10]; p.sgu_bias = (const float*)d_in[11]; p.w_sp = (const float*)d_in[12]; p.b_sp = (const float*)d_in[13]; p.w_o_sgu = (const float*)d_in[14];
    p.w_out = (const float*)d_in[15]; p.g_ffn = (const float*)d_in[16]; p.w_rg = (const float*)d_in[17]; p.b_rg = (const float*)d_in[18]; p.w_re = (const float*)d_in[19];
    p.b_re = (const float*)d_in[20]; p.w_eg = (const float*)d_in[21]; p.w_eu = (const float*)d_in[22]; p.w_ed = (const float*)d_in[23]; p.g_final = (const float*)d_in[24];
    p.out = (float*)d_out;
    unsigned char* w = (unsigned char*)d_ws; size_t off = 0;
    auto take = [&](size_t bytes) { unsigned char* r = w + off; off += (bytes + 255) & ~(size_t)255; return r; };
    p.cnt = (int*)take(4096);
    p.WinT = (bf16_t*)take((size_t)ZP * DM * 2); p.WuqT = (bf16_t*)take(768 * 256 * 2); p.WukT = (bf16_t*)take(512 * 128 * 2); p.WuvT = (bf16_t*)take(512 * 128 * 2);
    p.WoaT = (bf16_t*)take(1024 * 512 * 2); p.WosT = (bf16_t*)take(1024 * 512 * 2); p.WoutT = (bf16_t*)take(1024 * 1024 * 2); p.Wsp = (bf16_t*)take(8 * 128 * 128 * 2);
    p.cs = (float*)take((size_t)NT * 32 * 4); p.cqn = (bf16_t*)take((size_t)NT * 256 * 2); p.ckvn = (bf16_t*)take((size_t)NT * 128 * 2);
    p.list = (int*)take((size_t)NE * NT * 4); p.aw = (float*)take((size_t)2 * NT * 4); p.aexp = (int*)take((size_t)2 * NT * 4);
    p.slotA = (bf16_t*)take((size_t)NT * DM * 2);
    p.slotB = take((size_t)NT * 512 * 4);
    p.slotC = (bf16_t*)take((size_t)NT * 1024 * 2);
    p.slotD = (bf16_t*)take((size_t)NT * 2048 * 2);
    p.slotE = (bf16_t*)take((size_t)NT * NH * 96 * 2);
    p.slotF = (bf16_t*)take((size_t)512 * NT * 2);
    p.slotG = (bf16_t*)take((size_t)NT * 512 * 2);
    if (off > ws_size) { fprintf(stderr, "workspace too small: need %zu have %zu\n", off, ws_size); return; }
#if MK_LAUNCHES == 1
    static int grid_blocks = 0;
    if (!grid_blocks) { int dev = 0, cus = 0, per_cu = 0; hipGetDevice(&dev); hipDeviceGetAttribute(&cus, hipDeviceAttributeMultiprocessorCount, dev);
        hipOccupancyMaxActiveBlocksPerMultiprocessor(&per_cu, k_mega, 256, LDS_BYTES); if (per_cu > 2) per_cu = 2; grid_blocks = cus * per_cu; }
    void* args[] = {&p};
    hipError_t e = hipLaunchCooperativeKernel((void*)k_mega, dim3(grid_blocks), dim3(256), args, LDS_BYTES, stream);
    if (e != hipSuccess) fprintf(stderr, "cooperative launch failed: %s (grid %d)\n", hipGetErrorString(e), grid_blocks);
#else
    for (int ph = 0; ph < 12; ++ph) k_phase<<<2048, 256, LDS_BYTES, stream>>>(p, ph);
#endif
}
```

```cpp
#include <hip/hip_runtime.h>
#include <hip/hip_cooperative_groups.h>
#include <cstdint>
#include <cstdio>
namespace cg = cooperative_groups;

#ifndef MK_LAUNCHES
#define MK_LAUNCHES 1
#endif

typedef unsigned short bf16_t;
constexpr int NT = 16384, SEQ = 8192, DM = 1024, NBATCH = 2;
constexpr int ZC = 3488;
constexpr int ZP = 3584;
constexpr int NH = 8;
constexpr float EPS = 1e-6f;
constexpr int NE = 32;

struct P {
    const float* x; const int* pos; const float* g_attn; const float* w_in; const float* g_cq; const float* w_uq;
    const float* g_ckv; const float* w_uk; const float* w_uv; const float* w_o_attn; const float* sgu_gain; const float* sgu_bias;
    const float* w_sp; const float* b_sp; const float* w_o_sgu; const float* w_out; const float* g_ffn; const float* w_rg;
    const float* b_rg; const float* w_re; const float* b_re; const float* w_eg; const float* w_eu; const float* w_ed; const float* g_final;
    float* out;
    unsigned* bar;
    int* cnt;
    bf16_t* WinT;
    bf16_t* WuqT;
    bf16_t* WukT;
    bf16_t* WuvT;
    bf16_t* WoaT;
    bf16_t* WosT;
    bf16_t* WoutT;
    bf16_t* Wsp;
    float* cs;
    bf16_t* cqn;
    bf16_t* ckvn;
    int* list;
    float* aw;
    int* aexp;
    bf16_t* slotA;
    unsigned char* slotB;
    bf16_t* slotC;
    bf16_t* slotD;
    bf16_t* slotE;
    bf16_t* slotF;
    bf16_t* slotG;
};

__device__ __forceinline__ float bf2f(bf16_t v) { return __uint_as_float(((unsigned)v) << 16); }
__device__ __forceinline__ bf16_t f2bf(float f) { unsigned u = __float_as_uint(f); u += 0x7fffu + ((u >> 16) & 1u); return (bf16_t)(u >> 16); }
__device__ __forceinline__ float dot8(const uint4 a, const uint4 b) {
    float s = 0.f;
    s += __uint_as_float(a.x << 16) * __uint_as_float(b.x << 16) + __uint_as_float(a.x & 0xffff0000u) * __uint_as_float(b.x & 0xffff0000u);
    s += __uint_as_float(a.y << 16) * __uint_as_float(b.y << 16) + __uint_as_float(a.y & 0xffff0000u) * __uint_as_float(b.y & 0xffff0000u);
    s += __uint_as_float(a.z << 16) * __uint_as_float(b.z << 16) + __uint_as_float(a.z & 0xffff0000u) * __uint_as_float(b.z & 0xffff0000u);
    s += __uint_as_float(a.w << 16) * __uint_as_float(b.w << 16) + __uint_as_float(a.w & 0xffff0000u) * __uint_as_float(b.w & 0xffff0000u);
    return s;
}
__device__ __forceinline__ float wsum(float v) { for (int o = 32; o > 0; o >>= 1) v += __shfl_xor(v, o); return v; }
__device__ __forceinline__ float wmax(float v) { for (int o = 32; o > 0; o >>= 1) v = fmaxf(v, __shfl_xor(v, o)); return v; }
__device__ __forceinline__ float gelu_tanh(float v) { const float u = 0.7978845608028654f * (v + 0.044715f * v * v * v); const float t = 1.f - 2.f / (__expf(2.f * u) + 1.f); return 0.5f * v * (1.f + t); }
__device__ __forceinline__ float sigmoidf_(float v) { return 1.f / (1.f + __expf(-v)); }

#define LAS __attribute__((address_space(3)))
typedef short bf16x8 __attribute__((ext_vector_type(8)));
typedef float f32x4 __attribute__((ext_vector_type(4)));
constexpr int GEMM_LDS = 65536;
typedef float f32x16 __attribute__((ext_vector_type(16)));
typedef unsigned u32x2 __attribute__((ext_vector_type(2)));
typedef unsigned u32x4 __attribute__((ext_vector_type(4)));
typedef __bf16 bf16v2 __attribute__((ext_vector_type(2)));
typedef float f32v2 __attribute__((ext_vector_type(2)));
__device__ __forceinline__ unsigned pk2(float lo, float hi) { const f32v2 v = {lo, hi}; return __builtin_bit_cast(unsigned, __builtin_convertvector(v, bf16v2)); }


template <class F>
__device__ __forceinline__ int tconv(bf16_t* dst, int R, int K, F f, int base, int bid, int nb, float* sm) {
    const int tid = threadIdx.x, tk = K / 64, ntile = (R / 64) * tk;
    for (int tile = ((bid - base) % nb + nb) % nb; tile < ntile; tile += nb) {
        const int rho0 = (tile / tk) * 64, k0 = (tile % tk) * 64;
#pragma unroll
        for (int i = 0; i < 16; ++i) { const int kk = (tid >> 6) + 4 * i, rr = tid & 63; sm[kk * 65 + rr] = f(k0 + kk, rho0 + rr); }
        __syncthreads();
#pragma unroll
        for (int i = 0; i < 8; ++i) { const int rr = (tid >> 5) + 8 * i, kk = (tid & 31) * 2;
            *(unsigned*)(dst + (size_t)(rho0 + rr) * K + k0 + kk) = pk2(sm[kk * 65 + rr], sm[(kk + 1) * 65 + rr]); }
        __syncthreads();
    }
    return base + ntile;
}

__device__ void phase0(const P& p, int bid, int nb, float* sm) {
    const int tid = threadIdx.x, lane = tid & 63, wid = tid >> 6;
    const size_t gtid = (size_t)bid * 256 + tid, gsz = (size_t)nb * 256;
    if (bid == 0 && tid < NE) p.cnt[tid] = 0;
    for (int t = bid * 4 + wid; t < NT; t += nb * 4) {
        const float* xr = p.x + (size_t)t * DM; float v[16]; float ss = 0.f;
#pragma unroll
        for (int i = 0; i < 16; ++i) { v[i] = xr[lane + 64 * i]; ss += v[i] * v[i]; }
        ss = wsum(ss); const float r = rsqrtf(ss * (1.f / DM) + EPS);
        bf16_t* hr = p.slotA + (size_t)t * DM;
#pragma unroll
        for (int i = 0; i < 16; ++i) hr[lane + 64 * i] = f2bf(v[i] * r);
    }
    int base = 0;
    base = tconv(p.WinT, ZP, DM, [&](int k, int rho) { float v = 0.f;
        if (rho < 416) v = p.w_in[(size_t)k * ZC + rho]; else if (rho >= 512) v = p.w_in[(size_t)k * ZC + rho - 96];
        return v * p.g_attn[k]; }, base, bid, nb, sm);
    const float qscale = 0.10206207261596575f * 1.4426950408889634f;
    base = tconv(p.WuqT, 768, 256, [&](int k, int rho) { int col;
        if (rho < 512) col = (rho >> 6) * 96 + (rho & 63); else { const int hh = (rho - 512) >> 5, w = (rho - 512) & 31; col = hh * 96 + 64 + (w >> 1) + 16 * (w & 1); }
        return p.w_uq[(size_t)k * 768 + col] * p.g_cq[k] * qscale; }, base, bid, nb, sm);
    base = tconv(p.WukT, 512, 128, [&](int k, int c) { return p.w_uk[(size_t)k * 512 + c] * p.g_ckv[k]; }, base, bid, nb, sm);
    base = tconv(p.WuvT, 512, 128, [&](int k, int c) { return p.w_uv[(size_t)k * 512 + c] * p.g_ckv[k]; }, base, bid, nb, sm);
    base = tconv(p.WoaT, 1024, 512, [&](int k, int n) { return p.w_o_attn[(size_t)k * 1024 + n]; }, base, bid, nb, sm);
    base = tconv(p.WosT, 1024, 512, [&](int k, int n) { return p.w_o_sgu[(size_t)k * 1024 + n]; }, base, bid, nb, sm);
    base = tconv(p.WoutT, 1024, 1024, [&](int k, int n) { return p.w_out[(size_t)k * 1024 + n]; }, base, bid, nb, sm);
    for (size_t i = gtid; i < (size_t)8 * 128 * 128; i += gsz) { const int j = (int)(i & 127), ii = (int)((i >> 7) & 127);
        p.Wsp[i] = ((j >> 6) <= (ii >> 6)) ? f2bf(p.w_sp[i]) : (bf16_t)0; }
}

template <class Epi>
__device__ void ngemm(const bf16_t* A, int lda, const bf16_t* Bt, int ldb, int M, int N, int K, Epi epi, int bid, int nb, float* sm) {
    float* As = sm; float* Bs = sm + 16 * 68;
    const int tid = threadIdx.x, ty = tid >> 4, tx = tid & 15; const int tn = N / 64, ntile = (M / 64) * tn;
    for (int tile = bid; tile < ntile; tile += nb) {
        const int row0 = (tile / tn) * 64, col0 = (tile % tn) * 64;
        float acc[4][4];
#pragma unroll
        for (int i = 0; i < 4; ++i)
#pragma unroll
            for (int j = 0; j < 4; ++j) acc[i][j] = 0.f;
        for (int k0 = 0; k0 < K; k0 += 16) {
#pragma unroll
            for (int i = 0; i < 4; ++i) { const int idx = tid + i * 256, r = idx >> 4, kk = idx & 15;
                As[kk * 68 + r] = bf2f(A[(size_t)(row0 + r) * lda + k0 + kk]);
                Bs[kk * 68 + r] = bf2f(Bt[(size_t)(col0 + r) * ldb + k0 + kk]); }
            __syncthreads();
#pragma unroll
            for (int kk = 0; kk < 16; ++kk) { float a[4], b[4];
#pragma unroll
                for (int i = 0; i < 4; ++i) { a[i] = As[kk * 68 + ty * 4 + i]; b[i] = Bs[kk * 68 + tx * 4 + i]; }
#pragma unroll
                for (int i = 0; i < 4; ++i)
#pragma unroll
                    for (int j = 0; j < 4; ++j) acc[i][j] += a[i] * b[j]; }
            __syncthreads();
        }
#pragma unroll
        for (int i = 0; i < 4; ++i) epi(row0 + ty * 4 + i, col0 + tx * 4, acc[i]);
    }
}


__device__ __forceinline__ bool tile_of(int it, int bid, int nb, int RT, int CT, int& rt, int& ct) {
    if ((RT & 31) == 0 && (nb & 7) == 0) {
        const int x = bid & 7, l = bid >> 3, nl = nb >> 3, rpx = RT >> 3; const int lt = l + it * nl; if (lt >= rpx * CT) return false;
        const int rg = lt / (4 * CT), w = lt % (4 * CT); rt = x * rpx + rg * 4 + (w & 3); ct = w >> 2; return true;
    }
    const int tile = bid + it * nb; if (tile >= RT * CT) return false; rt = tile / CT; ct = tile % CT; return true;
}
__device__ __forceinline__ void mg_kloop4(f32x4 (&acc)[4][4], const bf16_t* a0, const bf16_t* a1, const bf16_t* a2, const bf16_t* a3, const bf16_t* bp, size_t bstep, int nk, LAS unsigned char* lds) {
    const int tid = threadIdx.x, lane = tid & 63, wid = tid >> 6, wr = wid >> 1, wc = wid & 1, fr = lane & 15, fq = lane >> 4;
    auto stage = [&](int t) { LAS unsigned char* d = lds + (t & 1) * 32768 + tid * 16; const int k0 = t * 64;
        __builtin_amdgcn_global_load_lds((const unsigned*)(a0 + k0), (LAS unsigned*)(d), 16, 0, 0);
        __builtin_amdgcn_global_load_lds((const unsigned*)(a1 + k0), (LAS unsigned*)(d + 4096), 16, 0, 0);
        __builtin_amdgcn_global_load_lds((const unsigned*)(a2 + k0), (LAS unsigned*)(d + 8192), 16, 0, 0);
        __builtin_amdgcn_global_load_lds((const unsigned*)(a3 + k0), (LAS unsigned*)(d + 12288), 16, 0, 0);
#pragma unroll
        for (int i = 0; i < 4; ++i) __builtin_amdgcn_global_load_lds((const unsigned*)(bp + i * bstep + k0), (LAS unsigned*)(d + 16384 + i * 4096), 16, 0, 0); };
    stage(0);
    for (int t = 0; t < nk; ++t) {
        asm volatile("s_waitcnt vmcnt(0)" ::: "memory");
        __syncthreads();
        if (t + 1 < nk) stage(t + 1);
        const LAS unsigned char* ab = lds + (t & 1) * 32768 + (wr * 64 + fr) * 128; const LAS unsigned char* bb = lds + (t & 1) * 32768 + 16384 + (wc * 64 + fr) * 128;
#pragma unroll
        for (int ks = 0; ks < 2; ++ks) { const int pc = ((ks * 4 + fq) ^ (fr & 7)) * 16; bf16x8 af[4], bfr[4];
#pragma unroll
            for (int m = 0; m < 4; ++m) { af[m] = *(const LAS bf16x8*)(ab + m * 2048 + pc); bfr[m] = *(const LAS bf16x8*)(bb + m * 2048 + pc); }
#pragma unroll
            for (int m = 0; m < 4; ++m)
#pragma unroll
                for (int n = 0; n < 4; ++n) acc[m][n] = __builtin_amdgcn_mfma_f32_16x16x32_bf16(bfr[n], af[m], acc[m][n], 0, 0, 0); }
    }
    __syncthreads();
}
__device__ __forceinline__ void mg_kloop(f32x4 (&acc)[4][4], const bf16_t* ap, size_t astep  , const bf16_t* bp, size_t bstep, int nk, LAS unsigned char* lds) {
    mg_kloop4(acc, ap, ap + astep, ap + 2 * astep, ap + 3 * astep, bp, bstep, nk, lds);
}
template <class Epi>
__device__ void mgemm(const bf16_t* A, int lda, const bf16_t* Bt, int ldb, int M, int N, int K, Epi epi, int bid, int nb, LAS unsigned char* lds) {
    const int tid = threadIdx.x, lane = tid & 63, wid = tid >> 6, wr = wid >> 1, wc = wid & 1, fr = lane & 15, fq = lane >> 4;
    const int RT = M / 128, CT = N / 128; const int c8 = ((tid & 7) ^ ((tid >> 3) & 7)) * 8;
    int rt, ct;
    for (int it = 0; tile_of(it, bid, nb, RT, CT, rt, ct); ++it) {
        const int row0 = rt * 128, col0 = ct * 128;
        f32x4 acc[4][4];
#pragma unroll
        for (int m = 0; m < 4; ++m)
#pragma unroll
            for (int n = 0; n < 4; ++n) acc[m][n] = (f32x4){0.f, 0.f, 0.f, 0.f};
        mg_kloop(acc, A + (size_t)(row0 + (tid >> 3)) * lda + c8, (size_t)32 * lda, Bt + (size_t)(col0 + (tid >> 3)) * ldb + c8, (size_t)32 * ldb, K / 64, lds);
#pragma unroll
        for (int m = 0; m < 4; ++m)
#pragma unroll
            for (int n = 0; n < 4; ++n) { const float v[4] = {acc[m][n][0], acc[m][n][1], acc[m][n][2], acc[m][n][3]}; epi(row0 + wr * 64 + m * 16 + fr, col0 + wc * 64 + n * 16 + fq * 4, v); }
    }
}

__device__ void phase1(const P& p, int bid, int nb, LAS unsigned char* sm) {
    float* zs = (float*)p.slotB; bf16_t* uvg = p.slotC; bf16_t* gates = p.slotD;
    mgemm(p.slotA, DM, p.WinT, DM, NT, ZP, DM, [=](int t, int c, const float* v) {
#pragma unroll
        for (int j = 0; j < 4; ++j) { const int cc = c + j;
            if (cc < 512) zs[(size_t)t * 512 + cc] = v[j];
            else if (cc < 1536) uvg[(size_t)t * 1024 + cc - 512] = f2bf(gelu_tanh(v[j]));
            else gates[(size_t)t * 2048 + cc - 1536] = f2bf(sigmoidf_(v[j])); }
    }, bid, nb, sm);
}

__device__ void phase2a(const P& p, int bid, int nb) {
    const int tid = threadIdx.x, lane = tid & 63, wid = tid >> 6;
    const float* zs = (const float*)p.slotB; bf16_t* K = p.slotE; bf16_t* uvg = p.slotC;
    for (int t = bid * 4 + wid; t < NT; t += nb * 4) {
        const float* z = zs + (size_t)t * 512;
        { float v[4]; float ss = 0.f;
#pragma unroll
          for (int i = 0; i < 4; ++i) { v[i] = z[lane + 64 * i]; ss += v[i] * v[i]; }
          ss = wsum(ss); const float r = rsqrtf(ss * (1.f / 256.f) + EPS);
#pragma unroll
          for (int i = 0; i < 4; ++i) p.cqn[(size_t)t * 256 + lane + 64 * i] = f2bf(v[i] * r); }
        { float v[2]; float ss = 0.f;
#pragma unroll
          for (int i = 0; i < 2; ++i) { v[i] = z[256 + lane + 64 * i]; ss += v[i] * v[i]; }
          ss = wsum(ss); const float r = rsqrtf(ss * (1.f / 128.f) + EPS);
#pragma unroll
          for (int i = 0; i < 2; ++i) p.ckvn[(size_t)t * 128 + lane + 64 * i] = f2bf(v[i] * r); }
        const int b = t >> 13, s = t & 8191;
        if (lane < 16) {
            const float fr4[4] = {1.0f, 0.5623413251903491f, 0.31622776601683794f, 0.1778279410038923f};
            float f = (lane & 3) == 0 ? fr4[0] : (lane & 3) == 1 ? fr4[1] : (lane & 3) == 2 ? fr4[2] : fr4[3];
            const int q4 = lane >> 2; f *= (q4 == 0 ? 1.0f : q4 == 1 ? 0.1f : q4 == 2 ? 0.01f : 0.001f);
            const float ang = (float)p.pos[t] * f;
            const double rev = (double)ang * 0.15915494309189535; const float fr = (float)(rev - floor(rev));
            const float sn = __builtin_amdgcn_sinf(fr), cn = __builtin_amdgcn_cosf(fr);
            p.cs[(size_t)t * 32 + lane] = cn; p.cs[(size_t)t * 32 + 16 + lane] = sn;
            const float k1 = z[384 + lane], k2 = z[400 + lane];
            const bf16_t o1 = f2bf(k1 * cn - k2 * sn), o2 = f2bf(k1 * sn + k2 * cn);
#pragma unroll
            for (int h = 0; h < NH; ++h) { bf16_t* kr = K + ((size_t)(b * NH + h) * SEQ + s) * 96; kr[64 + lane] = o1; kr[80 + lane] = o2; }
        }
        { bf16_t* vr = uvg + (size_t)t * 1024 + 512; float v[8]; float sm_ = 0.f;
#pragma unroll
          for (int i = 0; i < 8; ++i) { v[i] = bf2f(vr[lane + 64 * i]); sm_ += v[i]; }
          sm_ = wsum(sm_); const float mu = sm_ * (1.f / 512.f); float q = 0.f;
#pragma unroll
          for (int i = 0; i < 8; ++i) { const float d = v[i] - mu; q += d * d; }
          q = wsum(q); const float r = rsqrtf(q * (1.f / 512.f) + EPS);
#pragma unroll
          for (int i = 0; i < 8; ++i) { const int c = lane + 64 * i; vr[c] = f2bf((v[i] - mu) * r * p.sgu_gain[c] + p.sgu_bias[c]); } }
    }
}

__device__ void phase2b(const P& p, int bid, int nb, LAS unsigned char* sm) {
    bf16_t* Q = p.slotA; bf16_t* K = p.slotE; bf16_t* VT = p.slotF; const float* cs = p.cs;
    mgemm(p.cqn, 256, p.WuqT, 256, NT, 768, 256, [=](int t, int c, const float* v) {
        const int b = t >> 13, s = t & 8191;
        if (c < 512) { const int h = c >> 6, d = c & 63; bf16_t* q = Q + ((size_t)(b * NH + h) * SEQ + s) * 96 + d;
#pragma unroll
            for (int j = 0; j < 4; ++j) q[j] = f2bf(v[j]); }
        else { const int h = (c - 512) >> 5, i0 = ((c - 512) & 31) >> 1; bf16_t* q = Q + ((size_t)(b * NH + h) * SEQ + s) * 96;
#pragma unroll
            for (int e = 0; e < 2; ++e) { const int i = i0 + e; const float cn = cs[(size_t)t * 32 + i], sn = cs[(size_t)t * 32 + 16 + i]; const float x1 = v[2 * e], x2 = v[2 * e + 1];
                q[64 + i] = f2bf(x1 * cn - x2 * sn); q[80 + i] = f2bf(x1 * sn + x2 * cn); } }
    }, bid, nb, sm);
    mgemm(p.ckvn, 128, p.WukT, 128, NT, 512, 128, [=](int t, int c, const float* v) {
        const int b = t >> 13, s = t & 8191, h = c >> 6, d = c & 63; bf16_t* k = K + ((size_t)(b * NH + h) * SEQ + s) * 96 + d;
#pragma unroll
        for (int j = 0; j < 4; ++j) k[j] = f2bf(v[j]);
    }, bid, nb, sm);
    mgemm(p.WuvT, 128, p.ckvn, 128, 512, NT, 128, [=](int r, int t, const float* v) {
#pragma unroll
        for (int j = 0; j < 4; ++j) VT[(size_t)r * NT + t + j] = f2bf(v[j]);
    }, bid, nb, sm);
}

__device__ void phase2c(const P& p, int bid, int nb) {
    const bf16_t* uvg = p.slotC; bf16_t* su = p.slotG;
    for (size_t i = (size_t)bid * 256 + threadIdx.x; i < (size_t)NT * 512; i += (size_t)nb * 256) {
        const int t = (int)(i >> 9), c = (int)(i & 511), g = c >> 6, ii = t & 127, t0 = t - ii;
        const bf16_t* w = p.Wsp + ((size_t)g * 128 + ii) * 128; float s = 0.f;
        for (int j = 0; j < 128; ++j) s += bf2f(w[j]) * bf2f(uvg[(size_t)(t0 + j) * 1024 + 512 + c]);
        s += p.b_sp[g * 128 + ii];
        su[i] = f2bf(bf2f(uvg[(size_t)t * 1024 + c]) * s);
    }
}


__device__ void phase2c_m(const P& p, int bid, int nb, LAS unsigned char* lds) {
    const bf16_t* uvg = p.slotC; bf16_t* su = p.slotG;
    const int tid = threadIdx.x, lane = tid & 63, wid = tid >> 6, fr = lane & 15, fq = lane >> 4;
    const int c8 = ((tid & 7) ^ ((tid >> 3) & 7)) * 8;
    for (int u = bid; u < 1024; u += nb) {
        const int g = u & 7, t0 = (u >> 3) * 128;
        { const bf16_t* wp = p.Wsp + ((size_t)g * 128 + (tid >> 3)) * 128 + c8; LAS unsigned char* d = lds + tid * 16;
#pragma unroll
          for (int ks = 0; ks < 2; ++ks)
#pragma unroll
              for (int i = 0; i < 4; ++i) __builtin_amdgcn_global_load_lds((const unsigned*)(wp + (size_t)i * 32 * 128 + ks * 64), (LAS unsigned*)(d + ks * 16384 + i * 4096), 16, 0, 0); }
#pragma unroll
        for (int i = 0; i < 4; ++i) { const int q = tid + 256 * i, j = q >> 3, c0 = (q & 7) * 8;
            const uint4 v = *(const uint4*)(uvg + (size_t)(t0 + j) * 1024 + 512 + g * 64 + c0);
            const unsigned w[4] = {v.x, v.y, v.z, v.w};
            LAS unsigned char* bimg = lds + 32768 + (j >> 6) * 8192 + (j & 7) * 2; const int lc = (j & 63) >> 3;
#pragma unroll
            for (int e = 0; e < 8; ++e) { const int row = c0 + e; const bf16_t val = (bf16_t)((e & 1) ? (w[e >> 1] >> 16) : (w[e >> 1] & 0xffffu));
                *(LAS bf16_t*)(bimg + row * 128 + ((lc ^ (row & 7)) * 16)) = val; } }
        asm volatile("s_waitcnt vmcnt(0)" ::: "memory");
        __syncthreads();
        f32x4 acc[2][4];
#pragma unroll
        for (int m = 0; m < 2; ++m)
#pragma unroll
            for (int n = 0; n < 4; ++n) acc[m][n] = (f32x4){0.f, 0.f, 0.f, 0.f};
#pragma unroll
        for (int ks = 0; ks < 2; ++ks)
#pragma unroll
            for (int k2 = 0; k2 < 2; ++k2) { const int pc = ((k2 * 4 + fq) ^ (fr & 7)) * 16; bf16x8 af[2], bfr[4];
#pragma unroll
                for (int m = 0; m < 2; ++m) af[m] = *(const LAS bf16x8*)(lds + ks * 16384 + (wid * 32 + m * 16 + fr) * 128 + pc);
#pragma unroll
                for (int n = 0; n < 4; ++n) bfr[n] = *(const LAS bf16x8*)(lds + 32768 + ks * 8192 + (n * 16 + fr) * 128 + pc);
#pragma unroll
                for (int m = 0; m < 2; ++m)
#pragma unroll
                    for (int n = 0; n < 4; ++n) acc[m][n] = __builtin_amdgcn_mfma_f32_16x16x32_bf16(bfr[n], af[m], acc[m][n], 0, 0, 0); }
#pragma unroll
        for (int m = 0; m < 2; ++m) { const int i = wid * 32 + m * 16 + fr; const float bs = p.b_sp[g * 128 + i];
#pragma unroll
            for (int n = 0; n < 4; ++n) { const int c = g * 64 + n * 16 + fq * 4;
                const uint2 uu = *(const uint2*)(uvg + (size_t)(t0 + i) * 1024 + c);
                uint2 o; o.x = pk2(__uint_as_float(uu.x << 16) * (acc[m][n][0] + bs), __uint_as_float(uu.x & 0xffff0000u) * (acc[m][n][1] + bs));
                o.y = pk2(__uint_as_float(uu.y << 16) * (acc[m][n][2] + bs), __uint_as_float(uu.y & 0xffff0000u) * (acc[m][n][3] + bs));
                *(uint2*)(su + (size_t)(t0 + i) * 512 + c) = o; } }
        __syncthreads();
    }
}

__device__ void phase3(const P& p, int bid, int nb, float* sm) {
    float* sc = sm; float* qs = sm + 8192; float* red = qs + 96;
    const bf16_t* Q = p.slotA; const bf16_t* K = p.slotE; const bf16_t* VT = p.slotF; bf16_t* O = (bf16_t*)p.slotB;
    const int tid = threadIdx.x;
    for (int row = bid; row < NBATCH * NH * SEQ; row += nb) {
        const int q = row % SEQ, bh = row / SEQ, nk = ((q >> 6) + 1) * 64;
        if (tid < 12) ((uint4*)qs)[tid] = ((const uint4*)(Q + ((size_t)bh * SEQ + q) * 96))[tid];
        __syncthreads();
        float mx = -1e30f;
        for (int k = tid; k < nk; k += 256) { const uint4* kp = (const uint4*)(K + ((size_t)bh * SEQ + k) * 96); float s = 0.f;
#pragma unroll
            for (int d = 0; d < 12; ++d) s += dot8(((const uint4*)qs)[d], kp[d]);
            sc[k] = s; mx = fmaxf(mx, s); }
        mx = wmax(mx); if ((tid & 63) == 0) red[tid >> 6] = mx; __syncthreads();
        mx = fmaxf(fmaxf(red[0], red[1]), fmaxf(red[2], red[3])); __syncthreads();
        float sum = 0.f;
        for (int k = tid; k < nk; k += 256) { const float e = exp2f(sc[k] - mx); sc[k] = e; sum += e; }
        sum = wsum(sum); if ((tid & 63) == 0) red[tid >> 6] = sum; __syncthreads();
        sum = (red[0] + red[1]) + (red[2] + red[3]);
        const int dv = tid >> 2, part = tid & 3, h = bh & 7, b = bh >> 3;
        const bf16_t* vp = VT + (size_t)(h * 64 + dv) * NT + (size_t)b * SEQ; float o = 0.f;
        for (int k = part; k < nk; k += 4) o += sc[k] * bf2f(vp[k]);
        o += __shfl_xor(o, 1); o += __shfl_xor(o, 2);
        if (part == 0) O[(size_t)(b * SEQ + q) * 512 + h * 64 + dv] = f2bf(o / sum);
        __syncthreads();
    }
}


constexpr int ATT_BUF = 20480;
__device__ void phase3m(const P& p, int bid, int nb, LAS unsigned char* lds) {
    const bf16_t* Q = p.slotA; const bf16_t* K = p.slotE; const bf16_t* VT = p.slotF; bf16_t* O = (bf16_t*)p.slotB;
    const int tid = threadIdx.x, lane = tid & 63, wid = tid >> 6, l31 = lane & 31, hh = lane >> 5;
    int koff[3]; size_t voff[2];
#pragma unroll
    for (int i = 0; i < 3; ++i) { const int s = tid + 256 * i, r = s / 12, pc = s % 12, c = (pc + 12 - ((r >> 2) & 3)) % 12; koff[i] = r * 96 + c * 8; }
#pragma unroll
    for (int i = 0; i < 2; ++i) { const int s = tid + 256 * i, dv = s >> 3, pc = s & 7, cl = pc ^ ((dv >> 1) & 7); voff[i] = (size_t)dv * NT + cl * 8; }
    int kro[6];
#pragma unroll
    for (int ks = 0; ks < 6; ++ks) { const int v = 2 * ks + hh + ((lane >> 2) & 3); kro[ks] = (v >= 12 ? v - 12 : v) * 16; }
    const int krow = l31 * 192, vsw = (lane >> 1) & 7, vrow = l31 * 128 + 8 * hh;
    for (int iu = 0;; ++iu) {
        const int r = iu * nb + ((iu & 1) ? nb - 1 - bid : bid); if (r >= 1024) break;
        const int qb = 63 - (r >> 4), bh = r & 15, b = bh >> 3, h = bh & 7;
        const int q0 = qb * 128 + wid * 32, ntw = (q0 >> 6) + 1, nt = 2 * qb + 2;
        const bf16_t* Kb = K + (size_t)bh * SEQ * 96; const bf16_t* Vb = VT + (size_t)(h * 64) * NT + (size_t)b * SEQ;
        bf16x8 qf[6]; { const bf16_t* qp = Q + ((size_t)bh * SEQ + q0 + l31) * 96 + hh * 8;
#pragma unroll
            for (int ks = 0; ks < 6; ++ks) qf[ks] = *(const bf16x8*)(qp + ks * 16); }
        f32x16 o0, o1;
#pragma unroll
        for (int e = 0; e < 16; ++e) { o0[e] = 0.f; o1[e] = 0.f; }
        float mrun = -1e30f, lsum = 0.f;
        auto stage = [&](int j) { LAS unsigned char* d = lds + (j & 1) * ATT_BUF + tid * 16; const bf16_t* kt = Kb + (size_t)j * 64 * 96; const bf16_t* vt = Vb + j * 64;
#pragma unroll
            for (int i = 0; i < 3; ++i) __builtin_amdgcn_global_load_lds((const unsigned*)(kt + koff[i]), (LAS unsigned*)(d + i * 4096), 16, 0, 0);
#pragma unroll
            for (int i = 0; i < 2; ++i) __builtin_amdgcn_global_load_lds((const unsigned*)(vt + voff[i]), (LAS unsigned*)(d + 12288 + i * 4096), 16, 0, 0); };
        stage(0);
        for (int j = 0; j < nt; ++j) {
            asm volatile("s_waitcnt vmcnt(0)" ::: "memory");
            __syncthreads();
            if (j + 1 < nt) stage(j + 1);
            if (j < ntw) {
                const LAS unsigned char* kb_ = lds + (j & 1) * ATT_BUF + krow; const LAS unsigned char* vb_ = lds + (j & 1) * ATT_BUF + 12288 + vrow;
                f32x16 s0, s1;
#pragma unroll
                for (int e = 0; e < 16; ++e) { s0[e] = 0.f; s1[e] = 0.f; }
#pragma unroll
                for (int ks = 0; ks < 6; ++ks) { const bf16x8 k0 = *(const LAS bf16x8*)(kb_ + kro[ks]); const bf16x8 k1 = *(const LAS bf16x8*)(kb_ + 32 * 192 + kro[ks]);
                    s0 = __builtin_amdgcn_mfma_f32_32x32x16_bf16(k0, qf[ks], s0, 0, 0, 0); s1 = __builtin_amdgcn_mfma_f32_32x32x16_bf16(k1, qf[ks], s1, 0, 0, 0); }
                float mx = fmaxf(s0[0], s1[0]);
#pragma unroll
                for (int e = 1; e < 16; ++e) mx = fmaxf(mx, fmaxf(s0[e], s1[e]));
                mx = fmaxf(mx, __shfl_xor(mx, 32));
                const float mn = fmaxf(mrun, mx), alpha = __builtin_amdgcn_exp2f(mrun - mn); mrun = mn;
                float ps = 0.f;
#pragma unroll
                for (int e = 0; e < 16; ++e) { s0[e] = __builtin_amdgcn_exp2f(s0[e] - mn); s1[e] = __builtin_amdgcn_exp2f(s1[e] - mn); ps += s0[e] + s1[e]; }
                lsum = lsum * alpha + ps;
#pragma unroll
                for (int e = 0; e < 16; ++e) { o0[e] *= alpha; o1[e] *= alpha; }
                unsigned pw[16];
#pragma unroll
                for (int e = 0; e < 8; ++e) { pw[e] = pk2(s0[2 * e], s0[2 * e + 1]); pw[8 + e] = pk2(s1[2 * e], s1[2 * e + 1]); }
#pragma unroll
                for (int s = 0; s < 4; ++s) {
                    const u32x4 pbu = {pw[4 * s], pw[4 * s + 1], pw[4 * s + 2], pw[4 * s + 3]}; const bf16x8 pb = __builtin_bit_cast(bf16x8, pbu);
                    const int c0 = ((2 * s) ^ vsw) * 16, c1 = ((2 * s + 1) ^ vsw) * 16;
                    const u32x2 a0 = *(const LAS u32x2*)(vb_ + c0), a1 = *(const LAS u32x2*)(vb_ + c1);
                    const u32x2 b0 = *(const LAS u32x2*)(vb_ + 32 * 128 + c0), b1 = *(const LAS u32x2*)(vb_ + 32 * 128 + c1);
                    const u32x4 va = {a0.x, a0.y, a1.x, a1.y}, vb = {b0.x, b0.y, b1.x, b1.y};
                    o0 = __builtin_amdgcn_mfma_f32_32x32x16_bf16(__builtin_bit_cast(bf16x8, va), pb, o0, 0, 0, 0);
                    o1 = __builtin_amdgcn_mfma_f32_32x32x16_bf16(__builtin_bit_cast(bf16x8, vb), pb, o1, 0, 0, 0);
                }
            }
        }
        const float inv = 1.f / (lsum + __shfl_xor(lsum, 32));
        bf16_t* op = O + (size_t)(b * SEQ + q0 + l31) * 512 + h * 64 + 4 * hh;
#pragma unroll
        for (int g = 0; g < 4; ++g) { uint2 w0, w1;
            w0.x = pk2(o0[4 * g] * inv, o0[4 * g + 1] * inv); w0.y = pk2(o0[4 * g + 2] * inv, o0[4 * g + 3] * inv);
            w1.x = pk2(o1[4 * g] * inv, o1[4 * g + 1] * inv); w1.y = pk2(o1[4 * g + 2] * inv, o1[4 * g + 3] * inv);
            *(uint2*)(op + 8 * g) = w0; *(uint2*)(op + 32 + 8 * g) = w1; }
        __syncthreads();
    }
}

__device__ __forceinline__ unsigned pack2bf(float lo, float hi) { return (unsigned)f2bf(lo) | ((unsigned)f2bf(hi) << 16); }
__device__ void phase4(const P& p, int bid, int nb, LAS unsigned char* lds) {
    const bf16_t* O = (const bf16_t*)p.slotB; const bf16_t* su = p.slotG; const bf16_t* gates = p.slotD; bf16_t* mo = p.slotA;
    const int tid = threadIdx.x, lane = tid & 63, wid = tid >> 6, wr = wid >> 1, wc = wid & 1, fr = lane & 15, fq = lane >> 4;
    const int c8 = ((tid & 7) ^ ((tid >> 3) & 7)) * 8;
    int rt, ct;
    for (int it = 0; tile_of(it, bid, nb, NT / 128, DM / 128, rt, ct); ++it) {
        const int row0 = rt * 128, col0 = ct * 128;
        f32x4 acc0[4][4], acc1[4][4];
#pragma unroll
        for (int m = 0; m < 4; ++m)
#pragma unroll
            for (int n = 0; n < 4; ++n) { acc0[m][n] = (f32x4){0.f, 0.f, 0.f, 0.f}; acc1[m][n] = (f32x4){0.f, 0.f, 0.f, 0.f}; }
        mg_kloop(acc0, O + (size_t)(row0 + (tid >> 3)) * 512 + c8, (size_t)32 * 512, p.WoaT + (size_t)(col0 + (tid >> 3)) * 512 + c8, (size_t)32 * 512, 8, lds);
        mg_kloop(acc1, su + (size_t)(row0 + (tid >> 3)) * 512 + c8, (size_t)32 * 512, p.WosT + (size_t)(col0 + (tid >> 3)) * 512 + c8, (size_t)32 * 512, 8, lds);
#pragma unroll
        for (int m = 0; m < 4; ++m)
#pragma unroll
            for (int n = 0; n < 4; ++n) { const int t = row0 + wr * 64 + m * 16 + fr, c = col0 + wc * 64 + n * 16 + fq * 4;
                const uint2 ga = *(const uint2*)(gates + (size_t)t * 2048 + c), gb = *(const uint2*)(gates + (size_t)t * 2048 + 1024 + c);
                const float r0 = __uint_as_float(ga.x << 16) * acc0[m][n][0] + __uint_as_float(gb.x << 16) * acc1[m][n][0];
                const float r1 = __uint_as_float(ga.x & 0xffff0000u) * acc0[m][n][1] + __uint_as_float(gb.x & 0xffff0000u) * acc1[m][n][1];
                const float r2 = __uint_as_float(ga.y << 16) * acc0[m][n][2] + __uint_as_float(gb.y << 16) * acc1[m][n][2];
                const float r3 = __uint_as_float(ga.y & 0xffff0000u) * acc0[m][n][3] + __uint_as_float(gb.y & 0xffff0000u) * acc1[m][n][3];
                uint2 o; o.x = pack2bf(r0, r1); o.y = pack2bf(r2, r3); *(uint2*)(mo + (size_t)t * DM + c) = o; }
    }
}

__device__ void phase5(const P& p, int bid, int nb, LAS unsigned char* sm) {
    const float* x = p.x; float* xm = p.out;
    mgemm(p.slotA, DM, p.WoutT, DM, NT, DM, DM, [=](int t, int c, const float* v) {
#pragma unroll
        for (int j = 0; j < 4; ++j) xm[(size_t)t * DM + c + j] = x[(size_t)t * DM + c + j] + v[j];
    }, bid, nb, sm);
}

__device__ __forceinline__ int gu_src_col(int rho, int& isup) {
    const int tt = rho >> 7, w = rho & 127, wc = w >> 6, n = (w >> 4) & 3, i = w & 15; isup = n >> 1; return tt * 64 + wc * 32 + (n & 1) * 16 + i;
}
__device__ void phase6(const P& p, int bid, int nb, float* sm) {
    const int tid = threadIdx.x, lane = tid & 63, wid = tid >> 6;
    bf16_t* h2 = p.slotA; const float* xm = p.out;
    for (int t = bid * 4 + wid; t < NT; t += nb * 4) {
        float v[16]; float ss = 0.f;
#pragma unroll
        for (int i = 0; i < 16; ++i) { v[i] = xm[(size_t)t * DM + lane + 64 * i]; ss += v[i] * v[i]; }
        ss = wsum(ss); const float r = rsqrtf(ss * (1.f / DM) + EPS);
#pragma unroll
        for (int i = 0; i < 16; ++i) { v[i] = v[i] * r * p.g_ffn[lane + 64 * i]; h2[(size_t)t * DM + lane + 64 * i] = f2bf(v[i]); }
        float lg[4] = {0.f, 0.f, 0.f, 0.f};
#pragma unroll
        for (int i = 0; i < 16; ++i) { const float* w = p.w_rg + (size_t)(lane + 64 * i) * 4;
#pragma unroll
            for (int g = 0; g < 4; ++g) lg[g] += v[i] * w[g]; }
#pragma unroll
        for (int g = 0; g < 4; ++g) lg[g] = wsum(lg[g]) + p.b_rg[g];
        int gs = 0; float gm = lg[0];
#pragma unroll
        for (int g = 1; g < 4; ++g) if (lg[g] > gm) { gm = lg[g]; gs = g; }
        float den = 0.f;
#pragma unroll
        for (int g = 0; g < 4; ++g) den += __expf(lg[g] - gm);
        const float ptop = 1.f / den;
        float le[8] = {0.f, 0.f, 0.f, 0.f, 0.f, 0.f, 0.f, 0.f};
#pragma unroll
        for (int i = 0; i < 16; ++i) { const float* w = p.w_re + ((size_t)gs * DM + lane + 64 * i) * 8;
#pragma unroll
            for (int e = 0; e < 8; ++e) le[e] += v[i] * w[e]; }
#pragma unroll
        for (int e = 0; e < 8; ++e) le[e] = wsum(le[e]) + p.b_re[gs * 8 + e];
        int e1 = 0; float l1 = le[0];
#pragma unroll
        for (int e = 1; e < 8; ++e) if (le[e] > l1) { l1 = le[e]; e1 = e; }
        int e2 = -1; float l2 = -3.0e38f;
#pragma unroll
        for (int e = 0; e < 8; ++e) if (e != e1 && le[e] > l2) { l2 = le[e]; e2 = e; }
        const float s1 = 1.f / (1.f + __expf(l2 - l1)), s2 = 1.f - s1;
        if (lane == 0) {
            const int ea = gs * 8 + e1, eb = gs * 8 + e2;
            const int ra = atomicAdd(&p.cnt[ea], 1); p.list[(size_t)ea * NT + ra] = 2 * t;
            const int rb = atomicAdd(&p.cnt[eb], 1); p.list[(size_t)eb * NT + rb] = 2 * t + 1;
            p.aw[2 * t] = s1 * ptop; p.aw[2 * t + 1] = s2 * ptop; p.aexp[2 * t] = ea; p.aexp[2 * t + 1] = eb;
        }
    }
    bf16_t* WguT = (bf16_t*)p.slotB; bf16_t* WdT = WguT + (size_t)NE * 512 * 1024;
    const size_t gtid = (size_t)bid * 256 + tid, gsz = (size_t)nb * 256;
    int base = 0;
    for (int e = 0; e < NE; ++e) {
        base = tconv(WguT + (size_t)e * 512 * 1024, 512, 1024, [&](int k, int rho) { int isup; const int col = gu_src_col(rho, isup); const float* src = isup ? p.w_eu : p.w_eg;
            return src[((size_t)e * 1024 + k) * 256 + col]; }, base, bid, nb, sm);
        base = tconv(WdT + (size_t)e * 1024 * 256, 1024, 256, [&](int k, int n) { return p.w_ed[((size_t)e * 256 + k) * 1024 + n]; }, base, bid, nb, sm);
    }
}

__device__ void phase7a(const P& p, int bid, int nb) {
    const bf16_t* h2 = p.slotA; const bf16_t* WguT = (const bf16_t*)p.slotB; bf16_t* hid = p.slotE;
    for (size_t i = (size_t)bid * 256 + threadIdx.x; i < (size_t)2 * NT * 256; i += (size_t)nb * 256) {
        const int a = (int)(i >> 8), c = (int)(i & 255), t = a >> 1, e = p.aexp[a];
        const int tt = c >> 6, wc = (c >> 5) & 1, nn = (c >> 4) & 1, ii = c & 15; const int rg = tt * 128 + wc * 64 + nn * 16 + ii, ru = rg + 32;
        const bf16_t* wg = WguT + ((size_t)e * 512 + rg) * 1024; const bf16_t* wu = WguT + ((size_t)e * 512 + ru) * 1024; const bf16_t* hr = h2 + (size_t)t * DM;
        float G = 0.f, U = 0.f;
        for (int k = 0; k < DM / 8; ++k) { const uint4 hv = ((const uint4*)hr)[k]; G += dot8(hv, ((const uint4*)wg)[k]); U += dot8(hv, ((const uint4*)wu)[k]); }
        hid[i] = f2bf(G * sigmoidf_(G) * U);
    }
}
__device__ void phase7b(const P& p, int bid, int nb) {
    const bf16_t* hid = p.slotE; const bf16_t* WdT = (const bf16_t*)p.slotB + (size_t)NE * 512 * 1024; bf16_t* Y = p.slotD;
    for (size_t i = (size_t)bid * 256 + threadIdx.x; i < (size_t)2 * NT * DM; i += (size_t)nb * 256) {
        const int a = (int)(i >> 10), n = (int)(i & 1023), e = p.aexp[a];
        const bf16_t* w = WdT + ((size_t)e * 1024 + n) * 256; const bf16_t* hr = hid + (size_t)a * 256; float s = 0.f;
        for (int k = 0; k < 32; ++k) s += dot8(((const uint4*)hr)[k], ((const uint4*)w)[k]);
        Y[i] = f2bf(s * p.aw[a]);
    }
}


__device__ __forceinline__ bool find_expert(const int* cnt, int ub, int& e, int& blk, int& ce) {
    int acc = 0;
    for (int i = 0; i < NE; ++i) { const int c = cnt[i], n = (c + 127) >> 7; if (ub < acc + n) { e = i; blk = ub - acc; ce = c; return true; } acc += n; }
    return false;
}
__device__ void phase7a_m(const P& p, int bid, int nb, LAS unsigned char* lds) {
    const bf16_t* h2 = p.slotA; const bf16_t* WguT = (const bf16_t*)p.slotB; bf16_t* hid = p.slotE;
    const int tid = threadIdx.x, lane = tid & 63, wid = tid >> 6, wr = wid >> 1, wc = wid & 1, fr = lane & 15, fq = lane >> 4;
    const int c8 = ((tid & 7) ^ ((tid >> 3) & 7)) * 8;
    for (int u = bid;; u += nb) {
        int e, blk, ce; if (!find_expert(p.cnt, u >> 2, e, blk, ce)) break;
        const int ct = u & 3; const int* lst = p.list + (size_t)e * NT;
        const bf16_t* ap[4];
#pragma unroll
        for (int i = 0; i < 4; ++i) { int r = blk * 128 + (tid >> 3) + 32 * i; r = r < ce ? r : ce - 1; ap[i] = h2 + (size_t)(lst[r] >> 1) * DM + c8; }
        f32x4 acc[4][4];
#pragma unroll
        for (int m = 0; m < 4; ++m)
#pragma unroll
            for (int n = 0; n < 4; ++n) acc[m][n] = (f32x4){0.f, 0.f, 0.f, 0.f};
        mg_kloop4(acc, ap[0], ap[1], ap[2], ap[3], WguT + ((size_t)e * 512 + ct * 128 + (tid >> 3)) * 1024 + c8, (size_t)32 * 1024, 16, lds);
        bf16_t* hb = hid + ((size_t)(u >> 2) * 128 + wr * 64 + fr) * 256 + ct * 64 + wc * 32 + fq * 4;
#pragma unroll
        for (int m = 0; m < 4; ++m)
#pragma unroll
            for (int n = 0; n < 2; ++n) { float v[4];
#pragma unroll
                for (int j = 0; j < 4; ++j) { const float g = acc[m][n][j]; v[j] = g * sigmoidf_(g) * acc[m][n + 2][j]; }
                uint2 o; o.x = pk2(v[0], v[1]); o.y = pk2(v[2], v[3]); *(uint2*)(hb + (size_t)(m * 16) * 256 + n * 16) = o; }
    }
}
__device__ void phase7b_m(const P& p, int bid, int nb, LAS unsigned char* lds) {
    const bf16_t* hid = p.slotE; const bf16_t* WdT = (const bf16_t*)p.slotB + (size_t)NE * 512 * 1024; bf16_t* Y = p.slotD;
    const int tid = threadIdx.x, lane = tid & 63, wid = tid >> 6, wr = wid >> 1, wc = wid & 1, fr = lane & 15, fq = lane >> 4;
    const int c8 = ((tid & 7) ^ ((tid >> 3) & 7)) * 8;
    for (int u = bid;; u += nb) {
        int e, blk, ce; if (!find_expert(p.cnt, u >> 3, e, blk, ce)) break;
        const int ct = u & 7; const int* lst = p.list + (size_t)e * NT;
        f32x4 acc[4][4];
#pragma unroll
        for (int m = 0; m < 4; ++m)
#pragma unroll
            for (int n = 0; n < 4; ++n) acc[m][n] = (f32x4){0.f, 0.f, 0.f, 0.f};
        mg_kloop(acc, hid + ((size_t)(u >> 3) * 128 + (tid >> 3)) * 256 + c8, (size_t)32 * 256, WdT + ((size_t)e * 1024 + ct * 128 + (tid >> 3)) * 256 + c8, (size_t)32 * 256, 4, lds);
#pragma unroll
        for (int m = 0; m < 4; ++m) { const int r = blk * 128 + wr * 64 + m * 16 + fr;
            if (r < ce) { const int a = lst[r]; const float w = p.aw[a]; bf16_t* yp = Y + (size_t)a * DM + ct * 128 + wc * 64 + fq * 4;
#pragma unroll
                for (int n = 0; n < 4; ++n) { uint2 o; o.x = pk2(acc[m][n][0] * w, acc[m][n][1] * w); o.y = pk2(acc[m][n][2] * w, acc[m][n][3] * w); *(uint2*)(yp + n * 16) = o; } } }
    }
}

__device__ void phase8(const P& p, int bid, int nb) {
    const int tid = threadIdx.x, lane = tid & 63, wid = tid >> 6; const bf16_t* Y = p.slotD;
    for (int t = bid * 4 + wid; t < NT; t += nb * 4) {
        float v[16]; float ss = 0.f;
#pragma unroll
        for (int i = 0; i < 16; ++i) { const int c = lane + 64 * i; v[i] = p.out[(size_t)t * DM + c] + bf2f(Y[(size_t)(2 * t) * DM + c]) + bf2f(Y[(size_t)(2 * t + 1) * DM + c]); ss += v[i] * v[i]; }
        ss = wsum(ss); const float r = rsqrtf(ss * (1.f / DM) + EPS);
#pragma unroll
        for (int i = 0; i < 16; ++i) { const int c = lane + 64 * i; p.out[(size_t)t * DM + c] = v[i] * r * p.g_final[c]; }
    }
}


#define XB_TMO      128
#define XB_XCNT(j)  (256  + 64 * (j))
#define XB_XSUB(j)  (1280 + 64 * (j))
#define XB_XGEN(j)  (2304 + 64 * (j))
#define XB_TOP      3328
#define XB_TOPGEN   3392
#define XCD_BAR_WORDS 3456
#define XB_SPIN_CAP (1u << 18)
__device__ __forceinline__ unsigned xb_ld(unsigned* p)              { return __hip_atomic_load(p, __ATOMIC_RELAXED, __HIP_MEMORY_SCOPE_AGENT); }
__device__ __forceinline__ unsigned xb_add(unsigned* p, unsigned v) { return __hip_atomic_fetch_add(p, v, __ATOMIC_RELAXED, __HIP_MEMORY_SCOPE_AGENT); }
__device__ __forceinline__ unsigned xb_xcc_id() { return (unsigned)__builtin_amdgcn_s_getreg((3 << 11) | 20) & 0xFu; }
#define XB_SPIN(cond, bar) do { unsigned _sp = 0; while (cond) { __builtin_amdgcn_s_sleep(1); \
    if ((++_sp & 255u) == 0u) { if (xb_ld(&(bar)[XB_TMO])) break; if (_sp > XB_SPIN_CAP) { atomicAdd(&(bar)[XB_TMO], 1u); break; } } } } while (0)
struct XcdBarrier { unsigned* bar; unsigned x; volatile LAS unsigned* st; };
__device__ __forceinline__ XcdBarrier xcd_barrier_post(unsigned* bar, volatile LAS unsigned* st) {
    XcdBarrier b; b.bar = bar; b.x = xb_xcc_id(); b.st = st;
    if (threadIdx.x == 0) (void)xb_add(&bar[XB_XCNT(b.x)], 1u);
    return b;
}
__device__ __forceinline__ void xcd_barrier_complete(unsigned* bar, unsigned x, unsigned& nloc, unsigned& nx) {
    const unsigned G = gridDim.x * gridDim.y * gridDim.z;
    unsigned sum, cnt, mine, sp = 0u;
    for (;;) {
        sum = 0u; cnt = 0u; mine = 0u;
#pragma unroll
        for (unsigned j = 0; j < 16; ++j) { const unsigned c = xb_ld(&bar[XB_XCNT(j)]); sum += c; cnt += (c > 0u) ? 1u : 0u; mine = (j == x) ? c : mine; }
        if (sum == G) break;
        __builtin_amdgcn_s_sleep(1);
        if ((++sp & 255u) == 0u) { if (xb_ld(&bar[XB_TMO])) break; if (sp > XB_SPIN_CAP) { atomicAdd(&bar[XB_TMO], 1u); break; } }
    }
    nloc = mine > 0u ? mine : 1u; nx = cnt > 0u ? cnt : 1u;
}
__device__ __forceinline__ void xcd_barrier(const XcdBarrier& b) {
    asm volatile("s_waitcnt vmcnt(0)" ::: "memory");
    __syncthreads();
    if (threadIdx.x == 0) {
        unsigned* bar = b.bar;
        __builtin_amdgcn_s_waitcnt(0);
        unsigned nloc = b.st[0], nx = b.st[1];
        if (nloc == 0u) { xcd_barrier_complete(bar, b.x, nloc, nx); b.st[0] = nloc; b.st[1] = nx; }
        const unsigned old = xb_add(&bar[XB_XSUB(b.x)], 1u);
        const unsigned gen = old / nloc;
        if (old + 1u == (gen + 1u) * nloc) {
            __builtin_amdgcn_fence(__ATOMIC_RELEASE, "agent");
            asm volatile("s_waitcnt vmcnt(0)" ::: "memory");
            const unsigned og = xb_add(&bar[XB_TOP], 1u);
            const unsigned tg = og / nx;
            if (og + 1u == (tg + 1u) * nx) xb_add(&bar[XB_TOPGEN], 1u);
            else XB_SPIN(xb_ld(&bar[XB_TOPGEN]) == tg, bar);
            __builtin_amdgcn_fence(__ATOMIC_ACQUIRE, "agent");
            xb_add(&bar[XB_XGEN(b.x)], 1u);
            asm volatile("s_waitcnt vmcnt(0)" ::: "memory");
        } else {
            XB_SPIN(xb_ld(&bar[XB_XGEN(b.x)]) == gen, bar);
            __builtin_amdgcn_fence(__ATOMIC_ACQUIRE, "agent");
            asm volatile("s_waitcnt vmcnt(0)" ::: "memory");
        }
    }
    __syncthreads();
}

constexpr int LDS_MAIN = 64 * 1024;
constexpr int LDS_BYTES = LDS_MAIN + 16;
extern __shared__ __attribute__((aligned(16))) unsigned char smem_raw[];

__global__ void __launch_bounds__(256, 2) k_phase(P p, int ph) {
    float* sm = (float*)smem_raw; LAS unsigned char* lds = (LAS unsigned char*)smem_raw; const int bid = blockIdx.x, nb = gridDim.x;
    switch (ph) {
        case 0: phase0(p, bid, nb, sm); break;
        case 1: phase1(p, bid, nb, lds); break;
        case 2: phase2a(p, bid, nb); break;
        case 3: phase2b(p, bid, nb, lds); break;
        case 4: phase2c_m(p, bid, nb, lds); break;
        case 5: phase3m(p, bid, nb, lds); break;
        case 6: phase4(p, bid, nb, lds); break;
        case 7: phase5(p, bid, nb, lds); break;
        case 8: phase6(p, bid, nb, sm); break;
        case 9: phase7a_m(p, bid, nb, lds); break;
        case 10: phase7b_m(p, bid, nb, lds); break;
        case 11: phase8(p, bid, nb); break;
    }
}

__global__ void __launch_bounds__(256, 2) k_mega(P p) {
    float* sm = (float*)smem_raw; LAS unsigned char* lds = (LAS unsigned char*)smem_raw; const int bid = blockIdx.x, nb = gridDim.x;
    volatile LAS unsigned* st = (volatile LAS unsigned*)(lds + LDS_MAIN);
    if (threadIdx.x < 4) st[threadIdx.x] = 0u;
    __syncthreads();
    const XcdBarrier gb = xcd_barrier_post(p.bar, st);
    phase0(p, bid, nb, sm); xcd_barrier(gb);
    phase1(p, bid, nb, lds); xcd_barrier(gb);
    phase2a(p, bid, nb); xcd_barrier(gb);
    phase2b(p, bid, nb, lds); phase2c_m(p, bid, nb, lds); xcd_barrier(gb);
    phase3m(p, bid, nb, lds); xcd_barrier(gb);
    phase4(p, bid, nb, lds); xcd_barrier(gb);
    phase5(p, bid, nb, lds); xcd_barrier(gb);
    phase6(p, bid, nb, sm); xcd_barrier(gb);
    phase7a_m(p, bid, nb, lds); xcd_barrier(gb);
    phase7b_m(p, bid, nb, lds); xcd_barrier(gb);
    phase8(p, bid, nb);
}

extern "C" void kernel_launch(void* const* d_in, const int* in_sizes, int n_in, void* d_out, int out_size, void* d_ws, size_t ws_size, hipStream_t stream) {
    P p{};
    p.x = (const float*)d_in[0]; p.pos = (const int*)d_in[1]; p.g_attn = (const float*)d_in[2]; p.w_in = (const float*)d_in[3]; p.g_cq = (const float*)d_in[4];
    p.w_uq = (const float*)d_in[5]; p.g_ckv = (const float*)d_in[6]; p.w_uk = (const float*)d_in[7]; p.w_uv = (const float*)d_in[8]; p.w_o_attn = (const float*)d_in[9];
    p.sgu_gain = (const float*)d_in[10]; p.sgu_bias = (const float*)d_in[11]; p.w_sp = (const float*)d_in[12]; p.b_sp = (const float*)d_in[13]; p.w_o_sgu = (const float*)d_in[14];
    p.w_out = (const float*)d_in[15]; p.g_ffn = (const float*)d_in[16]; p.w_rg = (const float*)d_in[17]; p.b_rg = (const float*)d_in[18]; p.w_re = (const float*)d_in[19];
    p.b_re = (const float*)d_in[20]; p.w_eg = (const float*)d_in[21]; p.w_eu = (const float*)d_in[22]; p.w_ed = (const float*)d_in[23]; p.g_final = (const float*)d_in[24];
    p.out = (float*)d_out;
    unsigned char* w = (unsigned char*)d_ws; size_t off = 0;
    auto take = [&](size_t bytes) { unsigned char* r = w + off; off += (bytes + 255) & ~(size_t)255; return r; };
    p.bar = (unsigned*)take(XCD_BAR_WORDS * 4);
    p.cnt = (int*)take(4096);
    p.WinT = (bf16_t*)take((size_t)ZP * DM * 2); p.WuqT = (bf16_t*)take(768 * 256 * 2); p.WukT = (bf16_t*)take(512 * 128 * 2); p.WuvT = (bf16_t*)take(512 * 128 * 2);
    p.WoaT = (bf16_t*)take(1024 * 512 * 2); p.WosT = (bf16_t*)take(1024 * 512 * 2); p.WoutT = (bf16_t*)take(1024 * 1024 * 2); p.Wsp = (bf16_t*)take(8 * 128 * 128 * 2);
    p.cs = (float*)take((size_t)NT * 32 * 4); p.cqn = (bf16_t*)take((size_t)NT * 256 * 2); p.ckvn = (bf16_t*)take((size_t)NT * 128 * 2);
    p.list = (int*)take((size_t)NE * NT * 4); p.aw = (float*)take((size_t)2 * NT * 4); p.aexp = (int*)take((size_t)2 * NT * 4);
    p.slotA = (bf16_t*)take((size_t)NT * DM * 2);
    p.slotB = take((size_t)NT * 512 * 4);
    p.slotC = (bf16_t*)take((size_t)NT * 1024 * 2);
    p.slotD = (bf16_t*)take((size_t)NT * 2048 * 2);
    p.slotE = (bf16_t*)take((size_t)NT * NH * 96 * 2);
    p.slotF = (bf16_t*)take((size_t)512 * NT * 2);
    p.slotG = (bf16_t*)take((size_t)NT * 512 * 2);
    if (off > ws_size) { fprintf(stderr, "workspace too small: need %zu have %zu\n", off, ws_size); return; }
#if MK_LAUNCHES == 1
    static int grid_blocks = 0;
    if (!grid_blocks) { int dev = 0, cus = 0, per_cu = 0; hipGetDevice(&dev); hipDeviceGetAttribute(&cus, hipDeviceAttributeMultiprocessorCount, dev);
        hipOccupancyMaxActiveBlocksPerMultiprocessor(&per_cu, k_mega, 256, LDS_BYTES); if (per_cu > 2) per_cu = 2; grid_blocks = cus * per_cu; }
    (void)hipMemsetAsync(p.bar, 0, XCD_BAR_WORDS * 4, stream);
    void* args[] = {&p};
    hipError_t e = hipLaunchCooperativeKernel((void*)k_mega, dim3(grid_blocks), dim3(256), args, LDS_BYTES, stream);
    if (e != hipSuccess) fprintf(stderr, "cooperative launch failed: %s (grid %d)\n", hipGetErrorString(e), grid_blocks);
#else
    for (int ph = 0; ph < 12; ++ph) k_phase<<<2048, 256, LDS_BYTES, stream>>>(p, ph);
#endif
}
```

```cpp
#include <hip/hip_runtime.h>
#include <hip/hip_cooperative_groups.h>
#include <cstdint>
#include <cstdio>
namespace cg = cooperative_groups;

#ifndef ATT_SGB
#define ATT_SGB 1
#endif
#ifndef PROBE
#define PROBE 0
#endif
#ifndef MK_LAUNCHES
#define MK_LAUNCHES 1
#endif

typedef unsigned short bf16_t;
constexpr int NT = 16384, SEQ = 8192, DM = 1024, NBATCH = 2;
constexpr int ZC = 3488;
constexpr int ZP = 3584;
constexpr int NH = 8;
constexpr float EPS = 1e-6f;
constexpr int NE = 32;

struct P {
    const float* x; const int* pos; const float* g_attn; const float* w_in; const float* g_cq; const float* w_uq;
    const float* g_ckv; const float* w_uk; const float* w_uv; const float* w_o_attn; const float* sgu_gain; const float* sgu_bias;
    const float* w_sp; const float* b_sp; const float* w_o_sgu; const float* w_out; const float* g_ffn; const float* w_rg;
    const float* b_rg; const float* w_re; const float* b_re; const float* w_eg; const float* w_eu; const float* w_ed; const float* g_final;
    float* out;
    unsigned* bar;
    int* cnt;
    bf16_t* WinT;
    bf16_t* WuqT;
    bf16_t* WukT;
    bf16_t* WuvT;
    bf16_t* WoaT;
    bf16_t* WosT;
    bf16_t* WoutT;
    bf16_t* Wsp;
    float* cs;
    bf16_t* cqn;
    bf16_t* ckvn;
    int* list;
    float* aw;
    int* aexp;
    bf16_t* slotA;
    unsigned char* slotB;
    bf16_t* slotC;
    bf16_t* slotD;
    bf16_t* slotE;
    bf16_t* slotF;
    bf16_t* slotG;
};

__device__ __forceinline__ int opaque_tid() { int t = threadIdx.x; asm volatile("" : "+v"(t)); return t; }
__device__ __forceinline__ float bf2f(bf16_t v) { return __uint_as_float(((unsigned)v) << 16); }
__device__ __forceinline__ bf16_t f2bf(float f) { unsigned u = __float_as_uint(f); u += 0x7fffu + ((u >> 16) & 1u); return (bf16_t)(u >> 16); }
__device__ __forceinline__ float dot8(const uint4 a, const uint4 b) {
    float s = 0.f;
    s += __uint_as_float(a.x << 16) * __uint_as_float(b.x << 16) + __uint_as_float(a.x & 0xffff0000u) * __uint_as_float(b.x & 0xffff0000u);
    s += __uint_as_float(a.y << 16) * __uint_as_float(b.y << 16) + __uint_as_float(a.y & 0xffff0000u) * __uint_as_float(b.y & 0xffff0000u);
    s += __uint_as_float(a.z << 16) * __uint_as_float(b.z << 16) + __uint_as_float(a.z & 0xffff0000u) * __uint_as_float(b.z & 0xffff0000u);
    s += __uint_as_float(a.w << 16) * __uint_as_float(b.w << 16) + __uint_as_float(a.w & 0xffff0000u) * __uint_as_float(b.w & 0xffff0000u);
    return s;
}
__device__ __forceinline__ float wsum(float v) { for (int o = 32; o > 0; o >>= 1) v += __shfl_xor(v, o); return v; }
__device__ __forceinline__ float wmax(float v) { for (int o = 32; o > 0; o >>= 1) v = fmaxf(v, __shfl_xor(v, o)); return v; }
__device__ __forceinline__ float fsigmoid(float v) { return __builtin_amdgcn_rcpf(1.f + __builtin_amdgcn_exp2f(-1.4426950408889634f * v)); }
__device__ __forceinline__ float fgelu(float v) { const float u2 = 1.5957691216057308f * (v + 0.044715f * v * v * v); return v * fsigmoid(u2); }
__device__ __forceinline__ float gelu_tanh(float v) { const float u = 0.7978845608028654f * (v + 0.044715f * v * v * v); const float t = 1.f - 2.f / (__expf(2.f * u) + 1.f); return 0.5f * v * (1.f + t); }
__device__ __forceinline__ float sigmoidf_(float v) { return 1.f / (1.f + __expf(-v)); }

#define LAS __attribute__((address_space(3)))
typedef short bf16x8 __attribute__((ext_vector_type(8)));
typedef float f32x4 __attribute__((ext_vector_type(4)));
constexpr int GEMM_LDS = 65536;
typedef float f32x16 __attribute__((ext_vector_type(16)));
typedef unsigned u32x2 __attribute__((ext_vector_type(2)));
typedef unsigned u32x4 __attribute__((ext_vector_type(4)));
typedef __bf16 bf16v2 __attribute__((ext_vector_type(2)));
typedef float f32v2 __attribute__((ext_vector_type(2)));
__device__ __forceinline__ unsigned pk2(float lo, float hi) { const f32v2 v = {lo, hi}; return __builtin_bit_cast(unsigned, __builtin_convertvector(v, bf16v2)); }


template <class F>
__device__ __forceinline__ int tconv(bf16_t* dst, int R, int K, F f, int base, int bid, int nb, float* sm) {
    const int tid = opaque_tid(), tk = K / 64, ntile = (R / 64) * tk;
    for (int tile = ((bid - base) % nb + nb) % nb; tile < ntile; tile += nb) {
        const int rho0 = (tile / tk) * 64, k0 = (tile % tk) * 64;
#pragma unroll
        for (int i = 0; i < 16; ++i) { const int kk = (tid >> 6) + 4 * i, rr = tid & 63; sm[kk * 65 + rr] = f(k0 + kk, rho0 + rr); }
        __syncthreads();
#pragma unroll
        for (int i = 0; i < 8; ++i) { const int rr = (tid >> 5) + 8 * i, kk = (tid & 31) * 2;
            *(unsigned*)(dst + (size_t)(rho0 + rr) * K + k0 + kk) = pk2(sm[kk * 65 + rr], sm[(kk + 1) * 65 + rr]); }
        __syncthreads();
    }
    return base + ntile;
}

__device__ void phase0(const P& p, int bid, int nb, float* sm) {
    const int tid = opaque_tid(), lane = tid & 63, wid = tid >> 6;
    const size_t gtid = (size_t)bid * 256 + tid, gsz = (size_t)nb * 256;
    if (bid == 0 && tid < NE) p.cnt[tid] = 0;
    for (int t = bid * 4 + wid; t < NT; t += nb * 4) {
        const float* xr = p.x + (size_t)t * DM; f32x4 v[4]; float ss = 0.f;
#pragma unroll
        for (int i = 0; i < 4; ++i) { v[i] = *(const f32x4*)(xr + (lane + 64 * i) * 4); ss += v[i][0] * v[i][0] + v[i][1] * v[i][1] + v[i][2] * v[i][2] + v[i][3] * v[i][3]; }
        ss = wsum(ss); const float r = rsqrtf(ss * (1.f / DM) + EPS);
        bf16_t* hr = p.slotA + (size_t)t * DM;
#pragma unroll
        for (int i = 0; i < 4; ++i) { uint2 o; o.x = pk2(v[i][0] * r, v[i][1] * r); o.y = pk2(v[i][2] * r, v[i][3] * r); *(uint2*)(hr + (lane + 64 * i) * 4) = o; }
    }
    int base = 0;
    base = tconv(p.WinT, ZP, DM, [&](int k, int rho) { float v = 0.f;
        if (rho < 416) v = p.w_in[(size_t)k * ZC + rho]; else if (rho >= 512) v = p.w_in[(size_t)k * ZC + rho - 96];
        return v * p.g_attn[k]; }, base, bid, nb, sm);
    const float qscale = 0.10206207261596575f * 1.4426950408889634f;
    base = tconv(p.WuqT, 768, 256, [&](int k, int rho) { int col;
        if (rho < 512) col = (rho >> 6) * 96 + (rho & 63); else { const int hh = (rho - 512) >> 5, w = (rho - 512) & 31; col = hh * 96 + 64 + (w >> 1) + 16 * (w & 1); }
        return p.w_uq[(size_t)k * 768 + col] * p.g_cq[k] * qscale; }, base, bid, nb, sm);
    base = tconv(p.WukT, 512, 128, [&](int k, int c) { return p.w_uk[(size_t)k * 512 + c] * p.g_ckv[k]; }, base, bid, nb, sm);
    base = tconv(p.WuvT, 512, 128, [&](int k, int c) { return p.w_uv[(size_t)k * 512 + c] * p.g_ckv[k]; }, base, bid, nb, sm);
    base = tconv(p.WoaT, 1024, 512, [&](int k, int n) { return p.w_o_attn[(size_t)k * 1024 + n]; }, base, bid, nb, sm);
    base = tconv(p.WosT, 1024, 512, [&](int k, int n) { return p.w_o_sgu[(size_t)k * 1024 + n]; }, base, bid, nb, sm);
    base = tconv(p.WoutT, 1024, 1024, [&](int k, int n) { return p.w_out[(size_t)k * 1024 + n]; }, base, bid, nb, sm);
    for (size_t i = gtid; i < (size_t)8 * 128 * 128; i += gsz) { const int j = (int)(i & 127), ii = (int)((i >> 7) & 127);
        p.Wsp[i] = ((j >> 6) <= (ii >> 6)) ? f2bf(p.w_sp[i]) : (bf16_t)0; }
}

template <class Epi>
__device__ void ngemm(const bf16_t* A, int lda, const bf16_t* Bt, int ldb, int M, int N, int K, Epi epi, int bid, int nb, float* sm) {
    float* As = sm; float* Bs = sm + 16 * 68;
    const int tid = opaque_tid(), ty = tid >> 4, tx = tid & 15; const int tn = N / 64, ntile = (M / 64) * tn;
    for (int tile = bid; tile < ntile; tile += nb) {
        const int row0 = (tile / tn) * 64, col0 = (tile % tn) * 64;
        float acc[4][4];
#pragma unroll
        for (int i = 0; i < 4; ++i)
#pragma unroll
            for (int j = 0; j < 4; ++j) acc[i][j] = 0.f;
        for (int k0 = 0; k0 < K; k0 += 16) {
#pragma unroll
            for (int i = 0; i < 4; ++i) { const int idx = tid + i * 256, r = idx >> 4, kk = idx & 15;
                As[kk * 68 + r] = bf2f(A[(size_t)(row0 + r) * lda + k0 + kk]);
                Bs[kk * 68 + r] = bf2f(Bt[(size_t)(col0 + r) * ldb + k0 + kk]); }
            __syncthreads();
#pragma unroll
            for (int kk = 0; kk < 16; ++kk) { float a[4], b[4];
#pragma unroll
                for (int i = 0; i < 4; ++i) { a[i] = As[kk * 68 + ty * 4 + i]; b[i] = Bs[kk * 68 + tx * 4 + i]; }
#pragma unroll
                for (int i = 0; i < 4; ++i)
#pragma unroll
                    for (int j = 0; j < 4; ++j) acc[i][j] += a[i] * b[j]; }
            __syncthreads();
        }
#pragma unroll
        for (int i = 0; i < 4; ++i) epi(row0 + ty * 4 + i, col0 + tx * 4, acc[i]);
    }
}


__device__ __forceinline__ bool tile_of(int it, int bid, int nb, int RT, int CT, int& rt, int& ct) {
    if ((RT & 31) == 0 && (nb & 7) == 0) {
        const int x = bid & 7, l = bid >> 3, nl = nb >> 3, rpx = RT >> 3; const int lt = l + it * nl; if (lt >= rpx * CT) return false;
        const int rg = lt / (4 * CT), w = lt % (4 * CT); rt = x * rpx + rg * 4 + (w & 3); ct = w >> 2; return true;
    }
    const int tile = bid + it * nb; if (tile >= RT * CT) return false; rt = tile / CT; ct = tile % CT; return true;
}
__device__ __forceinline__ void mg_kloop4(f32x4 (&acc)[4][4], const bf16_t* a0, const bf16_t* a1, const bf16_t* a2, const bf16_t* a3, const bf16_t* bp, size_t bstep, int nk, LAS unsigned char* lds) {
    const int tid = opaque_tid(), lane = tid & 63, wid = tid >> 6, wr = wid >> 1, wc = wid & 1, fr = lane & 15, fq = lane >> 4;
    const int widu = __builtin_amdgcn_readfirstlane(wid);
    auto stage = [&](int t) { LAS unsigned char* d = lds + (t & 1) * 32768 + widu * 1024; const int k0 = t * 64;
        __builtin_amdgcn_global_load_lds((const unsigned*)(a0 + k0), (LAS unsigned*)(d), 16, 0, 0);
        __builtin_amdgcn_global_load_lds((const unsigned*)(a1 + k0), (LAS unsigned*)(d + 4096), 16, 0, 0);
        __builtin_amdgcn_global_load_lds((const unsigned*)(a2 + k0), (LAS unsigned*)(d + 8192), 16, 0, 0);
        __builtin_amdgcn_global_load_lds((const unsigned*)(a3 + k0), (LAS unsigned*)(d + 12288), 16, 0, 0);
#pragma unroll
        for (int i = 0; i < 4; ++i) __builtin_amdgcn_global_load_lds((const unsigned*)(bp + i * bstep + k0), (LAS unsigned*)(d + 16384 + i * 4096), 16, 0, 0); };
    stage(0);
    const int pc0 = ((fq) ^ (fr & 7)) * 16, pc1 = ((4 + fq) ^ (fr & 7)) * 16;
    for (int t = 0; t < nk; ++t) {
        asm volatile("s_waitcnt vmcnt(0)" ::: "memory");
        __syncthreads();
        if (t + 1 < nk) stage(t + 1);
        const LAS unsigned char* ab = lds + (t & 1) * 32768 + (wr * 64 + fr) * 128; const LAS unsigned char* bb = lds + (t & 1) * 32768 + 16384 + (wc * 64 + fr) * 128;
        bf16x8 af[2][4], bfr[2][4];
#pragma unroll
        for (int m = 0; m < 4; ++m) { af[0][m] = *(const LAS bf16x8*)(ab + m * 2048 + pc0); bfr[0][m] = *(const LAS bf16x8*)(bb + m * 2048 + pc0); }
#pragma unroll
        for (int m = 0; m < 4; ++m) { af[1][m] = *(const LAS bf16x8*)(ab + m * 2048 + pc1); bfr[1][m] = *(const LAS bf16x8*)(bb + m * 2048 + pc1); }
        __builtin_amdgcn_sched_barrier(0);
#pragma unroll
        for (int ks = 0; ks < 2; ++ks)
#pragma unroll
            for (int m = 0; m < 4; ++m)
#pragma unroll
                for (int n = 0; n < 4; ++n) acc[m][n] = __builtin_amdgcn_mfma_f32_16x16x32_bf16(bfr[ks][n], af[ks][m], acc[m][n], 0, 0, 0);
    }
    __syncthreads();
}
__device__ __forceinline__ void mg_kloop(f32x4 (&acc)[4][4], const bf16_t* ap, size_t astep  , const bf16_t* bp, size_t bstep, int nk, LAS unsigned char* lds) {
    mg_kloop4(acc, ap, ap + astep, ap + 2 * astep, ap + 3 * astep, bp, bstep, nk, lds);
}
template <class Epi>
__device__ void mgemm(const bf16_t* A, int lda, const bf16_t* Bt, int ldb, int M, int N, int K, Epi epi, int bid, int nb, LAS unsigned char* lds) {
    const int tid = opaque_tid(), lane = tid & 63, wid = tid >> 6, wr = wid >> 1, wc = wid & 1, fr = lane & 15, fq = lane >> 4;
    const int RT = M / 128, CT = N / 128; const int c8 = ((tid & 7) ^ ((tid >> 3) & 7)) * 8;
    int rt, ct;
    for (int it = 0; tile_of(it, bid, nb, RT, CT, rt, ct); ++it) {
        const int row0 = rt * 128, col0 = ct * 128;
        f32x4 acc[4][4];
#pragma unroll
        for (int m = 0; m < 4; ++m)
#pragma unroll
            for (int n = 0; n < 4; ++n) acc[m][n] = (f32x4){0.f, 0.f, 0.f, 0.f};
        mg_kloop(acc, A + (size_t)(row0 + (tid >> 3)) * lda + c8, (size_t)32 * lda, Bt + (size_t)(col0 + (tid >> 3)) * ldb + c8, (size_t)32 * ldb, K / 64, lds);
#pragma unroll
        for (int m = 0; m < 4; ++m)
#pragma unroll
            for (int n = 0; n < 4; ++n) epi(row0 + wr * 64 + m * 16 + fr, col0 + wc * 64 + n * 16 + fq * 4, acc[m][n]);
    }
}

__device__ void phase1(const P& p, int bid, int nb, LAS unsigned char* sm) {
    float* zs = (float*)p.slotB; bf16_t* uvg = p.slotC; bf16_t* gates = p.slotD;
    mgemm(p.slotA, DM, p.WinT, DM, NT, ZP, DM, [=](int t, int c, const f32x4& v) {
        if (c < 512) *(f32x4*)(zs + (size_t)t * 512 + c) = v;
        else if (c < 1536) { uint2 o; o.x = pk2(fgelu(v[0]), fgelu(v[1])); o.y = pk2(fgelu(v[2]), fgelu(v[3])); *(uint2*)(uvg + (size_t)t * 1024 + c - 512) = o; }
        else { uint2 o; o.x = pk2(fsigmoid(v[0]), fsigmoid(v[1])); o.y = pk2(fsigmoid(v[2]), fsigmoid(v[3])); *(uint2*)(gates + (size_t)t * 2048 + c - 1536) = o; }
    }, bid, nb, sm);
}

__device__ void phase2a(const P& p, int bid, int nb, bool dry) {
    const int tid = opaque_tid(), lane = tid & 63, wid = tid >> 6;
    const float* zs = (const float*)p.slotB; bf16_t* K = p.slotE; bf16_t* uvg = p.slotC;
    const f32x4 gn0 = *(const f32x4*)(p.sgu_gain + lane * 8), gn1 = *(const f32x4*)(p.sgu_gain + lane * 8 + 4);
    const f32x4 bs0 = *(const f32x4*)(p.sgu_bias + lane * 8), bs1 = *(const f32x4*)(p.sgu_bias + lane * 8 + 4);
    for (int t = bid * 4 + wid; t < NT; t += nb * 4) {
        const float* z = zs + (size_t)t * 512;
        const f32x4 cq = *(const f32x4*)(z + lane * 4);
        const f32x4 ck = *(const f32x4*)(z + 256 + (lane & 31) * 4);
        bf16_t* vr = uvg + (size_t)t * 1024 + 512 + lane * 8;
        const uint4 vraw = *(const uint4*)vr;
        { const float ss = wsum(cq[0] * cq[0] + cq[1] * cq[1] + cq[2] * cq[2] + cq[3] * cq[3]); const float r = rsqrtf(ss * (1.f / 256.f) + EPS);
          uint2 o; o.x = pk2(cq[0] * r, cq[1] * r); o.y = pk2(cq[2] * r, cq[3] * r); *(uint2*)(p.cqn + (size_t)t * 256 + lane * 4) = o; }
        { const float ss = wsum(lane < 32 ? ck[0] * ck[0] + ck[1] * ck[1] + ck[2] * ck[2] + ck[3] * ck[3] : 0.f); const float r = rsqrtf(ss * (1.f / 128.f) + EPS);
          if (lane < 32) { uint2 o; o.x = pk2(ck[0] * r, ck[1] * r); o.y = pk2(ck[2] * r, ck[3] * r); *(uint2*)(p.ckvn + (size_t)t * 128 + lane * 4) = o; } }
        { const int b = t >> 13, sq = t & 8191, hd = lane >> 3, j = lane & 7; const float posf = (float)p.pos[t]; float val[4], tab[4];
#pragma unroll
          for (int q = 0; q < 4; ++q) { const int i = (4 * j + q) & 15;
              float f = (i & 3) == 0 ? 1.0f : (i & 3) == 1 ? 0.5623413251903491f : (i & 3) == 2 ? 0.31622776601683794f : 0.1778279410038923f;
              const int q4 = i >> 2; f *= (q4 == 0 ? 1.0f : q4 == 1 ? 0.1f : q4 == 2 ? 0.01f : 0.001f);
              const float ang = posf * f; const double rev = (double)ang * 0.15915494309189535; const float frc = (float)(rev - floor(rev));
              const float sn = __builtin_amdgcn_sinf(frc), cn = __builtin_amdgcn_cosf(frc);
              const float k1 = z[384 + i], k2 = z[400 + i];
              val[q] = (j < 4) ? (k1 * cn - k2 * sn) : (k1 * sn + k2 * cn); tab[q] = (j < 4) ? cn : sn; }
          uint2 o; o.x = pk2(val[0], val[1]); o.y = pk2(val[2], val[3]);
          *(uint2*)(K + ((size_t)(b * NH + hd) * SEQ + sq) * 96 + 64 + 4 * j) = o;
          if (hd == 0) *(f32x4*)(p.cs + (size_t)t * 32 + 4 * j) = (f32x4){tab[0], tab[1], tab[2], tab[3]}; }
        { float v[8]; const unsigned w[4] = {vraw.x, vraw.y, vraw.z, vraw.w};
#pragma unroll
          for (int i = 0; i < 4; ++i) { v[2 * i] = __uint_as_float(w[i] << 16); v[2 * i + 1] = __uint_as_float(w[i] & 0xffff0000u); }
          float sm_ = 0.f;
#pragma unroll
          for (int i = 0; i < 8; ++i) sm_ += v[i];
          sm_ = wsum(sm_); const float mu = sm_ * (1.f / 512.f); float q = 0.f;
#pragma unroll
          for (int i = 0; i < 8; ++i) { const float d = v[i] - mu; q += d * d; }
          q = wsum(q); const float r = rsqrtf(q * (1.f / 512.f) + EPS);
          uint4 o;
          o.x = pk2((v[0] - mu) * r * gn0[0] + bs0[0], (v[1] - mu) * r * gn0[1] + bs0[1]); o.y = pk2((v[2] - mu) * r * gn0[2] + bs0[2], (v[3] - mu) * r * gn0[3] + bs0[3]);
          o.z = pk2((v[4] - mu) * r * gn1[0] + bs1[0], (v[5] - mu) * r * gn1[1] + bs1[1]); o.w = pk2((v[6] - mu) * r * gn1[2] + bs1[2], (v[7] - mu) * r * gn1[3] + bs1[3]);
          *(uint4*)(dry ? p.slotG + (size_t)t * 512 + lane * 8 : vr) = o; }
    }
}

__device__ void phase2b(const P& p, int bid, int nb, LAS unsigned char* sm) {
    bf16_t* Q = p.slotA; bf16_t* K = p.slotE; bf16_t* VT = p.slotF; const float* cs = p.cs;
    mgemm(p.cqn, 256, p.WuqT, 256, NT, 768, 256, [=](int t, int c, const f32x4& v) {
        const int b = t >> 13, s = t & 8191;
        if (c < 512) { const int h = c >> 6, d = c & 63; uint2 o; o.x = pk2(v[0], v[1]); o.y = pk2(v[2], v[3]); *(uint2*)(Q + ((size_t)(b * NH + h) * SEQ + s) * 96 + d) = o; }
        else { const int h = (c - 512) >> 5, i0 = ((c - 512) & 31) >> 1; bf16_t* q = Q + ((size_t)(b * NH + h) * SEQ + s) * 96;
            const float2 cn = *(const float2*)(cs + (size_t)t * 32 + i0), sn = *(const float2*)(cs + (size_t)t * 32 + 16 + i0);
            *(unsigned*)(q + 64 + i0) = pk2(v[0] * cn.x - v[1] * sn.x, v[2] * cn.y - v[3] * sn.y);
            *(unsigned*)(q + 80 + i0) = pk2(v[0] * sn.x + v[1] * cn.x, v[2] * sn.y + v[3] * cn.y); }
    }, bid, nb, sm);
    mgemm(p.ckvn, 128, p.WukT, 128, NT, 512, 128, [=](int t, int c, const f32x4& v) {
        const int b = t >> 13, s = t & 8191, h = c >> 6, d = c & 63; uint2 o; o.x = pk2(v[0], v[1]); o.y = pk2(v[2], v[3]);
        *(uint2*)(K + ((size_t)(b * NH + h) * SEQ + s) * 96 + d) = o;
    }, bid, nb, sm);
    mgemm(p.WuvT, 128, p.ckvn, 128, 512, NT, 128, [=](int r, int t, const f32x4& v) {
        uint2 o; o.x = pk2(v[0], v[1]); o.y = pk2(v[2], v[3]); *(uint2*)(VT + (size_t)r * NT + t) = o;
    }, bid, nb, sm);
}

__device__ void phase2c(const P& p, int bid, int nb) {
    const bf16_t* uvg = p.slotC; bf16_t* su = p.slotG;
    for (size_t i = (size_t)bid * 256 + threadIdx.x; i < (size_t)NT * 512; i += (size_t)nb * 256) {
        const int t = (int)(i >> 9), c = (int)(i & 511), g = c >> 6, ii = t & 127, t0 = t - ii;
        const bf16_t* w = p.Wsp + ((size_t)g * 128 + ii) * 128; float s = 0.f;
        for (int j = 0; j < 128; ++j) s += bf2f(w[j]) * bf2f(uvg[(size_t)(t0 + j) * 1024 + 512 + c]);
        s += p.b_sp[g * 128 + ii];
        su[i] = f2bf(bf2f(uvg[(size_t)t * 1024 + c]) * s);
    }
}


__device__ void phase2c_m(const P& p, int bid, int nb, LAS unsigned char* lds) {
    const bf16_t* uvg = p.slotC; bf16_t* su = p.slotG;
    const int tid = opaque_tid(), lane = tid & 63, wid = tid >> 6, fr = lane & 15, fq = lane >> 4;
    const int c8 = ((tid & 7) ^ ((tid >> 3) & 7)) * 8;
    for (int u = bid; u < 1024; u += nb) {
        const int g = u & 7, t0 = (u >> 3) * 128;
        { const bf16_t* wp = p.Wsp + ((size_t)g * 128 + (tid >> 3)) * 128 + c8; LAS unsigned char* d = lds + tid * 16;
#pragma unroll
          for (int ks = 0; ks < 2; ++ks)
#pragma unroll
              for (int i = 0; i < 4; ++i) __builtin_amdgcn_global_load_lds((const unsigned*)(wp + (size_t)i * 32 * 128 + ks * 64), (LAS unsigned*)(d + ks * 16384 + i * 4096), 16, 0, 0); }
#pragma unroll
        for (int i = 0; i < 4; ++i) { const int q = tid + 256 * i, j = q >> 3, c0 = (q & 7) * 8;
            const uint4 v = *(const uint4*)(uvg + (size_t)(t0 + j) * 1024 + 512 + g * 64 + c0);
            const unsigned w[4] = {v.x, v.y, v.z, v.w};
            LAS unsigned char* bimg = lds + 32768 + (j >> 6) * 8192 + (j & 7) * 2; const int lc = (j & 63) >> 3;
#pragma unroll
            for (int e = 0; e < 8; ++e) { const int row = c0 + e; const bf16_t val = (bf16_t)((e & 1) ? (w[e >> 1] >> 16) : (w[e >> 1] & 0xffffu));
                *(LAS bf16_t*)(bimg + row * 128 + ((lc ^ (row & 7)) * 16)) = val; } }
        asm volatile("s_waitcnt vmcnt(0)" ::: "memory");
        __syncthreads();
        f32x4 acc[2][4];
#pragma unroll
        for (int m = 0; m < 2; ++m)
#pragma unroll
            for (int n = 0; n < 4; ++n) acc[m][n] = (f32x4){0.f, 0.f, 0.f, 0.f};
#pragma unroll
        for (int ks = 0; ks < 2; ++ks)
#pragma unroll
            for (int k2 = 0; k2 < 2; ++k2) { const int pc = ((k2 * 4 + fq) ^ (fr & 7)) * 16; bf16x8 af[2], bfr[4];
#pragma unroll
                for (int m = 0; m < 2; ++m) af[m] = *(const LAS bf16x8*)(lds + ks * 16384 + (wid * 32 + m * 16 + fr) * 128 + pc);
#pragma unroll
                for (int n = 0; n < 4; ++n) bfr[n] = *(const LAS bf16x8*)(lds + 32768 + ks * 8192 + (n * 16 + fr) * 128 + pc);
#pragma unroll
                for (int m = 0; m < 2; ++m)
#pragma unroll
                    for (int n = 0; n < 4; ++n) acc[m][n] = __builtin_amdgcn_mfma_f32_16x16x32_bf16(bfr[n], af[m], acc[m][n], 0, 0, 0); }
#pragma unroll
        for (int m = 0; m < 2; ++m) { const int i = wid * 32 + m * 16 + fr; const float bs = p.b_sp[g * 128 + i];
#pragma unroll
            for (int n = 0; n < 4; ++n) { const int c = g * 64 + n * 16 + fq * 4;
                const uint2 uu = *(const uint2*)(uvg + (size_t)(t0 + i) * 1024 + c);
                uint2 o; o.x = pk2(__uint_as_float(uu.x << 16) * (acc[m][n][0] + bs), __uint_as_float(uu.x & 0xffff0000u) * (acc[m][n][1] + bs));
                o.y = pk2(__uint_as_float(uu.y << 16) * (acc[m][n][2] + bs), __uint_as_float(uu.y & 0xffff0000u) * (acc[m][n][3] + bs));
                *(uint2*)(su + (size_t)(t0 + i) * 512 + c) = o; } }
        __syncthreads();
    }
}

__device__ void phase3(const P& p, int bid, int nb, float* sm) {
    float* sc = sm; float* qs = sm + 8192; float* red = qs + 96;
    const bf16_t* Q = p.slotA; const bf16_t* K = p.slotE; const bf16_t* VT = p.slotF; bf16_t* O = (bf16_t*)p.slotB;
    const int tid = opaque_tid();
    for (int row = bid; row < NBATCH * NH * SEQ; row += nb) {
        const int q = row % SEQ, bh = row / SEQ, nk = ((q >> 6) + 1) * 64;
        if (tid < 12) ((uint4*)qs)[tid] = ((const uint4*)(Q + ((size_t)bh * SEQ + q) * 96))[tid];
        __syncthreads();
        float mx = -1e30f;
        for (int k = tid; k < nk; k += 256) { const uint4* kp = (const uint4*)(K + ((size_t)bh * SEQ + k) * 96); float s = 0.f;
#pragma unroll
            for (int d = 0; d < 12; ++d) s += dot8(((const uint4*)qs)[d], kp[d]);
            sc[k] = s; mx = fmaxf(mx, s); }
        mx = wmax(mx); if ((tid & 63) == 0) red[tid >> 6] = mx; __syncthreads();
        mx = fmaxf(fmaxf(red[0], red[1]), fmaxf(red[2], red[3])); __syncthreads();
        float sum = 0.f;
        for (int k = tid; k < nk; k += 256) { const float e = exp2f(sc[k] - mx); sc[k] = e; sum += e; }
        sum = wsum(sum); if ((tid & 63) == 0) red[tid >> 6] = sum; __syncthreads();
        sum = (red[0] + red[1]) + (red[2] + red[3]);
        const int dv = tid >> 2, part = tid & 3, h = bh & 7, b = bh >> 3;
        const bf16_t* vp = VT + (size_t)(h * 64 + dv) * NT + (size_t)b * SEQ; float o = 0.f;
        for (int k = part; k < nk; k += 4) o += sc[k] * bf2f(vp[k]);
        o += __shfl_xor(o, 1); o += __shfl_xor(o, 2);
        if (part == 0) O[(size_t)(b * SEQ + q) * 512 + h * 64 + dv] = f2bf(o / sum);
        __syncthreads();
    }
}


constexpr int ATT_BUF = 20480;
template <int VAR>
__device__ void phase3m(const P& p, int bid, int nb, LAS unsigned char* lds) {
    const bf16_t* Q = p.slotA; const bf16_t* K = p.slotE; const bf16_t* VT = p.slotF; bf16_t* O = (VAR == 0) ? (bf16_t*)p.slotB : p.slotC;
    const int tid = opaque_tid(), lane = tid & 63, wid = tid >> 6, l31 = lane & 31, hh = lane >> 5;
    int koff[3]; size_t voff[2];
#pragma unroll
    for (int i = 0; i < 3; ++i) { const int s = tid + 256 * i, r = s / 12, pc = s % 12, c = (pc + 12 - ((r >> 2) & 3)) % 12; koff[i] = r * 96 + c * 8; }
#pragma unroll
    for (int i = 0; i < 2; ++i) { const int s = tid + 256 * i, dv = s >> 3, pc = s & 7, cl = pc ^ ((dv >> 1) & 7); voff[i] = (size_t)dv * NT + cl * 8; }
    int kro[6];
#pragma unroll
    for (int ks = 0; ks < 6; ++ks) { const int v = 2 * ks + hh + ((lane >> 2) & 3); kro[ks] = (v >= 12 ? v - 12 : v) * 16; }
    const int krow = l31 * 192, vsw = (lane >> 1) & 7, vrow = l31 * 128 + 8 * hh;
    for (int iu = 0;; ++iu) {
        const int r = iu * nb + ((iu & 1) ? nb - 1 - bid : bid); if (r >= 1024) break;
        const int qb = 63 - (r >> 4), bh = r & 15, b = bh >> 3, h = bh & 7;
        const int q0 = qb * 128 + wid * 32, ntw = (q0 >> 6) + 1, nt = 2 * qb + 2;
        const bf16_t* Kb = K + (size_t)bh * SEQ * 96; const bf16_t* Vb = VT + (size_t)(h * 64) * NT + (size_t)b * SEQ;
        bf16x8 qf[6]; { const bf16_t* qp = Q + ((size_t)bh * SEQ + q0 + l31) * 96 + hh * 8;
#pragma unroll
            for (int ks = 0; ks < 6; ++ks) qf[ks] = *(const bf16x8*)(qp + ks * 16); }
        f32x16 o0, o1;
#pragma unroll
        for (int e = 0; e < 16; ++e) { o0[e] = 0.f; o1[e] = 0.f; }
        float mrun = -1e30f, lsum = 0.f;
        auto stage = [&](int j) { LAS unsigned char* d = lds + (j & 1) * ATT_BUF + tid * 16; const bf16_t* kt = Kb + (size_t)j * 64 * 96; const bf16_t* vt = Vb + j * 64;
#pragma unroll
            for (int i = 0; i < 3; ++i) __builtin_amdgcn_global_load_lds((const unsigned*)(kt + koff[i]), (LAS unsigned*)(d + i * 4096), 16, 0, 0);
#pragma unroll
            for (int i = 0; i < 2; ++i) __builtin_amdgcn_global_load_lds((const unsigned*)(vt + voff[i]), (LAS unsigned*)(d + 12288 + i * 4096), 16, 0, 0); };
        if (VAR != 3) stage(0);
        for (int j = 0; j < nt; ++j) {
            asm volatile("s_waitcnt vmcnt(0)" ::: "memory");
            __syncthreads();
            if (VAR != 3 && j + 1 < nt) stage(j + 1);
            if (j < ntw) {
                const LAS unsigned char* kb_ = lds + (j & 1) * ATT_BUF + krow; const LAS unsigned char* vb_ = lds + (j & 1) * ATT_BUF + 12288 + vrow;
                f32x16 s0, s1;
#pragma unroll
                for (int e = 0; e < 16; ++e) { s0[e] = 0.f; s1[e] = 0.f; }
#pragma unroll
                for (int ks = 0; ks < 6; ++ks) { const bf16x8 k0 = *(const LAS bf16x8*)(kb_ + kro[ks]); const bf16x8 k1 = *(const LAS bf16x8*)(kb_ + 32 * 192 + kro[ks]);
                    if (VAR != 2) { s0 = __builtin_amdgcn_mfma_f32_32x32x16_bf16(k0, qf[ks], s0, 0, 0, 0); s1 = __builtin_amdgcn_mfma_f32_32x32x16_bf16(k1, qf[ks], s1, 0, 0, 0); }
                    else { s0[ks] += __builtin_bit_cast(float, (int)k0[0]) + __builtin_bit_cast(float, (int)qf[ks][1]); s1[ks] += __builtin_bit_cast(float, (int)k1[0]); } }
                if (VAR != 1) {
                float mx = fmaxf(s0[0], s1[0]);
#pragma unroll
                for (int e = 1; e < 16; ++e) mx = fmaxf(mx, fmaxf(s0[e], s1[e]));
                mx = fmaxf(mx, __shfl_xor(mx, 32));
                const float mn = fmaxf(mrun, mx), alpha = __builtin_amdgcn_exp2f(mrun - mn); mrun = mn;
                float ps = 0.f;
#pragma unroll
                for (int e = 0; e < 16; ++e) { s0[e] = __builtin_amdgcn_exp2f(s0[e] - mn); s1[e] = __builtin_amdgcn_exp2f(s1[e] - mn); ps += s0[e] + s1[e]; }
                lsum = lsum * alpha + ps;
#pragma unroll
                for (int e = 0; e < 16; ++e) { o0[e] *= alpha; o1[e] *= alpha; }
                }
                unsigned pw[16];
#pragma unroll
                for (int e = 0; e < 8; ++e) { pw[e] = pk2(s0[2 * e], s0[2 * e + 1]); pw[8 + e] = pk2(s1[2 * e], s1[2 * e + 1]); }
#pragma unroll
                for (int s = 0; s < 4; ++s) {
                    const u32x4 pbu = {pw[4 * s], pw[4 * s + 1], pw[4 * s + 2], pw[4 * s + 3]}; const bf16x8 pb = __builtin_bit_cast(bf16x8, pbu);
                    const int c0 = ((2 * s) ^ vsw) * 16, c1 = ((2 * s + 1) ^ vsw) * 16;
                    const u32x2 a0 = *(const LAS u32x2*)(vb_ + c0), a1 = *(const LAS u32x2*)(vb_ + c1);
                    const u32x2 b0 = *(const LAS u32x2*)(vb_ + 32 * 128 + c0), b1 = *(const LAS u32x2*)(vb_ + 32 * 128 + c1);
                    const u32x4 va = {a0.x, a0.y, a1.x, a1.y}, vb = {b0.x, b0.y, b1.x, b1.y};
                    if (VAR != 2) { o0 = __builtin_amdgcn_mfma_f32_32x32x16_bf16(__builtin_bit_cast(bf16x8, va), pb, o0, 0, 0, 0);
                    o1 = __builtin_amdgcn_mfma_f32_32x32x16_bf16(__builtin_bit_cast(bf16x8, vb), pb, o1, 0, 0, 0); }
                    else { o0[s] += __builtin_bit_cast(float, va[0] ^ pbu[0]); o1[s] += __builtin_bit_cast(float, vb[1] ^ pbu[1]); }
                }
            }
        }
        const float inv = 1.f / (lsum + __shfl_xor(lsum, 32));
        bf16_t* op = O + (size_t)(b * SEQ + q0 + l31) * 512 + h * 64 + 4 * hh;
#pragma unroll
        for (int g = 0; g < 4; ++g) { uint2 w0, w1;
            w0.x = pk2(o0[4 * g] * inv, o0[4 * g + 1] * inv); w0.y = pk2(o0[4 * g + 2] * inv, o0[4 * g + 3] * inv);
            w1.x = pk2(o1[4 * g] * inv, o1[4 * g + 1] * inv); w1.y = pk2(o1[4 * g + 2] * inv, o1[4 * g + 3] * inv);
            *(uint2*)(op + 8 * g) = w0; *(uint2*)(op + 32 + 8 * g) = w1; }
        __syncthreads();
    }
}


template <int DUMMY>
__device__ void phase3p(const P& p, int bid, int nb, LAS unsigned char* lds) {
    const bf16_t* Q = p.slotA; const bf16_t* K = p.slotE; const bf16_t* VT = p.slotF; bf16_t* O = (DUMMY == 0) ? (bf16_t*)p.slotB : p.slotC;
    const int tid = opaque_tid(), lane = tid & 63, wid = tid >> 6, l31 = lane & 31, hh = lane >> 5;
    constexpr float THR = 8.f;
    int koff[3]; size_t voff[2];
#pragma unroll
    for (int i = 0; i < 3; ++i) { const int s = tid + 256 * i, r = s / 12, pc = s % 12, c = (pc + 12 - ((r >> 2) & 3)) % 12; koff[i] = r * 96 + c * 8; }
#pragma unroll
    for (int i = 0; i < 2; ++i) { const int s = tid + 256 * i, dv = s >> 3, pc = s & 7, cl = pc ^ ((dv >> 1) & 7); voff[i] = (size_t)dv * NT + cl * 8; }
    int kro[6];
#pragma unroll
    for (int ks = 0; ks < 6; ++ks) { const int v = 2 * ks + hh + ((lane >> 2) & 3); kro[ks] = (v >= 12 ? v - 12 : v) * 16; }
    const int krow = l31 * 192, vsw = (lane >> 1) & 7, vrow = l31 * 128 + 8 * hh;
    for (int iu = 0;; ++iu) {
        const int r = iu * nb + ((iu & 1) ? nb - 1 - bid : bid); if (r >= 1024) break;
        const int qb = 63 - (r >> 4), bh = r & 15, b = bh >> 3, h = bh & 7;
        const int q0 = qb * 128 + wid * 32, ntw = (q0 >> 6) + 1, nt = 2 * qb + 2;
        const bf16_t* Kb = K + (size_t)bh * SEQ * 96; const bf16_t* Vb = VT + (size_t)(h * 64) * NT + (size_t)b * SEQ;
        bf16x8 qf[6]; { const bf16_t* qp = Q + ((size_t)bh * SEQ + q0 + l31) * 96 + hh * 8;
#pragma unroll
            for (int ks = 0; ks < 6; ++ks) qf[ks] = *(const bf16x8*)(qp + ks * 16); }
        f32x16 o0, o1;
#pragma unroll
        for (int e = 0; e < 16; ++e) { o0[e] = 0.f; o1[e] = 0.f; }
        float mrun = -1e30f, lsum = 0.f;
        auto stageK = [&](int j) { LAS unsigned char* d = lds + (j & 1) * 12288 + tid * 16; const bf16_t* kt = Kb + (size_t)j * 64 * 96;
#pragma unroll
            for (int i = 0; i < 3; ++i) __builtin_amdgcn_global_load_lds((const unsigned*)(kt + koff[i]), (LAS unsigned*)(d + i * 4096), 16, 0, 0); };
        auto stageV = [&](int j) { LAS unsigned char* d = lds + 24576 + (j & 1) * 8192 + tid * 16; const bf16_t* vt = Vb + j * 64;
#pragma unroll
            for (int i = 0; i < 2; ++i) __builtin_amdgcn_global_load_lds((const unsigned*)(vt + voff[i]), (LAS unsigned*)(d + i * 4096), 16, 0, 0); };
        auto qk = [&](f32x16& a, f32x16& bq, int buf) { const LAS unsigned char* kb_ = lds + buf * 12288 + krow;
#pragma unroll
            for (int e = 0; e < 16; ++e) { a[e] = 0.f; bq[e] = 0.f; }
#pragma unroll
            for (int ks = 0; ks < 6; ++ks) { const bf16x8 k0 = *(const LAS bf16x8*)(kb_ + kro[ks]); const bf16x8 k1 = *(const LAS bf16x8*)(kb_ + 32 * 192 + kro[ks]);
                a = __builtin_amdgcn_mfma_f32_32x32x16_bf16(k0, qf[ks], a, 0, 0, 0); bq = __builtin_amdgcn_mfma_f32_32x32x16_bf16(k1, qf[ks], bq, 0, 0, 0); } };
        auto rowmax = [&](const f32x16& a, const f32x16& bq) { float m = fmaxf(a[0], bq[0]);
#pragma unroll
            for (int e = 1; e < 16; ++e) m = fmaxf(fmaxf(m, a[e]), bq[e]);
            return fmaxf(m, __shfl_xor(m, 32)); };
        f32x16 sA0, sA1, sB0, sB1; float mxA, mxB = 0.f;
        stageK(0); stageK(1); stageV(0);
        asm volatile("s_waitcnt vmcnt(0)" ::: "memory");
        __syncthreads();
        qk(sA0, sA1, 0); mxA = rowmax(sA0, sA1);
        auto step = [&](f32x16& c0, f32x16& c1, float& mxc, f32x16& n0, f32x16& n1, float& mxn, int j) {
            asm volatile("s_waitcnt vmcnt(0)" ::: "memory");
            __syncthreads();
            if (j + 2 < nt) stageK(j + 2);
            if (j + 1 < nt) stageV(j + 1);
            if (j < ntw) {
                if (!__all(mxc <= mrun + THR)) { const float mn = fmaxf(mrun, mxc), alpha = __builtin_amdgcn_exp2f(mrun - mn); mrun = mn; lsum *= alpha;
#pragma unroll
                    for (int e = 0; e < 16; ++e) { o0[e] *= alpha; o1[e] *= alpha; } }
                qk(n0, n1, (j + 1) & 1);
                float ps = 0.f;
#pragma unroll
                for (int e = 0; e < 16; ++e) { c0[e] = __builtin_amdgcn_exp2f(c0[e] - mrun); c1[e] = __builtin_amdgcn_exp2f(c1[e] - mrun); ps += c0[e] + c1[e]; }
                lsum += ps;
                unsigned pw[16];
#pragma unroll
                for (int e = 0; e < 8; ++e) { pw[e] = pk2(c0[2 * e], c0[2 * e + 1]); pw[8 + e] = pk2(c1[2 * e], c1[2 * e + 1]); }
                const LAS unsigned char* vb_ = lds + 24576 + (j & 1) * 8192 + vrow;
#pragma unroll
                for (int s = 0; s < 4; ++s) {
                    const u32x4 pbu = {pw[4 * s], pw[4 * s + 1], pw[4 * s + 2], pw[4 * s + 3]}; const bf16x8 pb = __builtin_bit_cast(bf16x8, pbu);
                    const int c0_ = ((2 * s) ^ vsw) * 16, c1_ = ((2 * s + 1) ^ vsw) * 16;
                    const u32x2 a0 = *(const LAS u32x2*)(vb_ + c0_), a1 = *(const LAS u32x2*)(vb_ + c1_);
                    const u32x2 b0 = *(const LAS u32x2*)(vb_ + 32 * 128 + c0_), b1 = *(const LAS u32x2*)(vb_ + 32 * 128 + c1_);
                    const u32x4 va = {a0.x, a0.y, a1.x, a1.y}, vb = {b0.x, b0.y, b1.x, b1.y};
                    o0 = __builtin_amdgcn_mfma_f32_32x32x16_bf16(__builtin_bit_cast(bf16x8, va), pb, o0, 0, 0, 0);
                    o1 = __builtin_amdgcn_mfma_f32_32x32x16_bf16(__builtin_bit_cast(bf16x8, vb), pb, o1, 0, 0, 0);
                }
                mxn = rowmax(n0, n1);
#if ATT_SGB
#pragma unroll
                for (int g_ = 0; g_ < 20; ++g_) { __builtin_amdgcn_sched_group_barrier(0x008, 1, 0); __builtin_amdgcn_sched_group_barrier(0x100, 2, 0); __builtin_amdgcn_sched_group_barrier(0x002, 7, 0); }
#endif
            }
        };
        for (int j = 0; j < nt; j += 2) { step(sA0, sA1, mxA, sB0, sB1, mxB, j); step(sB0, sB1, mxB, sA0, sA1, mxA, j + 1); }
        const float inv = 1.f / (lsum + __shfl_xor(lsum, 32));
        bf16_t* op = O + (size_t)(b * SEQ + q0 + l31) * 512 + h * 64 + 4 * hh;
#pragma unroll
        for (int g = 0; g < 4; ++g) { uint2 w0, w1;
            w0.x = pk2(o0[4 * g] * inv, o0[4 * g + 1] * inv); w0.y = pk2(o0[4 * g + 2] * inv, o0[4 * g + 3] * inv);
            w1.x = pk2(o1[4 * g] * inv, o1[4 * g + 1] * inv); w1.y = pk2(o1[4 * g + 2] * inv, o1[4 * g + 3] * inv);
            *(uint2*)(op + 8 * g) = w0; *(uint2*)(op + 32 + 8 * g) = w1; }
        __syncthreads();
    }
}

__device__ __forceinline__ float xmax32(float x) { const unsigned u = __float_as_uint(x);
    const auto r = __builtin_amdgcn_permlane32_swap(u, u, false, false); return fmaxf(__uint_as_float(r[0]), __uint_as_float(r[1])); }
template <int VAR>
__device__ __forceinline__ void att_step(const LAS unsigned char* kb_, const LAS unsigned char* vb_, const int kt16, const int k4o, const int k5o, const int vsw, const bf16x8 (&qf)[6],
                                         f32x16& c0, f32x16& c1, f32x16& n0, f32x16& n1, unsigned (&pw)[16], f32x16& o0, f32x16& o1,
                                         float& mrun, float& ps, float& alpha, bool& resc) {
    constexpr float THR_ = 8.f;
    f32x16 zero16;
#pragma unroll
    for (int e = 0; e < 16; ++e) zero16[e] = 0.f;
    if constexpr (VAR == 0) {
        bf16x8 kf0, kf1, kf2;
        float mxl;
        mxl = fmaxf(c0[0], c1[0]); mxl = fmaxf(fmaxf(mxl, c0[1]), c1[1]); mxl = fmaxf(fmaxf(mxl, c0[2]), c1[2]); mxl = fmaxf(fmaxf(mxl, c0[3]), c1[3]); mxl = fmaxf(fmaxf(mxl, c0[4]), c1[4]); mxl = fmaxf(fmaxf(mxl, c0[5]), c1[5]); mxl = fmaxf(fmaxf(mxl, c0[6]), c1[6]); mxl = fmaxf(fmaxf(mxl, c0[7]), c1[7]); asm volatile("" :: "v"(mxl));
        __builtin_amdgcn_sched_barrier(0);
        mxl = fmaxf(fmaxf(mxl, c0[8]), c1[8]); mxl = fmaxf(fmaxf(mxl, c0[9]), c1[9]); mxl = fmaxf(fmaxf(mxl, c0[10]), c1[10]); mxl = fmaxf(fmaxf(mxl, c0[11]), c1[11]); mxl = fmaxf(fmaxf(mxl, c0[12]), c1[12]); mxl = fmaxf(fmaxf(mxl, c0[13]), c1[13]); mxl = fmaxf(fmaxf(mxl, c0[14]), c1[14]); mxl = fmaxf(fmaxf(mxl, c0[15]), c1[15]); asm volatile("" :: "v"(mxl));
        { const float mx = xmax32(mxl); resc = false; alpha = 1.f; mrun = mx; }
        __builtin_amdgcn_sched_barrier(0);
        c0[0] = __builtin_amdgcn_exp2f(c0[0] - mrun); ps += c0[0]; c0[1] = __builtin_amdgcn_exp2f(c0[1] - mrun); ps += c0[1]; pw[0] = pk2(c0[0], c0[1]); asm volatile("" :: "v"(pw[0]), "v"(ps));
        __builtin_amdgcn_sched_barrier(0);
        c0[2] = __builtin_amdgcn_exp2f(c0[2] - mrun); ps += c0[2]; c0[3] = __builtin_amdgcn_exp2f(c0[3] - mrun); ps += c0[3]; pw[1] = pk2(c0[2], c0[3]); asm volatile("" :: "v"(pw[1]), "v"(ps));
        __builtin_amdgcn_sched_barrier(0);
        c0[4] = __builtin_amdgcn_exp2f(c0[4] - mrun); ps += c0[4]; c0[5] = __builtin_amdgcn_exp2f(c0[5] - mrun); ps += c0[5]; pw[2] = pk2(c0[4], c0[5]); asm volatile("" :: "v"(pw[2]), "v"(ps));
        __builtin_amdgcn_sched_barrier(0);
        c0[6] = __builtin_amdgcn_exp2f(c0[6] - mrun); ps += c0[6]; c0[7] = __builtin_amdgcn_exp2f(c0[7] - mrun); ps += c0[7]; pw[3] = pk2(c0[6], c0[7]); asm volatile("" :: "v"(pw[3]), "v"(ps));
        __builtin_amdgcn_sched_barrier(0);
        kf0 = *(const LAS bf16x8*)(kb_ + 0*32*192 + kt16 + 0);
        c0[8] = __builtin_amdgcn_exp2f(c0[8] - mrun); ps += c0[8]; c0[9] = __builtin_amdgcn_exp2f(c0[9] - mrun); ps += c0[9]; pw[4] = pk2(c0[8], c0[9]); asm volatile("" :: "v"(pw[4]), "v"(ps));
        __builtin_amdgcn_sched_barrier(0);
        kf1 = *(const LAS bf16x8*)(kb_ + 0*32*192 + kt16 + 32);
        c0[10] = __builtin_amdgcn_exp2f(c0[10] - mrun); ps += c0[10]; c0[11] = __builtin_amdgcn_exp2f(c0[11] - mrun); ps += c0[11]; pw[5] = pk2(c0[10], c0[11]); asm volatile("" :: "v"(pw[5]), "v"(ps));
        __builtin_amdgcn_sched_barrier(0);
        kf2 = *(const LAS bf16x8*)(kb_ + 0*32*192 + kt16 + 64);
        n0 = __builtin_amdgcn_mfma_f32_32x32x16_bf16(kf0, qf[0], zero16, 0, 0, 0);
        c0[12] = __builtin_amdgcn_exp2f(c0[12] - mrun); ps += c0[12]; c0[13] = __builtin_amdgcn_exp2f(c0[13] - mrun); ps += c0[13]; pw[6] = pk2(c0[12], c0[13]); asm volatile("" :: "v"(pw[6]), "v"(ps));
        __builtin_amdgcn_sched_barrier(0);
        kf0 = *(const LAS bf16x8*)(kb_ + 0*32*192 + kt16 + 96);
        n0 = __builtin_amdgcn_mfma_f32_32x32x16_bf16(kf1, qf[1], n0, 0, 0, 0);
        c0[14] = __builtin_amdgcn_exp2f(c0[14] - mrun); ps += c0[14]; c0[15] = __builtin_amdgcn_exp2f(c0[15] - mrun); ps += c0[15]; pw[7] = pk2(c0[14], c0[15]); asm volatile("" :: "v"(pw[7]), "v"(ps));
        __builtin_amdgcn_sched_barrier(0);
        kf1 = *(const LAS bf16x8*)(kb_ + 0*32*192 + k4o);
        n0 = __builtin_amdgcn_mfma_f32_32x32x16_bf16(kf2, qf[2], n0, 0, 0, 0);
        c1[0] = __builtin_amdgcn_exp2f(c1[0] - mrun); ps += c1[0]; c1[1] = __builtin_amdgcn_exp2f(c1[1] - mrun); ps += c1[1]; pw[8] = pk2(c1[0], c1[1]); asm volatile("" :: "v"(pw[8]), "v"(ps));
        __builtin_amdgcn_sched_barrier(0);
        kf2 = *(const LAS bf16x8*)(kb_ + 0*32*192 + k5o);
        n0 = __builtin_amdgcn_mfma_f32_32x32x16_bf16(kf0, qf[3], n0, 0, 0, 0);
        c1[2] = __builtin_amdgcn_exp2f(c1[2] - mrun); ps += c1[2]; c1[3] = __builtin_amdgcn_exp2f(c1[3] - mrun); ps += c1[3]; pw[9] = pk2(c1[2], c1[3]); asm volatile("" :: "v"(pw[9]), "v"(ps));
        __builtin_amdgcn_sched_barrier(0);
        kf0 = *(const LAS bf16x8*)(kb_ + 1*32*192 + kt16 + 0);
        n0 = __builtin_amdgcn_mfma_f32_32x32x16_bf16(kf1, qf[4], n0, 0, 0, 0);
        c1[4] = __builtin_amdgcn_exp2f(c1[4] - mrun); ps += c1[4]; c1[5] = __builtin_amdgcn_exp2f(c1[5] - mrun); ps += c1[5]; pw[10] = pk2(c1[4], c1[5]); asm volatile("" :: "v"(pw[10]), "v"(ps));
        __builtin_amdgcn_sched_barrier(0);
        kf1 = *(const LAS bf16x8*)(kb_ + 1*32*192 + kt16 + 32);
        n0 = __builtin_amdgcn_mfma_f32_32x32x16_bf16(kf2, qf[5], n0, 0, 0, 0);
        c1[6] = __builtin_amdgcn_exp2f(c1[6] - mrun); ps += c1[6]; c1[7] = __builtin_amdgcn_exp2f(c1[7] - mrun); ps += c1[7]; pw[11] = pk2(c1[6], c1[7]); asm volatile("" :: "v"(pw[11]), "v"(ps));
        __builtin_amdgcn_sched_barrier(0);
        kf2 = *(const LAS bf16x8*)(kb_ + 1*32*192 + kt16 + 64);
        n1 = __builtin_amdgcn_mfma_f32_32x32x16_bf16(kf0, qf[0], zero16, 0, 0, 0);
        c1[8] = __builtin_amdgcn_exp2f(c1[8] - mrun); ps += c1[8]; c1[9] = __builtin_amdgcn_exp2f(c1[9] - mrun); ps += c1[9]; pw[12] = pk2(c1[8], c1[9]); asm volatile("" :: "v"(pw[12]), "v"(ps));
        __builtin_amdgcn_sched_barrier(0);
        kf0 = *(const LAS bf16x8*)(kb_ + 1*32*192 + kt16 + 96);
        n1 = __builtin_amdgcn_mfma_f32_32x32x16_bf16(kf1, qf[1], n1, 0, 0, 0);
        c1[10] = __builtin_amdgcn_exp2f(c1[10] - mrun); ps += c1[10]; c1[11] = __builtin_amdgcn_exp2f(c1[11] - mrun); ps += c1[11]; pw[13] = pk2(c1[10], c1[11]); asm volatile("" :: "v"(pw[13]), "v"(ps));
        __builtin_amdgcn_sched_barrier(0);
        kf1 = *(const LAS bf16x8*)(kb_ + 1*32*192 + k4o);
        n1 = __builtin_amdgcn_mfma_f32_32x32x16_bf16(kf2, qf[2], n1, 0, 0, 0);
        c1[12] = __builtin_amdgcn_exp2f(c1[12] - mrun); ps += c1[12]; c1[13] = __builtin_amdgcn_exp2f(c1[13] - mrun); ps += c1[13]; pw[14] = pk2(c1[12], c1[13]); asm volatile("" :: "v"(pw[14]), "v"(ps));
        __builtin_amdgcn_sched_barrier(0);
        kf2 = *(const LAS bf16x8*)(kb_ + 1*32*192 + k5o);
        n1 = __builtin_amdgcn_mfma_f32_32x32x16_bf16(kf0, qf[3], n1, 0, 0, 0);
        c1[14] = __builtin_amdgcn_exp2f(c1[14] - mrun); ps += c1[14]; c1[15] = __builtin_amdgcn_exp2f(c1[15] - mrun); ps += c1[15]; pw[15] = pk2(c1[14], c1[15]); asm volatile("" :: "v"(pw[15]), "v"(ps));
        __builtin_amdgcn_sched_barrier(0);
        n1 = __builtin_amdgcn_mfma_f32_32x32x16_bf16(kf1, qf[4], n1, 0, 0, 0);
        __builtin_amdgcn_sched_barrier(0);
        n1 = __builtin_amdgcn_mfma_f32_32x32x16_bf16(kf2, qf[5], n1, 0, 0, 0);
        __builtin_amdgcn_sched_barrier(0);
    } else if constexpr (VAR == 1) {
        bf16x8 kf0, kf1, kf2;
        u32x2 vf0a, vf0b, vf1a, vf1b, vf2a, vf2b;
        vf0a = *(const LAS u32x2*)(vb_ + ((0) ^ vsw) * 16); vf0b = *(const LAS u32x2*)(vb_ + ((1) ^ vsw) * 16);
        vf1a = *(const LAS u32x2*)(vb_ + 32 * 128 + ((0) ^ vsw) * 16); vf1b = *(const LAS u32x2*)(vb_ + 32 * 128 + ((1) ^ vsw) * 16);
        float mxl;
        vf2a = *(const LAS u32x2*)(vb_ + ((2) ^ vsw) * 16); vf2b = *(const LAS u32x2*)(vb_ + ((3) ^ vsw) * 16);
        { const u32x4 pbu = {pw[0], pw[1], pw[2], pw[3]}; const u32x4 vv = {vf0a.x, vf0a.y, vf0b.x, vf0b.y};
          o0 = __builtin_amdgcn_mfma_f32_32x32x16_bf16(__builtin_bit_cast(bf16x8, vv), __builtin_bit_cast(bf16x8, pbu), o0, 0, 0, 0); }
        mxl = fmaxf(c0[0], c1[0]); mxl = fmaxf(fmaxf(mxl, c0[1]), c1[1]); mxl = fmaxf(fmaxf(mxl, c0[2]), c1[2]); mxl = fmaxf(fmaxf(mxl, c0[3]), c1[3]); mxl = fmaxf(fmaxf(mxl, c0[4]), c1[4]); mxl = fmaxf(fmaxf(mxl, c0[5]), c1[5]); mxl = fmaxf(fmaxf(mxl, c0[6]), c1[6]); mxl = fmaxf(fmaxf(mxl, c0[7]), c1[7]); asm volatile("" :: "v"(mxl));
        __builtin_amdgcn_sched_barrier(0);
        vf0a = *(const LAS u32x2*)(vb_ + 32 * 128 + ((2) ^ vsw) * 16); vf0b = *(const LAS u32x2*)(vb_ + 32 * 128 + ((3) ^ vsw) * 16);
        { const u32x4 pbu = {pw[0], pw[1], pw[2], pw[3]}; const u32x4 vv = {vf1a.x, vf1a.y, vf1b.x, vf1b.y};
          o1 = __builtin_amdgcn_mfma_f32_32x32x16_bf16(__builtin_bit_cast(bf16x8, vv), __builtin_bit_cast(bf16x8, pbu), o1, 0, 0, 0); }
        mxl = fmaxf(fmaxf(mxl, c0[8]), c1[8]); mxl = fmaxf(fmaxf(mxl, c0[9]), c1[9]); mxl = fmaxf(fmaxf(mxl, c0[10]), c1[10]); mxl = fmaxf(fmaxf(mxl, c0[11]), c1[11]); mxl = fmaxf(fmaxf(mxl, c0[12]), c1[12]); mxl = fmaxf(fmaxf(mxl, c0[13]), c1[13]); mxl = fmaxf(fmaxf(mxl, c0[14]), c1[14]); mxl = fmaxf(fmaxf(mxl, c0[15]), c1[15]); asm volatile("" :: "v"(mxl));
        { const float mx = xmax32(mxl); resc = !__all(mx <= mrun + THR_); const float mn = resc ? fmaxf(mrun, mx) : mrun; alpha = __builtin_amdgcn_exp2f(mrun - mn); mrun = mn; }
        __builtin_amdgcn_sched_barrier(0);
        vf1a = *(const LAS u32x2*)(vb_ + ((4) ^ vsw) * 16); vf1b = *(const LAS u32x2*)(vb_ + ((5) ^ vsw) * 16);
        { const u32x4 pbu = {pw[4], pw[5], pw[6], pw[7]}; const u32x4 vv = {vf2a.x, vf2a.y, vf2b.x, vf2b.y};
          o0 = __builtin_amdgcn_mfma_f32_32x32x16_bf16(__builtin_bit_cast(bf16x8, vv), __builtin_bit_cast(bf16x8, pbu), o0, 0, 0, 0); }
        c0[0] = __builtin_amdgcn_exp2f(c0[0] - mrun); ps += c0[0]; c0[1] = __builtin_amdgcn_exp2f(c0[1] - mrun); ps += c0[1]; pw[0] = pk2(c0[0], c0[1]); asm volatile("" :: "v"(pw[0]), "v"(ps));
        __builtin_amdgcn_sched_barrier(0);
        vf2a = *(const LAS u32x2*)(vb_ + 32 * 128 + ((4) ^ vsw) * 16); vf2b = *(const LAS u32x2*)(vb_ + 32 * 128 + ((5) ^ vsw) * 16);
        { const u32x4 pbu = {pw[4], pw[5], pw[6], pw[7]}; const u32x4 vv = {vf0a.x, vf0a.y, vf0b.x, vf0b.y};
          o1 = __builtin_amdgcn_mfma_f32_32x32x16_bf16(__builtin_bit_cast(bf16x8, vv), __builtin_bit_cast(bf16x8, pbu), o1, 0, 0, 0); }
        c0[2] = __builtin_amdgcn_exp2f(c0[2] - mrun); ps += c0[2]; c0[3] = __builtin_amdgcn_exp2f(c0[3] - mrun); ps += c0[3]; pw[1] = pk2(c0[2], c0[3]); asm volatile("" :: "v"(pw[1]), "v"(ps));
        __builtin_amdgcn_sched_barrier(0);
        vf0a = *(const LAS u32x2*)(vb_ + ((6) ^ vsw) * 16); vf0b = *(const LAS u32x2*)(vb_ + ((7) ^ vsw) * 16);
        { const u32x4 pbu = {pw[8], pw[9], pw[10], pw[11]}; const u32x4 vv = {vf1a.x, vf1a.y, vf1b.x, vf1b.y};
          o0 = __builtin_amdgcn_mfma_f32_32x32x16_bf16(__builtin_bit_cast(bf16x8, vv), __builtin_bit_cast(bf16x8, pbu), o0, 0, 0, 0); }
        c0[4] = __builtin_amdgcn_exp2f(c0[4] - mrun); ps += c0[4]; c0[5] = __builtin_amdgcn_exp2f(c0[5] - mrun); ps += c0[5]; pw[2] = pk2(c0[4], c0[5]); asm volatile("" :: "v"(pw[2]), "v"(ps));
        __builtin_amdgcn_sched_barrier(0);
        vf1a = *(const LAS u32x2*)(vb_ + 32 * 128 + ((6) ^ vsw) * 16); vf1b = *(const LAS u32x2*)(vb_ + 32 * 128 + ((7) ^ vsw) * 16);
        { const u32x4 pbu = {pw[8], pw[9], pw[10], pw[11]}; const u32x4 vv = {vf2a.x, vf2a.y, vf2b.x, vf2b.y};
          o1 = __builtin_amdgcn_mfma_f32_32x32x16_bf16(__builtin_bit_cast(bf16x8, vv), __builtin_bit_cast(bf16x8, pbu), o1, 0, 0, 0); }
        c0[6] = __builtin_amdgcn_exp2f(c0[6] - mrun); ps += c0[6]; c0[7] = __builtin_amdgcn_exp2f(c0[7] - mrun); ps += c0[7]; pw[3] = pk2(c0[6], c0[7]); asm volatile("" :: "v"(pw[3]), "v"(ps));
        __builtin_amdgcn_sched_barrier(0);
        { const u32x4 pbu = {pw[12], pw[13], pw[14], pw[15]}; const u32x4 vv = {vf0a.x, vf0a.y, vf0b.x, vf0b.y};
          o0 = __builtin_amdgcn_mfma_f32_32x32x16_bf16(__builtin_bit_cast(bf16x8, vv), __builtin_bit_cast(bf16x8, pbu), o0, 0, 0, 0); }
        kf0 = *(const LAS bf16x8*)(kb_ + 0*32*192 + kt16 + 0);
        c0[8] = __builtin_amdgcn_exp2f(c0[8] - mrun); ps += c0[8]; c0[9] = __builtin_amdgcn_exp2f(c0[9] - mrun); ps += c0[9]; pw[4] = pk2(c0[8], c0[9]); asm volatile("" :: "v"(pw[4]), "v"(ps));
        __builtin_amdgcn_sched_barrier(0);
        { const u32x4 pbu = {pw[12], pw[13], pw[14], pw[15]}; const u32x4 vv = {vf1a.x, vf1a.y, vf1b.x, vf1b.y};
          o1 = __builtin_amdgcn_mfma_f32_32x32x16_bf16(__builtin_bit_cast(bf16x8, vv), __builtin_bit_cast(bf16x8, pbu), o1, 0, 0, 0); }
        kf1 = *(const LAS bf16x8*)(kb_ + 0*32*192 + kt16 + 32);
        c0[10] = __builtin_amdgcn_exp2f(c0[10] - mrun); ps += c0[10]; c0[11] = __builtin_amdgcn_exp2f(c0[11] - mrun); ps += c0[11]; pw[5] = pk2(c0[10], c0[11]); asm volatile("" :: "v"(pw[5]), "v"(ps));
        __builtin_amdgcn_sched_barrier(0);
        kf2 = *(const LAS bf16x8*)(kb_ + 0*32*192 + kt16 + 64);
        n0 = __builtin_amdgcn_mfma_f32_32x32x16_bf16(kf0, qf[0], zero16, 0, 0, 0);
        c0[12] = __builtin_amdgcn_exp2f(c0[12] - mrun); ps += c0[12]; c0[13] = __builtin_amdgcn_exp2f(c0[13] - mrun); ps += c0[13]; pw[6] = pk2(c0[12], c0[13]); asm volatile("" :: "v"(pw[6]), "v"(ps));
        __builtin_amdgcn_sched_barrier(0);
        kf0 = *(const LAS bf16x8*)(kb_ + 0*32*192 + kt16 + 96);
        n0 = __builtin_amdgcn_mfma_f32_32x32x16_bf16(kf1, qf[1], n0, 0, 0, 0);
        c0[14] = __builtin_amdgcn_exp2f(c0[14] - mrun); ps += c0[14]; c0[15] = __builtin_amdgcn_exp2f(c0[15] - mrun); ps += c0[15]; pw[7] = pk2(c0[14], c0[15]); asm volatile("" :: "v"(pw[7]), "v"(ps));
        __builtin_amdgcn_sched_barrier(0);
        kf1 = *(const LAS bf16x8*)(kb_ + 0*32*192 + k4o);
        n0 = __builtin_amdgcn_mfma_f32_32x32x16_bf16(kf2, qf[2], n0, 0, 0, 0);
        c1[0] = __builtin_amdgcn_exp2f(c1[0] - mrun); ps += c1[0]; c1[1] = __builtin_amdgcn_exp2f(c1[1] - mrun); ps += c1[1]; pw[8] = pk2(c1[0], c1[1]); asm volatile("" :: "v"(pw[8]), "v"(ps));
        __builtin_amdgcn_sched_barrier(0);
        kf2 = *(const LAS bf16x8*)(kb_ + 0*32*192 + k5o);
        n0 = __builtin_amdgcn_mfma_f32_32x32x16_bf16(kf0, qf[3], n0, 0, 0, 0);
        c1[2] = __builtin_amdgcn_exp2f(c1[2] - mrun); ps += c1[2]; c1[3] = __builtin_amdgcn_exp2f(c1[3] - mrun); ps += c1[3]; pw[9] = pk2(c1[2], c1[3]); asm volatile("" :: "v"(pw[9]), "v"(ps));
        __builtin_amdgcn_sched_barrier(0);
        kf0 = *(const LAS bf16x8*)(kb_ + 1*32*192 + kt16 + 0);
        n0 = __builtin_amdgcn_mfma_f32_32x32x16_bf16(kf1, qf[4], n0, 0, 0, 0);
        c1[4] = __builtin_amdgcn_exp2f(c1[4] - mrun); ps += c1[4]; c1[5] = __builtin_amdgcn_exp2f(c1[5] - mrun); ps += c1[5]; pw[10] = pk2(c1[4], c1[5]); asm volatile("" :: "v"(pw[10]), "v"(ps));
        __builtin_amdgcn_sched_barrier(0);
        kf1 = *(const LAS bf16x8*)(kb_ + 1*32*192 + kt16 + 32);
        n0 = __builtin_amdgcn_mfma_f32_32x32x16_bf16(kf2, qf[5], n0, 0, 0, 0);
        c1[6] = __builtin_amdgcn_exp2f(c1[6] - mrun); ps += c1[6]; c1[7] = __builtin_amdgcn_exp2f(c1[7] - mrun); ps += c1[7]; pw[11] = pk2(c1[6], c1[7]); asm volatile("" :: "v"(pw[11]), "v"(ps));
        __builtin_amdgcn_sched_barrier(0);
        kf2 = *(const LAS bf16x8*)(kb_ + 1*32*192 + kt16 + 64);
        n1 = __builtin_amdgcn_mfma_f32_32x32x16_bf16(kf0, qf[0], zero16, 0, 0, 0);
        c1[8] = __builtin_amdgcn_exp2f(c1[8] - mrun); ps += c1[8]; c1[9] = __builtin_amdgcn_exp2f(c1[9] - mrun); ps += c1[9]; pw[12] = pk2(c1[8], c1[9]); asm volatile("" :: "v"(pw[12]), "v"(ps));
        __builtin_amdgcn_sched_barrier(0);
        kf0 = *(const LAS bf16x8*)(kb_ + 1*32*192 + kt16 + 96);
        n1 = __builtin_amdgcn_mfma_f32_32x32x16_bf16(kf1, qf[1], n1, 0, 0, 0);
        c1[10] = __builtin_amdgcn_exp2f(c1[10] - mrun); ps += c1[10]; c1[11] = __builtin_amdgcn_exp2f(c1[11] - mrun); ps += c1[11]; pw[13] = pk2(c1[10], c1[11]); asm volatile("" :: "v"(pw[13]), "v"(ps));
        __builtin_amdgcn_sched_barrier(0);
        kf1 = *(const LAS bf16x8*)(kb_ + 1*32*192 + k4o);
        n1 = __builtin_amdgcn_mfma_f32_32x32x16_bf16(kf2, qf[2], n1, 0, 0, 0);
        c1[12] = __builtin_amdgcn_exp2f(c1[12] - mrun); ps += c1[12]; c1[13] = __builtin_amdgcn_exp2f(c1[13] - mrun); ps += c1[13]; pw[14] = pk2(c1[12], c1[13]); asm volatile("" :: "v"(pw[14]), "v"(ps));
        __builtin_amdgcn_sched_barrier(0);
        kf2 = *(const LAS bf16x8*)(kb_ + 1*32*192 + k5o);
        n1 = __builtin_amdgcn_mfma_f32_32x32x16_bf16(kf0, qf[3], n1, 0, 0, 0);
        c1[14] = __builtin_amdgcn_exp2f(c1[14] - mrun); ps += c1[14]; c1[15] = __builtin_amdgcn_exp2f(c1[15] - mrun); ps += c1[15]; pw[15] = pk2(c1[14], c1[15]); asm volatile("" :: "v"(pw[15]), "v"(ps));
        __builtin_amdgcn_sched_barrier(0);
        n1 = __builtin_amdgcn_mfma_f32_32x32x16_bf16(kf1, qf[4], n1, 0, 0, 0);
        __builtin_amdgcn_sched_barrier(0);
        n1 = __builtin_amdgcn_mfma_f32_32x32x16_bf16(kf2, qf[5], n1, 0, 0, 0);
        __builtin_amdgcn_sched_barrier(0);
    } else {
        u32x2 vf0a, vf0b, vf1a, vf1b, vf2a, vf2b;
        vf0a = *(const LAS u32x2*)(vb_ + ((0) ^ vsw) * 16); vf0b = *(const LAS u32x2*)(vb_ + ((1) ^ vsw) * 16);
        vf1a = *(const LAS u32x2*)(vb_ + 32 * 128 + ((0) ^ vsw) * 16); vf1b = *(const LAS u32x2*)(vb_ + 32 * 128 + ((1) ^ vsw) * 16);
        vf2a = *(const LAS u32x2*)(vb_ + ((2) ^ vsw) * 16); vf2b = *(const LAS u32x2*)(vb_ + ((3) ^ vsw) * 16);
        { const u32x4 pbu = {pw[0], pw[1], pw[2], pw[3]}; const u32x4 vv = {vf0a.x, vf0a.y, vf0b.x, vf0b.y};
          o0 = __builtin_amdgcn_mfma_f32_32x32x16_bf16(__builtin_bit_cast(bf16x8, vv), __builtin_bit_cast(bf16x8, pbu), o0, 0, 0, 0); }
        __builtin_amdgcn_sched_barrier(0);
        vf0a = *(const LAS u32x2*)(vb_ + 32 * 128 + ((2) ^ vsw) * 16); vf0b = *(const LAS u32x2*)(vb_ + 32 * 128 + ((3) ^ vsw) * 16);
        { const u32x4 pbu = {pw[0], pw[1], pw[2], pw[3]}; const u32x4 vv = {vf1a.x, vf1a.y, vf1b.x, vf1b.y};
          o1 = __builtin_amdgcn_mfma_f32_32x32x16_bf16(__builtin_bit_cast(bf16x8, vv), __builtin_bit_cast(bf16x8, pbu), o1, 0, 0, 0); }
        __builtin_amdgcn_sched_barrier(0);
        vf1a = *(const LAS u32x2*)(vb_ + ((4) ^ vsw) * 16); vf1b = *(const LAS u32x2*)(vb_ + ((5) ^ vsw) * 16);
        { const u32x4 pbu = {pw[4], pw[5], pw[6], pw[7]}; const u32x4 vv = {vf2a.x, vf2a.y, vf2b.x, vf2b.y};
          o0 = __builtin_amdgcn_mfma_f32_32x32x16_bf16(__builtin_bit_cast(bf16x8, vv), __builtin_bit_cast(bf16x8, pbu), o0, 0, 0, 0); }
        __builtin_amdgcn_sched_barrier(0);
        vf2a = *(const LAS u32x2*)(vb_ + 32 * 128 + ((4) ^ vsw) * 16); vf2b = *(const LAS u32x2*)(vb_ + 32 * 128 + ((5) ^ vsw) * 16);
        { const u32x4 pbu = {pw[4], pw[5], pw[6], pw[7]}; const u32x4 vv = {vf0a.x, vf0a.y, vf0b.x, vf0b.y};
          o1 = __builtin_amdgcn_mfma_f32_32x32x16_bf16(__builtin_bit_cast(bf16x8, vv), __builtin_bit_cast(bf16x8, pbu), o1, 0, 0, 0); }
        __builtin_amdgcn_sched_barrier(0);
        vf0a = *(const LAS u32x2*)(vb_ + ((6) ^ vsw) * 16); vf0b = *(const LAS u32x2*)(vb_ + ((7) ^ vsw) * 16);
        { const u32x4 pbu = {pw[8], pw[9], pw[10], pw[11]}; const u32x4 vv = {vf1a.x, vf1a.y, vf1b.x, vf1b.y};
          o0 = __builtin_amdgcn_mfma_f32_32x32x16_bf16(__builtin_bit_cast(bf16x8, vv), __builtin_bit_cast(bf16x8, pbu), o0, 0, 0, 0); }
        __builtin_amdgcn_sched_barrier(0);
        vf1a = *(const LAS u32x2*)(vb_ + 32 * 128 + ((6) ^ vsw) * 16); vf1b = *(const LAS u32x2*)(vb_ + 32 * 128 + ((7) ^ vsw) * 16);
        { const u32x4 pbu = {pw[8], pw[9], pw[10], pw[11]}; const u32x4 vv = {vf2a.x, vf2a.y, vf2b.x, vf2b.y};
          o1 = __builtin_amdgcn_mfma_f32_32x32x16_bf16(__builtin_bit_cast(bf16x8, vv), __builtin_bit_cast(bf16x8, pbu), o1, 0, 0, 0); }
        __builtin_amdgcn_sched_barrier(0);
        { const u32x4 pbu = {pw[12], pw[13], pw[14], pw[15]}; const u32x4 vv = {vf0a.x, vf0a.y, vf0b.x, vf0b.y};
          o0 = __builtin_amdgcn_mfma_f32_32x32x16_bf16(__builtin_bit_cast(bf16x8, vv), __builtin_bit_cast(bf16x8, pbu), o0, 0, 0, 0); }
        __builtin_amdgcn_sched_barrier(0);
        { const u32x4 pbu = {pw[12], pw[13], pw[14], pw[15]}; const u32x4 vv = {vf1a.x, vf1a.y, vf1b.x, vf1b.y};
          o1 = __builtin_amdgcn_mfma_f32_32x32x16_bf16(__builtin_bit_cast(bf16x8, vv), __builtin_bit_cast(bf16x8, pbu), o1, 0, 0, 0); }
        __builtin_amdgcn_sched_barrier(0);
    }
}

template <int DUMMY>
__device__ void phase3q(const P& p, int bid, int nb, LAS unsigned char* lds) {
    const bf16_t* Q = p.slotA; const bf16_t* K = p.slotE; const bf16_t* VT = p.slotF; bf16_t* O = (DUMMY == 0) ? (bf16_t*)p.slotB : p.slotC;
    const int tid = opaque_tid(), lane = tid & 63, wid = tid >> 6, l31 = lane & 31, hh = lane >> 5;
    constexpr float THR = 8.f; (void)THR;
    const int widu = __builtin_amdgcn_readfirstlane(tid >> 6);
    const int kr0 = tid / 12, kpc = tid % 12, koff0 = kr0 * 96 + ((kpc + 12 - ((kr0 >> 2) & 3)) % 12) * 8;
    const int kt = hh + ((lane >> 2) & 3), kt16 = kt * 16, k4o = (8 + kt >= 12 ? kt - 4 : 8 + kt) * 16, k5o = (10 + kt >= 12 ? kt - 2 : 10 + kt) * 16;
    const int krow = l31 * 192, vsw = (lane >> 1) & 7, vrow = l31 * 128 + 8 * hh;
    for (int iu = 0;; ++iu) {
        const int r = iu * nb + ((iu & 1) ? nb - 1 - bid : bid); if (r >= 1024) break;
        const int qb = 63 - (r >> 4), bh = r & 15, b = bh >> 3, h = bh & 7;
        const int q0 = qb * 128 + wid * 32, ntw = (q0 >> 6) + 1, nt = 2 * qb + 2;
        const bf16_t* Kb = K + (size_t)bh * SEQ * 96; const bf16_t* Vb = VT + (size_t)(h * 64) * NT + (size_t)b * SEQ;
        bf16x8 qf[6]; { const bf16_t* qp = Q + ((size_t)bh * SEQ + q0 + l31) * 96 + hh * 8;
#pragma unroll
            for (int ks = 0; ks < 6; ++ks) qf[ks] = *(const bf16x8*)(qp + ks * 16); }
        f32x16 o0, o1;
#pragma unroll
        for (int e = 0; e < 16; ++e) { o0[e] = 0.f; o1[e] = 0.f; }
        float mrun = 0.f, lsum = 0.f;
        auto stageK = [&](int j) { LAS unsigned char* d = lds + (j & 1) * 12288 + widu * 1024; const bf16_t* kt = Kb + (size_t)j * 64 * 96 + koff0;
            if (wid < 3) {
#pragma unroll
                for (int i = 0; i < 4; ++i) __builtin_amdgcn_global_load_lds((const unsigned*)(kt + i * 16 * 96), (LAS unsigned*)(d + i * 3072), 16, 0, 0); } };
        auto stageV = [&](int j) { LAS unsigned char* d = lds + 24576 + (j & 1) * 8192 + widu * 1024; const bf16_t* vt = Vb + j * 64;
#pragma unroll
            for (int i = 0; i < 2; ++i) { const int dv = (tid >> 3) + 32 * i, cl = (tid & 7) ^ ((dv >> 1) & 7);
                __builtin_amdgcn_global_load_lds((const unsigned*)(vt + (size_t)dv * NT + cl * 8), (LAS unsigned*)(d + i * 4096), 16, 0, 0); } };
        f32x16 sA0, sA1, sB0, sB1; unsigned pw[16];
#pragma unroll
        for (int e = 0; e < 16; ++e) pw[e] = 0u;
        stageK(0); stageK(1);
        asm volatile("s_waitcnt vmcnt(0)" ::: "memory");
        __syncthreads();
        { const LAS unsigned char* kb_ = lds + krow;
#pragma unroll
          for (int e = 0; e < 16; ++e) { sA0[e] = 0.f; sA1[e] = 0.f; }
#pragma unroll
          for (int ks = 0; ks < 6; ++ks) { const int ko = ks <= 3 ? kt16 + 32 * ks : (ks == 4 ? k4o : k5o); const bf16x8 k0 = *(const LAS bf16x8*)(kb_ + ko); const bf16x8 k1 = *(const LAS bf16x8*)(kb_ + 32 * 192 + ko);
              sA0 = __builtin_amdgcn_mfma_f32_32x32x16_bf16(k0, qf[ks], sA0, 0, 0, 0); sA1 = __builtin_amdgcn_mfma_f32_32x32x16_bf16(k1, qf[ks], sA1, 0, 0, 0); } }
        auto step = [&](f32x16& c0, f32x16& c1, f32x16& n0, f32x16& n1, int s) {
            asm volatile("s_waitcnt vmcnt(0)" ::: "memory");
            __syncthreads();
            if (s + 2 < nt) stageK(s + 2);
            if (s < nt) stageV(s);
            if (s <= ntw) {
                const LAS unsigned char* kb_ = lds + ((s + 1) & 1) * 12288 + krow; const LAS unsigned char* vb_ = lds + 24576 + ((s + 1) & 1) * 8192 + vrow;
                float ps = 0.f, alpha = 1.f; bool resc = false;
                if (s < ntw) {
                    if (s == 0) att_step<0>(kb_, vb_, kt16, k4o, k5o, vsw, qf, c0, c1, n0, n1, pw, o0, o1, mrun, ps, alpha, resc);
                    else att_step<1>(kb_, vb_, kt16, k4o, k5o, vsw, qf, c0, c1, n0, n1, pw, o0, o1, mrun, ps, alpha, resc);
                    if (resc) {
#pragma unroll
                        for (int e = 0; e < 16; ++e) { o0[e] *= alpha; o1[e] *= alpha; } }
                    lsum = lsum * alpha + ps;
                } else att_step<2>(kb_, vb_, kt16, k4o, k5o, vsw, qf, c0, c1, n0, n1, pw, o0, o1, mrun, ps, alpha, resc);
            }
        };
        for (int s = 0; s <= nt; s += 2) { step(sA0, sA1, sB0, sB1, s); if (s + 1 <= nt) step(sB0, sB1, sA0, sA1, s + 1); }
        const float inv = 1.f / (lsum + __shfl_xor(lsum, 32));
        int tq = tid; asm volatile("" : "+v"(tq));
        bf16_t* op = O + (size_t)(b * SEQ + qb * 128 + (tq >> 6) * 32 + (tq & 31)) * 512 + h * 64 + 4 * ((tq >> 5) & 1);
#pragma unroll
        for (int g = 0; g < 4; ++g) { uint2 w0, w1;
            w0.x = pk2(o0[4 * g] * inv, o0[4 * g + 1] * inv); w0.y = pk2(o0[4 * g + 2] * inv, o0[4 * g + 3] * inv);
            w1.x = pk2(o1[4 * g] * inv, o1[4 * g + 1] * inv); w1.y = pk2(o1[4 * g + 2] * inv, o1[4 * g + 3] * inv);
            *(uint2*)(op + 8 * g) = w0; *(uint2*)(op + 32 + 8 * g) = w1; }
        __syncthreads();
    }
}

__device__ __forceinline__ unsigned pack2bf(float lo, float hi) { return (unsigned)f2bf(lo) | ((unsigned)f2bf(hi) << 16); }
__device__ void phase4(const P& p, int bid, int nb, LAS unsigned char* lds) {
    const bf16_t* O = (const bf16_t*)p.slotB; const bf16_t* su = p.slotG; const bf16_t* gates = p.slotD; bf16_t* mo = p.slotA;
    const int tid = opaque_tid(), lane = tid & 63, wid = tid >> 6, wr = wid >> 1, wc = wid & 1, fr = lane & 15, fq = lane >> 4;
    const int c8 = ((tid & 7) ^ ((tid >> 3) & 7)) * 8;
    int rt, ct;
    for (int it = 0; tile_of(it, bid, nb, NT / 128, DM / 128, rt, ct); ++it) {
        const int row0 = rt * 128, col0 = ct * 128;
        f32x4 acc0[4][4], acc1[4][4];
#pragma unroll
        for (int m = 0; m < 4; ++m)
#pragma unroll
            for (int n = 0; n < 4; ++n) { acc0[m][n] = (f32x4){0.f, 0.f, 0.f, 0.f}; acc1[m][n] = (f32x4){0.f, 0.f, 0.f, 0.f}; }
        mg_kloop(acc0, O + (size_t)(row0 + (tid >> 3)) * 512 + c8, (size_t)32 * 512, p.WoaT + (size_t)(col0 + (tid >> 3)) * 512 + c8, (size_t)32 * 512, 8, lds);
        mg_kloop(acc1, su + (size_t)(row0 + (tid >> 3)) * 512 + c8, (size_t)32 * 512, p.WosT + (size_t)(col0 + (tid >> 3)) * 512 + c8, (size_t)32 * 512, 8, lds);
#pragma unroll
        for (int m = 0; m < 4; ++m)
#pragma unroll
            for (int n = 0; n < 4; ++n) { const int t = row0 + wr * 64 + m * 16 + fr, c = col0 + wc * 64 + n * 16 + fq * 4;
                const uint2 ga = *(const uint2*)(gates + (size_t)t * 2048 + c), gb = *(const uint2*)(gates + (size_t)t * 2048 + 1024 + c);
                const float r0 = __uint_as_float(ga.x << 16) * acc0[m][n][0] + __uint_as_float(gb.x << 16) * acc1[m][n][0];
                const float r1 = __uint_as_float(ga.x & 0xffff0000u) * acc0[m][n][1] + __uint_as_float(gb.x & 0xffff0000u) * acc1[m][n][1];
                const float r2 = __uint_as_float(ga.y << 16) * acc0[m][n][2] + __uint_as_float(gb.y << 16) * acc1[m][n][2];
                const float r3 = __uint_as_float(ga.y & 0xffff0000u) * acc0[m][n][3] + __uint_as_float(gb.y & 0xffff0000u) * acc1[m][n][3];
                uint2 o; o.x = pack2bf(r0, r1); o.y = pack2bf(r2, r3); *(uint2*)(mo + (size_t)t * DM + c) = o; }
    }
}

__device__ void phase5(const P& p, int bid, int nb, LAS unsigned char* sm) {
    const float* x = p.x; float* xm = p.out;
    mgemm(p.slotA, DM, p.WoutT, DM, NT, DM, DM, [=](int t, int c, const f32x4& v) {
        const f32x4 xv = *(const f32x4*)(x + (size_t)t * DM + c); *(f32x4*)(xm + (size_t)t * DM + c) = xv + v;
    }, bid, nb, sm);
}

__device__ __forceinline__ int gu_src_col(int rho, int& isup) {
    const int tt = rho >> 7, w = rho & 127, wc = w >> 6, n = (w >> 4) & 3, i = w & 15; isup = n >> 1; return tt * 64 + wc * 32 + (n & 1) * 16 + i;
}
__device__ void phase6(const P& p, int bid, int nb, float* sm, int mode  ) {
    const int tid = opaque_tid(), lane = tid & 63, wid = tid >> 6;
    bf16_t* h2 = p.slotA; const float* xm = p.out;
    if (mode != 2)
    for (int t = bid * 4 + wid; t < NT; t += nb * 4) {
        f32x4 v[4]; float ss = 0.f;
#pragma unroll
        for (int i = 0; i < 4; ++i) { v[i] = *(const f32x4*)(xm + (size_t)t * DM + (lane + 64 * i) * 4); ss += v[i][0] * v[i][0] + v[i][1] * v[i][1] + v[i][2] * v[i][2] + v[i][3] * v[i][3]; }
        ss = wsum(ss); const float r = rsqrtf(ss * (1.f / DM) + EPS);
#pragma unroll
        for (int i = 0; i < 4; ++i) { const f32x4 g = *(const f32x4*)(p.g_ffn + (lane + 64 * i) * 4); v[i] = v[i] * r * g;
            uint2 o; o.x = pk2(v[i][0], v[i][1]); o.y = pk2(v[i][2], v[i][3]); *(uint2*)(h2 + (size_t)t * DM + (lane + 64 * i) * 4) = o; }
        float lg[4] = {0.f, 0.f, 0.f, 0.f};
#pragma unroll
        for (int i = 0; i < 4; ++i)
#pragma unroll
            for (int j = 0; j < 4; ++j) { const f32x4 w = *(const f32x4*)(p.w_rg + (size_t)((lane + 64 * i) * 4 + j) * 4);
#pragma unroll
                for (int g = 0; g < 4; ++g) lg[g] += v[i][j] * w[g]; }
#pragma unroll
        for (int g = 0; g < 4; ++g) lg[g] = wsum(lg[g]) + p.b_rg[g];
        int gs = 0; float gm = lg[0];
#pragma unroll
        for (int g = 1; g < 4; ++g) if (lg[g] > gm) { gm = lg[g]; gs = g; }
        float den = 0.f;
#pragma unroll
        for (int g = 0; g < 4; ++g) den += __expf(lg[g] - gm);
        const float ptop = 1.f / den;
        float le[8] = {0.f, 0.f, 0.f, 0.f, 0.f, 0.f, 0.f, 0.f};
#pragma unroll
        for (int i = 0; i < 4; ++i)
#pragma unroll
            for (int j = 0; j < 4; ++j) { const float* w = p.w_re + ((size_t)gs * DM + (lane + 64 * i) * 4 + j) * 8; const f32x4 w0 = *(const f32x4*)w, w1 = *(const f32x4*)(w + 4);
#pragma unroll
                for (int e = 0; e < 4; ++e) { le[e] += v[i][j] * w0[e]; le[4 + e] += v[i][j] * w1[e]; } }
#pragma unroll
        for (int e = 0; e < 8; ++e) le[e] = wsum(le[e]) + p.b_re[gs * 8 + e];
        int e1 = 0; float l1 = le[0];
#pragma unroll
        for (int e = 1; e < 8; ++e) if (le[e] > l1) { l1 = le[e]; e1 = e; }
        int e2 = -1; float l2 = -3.0e38f;
#pragma unroll
        for (int e = 0; e < 8; ++e) if (e != e1 && le[e] > l2) { l2 = le[e]; e2 = e; }
        const float s1 = 1.f / (1.f + __expf(l2 - l1)), s2 = 1.f - s1;
        if (lane == 0 && mode != 1) {
            const int ea = gs * 8 + e1, eb = gs * 8 + e2;
            const int ra = atomicAdd(&p.cnt[ea], 1); p.list[(size_t)ea * NT + ra] = 2 * t;
            const int rb = atomicAdd(&p.cnt[eb], 1); p.list[(size_t)eb * NT + rb] = 2 * t + 1;
            p.aw[2 * t] = s1 * ptop; p.aw[2 * t + 1] = s2 * ptop; p.aexp[2 * t] = ea; p.aexp[2 * t + 1] = eb;
        }
    }
    bf16_t* WguT = (bf16_t*)p.slotB; bf16_t* WdT = WguT + (size_t)NE * 512 * 1024;
    const size_t gtid = (size_t)bid * 256 + tid, gsz = (size_t)nb * 256;
    int base = 0;
    if (mode != 1)
    for (int e = 0; e < NE; ++e) {
        base = tconv(WguT + (size_t)e * 512 * 1024, 512, 1024, [&](int k, int rho) { int isup; const int col = gu_src_col(rho, isup); const float* src = isup ? p.w_eu : p.w_eg;
            return src[((size_t)e * 1024 + k) * 256 + col]; }, base, bid, nb, sm);
        base = tconv(WdT + (size_t)e * 1024 * 256, 1024, 256, [&](int k, int n) { return p.w_ed[((size_t)e * 256 + k) * 1024 + n]; }, base, bid, nb, sm);
    }
}

__device__ void phase7a(const P& p, int bid, int nb) {
    const bf16_t* h2 = p.slotA; const bf16_t* WguT = (const bf16_t*)p.slotB; bf16_t* hid = p.slotE;
    for (size_t i = (size_t)bid * 256 + threadIdx.x; i < (size_t)2 * NT * 256; i += (size_t)nb * 256) {
        const int a = (int)(i >> 8), c = (int)(i & 255), t = a >> 1, e = p.aexp[a];
        const int tt = c >> 6, wc = (c >> 5) & 1, nn = (c >> 4) & 1, ii = c & 15; const int rg = tt * 128 + wc * 64 + nn * 16 + ii, ru = rg + 32;
        const bf16_t* wg = WguT + ((size_t)e * 512 + rg) * 1024; const bf16_t* wu = WguT + ((size_t)e * 512 + ru) * 1024; const bf16_t* hr = h2 + (size_t)t * DM;
        float G = 0.f, U = 0.f;
        for (int k = 0; k < DM / 8; ++k) { const uint4 hv = ((const uint4*)hr)[k]; G += dot8(hv, ((const uint4*)wg)[k]); U += dot8(hv, ((const uint4*)wu)[k]); }
        hid[i] = f2bf(G * sigmoidf_(G) * U);
    }
}
__device__ void phase7b(const P& p, int bid, int nb) {
    const bf16_t* hid = p.slotE; const bf16_t* WdT = (const bf16_t*)p.slotB + (size_t)NE * 512 * 1024; bf16_t* Y = p.slotD;
    for (size_t i = (size_t)bid * 256 + threadIdx.x; i < (size_t)2 * NT * DM; i += (size_t)nb * 256) {
        const int a = (int)(i >> 10), n = (int)(i & 1023), e = p.aexp[a];
        const bf16_t* w = WdT + ((size_t)e * 1024 + n) * 256; const bf16_t* hr = hid + (size_t)a * 256; float s = 0.f;
        for (int k = 0; k < 32; ++k) s += dot8(((const uint4*)hr)[k], ((const uint4*)w)[k]);
        Y[i] = f2bf(s * p.aw[a]);
    }
}


__device__ __forceinline__ bool find_expert(const int* cnt, int ub, int& e, int& blk, int& ce) {
    int acc = 0;
    for (int i = 0; i < NE; ++i) { const int c = cnt[i], n = (c + 127) >> 7; if (ub < acc + n) { e = i; blk = ub - acc; ce = c; return true; } acc += n; }
    return false;
}
__device__ void phase7a_m(const P& p, int bid, int nb, LAS unsigned char* lds) {
    const bf16_t* h2 = p.slotA; const bf16_t* WguT = (const bf16_t*)p.slotB; bf16_t* hid = p.slotE;
    const int tid = opaque_tid(), lane = tid & 63, wid = tid >> 6, wr = wid >> 1, wc = wid & 1, fr = lane & 15, fq = lane >> 4;
    const int c8 = ((tid & 7) ^ ((tid >> 3) & 7)) * 8;
    for (int u = bid;; u += nb) {
        int e, blk, ce; if (!find_expert(p.cnt, u >> 2, e, blk, ce)) break;
        const int ct = u & 3; const int* lst = p.list + (size_t)e * NT;
        const bf16_t* ap[4];
#pragma unroll
        for (int i = 0; i < 4; ++i) { int r = blk * 128 + (tid >> 3) + 32 * i; r = r < ce ? r : ce - 1; ap[i] = h2 + (size_t)(lst[r] >> 1) * DM + c8; }
        f32x4 acc[4][4];
#pragma unroll
        for (int m = 0; m < 4; ++m)
#pragma unroll
            for (int n = 0; n < 4; ++n) acc[m][n] = (f32x4){0.f, 0.f, 0.f, 0.f};
        mg_kloop4(acc, ap[0], ap[1], ap[2], ap[3], WguT + ((size_t)e * 512 + ct * 128 + (tid >> 3)) * 1024 + c8, (size_t)32 * 1024, 16, lds);
        bf16_t* hb = hid + ((size_t)(u >> 2) * 128 + wr * 64 + fr) * 256 + ct * 64 + wc * 32 + fq * 4;
#pragma unroll
        for (int m = 0; m < 4; ++m)
#pragma unroll
            for (int n = 0; n < 2; ++n) { float v[4];
#pragma unroll
                for (int j = 0; j < 4; ++j) { const float g = acc[m][n][j]; v[j] = g * sigmoidf_(g) * acc[m][n + 2][j]; }
                uint2 o; o.x = pk2(v[0], v[1]); o.y = pk2(v[2], v[3]); *(uint2*)(hb + (size_t)(m * 16) * 256 + n * 16) = o; }
    }
}
__device__ void phase7b_m(const P& p, int bid, int nb, LAS unsigned char* lds) {
    const bf16_t* hid = p.slotE; const bf16_t* WdT = (const bf16_t*)p.slotB + (size_t)NE * 512 * 1024; bf16_t* Y = p.slotD;
    const int tid = opaque_tid(), lane = tid & 63, wid = tid >> 6, wr = wid >> 1, wc = wid & 1, fr = lane & 15, fq = lane >> 4;
    const int c8 = ((tid & 7) ^ ((tid >> 3) & 7)) * 8;
    for (int u = bid;; u += nb) {
        int e, blk, ce; if (!find_expert(p.cnt, u >> 3, e, blk, ce)) break;
        const int ct = u & 7; const int* lst = p.list + (size_t)e * NT;
        f32x4 acc[4][4];
#pragma unroll
        for (int m = 0; m < 4; ++m)
#pragma unroll
            for (int n = 0; n < 4; ++n) acc[m][n] = (f32x4){0.f, 0.f, 0.f, 0.f};
        mg_kloop(acc, hid + ((size_t)(u >> 3) * 128 + (tid >> 3)) * 256 + c8, (size_t)32 * 256, WdT + ((size_t)e * 1024 + ct * 128 + (tid >> 3)) * 256 + c8, (size_t)32 * 256, 4, lds);
#pragma unroll
        for (int m = 0; m < 4; ++m) { const int r = blk * 128 + wr * 64 + m * 16 + fr;
            if (r < ce) { const int a = lst[r]; const float w = p.aw[a]; bf16_t* yp = Y + (size_t)a * DM + ct * 128 + wc * 64 + fq * 4;
#pragma unroll
                for (int n = 0; n < 4; ++n) { uint2 o; o.x = pk2(acc[m][n][0] * w, acc[m][n][1] * w); o.y = pk2(acc[m][n][2] * w, acc[m][n][3] * w); *(uint2*)(yp + n * 16) = o; } } }
    }
}

__device__ __forceinline__ f32x4 bf4(const uint2 u) { return (f32x4){__uint_as_float(u.x << 16), __uint_as_float(u.x & 0xffff0000u), __uint_as_float(u.y << 16), __uint_as_float(u.y & 0xffff0000u)}; }
__device__ void phase8(const P& p, int bid, int nb, float* dst) {
    const int tid = opaque_tid(), lane = tid & 63, wid = tid >> 6; const bf16_t* Y = p.slotD;
    for (int t = bid * 4 + wid; t < NT; t += nb * 4) {
        f32x4 v[4]; float ss = 0.f;
#pragma unroll
        for (int i = 0; i < 4; ++i) { const int c = (lane + 64 * i) * 4;
            v[i] = *(const f32x4*)(p.out + (size_t)t * DM + c) + bf4(*(const uint2*)(Y + (size_t)(2 * t) * DM + c)) + bf4(*(const uint2*)(Y + (size_t)(2 * t + 1) * DM + c));
            ss += v[i][0] * v[i][0] + v[i][1] * v[i][1] + v[i][2] * v[i][2] + v[i][3] * v[i][3]; }
        ss = wsum(ss); const float r = rsqrtf(ss * (1.f / DM) + EPS);
#pragma unroll
        for (int i = 0; i < 4; ++i) { const int c = (lane + 64 * i) * 4; const f32x4 g = *(const f32x4*)(p.g_final + c); *(f32x4*)(dst + (size_t)t * DM + c) = v[i] * r * g; }
    }
}

#define XB_TMO      128
#define XB_XCNT(j)  (256  + 64 * (j))
#define XB_XSUB(j)  (1280 + 64 * (j))
#define XB_XGEN(j)  (2304 + 64 * (j))
#define XB_TOP      3328
#define XB_TOPGEN   3392
#define XCD_BAR_WORDS 3456
#define XB_SPIN_CAP (1u << 18)
__device__ __forceinline__ unsigned xb_ld(unsigned* p)              { return __hip_atomic_load(p, __ATOMIC_RELAXED, __HIP_MEMORY_SCOPE_AGENT); }
__device__ __forceinline__ unsigned xb_add(unsigned* p, unsigned v) { return __hip_atomic_fetch_add(p, v, __ATOMIC_RELAXED, __HIP_MEMORY_SCOPE_AGENT); }
__device__ __forceinline__ unsigned xb_xcc_id() { return (unsigned)__builtin_amdgcn_s_getreg((3 << 11) | 20) & 0xFu; }
#define XB_SPIN(cond, bar) do { unsigned _sp = 0; while (cond) { __builtin_amdgcn_s_sleep(1); \
    if ((++_sp & 255u) == 0u) { if (xb_ld(&(bar)[XB_TMO])) break; if (_sp > XB_SPIN_CAP) { atomicAdd(&(bar)[XB_TMO], 1u); break; } } } } while (0)
struct XcdBarrier { unsigned* bar; unsigned x; volatile LAS unsigned* st; };
__device__ __forceinline__ XcdBarrier xcd_barrier_post(unsigned* bar, volatile LAS unsigned* st) {
    XcdBarrier b; b.bar = bar; b.x = xb_xcc_id(); b.st = st;
    if (threadIdx.x == 0) (void)xb_add(&bar[XB_XCNT(b.x)], 1u);
    return b;
}
__device__ __forceinline__ void xcd_barrier_complete(unsigned* bar, unsigned x, unsigned& nloc, unsigned& nx) {
    const unsigned G = gridDim.x * gridDim.y * gridDim.z;
    unsigned sum, cnt, mine, sp = 0u;
    for (;;) {
        sum = 0u; cnt = 0u; mine = 0u;
#pragma unroll
        for (unsigned j = 0; j < 16; ++j) { const unsigned c = xb_ld(&bar[XB_XCNT(j)]); sum += c; cnt += (c > 0u) ? 1u : 0u; mine = (j == x) ? c : mine; }
        if (sum == G) break;
        __builtin_amdgcn_s_sleep(1);
        if ((++sp & 255u) == 0u) { if (xb_ld(&bar[XB_TMO])) break; if (sp > XB_SPIN_CAP) { atomicAdd(&bar[XB_TMO], 1u); break; } }
    }
    nloc = mine > 0u ? mine : 1u; nx = cnt > 0u ? cnt : 1u;
}
__device__ __forceinline__ void xcd_barrier(const XcdBarrier& b) {
    asm volatile("s_waitcnt vmcnt(0)" ::: "memory");
    __syncthreads();
    if (threadIdx.x == 0) {
        unsigned* bar = b.bar;
        __builtin_amdgcn_s_waitcnt(0);
        unsigned nloc = b.st[0], nx = b.st[1];
        if (nloc == 0u) { xcd_barrier_complete(bar, b.x, nloc, nx); b.st[0] = nloc; b.st[1] = nx; }
        const unsigned old = xb_add(&bar[XB_XSUB(b.x)], 1u);
        const unsigned gen = old / nloc;
        if (old + 1u == (gen + 1u) * nloc) {
            __builtin_amdgcn_fence(__ATOMIC_RELEASE, "agent");
            asm volatile("s_waitcnt vmcnt(0)" ::: "memory");
            const unsigned og = xb_add(&bar[XB_TOP], 1u);
            const unsigned tg = og / nx;
            if (og + 1u == (tg + 1u) * nx) xb_add(&bar[XB_TOPGEN], 1u);
            else XB_SPIN(xb_ld(&bar[XB_TOPGEN]) == tg, bar);
            __builtin_amdgcn_fence(__ATOMIC_ACQUIRE, "agent");
            xb_add(&bar[XB_XGEN(b.x)], 1u);
            asm volatile("s_waitcnt vmcnt(0)" ::: "memory");
        } else {
            XB_SPIN(xb_ld(&bar[XB_XGEN(b.x)]) == gen, bar);
            __builtin_amdgcn_fence(__ATOMIC_ACQUIRE, "agent");
            asm volatile("s_waitcnt vmcnt(0)" ::: "memory");
        }
    }
    __syncthreads();
}

constexpr int LDS_MAIN = 64 * 1024;
constexpr int LDS_BYTES = LDS_MAIN + 16;
extern __shared__ __attribute__((aligned(16))) unsigned char smem_raw[];

#if MK_LAUNCHES != 1
__global__ void __launch_bounds__(256, 2) k_phase(P p, int ph) {
    float* sm = (float*)smem_raw; LAS unsigned char* lds = (LAS unsigned char*)smem_raw; const int bid = blockIdx.x, nb = gridDim.x;
    switch (ph) {
        case 0: phase0(p, bid, nb, sm); break;
        case 1: phase1(p, bid, nb, lds); break;
        case 2: phase2a(p, bid, nb, false); break;
        case 3: phase2b(p, bid, nb, lds); break;
        case 4: phase2c_m(p, bid, nb, lds); break;
        case 5: phase3q<0>(p, bid, nb, lds); break;
        case 6: phase4(p, bid, nb, lds); break;
        case 7: phase5(p, bid, nb, lds); break;
        case 8: phase6(p, bid, nb, sm, 0); break;
        case 9: phase7a_m(p, bid, nb, lds); break;
        case 10: phase7b_m(p, bid, nb, lds); break;
        case 11: phase8(p, bid, nb, p.out); break;
    }
}
#endif

__global__ void __launch_bounds__(256, 2) k_mega(P p) {
    float* sm = (float*)smem_raw; LAS unsigned char* lds = (LAS unsigned char*)smem_raw; const int bid = blockIdx.x, nb = gridDim.x;
    volatile LAS unsigned* st = (volatile LAS unsigned*)(lds + LDS_MAIN);
    if (threadIdx.x < 4) st[threadIdx.x] = 0u;
    __syncthreads();
    const XcdBarrier gb = xcd_barrier_post(p.bar, st);
    for (int rep_ = 0; rep_ < (PROBE == 10 ? 2 : 1); ++rep_) { phase0(p, bid, nb, sm); }
    xcd_barrier(gb);
    if (PROBE == 9) {
#pragma unroll 1
        for (int rep_ = 0; rep_ < 10; ++rep_) xcd_barrier(gb);
    }
    for (int rep_ = 0; rep_ < (PROBE == 1 ? 2 : 1); ++rep_) { phase1(p, bid, nb, lds); }
    xcd_barrier(gb);
    for (int rep_ = (PROBE == 12 ? 0 : 1); rep_ < 2; ++rep_) { phase2a(p, bid, nb, rep_ == 0); }
    xcd_barrier(gb);
    for (int rep_ = 0; rep_ < (PROBE == 2 ? 2 : 1); ++rep_) { phase2b(p, bid, nb, lds); phase2c_m(p, bid, nb, lds); }
    xcd_barrier(gb);
    if (PROBE == 31) phase3m<1>(p, bid, nb, lds);
    if (PROBE == 32) phase3m<2>(p, bid, nb, lds);
    if (PROBE == 33) phase3m<3>(p, bid, nb, lds);
    if (PROBE == 30) phase3m<4>(p, bid, nb, lds);
    if (PROBE == 34) phase3p<1>(p, bid, nb, lds);
    phase3q<0>(p, bid, nb, lds);
    xcd_barrier(gb);
    for (int rep_ = 0; rep_ < (PROBE == 4 ? 2 : 1); ++rep_) { phase4(p, bid, nb, lds); }
    xcd_barrier(gb);
    for (int rep_ = 0; rep_ < (PROBE == 5 ? 2 : 1); ++rep_) { phase5(p, bid, nb, lds); }
    xcd_barrier(gb);
    for (int rep_ = ((PROBE == 13 || PROBE == 14) ? 0 : 1); rep_ < 2; ++rep_) { phase6(p, bid, nb, sm, rep_ ? 0 : (PROBE == 13 ? 2 : 1)); }
    xcd_barrier(gb);
    for (int rep_ = 0; rep_ < (PROBE == 7 ? 2 : 1); ++rep_) { phase7a_m(p, bid, nb, lds); }
    xcd_barrier(gb);
    for (int rep_ = 0; rep_ < (PROBE == 8 ? 2 : 1); ++rep_) { phase7b_m(p, bid, nb, lds); }
    xcd_barrier(gb);
    for (int rep_ = (PROBE == 11 ? 0 : 1); rep_ < 2; ++rep_) { phase8(p, bid, nb, rep_ ? p.out : (float*)p.slotB); }
}

extern "C" void kernel_launch(void* const* d_in, const int* in_sizes, int n_in, void* d_out, int out_size, void* d_ws, size_t ws_size, hipStream_t stream) {
    P p{};
    p.x = (const float*)d_in[0]; p.pos = (const int*)d_in[1]; p.g_attn = (const float*)d_in[2]; p.w_in = (const float*)d_in[3]; p.g_cq = (const float*)d_in[4];
    p.w_uq = (const float*)d_in[5]; p.g_ckv = (const float*)d_in[6]; p.w_uk = (const float*)d_in[7]; p.w_uv = (const float*)d_in[8]; p.w_o_attn = (const float*)d_in[9];
    p.sgu_gain = (const float*)d_in[10]; p.sgu_bias = (const float*)d_in[11]; p.w_sp = (const float*)d_in[12]; p.b_sp = (const float*)d_in[13]; p.w_o_sgu = (const float*)d_in[14];
    p.w_out = (const float*)d_in[15]; p.g_ffn = (const float*)d_in[16]; p.w_rg = (const float*)d_in[17]; p.b_rg = (const float*)d_in[18]; p.w_re = (const float*)d_in[19];
    p.b_re = (const float*)d_in[20]; p.w_eg = (const float*)d_in[21]; p.w_eu = (const float*)d_in[22]; p.w_ed = (const float*)d_in[23]; p.g_final = (const float*)d_in[24];
    p.out = (float*)d_out;
    unsigned char* w = (unsigned char*)d_ws; size_t off = 0;
    auto take = [&](size_t bytes) { unsigned char* r = w + off; off += (bytes + 255) & ~(size_t)255; return r; };
    p.bar = (unsigned*)take(XCD_BAR_WORDS * 4);
    p.cnt = (int*)take(4096);
    p.WinT = (bf16_t*)take((size_t)ZP * DM * 2); p.WuqT = (bf16_t*)take(768 * 256 * 2); p.WukT = (bf16_t*)take(512 * 128 * 2); p.WuvT = (bf16_t*)take(512 * 128 * 2);
    p.WoaT = (bf16_t*)take(1024 * 512 * 2); p.WosT = (bf16_t*)take(1024 * 512 * 2); p.WoutT = (bf16_t*)take(1024 * 1024 * 2); p.Wsp = (bf16_t*)take(8 * 128 * 128 * 2);
    p.cs = (float*)take((size_t)NT * 32 * 4); p.cqn = (bf16_t*)take((size_t)NT * 256 * 2); p.ckvn = (bf16_t*)take((size_t)NT * 128 * 2);
    p.list = (int*)take((size_t)NE * NT * 4); p.aw = (float*)take((size_t)2 * NT * 4); p.aexp = (int*)take((size_t)2 * NT * 4);
    p.slotA = (bf16_t*)take((size_t)NT * DM * 2);
    p.slotB = take((size_t)NT * 512 * 4);
    p.slotC = (bf16_t*)take((size_t)NT * 1024 * 2);
    p.slotD = (bf16_t*)take((size_t)NT * 2048 * 2);
    p.slotE = (bf16_t*)take((size_t)NT * NH * 96 * 2);
    p.slotF = (bf16_t*)take((size_t)512 * NT * 2);
    p.slotG = (bf16_t*)take((size_t)NT * 512 * 2);
    if (off > ws_size) { fprintf(stderr, "workspace too small: need %zu have %zu\n", off, ws_size); return; }
#if MK_LAUNCHES == 1
    static int grid_blocks = 0;
    if (!grid_blocks) { int dev = 0, cus = 0, per_cu = 0; hipGetDevice(&dev); hipDeviceGetAttribute(&cus, hipDeviceAttributeMultiprocessorCount, dev);
        hipOccupancyMaxActiveBlocksPerMultiprocessor(&per_cu, k_mega, 256, LDS_BYTES); if (per_cu > 2) per_cu = 2; grid_blocks = cus * per_cu; }
    (void)hipMemsetAsync(p.bar, 0, XCD_BAR_WORDS * 4, stream);
    void* args[] = {&p};
    hipError_t e = hipLaunchCooperativeKernel((void*)k_mega, dim3(grid_blocks), dim3(256), args, LDS_BYTES, stream);
    if (e != hipSuccess) fprintf(stderr, "cooperative launch failed: %s (grid %d)\n", hipGetErrorString(e), grid_blocks);
#else
    for (int ph = 0; ph < 12; ++ph) k_phase<<<2048, 256, LDS_BYTES, stream>>>(p, ph);
#endif
}
```

```cpp
#include <hip/hip_runtime.h>
#include <hip/hip_cooperative_groups.h>
#include <cstdint>
#include <cstdio>
namespace cg = cooperative_groups;

#ifndef ATT_SGB
#define ATT_SGB 1
#endif
#ifndef PROBE
#define PROBE 0
#endif
#ifndef MK_LAUNCHES
#define MK_LAUNCHES 1
#endif

typedef unsigned short bf16_t;
constexpr int NT = 16384, SEQ = 8192, DM = 1024, NBATCH = 2;
constexpr int ZC = 3488;
constexpr int ZP = 3584;
constexpr int NH = 8;
constexpr float EPS = 1e-6f;
constexpr int NE = 32;

struct P {
    const float* x; const int* pos; const float* g_attn; const float* w_in; const float* g_cq; const float* w_uq;
    const float* g_ckv; const float* w_uk; const float* w_uv; const float* w_o_attn; const float* sgu_gain; const float* sgu_bias;
    const float* w_sp; const float* b_sp; const float* w_o_sgu; const float* w_out; const float* g_ffn; const float* w_rg;
    const float* b_rg; const float* w_re; const float* b_re; const float* w_eg; const float* w_eu; const float* w_ed; const float* g_final;
    float* out;
    unsigned* bar;
    int* cnt;
    bf16_t* WinT;
    bf16_t* WuqT;
    bf16_t* WukT;
    bf16_t* WuvT;
    bf16_t* WoaT;
    bf16_t* WosT;
    bf16_t* WoutT;
    bf16_t* Wsp;
    float* cs;
    bf16_t* cqn;
    bf16_t* ckvn;
    int* list;
    float* aw;
    int* aexp;
    bf16_t* slotA;
    unsigned char* slotB;
    bf16_t* slotC;
    bf16_t* slotD;
    bf16_t* slotE;
    bf16_t* slotF;
    bf16_t* slotG;
};

__device__ __forceinline__ int opaque_tid() { int t = threadIdx.x; asm volatile("" : "+v"(t)); return t; }
__device__ __forceinline__ float bf2f(bf16_t v) { return __uint_as_float(((unsigned)v) << 16); }
__device__ __forceinline__ bf16_t f2bf(float f) { unsigned u = __float_as_uint(f); u += 0x7fffu + ((u >> 16) & 1u); return (bf16_t)(u >> 16); }
__device__ __forceinline__ float dot8(const uint4 a, const uint4 b) {
    float s = 0.f;
    s += __uint_as_float(a.x << 16) * __uint_as_float(b.x << 16) + __uint_as_float(a.x & 0xffff0000u) * __uint_as_float(b.x & 0xffff0000u);
    s += __uint_as_float(a.y << 16) * __uint_as_float(b.y << 16) + __uint_as_float(a.y & 0xffff0000u) * __uint_as_float(b.y & 0xffff0000u);
    s += __uint_as_float(a.z << 16) * __uint_as_float(b.z << 16) + __uint_as_float(a.z & 0xffff0000u) * __uint_as_float(b.z & 0xffff0000u);
    s += __uint_as_float(a.w << 16) * __uint_as_float(b.w << 16) + __uint_as_float(a.w & 0xffff0000u) * __uint_as_float(b.w & 0xffff0000u);
    return s;
}
__device__ __forceinline__ float wsum(float v) { for (int o = 32; o > 0; o >>= 1) v += __shfl_xor(v, o); return v; }

#define DPP_F(v, ctrl) __builtin_bit_cast(float, __builtin_amdgcn_update_dpp(0, __builtin_bit_cast(int, (v)), (ctrl), 0xF, 0xF, true))
__device__ __forceinline__ float xrows(float v) {
    { const auto r = __builtin_amdgcn_permlane16_swap(__float_as_uint(v), __float_as_uint(v), false, false); v = __uint_as_float(r[0]) + __uint_as_float(r[1]); }
    { const auto r = __builtin_amdgcn_permlane32_swap(__float_as_uint(v), __float_as_uint(v), false, false); v = __uint_as_float(r[0]) + __uint_as_float(r[1]); }
    return v;
}
__device__ __forceinline__ float wsumf(float v) {
    v += DPP_F(v, 0xB1); v += DPP_F(v, 0x4E); v += DPP_F(v, 0x141); v += DPP_F(v, 0x140); return xrows(v);
}
__device__ __forceinline__ float wsum_par(float v) {
    v += DPP_F(v, 0x128); v += DPP_F(v, 0x124); v += DPP_F(v, 0x122); return xrows(v);
}
__device__ __forceinline__ float wmax(float v) { for (int o = 32; o > 0; o >>= 1) v = fmaxf(v, __shfl_xor(v, o)); return v; }
__device__ __forceinline__ float fsigmoid(float v) { return __builtin_amdgcn_rcpf(1.f + __builtin_amdgcn_exp2f(-1.4426950408889634f * v)); }
__device__ __forceinline__ float fgelu(float v) { const float u2 = 1.5957691216057308f * (v + 0.044715f * v * v * v); return v * fsigmoid(u2); }
__device__ __forceinline__ float gelu_tanh(float v) { const float u = 0.7978845608028654f * (v + 0.044715f * v * v * v); const float t = 1.f - 2.f / (__expf(2.f * u) + 1.f); return 0.5f * v * (1.f + t); }
__device__ __forceinline__ float sigmoidf_(float v) { return 1.f / (1.f + __expf(-v)); }

#define LAS __attribute__((address_space(3)))
typedef short bf16x8 __attribute__((ext_vector_type(8)));
typedef float f32x4 __attribute__((ext_vector_type(4)));
constexpr int GEMM_LDS = 65536;
typedef float f32x16 __attribute__((ext_vector_type(16)));
typedef unsigned u32x2 __attribute__((ext_vector_type(2)));
typedef unsigned u32x4 __attribute__((ext_vector_type(4)));
typedef __bf16 bf16v2 __attribute__((ext_vector_type(2)));
typedef float f32v2 __attribute__((ext_vector_type(2)));
__device__ __forceinline__ unsigned pk2(float lo, float hi) { const f32v2 v = {lo, hi}; return __builtin_bit_cast(unsigned, __builtin_convertvector(v, bf16v2)); }


template <class F>
__device__ __forceinline__ int tconv(bf16_t* dst, int R, int K, F f, int base, int bid, int nb, float* sm) {
    const int tid = opaque_tid(), tk = K / 64, ntile = (R / 64) * tk;
    for (int tile = ((bid - base) % nb + nb) % nb; tile < ntile; tile += nb) {
        const int rho0 = (tile / tk) * 64, k0 = (tile % tk) * 64;
#pragma unroll
        for (int i = 0; i < 16; ++i) { const int kk = (tid >> 6) + 4 * i, rr = tid & 63; sm[kk * 65 + rr] = f(k0 + kk, rho0 + rr); }
        __syncthreads();
#pragma unroll
        for (int i = 0; i < 8; ++i) { const int rr = (tid >> 5) + 8 * i, kk = (tid & 31) * 2;
            *(unsigned*)(dst + (size_t)(rho0 + rr) * K + k0 + kk) = pk2(sm[kk * 65 + rr], sm[(kk + 1) * 65 + rr]); }
        __syncthreads();
    }
    return base + ntile;
}

__device__ void phase0(const P& p, int bid, int nb, float* sm) {
    const int tid = opaque_tid(), lane = tid & 63, wid = tid >> 6;
    const size_t gtid = (size_t)bid * 256 + tid, gsz = (size_t)nb * 256;
    if (bid == 0 && tid < NE) p.cnt[tid] = 0;
    for (int t = bid * 4 + wid; t < NT; t += nb * 4) {
        const float* xr = p.x + (size_t)t * DM; f32x4 v[4]; float ss = 0.f;
#pragma unroll
        for (int i = 0; i < 4; ++i) { v[i] = *(const f32x4*)(xr + (lane + 64 * i) * 4); ss += v[i][0] * v[i][0] + v[i][1] * v[i][1] + v[i][2] * v[i][2] + v[i][3] * v[i][3]; }
        ss = wsumf(ss); const float r = rsqrtf(ss * (1.f / DM) + EPS);
        bf16_t* hr = p.slotA + (size_t)t * DM;
#pragma unroll
        for (int i = 0; i < 4; ++i) { uint2 o; o.x = pk2(v[i][0] * r, v[i][1] * r); o.y = pk2(v[i][2] * r, v[i][3] * r); *(uint2*)(hr + (lane + 64 * i) * 4) = o; }
    }
    int base = 0;
    base = tconv(p.WinT, ZP, DM, [&](int k, int rho) { float v = 0.f;
        if (rho < 416) v = p.w_in[(size_t)k * ZC + rho]; else if (rho >= 512) v = p.w_in[(size_t)k * ZC + rho - 96];
        return v * p.g_attn[k]; }, base, bid, nb, sm);
    const float qscale = 0.10206207261596575f * 1.4426950408889634f;
    base = tconv(p.WuqT, 768, 256, [&](int k, int rho) { int col;
        if (rho < 512) col = (rho >> 6) * 96 + (rho & 63); else { const int hh = (rho - 512) >> 5, w = (rho - 512) & 31; col = hh * 96 + 64 + (w >> 1) + 16 * (w & 1); }
        return p.w_uq[(size_t)k * 768 + col] * p.g_cq[k] * qscale; }, base, bid, nb, sm);
    base = tconv(p.WukT, 512, 128, [&](int k, int c) { return p.w_uk[(size_t)k * 512 + c] * p.g_ckv[k]; }, base, bid, nb, sm);
    base = tconv(p.WuvT, 512, 128, [&](int k, int c) { return p.w_uv[(size_t)k * 512 + c] * p.g_ckv[k]; }, base, bid, nb, sm);
    base = tconv(p.WoaT, 1024, 512, [&](int k, int n) { return p.w_o_attn[(size_t)k * 1024 + n]; }, base, bid, nb, sm);
    base = tconv(p.WosT, 1024, 512, [&](int k, int n) { return p.w_o_sgu[(size_t)k * 1024 + n]; }, base, bid, nb, sm);
    base = tconv(p.WoutT, 1024, 1024, [&](int k, int n) { return p.w_out[(size_t)k * 1024 + n]; }, base, bid, nb, sm);
    for (size_t i = gtid; i < (size_t)8 * 128 * 128; i += gsz) { const int j = (int)(i & 127), ii = (int)((i >> 7) & 127);
        p.Wsp[i] = ((j >> 6) <= (ii >> 6)) ? f2bf(p.w_sp[i]) : (bf16_t)0; }
}

template <class Epi>
__device__ void ngemm(const bf16_t* A, int lda, const bf16_t* Bt, int ldb, int M, int N, int K, Epi epi, int bid, int nb, float* sm) {
    float* As = sm; float* Bs = sm + 16 * 68;
    const int tid = opaque_tid(), ty = tid >> 4, tx = tid & 15; const int tn = N / 64, ntile = (M / 64) * tn;
    for (int tile = bid; tile < ntile; tile += nb) {
        const int row0 = (tile / tn) * 64, col0 = (tile % tn) * 64;
        float acc[4][4];
#pragma unroll
        for (int i = 0; i < 4; ++i)
#pragma unroll
            for (int j = 0; j < 4; ++j) acc[i][j] = 0.f;
        for (int k0 = 0; k0 < K; k0 += 16) {
#pragma unroll
            for (int i = 0; i < 4; ++i) { const int idx = tid + i * 256, r = idx >> 4, kk = idx & 15;
                As[kk * 68 + r] = bf2f(A[(size_t)(row0 + r) * lda + k0 + kk]);
                Bs[kk * 68 + r] = bf2f(Bt[(size_t)(col0 + r) * ldb + k0 + kk]); }
            __syncthreads();
#pragma unroll
            for (int kk = 0; kk < 16; ++kk) { float a[4], b[4];
#pragma unroll
                for (int i = 0; i < 4; ++i) { a[i] = As[kk * 68 + ty * 4 + i]; b[i] = Bs[kk * 68 + tx * 4 + i]; }
#pragma unroll
                for (int i = 0; i < 4; ++i)
#pragma unroll
                    for (int j = 0; j < 4; ++j) acc[i][j] += a[i] * b[j]; }
            __syncthreads();
        }
#pragma unroll
        for (int i = 0; i < 4; ++i) epi(row0 + ty * 4 + i, col0 + tx * 4, acc[i]);
    }
}


__device__ __forceinline__ bool tile_of(int it, int bid, int nb, int RT, int CT, int& rt, int& ct) {
    if ((RT & 31) == 0 && (nb & 7) == 0) {
        const int x = bid & 7, l = bid >> 3, nl = nb >> 3, rpx = RT >> 3; const int lt = l + it * nl; if (lt >= rpx * CT) return false;
        const int rg = lt / (4 * CT), w = lt % (4 * CT); rt = x * rpx + rg * 4 + (w & 3); ct = w >> 2; return true;
    }
    const int tile = bid + it * nb; if (tile >= RT * CT) return false; rt = tile / CT; ct = tile % CT; return true;
}
__device__ __forceinline__ void mg_kloop4(f32x4 (&acc)[4][4], const bf16_t* a0, const bf16_t* a1, const bf16_t* a2, const bf16_t* a3, const bf16_t* bp, size_t bstep, int nk, LAS unsigned char* lds) {
    const int tid = opaque_tid(), lane = tid & 63, wid = tid >> 6, wr = wid >> 1, wc = wid & 1, fr = lane & 15, fq = lane >> 4;
    const int widu = __builtin_amdgcn_readfirstlane(wid);
    auto stage = [&](int t) { LAS unsigned char* d = lds + (t & 1) * 32768 + widu * 1024; const int k0 = t * 64;
        __builtin_amdgcn_global_load_lds((const unsigned*)(a0 + k0), (LAS unsigned*)(d), 16, 0, 0);
        __builtin_amdgcn_global_load_lds((const unsigned*)(a1 + k0), (LAS unsigned*)(d + 4096), 16, 0, 0);
        __builtin_amdgcn_global_load_lds((const unsigned*)(a2 + k0), (LAS unsigned*)(d + 8192), 16, 0, 0);
        __builtin_amdgcn_global_load_lds((const unsigned*)(a3 + k0), (LAS unsigned*)(d + 12288), 16, 0, 0);
#pragma unroll
        for (int i = 0; i < 4; ++i) __builtin_amdgcn_global_load_lds((const unsigned*)(bp + i * bstep + k0), (LAS unsigned*)(d + 16384 + i * 4096), 16, 0, 0); };
    stage(0);
    const int pc0 = ((fq) ^ (fr & 7)) * 16, pc1 = ((4 + fq) ^ (fr & 7)) * 16;
    for (int t = 0; t < nk; ++t) {
        asm volatile("s_waitcnt vmcnt(0)" ::: "memory");
        __syncthreads();
        if (t + 1 < nk) stage(t + 1);
        const LAS unsigned char* ab = lds + (t & 1) * 32768 + (wr * 64 + fr) * 128; const LAS unsigned char* bb = lds + (t & 1) * 32768 + 16384 + (wc * 64 + fr) * 128;
        bf16x8 af[2][4], bfr[2][4];
#pragma unroll
        for (int m = 0; m < 4; ++m) { af[0][m] = *(const LAS bf16x8*)(ab + m * 2048 + pc0); bfr[0][m] = *(const LAS bf16x8*)(bb + m * 2048 + pc0); }
#pragma unroll
        for (int m = 0; m < 4; ++m) { af[1][m] = *(const LAS bf16x8*)(ab + m * 2048 + pc1); bfr[1][m] = *(const LAS bf16x8*)(bb + m * 2048 + pc1); }
        __builtin_amdgcn_sched_barrier(0);
#pragma unroll
        for (int ks = 0; ks < 2; ++ks)
#pragma unroll
            for (int m = 0; m < 4; ++m)
#pragma unroll
                for (int n = 0; n < 4; ++n) acc[m][n] = __builtin_amdgcn_mfma_f32_16x16x32_bf16(bfr[ks][n], af[ks][m], acc[m][n], 0, 0, 0);
    }
    __syncthreads();
}
__device__ __forceinline__ void mg_kloop(f32x4 (&acc)[4][4], const bf16_t* ap, size_t astep  , const bf16_t* bp, size_t bstep, int nk, LAS unsigned char* lds) {
    mg_kloop4(acc, ap, ap + astep, ap + 2 * astep, ap + 3 * astep, bp, bstep, nk, lds);
}
template <class Epi>
__device__ void mgemm(const bf16_t* A, int lda, const bf16_t* Bt, int ldb, int M, int N, int K, Epi epi, int bid, int nb, LAS unsigned char* lds) {
    const int tid = opaque_tid(), lane = tid & 63, wid = tid >> 6, wr = wid >> 1, wc = wid & 1, fr = lane & 15, fq = lane >> 4;
    const int RT = M / 128, CT = N / 128; const int c8 = ((tid & 7) ^ ((tid >> 3) & 7)) * 8;
    int rt, ct;
    for (int it = 0; tile_of(it, bid, nb, RT, CT, rt, ct); ++it) {
        const int row0 = rt * 128, col0 = ct * 128;
        f32x4 acc[4][4];
#pragma unroll
        for (int m = 0; m < 4; ++m)
#pragma unroll
            for (int n = 0; n < 4; ++n) acc[m][n] = (f32x4){0.f, 0.f, 0.f, 0.f};
        mg_kloop(acc, A + (size_t)(row0 + (tid >> 3)) * lda + c8, (size_t)32 * lda, Bt + (size_t)(col0 + (tid >> 3)) * ldb + c8, (size_t)32 * ldb, K / 64, lds);
#pragma unroll
        for (int m = 0; m < 4; ++m)
#pragma unroll
            for (int n = 0; n < 4; ++n) epi(row0 + wr * 64 + m * 16 + fr, col0 + wc * 64 + n * 16 + fq * 4, acc[m][n]);
    }
}

__device__ void phase1(const P& p, int bid, int nb, LAS unsigned char* sm) {
    float* zs = (float*)p.slotB; bf16_t* uvg = p.slotC; bf16_t* gates = p.slotD;
    mgemm(p.slotA, DM, p.WinT, DM, NT, ZP, DM, [=](int t, int c, const f32x4& v) {
        if (c < 512) *(f32x4*)(zs + (size_t)t * 512 + c) = v;
        else if (c < 1536) { uint2 o; o.x = pk2(fgelu(v[0]), fgelu(v[1])); o.y = pk2(fgelu(v[2]), fgelu(v[3])); *(uint2*)(uvg + (size_t)t * 1024 + c - 512) = o; }
        else { uint2 o; o.x = pk2(fsigmoid(v[0]), fsigmoid(v[1])); o.y = pk2(fsigmoid(v[2]), fsigmoid(v[3])); *(uint2*)(gates + (size_t)t * 2048 + c - 1536) = o; }
    }, bid, nb, sm);
}

__device__ void phase2a(const P& p, int bid, int nb, bool dry) {
    const int tid = opaque_tid(), lane = tid & 63, wid = tid >> 6;
    const float* zs = (const float*)p.slotB; bf16_t* K = p.slotE; bf16_t* uvg = p.slotC;
    const f32x4 gn0 = *(const f32x4*)(p.sgu_gain + lane * 8), gn1 = *(const f32x4*)(p.sgu_gain + lane * 8 + 4);
    const f32x4 bs0 = *(const f32x4*)(p.sgu_bias + lane * 8), bs1 = *(const f32x4*)(p.sgu_bias + lane * 8 + 4);
    for (int t = bid * 4 + wid; t < NT; t += nb * 4) {
        const float* z = zs + (size_t)t * 512;
        const f32x4 cq = *(const f32x4*)(z + lane * 4);
        const f32x4 ck = *(const f32x4*)(z + 256 + (lane & 31) * 4);
        bf16_t* vr = uvg + (size_t)t * 1024 + 512 + lane * 8;
        const uint4 vraw = *(const uint4*)vr;
        { const float ss = wsumf(cq[0] * cq[0] + cq[1] * cq[1] + cq[2] * cq[2] + cq[3] * cq[3]); const float r = rsqrtf(ss * (1.f / 256.f) + EPS);
          uint2 o; o.x = pk2(cq[0] * r, cq[1] * r); o.y = pk2(cq[2] * r, cq[3] * r); *(uint2*)(p.cqn + (size_t)t * 256 + lane * 4) = o; }
        { const float ss = wsumf(lane < 32 ? ck[0] * ck[0] + ck[1] * ck[1] + ck[2] * ck[2] + ck[3] * ck[3] : 0.f); const float r = rsqrtf(ss * (1.f / 128.f) + EPS);
          if (lane < 32) { uint2 o; o.x = pk2(ck[0] * r, ck[1] * r); o.y = pk2(ck[2] * r, ck[3] * r); *(uint2*)(p.ckvn + (size_t)t * 128 + lane * 4) = o; } }
        { const int b = t >> 13, sq = t & 8191, hd = lane >> 3, j = lane & 7; const float posf = (float)p.pos[t]; float val[4], tab[4];
#pragma unroll
          for (int q = 0; q < 4; ++q) { const int i = (4 * j + q) & 15;
              float f = (i & 3) == 0 ? 1.0f : (i & 3) == 1 ? 0.5623413251903491f : (i & 3) == 2 ? 0.31622776601683794f : 0.1778279410038923f;
              const int q4 = i >> 2; f *= (q4 == 0 ? 1.0f : q4 == 1 ? 0.1f : q4 == 2 ? 0.01f : 0.001f);
              const float ang = posf * f; const double rev = (double)ang * 0.15915494309189535; const float frc = (float)(rev - floor(rev));
              const float sn = __builtin_amdgcn_sinf(frc), cn = __builtin_amdgcn_cosf(frc);
              const float k1 = z[384 + i], k2 = z[400 + i];
              val[q] = (j < 4) ? (k1 * cn - k2 * sn) : (k1 * sn + k2 * cn); tab[q] = (j < 4) ? cn : sn; }
          uint2 o; o.x = pk2(val[0], val[1]); o.y = pk2(val[2], val[3]);
          *(uint2*)(K + ((size_t)(b * NH + hd) * SEQ + sq) * 96 + 64 + 4 * j) = o;
          if (hd == 0) *(f32x4*)(p.cs + (size_t)t * 32 + 4 * j) = (f32x4){tab[0], tab[1], tab[2], tab[3]}; }
        { float v[8]; const unsigned w[4] = {vraw.x, vraw.y, vraw.z, vraw.w};
#pragma unroll
          for (int i = 0; i < 4; ++i) { v[2 * i] = __uint_as_float(w[i] << 16); v[2 * i + 1] = __uint_as_float(w[i] & 0xffff0000u); }
          float sm_ = 0.f;
#pragma unroll
          for (int i = 0; i < 8; ++i) sm_ += v[i];
          sm_ = wsumf(sm_); const float mu = sm_ * (1.f / 512.f); float q = 0.f;
#pragma unroll
          for (int i = 0; i < 8; ++i) { const float d = v[i] - mu; q += d * d; }
          q = wsumf(q); const float r = rsqrtf(q * (1.f / 512.f) + EPS);
          uint4 o;
          o.x = pk2((v[0] - mu) * r * gn0[0] + bs0[0], (v[1] - mu) * r * gn0[1] + bs0[1]); o.y = pk2((v[2] - mu) * r * gn0[2] + bs0[2], (v[3] - mu) * r * gn0[3] + bs0[3]);
          o.z = pk2((v[4] - mu) * r * gn1[0] + bs1[0], (v[5] - mu) * r * gn1[1] + bs1[1]); o.w = pk2((v[6] - mu) * r * gn1[2] + bs1[2], (v[7] - mu) * r * gn1[3] + bs1[3]);
          *(uint4*)(dry ? p.slotG + (size_t)t * 512 + lane * 8 : vr) = o; }
    }
}

__device__ void phase2b(const P& p, int bid, int nb, LAS unsigned char* sm) {
    bf16_t* Q = p.slotA; bf16_t* K = p.slotE; bf16_t* VT = p.slotF; const float* cs = p.cs;
    mgemm(p.cqn, 256, p.WuqT, 256, NT, 768, 256, [=](int t, int c, const f32x4& v) {
        const int b = t >> 13, s = t & 8191;
        if (c < 512) { const int h = c >> 6, d = c & 63; uint2 o; o.x = pk2(v[0], v[1]); o.y = pk2(v[2], v[3]); *(uint2*)(Q + ((size_t)(b * NH + h) * SEQ + s) * 96 + d) = o; }
        else { const int h = (c - 512) >> 5, i0 = ((c - 512) & 31) >> 1; bf16_t* q = Q + ((size_t)(b * NH + h) * SEQ + s) * 96;
            const float2 cn = *(const float2*)(cs + (size_t)t * 32 + i0), sn = *(const float2*)(cs + (size_t)t * 32 + 16 + i0);
            *(unsigned*)(q + 64 + i0) = pk2(v[0] * cn.x - v[1] * sn.x, v[2] * cn.y - v[3] * sn.y);
            *(unsigned*)(q + 80 + i0) = pk2(v[0] * sn.x + v[1] * cn.x, v[2] * sn.y + v[3] * cn.y); }
    }, bid, nb, sm);
    mgemm(p.ckvn, 128, p.WukT, 128, NT, 512, 128, [=](int t, int c, const f32x4& v) {
        const int b = t >> 13, s = t & 8191, h = c >> 6, d = c & 63; uint2 o; o.x = pk2(v[0], v[1]); o.y = pk2(v[2], v[3]);
        *(uint2*)(K + ((size_t)(b * NH + h) * SEQ + s) * 96 + d) = o;
    }, bid, nb, sm);
    mgemm(p.WuvT, 128, p.ckvn, 128, 512, NT, 128, [=](int r, int t, const f32x4& v) {
        uint2 o; o.x = pk2(v[0], v[1]); o.y = pk2(v[2], v[3]); *(uint2*)(VT + (size_t)r * NT + t) = o;
    }, bid, nb, sm);
}

__device__ void phase2c(const P& p, int bid, int nb) {
    const bf16_t* uvg = p.slotC; bf16_t* su = p.slotG;
    for (size_t i = (size_t)bid * 256 + threadIdx.x; i < (size_t)NT * 512; i += (size_t)nb * 256) {
        const int t = (int)(i >> 9), c = (int)(i & 511), g = c >> 6, ii = t & 127, t0 = t - ii;
        const bf16_t* w = p.Wsp + ((size_t)g * 128 + ii) * 128; float s = 0.f;
        for (int j = 0; j < 128; ++j) s += bf2f(w[j]) * bf2f(uvg[(size_t)(t0 + j) * 1024 + 512 + c]);
        s += p.b_sp[g * 128 + ii];
        su[i] = f2bf(bf2f(uvg[(size_t)t * 1024 + c]) * s);
    }
}


__device__ void phase2c_m(const P& p, int bid, int nb, LAS unsigned char* lds) {
    const bf16_t* uvg = p.slotC; bf16_t* su = p.slotG;
    const int tid = opaque_tid(), lane = tid & 63, wid = tid >> 6, fr = lane & 15, fq = lane >> 4;
    const int c8 = ((tid & 7) ^ ((tid >> 3) & 7)) * 8;
    for (int u = bid; u < 1024; u += nb) {
        const int g = u & 7, t0 = (u >> 3) * 128;
        { const bf16_t* wp = p.Wsp + ((size_t)g * 128 + (tid >> 3)) * 128 + c8; LAS unsigned char* d = lds + tid * 16;
#pragma unroll
          for (int ks = 0; ks < 2; ++ks)
#pragma unroll
              for (int i = 0; i < 4; ++i) __builtin_amdgcn_global_load_lds((const unsigned*)(wp + (size_t)i * 32 * 128 + ks * 64), (LAS unsigned*)(d + ks * 16384 + i * 4096), 16, 0, 0); }
#pragma unroll
        for (int i = 0; i < 4; ++i) { const int q = tid + 256 * i, j = q >> 3, c0 = (q & 7) * 8;
            const uint4 v = *(const uint4*)(uvg + (size_t)(t0 + j) * 1024 + 512 + g * 64 + c0);
            const unsigned w[4] = {v.x, v.y, v.z, v.w};
            LAS unsigned char* bimg = lds + 32768 + (j >> 6) * 8192 + (j & 7) * 2; const int lc = (j & 63) >> 3;
#pragma unroll
            for (int e = 0; e < 8; ++e) { const int row = c0 + e; const bf16_t val = (bf16_t)((e & 1) ? (w[e >> 1] >> 16) : (w[e >> 1] & 0xffffu));
                *(LAS bf16_t*)(bimg + row * 128 + ((lc ^ (row & 7)) * 16)) = val; } }
        asm volatile("s_waitcnt vmcnt(0)" ::: "memory");
        __syncthreads();
        f32x4 acc[2][4];
#pragma unroll
        for (int m = 0; m < 2; ++m)
#pragma unroll
            for (int n = 0; n < 4; ++n) acc[m][n] = (f32x4){0.f, 0.f, 0.f, 0.f};
#pragma unroll
        for (int ks = 0; ks < 2; ++ks)
#pragma unroll
            for (int k2 = 0; k2 < 2; ++k2) { const int pc = ((k2 * 4 + fq) ^ (fr & 7)) * 16; bf16x8 af[2], bfr[4];
#pragma unroll
                for (int m = 0; m < 2; ++m) af[m] = *(const LAS bf16x8*)(lds + ks * 16384 + (wid * 32 + m * 16 + fr) * 128 + pc);
#pragma unroll
                for (int n = 0; n < 4; ++n) bfr[n] = *(const LAS bf16x8*)(lds + 32768 + ks * 8192 + (n * 16 + fr) * 128 + pc);
#pragma unroll
                for (int m = 0; m < 2; ++m)
#pragma unroll
                    for (int n = 0; n < 4; ++n) acc[m][n] = __builtin_amdgcn_mfma_f32_16x16x32_bf16(bfr[n], af[m], acc[m][n], 0, 0, 0); }
#pragma unroll
        for (int m = 0; m < 2; ++m) { const int i = wid * 32 + m * 16 + fr; const float bs = p.b_sp[g * 128 + i];
#pragma unroll
            for (int n = 0; n < 4; ++n) { const int c = g * 64 + n * 16 + fq * 4;
                const uint2 uu = *(const uint2*)(uvg + (size_t)(t0 + i) * 1024 + c);
                uint2 o; o.x = pk2(__uint_as_float(uu.x << 16) * (acc[m][n][0] + bs), __uint_as_float(uu.x & 0xffff0000u) * (acc[m][n][1] + bs));
                o.y = pk2(__uint_as_float(uu.y << 16) * (acc[m][n][2] + bs), __uint_as_float(uu.y & 0xffff0000u) * (acc[m][n][3] + bs));
                *(uint2*)(su + (size_t)(t0 + i) * 512 + c) = o; } }
        __syncthreads();
    }
}

__device__ void phase3(const P& p, int bid, int nb, float* sm) {
    float* sc = sm; float* qs = sm + 8192; float* red = qs + 96;
    const bf16_t* Q = p.slotA; const bf16_t* K = p.slotE; const bf16_t* VT = p.slotF; bf16_t* O = (bf16_t*)p.slotB;
    const int tid = opaque_tid();
    for (int row = bid; row < NBATCH * NH * SEQ; row += nb) {
        const int q = row % SEQ, bh = row / SEQ, nk = ((q >> 6) + 1) * 64;
        if (tid < 12) ((uint4*)qs)[tid] = ((const uint4*)(Q + ((size_t)bh * SEQ + q) * 96))[tid];
        __syncthreads();
        float mx = -1e30f;
        for (int k = tid; k < nk; k += 256) { const uint4* kp = (const uint4*)(K + ((size_t)bh * SEQ + k) * 96); float s = 0.f;
#pragma unroll
            for (int d = 0; d < 12; ++d) s += dot8(((const uint4*)qs)[d], kp[d]);
            sc[k] = s; mx = fmaxf(mx, s); }
        mx = wmax(mx); if ((tid & 63) == 0) red[tid >> 6] = mx; __syncthreads();
        mx = fmaxf(fmaxf(red[0], red[1]), fmaxf(red[2], red[3])); __syncthreads();
        float sum = 0.f;
        for (int k = tid; k < nk; k += 256) { const float e = exp2f(sc[k] - mx); sc[k] = e; sum += e; }
        sum = wsum(sum); if ((tid & 63) == 0) red[tid >> 6] = sum; __syncthreads();
        sum = (red[0] + red[1]) + (red[2] + red[3]);
        const int dv = tid >> 2, part = tid & 3, h = bh & 7, b = bh >> 3;
        const bf16_t* vp = VT + (size_t)(h * 64 + dv) * NT + (size_t)b * SEQ; float o = 0.f;
        for (int k = part; k < nk; k += 4) o += sc[k] * bf2f(vp[k]);
        o += __shfl_xor(o, 1); o += __shfl_xor(o, 2);
        if (part == 0) O[(size_t)(b * SEQ + q) * 512 + h * 64 + dv] = f2bf(o / sum);
        __syncthreads();
    }
}


constexpr int ATT_BUF = 20480;
template <int VAR>
__device__ void phase3m(const P& p, int bid, int nb, LAS unsigned char* lds) {
    const bf16_t* Q = p.slotA; const bf16_t* K = p.slotE; const bf16_t* VT = p.slotF; bf16_t* O = (VAR == 0) ? (bf16_t*)p.slotB : p.slotC;
    const int tid = opaque_tid(), lane = tid & 63, wid = tid >> 6, l31 = lane & 31, hh = lane >> 5;
    int koff[3]; size_t voff[2];
#pragma unroll
    for (int i = 0; i < 3; ++i) { const int s = tid + 256 * i, r = s / 12, pc = s % 12, c = (pc + 12 - ((r >> 2) & 3)) % 12; koff[i] = r * 96 + c * 8; }
#pragma unroll
    for (int i = 0; i < 2; ++i) { const int s = tid + 256 * i, dv = s >> 3, pc = s & 7, cl = pc ^ ((dv >> 1) & 7); voff[i] = (size_t)dv * NT + cl * 8; }
    int kro[6];
#pragma unroll
    for (int ks = 0; ks < 6; ++ks) { const int v = 2 * ks + hh + ((lane >> 2) & 3); kro[ks] = (v >= 12 ? v - 12 : v) * 16; }
    const int krow = l31 * 192, vsw = (lane >> 1) & 7, vrow = l31 * 128 + 8 * hh;
    for (int iu = 0;; ++iu) {
        const int r = iu * nb + ((iu & 1) ? nb - 1 - bid : bid); if (r >= 1024) break;
        const int qb = 63 - (r >> 4), bh = r & 15, b = bh >> 3, h = bh & 7;
        const int q0 = qb * 128 + wid * 32, ntw = (q0 >> 6) + 1, nt = 2 * qb + 2;
        const bf16_t* Kb = K + (size_t)bh * SEQ * 96; const bf16_t* Vb = VT + (size_t)(h * 64) * NT + (size_t)b * SEQ;
        bf16x8 qf[6]; { const bf16_t* qp = Q + ((size_t)bh * SEQ + q0 + l31) * 96 + hh * 8;
#pragma unroll
            for (int ks = 0; ks < 6; ++ks) qf[ks] = *(const bf16x8*)(qp + ks * 16); }
        f32x16 o0, o1;
#pragma unroll
        for (int e = 0; e < 16; ++e) { o0[e] = 0.f; o1[e] = 0.f; }
        float mrun = -1e30f, lsum = 0.f;
        auto stage = [&](int j) { LAS unsigned char* d = lds + (j & 1) * ATT_BUF + tid * 16; const bf16_t* kt = Kb + (size_t)j * 64 * 96; const bf16_t* vt = Vb + j * 64;
#pragma unroll
            for (int i = 0; i < 3; ++i) __builtin_amdgcn_global_load_lds((const unsigned*)(kt + koff[i]), (LAS unsigned*)(d + i * 4096), 16, 0, 0);
#pragma unroll
            for (int i = 0; i < 2; ++i) __builtin_amdgcn_global_load_lds((const unsigned*)(vt + voff[i]), (LAS unsigned*)(d + 12288 + i * 4096), 16, 0, 0); };
        if (VAR != 3) stage(0);
        for (int j = 0; j < nt; ++j) {
            asm volatile("s_waitcnt vmcnt(0)" ::: "memory");
            __syncthreads();
            if (VAR != 3 && j + 1 < nt) stage(j + 1);
            if (j < ntw) {
                const LAS unsigned char* kb_ = lds + (j & 1) * ATT_BUF + krow; const LAS unsigned char* vb_ = lds + (j & 1) * ATT_BUF + 12288 + vrow;
                f32x16 s0, s1;
#pragma unroll
                for (int e = 0; e < 16; ++e) { s0[e] = 0.f; s1[e] = 0.f; }
#pragma unroll
                for (int ks = 0; ks < 6; ++ks) { const bf16x8 k0 = *(const LAS bf16x8*)(kb_ + kro[ks]); const bf16x8 k1 = *(const LAS bf16x8*)(kb_ + 32 * 192 + kro[ks]);
                    if (VAR != 2) { s0 = __builtin_amdgcn_mfma_f32_32x32x16_bf16(k0, qf[ks], s0, 0, 0, 0); s1 = __builtin_amdgcn_mfma_f32_32x32x16_bf16(k1, qf[ks], s1, 0, 0, 0); }
                    else { s0[ks] += __builtin_bit_cast(float, (int)k0[0]) + __builtin_bit_cast(float, (int)qf[ks][1]); s1[ks] += __builtin_bit_cast(float, (int)k1[0]); } }
                if (VAR != 1) {
                float mx = fmaxf(s0[0], s1[0]);
#pragma unroll
                for (int e = 1; e < 16; ++e) mx = fmaxf(mx, fmaxf(s0[e], s1[e]));
                mx = fmaxf(mx, __shfl_xor(mx, 32));
                const float mn = fmaxf(mrun, mx), alpha = __builtin_amdgcn_exp2f(mrun - mn); mrun = mn;
                float ps = 0.f;
#pragma unroll
                for (int e = 0; e < 16; ++e) { s0[e] = __builtin_amdgcn_exp2f(s0[e] - mn); s1[e] = __builtin_amdgcn_exp2f(s1[e] - mn); ps += s0[e] + s1[e]; }
                lsum = lsum * alpha + ps;
#pragma unroll
                for (int e = 0; e < 16; ++e) { o0[e] *= alpha; o1[e] *= alpha; }
                }
                unsigned pw[16];
#pragma unroll
                for (int e = 0; e < 8; ++e) { pw[e] = pk2(s0[2 * e], s0[2 * e + 1]); pw[8 + e] = pk2(s1[2 * e], s1[2 * e + 1]); }
#pragma unroll
                for (int s = 0; s < 4; ++s) {
                    const u32x4 pbu = {pw[4 * s], pw[4 * s + 1], pw[4 * s + 2], pw[4 * s + 3]}; const bf16x8 pb = __builtin_bit_cast(bf16x8, pbu);
                    const int c0 = ((2 * s) ^ vsw) * 16, c1 = ((2 * s + 1) ^ vsw) * 16;
                    const u32x2 a0 = *(const LAS u32x2*)(vb_ + c0), a1 = *(const LAS u32x2*)(vb_ + c1);
                    const u32x2 b0 = *(const LAS u32x2*)(vb_ + 32 * 128 + c0), b1 = *(const LAS u32x2*)(vb_ + 32 * 128 + c1);
                    const u32x4 va = {a0.x, a0.y, a1.x, a1.y}, vb = {b0.x, b0.y, b1.x, b1.y};
                    if (VAR != 2) { o0 = __builtin_amdgcn_mfma_f32_32x32x16_bf16(__builtin_bit_cast(bf16x8, va), pb, o0, 0, 0, 0);
                    o1 = __builtin_amdgcn_mfma_f32_32x32x16_bf16(__builtin_bit_cast(bf16x8, vb), pb, o1, 0, 0, 0); }
                    else { o0[s] += __builtin_bit_cast(float, va[0] ^ pbu[0]); o1[s] += __builtin_bit_cast(float, vb[1] ^ pbu[1]); }
                }
            }
        }
        const float inv = 1.f / (lsum + __shfl_xor(lsum, 32));
        bf16_t* op = O + (size_t)(b * SEQ + q0 + l31) * 512 + h * 64 + 4 * hh;
#pragma unroll
        for (int g = 0; g < 4; ++g) { uint2 w0, w1;
            w0.x = pk2(o0[4 * g] * inv, o0[4 * g + 1] * inv); w0.y = pk2(o0[4 * g + 2] * inv, o0[4 * g + 3] * inv);
            w1.x = pk2(o1[4 * g] * inv, o1[4 * g + 1] * inv); w1.y = pk2(o1[4 * g + 2] * inv, o1[4 * g + 3] * inv);
            *(uint2*)(op + 8 * g) = w0; *(uint2*)(op + 32 + 8 * g) = w1; }
        __syncthreads();
    }
}


template <int DUMMY>
__device__ void phase3p(const P& p, int bid, int nb, LAS unsigned char* lds) {
    const bf16_t* Q = p.slotA; const bf16_t* K = p.slotE; const bf16_t* VT = p.slotF; bf16_t* O = (DUMMY == 0) ? (bf16_t*)p.slotB : p.slotC;
    const int tid = opaque_tid(), lane = tid & 63, wid = tid >> 6, l31 = lane & 31, hh = lane >> 5;
    constexpr float THR = 8.f;
    int koff[3]; size_t voff[2];
#pragma unroll
    for (int i = 0; i < 3; ++i) { const int s = tid + 256 * i, r = s / 12, pc = s % 12, c = (pc + 12 - ((r >> 2) & 3)) % 12; koff[i] = r * 96 + c * 8; }
#pragma unroll
    for (int i = 0; i < 2; ++i) { const int s = tid + 256 * i, dv = s >> 3, pc = s & 7, cl = pc ^ ((dv >> 1) & 7); voff[i] = (size_t)dv * NT + cl * 8; }
    int kro[6];
#pragma unroll
    for (int ks = 0; ks < 6; ++ks) { const int v = 2 * ks + hh + ((lane >> 2) & 3); kro[ks] = (v >= 12 ? v - 12 : v) * 16; }
    const int krow = l31 * 192, vsw = (lane >> 1) & 7, vrow = l31 * 128 + 8 * hh;
    for (int iu = 0;; ++iu) {
        const int r = iu * nb + ((iu & 1) ? nb - 1 - bid : bid); if (r >= 1024) break;
        const int qb = 63 - (r >> 4), bh = r & 15, b = bh >> 3, h = bh & 7;
        const int q0 = qb * 128 + wid * 32, ntw = (q0 >> 6) + 1, nt = 2 * qb + 2;
        const bf16_t* Kb = K + (size_t)bh * SEQ * 96; const bf16_t* Vb = VT + (size_t)(h * 64) * NT + (size_t)b * SEQ;
        bf16x8 qf[6]; { const bf16_t* qp = Q + ((size_t)bh * SEQ + q0 + l31) * 96 + hh * 8;
#pragma unroll
            for (int ks = 0; ks < 6; ++ks) qf[ks] = *(const bf16x8*)(qp + ks * 16); }
        f32x16 o0, o1;
#pragma unroll
        for (int e = 0; e < 16; ++e) { o0[e] = 0.f; o1[e] = 0.f; }
        float mrun = -1e30f, lsum = 0.f;
        auto stageK = [&](int j) { LAS unsigned char* d = lds + (j & 1) * 12288 + tid * 16; const bf16_t* kt = Kb + (size_t)j * 64 * 96;
#pragma unroll
            for (int i = 0; i < 3; ++i) __builtin_amdgcn_global_load_lds((const unsigned*)(kt + koff[i]), (LAS unsigned*)(d + i * 4096), 16, 0, 0); };
        auto stageV = [&](int j) { LAS unsigned char* d = lds + 24576 + (j & 1) * 8192 + tid * 16; const bf16_t* vt = Vb + j * 64;
#pragma unroll
            for (int i = 0; i < 2; ++i) __builtin_amdgcn_global_load_lds((const unsigned*)(vt + voff[i]), (LAS unsigned*)(d + i * 4096), 16, 0, 0); };
        auto qk = [&](f32x16& a, f32x16& bq, int buf) { const LAS unsigned char* kb_ = lds + buf * 12288 + krow;
#pragma unroll
            for (int e = 0; e < 16; ++e) { a[e] = 0.f; bq[e] = 0.f; }
#pragma unroll
            for (int ks = 0; ks < 6; ++ks) { const bf16x8 k0 = *(const LAS bf16x8*)(kb_ + kro[ks]); const bf16x8 k1 = *(const LAS bf16x8*)(kb_ + 32 * 192 + kro[ks]);
                a = __builtin_amdgcn_mfma_f32_32x32x16_bf16(k0, qf[ks], a, 0, 0, 0); bq = __builtin_amdgcn_mfma_f32_32x32x16_bf16(k1, qf[ks], bq, 0, 0, 0); } };
        auto rowmax = [&](const f32x16& a, const f32x16& bq) { float m = fmaxf(a[0], bq[0]);
#pragma unroll
            for (int e = 1; e < 16; ++e) m = fmaxf(fmaxf(m, a[e]), bq[e]);
            return fmaxf(m, __shfl_xor(m, 32)); };
        f32x16 sA0, sA1, sB0, sB1; float mxA, mxB = 0.f;
        stageK(0); stageK(1); stageV(0);
        asm volatile("s_waitcnt vmcnt(0)" ::: "memory");
        __syncthreads();
        qk(sA0, sA1, 0); mxA = rowmax(sA0, sA1);
        auto step = [&](f32x16& c0, f32x16& c1, float& mxc, f32x16& n0, f32x16& n1, float& mxn, int j) {
            asm volatile("s_waitcnt vmcnt(0)" ::: "memory");
            __syncthreads();
            if (j + 2 < nt) stageK(j + 2);
            if (j + 1 < nt) stageV(j + 1);
            if (j < ntw) {
                if (!__all(mxc <= mrun + THR)) { const float mn = fmaxf(mrun, mxc), alpha = __builtin_amdgcn_exp2f(mrun - mn); mrun = mn; lsum *= alpha;
#pragma unroll
                    for (int e = 0; e < 16; ++e) { o0[e] *= alpha; o1[e] *= alpha; } }
                qk(n0, n1, (j + 1) & 1);
                float ps = 0.f;
#pragma unroll
                for (int e = 0; e < 16; ++e) { c0[e] = __builtin_amdgcn_exp2f(c0[e] - mrun); c1[e] = __builtin_amdgcn_exp2f(c1[e] - mrun); ps += c0[e] + c1[e]; }
                lsum += ps;
                unsigned pw[16];
#pragma unroll
                for (int e = 0; e < 8; ++e) { pw[e] = pk2(c0[2 * e], c0[2 * e + 1]); pw[8 + e] = pk2(c1[2 * e], c1[2 * e + 1]); }
                const LAS unsigned char* vb_ = lds + 24576 + (j & 1) * 8192 + vrow;
#pragma unroll
                for (int s = 0; s < 4; ++s) {
                    const u32x4 pbu = {pw[4 * s], pw[4 * s + 1], pw[4 * s + 2], pw[4 * s + 3]}; const bf16x8 pb = __builtin_bit_cast(bf16x8, pbu);
                    const int c0_ = ((2 * s) ^ vsw) * 16, c1_ = ((2 * s + 1) ^ vsw) * 16;
                    const u32x2 a0 = *(const LAS u32x2*)(vb_ + c0_), a1 = *(const LAS u32x2*)(vb_ + c1_);
                    const u32x2 b0 = *(const LAS u32x2*)(vb_ + 32 * 128 + c0_), b1 = *(const LAS u32x2*)(vb_ + 32 * 128 + c1_);
                    const u32x4 va = {a0.x, a0.y, a1.x, a1.y}, vb = {b0.x, b0.y, b1.x, b1.y};
                    o0 = __builtin_amdgcn_mfma_f32_32x32x16_bf16(__builtin_bit_cast(bf16x8, va), pb, o0, 0, 0, 0);
                    o1 = __builtin_amdgcn_mfma_f32_32x32x16_bf16(__builtin_bit_cast(bf16x8, vb), pb, o1, 0, 0, 0);
                }
                mxn = rowmax(n0, n1);
#if ATT_SGB
#pragma unroll
                for (int g_ = 0; g_ < 20; ++g_) { __builtin_amdgcn_sched_group_barrier(0x008, 1, 0); __builtin_amdgcn_sched_group_barrier(0x100, 2, 0); __builtin_amdgcn_sched_group_barrier(0x002, 7, 0); }
#endif
            }
        };
        for (int j = 0; j < nt; j += 2) { step(sA0, sA1, mxA, sB0, sB1, mxB, j); step(sB0, sB1, mxB, sA0, sA1, mxA, j + 1); }
        const float inv = 1.f / (lsum + __shfl_xor(lsum, 32));
        bf16_t* op = O + (size_t)(b * SEQ + q0 + l31) * 512 + h * 64 + 4 * hh;
#pragma unroll
        for (int g = 0; g < 4; ++g) { uint2 w0, w1;
            w0.x = pk2(o0[4 * g] * inv, o0[4 * g + 1] * inv); w0.y = pk2(o0[4 * g + 2] * inv, o0[4 * g + 3] * inv);
            w1.x = pk2(o1[4 * g] * inv, o1[4 * g + 1] * inv); w1.y = pk2(o1[4 * g + 2] * inv, o1[4 * g + 3] * inv);
            *(uint2*)(op + 8 * g) = w0; *(uint2*)(op + 32 + 8 * g) = w1; }
        __syncthreads();
    }
}

template <int VAR>
__device__ __forceinline__ void att_step(const LAS unsigned char* kb_, const LAS unsigned char* vb_, const int kt16, const int k4o, const int k5o, const int vsw, const bf16x8 (&qf)[6],
                                         f32x16& c0, f32x16& c1, f32x16& n0, f32x16& n1, const unsigned (&pwc)[16], unsigned (&pwn)[16], f32x16& o0, f32x16& o1,
                                         const float mrun, float& ps, float& mxn) {
    f32x16 zero16;
#pragma unroll
    for (int e = 0; e < 16; ++e) zero16[e] = 0.f;
    if constexpr (VAR == 0) {
        bf16x8 kf0, kf1, kf2;
        kf0 = *(const LAS bf16x8*)(kb_ + 0*32*192 + kt16 + 0); kf1 = *(const LAS bf16x8*)(kb_ + 1*32*192 + kt16 + 0);
        float mxl;
        kf2 = *(const LAS bf16x8*)(kb_ + 0*32*192 + kt16 + 32);
        n0 = __builtin_amdgcn_mfma_f32_32x32x16_bf16(kf0, qf[0], zero16, 0, 0, 0);
        c0[0] = __builtin_amdgcn_exp2f(c0[0] - mrun); ps += c0[0]; c0[1] = __builtin_amdgcn_exp2f(c0[1] - mrun); ps += c0[1]; pwn[0] = pk2(c0[0], c0[1]);
        __builtin_amdgcn_sched_barrier(0);
        kf0 = *(const LAS bf16x8*)(kb_ + 1*32*192 + kt16 + 32);
        n1 = __builtin_amdgcn_mfma_f32_32x32x16_bf16(kf1, qf[0], zero16, 0, 0, 0);
        c0[2] = __builtin_amdgcn_exp2f(c0[2] - mrun); ps += c0[2]; c0[3] = __builtin_amdgcn_exp2f(c0[3] - mrun); ps += c0[3]; pwn[1] = pk2(c0[2], c0[3]);
        __builtin_amdgcn_sched_barrier(0);
        kf1 = *(const LAS bf16x8*)(kb_ + 0*32*192 + kt16 + 64);
        n0 = __builtin_amdgcn_mfma_f32_32x32x16_bf16(kf2, qf[1], n0, 0, 0, 0);
        c0[4] = __builtin_amdgcn_exp2f(c0[4] - mrun); ps += c0[4]; c0[5] = __builtin_amdgcn_exp2f(c0[5] - mrun); ps += c0[5]; pwn[2] = pk2(c0[4], c0[5]);
        __builtin_amdgcn_sched_barrier(0);
        kf2 = *(const LAS bf16x8*)(kb_ + 1*32*192 + kt16 + 64);
        n1 = __builtin_amdgcn_mfma_f32_32x32x16_bf16(kf0, qf[1], n1, 0, 0, 0);
        c0[6] = __builtin_amdgcn_exp2f(c0[6] - mrun); ps += c0[6]; c0[7] = __builtin_amdgcn_exp2f(c0[7] - mrun); ps += c0[7]; pwn[3] = pk2(c0[6], c0[7]);
        __builtin_amdgcn_sched_barrier(0);
        kf0 = *(const LAS bf16x8*)(kb_ + 0*32*192 + kt16 + 96);
        n0 = __builtin_amdgcn_mfma_f32_32x32x16_bf16(kf1, qf[2], n0, 0, 0, 0);
        c0[8] = __builtin_amdgcn_exp2f(c0[8] - mrun); ps += c0[8]; c0[9] = __builtin_amdgcn_exp2f(c0[9] - mrun); ps += c0[9]; pwn[4] = pk2(c0[8], c0[9]);
        __builtin_amdgcn_sched_barrier(0);
        kf1 = *(const LAS bf16x8*)(kb_ + 1*32*192 + kt16 + 96);
        n1 = __builtin_amdgcn_mfma_f32_32x32x16_bf16(kf2, qf[2], n1, 0, 0, 0);
        c0[10] = __builtin_amdgcn_exp2f(c0[10] - mrun); ps += c0[10]; c0[11] = __builtin_amdgcn_exp2f(c0[11] - mrun); ps += c0[11]; pwn[5] = pk2(c0[10], c0[11]);
        __builtin_amdgcn_sched_barrier(0);
        kf2 = *(const LAS bf16x8*)(kb_ + 0*32*192 + k4o);
        n0 = __builtin_amdgcn_mfma_f32_32x32x16_bf16(kf0, qf[3], n0, 0, 0, 0);
        c0[12] = __builtin_amdgcn_exp2f(c0[12] - mrun); ps += c0[12]; c0[13] = __builtin_amdgcn_exp2f(c0[13] - mrun); ps += c0[13]; pwn[6] = pk2(c0[12], c0[13]);
        __builtin_amdgcn_sched_barrier(0);
        kf0 = *(const LAS bf16x8*)(kb_ + 1*32*192 + k4o);
        n1 = __builtin_amdgcn_mfma_f32_32x32x16_bf16(kf1, qf[3], n1, 0, 0, 0);
        c0[14] = __builtin_amdgcn_exp2f(c0[14] - mrun); ps += c0[14]; c0[15] = __builtin_amdgcn_exp2f(c0[15] - mrun); ps += c0[15]; pwn[7] = pk2(c0[14], c0[15]);
        __builtin_amdgcn_sched_barrier(0);
        kf1 = *(const LAS bf16x8*)(kb_ + 0*32*192 + k5o);
        n0 = __builtin_amdgcn_mfma_f32_32x32x16_bf16(kf2, qf[4], n0, 0, 0, 0);
        c1[0] = __builtin_amdgcn_exp2f(c1[0] - mrun); ps += c1[0]; c1[1] = __builtin_amdgcn_exp2f(c1[1] - mrun); ps += c1[1]; pwn[8] = pk2(c1[0], c1[1]);
        __builtin_amdgcn_sched_barrier(0);
        kf2 = *(const LAS bf16x8*)(kb_ + 1*32*192 + k5o);
        n1 = __builtin_amdgcn_mfma_f32_32x32x16_bf16(kf0, qf[4], n1, 0, 0, 0);
        c1[2] = __builtin_amdgcn_exp2f(c1[2] - mrun); ps += c1[2]; c1[3] = __builtin_amdgcn_exp2f(c1[3] - mrun); ps += c1[3]; pwn[9] = pk2(c1[2], c1[3]);
        __builtin_amdgcn_sched_barrier(0);
        n0 = __builtin_amdgcn_mfma_f32_32x32x16_bf16(kf1, qf[5], n0, 0, 0, 0);
        c1[4] = __builtin_amdgcn_exp2f(c1[4] - mrun); ps += c1[4]; c1[5] = __builtin_amdgcn_exp2f(c1[5] - mrun); ps += c1[5]; pwn[10] = pk2(c1[4], c1[5]);
        __builtin_amdgcn_sched_barrier(0);
        n1 = __builtin_amdgcn_mfma_f32_32x32x16_bf16(kf2, qf[5], n1, 0, 0, 0);
        c1[6] = __builtin_amdgcn_exp2f(c1[6] - mrun); ps += c1[6]; c1[7] = __builtin_amdgcn_exp2f(c1[7] - mrun); ps += c1[7]; pwn[11] = pk2(c1[6], c1[7]);
        __builtin_amdgcn_sched_barrier(0);
        c1[8] = __builtin_amdgcn_exp2f(c1[8] - mrun); ps += c1[8]; c1[9] = __builtin_amdgcn_exp2f(c1[9] - mrun); ps += c1[9]; pwn[12] = pk2(c1[8], c1[9]);
        __builtin_amdgcn_sched_barrier(0);
        c1[10] = __builtin_amdgcn_exp2f(c1[10] - mrun); ps += c1[10]; c1[11] = __builtin_amdgcn_exp2f(c1[11] - mrun); ps += c1[11]; pwn[13] = pk2(c1[10], c1[11]);
        __builtin_amdgcn_sched_barrier(0);
        c1[12] = __builtin_amdgcn_exp2f(c1[12] - mrun); ps += c1[12]; c1[13] = __builtin_amdgcn_exp2f(c1[13] - mrun); ps += c1[13]; pwn[14] = pk2(c1[12], c1[13]);
        __builtin_amdgcn_sched_barrier(0);
        c1[14] = __builtin_amdgcn_exp2f(c1[14] - mrun); ps += c1[14]; c1[15] = __builtin_amdgcn_exp2f(c1[15] - mrun); ps += c1[15]; pwn[15] = pk2(c1[14], c1[15]);
        __builtin_amdgcn_sched_barrier(0);
        mxl = fmaxf(n0[0], n1[0]); mxl = fmaxf(fmaxf(mxl, n0[1]), n1[1]); mxl = fmaxf(fmaxf(mxl, n0[2]), n1[2]); mxl = fmaxf(fmaxf(mxl, n0[3]), n1[3]);
        __builtin_amdgcn_sched_barrier(0);
        mxl = fmaxf(fmaxf(mxl, n0[4]), n1[4]); mxl = fmaxf(fmaxf(mxl, n0[5]), n1[5]); mxl = fmaxf(fmaxf(mxl, n0[6]), n1[6]); mxl = fmaxf(fmaxf(mxl, n0[7]), n1[7]);
        __builtin_amdgcn_sched_barrier(0);
        mxl = fmaxf(fmaxf(mxl, n0[8]), n1[8]); mxl = fmaxf(fmaxf(mxl, n0[9]), n1[9]); mxl = fmaxf(fmaxf(mxl, n0[10]), n1[10]); mxl = fmaxf(fmaxf(mxl, n0[11]), n1[11]);
        __builtin_amdgcn_sched_barrier(0);
        mxl = fmaxf(fmaxf(mxl, n0[12]), n1[12]); mxl = fmaxf(fmaxf(mxl, n0[13]), n1[13]); mxl = fmaxf(fmaxf(mxl, n0[14]), n1[14]); mxl = fmaxf(fmaxf(mxl, n0[15]), n1[15]);
        __builtin_amdgcn_sched_barrier(0);
        mxn = fmaxf(mxl, __shfl_xor(mxl, 32));
    } else if constexpr (VAR == 1) {
        bf16x8 kf0, kf1, kf2;
        kf0 = *(const LAS bf16x8*)(kb_ + 0*32*192 + kt16 + 0); kf1 = *(const LAS bf16x8*)(kb_ + 1*32*192 + kt16 + 0);
        u32x2 vf0a, vf0b, vf1a, vf1b, vf2a, vf2b;
        float mxl;
        kf2 = *(const LAS bf16x8*)(kb_ + 0*32*192 + kt16 + 32);
        n0 = __builtin_amdgcn_mfma_f32_32x32x16_bf16(kf0, qf[0], zero16, 0, 0, 0);
        c0[0] = __builtin_amdgcn_exp2f(c0[0] - mrun); ps += c0[0]; c0[1] = __builtin_amdgcn_exp2f(c0[1] - mrun); ps += c0[1]; pwn[0] = pk2(c0[0], c0[1]);
        __builtin_amdgcn_sched_barrier(0);
        kf0 = *(const LAS bf16x8*)(kb_ + 1*32*192 + kt16 + 32);
        n1 = __builtin_amdgcn_mfma_f32_32x32x16_bf16(kf1, qf[0], zero16, 0, 0, 0);
        c0[2] = __builtin_amdgcn_exp2f(c0[2] - mrun); ps += c0[2]; c0[3] = __builtin_amdgcn_exp2f(c0[3] - mrun); ps += c0[3]; pwn[1] = pk2(c0[2], c0[3]);
        __builtin_amdgcn_sched_barrier(0);
        kf1 = *(const LAS bf16x8*)(kb_ + 0*32*192 + kt16 + 64);
        n0 = __builtin_amdgcn_mfma_f32_32x32x16_bf16(kf2, qf[1], n0, 0, 0, 0);
        c0[4] = __builtin_amdgcn_exp2f(c0[4] - mrun); ps += c0[4]; c0[5] = __builtin_amdgcn_exp2f(c0[5] - mrun); ps += c0[5]; pwn[2] = pk2(c0[4], c0[5]);
        __builtin_amdgcn_sched_barrier(0);
        kf2 = *(const LAS bf16x8*)(kb_ + 1*32*192 + kt16 + 64);
        n1 = __builtin_amdgcn_mfma_f32_32x32x16_bf16(kf0, qf[1], n1, 0, 0, 0);
        c0[6] = __builtin_amdgcn_exp2f(c0[6] - mrun); ps += c0[6]; c0[7] = __builtin_amdgcn_exp2f(c0[7] - mrun); ps += c0[7]; pwn[3] = pk2(c0[6], c0[7]);
        __builtin_amdgcn_sched_barrier(0);
        kf0 = *(const LAS bf16x8*)(kb_ + 0*32*192 + kt16 + 96);
        n0 = __builtin_amdgcn_mfma_f32_32x32x16_bf16(kf1, qf[2], n0, 0, 0, 0);
        c0[8] = __builtin_amdgcn_exp2f(c0[8] - mrun); ps += c0[8]; c0[9] = __builtin_amdgcn_exp2f(c0[9] - mrun); ps += c0[9]; pwn[4] = pk2(c0[8], c0[9]);
        __builtin_amdgcn_sched_barrier(0);
        kf1 = *(const LAS bf16x8*)(kb_ + 1*32*192 + kt16 + 96);
        n1 = __builtin_amdgcn_mfma_f32_32x32x16_bf16(kf2, qf[2], n1, 0, 0, 0);
        c0[10] = __builtin_amdgcn_exp2f(c0[10] - mrun); ps += c0[10]; c0[11] = __builtin_amdgcn_exp2f(c0[11] - mrun); ps += c0[11]; pwn[5] = pk2(c0[10], c0[11]);
        __builtin_amdgcn_sched_barrier(0);
        kf2 = *(const LAS bf16x8*)(kb_ + 0*32*192 + k4o);
        n0 = __builtin_amdgcn_mfma_f32_32x32x16_bf16(kf0, qf[3], n0, 0, 0, 0);
        c0[12] = __builtin_amdgcn_exp2f(c0[12] - mrun); ps += c0[12]; c0[13] = __builtin_amdgcn_exp2f(c0[13] - mrun); ps += c0[13]; pwn[6] = pk2(c0[12], c0[13]);
        __builtin_amdgcn_sched_barrier(0);
        kf0 = *(const LAS bf16x8*)(kb_ + 1*32*192 + k4o);
        n1 = __builtin_amdgcn_mfma_f32_32x32x16_bf16(kf1, qf[3], n1, 0, 0, 0);
        c0[14] = __builtin_amdgcn_exp2f(c0[14] - mrun); ps += c0[14]; c0[15] = __builtin_amdgcn_exp2f(c0[15] - mrun); ps += c0[15]; pwn[7] = pk2(c0[14], c0[15]);
        __builtin_amdgcn_sched_barrier(0);
        kf1 = *(const LAS bf16x8*)(kb_ + 0*32*192 + k5o);
        n0 = __builtin_amdgcn_mfma_f32_32x32x16_bf16(kf2, qf[4], n0, 0, 0, 0);
        c1[0] = __builtin_amdgcn_exp2f(c1[0] - mrun); ps += c1[0]; c1[1] = __builtin_amdgcn_exp2f(c1[1] - mrun); ps += c1[1]; pwn[8] = pk2(c1[0], c1[1]);
        __builtin_amdgcn_sched_barrier(0);
        kf2 = *(const LAS bf16x8*)(kb_ + 1*32*192 + k5o);
        n1 = __builtin_amdgcn_mfma_f32_32x32x16_bf16(kf0, qf[4], n1, 0, 0, 0);
        c1[2] = __builtin_amdgcn_exp2f(c1[2] - mrun); ps += c1[2]; c1[3] = __builtin_amdgcn_exp2f(c1[3] - mrun); ps += c1[3]; pwn[9] = pk2(c1[2], c1[3]);
        __builtin_amdgcn_sched_barrier(0);
        vf0a = *(const LAS u32x2*)(vb_ + ((0) ^ vsw) * 16); vf0b = *(const LAS u32x2*)(vb_ + ((1) ^ vsw) * 16);
        n0 = __builtin_amdgcn_mfma_f32_32x32x16_bf16(kf1, qf[5], n0, 0, 0, 0);
        c1[4] = __builtin_amdgcn_exp2f(c1[4] - mrun); ps += c1[4]; c1[5] = __builtin_amdgcn_exp2f(c1[5] - mrun); ps += c1[5]; pwn[10] = pk2(c1[4], c1[5]);
        __builtin_amdgcn_sched_barrier(0);
        vf1a = *(const LAS u32x2*)(vb_ + 32 * 128 + ((0) ^ vsw) * 16); vf1b = *(const LAS u32x2*)(vb_ + 32 * 128 + ((1) ^ vsw) * 16);
        n1 = __builtin_amdgcn_mfma_f32_32x32x16_bf16(kf2, qf[5], n1, 0, 0, 0);
        c1[6] = __builtin_amdgcn_exp2f(c1[6] - mrun); ps += c1[6]; c1[7] = __builtin_amdgcn_exp2f(c1[7] - mrun); ps += c1[7]; pwn[11] = pk2(c1[6], c1[7]);
        __builtin_amdgcn_sched_barrier(0);
        vf2a = *(const LAS u32x2*)(vb_ + ((2) ^ vsw) * 16); vf2b = *(const LAS u32x2*)(vb_ + ((3) ^ vsw) * 16);
        { const u32x4 pbu = {pwc[0], pwc[1], pwc[2], pwc[3]}; const u32x4 vv = {vf0a.x, vf0a.y, vf0b.x, vf0b.y};
          o0 = __builtin_amdgcn_mfma_f32_32x32x16_bf16(__builtin_bit_cast(bf16x8, vv), __builtin_bit_cast(bf16x8, pbu), o0, 0, 0, 0); }
        c1[8] = __builtin_amdgcn_exp2f(c1[8] - mrun); ps += c1[8]; c1[9] = __builtin_amdgcn_exp2f(c1[9] - mrun); ps += c1[9]; pwn[12] = pk2(c1[8], c1[9]);
        __builtin_amdgcn_sched_barrier(0);
        vf0a = *(const LAS u32x2*)(vb_ + 32 * 128 + ((2) ^ vsw) * 16); vf0b = *(const LAS u32x2*)(vb_ + 32 * 128 + ((3) ^ vsw) * 16);
        { const u32x4 pbu = {pwc[0], pwc[1], pwc[2], pwc[3]}; const u32x4 vv = {vf1a.x, vf1a.y, vf1b.x, vf1b.y};
          o1 = __builtin_amdgcn_mfma_f32_32x32x16_bf16(__builtin_bit_cast(bf16x8, vv), __builtin_bit_cast(bf16x8, pbu), o1, 0, 0, 0); }
        c1[10] = __builtin_amdgcn_exp2f(c1[10] - mrun); ps += c1[10]; c1[11] = __builtin_amdgcn_exp2f(c1[11] - mrun); ps += c1[11]; pwn[13] = pk2(c1[10], c1[11]);
        __builtin_amdgcn_sched_barrier(0);
        vf1a = *(const LAS u32x2*)(vb_ + ((4) ^ vsw) * 16); vf1b = *(const LAS u32x2*)(vb_ + ((5) ^ vsw) * 16);
        { const u32x4 pbu = {pwc[4], pwc[5], pwc[6], pwc[7]}; const u32x4 vv = {vf2a.x, vf2a.y, vf2b.x, vf2b.y};
          o0 = __builtin_amdgcn_mfma_f32_32x32x16_bf16(__builtin_bit_cast(bf16x8, vv), __builtin_bit_cast(bf16x8, pbu), o0, 0, 0, 0); }
        c1[12] = __builtin_amdgcn_exp2f(c1[12] - mrun); ps += c1[12]; c1[13] = __builtin_amdgcn_exp2f(c1[13] - mrun); ps += c1[13]; pwn[14] = pk2(c1[12], c1[13]);
        __builtin_amdgcn_sched_barrier(0);
        vf2a = *(const LAS u32x2*)(vb_ + 32 * 128 + ((4) ^ vsw) * 16); vf2b = *(const LAS u32x2*)(vb_ + 32 * 128 + ((5) ^ vsw) * 16);
        { const u32x4 pbu = {pwc[4], pwc[5], pwc[6], pwc[7]}; const u32x4 vv = {vf0a.x, vf0a.y, vf0b.x, vf0b.y};
          o1 = __builtin_amdgcn_mfma_f32_32x32x16_bf16(__builtin_bit_cast(bf16x8, vv), __builtin_bit_cast(bf16x8, pbu), o1, 0, 0, 0); }
        c1[14] = __builtin_amdgcn_exp2f(c1[14] - mrun); ps += c1[14]; c1[15] = __builtin_amdgcn_exp2f(c1[15] - mrun); ps += c1[15]; pwn[15] = pk2(c1[14], c1[15]);
        __builtin_amdgcn_sched_barrier(0);
        vf0a = *(const LAS u32x2*)(vb_ + ((6) ^ vsw) * 16); vf0b = *(const LAS u32x2*)(vb_ + ((7) ^ vsw) * 16);
        { const u32x4 pbu = {pwc[8], pwc[9], pwc[10], pwc[11]}; const u32x4 vv = {vf1a.x, vf1a.y, vf1b.x, vf1b.y};
          o0 = __builtin_amdgcn_mfma_f32_32x32x16_bf16(__builtin_bit_cast(bf16x8, vv), __builtin_bit_cast(bf16x8, pbu), o0, 0, 0, 0); }
        mxl = fmaxf(n0[0], n1[0]); mxl = fmaxf(fmaxf(mxl, n0[1]), n1[1]); mxl = fmaxf(fmaxf(mxl, n0[2]), n1[2]); mxl = fmaxf(fmaxf(mxl, n0[3]), n1[3]);
        __builtin_amdgcn_sched_barrier(0);
        vf1a = *(const LAS u32x2*)(vb_ + 32 * 128 + ((6) ^ vsw) * 16); vf1b = *(const LAS u32x2*)(vb_ + 32 * 128 + ((7) ^ vsw) * 16);
        { const u32x4 pbu = {pwc[8], pwc[9], pwc[10], pwc[11]}; const u32x4 vv = {vf2a.x, vf2a.y, vf2b.x, vf2b.y};
          o1 = __builtin_amdgcn_mfma_f32_32x32x16_bf16(__builtin_bit_cast(bf16x8, vv), __builtin_bit_cast(bf16x8, pbu), o1, 0, 0, 0); }
        mxl = fmaxf(fmaxf(mxl, n0[4]), n1[4]); mxl = fmaxf(fmaxf(mxl, n0[5]), n1[5]); mxl = fmaxf(fmaxf(mxl, n0[6]), n1[6]); mxl = fmaxf(fmaxf(mxl, n0[7]), n1[7]);
        __builtin_amdgcn_sched_barrier(0);
        { const u32x4 pbu = {pwc[12], pwc[13], pwc[14], pwc[15]}; const u32x4 vv = {vf0a.x, vf0a.y, vf0b.x, vf0b.y};
          o0 = __builtin_amdgcn_mfma_f32_32x32x16_bf16(__builtin_bit_cast(bf16x8, vv), __builtin_bit_cast(bf16x8, pbu), o0, 0, 0, 0); }
        mxl = fmaxf(fmaxf(mxl, n0[8]), n1[8]); mxl = fmaxf(fmaxf(mxl, n0[9]), n1[9]); mxl = fmaxf(fmaxf(mxl, n0[10]), n1[10]); mxl = fmaxf(fmaxf(mxl, n0[11]), n1[11]);
        __builtin_amdgcn_sched_barrier(0);
        { const u32x4 pbu = {pwc[12], pwc[13], pwc[14], pwc[15]}; const u32x4 vv = {vf1a.x, vf1a.y, vf1b.x, vf1b.y};
          o1 = __builtin_amdgcn_mfma_f32_32x32x16_bf16(__builtin_bit_cast(bf16x8, vv), __builtin_bit_cast(bf16x8, pbu), o1, 0, 0, 0); }
        mxl = fmaxf(fmaxf(mxl, n0[12]), n1[12]); mxl = fmaxf(fmaxf(mxl, n0[13]), n1[13]); mxl = fmaxf(fmaxf(mxl, n0[14]), n1[14]); mxl = fmaxf(fmaxf(mxl, n0[15]), n1[15]);
        __builtin_amdgcn_sched_barrier(0);
        mxn = fmaxf(mxl, __shfl_xor(mxl, 32));
    } else {
        u32x2 vf0a, vf0b, vf1a, vf1b, vf2a, vf2b;
        vf0a = *(const LAS u32x2*)(vb_ + ((0) ^ vsw) * 16); vf0b = *(const LAS u32x2*)(vb_ + ((1) ^ vsw) * 16);
        vf1a = *(const LAS u32x2*)(vb_ + 32 * 128 + ((0) ^ vsw) * 16); vf1b = *(const LAS u32x2*)(vb_ + 32 * 128 + ((1) ^ vsw) * 16);
        vf2a = *(const LAS u32x2*)(vb_ + ((2) ^ vsw) * 16); vf2b = *(const LAS u32x2*)(vb_ + ((3) ^ vsw) * 16);
        { const u32x4 pbu = {pwc[0], pwc[1], pwc[2], pwc[3]}; const u32x4 vv = {vf0a.x, vf0a.y, vf0b.x, vf0b.y};
          o0 = __builtin_amdgcn_mfma_f32_32x32x16_bf16(__builtin_bit_cast(bf16x8, vv), __builtin_bit_cast(bf16x8, pbu), o0, 0, 0, 0); }
        __builtin_amdgcn_sched_barrier(0);
        vf0a = *(const LAS u32x2*)(vb_ + 32 * 128 + ((2) ^ vsw) * 16); vf0b = *(const LAS u32x2*)(vb_ + 32 * 128 + ((3) ^ vsw) * 16);
        { const u32x4 pbu = {pwc[0], pwc[1], pwc[2], pwc[3]}; const u32x4 vv = {vf1a.x, vf1a.y, vf1b.x, vf1b.y};
          o1 = __builtin_amdgcn_mfma_f32_32x32x16_bf16(__builtin_bit_cast(bf16x8, vv), __builtin_bit_cast(bf16x8, pbu), o1, 0, 0, 0); }
        __builtin_amdgcn_sched_barrier(0);
        vf1a = *(const LAS u32x2*)(vb_ + ((4) ^ vsw) * 16); vf1b = *(const LAS u32x2*)(vb_ + ((5) ^ vsw) * 16);
        { const u32x4 pbu = {pwc[4], pwc[5], pwc[6], pwc[7]}; const u32x4 vv = {vf2a.x, vf2a.y, vf2b.x, vf2b.y};
          o0 = __builtin_amdgcn_mfma_f32_32x32x16_bf16(__builtin_bit_cast(bf16x8, vv), __builtin_bit_cast(bf16x8, pbu), o0, 0, 0, 0); }
        __builtin_amdgcn_sched_barrier(0);
        vf2a = *(const LAS u32x2*)(vb_ + 32 * 128 + ((4) ^ vsw) * 16); vf2b = *(const LAS u32x2*)(vb_ + 32 * 128 + ((5) ^ vsw) * 16);
        { const u32x4 pbu = {pwc[4], pwc[5], pwc[6], pwc[7]}; const u32x4 vv = {vf0a.x, vf0a.y, vf0b.x, vf0b.y};
          o1 = __builtin_amdgcn_mfma_f32_32x32x16_bf16(__builtin_bit_cast(bf16x8, vv), __builtin_bit_cast(bf16x8, pbu), o1, 0, 0, 0); }
        __builtin_amdgcn_sched_barrier(0);
        vf0a = *(const LAS u32x2*)(vb_ + ((6) ^ vsw) * 16); vf0b = *(const LAS u32x2*)(vb_ + ((7) ^ vsw) * 16);
        { const u32x4 pbu = {pwc[8], pwc[9], pwc[10], pwc[11]}; const u32x4 vv = {vf1a.x, vf1a.y, vf1b.x, vf1b.y};
          o0 = __builtin_amdgcn_mfma_f32_32x32x16_bf16(__builtin_bit_cast(bf16x8, vv), __builtin_bit_cast(bf16x8, pbu), o0, 0, 0, 0); }
        __builtin_amdgcn_sched_barrier(0);
        vf1a = *(const LAS u32x2*)(vb_ + 32 * 128 + ((6) ^ vsw) * 16); vf1b = *(const LAS u32x2*)(vb_ + 32 * 128 + ((7) ^ vsw) * 16);
        { const u32x4 pbu = {pwc[8], pwc[9], pwc[10], pwc[11]}; const u32x4 vv = {vf2a.x, vf2a.y, vf2b.x, vf2b.y};
          o1 = __builtin_amdgcn_mfma_f32_32x32x16_bf16(__builtin_bit_cast(bf16x8, vv), __builtin_bit_cast(bf16x8, pbu), o1, 0, 0, 0); }
        __builtin_amdgcn_sched_barrier(0);
        { const u32x4 pbu = {pwc[12], pwc[13], pwc[14], pwc[15]}; const u32x4 vv = {vf0a.x, vf0a.y, vf0b.x, vf0b.y};
          o0 = __builtin_amdgcn_mfma_f32_32x32x16_bf16(__builtin_bit_cast(bf16x8, vv), __builtin_bit_cast(bf16x8, pbu), o0, 0, 0, 0); }
        __builtin_amdgcn_sched_barrier(0);
        { const u32x4 pbu = {pwc[12], pwc[13], pwc[14], pwc[15]}; const u32x4 vv = {vf1a.x, vf1a.y, vf1b.x, vf1b.y};
          o1 = __builtin_amdgcn_mfma_f32_32x32x16_bf16(__builtin_bit_cast(bf16x8, vv), __builtin_bit_cast(bf16x8, pbu), o1, 0, 0, 0); }
        __builtin_amdgcn_sched_barrier(0);
    }
}

template <int DUMMY>
__device__ void phase3q(const P& p, int bid, int nb, LAS unsigned char* lds) {
    const bf16_t* Q = p.slotA; const bf16_t* K = p.slotE; const bf16_t* VT = p.slotF; bf16_t* O = p.slotC;
    const int tid = opaque_tid(), lane = tid & 63, wid = tid >> 6, l31 = lane & 31, hh = lane >> 5;
    constexpr float THR = 8.f;
    const int widu = __builtin_amdgcn_readfirstlane(tid >> 6);
    int koff[3];
#pragma unroll
    for (int i = 0; i < 3; ++i) { const int s = tid + 256 * i, r = s / 12, pc = s % 12, c = (pc + 12 - ((r >> 2) & 3)) % 12; koff[i] = r * 96 + c * 8; }
    const int kt = hh + ((lane >> 2) & 3), kt16 = kt * 16, k4o = (8 + kt >= 12 ? kt - 4 : 8 + kt) * 16, k5o = (10 + kt >= 12 ? kt - 2 : 10 + kt) * 16;
    const int krow = l31 * 192, vsw = (lane >> 1) & 7, vrow = l31 * 128 + 8 * hh;
    for (int iu = 0;; ++iu) {
        const int r = iu * nb + ((iu & 1) ? nb - 1 - bid : bid); if (r >= 1024) break;
        const int qb = 63 - (r >> 4), bh = r & 15, b = bh >> 3, h = bh & 7;
        const int q0 = qb * 128 + wid * 32, ntw = (q0 >> 6) + 1, nt = 2 * qb + 2;
        const bf16_t* Kb = K + (size_t)bh * SEQ * 96; const bf16_t* Vb = VT + (size_t)(h * 64) * NT + (size_t)b * SEQ;
        bf16x8 qf[6]; { const bf16_t* qp = Q + ((size_t)bh * SEQ + q0 + l31) * 96 + hh * 8;
#pragma unroll
            for (int ks = 0; ks < 6; ++ks) qf[ks] = *(const bf16x8*)(qp + ks * 16); }
        f32x16 o0, o1;
#pragma unroll
        for (int e = 0; e < 16; ++e) { o0[e] = 0.f; o1[e] = 0.f; }
        float mrun = 0.f, lsum = 0.f;
        auto stageK = [&](int j) { LAS unsigned char* d = lds + (j & 1) * 12288 + widu * 1024; const bf16_t* kt = Kb + (size_t)j * 64 * 96;
#pragma unroll
            for (int i = 0; i < 3; ++i) __builtin_amdgcn_global_load_lds((const unsigned*)(kt + koff[i]), (LAS unsigned*)(d + i * 4096), 16, 0, 0); };
        auto stageV = [&](int j) { LAS unsigned char* d = lds + 24576 + (j & 1) * 8192 + widu * 1024; const bf16_t* vt = Vb + j * 64;
#pragma unroll
            for (int i = 0; i < 2; ++i) { const int dv = (tid >> 3) + 32 * i, cl = (tid & 7) ^ ((dv >> 1) & 7);
                __builtin_amdgcn_global_load_lds((const unsigned*)(vt + (size_t)dv * NT + cl * 8), (LAS unsigned*)(d + i * 4096), 16, 0, 0); } };
        f32x16 sA0, sA1, sB0, sB1; unsigned pA[16], pB[16]; float mxA, mxB = 0.f;
#pragma unroll
        for (int e = 0; e < 16; ++e) { pA[e] = 0u; pB[e] = 0u; }
        stageK(0); stageK(1);
        asm volatile("s_waitcnt vmcnt(0)" ::: "memory");
        __syncthreads();
        { const LAS unsigned char* kb_ = lds + krow;
#pragma unroll
          for (int e = 0; e < 16; ++e) { sA0[e] = 0.f; sA1[e] = 0.f; }
#pragma unroll
          for (int ks = 0; ks < 6; ++ks) { const int ko = ks <= 3 ? kt16 + 32 * ks : (ks == 4 ? k4o : k5o); const bf16x8 k0 = *(const LAS bf16x8*)(kb_ + ko); const bf16x8 k1 = *(const LAS bf16x8*)(kb_ + 32 * 192 + ko);
              sA0 = __builtin_amdgcn_mfma_f32_32x32x16_bf16(k0, qf[ks], sA0, 0, 0, 0); sA1 = __builtin_amdgcn_mfma_f32_32x32x16_bf16(k1, qf[ks], sA1, 0, 0, 0); }
          float m = fmaxf(sA0[0], sA1[0]);
#pragma unroll
          for (int e = 1; e < 16; ++e) m = fmaxf(fmaxf(m, sA0[e]), sA1[e]);
          mxA = fmaxf(m, __shfl_xor(m, 32)); }
        auto step = [&](f32x16& c0, f32x16& c1, float& mxc, f32x16& n0, f32x16& n1, float& mxn, const unsigned (&pwc)[16], unsigned (&pwn)[16], int s) {
            asm volatile("s_waitcnt vmcnt(0)" ::: "memory");
            __syncthreads();
            if (s + 2 < nt) stageK(s + 2);
            if (s < nt) stageV(s);
            if (s <= ntw) {
                const LAS unsigned char* kb_ = lds + ((s + 1) & 1) * 12288 + krow; const LAS unsigned char* vb_ = lds + 24576 + ((s + 1) & 1) * 8192 + vrow;
                if (s < ntw) {
                    const bool resc = (s == 0) || !__all(mxc <= mrun + THR); float alpha = 1.f;
                    if (resc) { const float mn = (s == 0) ? mxc : fmaxf(mrun, mxc); alpha = __builtin_amdgcn_exp2f(mrun - mn); mrun = mn; }
                    float ps = 0.f;
                    if (s == 0) att_step<0>(kb_, vb_, kt16, k4o, k5o, vsw, qf, c0, c1, n0, n1, pwc, pwn, o0, o1, mrun, ps, mxn);
                    else att_step<1>(kb_, vb_, kt16, k4o, k5o, vsw, qf, c0, c1, n0, n1, pwc, pwn, o0, o1, mrun, ps, mxn);
                    if (resc) {
#pragma unroll
                        for (int e = 0; e < 16; ++e) { o0[e] *= alpha; o1[e] *= alpha; } }
                    lsum = lsum * alpha + ps;
                } else att_step<2>(kb_, vb_, kt16, k4o, k5o, vsw, qf, c0, c1, n0, n1, pwc, pwn, o0, o1, mrun, lsum, mxn);
            }
        };
        for (int s = 0; s <= nt; s += 2) { step(sA0, sA1, mxA, sB0, sB1, mxB, pB, pA, s); if (s + 1 <= nt) step(sB0, sB1, mxB, sA0, sA1, mxA, pA, pB, s + 1); }
        const float inv = 1.f / (lsum + __shfl_xor(lsum, 32));
        bf16_t* op = O + (size_t)(b * SEQ + q0 + l31) * 512 + h * 64 + 4 * hh;
#pragma unroll
        for (int g = 0; g < 4; ++g) { uint2 w0, w1;
            w0.x = pk2(o0[4 * g] * inv, o0[4 * g + 1] * inv); w0.y = pk2(o0[4 * g + 2] * inv, o0[4 * g + 3] * inv);
            w1.x = pk2(o1[4 * g] * inv, o1[4 * g + 1] * inv); w1.y = pk2(o1[4 * g + 2] * inv, o1[4 * g + 3] * inv);
            *(uint2*)(op + 8 * g) = w0; *(uint2*)(op + 32 + 8 * g) = w1; }
        __syncthreads();
    }
}

__device__ __forceinline__ f32x4 bf4(const uint2 u) { return (f32x4){__uint_as_float(u.x << 16), __uint_as_float(u.x & 0xffff0000u), __uint_as_float(u.y << 16), __uint_as_float(u.y & 0xffff0000u)}; }
__device__ __forceinline__ unsigned pack2bf(float lo, float hi) { return (unsigned)f2bf(lo) | ((unsigned)f2bf(hi) << 16); }
__device__ void phase4(const P& p, int bid, int nb, LAS unsigned char* lds) {
    const bf16_t* O = p.slotC; const bf16_t* su = p.slotG; const bf16_t* gates = p.slotD; bf16_t* mo = p.slotA;
    const int tid = opaque_tid(), lane = tid & 63, wid = tid >> 6, wr = wid >> 1, wc = wid & 1, fr = lane & 15, fq = lane >> 4;
    const int c8 = ((tid & 7) ^ ((tid >> 3) & 7)) * 8;
    int rt, ct;
    for (int it = 0; tile_of(it, bid, nb, NT / 128, DM / 128, rt, ct); ++it) {
        const int row0 = rt * 128, col0 = ct * 128;
        f32x4 acc[4][4];
#pragma unroll
        for (int m = 0; m < 4; ++m)
#pragma unroll
            for (int n = 0; n < 4; ++n) acc[m][n] = (f32x4){0.f, 0.f, 0.f, 0.f};
        mg_kloop(acc, O + (size_t)(row0 + (tid >> 3)) * 512 + c8, (size_t)32 * 512, p.WoaT + (size_t)(col0 + (tid >> 3)) * 512 + c8, (size_t)32 * 512, 8, lds);
#pragma unroll
        for (int m = 0; m < 4; ++m)
#pragma unroll
            for (int n = 0; n < 4; ++n) { const int t = row0 + wr * 64 + m * 16 + fr, c = col0 + wc * 64 + n * 16 + fq * 4;
                const f32x4 ga = bf4(*(const uint2*)(gates + (size_t)t * 2048 + c)), gb = bf4(*(const uint2*)(gates + (size_t)t * 2048 + 1024 + c));
#pragma unroll
                for (int j = 0; j < 4; ++j) acc[m][n][j] *= ga[j] * __builtin_amdgcn_rcpf(gb[j]); }
        mg_kloop(acc, su + (size_t)(row0 + (tid >> 3)) * 512 + c8, (size_t)32 * 512, p.WosT + (size_t)(col0 + (tid >> 3)) * 512 + c8, (size_t)32 * 512, 8, lds);
#pragma unroll
        for (int m = 0; m < 4; ++m)
#pragma unroll
            for (int n = 0; n < 4; ++n) { const int t = row0 + wr * 64 + m * 16 + fr, c = col0 + wc * 64 + n * 16 + fq * 4;
                const f32x4 gb = bf4(*(const uint2*)(gates + (size_t)t * 2048 + 1024 + c));
                uint2 o; o.x = pk2(gb[0] * acc[m][n][0], gb[1] * acc[m][n][1]); o.y = pk2(gb[2] * acc[m][n][2], gb[3] * acc[m][n][3]); *(uint2*)(mo + (size_t)t * DM + c) = o; }
    }
}

__device__ void phase5(const P& p, int bid, int nb, LAS unsigned char* sm) {
    const float* x = p.x; float* xm = p.out;
    mgemm(p.slotA, DM, p.WoutT, DM, NT, DM, DM, [=](int t, int c, const f32x4& v) {
        const f32x4 xv = *(const f32x4*)(x + (size_t)t * DM + c); *(f32x4*)(xm + (size_t)t * DM + c) = xv + v;
    }, bid, nb, sm);
}

__device__ __forceinline__ int gu_src_col(int rho, int& isup) {
    const int tt = rho >> 7, w = rho & 127, wc = w >> 6, n = (w >> 4) & 3, i = w & 15; isup = n >> 1; return tt * 64 + wc * 32 + (n & 1) * 16 + i;
}
__device__ __forceinline__ void ex_tile(const P& p, int tile, const float*& s0, const float*& s1, size_t& ld, bf16_t*& dst, int& K) {
    bf16_t* WguT = (bf16_t*)p.slotB; bf16_t* WdT = p.slotC + (size_t)NT * 512;
    const int e = tile / 192, tt = tile % 192;
    if (tt < 128) { const int tr = tt >> 4, tk = tt & 15, T = tr >> 1, wc = tr & 1, k0 = tk * 64, c0 = T * 64 + wc * 32;
        s0 = p.w_eg + ((size_t)e * 1024 + k0) * 256 + c0; s1 = p.w_eu + ((size_t)e * 1024 + k0) * 256 + c0; ld = 256; K = 1024;
        dst = WguT + ((size_t)e * 512 + tr * 64) * 1024 + k0; }
    else { const int t2 = tt - 128, tr = t2 >> 2, tk = t2 & 3, k0 = tk * 64, n0 = tr * 64;
        s0 = p.w_ed + ((size_t)e * 256 + k0) * 1024 + n0; s1 = s0 + 32; ld = 1024; K = 256;
        dst = WdT + ((size_t)e * 1024 + n0) * 256 + k0; }
}
__device__ void expert_conv(const P& p, int first, int step, float* sm) {
    const int tid = opaque_tid(), kq = tid >> 4, r4 = (tid & 15) * 4;
    for (int t0 = first; t0 < 6144; t0 += 2 * step) {
        f32x4 v[2][4]; bf16_t* dst[2]; int K[2]; const int nt = (t0 + step < 6144) ? 2 : 1;
#pragma unroll
        for (int u = 0; u < 2; ++u) if (u < nt) { const float* s0; const float* s1; size_t ld; ex_tile(p, t0 + u * step, s0, s1, ld, dst[u], K[u]);
            const float* src = (r4 < 32 ? s0 + r4 : s1 + (r4 - 32));
#pragma unroll
            for (int i = 0; i < 4; ++i) v[u][i] = *(const f32x4*)(src + (size_t)(kq + 16 * i) * ld); }
#pragma unroll
        for (int u = 0; u < 2; ++u) if (u < nt) {
#pragma unroll
            for (int i = 0; i < 4; ++i)
#pragma unroll
                for (int j = 0; j < 4; ++j) sm[u * 4160 + (kq + 16 * i) * 65 + r4 + j] = v[u][i][j]; }
        __syncthreads();
#pragma unroll
        for (int u = 0; u < 2; ++u) if (u < nt) {
#pragma unroll
            for (int i = 0; i < 4; ++i) { const int rho = kq + 16 * i; const float* b = sm + u * 4160 + r4 * 65 + rho;
                uint2 o; o.x = pk2(b[0], b[65]); o.y = pk2(b[130], b[195]); *(uint2*)(dst[u] + (size_t)rho * K[u] + r4) = o; } }
        __syncthreads();
    }
}

__device__ void phase6(const P& p, int bid, int nb, float* sm) {
    const int tid = opaque_tid(), lane = tid & 63, wid = tid >> 6;
    bf16_t* h2 = p.slotA; const float* xm = p.out;
    int* s_cnt = (int*)sm; int* s_base = s_cnt + 32; int* s_e = s_base + 32; int* s_r = s_e + 128; float* s_w = (float*)(s_r + 128);
    if (tid < 32) s_cnt[tid] = 0;
    __syncthreads();
    int slot = wid * 16;
    float* xs = sm + 512 + wid * 1024;
    for (int t = bid * 4 + wid; t < NT; t += nb * 4, ++slot) {
        f32x4 v[4]; float ss = 0.f;
#pragma unroll
        for (int i = 0; i < 4; ++i) { v[i] = *(const f32x4*)(xm + (size_t)t * DM + (lane + 64 * i) * 4); ss += v[i][0] * v[i][0] + v[i][1] * v[i][1] + v[i][2] * v[i][2] + v[i][3] * v[i][3]; }
        ss = wsumf(ss); const float r = rsqrtf(ss * (1.f / DM) + EPS);
#pragma unroll
        for (int i = 0; i < 4; ++i) { const f32x4 g = *(const f32x4*)(p.g_ffn + (lane + 64 * i) * 4); v[i] = v[i] * r * g; *(f32x4*)(xs + (lane + 64 * i) * 4) = v[i];
            uint2 o; o.x = pk2(v[i][0], v[i][1]); o.y = pk2(v[i][2], v[i][3]); *(uint2*)(h2 + (size_t)t * DM + (lane + 64 * i) * 4) = o; }
        f32x4 lgv = {0.f, 0.f, 0.f, 0.f};
#pragma unroll 4
        for (int i = 0; i < 16; ++i) { const int k = lane + 64 * i; lgv += xs[k] * *(const f32x4*)(p.w_rg + (size_t)k * 4); }
        float lg[4];
#pragma unroll
        for (int g = 0; g < 4; ++g) lg[g] = wsumf(lgv[g]) + p.b_rg[g];
        int gs = 0; float gm = lg[0];
#pragma unroll
        for (int g = 1; g < 4; ++g) if (lg[g] > gm) { gm = lg[g]; gs = g; }
        float den = 0.f;
#pragma unroll
        for (int g = 0; g < 4; ++g) den += __expf(lg[g] - gm);
        const float ptop = 1.f / den;
        f32x4 lev = {0.f, 0.f, 0.f, 0.f}; const float* wre = p.w_re + (size_t)gs * DM * 8;
#pragma unroll 8
        for (int i = 0; i < 32; ++i) { const int c = lane + 64 * i; lev += xs[c >> 1] * *(const f32x4*)(wre + (size_t)c * 4); }
        float le[8];
#pragma unroll
        for (int e = 0; e < 4; ++e) { const float mine = wsum_par(lev[e]), oth = DPP_F(mine, 0xB1); le[e] = mine + p.b_re[gs * 8 + e]; le[4 + e] = oth + p.b_re[gs * 8 + 4 + e]; }
        int e1 = 0; float l1 = le[0];
#pragma unroll
        for (int e = 1; e < 8; ++e) if (le[e] > l1) { l1 = le[e]; e1 = e; }
        int e2 = -1; float l2 = -3.0e38f;
#pragma unroll
        for (int e = 0; e < 8; ++e) if (e != e1 && le[e] > l2) { l2 = le[e]; e2 = e; }
        const float s1 = 1.f / (1.f + __expf(l2 - l1)), s2 = 1.f - s1;
        if (lane == 0) {
            const int ea = gs * 8 + e1, eb = gs * 8 + e2;
            s_e[2 * slot] = ea; s_e[2 * slot + 1] = eb; s_r[2 * slot] = atomicAdd(&s_cnt[ea], 1); s_r[2 * slot + 1] = atomicAdd(&s_cnt[eb], 1);
            s_w[2 * slot] = s1 * ptop; s_w[2 * slot + 1] = s2 * ptop;
        }
    }
    __syncthreads();
    if (tid < 32) { const int c = s_cnt[tid]; s_base[tid] = c ? atomicAdd(&p.cnt[tid], c) : 0; }
    __syncthreads();
    if (tid < 128) { const int sl = tid >> 1, kk = tid & 1, w = sl >> 4, k = sl & 15, t = bid * 4 + w + k * nb * 4;
        if (t < NT) { const int a = 2 * t + kk, e = s_e[tid]; p.list[(size_t)e * NT + s_base[e] + s_r[tid]] = a; p.aw[a] = s_w[tid]; p.aexp[a] = e; } }
    __syncthreads();
}

__device__ void phase7a(const P& p, int bid, int nb) {
    const bf16_t* h2 = p.slotA; const bf16_t* WguT = (const bf16_t*)p.slotB; bf16_t* hid = p.slotE;
    for (size_t i = (size_t)bid * 256 + threadIdx.x; i < (size_t)2 * NT * 256; i += (size_t)nb * 256) {
        const int a = (int)(i >> 8), c = (int)(i & 255), t = a >> 1, e = p.aexp[a];
        const int tt = c >> 6, wc = (c >> 5) & 1, nn = (c >> 4) & 1, ii = c & 15; const int rg = tt * 128 + wc * 64 + nn * 16 + ii, ru = rg + 32;
        const bf16_t* wg = WguT + ((size_t)e * 512 + rg) * 1024; const bf16_t* wu = WguT + ((size_t)e * 512 + ru) * 1024; const bf16_t* hr = h2 + (size_t)t * DM;
        float G = 0.f, U = 0.f;
        for (int k = 0; k < DM / 8; ++k) { const uint4 hv = ((const uint4*)hr)[k]; G += dot8(hv, ((const uint4*)wg)[k]); U += dot8(hv, ((const uint4*)wu)[k]); }
        hid[i] = f2bf(G * sigmoidf_(G) * U);
    }
}
__device__ void phase7b(const P& p, int bid, int nb) {
    const bf16_t* hid = p.slotE; const bf16_t* WdT = p.slotC + (size_t)NT * 512; bf16_t* Y = p.slotD;
    for (size_t i = (size_t)bid * 256 + threadIdx.x; i < (size_t)2 * NT * DM; i += (size_t)nb * 256) {
        const int a = (int)(i >> 10), n = (int)(i & 1023), e = p.aexp[a];
        const bf16_t* w = WdT + ((size_t)e * 1024 + n) * 256; const bf16_t* hr = hid + (size_t)a * 256; float s = 0.f;
        for (int k = 0; k < 32; ++k) s += dot8(((const uint4*)hr)[k], ((const uint4*)w)[k]);
        Y[i] = f2bf(s * p.aw[a]);
    }
}


__device__ __forceinline__ bool find_expert(const int* cnt, int ub, int& e, int& blk, int& ce) {
    int acc = 0;
    for (int i = 0; i < NE; ++i) { const int c = cnt[i], n = (c + 127) >> 7; if (ub < acc + n) { e = i; blk = ub - acc; ce = c; return true; } acc += n; }
    return false;
}
__device__ void phase7a_m(const P& p, int bid, int nb, LAS unsigned char* lds) {
    const bf16_t* h2 = p.slotA; const bf16_t* WguT = (const bf16_t*)p.slotB; bf16_t* hid = p.slotE;
    const int tid = opaque_tid(), lane = tid & 63, wid = tid >> 6, wr = wid >> 1, wc = wid & 1, fr = lane & 15, fq = lane >> 4;
    const int c8 = ((tid & 7) ^ ((tid >> 3) & 7)) * 8;
    for (int u = bid;; u += nb) {
        int e, blk, ce; if (!find_expert(p.cnt, u >> 2, e, blk, ce)) break;
        const int ct = u & 3; const int* lst = p.list + (size_t)e * NT;
        const bf16_t* ap[4];
#pragma unroll
        for (int i = 0; i < 4; ++i) { int r = blk * 128 + (tid >> 3) + 32 * i; r = r < ce ? r : ce - 1; ap[i] = h2 + (size_t)(lst[r] >> 1) * DM + c8; }
        f32x4 acc[4][4];
#pragma unroll
        for (int m = 0; m < 4; ++m)
#pragma unroll
            for (int n = 0; n < 4; ++n) acc[m][n] = (f32x4){0.f, 0.f, 0.f, 0.f};
        mg_kloop4(acc, ap[0], ap[1], ap[2], ap[3], WguT + ((size_t)e * 512 + ct * 128 + (tid >> 3)) * 1024 + c8, (size_t)32 * 1024, 16, lds);
        bf16_t* hb = hid + ((size_t)(u >> 2) * 128 + wr * 64 + fr) * 256 + ct * 64 + wc * 32 + fq * 4;
#pragma unroll
        for (int m = 0; m < 4; ++m)
#pragma unroll
            for (int n = 0; n < 2; ++n) { float v[4];
#pragma unroll
                for (int j = 0; j < 4; ++j) { const float g = acc[m][n][j]; v[j] = g * sigmoidf_(g) * acc[m][n + 2][j]; }
                uint2 o; o.x = pk2(v[0], v[1]); o.y = pk2(v[2], v[3]); *(uint2*)(hb + (size_t)(m * 16) * 256 + n * 16) = o; }
    }
}
__device__ void phase7b_m(const P& p, int bid, int nb, LAS unsigned char* lds) {
    const bf16_t* hid = p.slotE; const bf16_t* WdT = p.slotC + (size_t)NT * 512; bf16_t* Y = p.slotD;
    const int tid = opaque_tid(), lane = tid & 63, wid = tid >> 6, wr = wid >> 1, wc = wid & 1, fr = lane & 15, fq = lane >> 4;
    const int c8 = ((tid & 7) ^ ((tid >> 3) & 7)) * 8;
    for (int u = bid;; u += nb) {
        int e, blk, ce; if (!find_expert(p.cnt, u >> 3, e, blk, ce)) break;
        const int ct = u & 7; const int* lst = p.list + (size_t)e * NT;
        f32x4 acc[4][4];
#pragma unroll
        for (int m = 0; m < 4; ++m)
#pragma unroll
            for (int n = 0; n < 4; ++n) acc[m][n] = (f32x4){0.f, 0.f, 0.f, 0.f};
        mg_kloop(acc, hid + ((size_t)(u >> 3) * 128 + (tid >> 3)) * 256 + c8, (size_t)32 * 256, WdT + ((size_t)e * 1024 + ct * 128 + (tid >> 3)) * 256 + c8, (size_t)32 * 256, 4, lds);
#pragma unroll
        for (int m = 0; m < 4; ++m) { const int r = blk * 128 + wr * 64 + m * 16 + fr;
            if (r < ce) { const int a = lst[r]; const float w = p.aw[a]; bf16_t* yp = Y + (size_t)a * DM + ct * 128 + wc * 64 + fq * 4;
#pragma unroll
                for (int n = 0; n < 4; ++n) { uint2 o; o.x = pk2(acc[m][n][0] * w, acc[m][n][1] * w); o.y = pk2(acc[m][n][2] * w, acc[m][n][3] * w); *(uint2*)(yp + n * 16) = o; } } }
    }
}

__device__ void phase8(const P& p, int bid, int nb, float* dst) {
    const int tid = opaque_tid(), lane = tid & 63, wid = tid >> 6; const bf16_t* Y = p.slotD;
    for (int t = bid * 4 + wid; t < NT; t += nb * 4) {
        f32x4 v[4]; float ss = 0.f;
#pragma unroll
        for (int i = 0; i < 4; ++i) { const int c = (lane + 64 * i) * 4;
            v[i] = *(const f32x4*)(p.out + (size_t)t * DM + c) + bf4(*(const uint2*)(Y + (size_t)(2 * t) * DM + c)) + bf4(*(const uint2*)(Y + (size_t)(2 * t + 1) * DM + c));
            ss += v[i][0] * v[i][0] + v[i][1] * v[i][1] + v[i][2] * v[i][2] + v[i][3] * v[i][3]; }
        ss = wsumf(ss); const float r = rsqrtf(ss * (1.f / DM) + EPS);
#pragma unroll
        for (int i = 0; i < 4; ++i) { const int c = (lane + 64 * i) * 4; const f32x4 g = *(const f32x4*)(p.g_final + c); *(f32x4*)(dst + (size_t)t * DM + c) = v[i] * r * g; }
    }
}

#define XB_TMO      128
#define XB_XCNT(j)  (256  + 64 * (j))
#define XB_XSUB(j)  (1280 + 64 * (j))
#define XB_XGEN(j)  (2304 + 64 * (j))
#define XB_TOP      3328
#define XB_TOPGEN   3392
#define XCD_BAR_WORDS 3456
#define XB_SPIN_CAP (1u << 18)
__device__ __forceinline__ unsigned xb_ld(unsigned* p)              { return __hip_atomic_load(p, __ATOMIC_RELAXED, __HIP_MEMORY_SCOPE_AGENT); }
__device__ __forceinline__ unsigned xb_add(unsigned* p, unsigned v) { return __hip_atomic_fetch_add(p, v, __ATOMIC_RELAXED, __HIP_MEMORY_SCOPE_AGENT); }
__device__ __forceinline__ unsigned xb_xcc_id() { return (unsigned)__builtin_amdgcn_s_getreg((3 << 11) | 20) & 0xFu; }
#define XB_SPIN(cond, bar) do { unsigned _sp = 0; while (cond) { __builtin_amdgcn_s_sleep(1); \
    if ((++_sp & 255u) == 0u) { if (xb_ld(&(bar)[XB_TMO])) break; if (_sp > XB_SPIN_CAP) { atomicAdd(&(bar)[XB_TMO], 1u); break; } } } } while (0)
struct XcdBarrier { unsigned* bar; unsigned x; volatile LAS unsigned* st; };
__device__ __forceinline__ XcdBarrier xcd_barrier_post(unsigned* bar, volatile LAS unsigned* st) {
    XcdBarrier b; b.bar = bar; b.x = xb_xcc_id(); b.st = st;
    if (threadIdx.x == 0) (void)xb_add(&bar[XB_XCNT(b.x)], 1u);
    return b;
}
__device__ __forceinline__ void xcd_barrier_complete(unsigned* bar, unsigned x, unsigned& nloc, unsigned& nx) {
    const unsigned G = gridDim.x * gridDim.y * gridDim.z;
    unsigned sum, cnt, mine, sp = 0u;
    for (;;) {
        sum = 0u; cnt = 0u; mine = 0u;
#pragma unroll
        for (unsigned j = 0; j < 16; ++j) { const unsigned c = xb_ld(&bar[XB_XCNT(j)]); sum += c; cnt += (c > 0u) ? 1u : 0u; mine = (j == x) ? c : mine; }
        if (sum == G) break;
        __builtin_amdgcn_s_sleep(1);
        if ((++sp & 255u) == 0u) { if (xb_ld(&bar[XB_TMO])) break; if (sp > XB_SPIN_CAP) { atomicAdd(&bar[XB_TMO], 1u); break; } }
    }
    nloc = mine > 0u ? mine : 1u; nx = cnt > 0u ? cnt : 1u;
}
__device__ __forceinline__ void xcd_barrier(const XcdBarrier& b) {
    asm volatile("s_waitcnt vmcnt(0)" ::: "memory");
    __syncthreads();
    if (threadIdx.x == 0) {
        unsigned* bar = b.bar;
        __builtin_amdgcn_s_waitcnt(0);
        unsigned nloc = b.st[0], nx = b.st[1];
        if (nloc == 0u) { xcd_barrier_complete(bar, b.x, nloc, nx); b.st[0] = nloc; b.st[1] = nx; }
        const unsigned old = xb_add(&bar[XB_XSUB(b.x)], 1u);
        const unsigned gen = old / nloc;
        if (old + 1u == (gen + 1u) * nloc) {
            __builtin_amdgcn_fence(__ATOMIC_RELEASE, "agent");
            asm volatile("s_waitcnt vmcnt(0)" ::: "memory");
            const unsigned og = xb_add(&bar[XB_TOP], 1u);
            const unsigned tg = og / nx;
            if (og + 1u == (tg + 1u) * nx) xb_add(&bar[XB_TOPGEN], 1u);
            else XB_SPIN(xb_ld(&bar[XB_TOPGEN]) == tg, bar);
            __builtin_amdgcn_fence(__ATOMIC_ACQUIRE, "agent");
            xb_add(&bar[XB_XGEN(b.x)], 1u);
            asm volatile("s_waitcnt vmcnt(0)" ::: "memory");
        } else {
            XB_SPIN(xb_ld(&bar[XB_XGEN(b.x)]) == gen, bar);
            __builtin_amdgcn_fence(__ATOMIC_ACQUIRE, "agent");
            asm volatile("s_waitcnt vmcnt(0)" ::: "memory");
        }
    }
    __syncthreads();
}

constexpr int LDS_MAIN = 64 * 1024;
constexpr int LDS_BYTES = LDS_MAIN + 16;
extern __shared__ __attribute__((aligned(16))) unsigned char smem_raw[];

#if MK_LAUNCHES != 1
__global__ void __launch_bounds__(256, 2) k_phase(P p, int ph) {
    float* sm = (float*)smem_raw; LAS unsigned char* lds = (LAS unsigned char*)smem_raw; const int bid = blockIdx.x, nb = gridDim.x;
    switch (ph) {
        case 0: phase0(p, bid, nb, sm); break;
        case 1: phase1(p, bid, nb, lds); break;
        case 2: phase2a(p, bid, nb, false); break;
        case 3: phase2b(p, bid, nb, lds); break;
        case 4: phase2c_m(p, bid, nb, lds); break;
        case 5: phase3q<0>(p, bid, nb, lds); break;
        case 6: phase4(p, bid, nb, lds); break;
        case 7: phase5(p, bid, nb, lds); break;
        case 8: phase6(p, bid, nb, sm); break;
        case 9: phase7a_m(p, bid, nb, lds); break;
        case 10: phase7b_m(p, bid, nb, lds); break;
        case 11: phase8(p, bid, nb, p.out); break;
    }
}
#endif

#ifndef PROF_SEL
#define PROF_SEL -1
#endif
#define PROF_MULT 4
__global__ void __launch_bounds__(256, 2) k_mega(P p) {
    float* sm = (float*)smem_raw; LAS unsigned char* lds = (LAS unsigned char*)smem_raw; const int bid = blockIdx.x, nb = gridDim.x;
    volatile LAS unsigned* st = (volatile LAS unsigned*)(lds + LDS_MAIN);
    if (threadIdx.x < 4) st[threadIdx.x] = 0u;
    __syncthreads();
    const XcdBarrier gb = xcd_barrier_post(p.bar, st);
    unsigned long long t_last = 0, t_sel = 0;
#define STAMP(k) do { if (PROF_SEL >= 0 && PROF_SEL < 100) { const unsigned long long t_ = __builtin_amdgcn_s_memrealtime(); if (PROF_SEL == (k) - 1) t_sel = t_ - t_last; t_last = t_; } } while (0)
#define BAR(k) do { if (PROF_SEL == 100 + (k)) { const unsigned long long ta_ = __builtin_amdgcn_s_memrealtime(); xcd_barrier(gb); const unsigned long long tb_ = __builtin_amdgcn_s_memrealtime(); \
        if (threadIdx.x == 0) atomicAdd(p.bar + XCD_BAR_WORDS, (unsigned)(tb_ - ta_)); } else xcd_barrier(gb); STAMP((k) + 1); } while (0)
    STAMP(0);
    phase0(p, bid, nb, sm); BAR(0);
    phase1(p, bid, nb, lds); BAR(1);
    phase2a(p, bid, nb, false); BAR(2);
    phase2b(p, bid, nb, lds); phase2c_m(p, bid, nb, lds); BAR(3);
    phase3q<0>(p, bid, nb, lds); expert_conv(p, bid, nb, sm); BAR(4);
    phase4(p, bid, nb, lds); BAR(5);
    phase5(p, bid, nb, lds); BAR(6);
    phase6(p, bid, nb, sm); BAR(7);
    phase7a_m(p, bid, nb, lds); BAR(8);
    phase7b_m(p, bid, nb, lds); BAR(9);
    phase8(p, bid, nb, p.out);
    if (PROF_SEL >= 0) {
        xcd_barrier(gb); STAMP(11);
        if (bid == 0 && threadIdx.x == 0) {
            unsigned long long metric = t_sel;
            if (PROF_SEL >= 100) metric = __hip_atomic_load(p.bar + XCD_BAR_WORDS, __ATOMIC_RELAXED, __HIP_MEMORY_SCOPE_AGENT) / (unsigned)nb;
            const unsigned long long t0 = __builtin_amdgcn_s_memrealtime();
            while (__builtin_amdgcn_s_memrealtime() - t0 < metric * PROF_MULT) __builtin_amdgcn_s_sleep(8);
        }
    }
}

extern "C" void kernel_launch(void* const* d_in, const int* in_sizes, int n_in, void* d_out, int out_size, void* d_ws, size_t ws_size, hipStream_t stream) {
    P p{};
    p.x = (const float*)d_in[0]; p.pos = (const int*)d_in[1]; p.g_attn = (const float*)d_in[2]; p.w_in = (const float*)d_in[3]; p.g_cq = (const float*)d_in[4];
    p.w_uq = (const float*)d_in[5]; p.g_ckv = (const float*)d_in[6]; p.w_uk = (const float*)d_in[7]; p.w_uv = (const float*)d_in[8]; p.w_o_attn = (const float*)d_in[9];
    p.sgu_gain = (const float*)d_in[10]; p.sgu_bias = (const float*)d_in[11]; p.w_sp = (const float*)d_in[12]; p.b_sp = (const float*)d_in[13]; p.w_o_sgu = (const float*)d_in[14];
    p.w_out = (const float*)d_in[15]; p.g_ffn = (const float*)d_in[16]; p.w_rg = (const float*)d_in[17]; p.b_rg = (const float*)d_in[18]; p.w_re = (const float*)d_in[19];
    p.b_re = (const float*)d_in[20]; p.w_eg = (const float*)d_in[21]; p.w_eu = (const float*)d_in[22]; p.w_ed = (const float*)d_in[23]; p.g_final = (const float*)d_in[24];
    p.out = (float*)d_out;
    unsigned char* w = (unsigned char*)d_ws; size_t off = 0;
    auto take = [&](size_t bytes) { unsigned char* r = w + off; off += (bytes + 255) & ~(size_t)255; return r; };
    p.bar = (unsigned*)take((XCD_BAR_WORDS + 64) * 4);
    p.cnt = (int*)take(4096);
    p.WinT = (bf16_t*)take((size_t)ZP * DM * 2); p.WuqT = (bf16_t*)take(768 * 256 * 2); p.WukT = (bf16_t*)take(512 * 128 * 2); p.WuvT = (bf16_t*)take(512 * 128 * 2);
    p.WoaT = (bf16_t*)take(1024 * 512 * 2); p.WosT = (bf16_t*)take(1024 * 512 * 2); p.WoutT = (bf16_t*)take(1024 * 1024 * 2); p.Wsp = (bf16_t*)take(8 * 128 * 128 * 2);
    p.cs = (float*)take((size_t)NT * 32 * 4); p.cqn = (bf16_t*)take((size_t)NT * 256 * 2); p.ckvn = (bf16_t*)take((size_t)NT * 128 * 2);
    p.list = (int*)take((size_t)NE * NT * 4); p.aw = (float*)take((size_t)2 * NT * 4); p.aexp = (int*)take((size_t)2 * NT * 4);
    p.slotA = (bf16_t*)take((size_t)NT * DM * 2);
    p.slotB = take((size_t)NT * 512 * 4);
    p.slotC = (bf16_t*)take((size_t)NT * 1024 * 2);
    p.slotD = (bf16_t*)take((size_t)NT * 2048 * 2);
    p.slotE = (bf16_t*)take((size_t)NT * NH * 96 * 2);
    p.slotF = (bf16_t*)take((size_t)512 * NT * 2);
    p.slotG = (bf16_t*)take((size_t)NT * 512 * 2);
    if (off > ws_size) { fprintf(stderr, "workspace too small: need %zu have %zu\n", off, ws_size); return; }
#if MK_LAUNCHES == 1
    static int grid_blocks = 0;
    if (!grid_blocks) { int dev = 0, cus = 0, per_cu = 0; hipGetDevice(&dev); hipDeviceGetAttribute(&cus, hipDeviceAttributeMultiprocessorCount, dev);
        hipOccupancyMaxActiveBlocksPerMultiprocessor(&per_cu, k_mega, 256, LDS_BYTES); if (per_cu > 2) per_cu = 2; grid_blocks = cus * per_cu; }
    (void)hipMemsetAsync(p.bar, 0, (XCD_BAR_WORDS + 64) * 4, stream);
    void* args[] = {&p};
    hipError_t e = hipLaunchCooperativeKernel((void*)k_mega, dim3(grid_blocks), dim3(256), args, LDS_BYTES, stream);
    if (e != hipSuccess) fprintf(stderr, "cooperative launch failed: %s (grid %d)\n", hipGetErrorString(e), grid_blocks);
#else
    for (int ph = 0; ph < 12; ++ph) k_phase<<<2048, 256, LDS_BYTES, stream>>>(p, ph);
#endif
}
```

```cpp
#include <hip/hip_runtime.h>
#include <hip/hip_cooperative_groups.h>
#include <cstdint>
#include <cstdio>
namespace cg = cooperative_groups;

#ifndef ATT_SGB
#define ATT_SGB 1
#endif
#ifndef PROBE
#define PROBE 0
#endif
#ifndef MK_LAUNCHES
#define MK_LAUNCHES 1
#endif

typedef unsigned short bf16_t;
constexpr int NT = 16384, SEQ = 8192, DM = 1024, NBATCH = 2;
constexpr int ZC = 3488;
constexpr int ZP = 3584;
constexpr int NH = 8;
constexpr float EPS = 1e-6f;
constexpr int NE = 32;
constexpr int LDS_TAB_ = 64 * 1024 + 16;

struct P {
    const float* x; const int* pos; const float* g_attn; const float* w_in; const float* g_cq; const float* w_uq;
    const float* g_ckv; const float* w_uk; const float* w_uv; const float* w_o_attn; const float* sgu_gain; const float* sgu_bias;
    const float* w_sp; const float* b_sp; const float* w_o_sgu; const float* w_out; const float* g_ffn; const float* w_rg;
    const float* b_rg; const float* w_re; const float* b_re; const float* w_eg; const float* w_eu; const float* w_ed; const float* g_final;
    float* out;
    unsigned* bar;
    int* cnt;
    bf16_t* WinT;
    bf16_t* WuqT;
    bf16_t* WukT;
    bf16_t* WuvT;
    bf16_t* WoaT;
    bf16_t* WosT;
    bf16_t* WoutT;
    bf16_t* Wsp;
    float* cs;
    bf16_t* cqn;
    bf16_t* ckvn;
    int* list;
    float* aw;
    int* aexp;
    bf16_t* slotA;
    unsigned char* slotB;
    bf16_t* slotC;
    bf16_t* slotD;
    bf16_t* slotE;
    bf16_t* slotF;
    bf16_t* slotG;
};

__device__ __forceinline__ int opaque_tid() { int t = threadIdx.x; asm volatile("" : "+v"(t)); return t; }
__device__ __forceinline__ float bf2f(bf16_t v) { return __uint_as_float(((unsigned)v) << 16); }
__device__ __forceinline__ bf16_t f2bf(float f) { unsigned u = __float_as_uint(f); u += 0x7fffu + ((u >> 16) & 1u); return (bf16_t)(u >> 16); }
__device__ __forceinline__ float dot8(const uint4 a, const uint4 b) {
    float s = 0.f;
    s += __uint_as_float(a.x << 16) * __uint_as_float(b.x << 16) + __uint_as_float(a.x & 0xffff0000u) * __uint_as_float(b.x & 0xffff0000u);
    s += __uint_as_float(a.y << 16) * __uint_as_float(b.y << 16) + __uint_as_float(a.y & 0xffff0000u) * __uint_as_float(b.y & 0xffff0000u);
    s += __uint_as_float(a.z << 16) * __uint_as_float(b.z << 16) + __uint_as_float(a.z & 0xffff0000u) * __uint_as_float(b.z & 0xffff0000u);
    s += __uint_as_float(a.w << 16) * __uint_as_float(b.w << 16) + __uint_as_float(a.w & 0xffff0000u) * __uint_as_float(b.w & 0xffff0000u);
    return s;
}
__device__ __forceinline__ float wsum(float v) { for (int o = 32; o > 0; o >>= 1) v += __shfl_xor(v, o); return v; }

#define DPP_F(v, ctrl) __builtin_bit_cast(float, __builtin_amdgcn_update_dpp(0, __builtin_bit_cast(int, (v)), (ctrl), 0xF, 0xF, true))
__device__ __forceinline__ float xrows(float v) {
    { const auto r = __builtin_amdgcn_permlane16_swap(__float_as_uint(v), __float_as_uint(v), false, false); v = __uint_as_float(r[0]) + __uint_as_float(r[1]); }
    { const auto r = __builtin_amdgcn_permlane32_swap(__float_as_uint(v), __float_as_uint(v), false, false); v = __uint_as_float(r[0]) + __uint_as_float(r[1]); }
    return v;
}
__device__ __forceinline__ float wsumf(float v) {
    v += DPP_F(v, 0xB1); v += DPP_F(v, 0x4E); v += DPP_F(v, 0x141); v += DPP_F(v, 0x140); return xrows(v);
}
__device__ __forceinline__ float wsum_par(float v) {
    v += DPP_F(v, 0x128); v += DPP_F(v, 0x124); v += DPP_F(v, 0x122); return xrows(v);
}
__device__ __forceinline__ float wmax(float v) { for (int o = 32; o > 0; o >>= 1) v = fmaxf(v, __shfl_xor(v, o)); return v; }
__device__ __forceinline__ float fsigmoid(float v) { return __builtin_amdgcn_rcpf(1.f + __builtin_amdgcn_exp2f(-1.4426950408889634f * v)); }
__device__ __forceinline__ float fgelu(float v) { const float u2 = 1.5957691216057308f * (v + 0.044715f * v * v * v); return v * fsigmoid(u2); }
__device__ __forceinline__ float gelu_tanh(float v) { const float u = 0.7978845608028654f * (v + 0.044715f * v * v * v); const float t = 1.f - 2.f / (__expf(2.f * u) + 1.f); return 0.5f * v * (1.f + t); }
__device__ __forceinline__ float sigmoidf_(float v) { return 1.f / (1.f + __expf(-v)); }

#define LAS __attribute__((address_space(3)))
typedef short bf16x8 __attribute__((ext_vector_type(8)));
typedef float f32x4 __attribute__((ext_vector_type(4)));
constexpr int GEMM_LDS = 65536;
typedef float f32x16 __attribute__((ext_vector_type(16)));
typedef unsigned u32x2 __attribute__((ext_vector_type(2)));
typedef unsigned u32x4 __attribute__((ext_vector_type(4)));
typedef __bf16 bf16v2 __attribute__((ext_vector_type(2)));
typedef float f32v2 __attribute__((ext_vector_type(2)));
__device__ __forceinline__ unsigned pk2(float lo, float hi) { const f32v2 v = {lo, hi}; return __builtin_bit_cast(unsigned, __builtin_convertvector(v, bf16v2)); }


template <class F>
__device__ __forceinline__ int tconv(bf16_t* dst, int R, int K, F f, int base, int bid, int nb, float* sm) {
    const int tid = opaque_tid(), tk = K / 64, ntile = (R / 64) * tk;
    for (int tile = ((bid - base) % nb + nb) % nb; tile < ntile; tile += nb) {
        const int rho0 = (tile / tk) * 64, k0 = (tile % tk) * 64;
#pragma unroll
        for (int i = 0; i < 16; ++i) { const int kk = (tid >> 6) + 4 * i, rr = tid & 63; sm[kk * 65 + rr] = f(k0 + kk, rho0 + rr); }
        __syncthreads();
#pragma unroll
        for (int i = 0; i < 8; ++i) { const int rr = (tid >> 5) + 8 * i, kk = (tid & 31) * 2;
            *(unsigned*)(dst + (size_t)(rho0 + rr) * K + k0 + kk) = pk2(sm[kk * 65 + rr], sm[(kk + 1) * 65 + rr]); }
        __syncthreads();
    }
    return base + ntile;
}

__device__ __forceinline__ void phase0(const P& p, int bid, int nb, float* sm) {
    const int tid = opaque_tid(), lane = tid & 63, wid = tid >> 6;
    const size_t gtid = (size_t)bid * 256 + tid, gsz = (size_t)nb * 256;
    if (bid == 0 && tid < NE) p.cnt[tid] = 0;
    for (int t = bid * 4 + wid; t < NT; t += nb * 4) {
        const float* xr = p.x + (size_t)t * DM; f32x4 v[4]; float ss = 0.f;
#pragma unroll
        for (int i = 0; i < 4; ++i) { v[i] = *(const f32x4*)(xr + (lane + 64 * i) * 4); ss += v[i][0] * v[i][0] + v[i][1] * v[i][1] + v[i][2] * v[i][2] + v[i][3] * v[i][3]; }
        ss = wsumf(ss); const float r = rsqrtf(ss * (1.f / DM) + EPS);
        bf16_t* hr = p.slotA + (size_t)t * DM;
#pragma unroll
        for (int i = 0; i < 4; ++i) { uint2 o; o.x = pk2(v[i][0] * r, v[i][1] * r); o.y = pk2(v[i][2] * r, v[i][3] * r); *(uint2*)(hr + (lane + 64 * i) * 4) = o; }
    }
    int base = 0;
    base = tconv(p.WinT, ZP, DM, [&](int k, int rho) { float v = 0.f;
        if (rho < 416) v = p.w_in[(size_t)k * ZC + rho]; else if (rho >= 512) v = p.w_in[(size_t)k * ZC + rho - 96];
        return v * p.g_attn[k]; }, base, bid, nb, sm);
    const float qscale = 0.10206207261596575f * 1.4426950408889634f;
    base = tconv(p.WuqT, 768, 256, [&](int k, int rho) { int col;
        if (rho < 512) col = (rho >> 6) * 96 + (rho & 63); else { const int hh = (rho - 512) >> 5, w = (rho - 512) & 31; col = hh * 96 + 64 + (w >> 1) + 16 * (w & 1); }
        return p.w_uq[(size_t)k * 768 + col] * p.g_cq[k] * qscale; }, base, bid, nb, sm);
    base = tconv(p.WukT, 512, 128, [&](int k, int c) { return p.w_uk[(size_t)k * 512 + c] * p.g_ckv[k]; }, base, bid, nb, sm);
    base = tconv(p.WuvT, 512, 128, [&](int k, int c) { return p.w_uv[(size_t)k * 512 + c] * p.g_ckv[k]; }, base, bid, nb, sm);
    base = tconv(p.WoaT, 1024, 512, [&](int k, int n) { return p.w_o_attn[(size_t)k * 1024 + n]; }, base, bid, nb, sm);
    base = tconv(p.WosT, 1024, 512, [&](int k, int n) { return p.w_o_sgu[(size_t)k * 1024 + n]; }, base, bid, nb, sm);
    base = tconv(p.WoutT, 1024, 1024, [&](int k, int n) { return p.w_out[(size_t)k * 1024 + n]; }, base, bid, nb, sm);
    for (size_t i = gtid; i < (size_t)8 * 128 * 128; i += gsz) { const int j = (int)(i & 127), ii = (int)((i >> 7) & 127);
        p.Wsp[i] = ((j >> 6) <= (ii >> 6)) ? f2bf(p.w_sp[i]) : (bf16_t)0; }
}

template <class Epi>
__device__ void ngemm(const bf16_t* A, int lda, const bf16_t* Bt, int ldb, int M, int N, int K, Epi epi, int bid, int nb, float* sm) {
    float* As = sm; float* Bs = sm + 16 * 68;
    const int tid = opaque_tid(), ty = tid >> 4, tx = tid & 15; const int tn = N / 64, ntile = (M / 64) * tn;
    for (int tile = bid; tile < ntile; tile += nb) {
        const int row0 = (tile / tn) * 64, col0 = (tile % tn) * 64;
        float acc[4][4];
#pragma unroll
        for (int i = 0; i < 4; ++i)
#pragma unroll
            for (int j = 0; j < 4; ++j) acc[i][j] = 0.f;
        for (int k0 = 0; k0 < K; k0 += 16) {
#pragma unroll
            for (int i = 0; i < 4; ++i) { const int idx = tid + i * 256, r = idx >> 4, kk = idx & 15;
                As[kk * 68 + r] = bf2f(A[(size_t)(row0 + r) * lda + k0 + kk]);
                Bs[kk * 68 + r] = bf2f(Bt[(size_t)(col0 + r) * ldb + k0 + kk]); }
            __syncthreads();
#pragma unroll
            for (int kk = 0; kk < 16; ++kk) { float a[4], b[4];
#pragma unroll
                for (int i = 0; i < 4; ++i) { a[i] = As[kk * 68 + ty * 4 + i]; b[i] = Bs[kk * 68 + tx * 4 + i]; }
#pragma unroll
                for (int i = 0; i < 4; ++i)
#pragma unroll
                    for (int j = 0; j < 4; ++j) acc[i][j] += a[i] * b[j]; }
            __syncthreads();
        }
#pragma unroll
        for (int i = 0; i < 4; ++i) epi(row0 + ty * 4 + i, col0 + tx * 4, acc[i]);
    }
}


__device__ __forceinline__ bool tile_of(int it, int bid, int nb, int RT, int CT, int& rt, int& ct) {
    if ((RT & 31) == 0 && (nb & 7) == 0) {
        const int x = bid & 7, l = bid >> 3, nl = nb >> 3, rpx = RT >> 3; const int lt = l + it * nl; if (lt >= rpx * CT) return false;
        const int rg = lt / (4 * CT), w = lt % (4 * CT); rt = x * rpx + rg * 4 + (w & 3); ct = w >> 2; return true;
    }
    const int tile = bid + it * nb; if (tile >= RT * CT) return false; rt = tile / CT; ct = tile % CT; return true;
}
struct GOps { const bf16_t* a0; const bf16_t* a1; const bf16_t* a2; const bf16_t* a3; const bf16_t* bp; size_t bstep; };
__device__ __forceinline__ GOps gops(const bf16_t* ap, size_t astep, const bf16_t* bp, size_t bstep) { GOps g; g.a0 = ap; g.a1 = ap + astep; g.a2 = ap + 2 * astep; g.a3 = ap + 3 * astep; g.bp = bp; g.bstep = bstep; return g; }
__device__ __forceinline__ void mg_stage(const GOps& g, int t, LAS unsigned char* lds, int widu) {
    LAS unsigned char* d = lds + (t & 1) * 32768 + widu * 1024; const int k0 = t * 64;
    __builtin_amdgcn_global_load_lds((const unsigned*)(g.a0 + k0), (LAS unsigned*)(d), 16, 0, 0);
    __builtin_amdgcn_global_load_lds((const unsigned*)(g.a1 + k0), (LAS unsigned*)(d + 4096), 16, 0, 0);
    __builtin_amdgcn_global_load_lds((const unsigned*)(g.a2 + k0), (LAS unsigned*)(d + 8192), 16, 0, 0);
    __builtin_amdgcn_global_load_lds((const unsigned*)(g.a3 + k0), (LAS unsigned*)(d + 12288), 16, 0, 0);
#pragma unroll
    for (int i = 0; i < 4; ++i) __builtin_amdgcn_global_load_lds((const unsigned*)(g.bp + i * g.bstep + k0), (LAS unsigned*)(d + 16384 + i * 4096), 16, 0, 0);
}
__device__ __forceinline__ void mg_kloop_p(f32x4 (&acc)[4][4], const GOps& g, int nk, LAS unsigned char* lds, bool prestaged, bool has_next, const GOps& nxt) {
    const int tid = opaque_tid(), lane = tid & 63, wid = tid >> 6, wr = wid >> 1, wc = wid & 1, fr = lane & 15, fq = lane >> 4;
    const int widu = __builtin_amdgcn_readfirstlane(wid);
    if (!prestaged) mg_stage(g, 0, lds, widu);
    const int pc0 = ((fq) ^ (fr & 7)) * 16, pc1 = ((4 + fq) ^ (fr & 7)) * 16;
    for (int t = 0; t < nk; ++t) {
        asm volatile("s_waitcnt vmcnt(0)" ::: "memory");
        __syncthreads();
        if (t + 1 < nk) mg_stage(g, t + 1, lds, widu); else if (has_next) mg_stage(nxt, 0, lds, widu);
        const LAS unsigned char* ab = lds + (t & 1) * 32768 + (wr * 64 + fr) * 128; const LAS unsigned char* bb = lds + (t & 1) * 32768 + 16384 + (wc * 64 + fr) * 128;
        bf16x8 af[2][4], bfr[2][4];
#pragma unroll
        for (int m = 0; m < 4; ++m) { af[0][m] = *(const LAS bf16x8*)(ab + m * 2048 + pc0); bfr[0][m] = *(const LAS bf16x8*)(bb + m * 2048 + pc0); }
#pragma unroll
        for (int m = 0; m < 4; ++m) { af[1][m] = *(const LAS bf16x8*)(ab + m * 2048 + pc1); bfr[1][m] = *(const LAS bf16x8*)(bb + m * 2048 + pc1); }
        __builtin_amdgcn_sched_barrier(0);
#pragma unroll
        for (int ks = 0; ks < 2; ++ks)
#pragma unroll
            for (int m = 0; m < 4; ++m)
#pragma unroll
                for (int n = 0; n < 4; ++n) acc[m][n] = __builtin_amdgcn_mfma_f32_16x16x32_bf16(bfr[ks][n], af[ks][m], acc[m][n], 0, 0, 0);
    }
}
template <class Epi>
__device__ __forceinline__ void mgemm(const bf16_t* A, int lda, const bf16_t* Bt, int ldb, int M, int N, int K, Epi epi, int bid, int nb, LAS unsigned char* lds) {
    const int tid = opaque_tid(), lane = tid & 63, wid = tid >> 6, wr = wid >> 1, wc = wid & 1, fr = lane & 15, fq = lane >> 4;
    const int RT = M / 128, CT = N / 128; const int c8 = ((tid & 7) ^ ((tid >> 3) & 7)) * 8;
    int rt, ct; bool have = tile_of(0, bid, nb, RT, CT, rt, ct);
    GOps cur = gops(A + (size_t)(rt * 128 + (tid >> 3)) * lda + c8, (size_t)32 * lda, Bt + (size_t)(ct * 128 + (tid >> 3)) * ldb + c8, (size_t)32 * ldb);
    for (int it = 0; have; ++it) {
        const int row0 = rt * 128, col0 = ct * 128;
        int rt2, ct2; const bool have2 = tile_of(it + 1, bid, nb, RT, CT, rt2, ct2);
        const GOps nxt = gops(A + (size_t)((have2 ? rt2 : rt) * 128 + (tid >> 3)) * lda + c8, (size_t)32 * lda, Bt + (size_t)((have2 ? ct2 : ct) * 128 + (tid >> 3)) * ldb + c8, (size_t)32 * ldb);
        f32x4 acc[4][4];
#pragma unroll
        for (int m = 0; m < 4; ++m)
#pragma unroll
            for (int n = 0; n < 4; ++n) acc[m][n] = (f32x4){0.f, 0.f, 0.f, 0.f};
        mg_kloop_p(acc, cur, K / 64, lds, it > 0, have2, nxt);
#pragma unroll
        for (int m = 0; m < 4; ++m)
#pragma unroll
            for (int n = 0; n < 4; ++n) epi(row0 + wr * 64 + m * 16 + fr, col0 + wc * 64 + n * 16 + fq * 4, acc[m][n]);
        cur = nxt; rt = rt2; ct = ct2; have = have2;
    }
    __syncthreads();
}

__device__ __forceinline__ void phase1(const P& p, int bid, int nb, LAS unsigned char* sm) {
    float* zs = (float*)p.slotB; bf16_t* uvg = p.slotC; bf16_t* gates = p.slotD;
    mgemm(p.slotA, DM, p.WinT, DM, NT, ZP, DM, [=](int t, int c, const f32x4& v) {
        if (c < 512) *(f32x4*)(zs + (size_t)t * 512 + c) = v;
        else if (c < 1536) { uint2 o; o.x = pk2(fgelu(v[0]), fgelu(v[1])); o.y = pk2(fgelu(v[2]), fgelu(v[3])); *(uint2*)(uvg + (size_t)t * 1024 + c - 512) = o; }
        else { uint2 o; o.x = pk2(fsigmoid(v[0]), fsigmoid(v[1])); o.y = pk2(fsigmoid(v[2]), fsigmoid(v[3])); *(uint2*)(gates + (size_t)t * 2048 + c - 1536) = o; }
    }, bid, nb, sm);
}

__device__ __forceinline__ void phase2a(const P& p, int bid, int nb, bool dry) {
    const int tid = opaque_tid(), lane = tid & 63, wid = tid >> 6;
    const float* zs = (const float*)p.slotB; bf16_t* K = p.slotE; bf16_t* uvg = p.slotC;
    const f32x4 gn0 = *(const f32x4*)(p.sgu_gain + lane * 8), gn1 = *(const f32x4*)(p.sgu_gain + lane * 8 + 4);
    const f32x4 bs0 = *(const f32x4*)(p.sgu_bias + lane * 8), bs1 = *(const f32x4*)(p.sgu_bias + lane * 8 + 4);
    for (int t = bid * 4 + wid; t < NT; t += nb * 4) {
        const float* z = zs + (size_t)t * 512;
        const f32x4 cq = *(const f32x4*)(z + lane * 4);
        const f32x4 ck = *(const f32x4*)(z + 256 + (lane & 31) * 4);
        bf16_t* vr = uvg + (size_t)t * 1024 + 512 + lane * 8;
        const uint4 vraw = *(const uint4*)vr;
        { const float ss = wsumf(cq[0] * cq[0] + cq[1] * cq[1] + cq[2] * cq[2] + cq[3] * cq[3]); const float r = rsqrtf(ss * (1.f / 256.f) + EPS);
          uint2 o; o.x = pk2(cq[0] * r, cq[1] * r); o.y = pk2(cq[2] * r, cq[3] * r); *(uint2*)(p.cqn + (size_t)t * 256 + lane * 4) = o; }
        { const float ss = wsumf(lane < 32 ? ck[0] * ck[0] + ck[1] * ck[1] + ck[2] * ck[2] + ck[3] * ck[3] : 0.f); const float r = rsqrtf(ss * (1.f / 128.f) + EPS);
          if (lane < 32) { uint2 o; o.x = pk2(ck[0] * r, ck[1] * r); o.y = pk2(ck[2] * r, ck[3] * r); *(uint2*)(p.ckvn + (size_t)t * 128 + lane * 4) = o; } }
        { const int b = t >> 13, sq = t & 8191, hd = lane >> 3, j = lane & 7; const float posf = (float)p.pos[t]; float val[4], tab[4];
#pragma unroll
          for (int q = 0; q < 4; ++q) { const int i = (4 * j + q) & 15;
              float f = (i & 3) == 0 ? 1.0f : (i & 3) == 1 ? 0.5623413251903491f : (i & 3) == 2 ? 0.31622776601683794f : 0.1778279410038923f;
              const int q4 = i >> 2; f *= (q4 == 0 ? 1.0f : q4 == 1 ? 0.1f : q4 == 2 ? 0.01f : 0.001f);
              const float ang = posf * f; const double rev = (double)ang * 0.15915494309189535; const float frc = (float)(rev - floor(rev));
              const float sn = __builtin_amdgcn_sinf(frc), cn = __builtin_amdgcn_cosf(frc);
              const float k1 = z[384 + i], k2 = z[400 + i];
              val[q] = (j < 4) ? (k1 * cn - k2 * sn) : (k1 * sn + k2 * cn); tab[q] = (j < 4) ? cn : sn; }
          uint2 o; o.x = pk2(val[0], val[1]); o.y = pk2(val[2], val[3]);
          *(uint2*)(K + ((size_t)(b * NH + hd) * SEQ + sq) * 96 + 64 + 4 * j) = o;
          if (hd == 0) *(f32x4*)(p.cs + (size_t)t * 32 + 4 * j) = (f32x4){tab[0], tab[1], tab[2], tab[3]}; }
        { float v[8]; const unsigned w[4] = {vraw.x, vraw.y, vraw.z, vraw.w};
#pragma unroll
          for (int i = 0; i < 4; ++i) { v[2 * i] = __uint_as_float(w[i] << 16); v[2 * i + 1] = __uint_as_float(w[i] & 0xffff0000u); }
          float sm_ = 0.f;
#pragma unroll
          for (int i = 0; i < 8; ++i) sm_ += v[i];
          sm_ = wsumf(sm_); const float mu = sm_ * (1.f / 512.f); float q = 0.f;
#pragma unroll
          for (int i = 0; i < 8; ++i) { const float d = v[i] - mu; q += d * d; }
          q = wsumf(q); const float r = rsqrtf(q * (1.f / 512.f) + EPS);
          uint4 o;
          o.x = pk2((v[0] - mu) * r * gn0[0] + bs0[0], (v[1] - mu) * r * gn0[1] + bs0[1]); o.y = pk2((v[2] - mu) * r * gn0[2] + bs0[2], (v[3] - mu) * r * gn0[3] + bs0[3]);
          o.z = pk2((v[4] - mu) * r * gn1[0] + bs1[0], (v[5] - mu) * r * gn1[1] + bs1[1]); o.w = pk2((v[6] - mu) * r * gn1[2] + bs1[2], (v[7] - mu) * r * gn1[3] + bs1[3]);
          *(uint4*)(dry ? p.slotG + (size_t)t * 512 + lane * 8 : vr) = o; }
    }
}

__device__ __forceinline__ void phase2b(const P& p, int bid, int nb, LAS unsigned char* sm) {
    bf16_t* Q = p.slotA; bf16_t* K = p.slotE; bf16_t* VT = p.slotF; const float* cs = p.cs;
    mgemm(p.cqn, 256, p.WuqT, 256, NT, 768, 256, [=](int t, int c, const f32x4& v) {
        const int b = t >> 13, s = t & 8191;
        if (c < 512) { const int h = c >> 6, d = c & 63; uint2 o; o.x = pk2(v[0], v[1]); o.y = pk2(v[2], v[3]); *(uint2*)(Q + ((size_t)(b * NH + h) * SEQ + s) * 96 + d) = o; }
        else { const int h = (c - 512) >> 5, i0 = ((c - 512) & 31) >> 1; bf16_t* q = Q + ((size_t)(b * NH + h) * SEQ + s) * 96;
            const float2 cn = *(const float2*)(cs + (size_t)t * 32 + i0), sn = *(const float2*)(cs + (size_t)t * 32 + 16 + i0);
            *(unsigned*)(q + 64 + i0) = pk2(v[0] * cn.x - v[1] * sn.x, v[2] * cn.y - v[3] * sn.y);
            *(unsigned*)(q + 80 + i0) = pk2(v[0] * sn.x + v[1] * cn.x, v[2] * sn.y + v[3] * cn.y); }
    }, bid, nb, sm);
    mgemm(p.ckvn, 128, p.WukT, 128, NT, 512, 128, [=](int t, int c, const f32x4& v) {
        const int b = t >> 13, s = t & 8191, h = c >> 6, d = c & 63; uint2 o; o.x = pk2(v[0], v[1]); o.y = pk2(v[2], v[3]);
        *(uint2*)(K + ((size_t)(b * NH + h) * SEQ + s) * 96 + d) = o;
    }, bid, nb, sm);
    mgemm(p.WuvT, 128, p.ckvn, 128, 512, NT, 128, [=](int r, int t, const f32x4& v) {
        uint2 o; o.x = pk2(v[0], v[1]); o.y = pk2(v[2], v[3]); *(uint2*)(VT + (size_t)r * NT + t) = o;
    }, bid, nb, sm);
}

__device__ __forceinline__ void phase2c(const P& p, int bid, int nb) {
    const bf16_t* uvg = p.slotC; bf16_t* su = p.slotG;
    for (size_t i = (size_t)bid * 256 + threadIdx.x; i < (size_t)NT * 512; i += (size_t)nb * 256) {
        const int t = (int)(i >> 9), c = (int)(i & 511), g = c >> 6, ii = t & 127, t0 = t - ii;
        const bf16_t* w = p.Wsp + ((size_t)g * 128 + ii) * 128; float s = 0.f;
        for (int j = 0; j < 128; ++j) s += bf2f(w[j]) * bf2f(uvg[(size_t)(t0 + j) * 1024 + 512 + c]);
        s += p.b_sp[g * 128 + ii];
        su[i] = f2bf(bf2f(uvg[(size_t)t * 1024 + c]) * s);
    }
}


__device__ __forceinline__ void phase2c_m(const P& p, int bid, int nb, LAS unsigned char* lds) {
    const bf16_t* uvg = p.slotC; bf16_t* su = p.slotG;
    const int tid = opaque_tid(), lane = tid & 63, wid = tid >> 6, fr = lane & 15, fq = lane >> 4;
    const int c8 = ((tid & 7) ^ ((tid >> 3) & 7)) * 8;
    for (int u = bid; u < 1024; u += nb) {
        const int g = u & 7, t0 = (u >> 3) * 128;
        { const bf16_t* wp = p.Wsp + ((size_t)g * 128 + (tid >> 3)) * 128 + c8; LAS unsigned char* d = lds + tid * 16;
#pragma unroll
          for (int ks = 0; ks < 2; ++ks)
#pragma unroll
              for (int i = 0; i < 4; ++i) __builtin_amdgcn_global_load_lds((const unsigned*)(wp + (size_t)i * 32 * 128 + ks * 64), (LAS unsigned*)(d + ks * 16384 + i * 4096), 16, 0, 0); }
#pragma unroll
        for (int i = 0; i < 4; ++i) { const int q = tid + 256 * i, j = q >> 3, c0 = (q & 7) * 8;
            const uint4 v = *(const uint4*)(uvg + (size_t)(t0 + j) * 1024 + 512 + g * 64 + c0);
            const unsigned w[4] = {v.x, v.y, v.z, v.w};
            LAS unsigned char* bimg = lds + 32768 + (j >> 6) * 8192 + (j & 7) * 2; const int lc = (j & 63) >> 3;
#pragma unroll
            for (int e = 0; e < 8; ++e) { const int row = c0 + e; const bf16_t val = (bf16_t)((e & 1) ? (w[e >> 1] >> 16) : (w[e >> 1] & 0xffffu));
                *(LAS bf16_t*)(bimg + row * 128 + ((lc ^ (row & 7)) * 16)) = val; } }
        asm volatile("s_waitcnt vmcnt(0)" ::: "memory");
        __syncthreads();
        f32x4 acc[2][4];
#pragma unroll
        for (int m = 0; m < 2; ++m)
#pragma unroll
            for (int n = 0; n < 4; ++n) acc[m][n] = (f32x4){0.f, 0.f, 0.f, 0.f};
#pragma unroll
        for (int ks = 0; ks < 2; ++ks)
#pragma unroll
            for (int k2 = 0; k2 < 2; ++k2) { const int pc = ((k2 * 4 + fq) ^ (fr & 7)) * 16; bf16x8 af[2], bfr[4];
#pragma unroll
                for (int m = 0; m < 2; ++m) af[m] = *(const LAS bf16x8*)(lds + ks * 16384 + (wid * 32 + m * 16 + fr) * 128 + pc);
#pragma unroll
                for (int n = 0; n < 4; ++n) bfr[n] = *(const LAS bf16x8*)(lds + 32768 + ks * 8192 + (n * 16 + fr) * 128 + pc);
#pragma unroll
                for (int m = 0; m < 2; ++m)
#pragma unroll
                    for (int n = 0; n < 4; ++n) acc[m][n] = __builtin_amdgcn_mfma_f32_16x16x32_bf16(bfr[n], af[m], acc[m][n], 0, 0, 0); }
#pragma unroll
        for (int m = 0; m < 2; ++m) { const int i = wid * 32 + m * 16 + fr; const float bs = p.b_sp[g * 128 + i];
#pragma unroll
            for (int n = 0; n < 4; ++n) { const int c = g * 64 + n * 16 + fq * 4;
                const uint2 uu = *(const uint2*)(uvg + (size_t)(t0 + i) * 1024 + c);
                uint2 o; o.x = pk2(__uint_as_float(uu.x << 16) * (acc[m][n][0] + bs), __uint_as_float(uu.x & 0xffff0000u) * (acc[m][n][1] + bs));
                o.y = pk2(__uint_as_float(uu.y << 16) * (acc[m][n][2] + bs), __uint_as_float(uu.y & 0xffff0000u) * (acc[m][n][3] + bs));
                *(uint2*)(su + (size_t)(t0 + i) * 512 + c) = o; } }
        __syncthreads();
    }
}

__device__ __forceinline__ void phase3(const P& p, int bid, int nb, float* sm) {
    float* sc = sm; float* qs = sm + 8192; float* red = qs + 96;
    const bf16_t* Q = p.slotA; const bf16_t* K = p.slotE; const bf16_t* VT = p.slotF; bf16_t* O = (bf16_t*)p.slotB;
    const int tid = opaque_tid();
    for (int row = bid; row < NBATCH * NH * SEQ; row += nb) {
        const int q = row % SEQ, bh = row / SEQ, nk = ((q >> 6) + 1) * 64;
        if (tid < 12) ((uint4*)qs)[tid] = ((const uint4*)(Q + ((size_t)bh * SEQ + q) * 96))[tid];
        __syncthreads();
        float mx = -1e30f;
        for (int k = tid; k < nk; k += 256) { const uint4* kp = (const uint4*)(K + ((size_t)bh * SEQ + k) * 96); float s = 0.f;
#pragma unroll
            for (int d = 0; d < 12; ++d) s += dot8(((const uint4*)qs)[d], kp[d]);
            sc[k] = s; mx = fmaxf(mx, s); }
        mx = wmax(mx); if ((tid & 63) == 0) red[tid >> 6] = mx; __syncthreads();
        mx = fmaxf(fmaxf(red[0], red[1]), fmaxf(red[2], red[3])); __syncthreads();
        float sum = 0.f;
        for (int k = tid; k < nk; k += 256) { const float e = exp2f(sc[k] - mx); sc[k] = e; sum += e; }
        sum = wsum(sum); if ((tid & 63) == 0) red[tid >> 6] = sum; __syncthreads();
        sum = (red[0] + red[1]) + (red[2] + red[3]);
        const int dv = tid >> 2, part = tid & 3, h = bh & 7, b = bh >> 3;
        const bf16_t* vp = VT + (size_t)(h * 64 + dv) * NT + (size_t)b * SEQ; float o = 0.f;
        for (int k = part; k < nk; k += 4) o += sc[k] * bf2f(vp[k]);
        o += __shfl_xor(o, 1); o += __shfl_xor(o, 2);
        if (part == 0) O[(size_t)(b * SEQ + q) * 512 + h * 64 + dv] = f2bf(o / sum);
        __syncthreads();
    }
}


constexpr int ATT_BUF = 20480;
template <int VAR>
__device__ __forceinline__ void phase3m(const P& p, int bid, int nb, LAS unsigned char* lds) {
    const bf16_t* Q = p.slotA; const bf16_t* K = p.slotE; const bf16_t* VT = p.slotF; bf16_t* O = (VAR == 0) ? (bf16_t*)p.slotB : p.slotC;
    const int tid = opaque_tid(), lane = tid & 63, wid = tid >> 6, l31 = lane & 31, hh = lane >> 5;
    int koff[3]; size_t voff[2];
#pragma unroll
    for (int i = 0; i < 3; ++i) { const int s = tid + 256 * i, r = s / 12, pc = s % 12, c = (pc + 12 - ((r >> 2) & 3)) % 12; koff[i] = r * 96 + c * 8; }
#pragma unroll
    for (int i = 0; i < 2; ++i) { const int s = tid + 256 * i, dv = s >> 3, pc = s & 7, cl = pc ^ ((dv >> 1) & 7); voff[i] = (size_t)dv * NT + cl * 8; }
    int kro[6];
#pragma unroll
    for (int ks = 0; ks < 6; ++ks) { const int v = 2 * ks + hh + ((lane >> 2) & 3); kro[ks] = (v >= 12 ? v - 12 : v) * 16; }
    const int krow = l31 * 192, vsw = (lane >> 1) & 7, vrow = l31 * 128 + 8 * hh;
    for (int iu = 0;; ++iu) {
        const int r = iu * nb + ((iu & 1) ? nb - 1 - bid : bid); if (r >= 1024) break;
        const int qb = 63 - (r >> 4), bh = r & 15, b = bh >> 3, h = bh & 7;
        const int q0 = qb * 128 + wid * 32, ntw = (q0 >> 6) + 1, nt = 2 * qb + 2;
        const bf16_t* Kb = K + (size_t)bh * SEQ * 96; const bf16_t* Vb = VT + (size_t)(h * 64) * NT + (size_t)b * SEQ;
        bf16x8 qf[6]; { const bf16_t* qp = Q + ((size_t)bh * SEQ + q0 + l31) * 96 + hh * 8;
#pragma unroll
            for (int ks = 0; ks < 6; ++ks) qf[ks] = *(const bf16x8*)(qp + ks * 16); }
        f32x16 o0, o1;
#pragma unroll
        for (int e = 0; e < 16; ++e) { o0[e] = 0.f; o1[e] = 0.f; }
        float mrun = -1e30f, lsum = 0.f;
        auto stage = [&](int j) { LAS unsigned char* d = lds + (j & 1) * ATT_BUF + tid * 16; const bf16_t* kt = Kb + (size_t)j * 64 * 96; const bf16_t* vt = Vb + j * 64;
#pragma unroll
            for (int i = 0; i < 3; ++i) __builtin_amdgcn_global_load_lds((const unsigned*)(kt + koff[i]), (LAS unsigned*)(d + i * 4096), 16, 0, 0);
#pragma unroll
            for (int i = 0; i < 2; ++i) __builtin_amdgcn_global_load_lds((const unsigned*)(vt + voff[i]), (LAS unsigned*)(d + 12288 + i * 4096), 16, 0, 0); };
        if (VAR != 3) stage(0);
        for (int j = 0; j < nt; ++j) {
            asm volatile("s_waitcnt vmcnt(0)" ::: "memory");
            __syncthreads();
            if (VAR != 3 && j + 1 < nt) stage(j + 1);
            if (j < ntw) {
                const LAS unsigned char* kb_ = lds + (j & 1) * ATT_BUF + krow; const LAS unsigned char* vb_ = lds + (j & 1) * ATT_BUF + 12288 + vrow;
                f32x16 s0, s1;
#pragma unroll
                for (int e = 0; e < 16; ++e) { s0[e] = 0.f; s1[e] = 0.f; }
#pragma unroll
                for (int ks = 0; ks < 6; ++ks) { const bf16x8 k0 = *(const LAS bf16x8*)(kb_ + kro[ks]); const bf16x8 k1 = *(const LAS bf16x8*)(kb_ + 32 * 192 + kro[ks]);
                    if (VAR != 2) { s0 = __builtin_amdgcn_mfma_f32_32x32x16_bf16(k0, qf[ks], s0, 0, 0, 0); s1 = __builtin_amdgcn_mfma_f32_32x32x16_bf16(k1, qf[ks], s1, 0, 0, 0); }
                    else { s0[ks] += __builtin_bit_cast(float, (int)k0[0]) + __builtin_bit_cast(float, (int)qf[ks][1]); s1[ks] += __builtin_bit_cast(float, (int)k1[0]); } }
                if (VAR != 1) {
                float mx = fmaxf(s0[0], s1[0]);
#pragma unroll
                for (int e = 1; e < 16; ++e) mx = fmaxf(mx, fmaxf(s0[e], s1[e]));
                mx = fmaxf(mx, __shfl_xor(mx, 32));
                const float mn = fmaxf(mrun, mx), alpha = __builtin_amdgcn_exp2f(mrun - mn); mrun = mn;
                float ps = 0.f;
#pragma unroll
                for (int e = 0; e < 16; ++e) { s0[e] = __builtin_amdgcn_exp2f(s0[e] - mn); s1[e] = __builtin_amdgcn_exp2f(s1[e] - mn); ps += s0[e] + s1[e]; }
                lsum = lsum * alpha + ps;
#pragma unroll
                for (int e = 0; e < 16; ++e) { o0[e] *= alpha; o1[e] *= alpha; }
                }
                unsigned pw[16];
#pragma unroll
                for (int e = 0; e < 8; ++e) { pw[e] = pk2(s0[2 * e], s0[2 * e + 1]); pw[8 + e] = pk2(s1[2 * e], s1[2 * e + 1]); }
#pragma unroll
                for (int s = 0; s < 4; ++s) {
                    const u32x4 pbu = {pw[4 * s], pw[4 * s + 1], pw[4 * s + 2], pw[4 * s + 3]}; const bf16x8 pb = __builtin_bit_cast(bf16x8, pbu);
                    const int c0 = ((2 * s) ^ vsw) * 16, c1 = ((2 * s + 1) ^ vsw) * 16;
                    const u32x2 a0 = *(const LAS u32x2*)(vb_ + c0), a1 = *(const LAS u32x2*)(vb_ + c1);
                    const u32x2 b0 = *(const LAS u32x2*)(vb_ + 32 * 128 + c0), b1 = *(const LAS u32x2*)(vb_ + 32 * 128 + c1);
                    const u32x4 va = {a0.x, a0.y, a1.x, a1.y}, vb = {b0.x, b0.y, b1.x, b1.y};
                    if (VAR != 2) { o0 = __builtin_amdgcn_mfma_f32_32x32x16_bf16(__builtin_bit_cast(bf16x8, va), pb, o0, 0, 0, 0);
                    o1 = __builtin_amdgcn_mfma_f32_32x32x16_bf16(__builtin_bit_cast(bf16x8, vb), pb, o1, 0, 0, 0); }
                    else { o0[s] += __builtin_bit_cast(float, va[0] ^ pbu[0]); o1[s] += __builtin_bit_cast(float, vb[1] ^ pbu[1]); }
                }
            }
        }
        const float inv = 1.f / (lsum + __shfl_xor(lsum, 32));
        bf16_t* op = O + (size_t)(b * SEQ + q0 + l31) * 512 + h * 64 + 4 * hh;
#pragma unroll
        for (int g = 0; g < 4; ++g) { uint2 w0, w1;
            w0.x = pk2(o0[4 * g] * inv, o0[4 * g + 1] * inv); w0.y = pk2(o0[4 * g + 2] * inv, o0[4 * g + 3] * inv);
            w1.x = pk2(o1[4 * g] * inv, o1[4 * g + 1] * inv); w1.y = pk2(o1[4 * g + 2] * inv, o1[4 * g + 3] * inv);
            *(uint2*)(op + 8 * g) = w0; *(uint2*)(op + 32 + 8 * g) = w1; }
        __syncthreads();
    }
}


template <int DUMMY>
__device__ __forceinline__ void phase3p(const P& p, int bid, int nb, LAS unsigned char* lds) {
    const bf16_t* Q = p.slotA; const bf16_t* K = p.slotE; const bf16_t* VT = p.slotF; bf16_t* O = (DUMMY == 0) ? (bf16_t*)p.slotB : p.slotC;
    const int tid = opaque_tid(), lane = tid & 63, wid = tid >> 6, l31 = lane & 31, hh = lane >> 5;
    constexpr float THR = 8.f;
    int koff[3]; size_t voff[2];
#pragma unroll
    for (int i = 0; i < 3; ++i) { const int s = tid + 256 * i, r = s / 12, pc = s % 12, c = (pc + 12 - ((r >> 2) & 3)) % 12; koff[i] = r * 96 + c * 8; }
#pragma unroll
    for (int i = 0; i < 2; ++i) { const int s = tid + 256 * i, dv = s >> 3, pc = s & 7, cl = pc ^ ((dv >> 1) & 7); voff[i] = (size_t)dv * NT + cl * 8; }
    int kro[6];
#pragma unroll
    for (int ks = 0; ks < 6; ++ks) { const int v = 2 * ks + hh + ((lane >> 2) & 3); kro[ks] = (v >= 12 ? v - 12 : v) * 16; }
    const int krow = l31 * 192, vsw = (lane >> 1) & 7, vrow = l31 * 128 + 8 * hh;
    for (int iu = 0;; ++iu) {
        const int r = iu * nb + ((iu & 1) ? nb - 1 - bid : bid); if (r >= 1024) break;
        const int qb = 63 - (r >> 4), bh = r & 15, b = bh >> 3, h = bh & 7;
        const int q0 = qb * 128 + wid * 32, ntw = (q0 >> 6) + 1, nt = 2 * qb + 2;
        const bf16_t* Kb = K + (size_t)bh * SEQ * 96; const bf16_t* Vb = VT + (size_t)(h * 64) * NT + (size_t)b * SEQ;
        bf16x8 qf[6]; { const bf16_t* qp = Q + ((size_t)bh * SEQ + q0 + l31) * 96 + hh * 8;
#pragma unroll
            for (int ks = 0; ks < 6; ++ks) qf[ks] = *(const bf16x8*)(qp + ks * 16); }
        f32x16 o0, o1;
#pragma unroll
        for (int e = 0; e < 16; ++e) { o0[e] = 0.f; o1[e] = 0.f; }
        float mrun = -1e30f, lsum = 0.f;
        auto stageK = [&](int j) { LAS unsigned char* d = lds + (j & 1) * 12288 + tid * 16; const bf16_t* kt = Kb + (size_t)j * 64 * 96;
#pragma unroll
            for (int i = 0; i < 3; ++i) __builtin_amdgcn_global_load_lds((const unsigned*)(kt + koff[i]), (LAS unsigned*)(d + i * 4096), 16, 0, 0); };
        auto stageV = [&](int j) { LAS unsigned char* d = lds + 24576 + (j & 1) * 8192 + tid * 16; const bf16_t* vt = Vb + j * 64;
#pragma unroll
            for (int i = 0; i < 2; ++i) __builtin_amdgcn_global_load_lds((const unsigned*)(vt + voff[i]), (LAS unsigned*)(d + i * 4096), 16, 0, 0); };
        auto qk = [&](f32x16& a, f32x16& bq, int buf) { const LAS unsigned char* kb_ = lds + buf * 12288 + krow;
#pragma unroll
            for (int e = 0; e < 16; ++e) { a[e] = 0.f; bq[e] = 0.f; }
#pragma unroll
            for (int ks = 0; ks < 6; ++ks) { const bf16x8 k0 = *(const LAS bf16x8*)(kb_ + kro[ks]); const bf16x8 k1 = *(const LAS bf16x8*)(kb_ + 32 * 192 + kro[ks]);
                a = __builtin_amdgcn_mfma_f32_32x32x16_bf16(k0, qf[ks], a, 0, 0, 0); bq = __builtin_amdgcn_mfma_f32_32x32x16_bf16(k1, qf[ks], bq, 0, 0, 0); } };
        auto rowmax = [&](const f32x16& a, const f32x16& bq) { float m = fmaxf(a[0], bq[0]);
#pragma unroll
            for (int e = 1; e < 16; ++e) m = fmaxf(fmaxf(m, a[e]), bq[e]);
            return fmaxf(m, __shfl_xor(m, 32)); };
        f32x16 sA0, sA1, sB0, sB1; float mxA, mxB = 0.f;
        stageK(0); stageK(1); stageV(0);
        asm volatile("s_waitcnt vmcnt(0)" ::: "memory");
        __syncthreads();
        qk(sA0, sA1, 0); mxA = rowmax(sA0, sA1);
        auto step = [&](f32x16& c0, f32x16& c1, float& mxc, f32x16& n0, f32x16& n1, float& mxn, int j) {
            asm volatile("s_waitcnt vmcnt(0)" ::: "memory");
            __syncthreads();
            if (j + 2 < nt) stageK(j + 2);
            if (j + 1 < nt) stageV(j + 1);
            if (j < ntw) {
                if (!__all(mxc <= mrun + THR)) { const float mn = fmaxf(mrun, mxc), alpha = __builtin_amdgcn_exp2f(mrun - mn); mrun = mn; lsum *= alpha;
#pragma unroll
                    for (int e = 0; e < 16; ++e) { o0[e] *= alpha; o1[e] *= alpha; } }
                qk(n0, n1, (j + 1) & 1);
                float ps = 0.f;
#pragma unroll
                for (int e = 0; e < 16; ++e) { c0[e] = __builtin_amdgcn_exp2f(c0[e] - mrun); c1[e] = __builtin_amdgcn_exp2f(c1[e] - mrun); ps += c0[e] + c1[e]; }
                lsum += ps;
                unsigned pw[16];
#pragma unroll
                for (int e = 0; e < 8; ++e) { pw[e] = pk2(c0[2 * e], c0[2 * e + 1]); pw[8 + e] = pk2(c1[2 * e], c1[2 * e + 1]); }
                const LAS unsigned char* vb_ = lds + 24576 + (j & 1) * 8192 + vrow;
#pragma unroll
                for (int s = 0; s < 4; ++s) {
                    const u32x4 pbu = {pw[4 * s], pw[4 * s + 1], pw[4 * s + 2], pw[4 * s + 3]}; const bf16x8 pb = __builtin_bit_cast(bf16x8, pbu);
                    const int c0_ = ((2 * s) ^ vsw) * 16, c1_ = ((2 * s + 1) ^ vsw) * 16;
                    const u32x2 a0 = *(const LAS u32x2*)(vb_ + c0_), a1 = *(const LAS u32x2*)(vb_ + c1_);
                    const u32x2 b0 = *(const LAS u32x2*)(vb_ + 32 * 128 + c0_), b1 = *(const LAS u32x2*)(vb_ + 32 * 128 + c1_);
                    const u32x4 va = {a0.x, a0.y, a1.x, a1.y}, vb = {b0.x, b0.y, b1.x, b1.y};
                    o0 = __builtin_amdgcn_mfma_f32_32x32x16_bf16(__builtin_bit_cast(bf16x8, va), pb, o0, 0, 0, 0);
                    o1 = __builtin_amdgcn_mfma_f32_32x32x16_bf16(__builtin_bit_cast(bf16x8, vb), pb, o1, 0, 0, 0);
                }
                mxn = rowmax(n0, n1);
#if ATT_SGB
#pragma unroll
                for (int g_ = 0; g_ < 20; ++g_) { __builtin_amdgcn_sched_group_barrier(0x008, 1, 0); __builtin_amdgcn_sched_group_barrier(0x100, 2, 0); __builtin_amdgcn_sched_group_barrier(0x002, 7, 0); }
#endif
            }
        };
        for (int j = 0; j < nt; j += 2) { step(sA0, sA1, mxA, sB0, sB1, mxB, j); step(sB0, sB1, mxB, sA0, sA1, mxA, j + 1); }
        const float inv = 1.f / (lsum + __shfl_xor(lsum, 32));
        bf16_t* op = O + (size_t)(b * SEQ + q0 + l31) * 512 + h * 64 + 4 * hh;
#pragma unroll
        for (int g = 0; g < 4; ++g) { uint2 w0, w1;
            w0.x = pk2(o0[4 * g] * inv, o0[4 * g + 1] * inv); w0.y = pk2(o0[4 * g + 2] * inv, o0[4 * g + 3] * inv);
            w1.x = pk2(o1[4 * g] * inv, o1[4 * g + 1] * inv); w1.y = pk2(o1[4 * g + 2] * inv, o1[4 * g + 3] * inv);
            *(uint2*)(op + 8 * g) = w0; *(uint2*)(op + 32 + 8 * g) = w1; }
        __syncthreads();
    }
}

template <int VAR>
__device__ __forceinline__ void att_step(const LAS unsigned char* kb_, const LAS unsigned char* vb_, const int kt16, const int k4o, const int k5o, const int vsw, const bf16x8 (&qf)[6],
                                         f32x16& c0, f32x16& c1, f32x16& n0, f32x16& n1, const unsigned (&pwc)[16], unsigned (&pwn)[16], f32x16& o0, f32x16& o1,
                                         const float mrun, float& ps, float& mxn) {
    f32x16 zero16;
#pragma unroll
    for (int e = 0; e < 16; ++e) zero16[e] = 0.f;
    if constexpr (VAR == 0) {
        bf16x8 kf0, kf1, kf2;
        kf0 = *(const LAS bf16x8*)(kb_ + 0*32*192 + kt16 + 0); kf1 = *(const LAS bf16x8*)(kb_ + 1*32*192 + kt16 + 0);
        float mxl;
        kf2 = *(const LAS bf16x8*)(kb_ + 0*32*192 + kt16 + 32);
        n0 = __builtin_amdgcn_mfma_f32_32x32x16_bf16(kf0, qf[0], zero16, 0, 0, 0);
        c0[0] = __builtin_amdgcn_exp2f(c0[0] - mrun); ps += c0[0]; c0[1] = __builtin_amdgcn_exp2f(c0[1] - mrun); ps += c0[1]; pwn[0] = pk2(c0[0], c0[1]);
        __builtin_amdgcn_sched_barrier(0);
        kf0 = *(const LAS bf16x8*)(kb_ + 1*32*192 + kt16 + 32);
        n1 = __builtin_amdgcn_mfma_f32_32x32x16_bf16(kf1, qf[0], zero16, 0, 0, 0);
        c0[2] = __builtin_amdgcn_exp2f(c0[2] - mrun); ps += c0[2]; c0[3] = __builtin_amdgcn_exp2f(c0[3] - mrun); ps += c0[3]; pwn[1] = pk2(c0[2], c0[3]);
        __builtin_amdgcn_sched_barrier(0);
        kf1 = *(const LAS bf16x8*)(kb_ + 0*32*192 + kt16 + 64);
        n0 = __builtin_amdgcn_mfma_f32_32x32x16_bf16(kf2, qf[1], n0, 0, 0, 0);
        c0[4] = __builtin_amdgcn_exp2f(c0[4] - mrun); ps += c0[4]; c0[5] = __builtin_amdgcn_exp2f(c0[5] - mrun); ps += c0[5]; pwn[2] = pk2(c0[4], c0[5]);
        __builtin_amdgcn_sched_barrier(0);
        kf2 = *(const LAS bf16x8*)(kb_ + 1*32*192 + kt16 + 64);
        n1 = __builtin_amdgcn_mfma_f32_32x32x16_bf16(kf0, qf[1], n1, 0, 0, 0);
        c0[6] = __builtin_amdgcn_exp2f(c0[6] - mrun); ps += c0[6]; c0[7] = __builtin_amdgcn_exp2f(c0[7] - mrun); ps += c0[7]; pwn[3] = pk2(c0[6], c0[7]);
        __builtin_amdgcn_sched_barrier(0);
        kf0 = *(const LAS bf16x8*)(kb_ + 0*32*192 + kt16 + 96);
        n0 = __builtin_amdgcn_mfma_f32_32x32x16_bf16(kf1, qf[2], n0, 0, 0, 0);
        c0[8] = __builtin_amdgcn_exp2f(c0[8] - mrun); ps += c0[8]; c0[9] = __builtin_amdgcn_exp2f(c0[9] - mrun); ps += c0[9]; pwn[4] = pk2(c0[8], c0[9]);
        __builtin_amdgcn_sched_barrier(0);
        kf1 = *(const LAS bf16x8*)(kb_ + 1*32*192 + kt16 + 96);
        n1 = __builtin_amdgcn_mfma_f32_32x32x16_bf16(kf2, qf[2], n1, 0, 0, 0);
        c0[10] = __builtin_amdgcn_exp2f(c0[10] - mrun); ps += c0[10]; c0[11] = __builtin_amdgcn_exp2f(c0[11] - mrun); ps += c0[11]; pwn[5] = pk2(c0[10], c0[11]);
        __builtin_amdgcn_sched_barrier(0);
        kf2 = *(const LAS bf16x8*)(kb_ + 0*32*192 + k4o);
        n0 = __builtin_amdgcn_mfma_f32_32x32x16_bf16(kf0, qf[3], n0, 0, 0, 0);
        c0[12] = __builtin_amdgcn_exp2f(c0[12] - mrun); ps += c0[12]; c0[13] = __builtin_amdgcn_exp2f(c0[13] - mrun); ps += c0[13]; pwn[6] = pk2(c0[12], c0[13]);
        __builtin_amdgcn_sched_barrier(0);
        kf0 = *(const LAS bf16x8*)(kb_ + 1*32*192 + k4o);
        n1 = __builtin_amdgcn_mfma_f32_32x32x16_bf16(kf1, qf[3], n1, 0, 0, 0);
        c0[14] = __builtin_amdgcn_exp2f(c0[14] - mrun); ps += c0[14]; c0[15] = __builtin_amdgcn_exp2f(c0[15] - mrun); ps += c0[15]; pwn[7] = pk2(c0[14], c0[15]);
        __builtin_amdgcn_sched_barrier(0);
        kf1 = *(const LAS bf16x8*)(kb_ + 0*32*192 + k5o);
        n0 = __builtin_amdgcn_mfma_f32_32x32x16_bf16(kf2, qf[4], n0, 0, 0, 0);
        c1[0] = __builtin_amdgcn_exp2f(c1[0] - mrun); ps += c1[0]; c1[1] = __builtin_amdgcn_exp2f(c1[1] - mrun); ps += c1[1]; pwn[8] = pk2(c1[0], c1[1]);
        __builtin_amdgcn_sched_barrier(0);
        kf2 = *(const LAS bf16x8*)(kb_ + 1*32*192 + k5o);
        n1 = __builtin_amdgcn_mfma_f32_32x32x16_bf16(kf0, qf[4], n1, 0, 0, 0);
        c1[2] = __builtin_amdgcn_exp2f(c1[2] - mrun); ps += c1[2]; c1[3] = __builtin_amdgcn_exp2f(c1[3] - mrun); ps += c1[3]; pwn[9] = pk2(c1[2], c1[3]);
        __builtin_amdgcn_sched_barrier(0);
        n0 = __builtin_amdgcn_mfma_f32_32x32x16_bf16(kf1, qf[5], n0, 0, 0, 0);
        c1[4] = __builtin_amdgcn_exp2f(c1[4] - mrun); ps += c1[4]; c1[5] = __builtin_amdgcn_exp2f(c1[5] - mrun); ps += c1[5]; pwn[10] = pk2(c1[4], c1[5]);
        __builtin_amdgcn_sched_barrier(0);
        n1 = __builtin_amdgcn_mfma_f32_32x32x16_bf16(kf2, qf[5], n1, 0, 0, 0);
        c1[6] = __builtin_amdgcn_exp2f(c1[6] - mrun); ps += c1[6]; c1[7] = __builtin_amdgcn_exp2f(c1[7] - mrun); ps += c1[7]; pwn[11] = pk2(c1[6], c1[7]);
        __builtin_amdgcn_sched_barrier(0);
        c1[8] = __builtin_amdgcn_exp2f(c1[8] - mrun); ps += c1[8]; c1[9] = __builtin_amdgcn_exp2f(c1[9] - mrun); ps += c1[9]; pwn[12] = pk2(c1[8], c1[9]);
        __builtin_amdgcn_sched_barrier(0);
        c1[10] = __builtin_amdgcn_exp2f(c1[10] - mrun); ps += c1[10]; c1[11] = __builtin_amdgcn_exp2f(c1[11] - mrun); ps += c1[11]; pwn[13] = pk2(c1[10], c1[11]);
        __builtin_amdgcn_sched_barrier(0);
        c1[12] = __builtin_amdgcn_exp2f(c1[12] - mrun); ps += c1[12]; c1[13] = __builtin_amdgcn_exp2f(c1[13] - mrun); ps += c1[13]; pwn[14] = pk2(c1[12], c1[13]);
        __builtin_amdgcn_sched_barrier(0);
        c1[14] = __builtin_amdgcn_exp2f(c1[14] - mrun); ps += c1[14]; c1[15] = __builtin_amdgcn_exp2f(c1[15] - mrun); ps += c1[15]; pwn[15] = pk2(c1[14], c1[15]);
        __builtin_amdgcn_sched_barrier(0);
        mxl = fmaxf(n0[0], n1[0]); mxl = fmaxf(fmaxf(mxl, n0[1]), n1[1]); mxl = fmaxf(fmaxf(mxl, n0[2]), n1[2]); mxl = fmaxf(fmaxf(mxl, n0[3]), n1[3]);
        __builtin_amdgcn_sched_barrier(0);
        mxl = fmaxf(fmaxf(mxl, n0[4]), n1[4]); mxl = fmaxf(fmaxf(mxl, n0[5]), n1[5]); mxl = fmaxf(fmaxf(mxl, n0[6]), n1[6]); mxl = fmaxf(fmaxf(mxl, n0[7]), n1[7]);
        __builtin_amdgcn_sched_barrier(0);
        mxl = fmaxf(fmaxf(mxl, n0[8]), n1[8]); mxl = fmaxf(fmaxf(mxl, n0[9]), n1[9]); mxl = fmaxf(fmaxf(mxl, n0[10]), n1[10]); mxl = fmaxf(fmaxf(mxl, n0[11]), n1[11]);
        __builtin_amdgcn_sched_barrier(0);
        mxl = fmaxf(fmaxf(mxl, n0[12]), n1[12]); mxl = fmaxf(fmaxf(mxl, n0[13]), n1[13]); mxl = fmaxf(fmaxf(mxl, n0[14]), n1[14]); mxl = fmaxf(fmaxf(mxl, n0[15]), n1[15]);
        __builtin_amdgcn_sched_barrier(0);
        mxn = fmaxf(mxl, __shfl_xor(mxl, 32));
    } else if constexpr (VAR == 1) {
        bf16x8 kf0, kf1, kf2;
        kf0 = *(const LAS bf16x8*)(kb_ + 0*32*192 + kt16 + 0); kf1 = *(const LAS bf16x8*)(kb_ + 1*32*192 + kt16 + 0);
        u32x2 vf0a, vf0b, vf1a, vf1b, vf2a, vf2b;
        float mxl;
        kf2 = *(const LAS bf16x8*)(kb_ + 0*32*192 + kt16 + 32);
        n0 = __builtin_amdgcn_mfma_f32_32x32x16_bf16(kf0, qf[0], zero16, 0, 0, 0);
        c0[0] = __builtin_amdgcn_exp2f(c0[0] - mrun); ps += c0[0]; c0[1] = __builtin_amdgcn_exp2f(c0[1] - mrun); ps += c0[1]; pwn[0] = pk2(c0[0], c0[1]);
        __builtin_amdgcn_sched_barrier(0);
        kf0 = *(const LAS bf16x8*)(kb_ + 1*32*192 + kt16 + 32);
        n1 = __builtin_amdgcn_mfma_f32_32x32x16_bf16(kf1, qf[0], zero16, 0, 0, 0);
        c0[2] = __builtin_amdgcn_exp2f(c0[2] - mrun); ps += c0[2]; c0[3] = __builtin_amdgcn_exp2f(c0[3] - mrun); ps += c0[3]; pwn[1] = pk2(c0[2], c0[3]);
        __builtin_amdgcn_sched_barrier(0);
        kf1 = *(const LAS bf16x8*)(kb_ + 0*32*192 + kt16 + 64);
        n0 = __builtin_amdgcn_mfma_f32_32x32x16_bf16(kf2, qf[1], n0, 0, 0, 0);
        c0[4] = __builtin_amdgcn_exp2f(c0[4] - mrun); ps += c0[4]; c0[5] = __builtin_amdgcn_exp2f(c0[5] - mrun); ps += c0[5]; pwn[2] = pk2(c0[4], c0[5]);
        __builtin_amdgcn_sched_barrier(0);
        kf2 = *(const LAS bf16x8*)(kb_ + 1*32*192 + kt16 + 64);
        n1 = __builtin_amdgcn_mfma_f32_32x32x16_bf16(kf0, qf[1], n1, 0, 0, 0);
        c0[6] = __builtin_amdgcn_exp2f(c0[6] - mrun); ps += c0[6]; c0[7] = __builtin_amdgcn_exp2f(c0[7] - mrun); ps += c0[7]; pwn[3] = pk2(c0[6], c0[7]);
        __builtin_amdgcn_sched_barrier(0);
        kf0 = *(const LAS bf16x8*)(kb_ + 0*32*192 + kt16 + 96);
        n0 = __builtin_amdgcn_mfma_f32_32x32x16_bf16(kf1, qf[2], n0, 0, 0, 0);
        c0[8] = __builtin_amdgcn_exp2f(c0[8] - mrun); ps += c0[8]; c0[9] = __builtin_amdgcn_exp2f(c0[9] - mrun); ps += c0[9]; pwn[4] = pk2(c0[8], c0[9]);
        __builtin_amdgcn_sched_barrier(0);
        kf1 = *(const LAS bf16x8*)(kb_ + 1*32*192 + kt16 + 96);
        n1 = __builtin_amdgcn_mfma_f32_32x32x16_bf16(kf2, qf[2], n1, 0, 0, 0);
        c0[10] = __builtin_amdgcn_exp2f(c0[10] - mrun); ps += c0[10]; c0[11] = __builtin_amdgcn_exp2f(c0[11] - mrun); ps += c0[11]; pwn[5] = pk2(c0[10], c0[11]);
        __builtin_amdgcn_sched_barrier(0);
        kf2 = *(const LAS bf16x8*)(kb_ + 0*32*192 + k4o);
        n0 = __builtin_amdgcn_mfma_f32_32x32x16_bf16(kf0, qf[3], n0, 0, 0, 0);
        c0[12] = __builtin_amdgcn_exp2f(c0[12] - mrun); ps += c0[12]; c0[13] = __builtin_amdgcn_exp2f(c0[13] - mrun); ps += c0[13]; pwn[6] = pk2(c0[12], c0[13]);
        __builtin_amdgcn_sched_barrier(0);
        kf0 = *(const LAS bf16x8*)(kb_ + 1*32*192 + k4o);
        n1 = __builtin_amdgcn_mfma_f32_32x32x16_bf16(kf1, qf[3], n1, 0, 0, 0);
        c0[14] = __builtin_amdgcn_exp2f(c0[14] - mrun); ps += c0[14]; c0[15] = __builtin_amdgcn_exp2f(c0[15] - mrun); ps += c0[15]; pwn[7] = pk2(c0[14], c0[15]);
        __builtin_amdgcn_sched_barrier(0);
        kf1 = *(const LAS bf16x8*)(kb_ + 0*32*192 + k5o);
        n0 = __builtin_amdgcn_mfma_f32_32x32x16_bf16(kf2, qf[4], n0, 0, 0, 0);
        c1[0] = __builtin_amdgcn_exp2f(c1[0] - mrun); ps += c1[0]; c1[1] = __builtin_amdgcn_exp2f(c1[1] - mrun); ps += c1[1]; pwn[8] = pk2(c1[0], c1[1]);
        __builtin_amdgcn_sched_barrier(0);
        kf2 = *(const LAS bf16x8*)(kb_ + 1*32*192 + k5o);
        n1 = __builtin_amdgcn_mfma_f32_32x32x16_bf16(kf0, qf[4], n1, 0, 0, 0);
        c1[2] = __builtin_amdgcn_exp2f(c1[2] - mrun); ps += c1[2]; c1[3] = __builtin_amdgcn_exp2f(c1[3] - mrun); ps += c1[3]; pwn[9] = pk2(c1[2], c1[3]);
        __builtin_amdgcn_sched_barrier(0);
        vf0a = *(const LAS u32x2*)(vb_ + ((0) ^ vsw) * 16); vf0b = *(const LAS u32x2*)(vb_ + ((1) ^ vsw) * 16);
        n0 = __builtin_amdgcn_mfma_f32_32x32x16_bf16(kf1, qf[5], n0, 0, 0, 0);
        c1[4] = __builtin_amdgcn_exp2f(c1[4] - mrun); ps += c1[4]; c1[5] = __builtin_amdgcn_exp2f(c1[5] - mrun); ps += c1[5]; pwn[10] = pk2(c1[4], c1[5]);
        __builtin_amdgcn_sched_barrier(0);
        vf1a = *(const LAS u32x2*)(vb_ + 32 * 128 + ((0) ^ vsw) * 16); vf1b = *(const LAS u32x2*)(vb_ + 32 * 128 + ((1) ^ vsw) * 16);
        n1 = __builtin_amdgcn_mfma_f32_32x32x16_bf16(kf2, qf[5], n1, 0, 0, 0);
        c1[6] = __builtin_amdgcn_exp2f(c1[6] - mrun); ps += c1[6]; c1[7] = __builtin_amdgcn_exp2f(c1[7] - mrun); ps += c1[7]; pwn[11] = pk2(c1[6], c1[7]);
        __builtin_amdgcn_sched_barrier(0);
        vf2a = *(const LAS u32x2*)(vb_ + ((2) ^ vsw) * 16); vf2b = *(const LAS u32x2*)(vb_ + ((3) ^ vsw) * 16);
        { const u32x4 pbu = {pwc[0], pwc[1], pwc[2], pwc[3]}; const u32x4 vv = {vf0a.x, vf0a.y, vf0b.x, vf0b.y};
          o0 = __builtin_amdgcn_mfma_f32_32x32x16_bf16(__builtin_bit_cast(bf16x8, vv), __builtin_bit_cast(bf16x8, pbu), o0, 0, 0, 0); }
        c1[8] = __builtin_amdgcn_exp2f(c1[8] - mrun); ps += c1[8]; c1[9] = __builtin_amdgcn_exp2f(c1[9] - mrun); ps += c1[9]; pwn[12] = pk2(c1[8], c1[9]);
        __builtin_amdgcn_sched_barrier(0);
        vf0a = *(const LAS u32x2*)(vb_ + 32 * 128 + ((2) ^ vsw) * 16); vf0b = *(const LAS u32x2*)(vb_ + 32 * 128 + ((3) ^ vsw) * 16);
        { const u32x4 pbu = {pwc[0], pwc[1], pwc[2], pwc[3]}; const u32x4 vv = {vf1a.x, vf1a.y, vf1b.x, vf1b.y};
          o1 = __builtin_amdgcn_mfma_f32_32x32x16_bf16(__builtin_bit_cast(bf16x8, vv), __builtin_bit_cast(bf16x8, pbu), o1, 0, 0, 0); }
        c1[10] = __builtin_amdgcn_exp2f(c1[10] - mrun); ps += c1[10]; c1[11] = __builtin_amdgcn_exp2f(c1[11] - mrun); ps += c1[11]; pwn[13] = pk2(c1[10], c1[11]);
        __builtin_amdgcn_sched_barrier(0);
        vf1a = *(const LAS u32x2*)(vb_ + ((4) ^ vsw) * 16); vf1b = *(const LAS u32x2*)(vb_ + ((5) ^ vsw) * 16);
        { const u32x4 pbu = {pwc[4], pwc[5], pwc[6], pwc[7]}; const u32x4 vv = {vf2a.x, vf2a.y, vf2b.x, vf2b.y};
          o0 = __builtin_amdgcn_mfma_f32_32x32x16_bf16(__builtin_bit_cast(bf16x8, vv), __builtin_bit_cast(bf16x8, pbu), o0, 0, 0, 0); }
        c1[12] = __builtin_amdgcn_exp2f(c1[12] - mrun); ps += c1[12]; c1[13] = __builtin_amdgcn_exp2f(c1[13] - mrun); ps += c1[13]; pwn[14] = pk2(c1[12], c1[13]);
        __builtin_amdgcn_sched_barrier(0);
        vf2a = *(const LAS u32x2*)(vb_ + 32 * 128 + ((4) ^ vsw) * 16); vf2b = *(const LAS u32x2*)(vb_ + 32 * 128 + ((5) ^ vsw) * 16);
        { const u32x4 pbu = {pwc[4], pwc[5], pwc[6], pwc[7]}; const u32x4 vv = {vf0a.x, vf0a.y, vf0b.x, vf0b.y};
          o1 = __builtin_amdgcn_mfma_f32_32x32x16_bf16(__builtin_bit_cast(bf16x8, vv), __builtin_bit_cast(bf16x8, pbu), o1, 0, 0, 0); }
        c1[14] = __builtin_amdgcn_exp2f(c1[14] - mrun); ps += c1[14]; c1[15] = __builtin_amdgcn_exp2f(c1[15] - mrun); ps += c1[15]; pwn[15] = pk2(c1[14], c1[15]);
        __builtin_amdgcn_sched_barrier(0);
        vf0a = *(const LAS u32x2*)(vb_ + ((6) ^ vsw) * 16); vf0b = *(const LAS u32x2*)(vb_ + ((7) ^ vsw) * 16);
        { const u32x4 pbu = {pwc[8], pwc[9], pwc[10], pwc[11]}; const u32x4 vv = {vf1a.x, vf1a.y, vf1b.x, vf1b.y};
          o0 = __builtin_amdgcn_mfma_f32_32x32x16_bf16(__builtin_bit_cast(bf16x8, vv), __builtin_bit_cast(bf16x8, pbu), o0, 0, 0, 0); }
        mxl = fmaxf(n0[0], n1[0]); mxl = fmaxf(fmaxf(mxl, n0[1]), n1[1]); mxl = fmaxf(fmaxf(mxl, n0[2]), n1[2]); mxl = fmaxf(fmaxf(mxl, n0[3]), n1[3]);
        __builtin_amdgcn_sched_barrier(0);
        vf1a = *(const LAS u32x2*)(vb_ + 32 * 128 + ((6) ^ vsw) * 16); vf1b = *(const LAS u32x2*)(vb_ + 32 * 128 + ((7) ^ vsw) * 16);
        { const u32x4 pbu = {pwc[8], pwc[9], pwc[10], pwc[11]}; const u32x4 vv = {vf2a.x, vf2a.y, vf2b.x, vf2b.y};
          o1 = __builtin_amdgcn_mfma_f32_32x32x16_bf16(__builtin_bit_cast(bf16x8, vv), __builtin_bit_cast(bf16x8, pbu), o1, 0, 0, 0); }
        mxl = fmaxf(fmaxf(mxl, n0[4]), n1[4]); mxl = fmaxf(fmaxf(mxl, n0[5]), n1[5]); mxl = fmaxf(fmaxf(mxl, n0[6]), n1[6]); mxl = fmaxf(fmaxf(mxl, n0[7]), n1[7]);
        __builtin_amdgcn_sched_barrier(0);
        { const u32x4 pbu = {pwc[12], pwc[13], pwc[14], pwc[15]}; const u32x4 vv = {vf0a.x, vf0a.y, vf0b.x, vf0b.y};
          o0 = __builtin_amdgcn_mfma_f32_32x32x16_bf16(__builtin_bit_cast(bf16x8, vv), __builtin_bit_cast(bf16x8, pbu), o0, 0, 0, 0); }
        mxl = fmaxf(fmaxf(mxl, n0[8]), n1[8]); mxl = fmaxf(fmaxf(mxl, n0[9]), n1[9]); mxl = fmaxf(fmaxf(mxl, n0[10]), n1[10]); mxl = fmaxf(fmaxf(mxl, n0[11]), n1[11]);
        __builtin_amdgcn_sched_barrier(0);
        { const u32x4 pbu = {pwc[12], pwc[13], pwc[14], pwc[15]}; const u32x4 vv = {vf1a.x, vf1a.y, vf1b.x, vf1b.y};
          o1 = __builtin_amdgcn_mfma_f32_32x32x16_bf16(__builtin_bit_cast(bf16x8, vv), __builtin_bit_cast(bf16x8, pbu), o1, 0, 0, 0); }
        mxl = fmaxf(fmaxf(mxl, n0[12]), n1[12]); mxl = fmaxf(fmaxf(mxl, n0[13]), n1[13]); mxl = fmaxf(fmaxf(mxl, n0[14]), n1[14]); mxl = fmaxf(fmaxf(mxl, n0[15]), n1[15]);
        __builtin_amdgcn_sched_barrier(0);
        mxn = fmaxf(mxl, __shfl_xor(mxl, 32));
    } else {
        u32x2 vf0a, vf0b, vf1a, vf1b, vf2a, vf2b;
        vf0a = *(const LAS u32x2*)(vb_ + ((0) ^ vsw) * 16); vf0b = *(const LAS u32x2*)(vb_ + ((1) ^ vsw) * 16);
        vf1a = *(const LAS u32x2*)(vb_ + 32 * 128 + ((0) ^ vsw) * 16); vf1b = *(const LAS u32x2*)(vb_ + 32 * 128 + ((1) ^ vsw) * 16);
        vf2a = *(const LAS u32x2*)(vb_ + ((2) ^ vsw) * 16); vf2b = *(const LAS u32x2*)(vb_ + ((3) ^ vsw) * 16);
        { const u32x4 pbu = {pwc[0], pwc[1], pwc[2], pwc[3]}; const u32x4 vv = {vf0a.x, vf0a.y, vf0b.x, vf0b.y};
          o0 = __builtin_amdgcn_mfma_f32_32x32x16_bf16(__builtin_bit_cast(bf16x8, vv), __builtin_bit_cast(bf16x8, pbu), o0, 0, 0, 0); }
        __builtin_amdgcn_sched_barrier(0);
        vf0a = *(const LAS u32x2*)(vb_ + 32 * 128 + ((2) ^ vsw) * 16); vf0b = *(const LAS u32x2*)(vb_ + 32 * 128 + ((3) ^ vsw) * 16);
        { const u32x4 pbu = {pwc[0], pwc[1], pwc[2], pwc[3]}; const u32x4 vv = {vf1a.x, vf1a.y, vf1b.x, vf1b.y};
          o1 = __builtin_amdgcn_mfma_f32_32x32x16_bf16(__builtin_bit_cast(bf16x8, vv), __builtin_bit_cast(bf16x8, pbu), o1, 0, 0, 0); }
        __builtin_amdgcn_sched_barrier(0);
        vf1a = *(const LAS u32x2*)(vb_ + ((4) ^ vsw) * 16); vf1b = *(const LAS u32x2*)(vb_ + ((5) ^ vsw) * 16);
        { const u32x4 pbu = {pwc[4], pwc[5], pwc[6], pwc[7]}; const u32x4 vv = {vf2a.x, vf2a.y, vf2b.x, vf2b.y};
          o0 = __builtin_amdgcn_mfma_f32_32x32x16_bf16(__builtin_bit_cast(bf16x8, vv), __builtin_bit_cast(bf16x8, pbu), o0, 0, 0, 0); }
        __builtin_amdgcn_sched_barrier(0);
        vf2a = *(const LAS u32x2*)(vb_ + 32 * 128 + ((4) ^ vsw) * 16); vf2b = *(const LAS u32x2*)(vb_ + 32 * 128 + ((5) ^ vsw) * 16);
        { const u32x4 pbu = {pwc[4], pwc[5], pwc[6], pwc[7]}; const u32x4 vv = {vf0a.x, vf0a.y, vf0b.x, vf0b.y};
          o1 = __builtin_amdgcn_mfma_f32_32x32x16_bf16(__builtin_bit_cast(bf16x8, vv), __builtin_bit_cast(bf16x8, pbu), o1, 0, 0, 0); }
        __builtin_amdgcn_sched_barrier(0);
        vf0a = *(const LAS u32x2*)(vb_ + ((6) ^ vsw) * 16); vf0b = *(const LAS u32x2*)(vb_ + ((7) ^ vsw) * 16);
        { const u32x4 pbu = {pwc[8], pwc[9], pwc[10], pwc[11]}; const u32x4 vv = {vf1a.x, vf1a.y, vf1b.x, vf1b.y};
          o0 = __builtin_amdgcn_mfma_f32_32x32x16_bf16(__builtin_bit_cast(bf16x8, vv), __builtin_bit_cast(bf16x8, pbu), o0, 0, 0, 0); }
        __builtin_amdgcn_sched_barrier(0);
        vf1a = *(const LAS u32x2*)(vb_ + 32 * 128 + ((6) ^ vsw) * 16); vf1b = *(const LAS u32x2*)(vb_ + 32 * 128 + ((7) ^ vsw) * 16);
        { const u32x4 pbu = {pwc[8], pwc[9], pwc[10], pwc[11]}; const u32x4 vv = {vf2a.x, vf2a.y, vf2b.x, vf2b.y};
          o1 = __builtin_amdgcn_mfma_f32_32x32x16_bf16(__builtin_bit_cast(bf16x8, vv), __builtin_bit_cast(bf16x8, pbu), o1, 0, 0, 0); }
        __builtin_amdgcn_sched_barrier(0);
        { const u32x4 pbu = {pwc[12], pwc[13], pwc[14], pwc[15]}; const u32x4 vv = {vf0a.x, vf0a.y, vf0b.x, vf0b.y};
          o0 = __builtin_amdgcn_mfma_f32_32x32x16_bf16(__builtin_bit_cast(bf16x8, vv), __builtin_bit_cast(bf16x8, pbu), o0, 0, 0, 0); }
        __builtin_amdgcn_sched_barrier(0);
        { const u32x4 pbu = {pwc[12], pwc[13], pwc[14], pwc[15]}; const u32x4 vv = {vf1a.x, vf1a.y, vf1b.x, vf1b.y};
          o1 = __builtin_amdgcn_mfma_f32_32x32x16_bf16(__builtin_bit_cast(bf16x8, vv), __builtin_bit_cast(bf16x8, pbu), o1, 0, 0, 0); }
        __builtin_amdgcn_sched_barrier(0);
    }
}

template <int DUMMY>
__device__ __forceinline__ void phase3q(const P& p, int bid, int nb, LAS unsigned char* lds) {
    const bf16_t* Q = p.slotA; const bf16_t* K = p.slotE; const bf16_t* VT = p.slotF; bf16_t* O = p.slotC;
    const int tid = opaque_tid(), lane = tid & 63, wid = tid >> 6, l31 = lane & 31, hh = lane >> 5;
    constexpr float THR = 8.f;
    const int widu = __builtin_amdgcn_readfirstlane(tid >> 6);
    int koff[3];
#pragma unroll
    for (int i = 0; i < 3; ++i) { const int s = tid + 256 * i, r = s / 12, pc = s % 12, c = (pc + 12 - ((r >> 2) & 3)) % 12; koff[i] = r * 96 + c * 8; }
    const int kt = hh + ((lane >> 2) & 3), kt16 = kt * 16, k4o = (8 + kt >= 12 ? kt - 4 : 8 + kt) * 16, k5o = (10 + kt >= 12 ? kt - 2 : 10 + kt) * 16;
    const int krow = l31 * 192, vsw = (lane >> 1) & 7, vrow = l31 * 128 + 8 * hh;
    for (int iu = 0;; ++iu) {
        const int r = iu * nb + ((iu & 1) ? nb - 1 - bid : bid); if (r >= 1024) break;
        const int qb = 63 - (r >> 4), bh = r & 15, b = bh >> 3, h = bh & 7;
        const int q0 = qb * 128 + wid * 32, ntw = (q0 >> 6) + 1, nt = 2 * qb + 2;
        const bf16_t* Kb = K + (size_t)bh * SEQ * 96; const bf16_t* Vb = VT + (size_t)(h * 64) * NT + (size_t)b * SEQ;
        bf16x8 qf[6]; { const bf16_t* qp = Q + ((size_t)bh * SEQ + q0 + l31) * 96 + hh * 8;
#pragma unroll
            for (int ks = 0; ks < 6; ++ks) qf[ks] = *(const bf16x8*)(qp + ks * 16); }
        f32x16 o0, o1;
#pragma unroll
        for (int e = 0; e < 16; ++e) { o0[e] = 0.f; o1[e] = 0.f; }
        float mrun = 0.f, lsum = 0.f;
        auto stageK = [&](int j) { LAS unsigned char* d = lds + (j & 1) * 12288 + widu * 1024; const bf16_t* kt = Kb + (size_t)j * 64 * 96;
#pragma unroll
            for (int i = 0; i < 3; ++i) __builtin_amdgcn_global_load_lds((const unsigned*)(kt + koff[i]), (LAS unsigned*)(d + i * 4096), 16, 0, 0); };
        auto stageV = [&](int j) { LAS unsigned char* d = lds + 24576 + (j & 1) * 8192 + widu * 1024; const bf16_t* vt = Vb + j * 64;
#pragma unroll
            for (int i = 0; i < 2; ++i) { const int dv = (tid >> 3) + 32 * i, cl = (tid & 7) ^ ((dv >> 1) & 7);
                __builtin_amdgcn_global_load_lds((const unsigned*)(vt + (size_t)dv * NT + cl * 8), (LAS unsigned*)(d + i * 4096), 16, 0, 0); } };
        f32x16 sA0, sA1, sB0, sB1; unsigned pA[16], pB[16]; float mxA, mxB = 0.f;
#pragma unroll
        for (int e = 0; e < 16; ++e) { pA[e] = 0u; pB[e] = 0u; }
        stageK(0); stageK(1);
        asm volatile("s_waitcnt vmcnt(0)" ::: "memory");
        __syncthreads();
        { const LAS unsigned char* kb_ = lds + krow;
#pragma unroll
          for (int e = 0; e < 16; ++e) { sA0[e] = 0.f; sA1[e] = 0.f; }
#pragma unroll
          for (int ks = 0; ks < 6; ++ks) { const int ko = ks <= 3 ? kt16 + 32 * ks : (ks == 4 ? k4o : k5o); const bf16x8 k0 = *(const LAS bf16x8*)(kb_ + ko); const bf16x8 k1 = *(const LAS bf16x8*)(kb_ + 32 * 192 + ko);
              sA0 = __builtin_amdgcn_mfma_f32_32x32x16_bf16(k0, qf[ks], sA0, 0, 0, 0); sA1 = __builtin_amdgcn_mfma_f32_32x32x16_bf16(k1, qf[ks], sA1, 0, 0, 0); }
          float m = fmaxf(sA0[0], sA1[0]);
#pragma unroll
          for (int e = 1; e < 16; ++e) m = fmaxf(fmaxf(m, sA0[e]), sA1[e]);
          mxA = fmaxf(m, __shfl_xor(m, 32)); }
        auto step = [&](f32x16& c0, f32x16& c1, float& mxc, f32x16& n0, f32x16& n1, float& mxn, const unsigned (&pwc)[16], unsigned (&pwn)[16], int s) {
            asm volatile("s_waitcnt vmcnt(0)" ::: "memory");
            __syncthreads();
            if (s + 2 < nt) stageK(s + 2);
            if (s < nt) stageV(s);
            if (s <= ntw) {
                const LAS unsigned char* kb_ = lds + ((s + 1) & 1) * 12288 + krow; const LAS unsigned char* vb_ = lds + 24576 + ((s + 1) & 1) * 8192 + vrow;
                if (s < ntw) {
                    const bool resc = (s == 0) || !__all(mxc <= mrun + THR); float alpha = 1.f;
                    if (resc) { const float mn = (s == 0) ? mxc : fmaxf(mrun, mxc); alpha = __builtin_amdgcn_exp2f(mrun - mn); mrun = mn; }
                    float ps = 0.f;
                    if (s == 0) att_step<0>(kb_, vb_, kt16, k4o, k5o, vsw, qf, c0, c1, n0, n1, pwc, pwn, o0, o1, mrun, ps, mxn);
                    else att_step<1>(kb_, vb_, kt16, k4o, k5o, vsw, qf, c0, c1, n0, n1, pwc, pwn, o0, o1, mrun, ps, mxn);
                    if (resc) {
#pragma unroll
                        for (int e = 0; e < 16; ++e) { o0[e] *= alpha; o1[e] *= alpha; } }
                    lsum = lsum * alpha + ps;
                } else att_step<2>(kb_, vb_, kt16, k4o, k5o, vsw, qf, c0, c1, n0, n1, pwc, pwn, o0, o1, mrun, lsum, mxn);
            }
        };
        for (int s = 0; s <= nt; s += 2) { step(sA0, sA1, mxA, sB0, sB1, mxB, pB, pA, s); if (s + 1 <= nt) step(sB0, sB1, mxB, sA0, sA1, mxA, pA, pB, s + 1); }
        const float inv = 1.f / (lsum + __shfl_xor(lsum, 32));
        bf16_t* op = O + (size_t)(b * SEQ + q0 + l31) * 512 + h * 64 + 4 * hh;
#pragma unroll
        for (int g = 0; g < 4; ++g) { uint2 w0, w1;
            w0.x = pk2(o0[4 * g] * inv, o0[4 * g + 1] * inv); w0.y = pk2(o0[4 * g + 2] * inv, o0[4 * g + 3] * inv);
            w1.x = pk2(o1[4 * g] * inv, o1[4 * g + 1] * inv); w1.y = pk2(o1[4 * g + 2] * inv, o1[4 * g + 3] * inv);
            *(uint2*)(op + 8 * g) = w0; *(uint2*)(op + 32 + 8 * g) = w1; }
        __syncthreads();
    }
}

__device__ __forceinline__ f32x4 bf4(const uint2 u) { return (f32x4){__uint_as_float(u.x << 16), __uint_as_float(u.x & 0xffff0000u), __uint_as_float(u.y << 16), __uint_as_float(u.y & 0xffff0000u)}; }
__device__ __forceinline__ unsigned pack2bf(float lo, float hi) { return (unsigned)f2bf(lo) | ((unsigned)f2bf(hi) << 16); }
__device__ __forceinline__ void phase4(const P& p, int bid, int nb, LAS unsigned char* lds) {
    const bf16_t* O = p.slotC; const bf16_t* su = p.slotG; const bf16_t* gates = p.slotD; bf16_t* mo = p.slotA;
    const int tid = opaque_tid(), lane = tid & 63, wid = tid >> 6, wr = wid >> 1, wc = wid & 1, fr = lane & 15, fq = lane >> 4;
    const int c8 = ((tid & 7) ^ ((tid >> 3) & 7)) * 8;
    auto ops1 = [&](int rt, int ct) __attribute__((always_inline)) { return gops(O + (size_t)(rt * 128 + (tid >> 3)) * 512 + c8, (size_t)32 * 512, p.WoaT + (size_t)(ct * 128 + (tid >> 3)) * 512 + c8, (size_t)32 * 512); };
    auto ops2 = [&](int rt, int ct) __attribute__((always_inline)) { return gops(su + (size_t)(rt * 128 + (tid >> 3)) * 512 + c8, (size_t)32 * 512, p.WosT + (size_t)(ct * 128 + (tid >> 3)) * 512 + c8, (size_t)32 * 512); };
    int rt, ct; bool have = tile_of(0, bid, nb, NT / 128, DM / 128, rt, ct);
    for (int it = 0; have; ++it) {
        const int row0 = rt * 128, col0 = ct * 128;
        int rt2, ct2; const bool have2 = tile_of(it + 1, bid, nb, NT / 128, DM / 128, rt2, ct2);
        f32x4 acc[4][4];
#pragma unroll
        for (int m = 0; m < 4; ++m)
#pragma unroll
            for (int n = 0; n < 4; ++n) acc[m][n] = (f32x4){0.f, 0.f, 0.f, 0.f};
        mg_kloop_p(acc, ops1(rt, ct), 8, lds, it > 0, true, ops2(rt, ct));
#pragma unroll
        for (int m = 0; m < 4; ++m)
#pragma unroll
            for (int n = 0; n < 4; ++n) { const int t = row0 + wr * 64 + m * 16 + fr, c = col0 + wc * 64 + n * 16 + fq * 4;
                const f32x4 ga = bf4(*(const uint2*)(gates + (size_t)t * 2048 + c)), gb = bf4(*(const uint2*)(gates + (size_t)t * 2048 + 1024 + c));
#pragma unroll
                for (int j = 0; j < 4; ++j) acc[m][n][j] *= ga[j] * __builtin_amdgcn_rcpf(gb[j]); }
        mg_kloop_p(acc, ops2(rt, ct), 8, lds, true, have2, ops1(have2 ? rt2 : rt, have2 ? ct2 : ct));
#pragma unroll
        for (int m = 0; m < 4; ++m)
#pragma unroll
            for (int n = 0; n < 4; ++n) { const int t = row0 + wr * 64 + m * 16 + fr, c = col0 + wc * 64 + n * 16 + fq * 4;
                const f32x4 gb = bf4(*(const uint2*)(gates + (size_t)t * 2048 + 1024 + c));
                uint2 o; o.x = pk2(gb[0] * acc[m][n][0], gb[1] * acc[m][n][1]); o.y = pk2(gb[2] * acc[m][n][2], gb[3] * acc[m][n][3]); *(uint2*)(mo + (size_t)t * DM + c) = o; }
        rt = rt2; ct = ct2; have = have2;
    }
    __syncthreads();
}

__device__ __forceinline__ void phase5(const P& p, int bid, int nb, LAS unsigned char* sm) {
    const float* x = p.x; float* xm = p.out;
    mgemm(p.slotA, DM, p.WoutT, DM, NT, DM, DM, [=](int t, int c, const f32x4& v) {
        const f32x4 xv = *(const f32x4*)(x + (size_t)t * DM + c); *(f32x4*)(xm + (size_t)t * DM + c) = xv + v;
    }, bid, nb, sm);
}

__device__ __forceinline__ int gu_src_col(int rho, int& isup) {
    const int tt = rho >> 7, w = rho & 127, wc = w >> 6, n = (w >> 4) & 3, i = w & 15; isup = n >> 1; return tt * 64 + wc * 32 + (n & 1) * 16 + i;
}
__device__ __forceinline__ void ex_tile(const P& p, int tile, const float*& s0, const float*& s1, size_t& ld, bf16_t*& dst, int& K) {
    bf16_t* WguT = (bf16_t*)p.slotB; bf16_t* WdT = p.slotC + (size_t)NT * 512;
    const int e = tile / 192, tt = tile % 192;
    if (tt < 128) { const int tr = tt >> 4, tk = tt & 15, T = tr >> 1, wc = tr & 1, k0 = tk * 64, c0 = T * 64 + wc * 32;
        s0 = p.w_eg + ((size_t)e * 1024 + k0) * 256 + c0; s1 = p.w_eu + ((size_t)e * 1024 + k0) * 256 + c0; ld = 256; K = 1024;
        dst = WguT + ((size_t)e * 512 + tr * 64) * 1024 + k0; }
    else { const int t2 = tt - 128, tr = t2 >> 2, tk = t2 & 3, k0 = tk * 64, n0 = tr * 64;
        s0 = p.w_ed + ((size_t)e * 256 + k0) * 1024 + n0; s1 = s0 + 32; ld = 1024; K = 256;
        dst = WdT + ((size_t)e * 1024 + n0) * 256 + k0; }
}
__device__ __forceinline__ void expert_conv(const P& p, int first, int step, float* sm) {
    const int tid = opaque_tid(), kq = tid >> 4, r4 = (tid & 15) * 4;
    for (int t0 = first; t0 < 6144; t0 += 2 * step) {
        f32x4 v[2][4]; bf16_t* dst[2]; int K[2]; const int nt = (t0 + step < 6144) ? 2 : 1;
#pragma unroll
        for (int u = 0; u < 2; ++u) if (u < nt) { const float* s0; const float* s1; size_t ld; ex_tile(p, t0 + u * step, s0, s1, ld, dst[u], K[u]);
            const float* src = (r4 < 32 ? s0 + r4 : s1 + (r4 - 32));
#pragma unroll
            for (int i = 0; i < 4; ++i) v[u][i] = *(const f32x4*)(src + (size_t)(kq + 16 * i) * ld); }
#pragma unroll
        for (int u = 0; u < 2; ++u) if (u < nt) {
#pragma unroll
            for (int i = 0; i < 4; ++i)
#pragma unroll
                for (int j = 0; j < 4; ++j) sm[u * 4160 + (kq + 16 * i) * 65 + r4 + j] = v[u][i][j]; }
        __syncthreads();
#pragma unroll
        for (int u = 0; u < 2; ++u) if (u < nt) {
#pragma unroll
            for (int i = 0; i < 4; ++i) { const int rho = kq + 16 * i; const float* b = sm + u * 4160 + r4 * 65 + rho;
                uint2 o; o.x = pk2(b[0], b[65]); o.y = pk2(b[130], b[195]); *(uint2*)(dst[u] + (size_t)rho * K[u] + r4) = o; } }
        __syncthreads();
    }
}

__device__ __forceinline__ void phase6(const P& p, int bid, int nb, float* sm) {
    const int tid = opaque_tid(), lane = tid & 63, wid = tid >> 6;
    bf16_t* h2 = p.slotA; const float* xm = p.out;
    int* s_cnt = (int*)sm; int* s_base = s_cnt + 32; int* s_e = s_base + 32; int* s_r = s_e + 128; float* s_w = (float*)(s_r + 128);
    if (tid < 32) s_cnt[tid] = 0;
    __syncthreads();
    int slot = wid * 16;
    float* xs = sm + 512 + wid * 1024;
    for (int t = bid * 4 + wid; t < NT; t += nb * 4, ++slot) {
        f32x4 v[4]; float ss = 0.f;
#pragma unroll
        for (int i = 0; i < 4; ++i) { v[i] = *(const f32x4*)(xm + (size_t)t * DM + (lane + 64 * i) * 4); ss += v[i][0] * v[i][0] + v[i][1] * v[i][1] + v[i][2] * v[i][2] + v[i][3] * v[i][3]; }
        ss = wsumf(ss); const float r = rsqrtf(ss * (1.f / DM) + EPS);
#pragma unroll
        for (int i = 0; i < 4; ++i) { const f32x4 g = *(const f32x4*)(p.g_ffn + (lane + 64 * i) * 4); v[i] = v[i] * r * g; *(f32x4*)(xs + (lane + 64 * i) * 4) = v[i];
            uint2 o; o.x = pk2(v[i][0], v[i][1]); o.y = pk2(v[i][2], v[i][3]); *(uint2*)(h2 + (size_t)t * DM + (lane + 64 * i) * 4) = o; }
        f32x4 lgv = {0.f, 0.f, 0.f, 0.f};
#pragma unroll 4
        for (int i = 0; i < 16; ++i) { const int k = lane + 64 * i; lgv += xs[k] * *(const f32x4*)(p.w_rg + (size_t)k * 4); }
        float lg[4];
#pragma unroll
        for (int g = 0; g < 4; ++g) lg[g] = wsumf(lgv[g]) + p.b_rg[g];
        int gs = 0; float gm = lg[0];
#pragma unroll
        for (int g = 1; g < 4; ++g) if (lg[g] > gm) { gm = lg[g]; gs = g; }
        float den = 0.f;
#pragma unroll
        for (int g = 0; g < 4; ++g) den += __expf(lg[g] - gm);
        const float ptop = 1.f / den;
        f32x4 lev = {0.f, 0.f, 0.f, 0.f}; const float* wre = p.w_re + (size_t)gs * DM * 8;
#pragma unroll 8
        for (int i = 0; i < 32; ++i) { const int c = lane + 64 * i; lev += xs[c >> 1] * *(const f32x4*)(wre + (size_t)c * 4); }
        float le[8];
#pragma unroll
        for (int e = 0; e < 4; ++e) { const float mine = wsum_par(lev[e]), oth = DPP_F(mine, 0xB1); le[e] = mine + p.b_re[gs * 8 + e]; le[4 + e] = oth + p.b_re[gs * 8 + 4 + e]; }
        int e1 = 0; float l1 = le[0];
#pragma unroll
        for (int e = 1; e < 8; ++e) if (le[e] > l1) { l1 = le[e]; e1 = e; }
        int e2 = -1; float l2 = -3.0e38f;
#pragma unroll
        for (int e = 0; e < 8; ++e) if (e != e1 && le[e] > l2) { l2 = le[e]; e2 = e; }
        const float s1 = 1.f / (1.f + __expf(l2 - l1)), s2 = 1.f - s1;
        if (lane == 0) {
            const int ea = gs * 8 + e1, eb = gs * 8 + e2;
            s_e[2 * slot] = ea; s_e[2 * slot + 1] = eb; s_r[2 * slot] = atomicAdd(&s_cnt[ea], 1); s_r[2 * slot + 1] = atomicAdd(&s_cnt[eb], 1);
            s_w[2 * slot] = s1 * ptop; s_w[2 * slot + 1] = s2 * ptop;
        }
    }
    __syncthreads();
    if (tid < 32) { const int c = s_cnt[tid]; s_base[tid] = c ? atomicAdd(&p.cnt[tid], c) : 0; }
    __syncthreads();
    if (tid < 128) { const int sl = tid >> 1, kk = tid & 1, w = sl >> 4, k = sl & 15, t = bid * 4 + w + k * nb * 4;
        if (t < NT) { const int a = 2 * t + kk, e = s_e[tid]; p.list[(size_t)e * NT + s_base[e] + s_r[tid]] = a; p.aw[a] = s_w[tid]; p.aexp[a] = e; } }
    __syncthreads();
}

__device__ __forceinline__ void phase7a(const P& p, int bid, int nb) {
    const bf16_t* h2 = p.slotA; const bf16_t* WguT = (const bf16_t*)p.slotB; bf16_t* hid = p.slotE;
    for (size_t i = (size_t)bid * 256 + threadIdx.x; i < (size_t)2 * NT * 256; i += (size_t)nb * 256) {
        const int a = (int)(i >> 8), c = (int)(i & 255), t = a >> 1, e = p.aexp[a];
        const int tt = c >> 6, wc = (c >> 5) & 1, nn = (c >> 4) & 1, ii = c & 15; const int rg = tt * 128 + wc * 64 + nn * 16 + ii, ru = rg + 32;
        const bf16_t* wg = WguT + ((size_t)e * 512 + rg) * 1024; const bf16_t* wu = WguT + ((size_t)e * 512 + ru) * 1024; const bf16_t* hr = h2 + (size_t)t * DM;
        float G = 0.f, U = 0.f;
        for (int k = 0; k < DM / 8; ++k) { const uint4 hv = ((const uint4*)hr)[k]; G += dot8(hv, ((const uint4*)wg)[k]); U += dot8(hv, ((const uint4*)wu)[k]); }
        hid[i] = f2bf(G * sigmoidf_(G) * U);
    }
}
__device__ __forceinline__ void phase7b(const P& p, int bid, int nb) {
    const bf16_t* hid = p.slotE; const bf16_t* WdT = p.slotC + (size_t)NT * 512; bf16_t* Y = p.slotD;
    for (size_t i = (size_t)bid * 256 + threadIdx.x; i < (size_t)2 * NT * DM; i += (size_t)nb * 256) {
        const int a = (int)(i >> 10), n = (int)(i & 1023), e = p.aexp[a];
        const bf16_t* w = WdT + ((size_t)e * 1024 + n) * 256; const bf16_t* hr = hid + (size_t)a * 256; float s = 0.f;
        for (int k = 0; k < 32; ++k) s += dot8(((const uint4*)hr)[k], ((const uint4*)w)[k]);
        Y[i] = f2bf(s * p.aw[a]);
    }
}


__device__ __forceinline__ void build_expert_table(const int* cnt, volatile LAS int* tab) {
    const int tid = threadIdx.x;
    if (tid < 64) { const int c = tid < NE ? cnt[tid] : 0; int n = (c + 127) >> 7, incl = n;
#pragma unroll
        for (int o = 1; o < 32; o <<= 1) { const int y = __shfl_up(incl, o); if ((tid & 63) >= o) incl += y; }
        if (tid < NE) { tab[tid] = incl - n; tab[32 + tid] = c; } if (tid == NE - 1) tab[64] = incl; }
    __syncthreads();
}
__device__ __forceinline__ bool find_expert(volatile LAS int* tab, int ub, int& e, int& blk, int& ce) {
    if (ub >= tab[64]) return false;
    int lo = 0;
#pragma unroll
    for (int st = 16; st > 0; st >>= 1) if (tab[lo + st] <= ub) lo += st;
    e = lo; blk = ub - tab[lo]; ce = tab[32 + lo]; return true;
}
__device__ __forceinline__ void phase7a_m(const P& p, int bid, int nb, LAS unsigned char* lds) {
    const bf16_t* h2 = p.slotA; const bf16_t* WguT = (const bf16_t*)p.slotB; bf16_t* hid = p.slotE;
    const int tid = opaque_tid(), lane = tid & 63, wid = tid >> 6, wr = wid >> 1, wc = wid & 1, fr = lane & 15, fq = lane >> 4;
    const int c8 = ((tid & 7) ^ ((tid >> 3) & 7)) * 8;
    volatile LAS int* tab = (volatile LAS int*)(lds + LDS_TAB_); build_expert_table(p.cnt, tab);
    auto make = [&](int u, GOps& g) __attribute__((always_inline)) -> bool {
        int e, blk, ce; if (!find_expert(tab, u >> 2, e, blk, ce)) return false;
        const int ct = u & 3; const int* lst = p.list + (size_t)e * NT; const bf16_t* ap[4];
#pragma unroll
        for (int i = 0; i < 4; ++i) { int r = blk * 128 + (tid >> 3) + 32 * i; r = r < ce ? r : ce - 1; ap[i] = h2 + (size_t)(lst[r] >> 1) * DM + c8; }
        g.a0 = ap[0]; g.a1 = ap[1]; g.a2 = ap[2]; g.a3 = ap[3]; g.bp = WguT + ((size_t)e * 512 + ct * 128 + (tid >> 3)) * 1024 + c8; g.bstep = (size_t)32 * 1024; return true; };
    GOps cur; bool have = make(bid, cur);
    for (int u = bid, it = 0; have; u += nb, ++it) {
        GOps nxt = cur; const bool have2 = make(u + nb, nxt);
        f32x4 acc[4][4];
#pragma unroll
        for (int m = 0; m < 4; ++m)
#pragma unroll
            for (int n = 0; n < 4; ++n) acc[m][n] = (f32x4){0.f, 0.f, 0.f, 0.f};
        mg_kloop_p(acc, cur, 16, lds, it > 0, have2, nxt);
        const int ct = u & 3;
        bf16_t* hb = hid + ((size_t)(u >> 2) * 128 + wr * 64 + fr) * 256 + ct * 64 + wc * 32 + fq * 4;
#pragma unroll
        for (int m = 0; m < 4; ++m)
#pragma unroll
            for (int n = 0; n < 2; ++n) { float v[4];
#pragma unroll
                for (int j = 0; j < 4; ++j) { const float g = acc[m][n][j]; v[j] = g * fsigmoid(g) * acc[m][n + 2][j]; }
                uint2 o; o.x = pk2(v[0], v[1]); o.y = pk2(v[2], v[3]); *(uint2*)(hb + (size_t)(m * 16) * 256 + n * 16) = o; }
        cur = nxt; have = have2;
    }
    __syncthreads();
}
__device__ __forceinline__ void phase7b_m(const P& p, int bid, int nb, LAS unsigned char* lds) {
    const bf16_t* hid = p.slotE; const bf16_t* WdT = p.slotC + (size_t)NT * 512; bf16_t* Y = p.slotD;
    const int tid = opaque_tid(), lane = tid & 63, wid = tid >> 6, wr = wid >> 1, wc = wid & 1, fr = lane & 15, fq = lane >> 4;
    const int c8 = ((tid & 7) ^ ((tid >> 3) & 7)) * 8;
    int e, blk, ce;
    volatile LAS int* tab = (volatile LAS int*)(lds + LDS_TAB_); build_expert_table(p.cnt, tab);
    auto make = [&](int u, GOps& g, int& e_, int& blk_, int& ce_) __attribute__((always_inline)) -> bool {
        if (!find_expert(tab, u >> 3, e_, blk_, ce_)) return false;
        g = gops(hid + ((size_t)(u >> 3) * 128 + (tid >> 3)) * 256 + c8, (size_t)32 * 256, WdT + ((size_t)e_ * 1024 + (u & 7) * 128 + (tid >> 3)) * 256 + c8, (size_t)32 * 256); return true; };
    GOps cur; bool have = make(bid, cur, e, blk, ce);
    for (int u = bid, it = 0; have; u += nb, ++it) {
        GOps nxt = cur; int e2 = 0, blk2 = 0, ce2 = 0; const bool have2 = make(u + nb, nxt, e2, blk2, ce2);
        const int ct = u & 7; const int* lst = p.list + (size_t)e * NT;
        f32x4 acc[4][4];
#pragma unroll
        for (int m = 0; m < 4; ++m)
#pragma unroll
            for (int n = 0; n < 4; ++n) acc[m][n] = (f32x4){0.f, 0.f, 0.f, 0.f};
        mg_kloop_p(acc, cur, 4, lds, it > 0, have2, nxt);
#pragma unroll
        for (int m = 0; m < 4; ++m) { const int r = blk * 128 + wr * 64 + m * 16 + fr;
            if (r < ce) { const int a = lst[r]; const float w = p.aw[a]; bf16_t* yp = Y + (size_t)a * DM + ct * 128 + wc * 64 + fq * 4;
#pragma unroll
                for (int n = 0; n < 4; ++n) { uint2 o; o.x = pk2(acc[m][n][0] * w, acc[m][n][1] * w); o.y = pk2(acc[m][n][2] * w, acc[m][n][3] * w); *(uint2*)(yp + n * 16) = o; } } }
        cur = nxt; e = e2; blk = blk2; ce = ce2; have = have2;
    }
    __syncthreads();
}

__device__ __forceinline__ void phase8(const P& p, int bid, int nb, float* dst) {
    const int tid = opaque_tid(), lane = tid & 63, wid = tid >> 6; const bf16_t* Y = p.slotD;
    for (int t = bid * 4 + wid; t < NT; t += nb * 4) {
        f32x4 v[4]; float ss = 0.f;
#pragma unroll
        for (int i = 0; i < 4; ++i) { const int c = (lane + 64 * i) * 4;
            v[i] = *(const f32x4*)(p.out + (size_t)t * DM + c) + bf4(*(const uint2*)(Y + (size_t)(2 * t) * DM + c)) + bf4(*(const uint2*)(Y + (size_t)(2 * t + 1) * DM + c));
            ss += v[i][0] * v[i][0] + v[i][1] * v[i][1] + v[i][2] * v[i][2] + v[i][3] * v[i][3]; }
        ss = wsumf(ss); const float r = rsqrtf(ss * (1.f / DM) + EPS);
#pragma unroll
        for (int i = 0; i < 4; ++i) { const int c = (lane + 64 * i) * 4; const f32x4 g = *(const f32x4*)(p.g_final + c); *(f32x4*)(dst + (size_t)t * DM + c) = v[i] * r * g; }
    }
}

#define XB_TMO      128
#define XB_XCNT(j)  (256  + 64 * (j))
#define XB_XSUB(j)  (1280 + 64 * (j))
#define XB_XGEN(j)  (2304 + 64 * (j))
#define XB_TOP      3328
#define XB_TOPGEN   3392
#define XCD_BAR_WORDS 3456
#define XB_SPIN_CAP (1u << 18)
__device__ __forceinline__ unsigned xb_ld(unsigned* p)              { return __hip_atomic_load(p, __ATOMIC_RELAXED, __HIP_MEMORY_SCOPE_AGENT); }
__device__ __forceinline__ unsigned xb_add(unsigned* p, unsigned v) { return __hip_atomic_fetch_add(p, v, __ATOMIC_RELAXED, __HIP_MEMORY_SCOPE_AGENT); }
__device__ __forceinline__ unsigned xb_xcc_id() { return (unsigned)__builtin_amdgcn_s_getreg((3 << 11) | 20) & 0xFu; }
#define XB_SPIN(cond, bar) do { unsigned _sp = 0; while (cond) { __builtin_amdgcn_s_sleep(1); \
    if ((++_sp & 255u) == 0u) { if (xb_ld(&(bar)[XB_TMO])) break; if (_sp > XB_SPIN_CAP) { atomicAdd(&(bar)[XB_TMO], 1u); break; } } } } while (0)
struct XcdBarrier { unsigned* bar; unsigned x; volatile LAS unsigned* st; };
__device__ __forceinline__ XcdBarrier xcd_barrier_post(unsigned* bar, volatile LAS unsigned* st) {
    XcdBarrier b; b.bar = bar; b.x = xb_xcc_id(); b.st = st;
    if (threadIdx.x == 0) (void)xb_add(&bar[XB_XCNT(b.x)], 1u);
    return b;
}
__device__ __forceinline__ void xcd_barrier_complete(unsigned* bar, unsigned x, unsigned& nloc, unsigned& nx) {
    const unsigned G = gridDim.x * gridDim.y * gridDim.z;
    unsigned sum, cnt, mine, sp = 0u;
    for (;;) {
        sum = 0u; cnt = 0u; mine = 0u;
#pragma unroll
        for (unsigned j = 0; j < 16; ++j) { const unsigned c = xb_ld(&bar[XB_XCNT(j)]); sum += c; cnt += (c > 0u) ? 1u : 0u; mine = (j == x) ? c : mine; }
        if (sum == G) break;
        __builtin_amdgcn_s_sleep(1);
        if ((++sp & 255u) == 0u) { if (xb_ld(&bar[XB_TMO])) break; if (sp > XB_SPIN_CAP) { atomicAdd(&bar[XB_TMO], 1u); break; } }
    }
    nloc = mine > 0u ? mine : 1u; nx = cnt > 0u ? cnt : 1u;
}
__device__ __forceinline__ void xcd_barrier(const XcdBarrier& b) {
    asm volatile("s_waitcnt vmcnt(0)" ::: "memory");
    __syncthreads();
    if (threadIdx.x == 0) {
        unsigned* bar = b.bar;
        __builtin_amdgcn_s_waitcnt(0);
        unsigned nloc = b.st[0], nx = b.st[1];
        if (nloc == 0u) { xcd_barrier_complete(bar, b.x, nloc, nx); b.st[0] = nloc; b.st[1] = nx; }
        const unsigned old = xb_add(&bar[XB_XSUB(b.x)], 1u);
        const unsigned gen = old / nloc;
        if (old + 1u == (gen + 1u) * nloc) {
            __builtin_amdgcn_fence(__ATOMIC_RELEASE, "agent");
            asm volatile("s_waitcnt vmcnt(0)" ::: "memory");
            const unsigned og = xb_add(&bar[XB_TOP], 1u);
            const unsigned tg = og / nx;
            if (og + 1u == (tg + 1u) * nx) xb_add(&bar[XB_TOPGEN], 1u);
            else XB_SPIN(xb_ld(&bar[XB_TOPGEN]) == tg, bar);
            __builtin_amdgcn_fence(__ATOMIC_ACQUIRE, "agent");
            xb_add(&bar[XB_XGEN(b.x)], 1u);
            asm volatile("s_waitcnt vmcnt(0)" ::: "memory");
        } else {
            XB_SPIN(xb_ld(&bar[XB_XGEN(b.x)]) == gen, bar);
            __builtin_amdgcn_fence(__ATOMIC_ACQUIRE, "agent");
            asm volatile("s_waitcnt vmcnt(0)" ::: "memory");
        }
    }
    __syncthreads();
}

constexpr int LDS_MAIN = 64 * 1024;
constexpr int LDS_BYTES = LDS_MAIN + 16 + 288;
extern __shared__ __attribute__((aligned(16))) unsigned char smem_raw[];

#if MK_LAUNCHES != 1
__global__ void __launch_bounds__(256, 2) k_phase(P p, int ph) {
    float* sm = (float*)smem_raw; LAS unsigned char* lds = (LAS unsigned char*)smem_raw; const int bid = blockIdx.x, nb = gridDim.x;
    switch (ph) {
        case 0: phase0(p, bid, nb, sm); break;
        case 1: phase1(p, bid, nb, lds); break;
        case 2: phase2a(p, bid, nb, false); break;
        case 3: phase2b(p, bid, nb, lds); break;
        case 4: phase2c_m(p, bid, nb, lds); break;
        case 5: phase3q<0>(p, bid, nb, lds); break;
        case 6: phase4(p, bid, nb, lds); break;
        case 7: phase5(p, bid, nb, lds); break;
        case 8: phase6(p, bid, nb, sm); break;
        case 9: phase7a_m(p, bid, nb, lds); break;
        case 10: phase7b_m(p, bid, nb, lds); break;
        case 11: phase8(p, bid, nb, p.out); break;
    }
}
#endif

#ifndef PROF_SEL
#define PROF_SEL -1
#endif
#define PROF_MULT 4
__global__ void __launch_bounds__(256, 2) k_mega(P p) {
    float* sm = (float*)smem_raw; LAS unsigned char* lds = (LAS unsigned char*)smem_raw; const int bid = blockIdx.x, nb = gridDim.x;
    volatile LAS unsigned* st = (volatile LAS unsigned*)(lds + LDS_MAIN);
    if (threadIdx.x < 4) st[threadIdx.x] = 0u;
    __syncthreads();
    const XcdBarrier gb = xcd_barrier_post(p.bar, st);
    unsigned long long t_last = 0, t_sel = 0;
#define STAMP(k) do { if (PROF_SEL >= 0 && PROF_SEL < 100) { const unsigned long long t_ = __builtin_amdgcn_s_memrealtime(); if (PROF_SEL == (k) - 1) t_sel = t_ - t_last; t_last = t_; } } while (0)
#define BAR(k) do { if (PROF_SEL == 100 + (k)) { const unsigned long long ta_ = __builtin_amdgcn_s_memrealtime(); xcd_barrier(gb); const unsigned long long tb_ = __builtin_amdgcn_s_memrealtime(); \
        if (threadIdx.x == 0) atomicAdd(p.bar + XCD_BAR_WORDS, (unsigned)(tb_ - ta_)); } else xcd_barrier(gb); STAMP((k) + 1); } while (0)
    STAMP(0);
    phase0(p, bid, nb, sm); BAR(0);
    phase1(p, bid, nb, lds); BAR(1);
    phase2a(p, bid, nb, false); BAR(2);
    phase2b(p, bid, nb, lds); phase2c_m(p, bid, nb, lds); BAR(3);
    phase3q<0>(p, bid, nb, lds); expert_conv(p, bid, nb, sm); BAR(4);
    phase4(p, bid, nb, lds); BAR(5);
    phase5(p, bid, nb, lds); BAR(6);
    phase6(p, bid, nb, sm); BAR(7);
    phase7a_m(p, bid, nb, lds); BAR(8);
    phase7b_m(p, bid, nb, lds); BAR(9);
    phase8(p, bid, nb, p.out);
    if (PROF_SEL >= 0) {
        xcd_barrier(gb); STAMP(11);
        if (bid == 0 && threadIdx.x == 0) {
            unsigned long long metric = t_sel;
            if (PROF_SEL >= 100) metric = __hip_atomic_load(p.bar + XCD_BAR_WORDS, __ATOMIC_RELAXED, __HIP_MEMORY_SCOPE_AGENT) / (unsigned)nb;
            const unsigned long long t0 = __builtin_amdgcn_s_memrealtime();
            while (__builtin_amdgcn_s_memrealtime() - t0 < metric * PROF_MULT) __builtin_amdgcn_s_sleep(8);
        }
    }
}

extern "C" void kernel_launch(void* const* d_in, const int* in_sizes, int n_in, void* d_out, int out_size, void* d_ws, size_t ws_size, hipStream_t stream) {
    P p{};
    p.x = (const float*)d_in[0]; p.pos = (const int*)d_in[1]; p.g_attn = (const float*)d_in[2]; p.w_in = (const float*)d_in[3]; p.g_cq = (const float*)d_in[4];
    p.w_uq = (const float*)d_in[5]; p.g_ckv = (const float*)d_in[6]; p.w_uk = (const float*)d_in[7]; p.w_uv = (const float*)d_in[8]; p.w_o_attn = (const float*)d_in[9];
    p.sgu_gain = (const float*)d_in[10]; p.sgu_bias = (const float*)d_in[11]; p.w_sp = (const float*)d_in[12]; p.b_sp = (const float*)d_in[13]; p.w_o_sgu = (const float*)d_in[14];
    p.w_out = (const float*)d_in[15]; p.g_ffn = (const float*)d_in[16]; p.w_rg = (const float*)d_in[17]; p.b_rg = (const float*)d_in[18]; p.w_re = (const float*)d_in[19];
    p.b_re = (const float*)d_in[20]; p.w_eg = (const float*)d_in[21]; p.w_eu = (const float*)d_in[22]; p.w_ed = (const float*)d_in[23]; p.g_final = (const float*)d_in[24];
    p.out = (float*)d_out;
    unsigned char* w = (unsigned char*)d_ws; size_t off = 0;
    auto take = [&](size_t bytes) { unsigned char* r = w + off; off += (bytes + 255) & ~(size_t)255; return r; };
    p.bar = (unsigned*)take((XCD_BAR_WORDS + 64) * 4);
    p.cnt = (int*)take(4096);
    p.WinT = (bf16_t*)take((size_t)ZP * DM * 2); p.WuqT = (bf16_t*)take(768 * 256 * 2); p.WukT = (bf16_t*)take(512 * 128 * 2); p.WuvT = (bf16_t*)take(512 * 128 * 2);
    p.WoaT = (bf16_t*)take(1024 * 512 * 2); p.WosT = (bf16_t*)take(1024 * 512 * 2); p.WoutT = (bf16_t*)take(1024 * 1024 * 2); p.Wsp = (bf16_t*)take(8 * 128 * 128 * 2);
    p.cs = (float*)take((size_t)NT * 32 * 4); p.cqn = (bf16_t*)take((size_t)NT * 256 * 2); p.ckvn = (bf16_t*)take((size_t)NT * 128 * 2);
    p.list = (int*)take((size_t)NE * NT * 4); p.aw = (float*)take((size_t)2 * NT * 4); p.aexp = (int*)take((size_t)2 * NT * 4);
    p.slotA = (bf16_t*)take((size_t)NT * DM * 2);
    p.slotB = take((size_t)NT * 512 * 4);
    p.slotC = (bf16_t*)take((size_t)NT * 1024 * 2);
    p.slotD = (bf16_t*)take((size_t)NT * 2048 * 2);
    p.slotE = (bf16_t*)take((size_t)NT * NH * 96 * 2);
    p.slotF = (bf16_t*)take((size_t)512 * NT * 2);
    p.slotG = (bf16_t*)take((size_t)NT * 512 * 2);
    if (off > ws_size) { fprintf(stderr, "workspace too small: need %zu have %zu\n", off, ws_size); return; }
#if MK_LAUNCHES == 1
    static int grid_blocks = 0;
    if (!grid_blocks) { int dev = 0, cus = 0, per_cu = 0; hipGetDevice(&dev); hipDeviceGetAttribute(&cus, hipDeviceAttributeMultiprocessorCount, dev);
        hipOccupancyMaxActiveBlocksPerMultiprocessor(&per_cu, k_mega, 256, LDS_BYTES); if (per_cu > 2) per_cu = 2; grid_blocks = cus * per_cu; }
    (void)hipMemsetAsync(p.bar, 0, (XCD_BAR_WORDS + 64) * 4, stream);
    void* args[] = {&p};
    hipError_t e = hipLaunchCooperativeKernel((void*)k_mega, dim3(grid_blocks), dim3(256), args, LDS_BYTES, stream);
    if (e != hipSuccess) fprintf(stderr, "cooperative launch failed: %s (grid %d)\n", hipGetErrorString(e), grid_blocks);
#else
    for (int ph = 0; ph < 12; ++ph) k_phase<<<2048, 256, LDS_BYTES, stream>>>(p, ph);
#endif
}
```

```cpp
#include <hip/hip_runtime.h>
#include <hip/hip_cooperative_groups.h>
#include <cstdint>
#include <cstdio>
namespace cg = cooperative_groups;

#ifndef ATT_SGB
#define ATT_SGB 1
#endif
#ifndef PROBE
#define PROBE 0
#endif
#ifndef MK_LAUNCHES
#define MK_LAUNCHES 1
#endif

typedef unsigned short bf16_t;
constexpr int NT = 16384, SEQ = 8192, DM = 1024, NBATCH = 2;
constexpr int ZC = 3488;
constexpr int ZP = 3584;
constexpr int NH = 8;
constexpr float EPS = 1e-6f;
constexpr int NE = 32;
constexpr int LDS_TAB_ = 64 * 1024 + 16;

struct P {
    const float* x; const int* pos; const float* g_attn; const float* w_in; const float* g_cq; const float* w_uq;
    const float* g_ckv; const float* w_uk; const float* w_uv; const float* w_o_attn; const float* sgu_gain; const float* sgu_bias;
    const float* w_sp; const float* b_sp; const float* w_o_sgu; const float* w_out; const float* g_ffn; const float* w_rg;
    const float* b_rg; const float* w_re; const float* b_re; const float* w_eg; const float* w_eu; const float* w_ed; const float* g_final;
    float* out;
    unsigned* bar;
    int* cnt;
    bf16_t* WinT;
    bf16_t* WuqT;
    bf16_t* WukT;
    bf16_t* WuvT;
    bf16_t* WoaT;
    bf16_t* WosT;
    bf16_t* WoutT;
    bf16_t* Wsp;
    float* cs;
    bf16_t* cqn;
    bf16_t* ckvn;
    int* list;
    float* aw;
    int* aexp;
    bf16_t* slotA;
    unsigned char* slotB;
    bf16_t* slotC;
    bf16_t* slotD;
    bf16_t* slotE;
    bf16_t* slotF;
    bf16_t* slotG;
};

__device__ __forceinline__ int opaque_tid() { int t = threadIdx.x; asm volatile("" : "+v"(t)); return t; }
__device__ __forceinline__ float bf2f(bf16_t v) { return __uint_as_float(((unsigned)v) << 16); }
__device__ __forceinline__ bf16_t f2bf(float f) { unsigned u = __float_as_uint(f); u += 0x7fffu + ((u >> 16) & 1u); return (bf16_t)(u >> 16); }
__device__ __forceinline__ float dot8(const uint4 a, const uint4 b) {
    float s = 0.f;
    s += __uint_as_float(a.x << 16) * __uint_as_float(b.x << 16) + __uint_as_float(a.x & 0xffff0000u) * __uint_as_float(b.x & 0xffff0000u);
    s += __uint_as_float(a.y << 16) * __uint_as_float(b.y << 16) + __uint_as_float(a.y & 0xffff0000u) * __uint_as_float(b.y & 0xffff0000u);
    s += __uint_as_float(a.z << 16) * __uint_as_float(b.z << 16) + __uint_as_float(a.z & 0xffff0000u) * __uint_as_float(b.z & 0xffff0000u);
    s += __uint_as_float(a.w << 16) * __uint_as_float(b.w << 16) + __uint_as_float(a.w & 0xffff0000u) * __uint_as_float(b.w & 0xffff0000u);
    return s;
}
__device__ __forceinline__ float wsum(float v) { for (int o = 32; o > 0; o >>= 1) v += __shfl_xor(v, o); return v; }

#define DPP_F(v, ctrl) __builtin_bit_cast(float, __builtin_amdgcn_update_dpp(0, __builtin_bit_cast(int, (v)), (ctrl), 0xF, 0xF, true))
__device__ __forceinline__ float xrows(float v) {
    { const auto r = __builtin_amdgcn_permlane16_swap(__float_as_uint(v), __float_as_uint(v), false, false); v = __uint_as_float(r[0]) + __uint_as_float(r[1]); }
    { const auto r = __builtin_amdgcn_permlane32_swap(__float_as_uint(v), __float_as_uint(v), false, false); v = __uint_as_float(r[0]) + __uint_as_float(r[1]); }
    return v;
}
__device__ __forceinline__ float wsumf(float v) {
    v += DPP_F(v, 0xB1); v += DPP_F(v, 0x4E); v += DPP_F(v, 0x141); v += DPP_F(v, 0x140); return xrows(v);
}
__device__ __forceinline__ float wsum_par(float v) {
    v += DPP_F(v, 0x128); v += DPP_F(v, 0x124); v += DPP_F(v, 0x122); return xrows(v);
}
__device__ __forceinline__ float wmax(float v) { for (int o = 32; o > 0; o >>= 1) v = fmaxf(v, __shfl_xor(v, o)); return v; }
__device__ __forceinline__ float fsigmoid(float v) { return __builtin_amdgcn_rcpf(1.f + __builtin_amdgcn_exp2f(-1.4426950408889634f * v)); }
__device__ __forceinline__ float fgelu(float v) { const float u2 = 1.5957691216057308f * (v + 0.044715f * v * v * v); return v * fsigmoid(u2); }
__device__ __forceinline__ float gelu_tanh(float v) { const float u = 0.7978845608028654f * (v + 0.044715f * v * v * v); const float t = 1.f - 2.f / (__expf(2.f * u) + 1.f); return 0.5f * v * (1.f + t); }
__device__ __forceinline__ float sigmoidf_(float v) { return 1.f / (1.f + __expf(-v)); }

#define LAS __attribute__((address_space(3)))
typedef short bf16x8 __attribute__((ext_vector_type(8)));
typedef float f32x4 __attribute__((ext_vector_type(4)));
constexpr int GEMM_LDS = 65536;
typedef float f32x16 __attribute__((ext_vector_type(16)));
typedef unsigned u32x2 __attribute__((ext_vector_type(2)));
typedef unsigned u32x4 __attribute__((ext_vector_type(4)));
typedef __bf16 bf16v2 __attribute__((ext_vector_type(2)));
typedef float f32v2 __attribute__((ext_vector_type(2)));
__device__ __forceinline__ unsigned pk2(float lo, float hi) { const f32v2 v = {lo, hi}; return __builtin_bit_cast(unsigned, __builtin_convertvector(v, bf16v2)); }
__device__ __forceinline__ f32x4 bf4(const uint2 u) { return (f32x4){__uint_as_float(u.x << 16), __uint_as_float(u.x & 0xffff0000u), __uint_as_float(u.y << 16), __uint_as_float(u.y & 0xffff0000u)}; }


template <class F>
__device__ __forceinline__ int tconv(bf16_t* dst, int R, int K, F f, int base, int bid, int nb, float* sm) {
    const int tid = opaque_tid(), tk = K / 64, ntile = (R / 64) * tk;
    for (int tile = ((bid - base) % nb + nb) % nb; tile < ntile; tile += nb) {
        const int rho0 = (tile / tk) * 64, k0 = (tile % tk) * 64;
#pragma unroll
        for (int i = 0; i < 16; ++i) { const int kk = (tid >> 6) + 4 * i, rr = tid & 63; sm[kk * 65 + rr] = f(k0 + kk, rho0 + rr); }
        __syncthreads();
#pragma unroll
        for (int i = 0; i < 8; ++i) { const int rr = (tid >> 5) + 8 * i, kk = (tid & 31) * 2;
            *(unsigned*)(dst + (size_t)(rho0 + rr) * K + k0 + kk) = pk2(sm[kk * 65 + rr], sm[(kk + 1) * 65 + rr]); }
        __syncthreads();
    }
    return base + ntile;
}

__device__ __forceinline__ void phase0(const P& p, int bid, int nb, float* sm) {
    const int tid = opaque_tid(), lane = tid & 63, wid = tid >> 6;
    const size_t gtid = (size_t)bid * 256 + tid, gsz = (size_t)nb * 256;
    if (bid == 0 && tid < NE) p.cnt[tid] = 0;
    for (int t = bid * 4 + wid; t < NT; t += nb * 4) {
        const float* xr = p.x + (size_t)t * DM; f32x4 v[4]; float ss = 0.f;
#pragma unroll
        for (int i = 0; i < 4; ++i) { v[i] = *(const f32x4*)(xr + (lane + 64 * i) * 4); ss += v[i][0] * v[i][0] + v[i][1] * v[i][1] + v[i][2] * v[i][2] + v[i][3] * v[i][3]; }
        ss = wsumf(ss); const float r = rsqrtf(ss * (1.f / DM) + EPS);
        bf16_t* hr = p.slotA + (size_t)t * DM;
#pragma unroll
        for (int i = 0; i < 4; ++i) { uint2 o; o.x = pk2(v[i][0] * r, v[i][1] * r); o.y = pk2(v[i][2] * r, v[i][3] * r); *(uint2*)(hr + (lane + 64 * i) * 4) = o; }
    }
    int base = 0;
    base = tconv(p.WinT, ZP, DM, [&](int k, int rho) { float v = 0.f;
        if (rho < 416) v = p.w_in[(size_t)k * ZC + rho]; else if (rho >= 512) v = p.w_in[(size_t)k * ZC + rho - 96];
        return v * p.g_attn[k]; }, base, bid, nb, sm);
    const float qscale = 0.10206207261596575f * 1.4426950408889634f;
    base = tconv(p.WuqT, 768, 256, [&](int k, int rho) { int col;
        if (rho < 512) col = (rho >> 6) * 96 + (rho & 63); else { const int hh = (rho - 512) >> 5, w = (rho - 512) & 31; col = hh * 96 + 64 + (w >> 1) + 16 * (w & 1); }
        return p.w_uq[(size_t)k * 768 + col] * p.g_cq[k] * qscale; }, base, bid, nb, sm);
    base = tconv(p.WukT, 512, 128, [&](int k, int c) { return p.w_uk[(size_t)k * 512 + c] * p.g_ckv[k]; }, base, bid, nb, sm);
    base = tconv(p.WuvT, 512, 128, [&](int k, int c) { return p.w_uv[(size_t)k * 512 + c] * p.g_ckv[k]; }, base, bid, nb, sm);
    base = tconv(p.WoaT, 1024, 512, [&](int k, int n) { return p.w_o_attn[(size_t)k * 1024 + n]; }, base, bid, nb, sm);
    base = tconv(p.WosT, 1024, 512, [&](int k, int n) { return p.w_o_sgu[(size_t)k * 1024 + n]; }, base, bid, nb, sm);
    base = tconv(p.WoutT, 1024, 1024, [&](int k, int n) { return p.w_out[(size_t)k * 1024 + n]; }, base, bid, nb, sm);
    for (size_t i = gtid; i < (size_t)8 * 128 * 128; i += gsz) { const int j = (int)(i & 127), ii = (int)((i >> 7) & 127);
        p.Wsp[i] = ((j >> 6) <= (ii >> 6)) ? f2bf(p.w_sp[i]) : (bf16_t)0; }
}

template <class Epi>
__device__ void ngemm(const bf16_t* A, int lda, const bf16_t* Bt, int ldb, int M, int N, int K, Epi epi, int bid, int nb, float* sm) {
    float* As = sm; float* Bs = sm + 16 * 68;
    const int tid = opaque_tid(), ty = tid >> 4, tx = tid & 15; const int tn = N / 64, ntile = (M / 64) * tn;
    for (int tile = bid; tile < ntile; tile += nb) {
        const int row0 = (tile / tn) * 64, col0 = (tile % tn) * 64;
        float acc[4][4];
#pragma unroll
        for (int i = 0; i < 4; ++i)
#pragma unroll
            for (int j = 0; j < 4; ++j) acc[i][j] = 0.f;
        for (int k0 = 0; k0 < K; k0 += 16) {
#pragma unroll
            for (int i = 0; i < 4; ++i) { const int idx = tid + i * 256, r = idx >> 4, kk = idx & 15;
                As[kk * 68 + r] = bf2f(A[(size_t)(row0 + r) * lda + k0 + kk]);
                Bs[kk * 68 + r] = bf2f(Bt[(size_t)(col0 + r) * ldb + k0 + kk]); }
            __syncthreads();
#pragma unroll
            for (int kk = 0; kk < 16; ++kk) { float a[4], b[4];
#pragma unroll
                for (int i = 0; i < 4; ++i) { a[i] = As[kk * 68 + ty * 4 + i]; b[i] = Bs[kk * 68 + tx * 4 + i]; }
#pragma unroll
                for (int i = 0; i < 4; ++i)
#pragma unroll
                    for (int j = 0; j < 4; ++j) acc[i][j] += a[i] * b[j]; }
            __syncthreads();
        }
#pragma unroll
        for (int i = 0; i < 4; ++i) epi(row0 + ty * 4 + i, col0 + tx * 4, acc[i]);
    }
}


__device__ __forceinline__ bool tile_of(int it, int bid, int nb, int RT, int CT, int& rt, int& ct) {
    if ((RT & 31) == 0 && (nb & 7) == 0) {
        const int x = bid & 7, l = bid >> 3, nl = nb >> 3, rpx = RT >> 3; const int lt = l + it * nl; if (lt >= rpx * CT) return false;
        const int rg = lt / (4 * CT), w = lt % (4 * CT); rt = x * rpx + rg * 4 + (w & 3); ct = w >> 2; return true;
    }
    const int tile = bid + it * nb; if (tile >= RT * CT) return false; rt = tile / CT; ct = tile % CT; return true;
}
struct GOps { const bf16_t* a0; const bf16_t* a1; const bf16_t* a2; const bf16_t* a3; const bf16_t* bp; size_t bstep; };
__device__ __forceinline__ GOps gops(const bf16_t* ap, size_t astep, const bf16_t* bp, size_t bstep) { GOps g; g.a0 = ap; g.a1 = ap + astep; g.a2 = ap + 2 * astep; g.a3 = ap + 3 * astep; g.bp = bp; g.bstep = bstep; return g; }
__device__ __forceinline__ void mg_stage(const GOps& g, int t, LAS unsigned char* lds, int widu) {
    LAS unsigned char* d = lds + (t & 1) * 32768 + widu * 1024; const int k0 = t * 64;
    __builtin_amdgcn_global_load_lds((const unsigned*)(g.a0 + k0), (LAS unsigned*)(d), 16, 0, 0);
    __builtin_amdgcn_global_load_lds((const unsigned*)(g.a1 + k0), (LAS unsigned*)(d + 4096), 16, 0, 0);
    __builtin_amdgcn_global_load_lds((const unsigned*)(g.a2 + k0), (LAS unsigned*)(d + 8192), 16, 0, 0);
    __builtin_amdgcn_global_load_lds((const unsigned*)(g.a3 + k0), (LAS unsigned*)(d + 12288), 16, 0, 0);
#pragma unroll
    for (int i = 0; i < 4; ++i) __builtin_amdgcn_global_load_lds((const unsigned*)(g.bp + i * g.bstep + k0), (LAS unsigned*)(d + 16384 + i * 4096), 16, 0, 0);
}
__device__ __forceinline__ void mg_kloop_p(f32x4 (&acc)[4][4], const GOps& g, int nk, LAS unsigned char* lds, bool prestaged, bool has_next, const GOps& nxt) {
    const int tid = opaque_tid(), lane = tid & 63, wid = tid >> 6, wr = wid >> 1, wc = wid & 1, fr = lane & 15, fq = lane >> 4;
    const int widu = __builtin_amdgcn_readfirstlane(wid);
    if (!prestaged) mg_stage(g, 0, lds, widu);
    const int pc0 = ((fq) ^ (fr & 7)) * 16, pc1 = ((4 + fq) ^ (fr & 7)) * 16;
    for (int t = 0; t < nk; ++t) {
        asm volatile("s_waitcnt vmcnt(0)" ::: "memory");
        __syncthreads();
        if (t + 1 < nk) mg_stage(g, t + 1, lds, widu); else if (has_next) mg_stage(nxt, 0, lds, widu);
        const LAS unsigned char* ab = lds + (t & 1) * 32768 + (wr * 64 + fr) * 128; const LAS unsigned char* bb = lds + (t & 1) * 32768 + 16384 + (wc * 64 + fr) * 128;
        bf16x8 af[2][4], bfr[2][4];
#pragma unroll
        for (int m = 0; m < 4; ++m) { af[0][m] = *(const LAS bf16x8*)(ab + m * 2048 + pc0); bfr[0][m] = *(const LAS bf16x8*)(bb + m * 2048 + pc0); }
#pragma unroll
        for (int m = 0; m < 4; ++m) { af[1][m] = *(const LAS bf16x8*)(ab + m * 2048 + pc1); bfr[1][m] = *(const LAS bf16x8*)(bb + m * 2048 + pc1); }
        __builtin_amdgcn_sched_barrier(0);
#pragma unroll
        for (int ks = 0; ks < 2; ++ks)
#pragma unroll
            for (int m = 0; m < 4; ++m)
#pragma unroll
                for (int n = 0; n < 4; ++n) acc[m][n] = __builtin_amdgcn_mfma_f32_16x16x32_bf16(bfr[ks][n], af[ks][m], acc[m][n], 0, 0, 0);
    }
}
template <class Epi>
__device__ __forceinline__ void mgemm(const bf16_t* A, int lda, const bf16_t* Bt, int ldb, int M, int N, int K, Epi epi, int bid, int nb, LAS unsigned char* lds) {
    const int tid = opaque_tid(), lane = tid & 63, wid = tid >> 6, wr = wid >> 1, wc = wid & 1, fr = lane & 15, fq = lane >> 4;
    const int RT = M / 128, CT = N / 128; const int c8 = ((tid & 7) ^ ((tid >> 3) & 7)) * 8;
    int rt, ct; bool have = tile_of(0, bid, nb, RT, CT, rt, ct);
    GOps cur = gops(A + (size_t)(rt * 128 + (tid >> 3)) * lda + c8, (size_t)32 * lda, Bt + (size_t)(ct * 128 + (tid >> 3)) * ldb + c8, (size_t)32 * ldb);
    for (int it = 0; have; ++it) {
        const int row0 = rt * 128, col0 = ct * 128;
        int rt2, ct2; const bool have2 = tile_of(it + 1, bid, nb, RT, CT, rt2, ct2);
        const GOps nxt = gops(A + (size_t)((have2 ? rt2 : rt) * 128 + (tid >> 3)) * lda + c8, (size_t)32 * lda, Bt + (size_t)((have2 ? ct2 : ct) * 128 + (tid >> 3)) * ldb + c8, (size_t)32 * ldb);
        f32x4 acc[4][4];
#pragma unroll
        for (int m = 0; m < 4; ++m)
#pragma unroll
            for (int n = 0; n < 4; ++n) acc[m][n] = (f32x4){0.f, 0.f, 0.f, 0.f};
        mg_kloop_p(acc, cur, K / 64, lds, it > 0, have2, nxt);
#pragma unroll
        for (int m = 0; m < 4; ++m)
#pragma unroll
            for (int n = 0; n < 4; ++n) epi(row0 + wr * 64 + m * 16 + fr, col0 + wc * 64 + n * 16 + fq * 4, acc[m][n]);
        cur = nxt; rt = rt2; ct = ct2; have = have2;
    }
    __syncthreads();
}


__device__ __forceinline__ void stg_put(LAS unsigned char* S, int r, int c4, const uint2 v) { const u32x2 w = {v.x, v.y};
    *(LAS u32x2*)(S + r * 256 + (((c4 >> 3) ^ (r & 15)) << 4) + ((c4 & 4) << 1)) = w; }
__device__ __forceinline__ void stg_put32(LAS unsigned char* S, int r, int c2, const unsigned v) {
    *(LAS unsigned*)(S + r * 256 + (((c2 >> 3) ^ (r & 15)) << 4) + ((c2 & 7) << 1)) = v; }
template <int SEG, class D>
__device__ __forceinline__ void stg_flush(LAS unsigned char* S, D dst) {
    const int tid = threadIdx.x, lane = tid & 63, wid = tid >> 6;
#pragma unroll
    for (int it = 0; it < 8; ++it) { const int r = wid * 32 + it * 4 + (lane >> 4), cc = lane & 15;
        const u32x4 v = *(const LAS u32x4*)(S + r * 256 + ((cc ^ (r & 15)) << 4));
        bf16_t* d = dst(r, cc / (SEG / 8));
        if (d) *(u32x4*)(d + (cc % (SEG / 8)) * 8) = v; }
}
template <int SEG, class Val, class Dst>
__device__ __forceinline__ void mgemm_st(const bf16_t* A, int lda, const bf16_t* Bt, int ldb, int M, int N, int K, Val val, Dst dst, int bid, int nb, LAS unsigned char* lds) {
    const int tid = opaque_tid(), lane = tid & 63, wid = tid >> 6, wr = wid >> 1, wc = wid & 1, fr = lane & 15, fq = lane >> 4;
    const int RT = M / 128, CT = N / 128; const int c8 = ((tid & 7) ^ ((tid >> 3) & 7)) * 8;
    LAS unsigned char* S = lds + 32768;
    int rt, ct; bool have = tile_of(0, bid, nb, RT, CT, rt, ct);
    GOps cur = gops(A + (size_t)(rt * 128 + (tid >> 3)) * lda + c8, (size_t)32 * lda, Bt + (size_t)(ct * 128 + (tid >> 3)) * ldb + c8, (size_t)32 * ldb);
    for (int it = 0; have; ++it) {
        const int row0 = rt * 128, col0 = ct * 128;
        int rt2, ct2; const bool have2 = tile_of(it + 1, bid, nb, RT, CT, rt2, ct2);
        const GOps nxt = gops(A + (size_t)((have2 ? rt2 : rt) * 128 + (tid >> 3)) * lda + c8, (size_t)32 * lda, Bt + (size_t)((have2 ? ct2 : ct) * 128 + (tid >> 3)) * ldb + c8, (size_t)32 * ldb);
        f32x4 acc[4][4];
#pragma unroll
        for (int m = 0; m < 4; ++m)
#pragma unroll
            for (int n = 0; n < 4; ++n) acc[m][n] = (f32x4){0.f, 0.f, 0.f, 0.f};
        mg_kloop_p(acc, cur, K / 64, lds, it > 0, have2, nxt);
        __syncthreads();
#pragma unroll
        for (int m = 0; m < 4; ++m)
#pragma unroll
            for (int n = 0; n < 4; ++n) { const int r = wr * 64 + m * 16 + fr, c = wc * 64 + n * 16 + fq * 4; stg_put(S, r, c, val(row0 + r, col0 + c, acc[m][n])); }
        __syncthreads();
        stg_flush<SEG>(S, [&](int r, int seg) __attribute__((always_inline)) { return dst(row0, col0, r, seg); });
        cur = nxt; rt = rt2; ct = ct2; have = have2;
    }
    __syncthreads();
}

__device__ __forceinline__ void phase1(const P& p, int bid, int nb, LAS unsigned char* sm) {
    bf16_t* zs = (bf16_t*)p.slotB; bf16_t* uvg = p.slotC; bf16_t* gates = p.slotD;
    mgemm_st<128>(p.slotA, DM, p.WinT, DM, NT, ZP, DM, [=](int t, int c, const f32x4& v) { uint2 o;
        if (c < 512) { o.x = pk2(v[0], v[1]); o.y = pk2(v[2], v[3]); }
        else if (c < 1536) { o.x = pk2(fgelu(v[0]), fgelu(v[1])); o.y = pk2(fgelu(v[2]), fgelu(v[3])); }
        else { o.x = pk2(fsigmoid(v[0]), fsigmoid(v[1])); o.y = pk2(fsigmoid(v[2]), fsigmoid(v[3])); }
        return o;
    }, [=](int row0, int col0, int r, int) -> bf16_t* { const size_t t = (size_t)(row0 + r);
        if (col0 < 512) return zs + t * 512 + col0; if (col0 < 1536) return uvg + t * 1024 + (col0 - 512); return gates + t * 2048 + (col0 - 1536);
    }, bid, nb, sm);
}

__device__ __forceinline__ void phase2a(const P& p, int bid, int nb, bool dry) {
    const int tid = opaque_tid(), lane = tid & 63, wid = tid >> 6;
    const bf16_t* zs = (const bf16_t*)p.slotB; bf16_t* K = p.slotE; bf16_t* uvg = p.slotC;
    const f32x4 gn0 = *(const f32x4*)(p.sgu_gain + lane * 8), gn1 = *(const f32x4*)(p.sgu_gain + lane * 8 + 4);
    const f32x4 bs0 = *(const f32x4*)(p.sgu_bias + lane * 8), bs1 = *(const f32x4*)(p.sgu_bias + lane * 8 + 4);
    for (int t = bid * 4 + wid; t < NT; t += nb * 4) {
        const bf16_t* z = zs + (size_t)t * 512;
        const f32x4 cq = bf4(*(const uint2*)(z + lane * 4));
        const f32x4 ck = bf4(*(const uint2*)(z + 256 + (lane & 31) * 4));
        bf16_t* vr = uvg + (size_t)t * 1024 + 512 + lane * 8;
        const uint4 vraw = *(const uint4*)vr;
        { const float ss = wsumf(cq[0] * cq[0] + cq[1] * cq[1] + cq[2] * cq[2] + cq[3] * cq[3]); const float r = rsqrtf(ss * (1.f / 256.f) + EPS);
          uint2 o; o.x = pk2(cq[0] * r, cq[1] * r); o.y = pk2(cq[2] * r, cq[3] * r); *(uint2*)(p.cqn + (size_t)t * 256 + lane * 4) = o; }
        { const float ss = wsumf(lane < 32 ? ck[0] * ck[0] + ck[1] * ck[1] + ck[2] * ck[2] + ck[3] * ck[3] : 0.f); const float r = rsqrtf(ss * (1.f / 128.f) + EPS);
          if (lane < 32) { uint2 o; o.x = pk2(ck[0] * r, ck[1] * r); o.y = pk2(ck[2] * r, ck[3] * r); *(uint2*)(p.ckvn + (size_t)t * 128 + lane * 4) = o; } }
        { const int b = t >> 13, sq = t & 8191, hd = lane >> 3, j = lane & 7; const float posf = (float)p.pos[t]; float val[4], tab[4];
#pragma unroll
          for (int q = 0; q < 4; ++q) { const int i = (4 * j + q) & 15;
              float f = (i & 3) == 0 ? 1.0f : (i & 3) == 1 ? 0.5623413251903491f : (i & 3) == 2 ? 0.31622776601683794f : 0.1778279410038923f;
              const int q4 = i >> 2; f *= (q4 == 0 ? 1.0f : q4 == 1 ? 0.1f : q4 == 2 ? 0.01f : 0.001f);
              const float ang = posf * f; const double rev = (double)ang * 0.15915494309189535; const float frc = (float)(rev - floor(rev));
              const float sn = __builtin_amdgcn_sinf(frc), cn = __builtin_amdgcn_cosf(frc);
              const float k1 = bf2f(z[384 + i]), k2 = bf2f(z[400 + i]);
              val[q] = (j < 4) ? (k1 * cn - k2 * sn) : (k1 * sn + k2 * cn); tab[q] = (j < 4) ? cn : sn; }
          uint2 o; o.x = pk2(val[0], val[1]); o.y = pk2(val[2], val[3]);
          *(uint2*)(K + ((size_t)(b * NH + hd) * SEQ + sq) * 96 + 64 + 4 * j) = o;
          if (hd == 0) *(f32x4*)(p.cs + (size_t)t * 32 + 4 * j) = (f32x4){tab[0], tab[1], tab[2], tab[3]}; }
        { float v[8]; const unsigned w[4] = {vraw.x, vraw.y, vraw.z, vraw.w};
#pragma unroll
          for (int i = 0; i < 4; ++i) { v[2 * i] = __uint_as_float(w[i] << 16); v[2 * i + 1] = __uint_as_float(w[i] & 0xffff0000u); }
          float sm_ = 0.f;
#pragma unroll
          for (int i = 0; i < 8; ++i) sm_ += v[i];
          sm_ = wsumf(sm_); const float mu = sm_ * (1.f / 512.f); float q = 0.f;
#pragma unroll
          for (int i = 0; i < 8; ++i) { const float d = v[i] - mu; q += d * d; }
          q = wsumf(q); const float r = rsqrtf(q * (1.f / 512.f) + EPS);
          uint4 o;
          o.x = pk2((v[0] - mu) * r * gn0[0] + bs0[0], (v[1] - mu) * r * gn0[1] + bs0[1]); o.y = pk2((v[2] - mu) * r * gn0[2] + bs0[2], (v[3] - mu) * r * gn0[3] + bs0[3]);
          o.z = pk2((v[4] - mu) * r * gn1[0] + bs1[0], (v[5] - mu) * r * gn1[1] + bs1[1]); o.w = pk2((v[6] - mu) * r * gn1[2] + bs1[2], (v[7] - mu) * r * gn1[3] + bs1[3]);
          *(uint4*)(dry ? p.slotG + (size_t)t * 512 + lane * 8 : vr) = o; }
    }
}

__device__ __forceinline__ void phase2b(const P& p, int bid, int nb, LAS unsigned char* sm) {
    bf16_t* Q = p.slotA; bf16_t* K = p.slotE; bf16_t* VT = p.slotF; const float* cs = p.cs;
    mgemm(p.cqn, 256, p.WuqT, 256, NT, 768, 256, [=](int t, int c, const f32x4& v) {
        const int b = t >> 13, s = t & 8191;
        if (c < 512) { const int h = c >> 6, d = c & 63; uint2 o; o.x = pk2(v[0], v[1]); o.y = pk2(v[2], v[3]); *(uint2*)(Q + ((size_t)(b * NH + h) * SEQ + s) * 96 + d) = o; }
        else { const int h = (c - 512) >> 5, i0 = ((c - 512) & 31) >> 1; bf16_t* q = Q + ((size_t)(b * NH + h) * SEQ + s) * 96;
            const float2 cn = *(const float2*)(cs + (size_t)t * 32 + i0), sn = *(const float2*)(cs + (size_t)t * 32 + 16 + i0);
            *(unsigned*)(q + 64 + i0) = pk2(v[0] * cn.x - v[1] * sn.x, v[2] * cn.y - v[3] * sn.y);
            *(unsigned*)(q + 80 + i0) = pk2(v[0] * sn.x + v[1] * cn.x, v[2] * sn.y + v[3] * cn.y); }
    }, bid, nb, sm);
    mgemm_st<64>(p.ckvn, 128, p.WukT, 128, NT, 512, 128, [=](int, int, const f32x4& v) { uint2 o; o.x = pk2(v[0], v[1]); o.y = pk2(v[2], v[3]); return o; },
        [=](int row0, int col0, int r, int seg) -> bf16_t* { const int t = row0 + r, b = t >> 13, s = t & 8191, h = (col0 >> 6) + seg; return K + ((size_t)(b * NH + h) * SEQ + s) * 96; }, bid, nb, sm);
    mgemm_st<128>(p.WuvT, 128, p.ckvn, 128, 512, NT, 128, [=](int, int, const f32x4& v) { uint2 o; o.x = pk2(v[0], v[1]); o.y = pk2(v[2], v[3]); return o; },
        [=](int row0, int col0, int r, int) -> bf16_t* { return VT + (size_t)(row0 + r) * NT + col0; }, bid, nb, sm);
}

__device__ __forceinline__ void phase2c(const P& p, int bid, int nb) {
    const bf16_t* uvg = p.slotC; bf16_t* su = p.slotG;
    for (size_t i = (size_t)bid * 256 + threadIdx.x; i < (size_t)NT * 512; i += (size_t)nb * 256) {
        const int t = (int)(i >> 9), c = (int)(i & 511), g = c >> 6, ii = t & 127, t0 = t - ii;
        const bf16_t* w = p.Wsp + ((size_t)g * 128 + ii) * 128; float s = 0.f;
        for (int j = 0; j < 128; ++j) s += bf2f(w[j]) * bf2f(uvg[(size_t)(t0 + j) * 1024 + 512 + c]);
        s += p.b_sp[g * 128 + ii];
        su[i] = f2bf(bf2f(uvg[(size_t)t * 1024 + c]) * s);
    }
}


__device__ __forceinline__ void phase2c_m(const P& p, int bid, int nb, LAS unsigned char* lds) {
    const bf16_t* uvg = p.slotC; bf16_t* su = p.slotG;
    const int tid = opaque_tid(), lane = tid & 63, wid = tid >> 6, fr = lane & 15, fq = lane >> 4;
    const int c8 = ((tid & 7) ^ ((tid >> 3) & 7)) * 8;
    for (int u = bid; u < 1024; u += nb) {
        const int g = u & 7, t0 = (u >> 3) * 128;
        { const bf16_t* wp = p.Wsp + ((size_t)g * 128 + (tid >> 3)) * 128 + c8; LAS unsigned char* d = lds + tid * 16;
#pragma unroll
          for (int ks = 0; ks < 2; ++ks)
#pragma unroll
              for (int i = 0; i < 4; ++i) __builtin_amdgcn_global_load_lds((const unsigned*)(wp + (size_t)i * 32 * 128 + ks * 64), (LAS unsigned*)(d + ks * 16384 + i * 4096), 16, 0, 0); }
#pragma unroll
        for (int i = 0; i < 4; ++i) { const int q = tid + 256 * i, j = q >> 3, c0 = (q & 7) * 8;
            const uint4 v = *(const uint4*)(uvg + (size_t)(t0 + j) * 1024 + 512 + g * 64 + c0);
            const unsigned w[4] = {v.x, v.y, v.z, v.w};
            LAS unsigned char* bimg = lds + 32768 + (j >> 6) * 8192 + (j & 7) * 2; const int lc = (j & 63) >> 3;
#pragma unroll
            for (int e = 0; e < 8; ++e) { const int row = c0 + e; const bf16_t val = (bf16_t)((e & 1) ? (w[e >> 1] >> 16) : (w[e >> 1] & 0xffffu));
                *(LAS bf16_t*)(bimg + row * 128 + ((lc ^ (row & 7)) * 16)) = val; } }
        asm volatile("s_waitcnt vmcnt(0)" ::: "memory");
        __syncthreads();
        f32x4 acc[2][4];
#pragma unroll
        for (int m = 0; m < 2; ++m)
#pragma unroll
            for (int n = 0; n < 4; ++n) acc[m][n] = (f32x4){0.f, 0.f, 0.f, 0.f};
#pragma unroll
        for (int ks = 0; ks < 2; ++ks)
#pragma unroll
            for (int k2 = 0; k2 < 2; ++k2) { const int pc = ((k2 * 4 + fq) ^ (fr & 7)) * 16; bf16x8 af[2], bfr[4];
#pragma unroll
                for (int m = 0; m < 2; ++m) af[m] = *(const LAS bf16x8*)(lds + ks * 16384 + (wid * 32 + m * 16 + fr) * 128 + pc);
#pragma unroll
                for (int n = 0; n < 4; ++n) bfr[n] = *(const LAS bf16x8*)(lds + 32768 + ks * 8192 + (n * 16 + fr) * 128 + pc);
#pragma unroll
                for (int m = 0; m < 2; ++m)
#pragma unroll
                    for (int n = 0; n < 4; ++n) acc[m][n] = __builtin_amdgcn_mfma_f32_16x16x32_bf16(bfr[n], af[m], acc[m][n], 0, 0, 0); }
#pragma unroll
        for (int m = 0; m < 2; ++m) { const int i = wid * 32 + m * 16 + fr; const float bs = p.b_sp[g * 128 + i];
#pragma unroll
            for (int n = 0; n < 4; ++n) { const int c = g * 64 + n * 16 + fq * 4;
                const uint2 uu = *(const uint2*)(uvg + (size_t)(t0 + i) * 1024 + c);
                uint2 o; o.x = pk2(__uint_as_float(uu.x << 16) * (acc[m][n][0] + bs), __uint_as_float(uu.x & 0xffff0000u) * (acc[m][n][1] + bs));
                o.y = pk2(__uint_as_float(uu.y << 16) * (acc[m][n][2] + bs), __uint_as_float(uu.y & 0xffff0000u) * (acc[m][n][3] + bs));
                *(uint2*)(su + (size_t)(t0 + i) * 512 + c) = o; } }
        __syncthreads();
    }
}

__device__ __forceinline__ void phase3(const P& p, int bid, int nb, float* sm) {
    float* sc = sm; float* qs = sm + 8192; float* red = qs + 96;
    const bf16_t* Q = p.slotA; const bf16_t* K = p.slotE; const bf16_t* VT = p.slotF; bf16_t* O = (bf16_t*)p.slotB;
    const int tid = opaque_tid();
    for (int row = bid; row < NBATCH * NH * SEQ; row += nb) {
        const int q = row % SEQ, bh = row / SEQ, nk = ((q >> 6) + 1) * 64;
        if (tid < 12) ((uint4*)qs)[tid] = ((const uint4*)(Q + ((size_t)bh * SEQ + q) * 96))[tid];
        __syncthreads();
        float mx = -1e30f;
        for (int k = tid; k < nk; k += 256) { const uint4* kp = (const uint4*)(K + ((size_t)bh * SEQ + k) * 96); float s = 0.f;
#pragma unroll
            for (int d = 0; d < 12; ++d) s += dot8(((const uint4*)qs)[d], kp[d]);
            sc[k] = s; mx = fmaxf(mx, s); }
        mx = wmax(mx); if ((tid & 63) == 0) red[tid >> 6] = mx; __syncthreads();
        mx = fmaxf(fmaxf(red[0], red[1]), fmaxf(red[2], red[3])); __syncthreads();
        float sum = 0.f;
        for (int k = tid; k < nk; k += 256) { const float e = exp2f(sc[k] - mx); sc[k] = e; sum += e; }
        sum = wsum(sum); if ((tid & 63) == 0) red[tid >> 6] = sum; __syncthreads();
        sum = (red[0] + red[1]) + (red[2] + red[3]);
        const int dv = tid >> 2, part = tid & 3, h = bh & 7, b = bh >> 3;
        const bf16_t* vp = VT + (size_t)(h * 64 + dv) * NT + (size_t)b * SEQ; float o = 0.f;
        for (int k = part; k < nk; k += 4) o += sc[k] * bf2f(vp[k]);
        o += __shfl_xor(o, 1); o += __shfl_xor(o, 2);
        if (part == 0) O[(size_t)(b * SEQ + q) * 512 + h * 64 + dv] = f2bf(o / sum);
        __syncthreads();
    }
}


constexpr int ATT_BUF = 20480;
template <int VAR>
__device__ __forceinline__ void phase3m(const P& p, int bid, int nb, LAS unsigned char* lds) {
    const bf16_t* Q = p.slotA; const bf16_t* K = p.slotE; const bf16_t* VT = p.slotF; bf16_t* O = (VAR == 0) ? (bf16_t*)p.slotB : p.slotC;
    const int tid = opaque_tid(), lane = tid & 63, wid = tid >> 6, l31 = lane & 31, hh = lane >> 5;
    int koff[3]; size_t voff[2];
#pragma unroll
    for (int i = 0; i < 3; ++i) { const int s = tid + 256 * i, r = s / 12, pc = s % 12, c = (pc + 12 - ((r >> 2) & 3)) % 12; koff[i] = r * 96 + c * 8; }
#pragma unroll
    for (int i = 0; i < 2; ++i) { const int s = tid + 256 * i, dv = s >> 3, pc = s & 7, cl = pc ^ ((dv >> 1) & 7); voff[i] = (size_t)dv * NT + cl * 8; }
    int kro[6];
#pragma unroll
    for (int ks = 0; ks < 6; ++ks) { const int v = 2 * ks + hh + ((lane >> 2) & 3); kro[ks] = (v >= 12 ? v - 12 : v) * 16; }
    const int krow = l31 * 192, vsw = (lane >> 1) & 7, vrow = l31 * 128 + 8 * hh;
    for (int iu = 0;; ++iu) {
        const int r = iu * nb + ((iu & 1) ? nb - 1 - bid : bid); if (r >= 1024) break;
        const int qb = 63 - (r >> 4), bh = r & 15, b = bh >> 3, h = bh & 7;
        const int q0 = qb * 128 + wid * 32, ntw = (q0 >> 6) + 1, nt = 2 * qb + 2;
        const bf16_t* Kb = K + (size_t)bh * SEQ * 96; const bf16_t* Vb = VT + (size_t)(h * 64) * NT + (size_t)b * SEQ;
        bf16x8 qf[6]; { const bf16_t* qp = Q + ((size_t)bh * SEQ + q0 + l31) * 96 + hh * 8;
#pragma unroll
            for (int ks = 0; ks < 6; ++ks) qf[ks] = *(const bf16x8*)(qp + ks * 16); }
        f32x16 o0, o1;
#pragma unroll
        for (int e = 0; e < 16; ++e) { o0[e] = 0.f; o1[e] = 0.f; }
        float mrun = -1e30f, lsum = 0.f;
        auto stage = [&](int j) { LAS unsigned char* d = lds + (j & 1) * ATT_BUF + tid * 16; const bf16_t* kt = Kb + (size_t)j * 64 * 96; const bf16_t* vt = Vb + j * 64;
#pragma unroll
            for (int i = 0; i < 3; ++i) __builtin_amdgcn_global_load_lds((const unsigned*)(kt + koff[i]), (LAS unsigned*)(d + i * 4096), 16, 0, 0);
#pragma unroll
            for (int i = 0; i < 2; ++i) __builtin_amdgcn_global_load_lds((const unsigned*)(vt + voff[i]), (LAS unsigned*)(d + 12288 + i * 4096), 16, 0, 0); };
        if (VAR != 3) stage(0);
        for (int j = 0; j < nt; ++j) {
            asm volatile("s_waitcnt vmcnt(0)" ::: "memory");
            __syncthreads();
            if (VAR != 3 && j + 1 < nt) stage(j + 1);
            if (j < ntw) {
                const LAS unsigned char* kb_ = lds + (j & 1) * ATT_BUF + krow; const LAS unsigned char* vb_ = lds + (j & 1) * ATT_BUF + 12288 + vrow;
                f32x16 s0, s1;
#pragma unroll
                for (int e = 0; e < 16; ++e) { s0[e] = 0.f; s1[e] = 0.f; }
#pragma unroll
                for (int ks = 0; ks < 6; ++ks) { const bf16x8 k0 = *(const LAS bf16x8*)(kb_ + kro[ks]); const bf16x8 k1 = *(const LAS bf16x8*)(kb_ + 32 * 192 + kro[ks]);
                    if (VAR != 2) { s0 = __builtin_amdgcn_mfma_f32_32x32x16_bf16(k0, qf[ks], s0, 0, 0, 0); s1 = __builtin_amdgcn_mfma_f32_32x32x16_bf16(k1, qf[ks], s1, 0, 0, 0); }
                    else { s0[ks] += __builtin_bit_cast(float, (int)k0[0]) + __builtin_bit_cast(float, (int)qf[ks][1]); s1[ks] += __builtin_bit_cast(float, (int)k1[0]); } }
                if (VAR != 1) {
                float mx = fmaxf(s0[0], s1[0]);
#pragma unroll
                for (int e = 1; e < 16; ++e) mx = fmaxf(mx, fmaxf(s0[e], s1[e]));
                mx = fmaxf(mx, __shfl_xor(mx, 32));
                const float mn = fmaxf(mrun, mx), alpha = __builtin_amdgcn_exp2f(mrun - mn); mrun = mn;
                float ps = 0.f;
#pragma unroll
                for (int e = 0; e < 16; ++e) { s0[e] = __builtin_amdgcn_exp2f(s0[e] - mn); s1[e] = __builtin_amdgcn_exp2f(s1[e] - mn); ps += s0[e] + s1[e]; }
                lsum = lsum * alpha + ps;
#pragma unroll
                for (int e = 0; e < 16; ++e) { o0[e] *= alpha; o1[e] *= alpha; }
                }
                unsigned pw[16];
#pragma unroll
                for (int e = 0; e < 8; ++e) { pw[e] = pk2(s0[2 * e], s0[2 * e + 1]); pw[8 + e] = pk2(s1[2 * e], s1[2 * e + 1]); }
#pragma unroll
                for (int s = 0; s < 4; ++s) {
                    const u32x4 pbu = {pw[4 * s], pw[4 * s + 1], pw[4 * s + 2], pw[4 * s + 3]}; const bf16x8 pb = __builtin_bit_cast(bf16x8, pbu);
                    const int c0 = ((2 * s) ^ vsw) * 16, c1 = ((2 * s + 1) ^ vsw) * 16;
                    const u32x2 a0 = *(const LAS u32x2*)(vb_ + c0), a1 = *(const LAS u32x2*)(vb_ + c1);
                    const u32x2 b0 = *(const LAS u32x2*)(vb_ + 32 * 128 + c0), b1 = *(const LAS u32x2*)(vb_ + 32 * 128 + c1);
                    const u32x4 va = {a0.x, a0.y, a1.x, a1.y}, vb = {b0.x, b0.y, b1.x, b1.y};
                    if (VAR != 2) { o0 = __builtin_amdgcn_mfma_f32_32x32x16_bf16(__builtin_bit_cast(bf16x8, va), pb, o0, 0, 0, 0);
                    o1 = __builtin_amdgcn_mfma_f32_32x32x16_bf16(__builtin_bit_cast(bf16x8, vb), pb, o1, 0, 0, 0); }
                    else { o0[s] += __builtin_bit_cast(float, va[0] ^ pbu[0]); o1[s] += __builtin_bit_cast(float, vb[1] ^ pbu[1]); }
                }
            }
        }
        const float inv = 1.f / (lsum + __shfl_xor(lsum, 32));
        bf16_t* op = O + (size_t)(b * SEQ + q0 + l31) * 512 + h * 64 + 4 * hh;
#pragma unroll
        for (int g = 0; g < 4; ++g) { uint2 w0, w1;
            w0.x = pk2(o0[4 * g] * inv, o0[4 * g + 1] * inv); w0.y = pk2(o0[4 * g + 2] * inv, o0[4 * g + 3] * inv);
            w1.x = pk2(o1[4 * g] * inv, o1[4 * g + 1] * inv); w1.y = pk2(o1[4 * g + 2] * inv, o1[4 * g + 3] * inv);
            *(uint2*)(op + 8 * g) = w0; *(uint2*)(op + 32 + 8 * g) = w1; }
        __syncthreads();
    }
}


template <int DUMMY>
__device__ __forceinline__ void phase3p(const P& p, int bid, int nb, LAS unsigned char* lds) {
    const bf16_t* Q = p.slotA; const bf16_t* K = p.slotE; const bf16_t* VT = p.slotF; bf16_t* O = (DUMMY == 0) ? (bf16_t*)p.slotB : p.slotC;
    const int tid = opaque_tid(), lane = tid & 63, wid = tid >> 6, l31 = lane & 31, hh = lane >> 5;
    constexpr float THR = 8.f;
    int koff[3]; size_t voff[2];
#pragma unroll
    for (int i = 0; i < 3; ++i) { const int s = tid + 256 * i, r = s / 12, pc = s % 12, c = (pc + 12 - ((r >> 2) & 3)) % 12; koff[i] = r * 96 + c * 8; }
#pragma unroll
    for (int i = 0; i < 2; ++i) { const int s = tid + 256 * i, dv = s >> 3, pc = s & 7, cl = pc ^ ((dv >> 1) & 7); voff[i] = (size_t)dv * NT + cl * 8; }
    int kro[6];
#pragma unroll
    for (int ks = 0; ks < 6; ++ks) { const int v = 2 * ks + hh + ((lane >> 2) & 3); kro[ks] = (v >= 12 ? v - 12 : v) * 16; }
    const int krow = l31 * 192, vsw = (lane >> 1) & 7, vrow = l31 * 128 + 8 * hh;
    for (int iu = 0;; ++iu) {
        const int r = iu * nb + ((iu & 1) ? nb - 1 - bid : bid); if (r >= 1024) break;
        const int qb = 63 - (r >> 4), bh = r & 15, b = bh >> 3, h = bh & 7;
        const int q0 = qb * 128 + wid * 32, ntw = (q0 >> 6) + 1, nt = 2 * qb + 2;
        const bf16_t* Kb = K + (size_t)bh * SEQ * 96; const bf16_t* Vb = VT + (size_t)(h * 64) * NT + (size_t)b * SEQ;
        bf16x8 qf[6]; { const bf16_t* qp = Q + ((size_t)bh * SEQ + q0 + l31) * 96 + hh * 8;
#pragma unroll
            for (int ks = 0; ks < 6; ++ks) qf[ks] = *(const bf16x8*)(qp + ks * 16); }
        f32x16 o0, o1;
#pragma unroll
        for (int e = 0; e < 16; ++e) { o0[e] = 0.f; o1[e] = 0.f; }
        float mrun = -1e30f, lsum = 0.f;
        auto stageK = [&](int j) { LAS unsigned char* d = lds + (j & 1) * 12288 + tid * 16; const bf16_t* kt = Kb + (size_t)j * 64 * 96;
#pragma unroll
            for (int i = 0; i < 3; ++i) __builtin_amdgcn_global_load_lds((const unsigned*)(kt + koff[i]), (LAS unsigned*)(d + i * 4096), 16, 0, 0); };
        auto stageV = [&](int j) { LAS unsigned char* d = lds + 24576 + (j & 1) * 8192 + tid * 16; const bf16_t* vt = Vb + j * 64;
#pragma unroll
            for (int i = 0; i < 2; ++i) __builtin_amdgcn_global_load_lds((const unsigned*)(vt + voff[i]), (LAS unsigned*)(d + i * 4096), 16, 0, 0); };
        auto qk = [&](f32x16& a, f32x16& bq, int buf) { const LAS unsigned char* kb_ = lds + buf * 12288 + krow;
#pragma unroll
            for (int e = 0; e < 16; ++e) { a[e] = 0.f; bq[e] = 0.f; }
#pragma unroll
            for (int ks = 0; ks < 6; ++ks) { const bf16x8 k0 = *(const LAS bf16x8*)(kb_ + kro[ks]); const bf16x8 k1 = *(const LAS bf16x8*)(kb_ + 32 * 192 + kro[ks]);
                a = __builtin_amdgcn_mfma_f32_32x32x16_bf16(k0, qf[ks], a, 0, 0, 0); bq = __builtin_amdgcn_mfma_f32_32x32x16_bf16(k1, qf[ks], bq, 0, 0, 0); } };
        auto rowmax = [&](const f32x16& a, const f32x16& bq) { float m = fmaxf(a[0], bq[0]);
#pragma unroll
            for (int e = 1; e < 16; ++e) m = fmaxf(fmaxf(m, a[e]), bq[e]);
            return fmaxf(m, __shfl_xor(m, 32)); };
        f32x16 sA0, sA1, sB0, sB1; float mxA, mxB = 0.f;
        stageK(0); stageK(1); stageV(0);
        asm volatile("s_waitcnt vmcnt(0)" ::: "memory");
        __syncthreads();
        qk(sA0, sA1, 0); mxA = rowmax(sA0, sA1);
        auto step = [&](f32x16& c0, f32x16& c1, float& mxc, f32x16& n0, f32x16& n1, float& mxn, int j) {
            asm volatile("s_waitcnt vmcnt(0)" ::: "memory");
            __syncthreads();
            if (j + 2 < nt) stageK(j + 2);
            if (j + 1 < nt) stageV(j + 1);
            if (j < ntw) {
                if (!__all(mxc <= mrun + THR)) { const float mn = fmaxf(mrun, mxc), alpha = __builtin_amdgcn_exp2f(mrun - mn); mrun = mn; lsum *= alpha;
#pragma unroll
                    for (int e = 0; e < 16; ++e) { o0[e] *= alpha; o1[e] *= alpha; } }
                qk(n0, n1, (j + 1) & 1);
                float ps = 0.f;
#pragma unroll
                for (int e = 0; e < 16; ++e) { c0[e] = __builtin_amdgcn_exp2f(c0[e] - mrun); c1[e] = __builtin_amdgcn_exp2f(c1[e] - mrun); ps += c0[e] + c1[e]; }
                lsum += ps;
                unsigned pw[16];
#pragma unroll
                for (int e = 0; e < 8; ++e) { pw[e] = pk2(c0[2 * e], c0[2 * e + 1]); pw[8 + e] = pk2(c1[2 * e], c1[2 * e + 1]); }
                const LAS unsigned char* vb_ = lds + 24576 + (j & 1) * 8192 + vrow;
#pragma unroll
                for (int s = 0; s < 4; ++s) {
                    const u32x4 pbu = {pw[4 * s], pw[4 * s + 1], pw[4 * s + 2], pw[4 * s + 3]}; const bf16x8 pb = __builtin_bit_cast(bf16x8, pbu);
                    const int c0_ = ((2 * s) ^ vsw) * 16, c1_ = ((2 * s + 1) ^ vsw) * 16;
                    const u32x2 a0 = *(const LAS u32x2*)(vb_ + c0_), a1 = *(const LAS u32x2*)(vb_ + c1_);
                    const u32x2 b0 = *(const LAS u32x2*)(vb_ + 32 * 128 + c0_), b1 = *(const LAS u32x2*)(vb_ + 32 * 128 + c1_);
                    const u32x4 va = {a0.x, a0.y, a1.x, a1.y}, vb = {b0.x, b0.y, b1.x, b1.y};
                    o0 = __builtin_amdgcn_mfma_f32_32x32x16_bf16(__builtin_bit_cast(bf16x8, va), pb, o0, 0, 0, 0);
                    o1 = __builtin_amdgcn_mfma_f32_32x32x16_bf16(__builtin_bit_cast(bf16x8, vb), pb, o1, 0, 0, 0);
                }
                mxn = rowmax(n0, n1);
#if ATT_SGB
#pragma unroll
                for (int g_ = 0; g_ < 20; ++g_) { __builtin_amdgcn_sched_group_barrier(0x008, 1, 0); __builtin_amdgcn_sched_group_barrier(0x100, 2, 0); __builtin_amdgcn_sched_group_barrier(0x002, 7, 0); }
#endif
            }
        };
        for (int j = 0; j < nt; j += 2) { step(sA0, sA1, mxA, sB0, sB1, mxB, j); step(sB0, sB1, mxB, sA0, sA1, mxA, j + 1); }
        const float inv = 1.f / (lsum + __shfl_xor(lsum, 32));
        bf16_t* op = O + (size_t)(b * SEQ + q0 + l31) * 512 + h * 64 + 4 * hh;
#pragma unroll
        for (int g = 0; g < 4; ++g) { uint2 w0, w1;
            w0.x = pk2(o0[4 * g] * inv, o0[4 * g + 1] * inv); w0.y = pk2(o0[4 * g + 2] * inv, o0[4 * g + 3] * inv);
            w1.x = pk2(o1[4 * g] * inv, o1[4 * g + 1] * inv); w1.y = pk2(o1[4 * g + 2] * inv, o1[4 * g + 3] * inv);
            *(uint2*)(op + 8 * g) = w0; *(uint2*)(op + 32 + 8 * g) = w1; }
        __syncthreads();
    }
}

template <int VAR>
__device__ __forceinline__ void att_step(const LAS unsigned char* kb_, const LAS unsigned char* vb_, const int kt16, const int k4o, const int k5o, const int vsw, const bf16x8 (&qf)[6],
                                         f32x16& c0, f32x16& c1, f32x16& n0, f32x16& n1, const unsigned (&pwc)[16], unsigned (&pwn)[16], f32x16& o0, f32x16& o1,
                                         const float mrun, float& ps, float& mxn) {
    f32x16 zero16;
#pragma unroll
    for (int e = 0; e < 16; ++e) zero16[e] = 0.f;
    if constexpr (VAR == 0) {
        bf16x8 kf0, kf1, kf2;
        kf0 = *(const LAS bf16x8*)(kb_ + 0*32*192 + kt16 + 0); kf1 = *(const LAS bf16x8*)(kb_ + 1*32*192 + kt16 + 0);
        float mxl;
        kf2 = *(const LAS bf16x8*)(kb_ + 0*32*192 + kt16 + 32);
        n0 = __builtin_amdgcn_mfma_f32_32x32x16_bf16(kf0, qf[0], zero16, 0, 0, 0);
        c0[0] = __builtin_amdgcn_exp2f(c0[0] - mrun); ps += c0[0]; c0[1] = __builtin_amdgcn_exp2f(c0[1] - mrun); ps += c0[1]; pwn[0] = pk2(c0[0], c0[1]);
        __builtin_amdgcn_sched_barrier(0);
        kf0 = *(const LAS bf16x8*)(kb_ + 1*32*192 + kt16 + 32);
        n1 = __builtin_amdgcn_mfma_f32_32x32x16_bf16(kf1, qf[0], zero16, 0, 0, 0);
        c0[2] = __builtin_amdgcn_exp2f(c0[2] - mrun); ps += c0[2]; c0[3] = __builtin_amdgcn_exp2f(c0[3] - mrun); ps += c0[3]; pwn[1] = pk2(c0[2], c0[3]);
        __builtin_amdgcn_sched_barrier(0);
        kf1 = *(const LAS bf16x8*)(kb_ + 0*32*192 + kt16 + 64);
        n0 = __builtin_amdgcn_mfma_f32_32x32x16_bf16(kf2, qf[1], n0, 0, 0, 0);
        c0[4] = __builtin_amdgcn_exp2f(c0[4] - mrun); ps += c0[4]; c0[5] = __builtin_amdgcn_exp2f(c0[5] - mrun); ps += c0[5]; pwn[2] = pk2(c0[4], c0[5]);
        __builtin_amdgcn_sched_barrier(0);
        kf2 = *(const LAS bf16x8*)(kb_ + 1*32*192 + kt16 + 64);
        n1 = __builtin_amdgcn_mfma_f32_32x32x16_bf16(kf0, qf[1], n1, 0, 0, 0);
        c0[6] = __builtin_amdgcn_exp2f(c0[6] - mrun); ps += c0[6]; c0[7] = __builtin_amdgcn_exp2f(c0[7] - mrun); ps += c0[7]; pwn[3] = pk2(c0[6], c0[7]);
        __builtin_amdgcn_sched_barrier(0);
        kf0 = *(const LAS bf16x8*)(kb_ + 0*32*192 + kt16 + 96);
        n0 = __builtin_amdgcn_mfma_f32_32x32x16_bf16(kf1, qf[2], n0, 0, 0, 0);
        c0[8] = __builtin_amdgcn_exp2f(c0[8] - mrun); ps += c0[8]; c0[9] = __builtin_amdgcn_exp2f(c0[9] - mrun); ps += c0[9]; pwn[4] = pk2(c0[8], c0[9]);
        __builtin_amdgcn_sched_barrier(0);
        kf1 = *(const LAS bf16x8*)(kb_ + 1*32*192 + kt16 + 96);
        n1 = __builtin_amdgcn_mfma_f32_32x32x16_bf16(kf2, qf[2], n1, 0, 0, 0);
        c0[10] = __builtin_amdgcn_exp2f(c0[10] - mrun); ps += c0[10]; c0[11] = __builtin_amdgcn_exp2f(c0[11] - mrun); ps += c0[11]; pwn[5] = pk2(c0[10], c0[11]);
        __builtin_amdgcn_sched_barrier(0);
        kf2 = *(const LAS bf16x8*)(kb_ + 0*32*192 + k4o);
        n0 = __builtin_amdgcn_mfma_f32_32x32x16_bf16(kf0, qf[3], n0, 0, 0, 0);
        c0[12] = __builtin_amdgcn_exp2f(c0[12] - mrun); ps += c0[12]; c0[13] = __builtin_amdgcn_exp2f(c0[13] - mrun); ps += c0[13]; pwn[6] = pk2(c0[12], c0[13]);
        __builtin_amdgcn_sched_barrier(0);
        kf0 = *(const LAS bf16x8*)(kb_ + 1*32*192 + k4o);
        n1 = __builtin_amdgcn_mfma_f32_32x32x16_bf16(kf1, qf[3], n1, 0, 0, 0);
        c0[14] = __builtin_amdgcn_exp2f(c0[14] - mrun); ps += c0[14]; c0[15] = __builtin_amdgcn_exp2f(c0[15] - mrun); ps += c0[15]; pwn[7] = pk2(c0[14], c0[15]);
        __builtin_amdgcn_sched_barrier(0);
        kf1 = *(const LAS bf16x8*)(kb_ + 0*32*192 + k5o);
        n0 = __builtin_amdgcn_mfma_f32_32x32x16_bf16(kf2, qf[4], n0, 0, 0, 0);
        c1[0] = __builtin_amdgcn_exp2f(c1[0] - mrun); ps += c1[0]; c1[1] = __builtin_amdgcn_exp2f(c1[1] - mrun); ps += c1[1]; pwn[8] = pk2(c1[0], c1[1]);
        __builtin_amdgcn_sched_barrier(0);
        kf2 = *(const LAS bf16x8*)(kb_ + 1*32*192 + k5o);
        n1 = __builtin_amdgcn_mfma_f32_32x32x16_bf16(kf0, qf[4], n1, 0, 0, 0);
        c1[2] = __builtin_amdgcn_exp2f(c1[2] - mrun); ps += c1[2]; c1[3] = __builtin_amdgcn_exp2f(c1[3] - mrun); ps += c1[3]; pwn[9] = pk2(c1[2], c1[3]);
        __builtin_amdgcn_sched_barrier(0);
        n0 = __builtin_amdgcn_mfma_f32_32x32x16_bf16(kf1, qf[5], n0, 0, 0, 0);
        c1[4] = __builtin_amdgcn_exp2f(c1[4] - mrun); ps += c1[4]; c1[5] = __builtin_amdgcn_exp2f(c1[5] - mrun); ps += c1[5]; pwn[10] = pk2(c1[4], c1[5]);
        __builtin_amdgcn_sched_barrier(0);
        n1 = __builtin_amdgcn_mfma_f32_32x32x16_bf16(kf2, qf[5], n1, 0, 0, 0);
        c1[6] = __builtin_amdgcn_exp2f(c1[6] - mrun); ps += c1[6]; c1[7] = __builtin_amdgcn_exp2f(c1[7] - mrun); ps += c1[7]; pwn[11] = pk2(c1[6], c1[7]);
        __builtin_amdgcn_sched_barrier(0);
        c1[8] = __builtin_amdgcn_exp2f(c1[8] - mrun); ps += c1[8]; c1[9] = __builtin_amdgcn_exp2f(c1[9] - mrun); ps += c1[9]; pwn[12] = pk2(c1[8], c1[9]);
        __builtin_amdgcn_sched_barrier(0);
        c1[10] = __builtin_amdgcn_exp2f(c1[10] - mrun); ps += c1[10]; c1[11] = __builtin_amdgcn_exp2f(c1[11] - mrun); ps += c1[11]; pwn[13] = pk2(c1[10], c1[11]);
        __builtin_amdgcn_sched_barrier(0);
        c1[12] = __builtin_amdgcn_exp2f(c1[12] - mrun); ps += c1[12]; c1[13] = __builtin_amdgcn_exp2f(c1[13] - mrun); ps += c1[13]; pwn[14] = pk2(c1[12], c1[13]);
        __builtin_amdgcn_sched_barrier(0);
        c1[14] = __builtin_amdgcn_exp2f(c1[14] - mrun); ps += c1[14]; c1[15] = __builtin_amdgcn_exp2f(c1[15] - mrun); ps += c1[15]; pwn[15] = pk2(c1[14], c1[15]);
        __builtin_amdgcn_sched_barrier(0);
        mxl = fmaxf(n0[0], n1[0]); mxl = fmaxf(fmaxf(mxl, n0[1]), n1[1]); mxl = fmaxf(fmaxf(mxl, n0[2]), n1[2]); mxl = fmaxf(fmaxf(mxl, n0[3]), n1[3]);
        __builtin_amdgcn_sched_barrier(0);
        mxl = fmaxf(fmaxf(mxl, n0[4]), n1[4]); mxl = fmaxf(fmaxf(mxl, n0[5]), n1[5]); mxl = fmaxf(fmaxf(mxl, n0[6]), n1[6]); mxl = fmaxf(fmaxf(mxl, n0[7]), n1[7]);
        __builtin_amdgcn_sched_barrier(0);
        mxl = fmaxf(fmaxf(mxl, n0[8]), n1[8]); mxl = fmaxf(fmaxf(mxl, n0[9]), n1[9]); mxl = fmaxf(fmaxf(mxl, n0[10]), n1[10]); mxl = fmaxf(fmaxf(mxl, n0[11]), n1[11]);
        __builtin_amdgcn_sched_barrier(0);
        mxl = fmaxf(fmaxf(mxl, n0[12]), n1[12]); mxl = fmaxf(fmaxf(mxl, n0[13]), n1[13]); mxl = fmaxf(fmaxf(mxl, n0[14]), n1[14]); mxl = fmaxf(fmaxf(mxl, n0[15]), n1[15]);
        __builtin_amdgcn_sched_barrier(0);
        mxn = fmaxf(mxl, __shfl_xor(mxl, 32));
    } else if constexpr (VAR == 1) {
        bf16x8 kf0, kf1, kf2;
        kf0 = *(const LAS bf16x8*)(kb_ + 0*32*192 + kt16 + 0); kf1 = *(const LAS bf16x8*)(kb_ + 1*32*192 + kt16 + 0);
        u32x2 vf0a, vf0b, vf1a, vf1b, vf2a, vf2b;
        float mxl;
        kf2 = *(const LAS bf16x8*)(kb_ + 0*32*192 + kt16 + 32);
        n0 = __builtin_amdgcn_mfma_f32_32x32x16_bf16(kf0, qf[0], zero16, 0, 0, 0);
        c0[0] = __builtin_amdgcn_exp2f(c0[0] - mrun); ps += c0[0]; c0[1] = __builtin_amdgcn_exp2f(c0[1] - mrun); ps += c0[1]; pwn[0] = pk2(c0[0], c0[1]);
        __builtin_amdgcn_sched_barrier(0);
        kf0 = *(const LAS bf16x8*)(kb_ + 1*32*192 + kt16 + 32);
        n1 = __builtin_amdgcn_mfma_f32_32x32x16_bf16(kf1, qf[0], zero16, 0, 0, 0);
        c0[2] = __builtin_amdgcn_exp2f(c0[2] - mrun); ps += c0[2]; c0[3] = __builtin_amdgcn_exp2f(c0[3] - mrun); ps += c0[3]; pwn[1] = pk2(c0[2], c0[3]);
        __builtin_amdgcn_sched_barrier(0);
        kf1 = *(const LAS bf16x8*)(kb_ + 0*32*192 + kt16 + 64);
        n0 = __builtin_amdgcn_mfma_f32_32x32x16_bf16(kf2, qf[1], n0, 0, 0, 0);
        c0[4] = __builtin_amdgcn_exp2f(c0[4] - mrun); ps += c0[4]; c0[5] = __builtin_amdgcn_exp2f(c0[5] - mrun); ps += c0[5]; pwn[2] = pk2(c0[4], c0[5]);
        __builtin_amdgcn_sched_barrier(0);
        kf2 = *(const LAS bf16x8*)(kb_ + 1*32*192 + kt16 + 64);
        n1 = __builtin_amdgcn_mfma_f32_32x32x16_bf16(kf0, qf[1], n1, 0, 0, 0);
        c0[6] = __builtin_amdgcn_exp2f(c0[6] - mrun); ps += c0[6]; c0[7] = __builtin_amdgcn_exp2f(c0[7] - mrun); ps += c0[7]; pwn[3] = pk2(c0[6], c0[7]);
        __builtin_amdgcn_sched_barrier(0);
        kf0 = *(const LAS bf16x8*)(kb_ + 0*32*192 + kt16 + 96);
        n0 = __builtin_amdgcn_mfma_f32_32x32x16_bf16(kf1, qf[2], n0, 0, 0, 0);
        c0[8] = __builtin_amdgcn_exp2f(c0[8] - mrun); ps += c0[8]; c0[9] = __builtin_amdgcn_exp2f(c0[9] - mrun); ps += c0[9]; pwn[4] = pk2(c0[8], c0[9]);
        __builtin_amdgcn_sched_barrier(0);
        kf1 = *(const LAS bf16x8*)(kb_ + 1*32*192 + kt16 + 96);
        n1 = __builtin_amdgcn_mfma_f32_32x32x16_bf16(kf2, qf[2], n1, 0, 0, 0);
        c0[10] = __builtin_amdgcn_exp2f(c0[10] - mrun); ps += c0[10]; c0[11] = __builtin_amdgcn_exp2f(c0[11] - mrun); ps += c0[11]; pwn[5] = pk2(c0[10], c0[11]);
        __builtin_amdgcn_sched_barrier(0);
        kf2 = *(const LAS bf16x8*)(kb_ + 0*32*192 + k4o);
        n0 = __builtin_amdgcn_mfma_f32_32x32x16_bf16(kf0, qf[3], n0, 0, 0, 0);
        c0[12] = __builtin_amdgcn_exp2f(c0[12] - mrun); ps += c0[12]; c0[13] = __builtin_amdgcn_exp2f(c0[13] - mrun); ps += c0[13]; pwn[6] = pk2(c0[12], c0[13]);
        __builtin_amdgcn_sched_barrier(0);
        kf0 = *(const LAS bf16x8*)(kb_ + 1*32*192 + k4o);
        n1 = __builtin_amdgcn_mfma_f32_32x32x16_bf16(kf1, qf[3], n1, 0, 0, 0);
        c0[14] = __builtin_amdgcn_exp2f(c0[14] - mrun); ps += c0[14]; c0[15] = __builtin_amdgcn_exp2f(c0[15] - mrun); ps += c0[15]; pwn[7] = pk2(c0[14], c0[15]);
        __builtin_amdgcn_sched_barrier(0);
        kf1 = *(const LAS bf16x8*)(kb_ + 0*32*192 + k5o);
        n0 = __builtin_amdgcn_mfma_f32_32x32x16_bf16(kf2, qf[4], n0, 0, 0, 0);
        c1[0] = __builtin_amdgcn_exp2f(c1[0] - mrun); ps += c1[0]; c1[1] = __builtin_amdgcn_exp2f(c1[1] - mrun); ps += c1[1]; pwn[8] = pk2(c1[0], c1[1]);
        __builtin_amdgcn_sched_barrier(0);
        kf2 = *(const LAS bf16x8*)(kb_ + 1*32*192 + k5o);
        n1 = __builtin_amdgcn_mfma_f32_32x32x16_bf16(kf0, qf[4], n1, 0, 0, 0);
        c1[2] = __builtin_amdgcn_exp2f(c1[2] - mrun); ps += c1[2]; c1[3] = __builtin_amdgcn_exp2f(c1[3] - mrun); ps += c1[3]; pwn[9] = pk2(c1[2], c1[3]);
        __builtin_amdgcn_sched_barrier(0);
        vf0a = *(const LAS u32x2*)(vb_ + ((0) ^ vsw) * 16); vf0b = *(const LAS u32x2*)(vb_ + ((1) ^ vsw) * 16);
        n0 = __builtin_amdgcn_mfma_f32_32x32x16_bf16(kf1, qf[5], n0, 0, 0, 0);
        c1[4] = __builtin_amdgcn_exp2f(c1[4] - mrun); ps += c1[4]; c1[5] = __builtin_amdgcn_exp2f(c1[5] - mrun); ps += c1[5]; pwn[10] = pk2(c1[4], c1[5]);
        __builtin_amdgcn_sched_barrier(0);
        vf1a = *(const LAS u32x2*)(vb_ + 32 * 128 + ((0) ^ vsw) * 16); vf1b = *(const LAS u32x2*)(vb_ + 32 * 128 + ((1) ^ vsw) * 16);
        n1 = __builtin_amdgcn_mfma_f32_32x32x16_bf16(kf2, qf[5], n1, 0, 0, 0);
        c1[6] = __builtin_amdgcn_exp2f(c1[6] - mrun); ps += c1[6]; c1[7] = __builtin_amdgcn_exp2f(c1[7] - mrun); ps += c1[7]; pwn[11] = pk2(c1[6], c1[7]);
        __builtin_amdgcn_sched_barrier(0);
        vf2a = *(const LAS u32x2*)(vb_ + ((2) ^ vsw) * 16); vf2b = *(const LAS u32x2*)(vb_ + ((3) ^ vsw) * 16);
        { const u32x4 pbu = {pwc[0], pwc[1], pwc[2], pwc[3]}; const u32x4 vv = {vf0a.x, vf0a.y, vf0b.x, vf0b.y};
          o0 = __builtin_amdgcn_mfma_f32_32x32x16_bf16(__builtin_bit_cast(bf16x8, vv), __builtin_bit_cast(bf16x8, pbu), o0, 0, 0, 0); }
        c1[8] = __builtin_amdgcn_exp2f(c1[8] - mrun); ps += c1[8]; c1[9] = __builtin_amdgcn_exp2f(c1[9] - mrun); ps += c1[9]; pwn[12] = pk2(c1[8], c1[9]);
        __builtin_amdgcn_sched_barrier(0);
        vf0a = *(const LAS u32x2*)(vb_ + 32 * 128 + ((2) ^ vsw) * 16); vf0b = *(const LAS u32x2*)(vb_ + 32 * 128 + ((3) ^ vsw) * 16);
        { const u32x4 pbu = {pwc[0], pwc[1], pwc[2], pwc[3]}; const u32x4 vv = {vf1a.x, vf1a.y, vf1b.x, vf1b.y};
          o1 = __builtin_amdgcn_mfma_f32_32x32x16_bf16(__builtin_bit_cast(bf16x8, vv), __builtin_bit_cast(bf16x8, pbu), o1, 0, 0, 0); }
        c1[10] = __builtin_amdgcn_exp2f(c1[10] - mrun); ps += c1[10]; c1[11] = __builtin_amdgcn_exp2f(c1[11] - mrun); ps += c1[11]; pwn[13] = pk2(c1[10], c1[11]);
        __builtin_amdgcn_sched_barrier(0);
        vf1a = *(const LAS u32x2*)(vb_ + ((4) ^ vsw) * 16); vf1b = *(const LAS u32x2*)(vb_ + ((5) ^ vsw) * 16);
        { const u32x4 pbu = {pwc[4], pwc[5], pwc[6], pwc[7]}; const u32x4 vv = {vf2a.x, vf2a.y, vf2b.x, vf2b.y};
          o0 = __builtin_amdgcn_mfma_f32_32x32x16_bf16(__builtin_bit_cast(bf16x8, vv), __builtin_bit_cast(bf16x8, pbu), o0, 0, 0, 0); }
        c1[12] = __builtin_amdgcn_exp2f(c1[12] - mrun); ps += c1[12]; c1[13] = __builtin_amdgcn_exp2f(c1[13] - mrun); ps += c1[13]; pwn[14] = pk2(c1[12], c1[13]);
        __builtin_amdgcn_sched_barrier(0);
        vf2a = *(const LAS u32x2*)(vb_ + 32 * 128 + ((4) ^ vsw) * 16); vf2b = *(const LAS u32x2*)(vb_ + 32 * 128 + ((5) ^ vsw) * 16);
        { const u32x4 pbu = {pwc[4], pwc[5], pwc[6], pwc[7]}; const u32x4 vv = {vf0a.x, vf0a.y, vf0b.x, vf0b.y};
          o1 = __builtin_amdgcn_mfma_f32_32x32x16_bf16(__builtin_bit_cast(bf16x8, vv), __builtin_bit_cast(bf16x8, pbu), o1, 0, 0, 0); }
        c1[14] = __builtin_amdgcn_exp2f(c1[14] - mrun); ps += c1[14]; c1[15] = __builtin_amdgcn_exp2f(c1[15] - mrun); ps += c1[15]; pwn[15] = pk2(c1[14], c1[15]);
        __builtin_amdgcn_sched_barrier(0);
        vf0a = *(const LAS u32x2*)(vb_ + ((6) ^ vsw) * 16); vf0b = *(const LAS u32x2*)(vb_ + ((7) ^ vsw) * 16);
        { const u32x4 pbu = {pwc[8], pwc[9], pwc[10], pwc[11]}; const u32x4 vv = {vf1a.x, vf1a.y, vf1b.x, vf1b.y};
          o0 = __builtin_amdgcn_mfma_f32_32x32x16_bf16(__builtin_bit_cast(bf16x8, vv), __builtin_bit_cast(bf16x8, pbu), o0, 0, 0, 0); }
        mxl = fmaxf(n0[0], n1[0]); mxl = fmaxf(fmaxf(mxl, n0[1]), n1[1]); mxl = fmaxf(fmaxf(mxl, n0[2]), n1[2]); mxl = fmaxf(fmaxf(mxl, n0[3]), n1[3]);
        __builtin_amdgcn_sched_barrier(0);
        vf1a = *(const LAS u32x2*)(vb_ + 32 * 128 + ((6) ^ vsw) * 16); vf1b = *(const LAS u32x2*)(vb_ + 32 * 128 + ((7) ^ vsw) * 16);
        { const u32x4 pbu = {pwc[8], pwc[9], pwc[10], pwc[11]}; const u32x4 vv = {vf2a.x, vf2a.y, vf2b.x, vf2b.y};
          o1 = __builtin_amdgcn_mfma_f32_32x32x16_bf16(__builtin_bit_cast(bf16x8, vv), __builtin_bit_cast(bf16x8, pbu), o1, 0, 0, 0); }
        mxl = fmaxf(fmaxf(mxl, n0[4]), n1[4]); mxl = fmaxf(fmaxf(mxl, n0[5]), n1[5]); mxl = fmaxf(fmaxf(mxl, n0[6]), n1[6]); mxl = fmaxf(fmaxf(mxl, n0[7]), n1[7]);
        __builtin_amdgcn_sched_barrier(0);
        { const u32x4 pbu = {pwc[12], pwc[13], pwc[14], pwc[15]}; const u32x4 vv = {vf0a.x, vf0a.y, vf0b.x, vf0b.y};
          o0 = __builtin_amdgcn_mfma_f32_32x32x16_bf16(__builtin_bit_cast(bf16x8, vv), __builtin_bit_cast(bf16x8, pbu), o0, 0, 0, 0); }
        mxl = fmaxf(fmaxf(mxl, n0[8]), n1[8]); mxl = fmaxf(fmaxf(mxl, n0[9]), n1[9]); mxl = fmaxf(fmaxf(mxl, n0[10]), n1[10]); mxl = fmaxf(fmaxf(mxl, n0[11]), n1[11]);
        __builtin_amdgcn_sched_barrier(0);
        { const u32x4 pbu = {pwc[12], pwc[13], pwc[14], pwc[15]}; const u32x4 vv = {vf1a.x, vf1a.y, vf1b.x, vf1b.y};
          o1 = __builtin_amdgcn_mfma_f32_32x32x16_bf16(__builtin_bit_cast(bf16x8, vv), __builtin_bit_cast(bf16x8, pbu), o1, 0, 0, 0); }
        mxl = fmaxf(fmaxf(mxl, n0[12]), n1[12]); mxl = fmaxf(fmaxf(mxl, n0[13]), n1[13]); mxl = fmaxf(fmaxf(mxl, n0[14]), n1[14]); mxl = fmaxf(fmaxf(mxl, n0[15]), n1[15]);
        __builtin_amdgcn_sched_barrier(0);
        mxn = fmaxf(mxl, __shfl_xor(mxl, 32));
    } else {
        u32x2 vf0a, vf0b, vf1a, vf1b, vf2a, vf2b;
        vf0a = *(const LAS u32x2*)(vb_ + ((0) ^ vsw) * 16); vf0b = *(const LAS u32x2*)(vb_ + ((1) ^ vsw) * 16);
        vf1a = *(const LAS u32x2*)(vb_ + 32 * 128 + ((0) ^ vsw) * 16); vf1b = *(const LAS u32x2*)(vb_ + 32 * 128 + ((1) ^ vsw) * 16);
        vf2a = *(const LAS u32x2*)(vb_ + ((2) ^ vsw) * 16); vf2b = *(const LAS u32x2*)(vb_ + ((3) ^ vsw) * 16);
        { const u32x4 pbu = {pwc[0], pwc[1], pwc[2], pwc[3]}; const u32x4 vv = {vf0a.x, vf0a.y, vf0b.x, vf0b.y};
          o0 = __builtin_amdgcn_mfma_f32_32x32x16_bf16(__builtin_bit_cast(bf16x8, vv), __builtin_bit_cast(bf16x8, pbu), o0, 0, 0, 0); }
        __builtin_amdgcn_sched_barrier(0);
        vf0a = *(const LAS u32x2*)(vb_ + 32 * 128 + ((2) ^ vsw) * 16); vf0b = *(const LAS u32x2*)(vb_ + 32 * 128 + ((3) ^ vsw) * 16);
        { const u32x4 pbu = {pwc[0], pwc[1], pwc[2], pwc[3]}; const u32x4 vv = {vf1a.x, vf1a.y, vf1b.x, vf1b.y};
          o1 = __builtin_amdgcn_mfma_f32_32x32x16_bf16(__builtin_bit_cast(bf16x8, vv), __builtin_bit_cast(bf16x8, pbu), o1, 0, 0, 0); }
        __builtin_amdgcn_sched_barrier(0);
        vf1a = *(const LAS u32x2*)(vb_ + ((4) ^ vsw) * 16); vf1b = *(const LAS u32x2*)(vb_ + ((5) ^ vsw) * 16);
        { const u32x4 pbu = {pwc[4], pwc[5], pwc[6], pwc[7]}; const u32x4 vv = {vf2a.x, vf2a.y, vf2b.x, vf2b.y};
          o0 = __builtin_amdgcn_mfma_f32_32x32x16_bf16(__builtin_bit_cast(bf16x8, vv), __builtin_bit_cast(bf16x8, pbu), o0, 0, 0, 0); }
        __builtin_amdgcn_sched_barrier(0);
        vf2a = *(const LAS u32x2*)(vb_ + 32 * 128 + ((4) ^ vsw) * 16); vf2b = *(const LAS u32x2*)(vb_ + 32 * 128 + ((5) ^ vsw) * 16);
        { const u32x4 pbu = {pwc[4], pwc[5], pwc[6], pwc[7]}; const u32x4 vv = {vf0a.x, vf0a.y, vf0b.x, vf0b.y};
          o1 = __builtin_amdgcn_mfma_f32_32x32x16_bf16(__builtin_bit_cast(bf16x8, vv), __builtin_bit_cast(bf16x8, pbu), o1, 0, 0, 0); }
        __builtin_amdgcn_sched_barrier(0);
        vf0a = *(const LAS u32x2*)(vb_ + ((6) ^ vsw) * 16); vf0b = *(const LAS u32x2*)(vb_ + ((7) ^ vsw) * 16);
        { const u32x4 pbu = {pwc[8], pwc[9], pwc[10], pwc[11]}; const u32x4 vv = {vf1a.x, vf1a.y, vf1b.x, vf1b.y};
          o0 = __builtin_amdgcn_mfma_f32_32x32x16_bf16(__builtin_bit_cast(bf16x8, vv), __builtin_bit_cast(bf16x8, pbu), o0, 0, 0, 0); }
        __builtin_amdgcn_sched_barrier(0);
        vf1a = *(const LAS u32x2*)(vb_ + 32 * 128 + ((6) ^ vsw) * 16); vf1b = *(const LAS u32x2*)(vb_ + 32 * 128 + ((7) ^ vsw) * 16);
        { const u32x4 pbu = {pwc[8], pwc[9], pwc[10], pwc[11]}; const u32x4 vv = {vf2a.x, vf2a.y, vf2b.x, vf2b.y};
          o1 = __builtin_amdgcn_mfma_f32_32x32x16_bf16(__builtin_bit_cast(bf16x8, vv), __builtin_bit_cast(bf16x8, pbu), o1, 0, 0, 0); }
        __builtin_amdgcn_sched_barrier(0);
        { const u32x4 pbu = {pwc[12], pwc[13], pwc[14], pwc[15]}; const u32x4 vv = {vf0a.x, vf0a.y, vf0b.x, vf0b.y};
          o0 = __builtin_amdgcn_mfma_f32_32x32x16_bf16(__builtin_bit_cast(bf16x8, vv), __builtin_bit_cast(bf16x8, pbu), o0, 0, 0, 0); }
        __builtin_amdgcn_sched_barrier(0);
        { const u32x4 pbu = {pwc[12], pwc[13], pwc[14], pwc[15]}; const u32x4 vv = {vf1a.x, vf1a.y, vf1b.x, vf1b.y};
          o1 = __builtin_amdgcn_mfma_f32_32x32x16_bf16(__builtin_bit_cast(bf16x8, vv), __builtin_bit_cast(bf16x8, pbu), o1, 0, 0, 0); }
        __builtin_amdgcn_sched_barrier(0);
    }
}

template <int DUMMY>
__device__ __forceinline__ void phase3q(const P& p, int bid, int nb, LAS unsigned char* lds) {
    const bf16_t* Q = p.slotA; const bf16_t* K = p.slotE; const bf16_t* VT = p.slotF; bf16_t* O = p.slotC;
    const int tid = opaque_tid(), lane = tid & 63, wid = tid >> 6, l31 = lane & 31, hh = lane >> 5;
    constexpr float THR = 8.f;
    const int widu = __builtin_amdgcn_readfirstlane(tid >> 6);
    int koff[3];
#pragma unroll
    for (int i = 0; i < 3; ++i) { const int s = tid + 256 * i, r = s / 12, pc = s % 12, c = (pc + 12 - ((r >> 2) & 3)) % 12; koff[i] = r * 96 + c * 8; }
    const int kt = hh + ((lane >> 2) & 3), kt16 = kt * 16, k4o = (8 + kt >= 12 ? kt - 4 : 8 + kt) * 16, k5o = (10 + kt >= 12 ? kt - 2 : 10 + kt) * 16;
    const int krow = l31 * 192, vsw = (lane >> 1) & 7, vrow = l31 * 128 + 8 * hh;
    for (int iu = 0;; ++iu) {
        const int r = iu * nb + ((iu & 1) ? nb - 1 - bid : bid); if (r >= 1024) break;
        const int qb = 63 - (r >> 4), bh = r & 15, b = bh >> 3, h = bh & 7;
        const int q0 = qb * 128 + wid * 32, ntw = (q0 >> 6) + 1, nt = 2 * qb + 2;
        const bf16_t* Kb = K + (size_t)bh * SEQ * 96; const bf16_t* Vb = VT + (size_t)(h * 64) * NT + (size_t)b * SEQ;
        bf16x8 qf[6]; { const bf16_t* qp = Q + ((size_t)bh * SEQ + q0 + l31) * 96 + hh * 8;
#pragma unroll
            for (int ks = 0; ks < 6; ++ks) qf[ks] = *(const bf16x8*)(qp + ks * 16); }
        f32x16 o0, o1;
#pragma unroll
        for (int e = 0; e < 16; ++e) { o0[e] = 0.f; o1[e] = 0.f; }
        float mrun = 0.f, lsum = 0.f;
        auto stageK = [&](int j) { LAS unsigned char* d = lds + (j & 1) * 12288 + widu * 1024; const bf16_t* kt = Kb + (size_t)j * 64 * 96;
#pragma unroll
            for (int i = 0; i < 3; ++i) __builtin_amdgcn_global_load_lds((const unsigned*)(kt + koff[i]), (LAS unsigned*)(d + i * 4096), 16, 0, 0); };
        auto stageV = [&](int j) { LAS unsigned char* d = lds + 24576 + (j & 1) * 8192 + widu * 1024; const bf16_t* vt = Vb + j * 64;
#pragma unroll
            for (int i = 0; i < 2; ++i) { const int dv = (tid >> 3) + 32 * i, cl = (tid & 7) ^ ((dv >> 1) & 7);
                __builtin_amdgcn_global_load_lds((const unsigned*)(vt + (size_t)dv * NT + cl * 8), (LAS unsigned*)(d + i * 4096), 16, 0, 0); } };
        f32x16 sA0, sA1, sB0, sB1; unsigned pA[16], pB[16]; float mxA, mxB = 0.f;
#pragma unroll
        for (int e = 0; e < 16; ++e) { pA[e] = 0u; pB[e] = 0u; }
        stageK(0); stageK(1);
        asm volatile("s_waitcnt vmcnt(0)" ::: "memory");
        __syncthreads();
        { const LAS unsigned char* kb_ = lds + krow;
#pragma unroll
          for (int e = 0; e < 16; ++e) { sA0[e] = 0.f; sA1[e] = 0.f; }
#pragma unroll
          for (int ks = 0; ks < 6; ++ks) { const int ko = ks <= 3 ? kt16 + 32 * ks : (ks == 4 ? k4o : k5o); const bf16x8 k0 = *(const LAS bf16x8*)(kb_ + ko); const bf16x8 k1 = *(const LAS bf16x8*)(kb_ + 32 * 192 + ko);
              sA0 = __builtin_amdgcn_mfma_f32_32x32x16_bf16(k0, qf[ks], sA0, 0, 0, 0); sA1 = __builtin_amdgcn_mfma_f32_32x32x16_bf16(k1, qf[ks], sA1, 0, 0, 0); }
          float m = fmaxf(sA0[0], sA1[0]);
#pragma unroll
          for (int e = 1; e < 16; ++e) m = fmaxf(fmaxf(m, sA0[e]), sA1[e]);
          mxA = fmaxf(m, __shfl_xor(m, 32)); }
        auto step = [&](f32x16& c0, f32x16& c1, float& mxc, f32x16& n0, f32x16& n1, float& mxn, const unsigned (&pwc)[16], unsigned (&pwn)[16], int s) {
            asm volatile("s_waitcnt vmcnt(0)" ::: "memory");
            __syncthreads();
            if (s + 2 < nt) stageK(s + 2);
            if (s < nt) stageV(s);
            if (s <= ntw) {
                const LAS unsigned char* kb_ = lds + ((s + 1) & 1) * 12288 + krow; const LAS unsigned char* vb_ = lds + 24576 + ((s + 1) & 1) * 8192 + vrow;
                if (s < ntw) {
                    const bool resc = (s == 0) || !__all(mxc <= mrun + THR); float alpha = 1.f;
                    if (resc) { const float mn = (s == 0) ? mxc : fmaxf(mrun, mxc); alpha = __builtin_amdgcn_exp2f(mrun - mn); mrun = mn; }
                    float ps = 0.f;
                    if (s == 0) att_step<0>(kb_, vb_, kt16, k4o, k5o, vsw, qf, c0, c1, n0, n1, pwc, pwn, o0, o1, mrun, ps, mxn);
                    else att_step<1>(kb_, vb_, kt16, k4o, k5o, vsw, qf, c0, c1, n0, n1, pwc, pwn, o0, o1, mrun, ps, mxn);
                    if (resc) {
#pragma unroll
                        for (int e = 0; e < 16; ++e) { o0[e] *= alpha; o1[e] *= alpha; } }
                    lsum = lsum * alpha + ps;
                } else att_step<2>(kb_, vb_, kt16, k4o, k5o, vsw, qf, c0, c1, n0, n1, pwc, pwn, o0, o1, mrun, lsum, mxn);
            }
        };
        for (int s = 0; s <= nt; s += 2) { step(sA0, sA1, mxA, sB0, sB1, mxB, pB, pA, s); if (s + 1 <= nt) step(sB0, sB1, mxB, sA0, sA1, mxA, pA, pB, s + 1); }
        const float inv = 1.f / (lsum + __shfl_xor(lsum, 32));
        bf16_t* op = O + (size_t)(b * SEQ + q0 + l31) * 512 + h * 64 + 4 * hh;
#pragma unroll
        for (int g = 0; g < 4; ++g) { uint2 w0, w1;
            w0.x = pk2(o0[4 * g] * inv, o0[4 * g + 1] * inv); w0.y = pk2(o0[4 * g + 2] * inv, o0[4 * g + 3] * inv);
            w1.x = pk2(o1[4 * g] * inv, o1[4 * g + 1] * inv); w1.y = pk2(o1[4 * g + 2] * inv, o1[4 * g + 3] * inv);
            *(uint2*)(op + 8 * g) = w0; *(uint2*)(op + 32 + 8 * g) = w1; }
        __syncthreads();
    }
}

__device__ __forceinline__ unsigned pack2bf(float lo, float hi) { return (unsigned)f2bf(lo) | ((unsigned)f2bf(hi) << 16); }
__device__ __forceinline__ void phase4(const P& p, int bid, int nb, LAS unsigned char* lds) {
    const bf16_t* O = p.slotC; const bf16_t* su = p.slotG; const bf16_t* gates = p.slotD; bf16_t* mo = p.slotA;
    const int tid = opaque_tid(), lane = tid & 63, wid = tid >> 6, wr = wid >> 1, wc = wid & 1, fr = lane & 15, fq = lane >> 4;
    const int c8 = ((tid & 7) ^ ((tid >> 3) & 7)) * 8;
    auto ops1 = [&](int rt, int ct) __attribute__((always_inline)) { return gops(O + (size_t)(rt * 128 + (tid >> 3)) * 512 + c8, (size_t)32 * 512, p.WoaT + (size_t)(ct * 128 + (tid >> 3)) * 512 + c8, (size_t)32 * 512); };
    auto ops2 = [&](int rt, int ct) __attribute__((always_inline)) { return gops(su + (size_t)(rt * 128 + (tid >> 3)) * 512 + c8, (size_t)32 * 512, p.WosT + (size_t)(ct * 128 + (tid >> 3)) * 512 + c8, (size_t)32 * 512); };
    int rt, ct; bool have = tile_of(0, bid, nb, NT / 128, DM / 128, rt, ct);
    for (int it = 0; have; ++it) {
        const int row0 = rt * 128, col0 = ct * 128;
        int rt2, ct2; const bool have2 = tile_of(it + 1, bid, nb, NT / 128, DM / 128, rt2, ct2);
        f32x4 acc[4][4];
#pragma unroll
        for (int m = 0; m < 4; ++m)
#pragma unroll
            for (int n = 0; n < 4; ++n) acc[m][n] = (f32x4){0.f, 0.f, 0.f, 0.f};
        mg_kloop_p(acc, ops1(rt, ct), 8, lds, it > 0, true, ops2(rt, ct));
#pragma unroll
        for (int m = 0; m < 4; ++m)
#pragma unroll
            for (int n = 0; n < 4; ++n) { const int t = row0 + wr * 64 + m * 16 + fr, c = col0 + wc * 64 + n * 16 + fq * 4;
                const f32x4 ga = bf4(*(const uint2*)(gates + (size_t)t * 2048 + c)), gb = bf4(*(const uint2*)(gates + (size_t)t * 2048 + 1024 + c));
#pragma unroll
                for (int j = 0; j < 4; ++j) acc[m][n][j] *= ga[j] * __builtin_amdgcn_rcpf(gb[j]); }
        mg_kloop_p(acc, ops2(rt, ct), 8, lds, true, have2, ops1(have2 ? rt2 : rt, have2 ? ct2 : ct));
#pragma unroll
        for (int m = 0; m < 4; ++m)
#pragma unroll
            for (int n = 0; n < 4; ++n) { const int t = row0 + wr * 64 + m * 16 + fr, c = col0 + wc * 64 + n * 16 + fq * 4;
                const f32x4 gb = bf4(*(const uint2*)(gates + (size_t)t * 2048 + 1024 + c));
                uint2 o; o.x = pk2(gb[0] * acc[m][n][0], gb[1] * acc[m][n][1]); o.y = pk2(gb[2] * acc[m][n][2], gb[3] * acc[m][n][3]); *(uint2*)(mo + (size_t)t * DM + c) = o; }
        rt = rt2; ct = ct2; have = have2;
    }
    __syncthreads();
}

__device__ __forceinline__ void phase5(const P& p, int bid, int nb, LAS unsigned char* sm) {
    const float* x = p.x; float* xm = p.out;
    mgemm(p.slotA, DM, p.WoutT, DM, NT, DM, DM, [=](int t, int c, const f32x4& v) {
        const f32x4 xv = *(const f32x4*)(x + (size_t)t * DM + c); *(f32x4*)(xm + (size_t)t * DM + c) = xv + v;
    }, bid, nb, sm);
}

__device__ __forceinline__ int gu_src_col(int rho, int& isup) {
    const int tt = rho >> 7, w = rho & 127, wc = w >> 6, n = (w >> 4) & 3, i = w & 15; isup = n >> 1; return tt * 64 + wc * 32 + (n & 1) * 16 + i;
}
__device__ __forceinline__ void ex_tile(const P& p, int tile, const float*& s0, const float*& s1, size_t& ld, bf16_t*& dst, int& K) {
    bf16_t* WguT = (bf16_t*)p.slotB; bf16_t* WdT = p.slotC + (size_t)NT * 512;
    const int e = tile / 192, tt = tile % 192;
    if (tt < 128) { const int tr = tt >> 4, tk = tt & 15, T = tr >> 1, wc = tr & 1, k0 = tk * 64, c0 = T * 64 + wc * 32;
        s0 = p.w_eg + ((size_t)e * 1024 + k0) * 256 + c0; s1 = p.w_eu + ((size_t)e * 1024 + k0) * 256 + c0; ld = 256; K = 1024;
        dst = WguT + ((size_t)e * 512 + tr * 64) * 1024 + k0; }
    else { const int t2 = tt - 128, tr = t2 >> 2, tk = t2 & 3, k0 = tk * 64, n0 = tr * 64;
        s0 = p.w_ed + ((size_t)e * 256 + k0) * 1024 + n0; s1 = s0 + 32; ld = 1024; K = 256;
        dst = WdT + ((size_t)e * 1024 + n0) * 256 + k0; }
}
__device__ __forceinline__ void expert_conv(const P& p, int first, int step, float* sm) {
    const int tid = opaque_tid(), kq = tid >> 4, r4 = (tid & 15) * 4;
    for (int t0 = first; t0 < 6144; t0 += 2 * step) {
        f32x4 v[2][4]; bf16_t* dst[2]; int K[2]; const int nt = (t0 + step < 6144) ? 2 : 1;
#pragma unroll
        for (int u = 0; u < 2; ++u) if (u < nt) { const float* s0; const float* s1; size_t ld; ex_tile(p, t0 + u * step, s0, s1, ld, dst[u], K[u]);
            const float* src = (r4 < 32 ? s0 + r4 : s1 + (r4 - 32));
#pragma unroll
            for (int i = 0; i < 4; ++i) v[u][i] = *(const f32x4*)(src + (size_t)(kq + 16 * i) * ld); }
#pragma unroll
        for (int u = 0; u < 2; ++u) if (u < nt) {
#pragma unroll
            for (int i = 0; i < 4; ++i)
#pragma unroll
                for (int j = 0; j < 4; ++j) sm[u * 4160 + (kq + 16 * i) * 65 + r4 + j] = v[u][i][j]; }
        __syncthreads();
#pragma unroll
        for (int u = 0; u < 2; ++u) if (u < nt) {
#pragma unroll
            for (int i = 0; i < 4; ++i) { const int rho = kq + 16 * i; const float* b = sm + u * 4160 + r4 * 65 + rho;
                uint2 o; o.x = pk2(b[0], b[65]); o.y = pk2(b[130], b[195]); *(uint2*)(dst[u] + (size_t)rho * K[u] + r4) = o; } }
        __syncthreads();
    }
}

__device__ __forceinline__ void phase6(const P& p, int bid, int nb, float* sm) {
    const int tid = opaque_tid(), lane = tid & 63, wid = tid >> 6;
    bf16_t* h2 = p.slotA; const float* xm = p.out;
    int* s_cnt = (int*)sm; int* s_base = s_cnt + 32; int* s_e = s_base + 32; int* s_r = s_e + 128; float* s_w = (float*)(s_r + 128);
    if (tid < 32) s_cnt[tid] = 0;
    __syncthreads();
    int slot = wid * 16;
    float* xs = sm + 512 + wid * 1024;
    for (int t = bid * 4 + wid; t < NT; t += nb * 4, ++slot) {
        f32x4 v[4]; float ss = 0.f;
#pragma unroll
        for (int i = 0; i < 4; ++i) { v[i] = *(const f32x4*)(xm + (size_t)t * DM + (lane + 64 * i) * 4); ss += v[i][0] * v[i][0] + v[i][1] * v[i][1] + v[i][2] * v[i][2] + v[i][3] * v[i][3]; }
        ss = wsumf(ss); const float r = rsqrtf(ss * (1.f / DM) + EPS);
#pragma unroll
        for (int i = 0; i < 4; ++i) { const f32x4 g = *(const f32x4*)(p.g_ffn + (lane + 64 * i) * 4); v[i] = v[i] * r * g; *(f32x4*)(xs + (lane + 64 * i) * 4) = v[i];
            uint2 o; o.x = pk2(v[i][0], v[i][1]); o.y = pk2(v[i][2], v[i][3]); *(uint2*)(h2 + (size_t)t * DM + (lane + 64 * i) * 4) = o; }
        f32x4 lgv = {0.f, 0.f, 0.f, 0.f};
#pragma unroll 4
        for (int i = 0; i < 16; ++i) { const int k = lane + 64 * i; lgv += xs[k] * *(const f32x4*)(p.w_rg + (size_t)k * 4); }
        float lg[4];
#pragma unroll
        for (int g = 0; g < 4; ++g) lg[g] = wsumf(lgv[g]) + p.b_rg[g];
        int gs = 0; float gm = lg[0];
#pragma unroll
        for (int g = 1; g < 4; ++g) if (lg[g] > gm) { gm = lg[g]; gs = g; }
        float den = 0.f;
#pragma unroll
        for (int g = 0; g < 4; ++g) den += __expf(lg[g] - gm);
        const float ptop = 1.f / den;
        f32x4 lev = {0.f, 0.f, 0.f, 0.f}; const float* wre = p.w_re + (size_t)gs * DM * 8;
#pragma unroll 8
        for (int i = 0; i < 32; ++i) { const int c = lane + 64 * i; lev += xs[c >> 1] * *(const f32x4*)(wre + (size_t)c * 4); }
        float le[8];
#pragma unroll
        for (int e = 0; e < 4; ++e) { const float mine = wsum_par(lev[e]), oth = DPP_F(mine, 0xB1); le[e] = mine + p.b_re[gs * 8 + e]; le[4 + e] = oth + p.b_re[gs * 8 + 4 + e]; }
        int e1 = 0; float l1 = le[0];
#pragma unroll
        for (int e = 1; e < 8; ++e) if (le[e] > l1) { l1 = le[e]; e1 = e; }
        int e2 = -1; float l2 = -3.0e38f;
#pragma unroll
        for (int e = 0; e < 8; ++e) if (e != e1 && le[e] > l2) { l2 = le[e]; e2 = e; }
        const float s1 = 1.f / (1.f + __expf(l2 - l1)), s2 = 1.f - s1;
        if (lane == 0) {
            const int ea = gs * 8 + e1, eb = gs * 8 + e2;
            s_e[2 * slot] = ea; s_e[2 * slot + 1] = eb; s_r[2 * slot] = atomicAdd(&s_cnt[ea], 1); s_r[2 * slot + 1] = atomicAdd(&s_cnt[eb], 1);
            s_w[2 * slot] = s1 * ptop; s_w[2 * slot + 1] = s2 * ptop;
        }
    }
    __syncthreads();
    if (tid < 32) { const int c = s_cnt[tid]; s_base[tid] = c ? atomicAdd(&p.cnt[tid], c) : 0; }
    __syncthreads();
    if (tid < 128) { const int sl = tid >> 1, kk = tid & 1, w = sl >> 4, k = sl & 15, t = bid * 4 + w + k * nb * 4;
        if (t < NT) { const int a = 2 * t + kk, e = s_e[tid]; p.list[(size_t)e * NT + s_base[e] + s_r[tid]] = a; p.aw[a] = s_w[tid]; p.aexp[a] = e; } }
    __syncthreads();
}

__device__ __forceinline__ void phase7a(const P& p, int bid, int nb) {
    const bf16_t* h2 = p.slotA; const bf16_t* WguT = (const bf16_t*)p.slotB; bf16_t* hid = p.slotE;
    for (size_t i = (size_t)bid * 256 + threadIdx.x; i < (size_t)2 * NT * 256; i += (size_t)nb * 256) {
        const int a = (int)(i >> 8), c = (int)(i & 255), t = a >> 1, e = p.aexp[a];
        const int tt = c >> 6, wc = (c >> 5) & 1, nn = (c >> 4) & 1, ii = c & 15; const int rg = tt * 128 + wc * 64 + nn * 16 + ii, ru = rg + 32;
        const bf16_t* wg = WguT + ((size_t)e * 512 + rg) * 1024; const bf16_t* wu = WguT + ((size_t)e * 512 + ru) * 1024; const bf16_t* hr = h2 + (size_t)t * DM;
        float G = 0.f, U = 0.f;
        for (int k = 0; k < DM / 8; ++k) { const uint4 hv = ((const uint4*)hr)[k]; G += dot8(hv, ((const uint4*)wg)[k]); U += dot8(hv, ((const uint4*)wu)[k]); }
        hid[i] = f2bf(G * sigmoidf_(G) * U);
    }
}
__device__ __forceinline__ void phase7b(const P& p, int bid, int nb) {
    const bf16_t* hid = p.slotE; const bf16_t* WdT = p.slotC + (size_t)NT * 512; bf16_t* Y = p.slotD;
    for (size_t i = (size_t)bid * 256 + threadIdx.x; i < (size_t)2 * NT * DM; i += (size_t)nb * 256) {
        const int a = (int)(i >> 10), n = (int)(i & 1023), e = p.aexp[a];
        const bf16_t* w = WdT + ((size_t)e * 1024 + n) * 256; const bf16_t* hr = hid + (size_t)a * 256; float s = 0.f;
        for (int k = 0; k < 32; ++k) s += dot8(((const uint4*)hr)[k], ((const uint4*)w)[k]);
        Y[i] = f2bf(s * p.aw[a]);
    }
}


__device__ __forceinline__ void build_expert_table(const int* cnt, volatile LAS int* tab) {
    const int tid = threadIdx.x;
    if (tid < 64) { const int c = tid < NE ? cnt[tid] : 0; int n = (c + 127) >> 7, incl = n;
#pragma unroll
        for (int o = 1; o < 32; o <<= 1) { const int y = __shfl_up(incl, o); if ((tid & 63) >= o) incl += y; }
        if (tid < NE) { tab[tid] = incl - n; tab[32 + tid] = c; } if (tid == NE - 1) tab[64] = incl; }
    __syncthreads();
}
__device__ __forceinline__ bool find_expert(volatile LAS int* tab, int ub, int& e, int& blk, int& ce) {
    if (ub >= tab[64]) return false;
    int lo = 0;
#pragma unroll
    for (int st = 16; st > 0; st >>= 1) if (tab[lo + st] <= ub) lo += st;
    e = lo; blk = ub - tab[lo]; ce = tab[32 + lo]; return true;
}
__device__ __forceinline__ void phase7a_m(const P& p, int bid, int nb, LAS unsigned char* lds) {
    const bf16_t* h2 = p.slotA; const bf16_t* WguT = (const bf16_t*)p.slotB; bf16_t* hid = p.slotE;
    const int tid = opaque_tid(), lane = tid & 63, wid = tid >> 6, wr = wid >> 1, wc = wid & 1, fr = lane & 15, fq = lane >> 4;
    const int c8 = ((tid & 7) ^ ((tid >> 3) & 7)) * 8;
    volatile LAS int* tab = (volatile LAS int*)(lds + LDS_TAB_); build_expert_table(p.cnt, tab);
    auto make = [&](int u, GOps& g) __attribute__((always_inline)) -> bool {
        int e, blk, ce; if (!find_expert(tab, u >> 2, e, blk, ce)) return false;
        const int ct = u & 3; const int* lst = p.list + (size_t)e * NT; const bf16_t* ap[4];
#pragma unroll
        for (int i = 0; i < 4; ++i) { int r = blk * 128 + (tid >> 3) + 32 * i; r = r < ce ? r : ce - 1; ap[i] = h2 + (size_t)(lst[r] >> 1) * DM + c8; }
        g.a0 = ap[0]; g.a1 = ap[1]; g.a2 = ap[2]; g.a3 = ap[3]; g.bp = WguT + ((size_t)e * 512 + ct * 128 + (tid >> 3)) * 1024 + c8; g.bstep = (size_t)32 * 1024; return true; };
    GOps cur; bool have = make(bid, cur);
    for (int u = bid, it = 0; have; u += nb, ++it) {
        GOps nxt = cur; const bool have2 = make(u + nb, nxt);
        f32x4 acc[4][4];
#pragma unroll
        for (int m = 0; m < 4; ++m)
#pragma unroll
            for (int n = 0; n < 4; ++n) acc[m][n] = (f32x4){0.f, 0.f, 0.f, 0.f};
        mg_kloop_p(acc, cur, 16, lds, it > 0, have2, nxt);
        const int ct = u & 3;
        bf16_t* hb = hid + ((size_t)(u >> 2) * 128 + wr * 64 + fr) * 256 + ct * 64 + wc * 32 + fq * 4;
#pragma unroll
        for (int m = 0; m < 4; ++m)
#pragma unroll
            for (int n = 0; n < 2; ++n) { float v[4];
#pragma unroll
                for (int j = 0; j < 4; ++j) { const float g = acc[m][n][j]; v[j] = g * fsigmoid(g) * acc[m][n + 2][j]; }
                uint2 o; o.x = pk2(v[0], v[1]); o.y = pk2(v[2], v[3]); *(uint2*)(hb + (size_t)(m * 16) * 256 + n * 16) = o; }
        cur = nxt; have = have2;
    }
    __syncthreads();
}
__device__ __forceinline__ void phase7b_m(const P& p, int bid, int nb, LAS unsigned char* lds) {
    const bf16_t* hid = p.slotE; const bf16_t* WdT = p.slotC + (size_t)NT * 512; bf16_t* Y = p.slotD;
    const int tid = opaque_tid(), lane = tid & 63, wid = tid >> 6, wr = wid >> 1, wc = wid & 1, fr = lane & 15, fq = lane >> 4;
    const int c8 = ((tid & 7) ^ ((tid >> 3) & 7)) * 8;
    int e, blk, ce;
    volatile LAS int* tab = (volatile LAS int*)(lds + LDS_TAB_); build_expert_table(p.cnt, tab);
    auto make = [&](int u, GOps& g, int& e_, int& blk_, int& ce_) __attribute__((always_inline)) -> bool {
        if (!find_expert(tab, u >> 3, e_, blk_, ce_)) return false;
        g = gops(hid + ((size_t)(u >> 3) * 128 + (tid >> 3)) * 256 + c8, (size_t)32 * 256, WdT + ((size_t)e_ * 1024 + (u & 7) * 128 + (tid >> 3)) * 256 + c8, (size_t)32 * 256); return true; };
    GOps cur; bool have = make(bid, cur, e, blk, ce);
    for (int u = bid, it = 0; have; u += nb, ++it) {
        GOps nxt = cur; int e2 = 0, blk2 = 0, ce2 = 0; const bool have2 = make(u + nb, nxt, e2, blk2, ce2);
        const int ct = u & 7; const int* lst = p.list + (size_t)e * NT;
        f32x4 acc[4][4];
#pragma unroll
        for (int m = 0; m < 4; ++m)
#pragma unroll
            for (int n = 0; n < 4; ++n) acc[m][n] = (f32x4){0.f, 0.f, 0.f, 0.f};
        mg_kloop_p(acc, cur, 4, lds, it > 0, have2, nxt);
#pragma unroll
        for (int m = 0; m < 4; ++m) { const int r = blk * 128 + wr * 64 + m * 16 + fr;
            if (r < ce) { const int a = lst[r]; const float w = p.aw[a]; bf16_t* yp = Y + (size_t)a * DM + ct * 128 + wc * 64 + fq * 4;
#pragma unroll
                for (int n = 0; n < 4; ++n) { uint2 o; o.x = pk2(acc[m][n][0] * w, acc[m][n][1] * w); o.y = pk2(acc[m][n][2] * w, acc[m][n][3] * w); *(uint2*)(yp + n * 16) = o; } } }
        cur = nxt; e = e2; blk = blk2; ce = ce2; have = have2;
    }
    __syncthreads();
}

__device__ __forceinline__ void phase8(const P& p, int bid, int nb, float* dst) {
    const int tid = opaque_tid(), lane = tid & 63, wid = tid >> 6; const bf16_t* Y = p.slotD;
    for (int t = bid * 4 + wid; t < NT; t += nb * 4) {
        f32x4 v[4]; float ss = 0.f;
#pragma unroll
        for (int i = 0; i < 4; ++i) { const int c = (lane + 64 * i) * 4;
            v[i] = *(const f32x4*)(p.out + (size_t)t * DM + c) + bf4(*(const uint2*)(Y + (size_t)(2 * t) * DM + c)) + bf4(*(const uint2*)(Y + (size_t)(2 * t + 1) * DM + c));
            ss += v[i][0] * v[i][0] + v[i][1] * v[i][1] + v[i][2] * v[i][2] + v[i][3] * v[i][3]; }
        ss = wsumf(ss); const float r = rsqrtf(ss * (1.f / DM) + EPS);
#pragma unroll
        for (int i = 0; i < 4; ++i) { const int c = (lane + 64 * i) * 4; const f32x4 g = *(const f32x4*)(p.g_final + c); *(f32x4*)(dst + (size_t)t * DM + c) = v[i] * r * g; }
    }
}

#define XB_TMO      128
#define XB_XCNT(j)  (256  + 64 * (j))
#define XB_XSUB(j)  (1280 + 64 * (j))
#define XB_XGEN(j)  (2304 + 64 * (j))
#define XB_TOP      3328
#define XB_TOPGEN   3392
#define XCD_BAR_WORDS 3456
#define XB_SPIN_CAP (1u << 18)
__device__ __forceinline__ unsigned xb_ld(unsigned* p)              { return __hip_atomic_load(p, __ATOMIC_RELAXED, __HIP_MEMORY_SCOPE_AGENT); }
__device__ __forceinline__ unsigned xb_add(unsigned* p, unsigned v) { return __hip_atomic_fetch_add(p, v, __ATOMIC_RELAXED, __HIP_MEMORY_SCOPE_AGENT); }
__device__ __forceinline__ unsigned xb_xcc_id() { return (unsigned)__builtin_amdgcn_s_getreg((3 << 11) | 20) & 0xFu; }
#define XB_SPIN(cond, bar) do { unsigned _sp = 0; while (cond) { __builtin_amdgcn_s_sleep(1); \
    if ((++_sp & 255u) == 0u) { if (xb_ld(&(bar)[XB_TMO])) break; if (_sp > XB_SPIN_CAP) { atomicAdd(&(bar)[XB_TMO], 1u); break; } } } } while (0)
struct XcdBarrier { unsigned* bar; unsigned x; volatile LAS unsigned* st; };
__device__ __forceinline__ XcdBarrier xcd_barrier_post(unsigned* bar, volatile LAS unsigned* st) {
    XcdBarrier b; b.bar = bar; b.x = xb_xcc_id(); b.st = st;
    if (threadIdx.x == 0) (void)xb_add(&bar[XB_XCNT(b.x)], 1u);
    return b;
}
__device__ __forceinline__ void xcd_barrier_complete(unsigned* bar, unsigned x, unsigned& nloc, unsigned& nx) {
    const unsigned G = gridDim.x * gridDim.y * gridDim.z;
    unsigned sum, cnt, mine, sp = 0u;
    for (;;) {
        sum = 0u; cnt = 0u; mine = 0u;
#pragma unroll
        for (unsigned j = 0; j < 16; ++j) { const unsigned c = xb_ld(&bar[XB_XCNT(j)]); sum += c; cnt += (c > 0u) ? 1u : 0u; mine = (j == x) ? c : mine; }
        if (sum == G) break;
        __builtin_amdgcn_s_sleep(1);
        if ((++sp & 255u) == 0u) { if (xb_ld(&bar[XB_TMO])) break; if (sp > XB_SPIN_CAP) { atomicAdd(&bar[XB_TMO], 1u); break; } }
    }
    nloc = mine > 0u ? mine : 1u; nx = cnt > 0u ? cnt : 1u;
}
__device__ __forceinline__ void xcd_barrier(const XcdBarrier& b) {
    asm volatile("s_waitcnt vmcnt(0)" ::: "memory");
    __syncthreads();
    if (threadIdx.x == 0) {
        unsigned* bar = b.bar;
        __builtin_amdgcn_s_waitcnt(0);
        unsigned nloc = b.st[0], nx = b.st[1];
        if (nloc == 0u) { xcd_barrier_complete(bar, b.x, nloc, nx); b.st[0] = nloc; b.st[1] = nx; }
        const unsigned old = xb_add(&bar[XB_XSUB(b.x)], 1u);
        const unsigned gen = old / nloc;
        if (old + 1u == (gen + 1u) * nloc) {
            __builtin_amdgcn_fence(__ATOMIC_RELEASE, "agent");
            asm volatile("s_waitcnt vmcnt(0)" ::: "memory");
            const unsigned og = xb_add(&bar[XB_TOP], 1u);
            const unsigned tg = og / nx;
            if (og + 1u == (tg + 1u) * nx) xb_add(&bar[XB_TOPGEN], 1u);
            else XB_SPIN(xb_ld(&bar[XB_TOPGEN]) == tg, bar);
            __builtin_amdgcn_fence(__ATOMIC_ACQUIRE, "agent");
            xb_add(&bar[XB_XGEN(b.x)], 1u);
            asm volatile("s_waitcnt vmcnt(0)" ::: "memory");
        } else {
            XB_SPIN(xb_ld(&bar[XB_XGEN(b.x)]) == gen, bar);
            __builtin_amdgcn_fence(__ATOMIC_ACQUIRE, "agent");
            asm volatile("s_waitcnt vmcnt(0)" ::: "memory");
        }
    }
    __syncthreads();
}

constexpr int LDS_MAIN = 64 * 1024;
constexpr int LDS_BYTES = LDS_MAIN + 16 + 288;
extern __shared__ __attribute__((aligned(16))) unsigned char smem_raw[];

#if MK_LAUNCHES != 1
__global__ void __launch_bounds__(256, 2) k_phase(P p, int ph) {
    float* sm = (float*)smem_raw; LAS unsigned char* lds = (LAS unsigned char*)smem_raw; const int bid = blockIdx.x, nb = gridDim.x;
    switch (ph) {
        case 0: phase0(p, bid, nb, sm); break;
        case 1: phase1(p, bid, nb, lds); break;
        case 2: phase2a(p, bid, nb, false); break;
        case 3: phase2b(p, bid, nb, lds); break;
        case 4: phase2c_m(p, bid, nb, lds); break;
        case 5: phase3q<0>(p, bid, nb, lds); break;
        case 6: phase4(p, bid, nb, lds); break;
        case 7: phase5(p, bid, nb, lds); break;
        case 8: phase6(p, bid, nb, sm); break;
        case 9: phase7a_m(p, bid, nb, lds); break;
        case 10: phase7b_m(p, bid, nb, lds); break;
        case 11: phase8(p, bid, nb, p.out); break;
    }
}
#endif

#ifndef PROF_SEL
#define PROF_SEL -1
#endif
#define PROF_MULT 4
__global__ void __launch_bounds__(256, 2) k_mega(P p) {
    float* sm = (float*)smem_raw; LAS unsigned char* lds = (LAS unsigned char*)smem_raw; const int bid = blockIdx.x, nb = gridDim.x;
    volatile LAS unsigned* st = (volatile LAS unsigned*)(lds + LDS_MAIN);
    if (threadIdx.x < 4) st[threadIdx.x] = 0u;
    __syncthreads();
    const XcdBarrier gb = xcd_barrier_post(p.bar, st);
    unsigned long long t_last = 0, t_sel = 0;
#define STAMP(k) do { if (PROF_SEL >= 0 && PROF_SEL < 100) { const unsigned long long t_ = __builtin_amdgcn_s_memrealtime(); if (PROF_SEL == (k) - 1) t_sel = t_ - t_last; t_last = t_; } } while (0)
#define BAR(k) do { if (PROF_SEL == 100 + (k)) { const unsigned long long ta_ = __builtin_amdgcn_s_memrealtime(); xcd_barrier(gb); const unsigned long long tb_ = __builtin_amdgcn_s_memrealtime(); \
        if (threadIdx.x == 0) atomicAdd(p.bar + XCD_BAR_WORDS, (unsigned)(tb_ - ta_)); } else xcd_barrier(gb); STAMP((k) + 1); } while (0)
    STAMP(0);
    phase0(p, bid, nb, sm); BAR(0);
    phase1(p, bid, nb, lds); BAR(1);
    phase2a(p, bid, nb, false); BAR(2);
    phase2b(p, bid, nb, lds); phase2c_m(p, bid, nb, lds); BAR(3);
    phase3q<0>(p, bid, nb, lds); expert_conv(p, bid, nb, sm); BAR(4);
    phase4(p, bid, nb, lds); BAR(5);
    phase5(p, bid, nb, lds); BAR(6);
    phase6(p, bid, nb, sm); BAR(7);
    phase7a_m(p, bid, nb, lds); BAR(8);
    phase7b_m(p, bid, nb, lds); BAR(9);
    phase8(p, bid, nb, p.out);
    if (PROF_SEL >= 0) {
        xcd_barrier(gb); STAMP(11);
        if (bid == 0 && threadIdx.x == 0) {
            unsigned long long metric = t_sel;
            if (PROF_SEL >= 100) metric = __hip_atomic_load(p.bar + XCD_BAR_WORDS, __ATOMIC_RELAXED, __HIP_MEMORY_SCOPE_AGENT) / (unsigned)nb;
            const unsigned long long t0 = __builtin_amdgcn_s_memrealtime();
            while (__builtin_amdgcn_s_memrealtime() - t0 < metric * PROF_MULT) __builtin_amdgcn_s_sleep(8);
        }
    }
}

extern "C" void kernel_launch(void* const* d_in, const int* in_sizes, int n_in, void* d_out, int out_size, void* d_ws, size_t ws_size, hipStream_t stream) {
    P p{};
    p.x = (const float*)d_in[0]; p.pos = (const int*)d_in[1]; p.g_attn = (const float*)d_in[2]; p.w_in = (const float*)d_in[3]; p.g_cq = (const float*)d_in[4];
    p.w_uq = (const float*)d_in[5]; p.g_ckv = (const float*)d_in[6]; p.w_uk = (const float*)d_in[7]; p.w_uv = (const float*)d_in[8]; p.w_o_attn = (const float*)d_in[9];
    p.sgu_gain = (const float*)d_in[10]; p.sgu_bias = (const float*)d_in[11]; p.w_sp = (const float*)d_in[12]; p.b_sp = (const float*)d_in[13]; p.w_o_sgu = (const float*)d_in[14];
    p.w_out = (const float*)d_in[15]; p.g_ffn = (const float*)d_in[16]; p.w_rg = (const float*)d_in[17]; p.b_rg = (const float*)d_in[18]; p.w_re = (const float*)d_in[19];
    p.b_re = (const float*)d_in[20]; p.w_eg = (const float*)d_in[21]; p.w_eu = (const float*)d_in[22]; p.w_ed = (const float*)d_in[23]; p.g_final = (const float*)d_in[24];
    p.out = (float*)d_out;
    unsigned char* w = (unsigned char*)d_ws; size_t off = 0;
    auto take = [&](size_t bytes) { unsigned char* r = w + off; off += (bytes + 255) & ~(size_t)255; return r; };
    p.bar = (unsigned*)take((XCD_BAR_WORDS + 64) * 4);
    p.cnt = (int*)take(4096);
    p.WinT = (bf16_t*)take((size_t)ZP * DM * 2); p.WuqT = (bf16_t*)take(768 * 256 * 2); p.WukT = (bf16_t*)take(512 * 128 * 2); p.WuvT = (bf16_t*)take(512 * 128 * 2);
    p.WoaT = (bf16_t*)take(1024 * 512 * 2); p.WosT = (bf16_t*)take(1024 * 512 * 2); p.WoutT = (bf16_t*)take(1024 * 1024 * 2); p.Wsp = (bf16_t*)take(8 * 128 * 128 * 2);
    p.cs = (float*)take((size_t)NT * 32 * 4); p.cqn = (bf16_t*)take((size_t)NT * 256 * 2); p.ckvn = (bf16_t*)take((size_t)NT * 128 * 2);
    p.list = (int*)take((size_t)NE * NT * 4); p.aw = (float*)take((size_t)2 * NT * 4); p.aexp = (int*)take((size_t)2 * NT * 4);
    p.slotA = (bf16_t*)take((size_t)NT * DM * 2);
    p.slotB = take((size_t)NT * 512 * 4);
    p.slotC = (bf16_t*)take((size_t)NT * 1024 * 2);
    p.slotD = (bf16_t*)take((size_t)NT * 2048 * 2);
    p.slotE = (bf16_t*)take((size_t)NT * NH * 96 * 2);
    p.slotF = (bf16_t*)take((size_t)512 * NT * 2);
    p.slotG = (bf16_t*)take((size_t)NT * 512 * 2);
    if (off > ws_size) { fprintf(stderr, "workspace too small: need %zu have %zu\n", off, ws_size); return; }
#if MK_LAUNCHES == 1
    static int grid_blocks = 0;
    if (!grid_blocks) { int dev = 0, cus = 0, per_cu = 0; hipGetDevice(&dev); hipDeviceGetAttribute(&cus, hipDeviceAttributeMultiprocessorCount, dev);
        hipOccupancyMaxActiveBlocksPerMultiprocessor(&per_cu, k_mega, 256, LDS_BYTES); if (per_cu > 2) per_cu = 2; grid_blocks = cus * per_cu; }
    (void)hipMemsetAsync(p.bar, 0, (XCD_BAR_WORDS + 64) * 4, stream);
    void* args[] = {&p};
    hipError_t e = hipLaunchCooperativeKernel((void*)k_mega, dim3(grid_blocks), dim3(256), args, LDS_BYTES, stream);
    if (e != hipSuccess) fprintf(stderr, "cooperative launch failed: %s (grid %d)\n", hipGetErrorString(e), grid_blocks);
#else
    for (int ph = 0; ph < 12; ++ph) k_phase<<<2048, 256, LDS_BYTES, stream>>>(p, ph);
#endif
}
```

```cpp
#include <hip/hip_runtime.h>
#include <hip/hip_cooperative_groups.h>
#include <cstdint>
#include <cstdio>
namespace cg = cooperative_groups;

#ifndef ATT_SGB
#define ATT_SGB 1
#endif
#ifndef PROBE
#define PROBE 0
#endif
#ifndef MK_LAUNCHES
#define MK_LAUNCHES 1
#endif

typedef unsigned short bf16_t;
constexpr int NT = 16384, SEQ = 8192, DM = 1024, NBATCH = 2;
constexpr int ZC = 3488;
constexpr int ZP = 3584;
constexpr int NH = 8;
constexpr float EPS = 1e-6f;
constexpr int NE = 32;
#define WQ_CTR(bar, k) ((bar) + 3456 + 64 + 16 * (k))
constexpr int LDS_MAIN_ = 64 * 1024;
constexpr int LDS_TAB_ = 64 * 1024 + 16;

struct P {
    const float* x; const int* pos; const float* g_attn; const float* w_in; const float* g_cq; const float* w_uq;
    const float* g_ckv; const float* w_uk; const float* w_uv; const float* w_o_attn; const float* sgu_gain; const float* sgu_bias;
    const float* w_sp; const float* b_sp; const float* w_o_sgu; const float* w_out; const float* g_ffn; const float* w_rg;
    const float* b_rg; const float* w_re; const float* b_re; const float* w_eg; const float* w_eu; const float* w_ed; const float* g_final;
    float* out;
    unsigned* bar;
    int* cnt;
    bf16_t* WinT;
    bf16_t* WuqT;
    bf16_t* WukT;
    bf16_t* WuvT;
    bf16_t* WoaT;
    bf16_t* WosT;
    bf16_t* WoutT;
    bf16_t* Wsp;
    float* cs;
    bf16_t* cqn;
    bf16_t* ckvn;
    int* list;
    float* aw;
    int* aexp;
    bf16_t* slotA;
    unsigned char* slotB;
    bf16_t* slotC;
    bf16_t* slotD;
    bf16_t* slotE;
    bf16_t* slotF;
    bf16_t* slotG;
};

__device__ __forceinline__ int opaque_tid() { int t = threadIdx.x; asm volatile("" : "+v"(t)); return t; }
__device__ __forceinline__ float bf2f(bf16_t v) { return __uint_as_float(((unsigned)v) << 16); }
__device__ __forceinline__ bf16_t f2bf(float f) { unsigned u = __float_as_uint(f); u += 0x7fffu + ((u >> 16) & 1u); return (bf16_t)(u >> 16); }
__device__ __forceinline__ float dot8(const uint4 a, const uint4 b) {
    float s = 0.f;
    s += __uint_as_float(a.x << 16) * __uint_as_float(b.x << 16) + __uint_as_float(a.x & 0xffff0000u) * __uint_as_float(b.x & 0xffff0000u);
    s += __uint_as_float(a.y << 16) * __uint_as_float(b.y << 16) + __uint_as_float(a.y & 0xffff0000u) * __uint_as_float(b.y & 0xffff0000u);
    s += __uint_as_float(a.z << 16) * __uint_as_float(b.z << 16) + __uint_as_float(a.z & 0xffff0000u) * __uint_as_float(b.z & 0xffff0000u);
    s += __uint_as_float(a.w << 16) * __uint_as_float(b.w << 16) + __uint_as_float(a.w & 0xffff0000u) * __uint_as_float(b.w & 0xffff0000u);
    return s;
}
__device__ __forceinline__ float wsum(float v) { for (int o = 32; o > 0; o >>= 1) v += __shfl_xor(v, o); return v; }

#define DPP_F(v, ctrl) __builtin_bit_cast(float, __builtin_amdgcn_update_dpp(0, __builtin_bit_cast(int, (v)), (ctrl), 0xF, 0xF, true))
__device__ __forceinline__ float xrows(float v) {
    { const auto r = __builtin_amdgcn_permlane16_swap(__float_as_uint(v), __float_as_uint(v), false, false); v = __uint_as_float(r[0]) + __uint_as_float(r[1]); }
    { const auto r = __builtin_amdgcn_permlane32_swap(__float_as_uint(v), __float_as_uint(v), false, false); v = __uint_as_float(r[0]) + __uint_as_float(r[1]); }
    return v;
}
__device__ __forceinline__ float wsumf(float v) {
    v += DPP_F(v, 0xB1); v += DPP_F(v, 0x4E); v += DPP_F(v, 0x141); v += DPP_F(v, 0x140); return xrows(v);
}
__device__ __forceinline__ float wsum_par(float v) {
    v += DPP_F(v, 0x128); v += DPP_F(v, 0x124); v += DPP_F(v, 0x122); return xrows(v);
}
__device__ __forceinline__ float wmax(float v) { for (int o = 32; o > 0; o >>= 1) v = fmaxf(v, __shfl_xor(v, o)); return v; }
__device__ __forceinline__ float fsigmoid(float v) { return __builtin_amdgcn_rcpf(1.f + __builtin_amdgcn_exp2f(-1.4426950408889634f * v)); }
__device__ __forceinline__ float fgelu(float v) { const float u2 = 1.5957691216057308f * (v + 0.044715f * v * v * v); return v * fsigmoid(u2); }
__device__ __forceinline__ float gelu_tanh(float v) { const float u = 0.7978845608028654f * (v + 0.044715f * v * v * v); const float t = 1.f - 2.f / (__expf(2.f * u) + 1.f); return 0.5f * v * (1.f + t); }
__device__ __forceinline__ float sigmoidf_(float v) { return 1.f / (1.f + __expf(-v)); }

#define LAS __attribute__((address_space(3)))
typedef short bf16x8 __attribute__((ext_vector_type(8)));
typedef float f32x4 __attribute__((ext_vector_type(4)));
constexpr int GEMM_LDS = 65536;
typedef float f32x16 __attribute__((ext_vector_type(16)));
typedef unsigned u32x2 __attribute__((ext_vector_type(2)));
typedef unsigned u32x4 __attribute__((ext_vector_type(4)));
typedef __bf16 bf16v2 __attribute__((ext_vector_type(2)));
typedef float f32v2 __attribute__((ext_vector_type(2)));
__device__ __forceinline__ unsigned pk2(float lo, float hi) { const f32v2 v = {lo, hi}; return __builtin_bit_cast(unsigned, __builtin_convertvector(v, bf16v2)); }
__device__ __forceinline__ f32x4 bf4(const uint2 u) { return (f32x4){__uint_as_float(u.x << 16), __uint_as_float(u.x & 0xffff0000u), __uint_as_float(u.y << 16), __uint_as_float(u.y & 0xffff0000u)}; }


template <class F>
__device__ __forceinline__ int tconv(bf16_t* dst, int R, int K, F f, int base, int bid, int nb, float* sm) {
    const int tid = opaque_tid(), tk = K / 64, ntile = (R / 64) * tk;
    for (int tile = ((bid - base) % nb + nb) % nb; tile < ntile; tile += nb) {
        const int rho0 = (tile / tk) * 64, k0 = (tile % tk) * 64;
#pragma unroll
        for (int i = 0; i < 16; ++i) { const int kk = (tid >> 6) + 4 * i, rr = tid & 63; sm[kk * 65 + rr] = f(k0 + kk, rho0 + rr); }
        __syncthreads();
#pragma unroll
        for (int i = 0; i < 8; ++i) { const int rr = (tid >> 5) + 8 * i, kk = (tid & 31) * 2;
            *(unsigned*)(dst + (size_t)(rho0 + rr) * K + k0 + kk) = pk2(sm[kk * 65 + rr], sm[(kk + 1) * 65 + rr]); }
        __syncthreads();
    }
    return base + ntile;
}

__device__ __forceinline__ void phase0(const P& p, int bid, int nb, float* sm) {
    const int tid = opaque_tid(), lane = tid & 63, wid = tid >> 6;
    const size_t gtid = (size_t)bid * 256 + tid, gsz = (size_t)nb * 256;
    if (bid == 0 && tid < NE) p.cnt[tid] = 0;
    { int t = bid * 4 + wid; f32x4 v[4];
      if (t < NT) {
#pragma unroll
          for (int i = 0; i < 4; ++i) v[i] = *(const f32x4*)(p.x + (size_t)t * DM + (lane + 64 * i) * 4); }
      for (; t < NT; t += nb * 4) {
          const int tn = t + nb * 4; f32x4 vn[4];
          if (tn < NT) {
#pragma unroll
              for (int i = 0; i < 4; ++i) vn[i] = *(const f32x4*)(p.x + (size_t)tn * DM + (lane + 64 * i) * 4); }
          float ss = 0.f;
#pragma unroll
          for (int i = 0; i < 4; ++i) ss += v[i][0] * v[i][0] + v[i][1] * v[i][1] + v[i][2] * v[i][2] + v[i][3] * v[i][3];
          ss = wsumf(ss); const float r = rsqrtf(ss * (1.f / DM) + EPS);
          bf16_t* hr = p.slotA + (size_t)t * DM;
#pragma unroll
          for (int i = 0; i < 4; ++i) { uint2 o; o.x = pk2(v[i][0] * r, v[i][1] * r); o.y = pk2(v[i][2] * r, v[i][3] * r); *(uint2*)(hr + (lane + 64 * i) * 4) = o; }
#pragma unroll
          for (int i = 0; i < 4; ++i) v[i] = vn[i];
      } }
    int base = 0;
    base = tconv(p.WinT, ZP, DM, [&](int k, int rho) { float v = 0.f;
        if (rho < 416) v = p.w_in[(size_t)k * ZC + rho]; else if (rho >= 512) v = p.w_in[(size_t)k * ZC + rho - 96];
        return v * p.g_attn[k]; }, base, bid, nb, sm);
    const float qscale = 0.10206207261596575f * 1.4426950408889634f;
    base = tconv(p.WuqT, 768, 256, [&](int k, int rho) { int col;
        if (rho < 512) col = (rho >> 6) * 96 + (rho & 63); else { const int hh = (rho - 512) >> 5, w = (rho - 512) & 31; col = hh * 96 + 64 + (w >> 1) + 16 * (w & 1); }
        return p.w_uq[(size_t)k * 768 + col] * p.g_cq[k] * qscale; }, base, bid, nb, sm);
    base = tconv(p.WukT, 512, 128, [&](int k, int c) { return p.w_uk[(size_t)k * 512 + c] * p.g_ckv[k]; }, base, bid, nb, sm);
    base = tconv(p.WuvT, 512, 128, [&](int k, int c) { return p.w_uv[(size_t)k * 512 + c] * p.g_ckv[k]; }, base, bid, nb, sm);
    base = tconv(p.WoaT, 1024, 512, [&](int k, int n) { return p.w_o_attn[(size_t)k * 1024 + n]; }, base, bid, nb, sm);
    base = tconv(p.WosT, 1024, 512, [&](int k, int n) { return p.w_o_sgu[(size_t)k * 1024 + n]; }, base, bid, nb, sm);
    base = tconv(p.WoutT, 1024, 1024, [&](int k, int n) { return p.w_out[(size_t)k * 1024 + n]; }, base, bid, nb, sm);
    for (size_t i = gtid; i < (size_t)8 * 128 * 128; i += gsz) { const int j = (int)(i & 127), ii = (int)((i >> 7) & 127);
        p.Wsp[i] = ((j >> 6) <= (ii >> 6)) ? f2bf(p.w_sp[i]) : (bf16_t)0; }
}

template <class Epi>
__device__ void ngemm(const bf16_t* A, int lda, const bf16_t* Bt, int ldb, int M, int N, int K, Epi epi, int bid, int nb, float* sm) {
    float* As = sm; float* Bs = sm + 16 * 68;
    const int tid = opaque_tid(), ty = tid >> 4, tx = tid & 15; const int tn = N / 64, ntile = (M / 64) * tn;
    for (int tile = bid; tile < ntile; tile += nb) {
        const int row0 = (tile / tn) * 64, col0 = (tile % tn) * 64;
        float acc[4][4];
#pragma unroll
        for (int i = 0; i < 4; ++i)
#pragma unroll
            for (int j = 0; j < 4; ++j) acc[i][j] = 0.f;
        for (int k0 = 0; k0 < K; k0 += 16) {
#pragma unroll
            for (int i = 0; i < 4; ++i) { const int idx = tid + i * 256, r = idx >> 4, kk = idx & 15;
                As[kk * 68 + r] = bf2f(A[(size_t)(row0 + r) * lda + k0 + kk]);
                Bs[kk * 68 + r] = bf2f(Bt[(size_t)(col0 + r) * ldb + k0 + kk]); }
            __syncthreads();
#pragma unroll
            for (int kk = 0; kk < 16; ++kk) { float a[4], b[4];
#pragma unroll
                for (int i = 0; i < 4; ++i) { a[i] = As[kk * 68 + ty * 4 + i]; b[i] = Bs[kk * 68 + tx * 4 + i]; }
#pragma unroll
                for (int i = 0; i < 4; ++i)
#pragma unroll
                    for (int j = 0; j < 4; ++j) acc[i][j] += a[i] * b[j]; }
            __syncthreads();
        }
#pragma unroll
        for (int i = 0; i < 4; ++i) epi(row0 + ty * 4 + i, col0 + tx * 4, acc[i]);
    }
}


__device__ __forceinline__ bool tile_of(int it, int bid, int nb, int RT, int CT, int& rt, int& ct) {
    if ((RT & 31) == 0 && (nb & 7) == 0) {
        const int x = bid & 7, l = bid >> 3, nl = nb >> 3, rpx = RT >> 3; const int lt = l + it * nl; if (lt >= rpx * CT) return false;
        const int rg = lt / (4 * CT), w = lt % (4 * CT); rt = x * rpx + rg * 4 + (w & 3); ct = w >> 2; return true;
    }
    const int tile = bid + it * nb; if (tile >= RT * CT) return false; rt = tile / CT; ct = tile % CT; return true;
}
struct GOps { const bf16_t* a0; const bf16_t* a1; const bf16_t* a2; const bf16_t* a3; const bf16_t* bp; size_t bstep; };
__device__ __forceinline__ GOps gops(const bf16_t* ap, size_t astep, const bf16_t* bp, size_t bstep) { GOps g; g.a0 = ap; g.a1 = ap + astep; g.a2 = ap + 2 * astep; g.a3 = ap + 3 * astep; g.bp = bp; g.bstep = bstep; return g; }
__device__ __forceinline__ void mg_stage(const GOps& g, int t, LAS unsigned char* lds, int widu) {
    LAS unsigned char* d = lds + (t & 1) * 32768 + widu * 1024; const int k0 = t * 64;
    __builtin_amdgcn_global_load_lds((const unsigned*)(g.a0 + k0), (LAS unsigned*)(d), 16, 0, 0);
    __builtin_amdgcn_global_load_lds((const unsigned*)(g.a1 + k0), (LAS unsigned*)(d + 4096), 16, 0, 0);
    __builtin_amdgcn_global_load_lds((const unsigned*)(g.a2 + k0), (LAS unsigned*)(d + 8192), 16, 0, 0);
    __builtin_amdgcn_global_load_lds((const unsigned*)(g.a3 + k0), (LAS unsigned*)(d + 12288), 16, 0, 0);
#pragma unroll
    for (int i = 0; i < 4; ++i) __builtin_amdgcn_global_load_lds((const unsigned*)(g.bp + i * g.bstep + k0), (LAS unsigned*)(d + 16384 + i * 4096), 16, 0, 0);
}
__device__ __forceinline__ void mg_kloop_p(f32x4 (&acc)[4][4], const GOps& g, int nk, LAS unsigned char* lds, bool prestaged, bool has_next, const GOps& nxt) {
    const int tid = opaque_tid(), lane = tid & 63, wid = tid >> 6, wr = wid >> 1, wc = wid & 1, fr = lane & 15, fq = lane >> 4;
    const int widu = __builtin_amdgcn_readfirstlane(wid);
    if (!prestaged) mg_stage(g, 0, lds, widu);
    const int pc0 = ((fq) ^ (fr & 7)) * 16, pc1 = ((4 + fq) ^ (fr & 7)) * 16;
    for (int t = 0; t < nk; ++t) {
        asm volatile("s_waitcnt vmcnt(0)" ::: "memory");
        __syncthreads();
        if (t + 1 < nk) mg_stage(g, t + 1, lds, widu); else if (has_next) mg_stage(nxt, 0, lds, widu);
        const LAS unsigned char* ab = lds + (t & 1) * 32768 + (wr * 64 + fr) * 128; const LAS unsigned char* bb = lds + (t & 1) * 32768 + 16384 + (wc * 64 + fr) * 128;
        bf16x8 af[2][4], bfr[2][4];
#pragma unroll
        for (int m = 0; m < 4; ++m) { af[0][m] = *(const LAS bf16x8*)(ab + m * 2048 + pc0); bfr[0][m] = *(const LAS bf16x8*)(bb + m * 2048 + pc0); }
#pragma unroll
        for (int m = 0; m < 4; ++m) { af[1][m] = *(const LAS bf16x8*)(ab + m * 2048 + pc1); bfr[1][m] = *(const LAS bf16x8*)(bb + m * 2048 + pc1); }
        __builtin_amdgcn_sched_barrier(0);
#pragma unroll
        for (int ks = 0; ks < 2; ++ks)
#pragma unroll
            for (int m = 0; m < 4; ++m)
#pragma unroll
                for (int n = 0; n < 4; ++n) acc[m][n] = __builtin_amdgcn_mfma_f32_16x16x32_bf16(bfr[ks][n], af[ks][m], acc[m][n], 0, 0, 0);
    }
}
template <class Epi>
__device__ __forceinline__ void mgemm(const bf16_t* A, int lda, const bf16_t* Bt, int ldb, int M, int N, int K, Epi epi, int bid, int nb, LAS unsigned char* lds) {
    const int tid = opaque_tid(), lane = tid & 63, wid = tid >> 6, wr = wid >> 1, wc = wid & 1, fr = lane & 15, fq = lane >> 4;
    const int RT = M / 128, CT = N / 128; const int c8 = ((tid & 7) ^ ((tid >> 3) & 7)) * 8;
    int rt, ct; bool have = tile_of(0, bid, nb, RT, CT, rt, ct);
    GOps cur = gops(A + (size_t)(rt * 128 + (tid >> 3)) * lda + c8, (size_t)32 * lda, Bt + (size_t)(ct * 128 + (tid >> 3)) * ldb + c8, (size_t)32 * ldb);
    for (int it = 0; have; ++it) {
        const int row0 = rt * 128, col0 = ct * 128;
        int rt2, ct2; const bool have2 = tile_of(it + 1, bid, nb, RT, CT, rt2, ct2);
        const GOps nxt = gops(A + (size_t)((have2 ? rt2 : rt) * 128 + (tid >> 3)) * lda + c8, (size_t)32 * lda, Bt + (size_t)((have2 ? ct2 : ct) * 128 + (tid >> 3)) * ldb + c8, (size_t)32 * ldb);
        f32x4 acc[4][4];
#pragma unroll
        for (int m = 0; m < 4; ++m)
#pragma unroll
            for (int n = 0; n < 4; ++n) acc[m][n] = (f32x4){0.f, 0.f, 0.f, 0.f};
        mg_kloop_p(acc, cur, K / 64, lds, it > 0, have2, nxt);
#pragma unroll
        for (int m = 0; m < 4; ++m)
#pragma unroll
            for (int n = 0; n < 4; ++n) epi(row0 + wr * 64 + m * 16 + fr, col0 + wc * 64 + n * 16 + fq * 4, acc[m][n]);
        cur = nxt; rt = rt2; ct = ct2; have = have2;
    }
    __syncthreads();
}


__device__ __forceinline__ void stg_put(LAS unsigned char* S, int r, int c4, const uint2 v) { const u32x2 w = {v.x, v.y};
    *(LAS u32x2*)(S + r * 256 + (((c4 >> 3) ^ (r & 15)) << 4) + ((c4 & 4) << 1)) = w; }
__device__ __forceinline__ void stg_put32(LAS unsigned char* S, int r, int c2, const unsigned v) {
    *(LAS unsigned*)(S + r * 256 + (((c2 >> 3) ^ (r & 15)) << 4) + ((c2 & 7) << 1)) = v; }
template <int SEG, class D>
__device__ __forceinline__ void stg_flush(LAS unsigned char* S, D dst) {
    const int tid = threadIdx.x, lane = tid & 63, wid = tid >> 6;
#pragma unroll
    for (int it = 0; it < 8; ++it) { const int r = wid * 32 + it * 4 + (lane >> 4), cc = lane & 15;
        const u32x4 v = *(const LAS u32x4*)(S + r * 256 + ((cc ^ (r & 15)) << 4));
        bf16_t* d = dst(r, cc / (SEG / 8));
        if (d) *(u32x4*)(d + (cc % (SEG / 8)) * 8) = v; }
}
template <int SEG, class Val, class Dst>
__device__ __forceinline__ void mgemm_st(const bf16_t* A, int lda, const bf16_t* Bt, int ldb, int M, int N, int K, Val val, Dst dst, int bid, int nb, LAS unsigned char* lds) {
    const int tid = opaque_tid(), lane = tid & 63, wid = tid >> 6, wr = wid >> 1, wc = wid & 1, fr = lane & 15, fq = lane >> 4;
    const int RT = M / 128, CT = N / 128; const int c8 = ((tid & 7) ^ ((tid >> 3) & 7)) * 8;
    LAS unsigned char* S = lds + 32768;
    int rt, ct; bool have = tile_of(0, bid, nb, RT, CT, rt, ct);
    GOps cur = gops(A + (size_t)(rt * 128 + (tid >> 3)) * lda + c8, (size_t)32 * lda, Bt + (size_t)(ct * 128 + (tid >> 3)) * ldb + c8, (size_t)32 * ldb);
    for (int it = 0; have; ++it) {
        const int row0 = rt * 128, col0 = ct * 128;
        int rt2, ct2; const bool have2 = tile_of(it + 1, bid, nb, RT, CT, rt2, ct2);
        const GOps nxt = gops(A + (size_t)((have2 ? rt2 : rt) * 128 + (tid >> 3)) * lda + c8, (size_t)32 * lda, Bt + (size_t)((have2 ? ct2 : ct) * 128 + (tid >> 3)) * ldb + c8, (size_t)32 * ldb);
        f32x4 acc[4][4];
#pragma unroll
        for (int m = 0; m < 4; ++m)
#pragma unroll
            for (int n = 0; n < 4; ++n) acc[m][n] = (f32x4){0.f, 0.f, 0.f, 0.f};
        mg_kloop_p(acc, cur, K / 64, lds, it > 0, have2, nxt);
        __syncthreads();
#pragma unroll
        for (int m = 0; m < 4; ++m)
#pragma unroll
            for (int n = 0; n < 4; ++n) { const int r = wr * 64 + m * 16 + fr, c = wc * 64 + n * 16 + fq * 4; stg_put(S, r, c, val(row0 + r, col0 + c, acc[m][n])); }
        __syncthreads();
        stg_flush<SEG>(S, [&](int r, int seg) __attribute__((always_inline)) { return dst(row0, col0, r, seg); });
        cur = nxt; rt = rt2; ct = ct2; have = have2;
    }
    __syncthreads();
}

__device__ __forceinline__ void phase1(const P& p, int bid, int nb, LAS unsigned char* sm) {
    bf16_t* zs = (bf16_t*)p.slotB; bf16_t* uvg = p.slotC; bf16_t* gates = p.slotD;
    mgemm_st<128>(p.slotA, DM, p.WinT, DM, NT, ZP, DM, [=](int t, int c, const f32x4& v) { uint2 o;
        if (c < 512) { o.x = pk2(v[0], v[1]); o.y = pk2(v[2], v[3]); }
        else if (c < 1536) { o.x = pk2(fgelu(v[0]), fgelu(v[1])); o.y = pk2(fgelu(v[2]), fgelu(v[3])); }
        else { o.x = pk2(fsigmoid(v[0]), fsigmoid(v[1])); o.y = pk2(fsigmoid(v[2]), fsigmoid(v[3])); }
        return o;
    }, [=](int row0, int col0, int r, int) -> bf16_t* { const size_t t = (size_t)(row0 + r);
        if (col0 < 512) return zs + t * 512 + col0; if (col0 < 1536) return uvg + t * 1024 + (col0 - 512); return gates + t * 2048 + (col0 - 1536);
    }, bid, nb, sm);
}

__device__ __forceinline__ void phase2a(const P& p, int bid, int nb, bool dry) {
    const int tid = opaque_tid(), lane = tid & 63, wid = tid >> 6;
    const bf16_t* zs = (const bf16_t*)p.slotB; bf16_t* K = p.slotE; bf16_t* uvg = p.slotC;
    const f32x4 gn0 = *(const f32x4*)(p.sgu_gain + lane * 8), gn1 = *(const f32x4*)(p.sgu_gain + lane * 8 + 4);
    const f32x4 bs0 = *(const f32x4*)(p.sgu_bias + lane * 8), bs1 = *(const f32x4*)(p.sgu_bias + lane * 8 + 4);
    const int hd = lane >> 3, j = lane & 7, i4 = 4 * (j & 3);
    struct In { uint2 cq, ck, k1, k2; uint4 v; int pos; };
    auto ld = [&](int t) __attribute__((always_inline)) { In r; const bf16_t* z = zs + (size_t)t * 512;
        r.cq = *(const uint2*)(z + lane * 4); r.ck = *(const uint2*)(z + 256 + (lane & 31) * 4); r.k1 = *(const uint2*)(z + 384 + i4); r.k2 = *(const uint2*)(z + 400 + i4);
        r.v = *(const uint4*)(uvg + (size_t)t * 1024 + 512 + lane * 8); r.pos = p.pos[t]; return r; };
    int t = bid * 4 + wid; In cur; if (t < NT) cur = ld(t);
    for (; t < NT; t += nb * 4) {
        const int tn = t + nb * 4; In nxt = cur; if (tn < NT) nxt = ld(tn);
        const f32x4 cq = bf4(cur.cq), ck = bf4(cur.ck);
        bf16_t* vr = uvg + (size_t)t * 1024 + 512 + lane * 8;
        { const float ss = wsumf(cq[0] * cq[0] + cq[1] * cq[1] + cq[2] * cq[2] + cq[3] * cq[3]); const float r = rsqrtf(ss * (1.f / 256.f) + EPS);
          uint2 o; o.x = pk2(cq[0] * r, cq[1] * r); o.y = pk2(cq[2] * r, cq[3] * r); *(uint2*)(p.cqn + (size_t)t * 256 + lane * 4) = o; }
        { const float ss = wsumf(lane < 32 ? ck[0] * ck[0] + ck[1] * ck[1] + ck[2] * ck[2] + ck[3] * ck[3] : 0.f); const float r = rsqrtf(ss * (1.f / 128.f) + EPS);
          if (lane < 32) { uint2 o; o.x = pk2(ck[0] * r, ck[1] * r); o.y = pk2(ck[2] * r, ck[3] * r); *(uint2*)(p.ckvn + (size_t)t * 128 + lane * 4) = o; } }
        { const int b = t >> 13, sq = t & 8191; const float posf = (float)cur.pos; const f32x4 k1 = bf4(cur.k1), k2 = bf4(cur.k2); float val[4], tab[4];
#pragma unroll
          for (int q = 0; q < 4; ++q) { const int i = i4 + q;
              float f = q == 0 ? 1.0f : q == 1 ? 0.5623413251903491f : q == 2 ? 0.31622776601683794f : 0.1778279410038923f;
              const int q4 = i >> 2; f *= (q4 == 0 ? 1.0f : q4 == 1 ? 0.1f : q4 == 2 ? 0.01f : 0.001f);
              const float ang = posf * f; const double rev = (double)ang * 0.15915494309189535; const float frc = (float)(rev - floor(rev));
              const float sn = __builtin_amdgcn_sinf(frc), cn = __builtin_amdgcn_cosf(frc);
              val[q] = (j < 4) ? (k1[q] * cn - k2[q] * sn) : (k1[q] * sn + k2[q] * cn); tab[q] = (j < 4) ? cn : sn; }
          uint2 o; o.x = pk2(val[0], val[1]); o.y = pk2(val[2], val[3]);
          *(uint2*)(K + ((size_t)(b * NH + hd) * SEQ + sq) * 96 + 64 + 4 * j) = o;
          if (hd == 0) *(f32x4*)(p.cs + (size_t)t * 32 + 4 * j) = (f32x4){tab[0], tab[1], tab[2], tab[3]}; }
        { float v[8]; const unsigned w[4] = {cur.v.x, cur.v.y, cur.v.z, cur.v.w};
#pragma unroll
          for (int i = 0; i < 4; ++i) { v[2 * i] = __uint_as_float(w[i] << 16); v[2 * i + 1] = __uint_as_float(w[i] & 0xffff0000u); }
          float sm_ = 0.f;
#pragma unroll
          for (int i = 0; i < 8; ++i) sm_ += v[i];
          sm_ = wsumf(sm_); const float mu = sm_ * (1.f / 512.f); float q = 0.f;
#pragma unroll
          for (int i = 0; i < 8; ++i) { const float d = v[i] - mu; q += d * d; }
          q = wsumf(q); const float r = rsqrtf(q * (1.f / 512.f) + EPS);
          uint4 o;
          o.x = pk2((v[0] - mu) * r * gn0[0] + bs0[0], (v[1] - mu) * r * gn0[1] + bs0[1]); o.y = pk2((v[2] - mu) * r * gn0[2] + bs0[2], (v[3] - mu) * r * gn0[3] + bs0[3]);
          o.z = pk2((v[4] - mu) * r * gn1[0] + bs1[0], (v[5] - mu) * r * gn1[1] + bs1[1]); o.w = pk2((v[6] - mu) * r * gn1[2] + bs1[2], (v[7] - mu) * r * gn1[3] + bs1[3]);
          *(uint4*)(dry ? p.slotG + (size_t)t * 512 + lane * 8 : vr) = o; }
        cur = nxt;
    }
}

__device__ __forceinline__ void phase2b(const P& p, int bid, int nb, LAS unsigned char* sm) {
    bf16_t* Q = p.slotA; bf16_t* K = p.slotE; bf16_t* VT = p.slotF; const float* cs = p.cs;
    mgemm(p.cqn, 256, p.WuqT, 256, NT, 768, 256, [=](int t, int c, const f32x4& v) {
        const int b = t >> 13, s = t & 8191;
        if (c < 512) { const int h = c >> 6, d = c & 63; uint2 o; o.x = pk2(v[0], v[1]); o.y = pk2(v[2], v[3]); *(uint2*)(Q + ((size_t)(b * NH + h) * SEQ + s) * 96 + d) = o; }
        else { const int h = (c - 512) >> 5, i0 = ((c - 512) & 31) >> 1; bf16_t* q = Q + ((size_t)(b * NH + h) * SEQ + s) * 96;
            const float2 cn = *(const float2*)(cs + (size_t)t * 32 + i0), sn = *(const float2*)(cs + (size_t)t * 32 + 16 + i0);
            *(unsigned*)(q + 64 + i0) = pk2(v[0] * cn.x - v[1] * sn.x, v[2] * cn.y - v[3] * sn.y);
            *(unsigned*)(q + 80 + i0) = pk2(v[0] * sn.x + v[1] * cn.x, v[2] * sn.y + v[3] * cn.y); }
    }, bid, nb, sm);
    mgemm_st<64>(p.ckvn, 128, p.WukT, 128, NT, 512, 128, [=](int, int, const f32x4& v) { uint2 o; o.x = pk2(v[0], v[1]); o.y = pk2(v[2], v[3]); return o; },
        [=](int row0, int col0, int r, int seg) -> bf16_t* { const int t = row0 + r, b = t >> 13, s = t & 8191, h = (col0 >> 6) + seg; return K + ((size_t)(b * NH + h) * SEQ + s) * 96; }, bid, nb, sm);
    mgemm_st<128>(p.WuvT, 128, p.ckvn, 128, 512, NT, 128, [=](int, int, const f32x4& v) { uint2 o; o.x = pk2(v[0], v[1]); o.y = pk2(v[2], v[3]); return o; },
        [=](int row0, int col0, int r, int) -> bf16_t* { return VT + (size_t)(row0 + r) * NT + col0; }, bid, nb, sm);
}

__device__ __forceinline__ void phase2c(const P& p, int bid, int nb) {
    const bf16_t* uvg = p.slotC; bf16_t* su = p.slotG;
    for (size_t i = (size_t)bid * 256 + threadIdx.x; i < (size_t)NT * 512; i += (size_t)nb * 256) {
        const int t = (int)(i >> 9), c = (int)(i & 511), g = c >> 6, ii = t & 127, t0 = t - ii;
        const bf16_t* w = p.Wsp + ((size_t)g * 128 + ii) * 128; float s = 0.f;
        for (int j = 0; j < 128; ++j) s += bf2f(w[j]) * bf2f(uvg[(size_t)(t0 + j) * 1024 + 512 + c]);
        s += p.b_sp[g * 128 + ii];
        su[i] = f2bf(bf2f(uvg[(size_t)t * 1024 + c]) * s);
    }
}


__device__ __forceinline__ void phase2c_m(const P& p, int bid, int nb, LAS unsigned char* lds) {
    const bf16_t* uvg = p.slotC; bf16_t* su = p.slotG;
    const int tid = opaque_tid(), lane = tid & 63, wid = tid >> 6, fr = lane & 15, fq = lane >> 4;
    const int c8 = ((tid & 7) ^ ((tid >> 3) & 7)) * 8;
    for (int u = bid; u < 1024; u += nb) {
        const int g = u & 7, t0 = (u >> 3) * 128;
        { const bf16_t* wp = p.Wsp + ((size_t)g * 128 + (tid >> 3)) * 128 + c8; LAS unsigned char* d = lds + tid * 16;
#pragma unroll
          for (int ks = 0; ks < 2; ++ks)
#pragma unroll
              for (int i = 0; i < 4; ++i) __builtin_amdgcn_global_load_lds((const unsigned*)(wp + (size_t)i * 32 * 128 + ks * 64), (LAS unsigned*)(d + ks * 16384 + i * 4096), 16, 0, 0); }
#pragma unroll
        for (int i = 0; i < 4; ++i) { const int q = tid + 256 * i, j = q >> 3, c0 = (q & 7) * 8;
            const uint4 v = *(const uint4*)(uvg + (size_t)(t0 + j) * 1024 + 512 + g * 64 + c0);
            const unsigned w[4] = {v.x, v.y, v.z, v.w};
            LAS unsigned char* bimg = lds + 32768 + (j >> 6) * 8192 + (j & 7) * 2; const int lc = (j & 63) >> 3;
#pragma unroll
            for (int e = 0; e < 8; ++e) { const int row = c0 + e; const bf16_t val = (bf16_t)((e & 1) ? (w[e >> 1] >> 16) : (w[e >> 1] & 0xffffu));
                *(LAS bf16_t*)(bimg + row * 128 + ((lc ^ (row & 7)) * 16)) = val; } }
        asm volatile("s_waitcnt vmcnt(0)" ::: "memory");
        __syncthreads();
        f32x4 acc[2][4];
#pragma unroll
        for (int m = 0; m < 2; ++m)
#pragma unroll
            for (int n = 0; n < 4; ++n) acc[m][n] = (f32x4){0.f, 0.f, 0.f, 0.f};
#pragma unroll
        for (int ks = 0; ks < 2; ++ks)
#pragma unroll
            for (int k2 = 0; k2 < 2; ++k2) { const int pc = ((k2 * 4 + fq) ^ (fr & 7)) * 16; bf16x8 af[2], bfr[4];
#pragma unroll
                for (int m = 0; m < 2; ++m) af[m] = *(const LAS bf16x8*)(lds + ks * 16384 + (wid * 32 + m * 16 + fr) * 128 + pc);
#pragma unroll
                for (int n = 0; n < 4; ++n) bfr[n] = *(const LAS bf16x8*)(lds + 32768 + ks * 8192 + (n * 16 + fr) * 128 + pc);
#pragma unroll
                for (int m = 0; m < 2; ++m)
#pragma unroll
                    for (int n = 0; n < 4; ++n) acc[m][n] = __builtin_amdgcn_mfma_f32_16x16x32_bf16(bfr[n], af[m], acc[m][n], 0, 0, 0); }
#pragma unroll
        for (int m = 0; m < 2; ++m) { const int i = wid * 32 + m * 16 + fr; const float bs = p.b_sp[g * 128 + i];
#pragma unroll
            for (int n = 0; n < 4; ++n) { const int c = g * 64 + n * 16 + fq * 4;
                const uint2 uu = *(const uint2*)(uvg + (size_t)(t0 + i) * 1024 + c);
                uint2 o; o.x = pk2(__uint_as_float(uu.x << 16) * (acc[m][n][0] + bs), __uint_as_float(uu.x & 0xffff0000u) * (acc[m][n][1] + bs));
                o.y = pk2(__uint_as_float(uu.y << 16) * (acc[m][n][2] + bs), __uint_as_float(uu.y & 0xffff0000u) * (acc[m][n][3] + bs));
                *(uint2*)(su + (size_t)(t0 + i) * 512 + c) = o; } }
        __syncthreads();
    }
}

__device__ __forceinline__ void phase3(const P& p, int bid, int nb, float* sm) {
    float* sc = sm; float* qs = sm + 8192; float* red = qs + 96;
    const bf16_t* Q = p.slotA; const bf16_t* K = p.slotE; const bf16_t* VT = p.slotF; bf16_t* O = (bf16_t*)p.slotB;
    const int tid = opaque_tid();
    for (int row = bid; row < NBATCH * NH * SEQ; row += nb) {
        const int q = row % SEQ, bh = row / SEQ, nk = ((q >> 6) + 1) * 64;
        if (tid < 12) ((uint4*)qs)[tid] = ((const uint4*)(Q + ((size_t)bh * SEQ + q) * 96))[tid];
        __syncthreads();
        float mx = -1e30f;
        for (int k = tid; k < nk; k += 256) { const uint4* kp = (const uint4*)(K + ((size_t)bh * SEQ + k) * 96); float s = 0.f;
#pragma unroll
            for (int d = 0; d < 12; ++d) s += dot8(((const uint4*)qs)[d], kp[d]);
            sc[k] = s; mx = fmaxf(mx, s); }
        mx = wmax(mx); if ((tid & 63) == 0) red[tid >> 6] = mx; __syncthreads();
        mx = fmaxf(fmaxf(red[0], red[1]), fmaxf(red[2], red[3])); __syncthreads();
        float sum = 0.f;
        for (int k = tid; k < nk; k += 256) { const float e = exp2f(sc[k] - mx); sc[k] = e; sum += e; }
        sum = wsum(sum); if ((tid & 63) == 0) red[tid >> 6] = sum; __syncthreads();
        sum = (red[0] + red[1]) + (red[2] + red[3]);
        const int dv = tid >> 2, part = tid & 3, h = bh & 7, b = bh >> 3;
        const bf16_t* vp = VT + (size_t)(h * 64 + dv) * NT + (size_t)b * SEQ; float o = 0.f;
        for (int k = part; k < nk; k += 4) o += sc[k] * bf2f(vp[k]);
        o += __shfl_xor(o, 1); o += __shfl_xor(o, 2);
        if (part == 0) O[(size_t)(b * SEQ + q) * 512 + h * 64 + dv] = f2bf(o / sum);
        __syncthreads();
    }
}


constexpr int ATT_BUF = 20480;
template <int VAR>
__device__ __forceinline__ void phase3m(const P& p, int bid, int nb, LAS unsigned char* lds) {
    const bf16_t* Q = p.slotA; const bf16_t* K = p.slotE; const bf16_t* VT = p.slotF; bf16_t* O = (VAR == 0) ? (bf16_t*)p.slotB : p.slotC;
    const int tid = opaque_tid(), lane = tid & 63, wid = tid >> 6, l31 = lane & 31, hh = lane >> 5;
    int koff[3]; size_t voff[2];
#pragma unroll
    for (int i = 0; i < 3; ++i) { const int s = tid + 256 * i, r = s / 12, pc = s % 12, c = (pc + 12 - ((r >> 2) & 3)) % 12; koff[i] = r * 96 + c * 8; }
#pragma unroll
    for (int i = 0; i < 2; ++i) { const int s = tid + 256 * i, dv = s >> 3, pc = s & 7, cl = pc ^ ((dv >> 1) & 7); voff[i] = (size_t)dv * NT + cl * 8; }
    int kro[6];
#pragma unroll
    for (int ks = 0; ks < 6; ++ks) { const int v = 2 * ks + hh + ((lane >> 2) & 3); kro[ks] = (v >= 12 ? v - 12 : v) * 16; }
    const int krow = l31 * 192, vsw = (lane >> 1) & 7, vrow = l31 * 128 + 8 * hh;
    for (int iu = 0;; ++iu) {
        const int r = iu * nb + ((iu & 1) ? nb - 1 - bid : bid); if (r >= 1024) break;
        const int qb = 63 - (r >> 4), bh = r & 15, b = bh >> 3, h = bh & 7;
        const int q0 = qb * 128 + wid * 32, ntw = (q0 >> 6) + 1, nt = 2 * qb + 2;
        const bf16_t* Kb = K + (size_t)bh * SEQ * 96; const bf16_t* Vb = VT + (size_t)(h * 64) * NT + (size_t)b * SEQ;
        bf16x8 qf[6]; { const bf16_t* qp = Q + ((size_t)bh * SEQ + q0 + l31) * 96 + hh * 8;
#pragma unroll
            for (int ks = 0; ks < 6; ++ks) qf[ks] = *(const bf16x8*)(qp + ks * 16); }
        f32x16 o0, o1;
#pragma unroll
        for (int e = 0; e < 16; ++e) { o0[e] = 0.f; o1[e] = 0.f; }
        float mrun = -1e30f, lsum = 0.f;
        auto stage = [&](int j) { LAS unsigned char* d = lds + (j & 1) * ATT_BUF + tid * 16; const bf16_t* kt = Kb + (size_t)j * 64 * 96; const bf16_t* vt = Vb + j * 64;
#pragma unroll
            for (int i = 0; i < 3; ++i) __builtin_amdgcn_global_load_lds((const unsigned*)(kt + koff[i]), (LAS unsigned*)(d + i * 4096), 16, 0, 0);
#pragma unroll
            for (int i = 0; i < 2; ++i) __builtin_amdgcn_global_load_lds((const unsigned*)(vt + voff[i]), (LAS unsigned*)(d + 12288 + i * 4096), 16, 0, 0); };
        if (VAR != 3) stage(0);
        for (int j = 0; j < nt; ++j) {
            asm volatile("s_waitcnt vmcnt(0)" ::: "memory");
            __syncthreads();
            if (VAR != 3 && j + 1 < nt) stage(j + 1);
            if (j < ntw) {
                const LAS unsigned char* kb_ = lds + (j & 1) * ATT_BUF + krow; const LAS unsigned char* vb_ = lds + (j & 1) * ATT_BUF + 12288 + vrow;
                f32x16 s0, s1;
#pragma unroll
                for (int e = 0; e < 16; ++e) { s0[e] = 0.f; s1[e] = 0.f; }
#pragma unroll
                for (int ks = 0; ks < 6; ++ks) { const bf16x8 k0 = *(const LAS bf16x8*)(kb_ + kro[ks]); const bf16x8 k1 = *(const LAS bf16x8*)(kb_ + 32 * 192 + kro[ks]);
                    if (VAR != 2) { s0 = __builtin_amdgcn_mfma_f32_32x32x16_bf16(k0, qf[ks], s0, 0, 0, 0); s1 = __builtin_amdgcn_mfma_f32_32x32x16_bf16(k1, qf[ks], s1, 0, 0, 0); }
                    else { s0[ks] += __builtin_bit_cast(float, (int)k0[0]) + __builtin_bit_cast(float, (int)qf[ks][1]); s1[ks] += __builtin_bit_cast(float, (int)k1[0]); } }
                if (VAR != 1) {
                float mx = fmaxf(s0[0], s1[0]);
#pragma unroll
                for (int e = 1; e < 16; ++e) mx = fmaxf(mx, fmaxf(s0[e], s1[e]));
                mx = fmaxf(mx, __shfl_xor(mx, 32));
                const float mn = fmaxf(mrun, mx), alpha = __builtin_amdgcn_exp2f(mrun - mn); mrun = mn;
                float ps = 0.f;
#pragma unroll
                for (int e = 0; e < 16; ++e) { s0[e] = __builtin_amdgcn_exp2f(s0[e] - mn); s1[e] = __builtin_amdgcn_exp2f(s1[e] - mn); ps += s0[e] + s1[e]; }
                lsum = lsum * alpha + ps;
#pragma unroll
                for (int e = 0; e < 16; ++e) { o0[e] *= alpha; o1[e] *= alpha; }
                }
                unsigned pw[16];
#pragma unroll
                for (int e = 0; e < 8; ++e) { pw[e] = pk2(s0[2 * e], s0[2 * e + 1]); pw[8 + e] = pk2(s1[2 * e], s1[2 * e + 1]); }
#pragma unroll
                for (int s = 0; s < 4; ++s) {
                    const u32x4 pbu = {pw[4 * s], pw[4 * s + 1], pw[4 * s + 2], pw[4 * s + 3]}; const bf16x8 pb = __builtin_bit_cast(bf16x8, pbu);
                    const int c0 = ((2 * s) ^ vsw) * 16, c1 = ((2 * s + 1) ^ vsw) * 16;
                    const u32x2 a0 = *(const LAS u32x2*)(vb_ + c0), a1 = *(const LAS u32x2*)(vb_ + c1);
                    const u32x2 b0 = *(const LAS u32x2*)(vb_ + 32 * 128 + c0), b1 = *(const LAS u32x2*)(vb_ + 32 * 128 + c1);
                    const u32x4 va = {a0.x, a0.y, a1.x, a1.y}, vb = {b0.x, b0.y, b1.x, b1.y};
                    if (VAR != 2) { o0 = __builtin_amdgcn_mfma_f32_32x32x16_bf16(__builtin_bit_cast(bf16x8, va), pb, o0, 0, 0, 0);
                    o1 = __builtin_amdgcn_mfma_f32_32x32x16_bf16(__builtin_bit_cast(bf16x8, vb), pb, o1, 0, 0, 0); }
                    else { o0[s] += __builtin_bit_cast(float, va[0] ^ pbu[0]); o1[s] += __builtin_bit_cast(float, vb[1] ^ pbu[1]); }
                }
            }
        }
        const float inv = 1.f / (lsum + __shfl_xor(lsum, 32));
        bf16_t* op = O + (size_t)(b * SEQ + q0 + l31) * 512 + h * 64 + 4 * hh;
#pragma unroll
        for (int g = 0; g < 4; ++g) { uint2 w0, w1;
            w0.x = pk2(o0[4 * g] * inv, o0[4 * g + 1] * inv); w0.y = pk2(o0[4 * g + 2] * inv, o0[4 * g + 3] * inv);
            w1.x = pk2(o1[4 * g] * inv, o1[4 * g + 1] * inv); w1.y = pk2(o1[4 * g + 2] * inv, o1[4 * g + 3] * inv);
            *(uint2*)(op + 8 * g) = w0; *(uint2*)(op + 32 + 8 * g) = w1; }
        __syncthreads();
    }
}


template <int DUMMY>
__device__ __forceinline__ void phase3p(const P& p, int bid, int nb, LAS unsigned char* lds) {
    const bf16_t* Q = p.slotA; const bf16_t* K = p.slotE; const bf16_t* VT = p.slotF; bf16_t* O = (DUMMY == 0) ? (bf16_t*)p.slotB : p.slotC;
    const int tid = opaque_tid(), lane = tid & 63, wid = tid >> 6, l31 = lane & 31, hh = lane >> 5;
    constexpr float THR = 8.f;
    int koff[3]; size_t voff[2];
#pragma unroll
    for (int i = 0; i < 3; ++i) { const int s = tid + 256 * i, r = s / 12, pc = s % 12, c = (pc + 12 - ((r >> 2) & 3)) % 12; koff[i] = r * 96 + c * 8; }
#pragma unroll
    for (int i = 0; i < 2; ++i) { const int s = tid + 256 * i, dv = s >> 3, pc = s & 7, cl = pc ^ ((dv >> 1) & 7); voff[i] = (size_t)dv * NT + cl * 8; }
    int kro[6];
#pragma unroll
    for (int ks = 0; ks < 6; ++ks) { const int v = 2 * ks + hh + ((lane >> 2) & 3); kro[ks] = (v >= 12 ? v - 12 : v) * 16; }
    const int krow = l31 * 192, vsw = (lane >> 1) & 7, vrow = l31 * 128 + 8 * hh;
    for (int iu = 0;; ++iu) {
        const int r = iu * nb + ((iu & 1) ? nb - 1 - bid : bid); if (r >= 1024) break;
        const int qb = 63 - (r >> 4), bh = r & 15, b = bh >> 3, h = bh & 7;
        const int q0 = qb * 128 + wid * 32, ntw = (q0 >> 6) + 1, nt = 2 * qb + 2;
        const bf16_t* Kb = K + (size_t)bh * SEQ * 96; const bf16_t* Vb = VT + (size_t)(h * 64) * NT + (size_t)b * SEQ;
        bf16x8 qf[6]; { const bf16_t* qp = Q + ((size_t)bh * SEQ + q0 + l31) * 96 + hh * 8;
#pragma unroll
            for (int ks = 0; ks < 6; ++ks) qf[ks] = *(const bf16x8*)(qp + ks * 16); }
        f32x16 o0, o1;
#pragma unroll
        for (int e = 0; e < 16; ++e) { o0[e] = 0.f; o1[e] = 0.f; }
        float mrun = -1e30f, lsum = 0.f;
        auto stageK = [&](int j) { LAS unsigned char* d = lds + (j & 1) * 12288 + tid * 16; const bf16_t* kt = Kb + (size_t)j * 64 * 96;
#pragma unroll
            for (int i = 0; i < 3; ++i) __builtin_amdgcn_global_load_lds((const unsigned*)(kt + koff[i]), (LAS unsigned*)(d + i * 4096), 16, 0, 0); };
        auto stageV = [&](int j) { LAS unsigned char* d = lds + 24576 + (j & 1) * 8192 + tid * 16; const bf16_t* vt = Vb + j * 64;
#pragma unroll
            for (int i = 0; i < 2; ++i) __builtin_amdgcn_global_load_lds((const unsigned*)(vt + voff[i]), (LAS unsigned*)(d + i * 4096), 16, 0, 0); };
        auto qk = [&](f32x16& a, f32x16& bq, int buf) { const LAS unsigned char* kb_ = lds + buf * 12288 + krow;
#pragma unroll
            for (int e = 0; e < 16; ++e) { a[e] = 0.f; bq[e] = 0.f; }
#pragma unroll
            for (int ks = 0; ks < 6; ++ks) { const bf16x8 k0 = *(const LAS bf16x8*)(kb_ + kro[ks]); const bf16x8 k1 = *(const LAS bf16x8*)(kb_ + 32 * 192 + kro[ks]);
                a = __builtin_amdgcn_mfma_f32_32x32x16_bf16(k0, qf[ks], a, 0, 0, 0); bq = __builtin_amdgcn_mfma_f32_32x32x16_bf16(k1, qf[ks], bq, 0, 0, 0); } };
        auto rowmax = [&](const f32x16& a, const f32x16& bq) { float m = fmaxf(a[0], bq[0]);
#pragma unroll
            for (int e = 1; e < 16; ++e) m = fmaxf(fmaxf(m, a[e]), bq[e]);
            return fmaxf(m, __shfl_xor(m, 32)); };
        f32x16 sA0, sA1, sB0, sB1; float mxA, mxB = 0.f;
        stageK(0); stageK(1); stageV(0);
        asm volatile("s_waitcnt vmcnt(0)" ::: "memory");
        __syncthreads();
        qk(sA0, sA1, 0); mxA = rowmax(sA0, sA1);
        auto step = [&](f32x16& c0, f32x16& c1, float& mxc, f32x16& n0, f32x16& n1, float& mxn, int j) {
            asm volatile("s_waitcnt vmcnt(0)" ::: "memory");
            __syncthreads();
            if (j + 2 < nt) stageK(j + 2);
            if (j + 1 < nt) stageV(j + 1);
            if (j < ntw) {
                if (!__all(mxc <= mrun + THR)) { const float mn = fmaxf(mrun, mxc), alpha = __builtin_amdgcn_exp2f(mrun - mn); mrun = mn; lsum *= alpha;
#pragma unroll
                    for (int e = 0; e < 16; ++e) { o0[e] *= alpha; o1[e] *= alpha; } }
                qk(n0, n1, (j + 1) & 1);
                float ps = 0.f;
#pragma unroll
                for (int e = 0; e < 16; ++e) { c0[e] = __builtin_amdgcn_exp2f(c0[e] - mrun); c1[e] = __builtin_amdgcn_exp2f(c1[e] - mrun); ps += c0[e] + c1[e]; }
                lsum += ps;
                unsigned pw[16];
#pragma unroll
                for (int e = 0; e < 8; ++e) { pw[e] = pk2(c0[2 * e], c0[2 * e + 1]); pw[8 + e] = pk2(c1[2 * e], c1[2 * e + 1]); }
                const LAS unsigned char* vb_ = lds + 24576 + (j & 1) * 8192 + vrow;
#pragma unroll
                for (int s = 0; s < 4; ++s) {
                    const u32x4 pbu = {pw[4 * s], pw[4 * s + 1], pw[4 * s + 2], pw[4 * s + 3]}; const bf16x8 pb = __builtin_bit_cast(bf16x8, pbu);
                    const int c0_ = ((2 * s) ^ vsw) * 16, c1_ = ((2 * s + 1) ^ vsw) * 16;
                    const u32x2 a0 = *(const LAS u32x2*)(vb_ + c0_), a1 = *(const LAS u32x2*)(vb_ + c1_);
                    const u32x2 b0 = *(const LAS u32x2*)(vb_ + 32 * 128 + c0_), b1 = *(const LAS u32x2*)(vb_ + 32 * 128 + c1_);
                    const u32x4 va = {a0.x, a0.y, a1.x, a1.y}, vb = {b0.x, b0.y, b1.x, b1.y};
                    o0 = __builtin_amdgcn_mfma_f32_32x32x16_bf16(__builtin_bit_cast(bf16x8, va), pb, o0, 0, 0, 0);
                    o1 = __builtin_amdgcn_mfma_f32_32x32x16_bf16(__builtin_bit_cast(bf16x8, vb), pb, o1, 0, 0, 0);
                }
                mxn = rowmax(n0, n1);
#if ATT_SGB
#pragma unroll
                for (int g_ = 0; g_ < 20; ++g_) { __builtin_amdgcn_sched_group_barrier(0x008, 1, 0); __builtin_amdgcn_sched_group_barrier(0x100, 2, 0); __builtin_amdgcn_sched_group_barrier(0x002, 7, 0); }
#endif
            }
        };
        for (int j = 0; j < nt; j += 2) { step(sA0, sA1, mxA, sB0, sB1, mxB, j); step(sB0, sB1, mxB, sA0, sA1, mxA, j + 1); }
        const float inv = 1.f / (lsum + __shfl_xor(lsum, 32));
        bf16_t* op = O + (size_t)(b * SEQ + q0 + l31) * 512 + h * 64 + 4 * hh;
#pragma unroll
        for (int g = 0; g < 4; ++g) { uint2 w0, w1;
            w0.x = pk2(o0[4 * g] * inv, o0[4 * g + 1] * inv); w0.y = pk2(o0[4 * g + 2] * inv, o0[4 * g + 3] * inv);
            w1.x = pk2(o1[4 * g] * inv, o1[4 * g + 1] * inv); w1.y = pk2(o1[4 * g + 2] * inv, o1[4 * g + 3] * inv);
            *(uint2*)(op + 8 * g) = w0; *(uint2*)(op + 32 + 8 * g) = w1; }
        __syncthreads();
    }
}

template <int VAR>
__device__ __forceinline__ void att_step(const LAS unsigned char* kb_, const LAS unsigned char* vb_, const int kt16, const int k4o, const int k5o, const int vsw, const bf16x8 (&qf)[6],
                                         f32x16& c0, f32x16& c1, f32x16& n0, f32x16& n1, const unsigned (&pwc)[16], unsigned (&pwn)[16], f32x16& o0, f32x16& o1,
                                         const f32x16& negm, float& ps, float& mxn) {
    f32x16 zero16;
#pragma unroll
    for (int e = 0; e < 16; ++e) zero16[e] = 0.f;
    if constexpr (VAR == 0) {
        bf16x8 kf0, kf1, kf2;
        kf0 = *(const LAS bf16x8*)(kb_ + 0*32*192 + kt16 + 0); kf1 = *(const LAS bf16x8*)(kb_ + 1*32*192 + kt16 + 0);
        float mxl;
        kf2 = *(const LAS bf16x8*)(kb_ + 0*32*192 + kt16 + 32);
        n0 = __builtin_amdgcn_mfma_f32_32x32x16_bf16(kf0, qf[0], negm, 0, 0, 0);
        c0[0] = __builtin_amdgcn_exp2f(c0[0]); ps += c0[0]; c0[1] = __builtin_amdgcn_exp2f(c0[1]); ps += c0[1]; pwn[0] = pk2(c0[0], c0[1]);
        __builtin_amdgcn_sched_barrier(0);
        kf0 = *(const LAS bf16x8*)(kb_ + 1*32*192 + kt16 + 32);
        n1 = __builtin_amdgcn_mfma_f32_32x32x16_bf16(kf1, qf[0], negm, 0, 0, 0);
        c0[2] = __builtin_amdgcn_exp2f(c0[2]); ps += c0[2]; c0[3] = __builtin_amdgcn_exp2f(c0[3]); ps += c0[3]; pwn[1] = pk2(c0[2], c0[3]);
        __builtin_amdgcn_sched_barrier(0);
        kf1 = *(const LAS bf16x8*)(kb_ + 0*32*192 + kt16 + 64);
        n0 = __builtin_amdgcn_mfma_f32_32x32x16_bf16(kf2, qf[1], n0, 0, 0, 0);
        c0[4] = __builtin_amdgcn_exp2f(c0[4]); ps += c0[4]; c0[5] = __builtin_amdgcn_exp2f(c0[5]); ps += c0[5]; pwn[2] = pk2(c0[4], c0[5]);
        __builtin_amdgcn_sched_barrier(0);
        kf2 = *(const LAS bf16x8*)(kb_ + 1*32*192 + kt16 + 64);
        n1 = __builtin_amdgcn_mfma_f32_32x32x16_bf16(kf0, qf[1], n1, 0, 0, 0);
        c0[6] = __builtin_amdgcn_exp2f(c0[6]); ps += c0[6]; c0[7] = __builtin_amdgcn_exp2f(c0[7]); ps += c0[7]; pwn[3] = pk2(c0[6], c0[7]);
        __builtin_amdgcn_sched_barrier(0);
        kf0 = *(const LAS bf16x8*)(kb_ + 0*32*192 + kt16 + 96);
        n0 = __builtin_amdgcn_mfma_f32_32x32x16_bf16(kf1, qf[2], n0, 0, 0, 0);
        c0[8] = __builtin_amdgcn_exp2f(c0[8]); ps += c0[8]; c0[9] = __builtin_amdgcn_exp2f(c0[9]); ps += c0[9]; pwn[4] = pk2(c0[8], c0[9]);
        __builtin_amdgcn_sched_barrier(0);
        kf1 = *(const LAS bf16x8*)(kb_ + 1*32*192 + kt16 + 96);
        n1 = __builtin_amdgcn_mfma_f32_32x32x16_bf16(kf2, qf[2], n1, 0, 0, 0);
        c0[10] = __builtin_amdgcn_exp2f(c0[10]); ps += c0[10]; c0[11] = __builtin_amdgcn_exp2f(c0[11]); ps += c0[11]; pwn[5] = pk2(c0[10], c0[11]);
        __builtin_amdgcn_sched_barrier(0);
        kf2 = *(const LAS bf16x8*)(kb_ + 0*32*192 + k4o);
        n0 = __builtin_amdgcn_mfma_f32_32x32x16_bf16(kf0, qf[3], n0, 0, 0, 0);
        c0[12] = __builtin_amdgcn_exp2f(c0[12]); ps += c0[12]; c0[13] = __builtin_amdgcn_exp2f(c0[13]); ps += c0[13]; pwn[6] = pk2(c0[12], c0[13]);
        __builtin_amdgcn_sched_barrier(0);
        kf0 = *(const LAS bf16x8*)(kb_ + 1*32*192 + k4o);
        n1 = __builtin_amdgcn_mfma_f32_32x32x16_bf16(kf1, qf[3], n1, 0, 0, 0);
        c0[14] = __builtin_amdgcn_exp2f(c0[14]); ps += c0[14]; c0[15] = __builtin_amdgcn_exp2f(c0[15]); ps += c0[15]; pwn[7] = pk2(c0[14], c0[15]);
        __builtin_amdgcn_sched_barrier(0);
        kf1 = *(const LAS bf16x8*)(kb_ + 0*32*192 + k5o);
        n0 = __builtin_amdgcn_mfma_f32_32x32x16_bf16(kf2, qf[4], n0, 0, 0, 0);
        c1[0] = __builtin_amdgcn_exp2f(c1[0]); ps += c1[0]; c1[1] = __builtin_amdgcn_exp2f(c1[1]); ps += c1[1]; pwn[8] = pk2(c1[0], c1[1]);
        __builtin_amdgcn_sched_barrier(0);
        kf2 = *(const LAS bf16x8*)(kb_ + 1*32*192 + k5o);
        n1 = __builtin_amdgcn_mfma_f32_32x32x16_bf16(kf0, qf[4], n1, 0, 0, 0);
        c1[2] = __builtin_amdgcn_exp2f(c1[2]); ps += c1[2]; c1[3] = __builtin_amdgcn_exp2f(c1[3]); ps += c1[3]; pwn[9] = pk2(c1[2], c1[3]);
        __builtin_amdgcn_sched_barrier(0);
        n0 = __builtin_amdgcn_mfma_f32_32x32x16_bf16(kf1, qf[5], n0, 0, 0, 0);
        c1[4] = __builtin_amdgcn_exp2f(c1[4]); ps += c1[4]; c1[5] = __builtin_amdgcn_exp2f(c1[5]); ps += c1[5]; pwn[10] = pk2(c1[4], c1[5]);
        __builtin_amdgcn_sched_barrier(0);
        n1 = __builtin_amdgcn_mfma_f32_32x32x16_bf16(kf2, qf[5], n1, 0, 0, 0);
        c1[6] = __builtin_amdgcn_exp2f(c1[6]); ps += c1[6]; c1[7] = __builtin_amdgcn_exp2f(c1[7]); ps += c1[7]; pwn[11] = pk2(c1[6], c1[7]);
        __builtin_amdgcn_sched_barrier(0);
        c1[8] = __builtin_amdgcn_exp2f(c1[8]); ps += c1[8]; c1[9] = __builtin_amdgcn_exp2f(c1[9]); ps += c1[9]; pwn[12] = pk2(c1[8], c1[9]);
        __builtin_amdgcn_sched_barrier(0);
        c1[10] = __builtin_amdgcn_exp2f(c1[10]); ps += c1[10]; c1[11] = __builtin_amdgcn_exp2f(c1[11]); ps += c1[11]; pwn[13] = pk2(c1[10], c1[11]);
        __builtin_amdgcn_sched_barrier(0);
        c1[12] = __builtin_amdgcn_exp2f(c1[12]); ps += c1[12]; c1[13] = __builtin_amdgcn_exp2f(c1[13]); ps += c1[13]; pwn[14] = pk2(c1[12], c1[13]);
        __builtin_amdgcn_sched_barrier(0);
        c1[14] = __builtin_amdgcn_exp2f(c1[14]); ps += c1[14]; c1[15] = __builtin_amdgcn_exp2f(c1[15]); ps += c1[15]; pwn[15] = pk2(c1[14], c1[15]);
        __builtin_amdgcn_sched_barrier(0);
        mxl = fmaxf(n0[0], n1[0]); mxl = fmaxf(fmaxf(mxl, n0[1]), n1[1]); mxl = fmaxf(fmaxf(mxl, n0[2]), n1[2]); mxl = fmaxf(fmaxf(mxl, n0[3]), n1[3]);
        __builtin_amdgcn_sched_barrier(0);
        mxl = fmaxf(fmaxf(mxl, n0[4]), n1[4]); mxl = fmaxf(fmaxf(mxl, n0[5]), n1[5]); mxl = fmaxf(fmaxf(mxl, n0[6]), n1[6]); mxl = fmaxf(fmaxf(mxl, n0[7]), n1[7]);
        __builtin_amdgcn_sched_barrier(0);
        mxl = fmaxf(fmaxf(mxl, n0[8]), n1[8]); mxl = fmaxf(fmaxf(mxl, n0[9]), n1[9]); mxl = fmaxf(fmaxf(mxl, n0[10]), n1[10]); mxl = fmaxf(fmaxf(mxl, n0[11]), n1[11]);
        __builtin_amdgcn_sched_barrier(0);
        mxl = fmaxf(fmaxf(mxl, n0[12]), n1[12]); mxl = fmaxf(fmaxf(mxl, n0[13]), n1[13]); mxl = fmaxf(fmaxf(mxl, n0[14]), n1[14]); mxl = fmaxf(fmaxf(mxl, n0[15]), n1[15]);
        __builtin_amdgcn_sched_barrier(0);
        mxn = fmaxf(mxl, __shfl_xor(mxl, 32));
    } else if constexpr (VAR == 1) {
        bf16x8 kf0, kf1, kf2;
        kf0 = *(const LAS bf16x8*)(kb_ + 0*32*192 + kt16 + 0); kf1 = *(const LAS bf16x8*)(kb_ + 1*32*192 + kt16 + 0);
        u32x2 vf0a, vf0b, vf1a, vf1b, vf2a, vf2b;
        float mxl;
        kf2 = *(const LAS bf16x8*)(kb_ + 0*32*192 + kt16 + 32);
        n0 = __builtin_amdgcn_mfma_f32_32x32x16_bf16(kf0, qf[0], negm, 0, 0, 0);
        c0[0] = __builtin_amdgcn_exp2f(c0[0]); ps += c0[0]; c0[1] = __builtin_amdgcn_exp2f(c0[1]); ps += c0[1]; pwn[0] = pk2(c0[0], c0[1]);
        __builtin_amdgcn_sched_barrier(0);
        kf0 = *(const LAS bf16x8*)(kb_ + 1*32*192 + kt16 + 32);
        n1 = __builtin_amdgcn_mfma_f32_32x32x16_bf16(kf1, qf[0], negm, 0, 0, 0);
        c0[2] = __builtin_amdgcn_exp2f(c0[2]); ps += c0[2]; c0[3] = __builtin_amdgcn_exp2f(c0[3]); ps += c0[3]; pwn[1] = pk2(c0[2], c0[3]);
        __builtin_amdgcn_sched_barrier(0);
        kf1 = *(const LAS bf16x8*)(kb_ + 0*32*192 + kt16 + 64);
        n0 = __builtin_amdgcn_mfma_f32_32x32x16_bf16(kf2, qf[1], n0, 0, 0, 0);
        c0[4] = __builtin_amdgcn_exp2f(c0[4]); ps += c0[4]; c0[5] = __builtin_amdgcn_exp2f(c0[5]); ps += c0[5]; pwn[2] = pk2(c0[4], c0[5]);
        __builtin_amdgcn_sched_barrier(0);
        kf2 = *(const LAS bf16x8*)(kb_ + 1*32*192 + kt16 + 64);
        n1 = __builtin_amdgcn_mfma_f32_32x32x16_bf16(kf0, qf[1], n1, 0, 0, 0);
        c0[6] = __builtin_amdgcn_exp2f(c0[6]); ps += c0[6]; c0[7] = __builtin_amdgcn_exp2f(c0[7]); ps += c0[7]; pwn[3] = pk2(c0[6], c0[7]);
        __builtin_amdgcn_sched_barrier(0);
        kf0 = *(const LAS bf16x8*)(kb_ + 0*32*192 + kt16 + 96);
        n0 = __builtin_amdgcn_mfma_f32_32x32x16_bf16(kf1, qf[2], n0, 0, 0, 0);
        c0[8] = __builtin_amdgcn_exp2f(c0[8]); ps += c0[8]; c0[9] = __builtin_amdgcn_exp2f(c0[9]); ps += c0[9]; pwn[4] = pk2(c0[8], c0[9]);
        __builtin_amdgcn_sched_barrier(0);
        kf1 = *(const LAS bf16x8*)(kb_ + 1*32*192 + kt16 + 96);
        n1 = __builtin_amdgcn_mfma_f32_32x32x16_bf16(kf2, qf[2], n1, 0, 0, 0);
        c0[10] = __builtin_amdgcn_exp2f(c0[10]); ps += c0[10]; c0[11] = __builtin_amdgcn_exp2f(c0[11]); ps += c0[11]; pwn[5] = pk2(c0[10], c0[11]);
        __builtin_amdgcn_sched_barrier(0);
        kf2 = *(const LAS bf16x8*)(kb_ + 0*32*192 + k4o);
        n0 = __builtin_amdgcn_mfma_f32_32x32x16_bf16(kf0, qf[3], n0, 0, 0, 0);
        c0[12] = __builtin_amdgcn_exp2f(c0[12]); ps += c0[12]; c0[13] = __builtin_amdgcn_exp2f(c0[13]); ps += c0[13]; pwn[6] = pk2(c0[12], c0[13]);
        __builtin_amdgcn_sched_barrier(0);
        kf0 = *(const LAS bf16x8*)(kb_ + 1*32*192 + k4o);
        n1 = __builtin_amdgcn_mfma_f32_32x32x16_bf16(kf1, qf[3], n1, 0, 0, 0);
        c0[14] = __builtin_amdgcn_exp2f(c0[14]); ps += c0[14]; c0[15] = __builtin_amdgcn_exp2f(c0[15]); ps += c0[15]; pwn[7] = pk2(c0[14], c0[15]);
        __builtin_amdgcn_sched_barrier(0);
        kf1 = *(const LAS bf16x8*)(kb_ + 0*32*192 + k5o);
        n0 = __builtin_amdgcn_mfma_f32_32x32x16_bf16(kf2, qf[4], n0, 0, 0, 0);
        c1[0] = __builtin_amdgcn_exp2f(c1[0]); ps += c1[0]; c1[1] = __builtin_amdgcn_exp2f(c1[1]); ps += c1[1]; pwn[8] = pk2(c1[0], c1[1]);
        __builtin_amdgcn_sched_barrier(0);
        kf2 = *(const LAS bf16x8*)(kb_ + 1*32*192 + k5o);
        n1 = __builtin_amdgcn_mfma_f32_32x32x16_bf16(kf0, qf[4], n1, 0, 0, 0);
        c1[2] = __builtin_amdgcn_exp2f(c1[2]); ps += c1[2]; c1[3] = __builtin_amdgcn_exp2f(c1[3]); ps += c1[3]; pwn[9] = pk2(c1[2], c1[3]);
        __builtin_amdgcn_sched_barrier(0);
        vf0a = *(const LAS u32x2*)(vb_ + ((0) ^ vsw) * 16); vf0b = *(const LAS u32x2*)(vb_ + ((1) ^ vsw) * 16);
        n0 = __builtin_amdgcn_mfma_f32_32x32x16_bf16(kf1, qf[5], n0, 0, 0, 0);
        c1[4] = __builtin_amdgcn_exp2f(c1[4]); ps += c1[4]; c1[5] = __builtin_amdgcn_exp2f(c1[5]); ps += c1[5]; pwn[10] = pk2(c1[4], c1[5]);
        __builtin_amdgcn_sched_barrier(0);
        vf1a = *(const LAS u32x2*)(vb_ + 32 * 128 + ((0) ^ vsw) * 16); vf1b = *(const LAS u32x2*)(vb_ + 32 * 128 + ((1) ^ vsw) * 16);
        n1 = __builtin_amdgcn_mfma_f32_32x32x16_bf16(kf2, qf[5], n1, 0, 0, 0);
        c1[6] = __builtin_amdgcn_exp2f(c1[6]); ps += c1[6]; c1[7] = __builtin_amdgcn_exp2f(c1[7]); ps += c1[7]; pwn[11] = pk2(c1[6], c1[7]);
        __builtin_amdgcn_sched_barrier(0);
        vf2a = *(const LAS u32x2*)(vb_ + ((2) ^ vsw) * 16); vf2b = *(const LAS u32x2*)(vb_ + ((3) ^ vsw) * 16);
        { const u32x4 pbu = {pwc[0], pwc[1], pwc[2], pwc[3]}; const u32x4 vv = {vf0a.x, vf0a.y, vf0b.x, vf0b.y};
          o0 = __builtin_amdgcn_mfma_f32_32x32x16_bf16(__builtin_bit_cast(bf16x8, vv), __builtin_bit_cast(bf16x8, pbu), o0, 0, 0, 0); }
        c1[8] = __builtin_amdgcn_exp2f(c1[8]); ps += c1[8]; c1[9] = __builtin_amdgcn_exp2f(c1[9]); ps += c1[9]; pwn[12] = pk2(c1[8], c1[9]);
        __builtin_amdgcn_sched_barrier(0);
        vf0a = *(const LAS u32x2*)(vb_ + 32 * 128 + ((2) ^ vsw) * 16); vf0b = *(const LAS u32x2*)(vb_ + 32 * 128 + ((3) ^ vsw) * 16);
        { const u32x4 pbu = {pwc[0], pwc[1], pwc[2], pwc[3]}; const u32x4 vv = {vf1a.x, vf1a.y, vf1b.x, vf1b.y};
          o1 = __builtin_amdgcn_mfma_f32_32x32x16_bf16(__builtin_bit_cast(bf16x8, vv), __builtin_bit_cast(bf16x8, pbu), o1, 0, 0, 0); }
        c1[10] = __builtin_amdgcn_exp2f(c1[10]); ps += c1[10]; c1[11] = __builtin_amdgcn_exp2f(c1[11]); ps += c1[11]; pwn[13] = pk2(c1[10], c1[11]);
        __builtin_amdgcn_sched_barrier(0);
        vf1a = *(const LAS u32x2*)(vb_ + ((4) ^ vsw) * 16); vf1b = *(const LAS u32x2*)(vb_ + ((5) ^ vsw) * 16);
        { const u32x4 pbu = {pwc[4], pwc[5], pwc[6], pwc[7]}; const u32x4 vv = {vf2a.x, vf2a.y, vf2b.x, vf2b.y};
          o0 = __builtin_amdgcn_mfma_f32_32x32x16_bf16(__builtin_bit_cast(bf16x8, vv), __builtin_bit_cast(bf16x8, pbu), o0, 0, 0, 0); }
        c1[12] = __builtin_amdgcn_exp2f(c1[12]); ps += c1[12]; c1[13] = __builtin_amdgcn_exp2f(c1[13]); ps += c1[13]; pwn[14] = pk2(c1[12], c1[13]);
        __builtin_amdgcn_sched_barrier(0);
        vf2a = *(const LAS u32x2*)(vb_ + 32 * 128 + ((4) ^ vsw) * 16); vf2b = *(const LAS u32x2*)(vb_ + 32 * 128 + ((5) ^ vsw) * 16);
        { const u32x4 pbu = {pwc[4], pwc[5], pwc[6], pwc[7]}; const u32x4 vv = {vf0a.x, vf0a.y, vf0b.x, vf0b.y};
          o1 = __builtin_amdgcn_mfma_f32_32x32x16_bf16(__builtin_bit_cast(bf16x8, vv), __builtin_bit_cast(bf16x8, pbu), o1, 0, 0, 0); }
        c1[14] = __builtin_amdgcn_exp2f(c1[14]); ps += c1[14]; c1[15] = __builtin_amdgcn_exp2f(c1[15]); ps += c1[15]; pwn[15] = pk2(c1[14], c1[15]);
        __builtin_amdgcn_sched_barrier(0);
        vf0a = *(const LAS u32x2*)(vb_ + ((6) ^ vsw) * 16); vf0b = *(const LAS u32x2*)(vb_ + ((7) ^ vsw) * 16);
        { const u32x4 pbu = {pwc[8], pwc[9], pwc[10], pwc[11]}; const u32x4 vv = {vf1a.x, vf1a.y, vf1b.x, vf1b.y};
          o0 = __builtin_amdgcn_mfma_f32_32x32x16_bf16(__builtin_bit_cast(bf16x8, vv), __builtin_bit_cast(bf16x8, pbu), o0, 0, 0, 0); }
        mxl = fmaxf(n0[0], n1[0]); mxl = fmaxf(fmaxf(mxl, n0[1]), n1[1]); mxl = fmaxf(fmaxf(mxl, n0[2]), n1[2]); mxl = fmaxf(fmaxf(mxl, n0[3]), n1[3]);
        __builtin_amdgcn_sched_barrier(0);
        vf1a = *(const LAS u32x2*)(vb_ + 32 * 128 + ((6) ^ vsw) * 16); vf1b = *(const LAS u32x2*)(vb_ + 32 * 128 + ((7) ^ vsw) * 16);
        { const u32x4 pbu = {pwc[8], pwc[9], pwc[10], pwc[11]}; const u32x4 vv = {vf2a.x, vf2a.y, vf2b.x, vf2b.y};
          o1 = __builtin_amdgcn_mfma_f32_32x32x16_bf16(__builtin_bit_cast(bf16x8, vv), __builtin_bit_cast(bf16x8, pbu), o1, 0, 0, 0); }
        mxl = fmaxf(fmaxf(mxl, n0[4]), n1[4]); mxl = fmaxf(fmaxf(mxl, n0[5]), n1[5]); mxl = fmaxf(fmaxf(mxl, n0[6]), n1[6]); mxl = fmaxf(fmaxf(mxl, n0[7]), n1[7]);
        __builtin_amdgcn_sched_barrier(0);
        { const u32x4 pbu = {pwc[12], pwc[13], pwc[14], pwc[15]}; const u32x4 vv = {vf0a.x, vf0a.y, vf0b.x, vf0b.y};
          o0 = __builtin_amdgcn_mfma_f32_32x32x16_bf16(__builtin_bit_cast(bf16x8, vv), __builtin_bit_cast(bf16x8, pbu), o0, 0, 0, 0); }
        mxl = fmaxf(fmaxf(mxl, n0[8]), n1[8]); mxl = fmaxf(fmaxf(mxl, n0[9]), n1[9]); mxl = fmaxf(fmaxf(mxl, n0[10]), n1[10]); mxl = fmaxf(fmaxf(mxl, n0[11]), n1[11]);
        __builtin_amdgcn_sched_barrier(0);
        { const u32x4 pbu = {pwc[12], pwc[13], pwc[14], pwc[15]}; const u32x4 vv = {vf1a.x, vf1a.y, vf1b.x, vf1b.y};
          o1 = __builtin_amdgcn_mfma_f32_32x32x16_bf16(__builtin_bit_cast(bf16x8, vv), __builtin_bit_cast(bf16x8, pbu), o1, 0, 0, 0); }
        mxl = fmaxf(fmaxf(mxl, n0[12]), n1[12]); mxl = fmaxf(fmaxf(mxl, n0[13]), n1[13]); mxl = fmaxf(fmaxf(mxl, n0[14]), n1[14]); mxl = fmaxf(fmaxf(mxl, n0[15]), n1[15]);
        __builtin_amdgcn_sched_barrier(0);
        mxn = fmaxf(mxl, __shfl_xor(mxl, 32));
    } else {
        u32x2 vf0a, vf0b, vf1a, vf1b, vf2a, vf2b;
        vf0a = *(const LAS u32x2*)(vb_ + ((0) ^ vsw) * 16); vf0b = *(const LAS u32x2*)(vb_ + ((1) ^ vsw) * 16);
        vf1a = *(const LAS u32x2*)(vb_ + 32 * 128 + ((0) ^ vsw) * 16); vf1b = *(const LAS u32x2*)(vb_ + 32 * 128 + ((1) ^ vsw) * 16);
        vf2a = *(const LAS u32x2*)(vb_ + ((2) ^ vsw) * 16); vf2b = *(const LAS u32x2*)(vb_ + ((3) ^ vsw) * 16);
        { const u32x4 pbu = {pwc[0], pwc[1], pwc[2], pwc[3]}; const u32x4 vv = {vf0a.x, vf0a.y, vf0b.x, vf0b.y};
          o0 = __builtin_amdgcn_mfma_f32_32x32x16_bf16(__builtin_bit_cast(bf16x8, vv), __builtin_bit_cast(bf16x8, pbu), o0, 0, 0, 0); }
        __builtin_amdgcn_sched_barrier(0);
        vf0a = *(const LAS u32x2*)(vb_ + 32 * 128 + ((2) ^ vsw) * 16); vf0b = *(const LAS u32x2*)(vb_ + 32 * 128 + ((3) ^ vsw) * 16);
        { const u32x4 pbu = {pwc[0], pwc[1], pwc[2], pwc[3]}; const u32x4 vv = {vf1a.x, vf1a.y, vf1b.x, vf1b.y};
          o1 = __builtin_amdgcn_mfma_f32_32x32x16_bf16(__builtin_bit_cast(bf16x8, vv), __builtin_bit_cast(bf16x8, pbu), o1, 0, 0, 0); }
        __builtin_amdgcn_sched_barrier(0);
        vf1a = *(const LAS u32x2*)(vb_ + ((4) ^ vsw) * 16); vf1b = *(const LAS u32x2*)(vb_ + ((5) ^ vsw) * 16);
        { const u32x4 pbu = {pwc[4], pwc[5], pwc[6], pwc[7]}; const u32x4 vv = {vf2a.x, vf2a.y, vf2b.x, vf2b.y};
          o0 = __builtin_amdgcn_mfma_f32_32x32x16_bf16(__builtin_bit_cast(bf16x8, vv), __builtin_bit_cast(bf16x8, pbu), o0, 0, 0, 0); }
        __builtin_amdgcn_sched_barrier(0);
        vf2a = *(const LAS u32x2*)(vb_ + 32 * 128 + ((4) ^ vsw) * 16); vf2b = *(const LAS u32x2*)(vb_ + 32 * 128 + ((5) ^ vsw) * 16);
        { const u32x4 pbu = {pwc[4], pwc[5], pwc[6], pwc[7]}; const u32x4 vv = {vf0a.x, vf0a.y, vf0b.x, vf0b.y};
          o1 = __builtin_amdgcn_mfma_f32_32x32x16_bf16(__builtin_bit_cast(bf16x8, vv), __builtin_bit_cast(bf16x8, pbu), o1, 0, 0, 0); }
        __builtin_amdgcn_sched_barrier(0);
        vf0a = *(const LAS u32x2*)(vb_ + ((6) ^ vsw) * 16); vf0b = *(const LAS u32x2*)(vb_ + ((7) ^ vsw) * 16);
        { const u32x4 pbu = {pwc[8], pwc[9], pwc[10], pwc[11]}; const u32x4 vv = {vf1a.x, vf1a.y, vf1b.x, vf1b.y};
          o0 = __builtin_amdgcn_mfma_f32_32x32x16_bf16(__builtin_bit_cast(bf16x8, vv), __builtin_bit_cast(bf16x8, pbu), o0, 0, 0, 0); }
        __builtin_amdgcn_sched_barrier(0);
        vf1a = *(const LAS u32x2*)(vb_ + 32 * 128 + ((6) ^ vsw) * 16); vf1b = *(const LAS u32x2*)(vb_ + 32 * 128 + ((7) ^ vsw) * 16);
        { const u32x4 pbu = {pwc[8], pwc[9], pwc[10], pwc[11]}; const u32x4 vv = {vf2a.x, vf2a.y, vf2b.x, vf2b.y};
          o1 = __builtin_amdgcn_mfma_f32_32x32x16_bf16(__builtin_bit_cast(bf16x8, vv), __builtin_bit_cast(bf16x8, pbu), o1, 0, 0, 0); }
        __builtin_amdgcn_sched_barrier(0);
        { const u32x4 pbu = {pwc[12], pwc[13], pwc[14], pwc[15]}; const u32x4 vv = {vf0a.x, vf0a.y, vf0b.x, vf0b.y};
          o0 = __builtin_amdgcn_mfma_f32_32x32x16_bf16(__builtin_bit_cast(bf16x8, vv), __builtin_bit_cast(bf16x8, pbu), o0, 0, 0, 0); }
        __builtin_amdgcn_sched_barrier(0);
        { const u32x4 pbu = {pwc[12], pwc[13], pwc[14], pwc[15]}; const u32x4 vv = {vf1a.x, vf1a.y, vf1b.x, vf1b.y};
          o1 = __builtin_amdgcn_mfma_f32_32x32x16_bf16(__builtin_bit_cast(bf16x8, vv), __builtin_bit_cast(bf16x8, pbu), o1, 0, 0, 0); }
        __builtin_amdgcn_sched_barrier(0);
    }
}

template <int DUMMY>
__device__ __forceinline__ void phase3q(const P& p, int bid, int nb, LAS unsigned char* lds) {
    const bf16_t* Q = p.slotA; const bf16_t* K = p.slotE; const bf16_t* VT = p.slotF; bf16_t* O = p.slotC;
    const int tid = opaque_tid(), lane = tid & 63, wid = tid >> 6, l31 = lane & 31, hh = lane >> 5;
    constexpr float THR = 8.f;
    const int widu = __builtin_amdgcn_readfirstlane(tid >> 6);
    int koff[3];
#pragma unroll
    for (int i = 0; i < 3; ++i) { const int s = tid + 256 * i, r = s / 12, pc = s % 12, c = (pc + 12 - ((r >> 2) & 3)) % 12; koff[i] = r * 96 + c * 8; }
    const int kt = hh + ((lane >> 2) & 3), kt16 = kt * 16, k4o = (8 + kt >= 12 ? kt - 4 : 8 + kt) * 16, k5o = (10 + kt >= 12 ? kt - 2 : 10 + kt) * 16;
    const int krow = l31 * 192, vsw = (lane >> 1) & 7, vrow = l31 * 128 + 8 * hh;
    for (int iu = 0;; ++iu) {
        const int r = iu * nb + ((iu & 1) ? nb - 1 - bid : bid); if (r >= 1024) break;
        const int qb = 63 - (r >> 4), bh = r & 15, b = bh >> 3, h = bh & 7;
        const int q0 = qb * 128 + wid * 32, ntw = (q0 >> 6) + 1, nt = 2 * qb + 2;
        const bf16_t* Kb = K + (size_t)bh * SEQ * 96; const bf16_t* Vb = VT + (size_t)(h * 64) * NT + (size_t)b * SEQ;
        bf16x8 qf[6]; { const bf16_t* qp = Q + ((size_t)bh * SEQ + q0 + l31) * 96 + hh * 8;
#pragma unroll
            for (int ks = 0; ks < 6; ++ks) qf[ks] = *(const bf16x8*)(qp + ks * 16); }
        f32x16 o0, o1;
#pragma unroll
        for (int e = 0; e < 16; ++e) { o0[e] = 0.f; o1[e] = 0.f; }
        float mrun = 0.f, lsum = 0.f; f32x16 negm;
#pragma unroll
        for (int e = 0; e < 16; ++e) negm[e] = 0.f;
        auto stageK = [&](int j) { LAS unsigned char* d = lds + (j & 1) * 12288 + widu * 1024; const bf16_t* kt = Kb + (size_t)j * 64 * 96;
#pragma unroll
            for (int i = 0; i < 3; ++i) __builtin_amdgcn_global_load_lds((const unsigned*)(kt + koff[i]), (LAS unsigned*)(d + i * 4096), 16, 0, 0); };
        auto stageV = [&](int j) { LAS unsigned char* d = lds + 24576 + (j & 1) * 8192 + widu * 1024; const bf16_t* vt = Vb + j * 64;
#pragma unroll
            for (int i = 0; i < 2; ++i) { const int dv = (tid >> 3) + 32 * i, cl = (tid & 7) ^ ((dv >> 1) & 7);
                __builtin_amdgcn_global_load_lds((const unsigned*)(vt + (size_t)dv * NT + cl * 8), (LAS unsigned*)(d + i * 4096), 16, 0, 0); } };
        f32x16 sA0, sA1, sB0, sB1; unsigned pA[16], pB[16]; float mxA, mxB = 0.f;
#pragma unroll
        for (int e = 0; e < 16; ++e) { pA[e] = 0u; pB[e] = 0u; }
        stageK(0); stageK(1);
        asm volatile("s_waitcnt vmcnt(0)" ::: "memory");
        __syncthreads();
        { const LAS unsigned char* kb_ = lds + krow;
#pragma unroll
          for (int e = 0; e < 16; ++e) { sA0[e] = 0.f; sA1[e] = 0.f; }
#pragma unroll
          for (int ks = 0; ks < 6; ++ks) { const int ko = ks <= 3 ? kt16 + 32 * ks : (ks == 4 ? k4o : k5o); const bf16x8 k0 = *(const LAS bf16x8*)(kb_ + ko); const bf16x8 k1 = *(const LAS bf16x8*)(kb_ + 32 * 192 + ko);
              sA0 = __builtin_amdgcn_mfma_f32_32x32x16_bf16(k0, qf[ks], sA0, 0, 0, 0); sA1 = __builtin_amdgcn_mfma_f32_32x32x16_bf16(k1, qf[ks], sA1, 0, 0, 0); }
          float m = fmaxf(sA0[0], sA1[0]);
#pragma unroll
          for (int e = 1; e < 16; ++e) m = fmaxf(fmaxf(m, sA0[e]), sA1[e]);
          mxA = fmaxf(m, __shfl_xor(m, 32)); }
        auto step = [&](f32x16& c0, f32x16& c1, float& mxc, f32x16& n0, f32x16& n1, float& mxn, const unsigned (&pwc)[16], unsigned (&pwn)[16], int s) {
            asm volatile("s_waitcnt vmcnt(0)" ::: "memory");
            __syncthreads();
            if (s + 2 < nt) stageK(s + 2);
            if (s < nt) stageV(s);
            if (s <= ntw) {
                const LAS unsigned char* kb_ = lds + ((s + 1) & 1) * 12288 + krow; const LAS unsigned char* vb_ = lds + 24576 + ((s + 1) & 1) * 8192 + vrow;
                if (s < ntw) {
                    const bool resc = (s == 0) || !__all(mxc <= THR); float alpha = 1.f;
                    if (resc) { const float dl = (s == 0) ? mxc : fmaxf(mxc, 0.f); alpha = __builtin_amdgcn_exp2f(-dl); mrun += dl;
#pragma unroll
                        for (int e = 0; e < 16; ++e) { c0[e] -= dl; c1[e] -= dl; negm[e] = -mrun; } }
                    float ps = 0.f;
                    if (s == 0) att_step<0>(kb_, vb_, kt16, k4o, k5o, vsw, qf, c0, c1, n0, n1, pwc, pwn, o0, o1, negm, ps, mxn);
                    else att_step<1>(kb_, vb_, kt16, k4o, k5o, vsw, qf, c0, c1, n0, n1, pwc, pwn, o0, o1, negm, ps, mxn);
                    if (resc) {
#pragma unroll
                        for (int e = 0; e < 16; ++e) { o0[e] *= alpha; o1[e] *= alpha; } }
                    lsum = lsum * alpha + ps;
                } else att_step<2>(kb_, vb_, kt16, k4o, k5o, vsw, qf, c0, c1, n0, n1, pwc, pwn, o0, o1, negm, lsum, mxn);
            }
        };
        for (int s = 0; s <= nt; s += 2) { step(sA0, sA1, mxA, sB0, sB1, mxB, pB, pA, s); if (s + 1 <= nt) step(sB0, sB1, mxB, sA0, sA1, mxA, pA, pB, s + 1); }
        const float inv = 1.f / (lsum + __shfl_xor(lsum, 32));
        bf16_t* op = O + (size_t)(b * SEQ + q0 + l31) * 512 + h * 64 + 4 * hh;
#pragma unroll
        for (int g = 0; g < 4; ++g) { uint2 w0, w1;
            w0.x = pk2(o0[4 * g] * inv, o0[4 * g + 1] * inv); w0.y = pk2(o0[4 * g + 2] * inv, o0[4 * g + 3] * inv);
            w1.x = pk2(o1[4 * g] * inv, o1[4 * g + 1] * inv); w1.y = pk2(o1[4 * g + 2] * inv, o1[4 * g + 3] * inv);
            *(uint2*)(op + 8 * g) = w0; *(uint2*)(op + 32 + 8 * g) = w1; }
        __syncthreads();
    }
}

__device__ __forceinline__ unsigned pack2bf(float lo, float hi) { return (unsigned)f2bf(lo) | ((unsigned)f2bf(hi) << 16); }
__device__ __forceinline__ void phase4(const P& p, int bid, int nb, LAS unsigned char* lds) {
    const bf16_t* O = p.slotC; const bf16_t* su = p.slotG; const bf16_t* gates = p.slotD; bf16_t* mo = p.slotA;
    const int tid = opaque_tid(), lane = tid & 63, wid = tid >> 6, wr = wid >> 1, wc = wid & 1, fr = lane & 15, fq = lane >> 4;
    const int c8 = ((tid & 7) ^ ((tid >> 3) & 7)) * 8;
    auto ops1 = [&](int rt, int ct) __attribute__((always_inline)) { return gops(O + (size_t)(rt * 128 + (tid >> 3)) * 512 + c8, (size_t)32 * 512, p.WoaT + (size_t)(ct * 128 + (tid >> 3)) * 512 + c8, (size_t)32 * 512); };
    auto ops2 = [&](int rt, int ct) __attribute__((always_inline)) { return gops(su + (size_t)(rt * 128 + (tid >> 3)) * 512 + c8, (size_t)32 * 512, p.WosT + (size_t)(ct * 128 + (tid >> 3)) * 512 + c8, (size_t)32 * 512); };
    int rt, ct; bool have = tile_of(0, bid, nb, NT / 128, DM / 128, rt, ct);
    for (int it = 0; have; ++it) {
        const int row0 = rt * 128, col0 = ct * 128;
        int rt2, ct2; const bool have2 = tile_of(it + 1, bid, nb, NT / 128, DM / 128, rt2, ct2);
        f32x4 acc[4][4];
#pragma unroll
        for (int m = 0; m < 4; ++m)
#pragma unroll
            for (int n = 0; n < 4; ++n) acc[m][n] = (f32x4){0.f, 0.f, 0.f, 0.f};
        uint2 gav[4][4], gbv[4][4];
#pragma unroll
        for (int m = 0; m < 4; ++m)
#pragma unroll
            for (int n = 0; n < 4; ++n) { const int t = row0 + wr * 64 + m * 16 + fr, c = col0 + wc * 64 + n * 16 + fq * 4;
                gav[m][n] = *(const uint2*)(gates + (size_t)t * 2048 + c); gbv[m][n] = *(const uint2*)(gates + (size_t)t * 2048 + 1024 + c); }
        mg_kloop_p(acc, ops1(rt, ct), 8, lds, it > 0, true, ops2(rt, ct));
#pragma unroll
        for (int m = 0; m < 4; ++m)
#pragma unroll
            for (int n = 0; n < 4; ++n) { const f32x4 ga = bf4(gav[m][n]), gb = bf4(gbv[m][n]);
#pragma unroll
                for (int j = 0; j < 4; ++j) acc[m][n][j] *= ga[j] * __builtin_amdgcn_rcpf(gb[j]); }
        mg_kloop_p(acc, ops2(rt, ct), 8, lds, true, have2, ops1(have2 ? rt2 : rt, have2 ? ct2 : ct));
#pragma unroll
        for (int m = 0; m < 4; ++m)
#pragma unroll
            for (int n = 0; n < 4; ++n) { const int t = row0 + wr * 64 + m * 16 + fr, c = col0 + wc * 64 + n * 16 + fq * 4;
                const f32x4 gb = bf4(gbv[m][n]);
                uint2 o; o.x = pk2(gb[0] * acc[m][n][0], gb[1] * acc[m][n][1]); o.y = pk2(gb[2] * acc[m][n][2], gb[3] * acc[m][n][3]); *(uint2*)(mo + (size_t)t * DM + c) = o; }
        rt = rt2; ct = ct2; have = have2;
    }
    __syncthreads();
}

__device__ __forceinline__ void phase5(const P& p, int bid, int nb, LAS unsigned char* sm) {
    const float* x = p.x; float* xm = p.out;
    mgemm(p.slotA, DM, p.WoutT, DM, NT, DM, DM, [=](int t, int c, const f32x4& v) {
        const f32x4 xv = *(const f32x4*)(x + (size_t)t * DM + c); *(f32x4*)(xm + (size_t)t * DM + c) = xv + v;
    }, bid, nb, sm);
}

__device__ __forceinline__ int gu_src_col(int rho, int& isup) {
    const int tt = rho >> 7, w = rho & 127, wc = w >> 6, n = (w >> 4) & 3, i = w & 15; isup = n >> 1; return tt * 64 + wc * 32 + (n & 1) * 16 + i;
}
__device__ __forceinline__ void ex_tile(const P& p, int tile, const float*& s0, const float*& s1, size_t& ld, bf16_t*& dst, int& K) {
    bf16_t* WguT = (bf16_t*)p.slotB; bf16_t* WdT = p.slotC + (size_t)NT * 512;
    const int e = tile / 192, tt = tile % 192;
    if (tt < 128) { const int tr = tt >> 4, tk = tt & 15, T = tr >> 1, wc = tr & 1, k0 = tk * 64, c0 = T * 64 + wc * 32;
        s0 = p.w_eg + ((size_t)e * 1024 + k0) * 256 + c0; s1 = p.w_eu + ((size_t)e * 1024 + k0) * 256 + c0; ld = 256; K = 1024;
        dst = WguT + ((size_t)e * 512 + tr * 64) * 1024 + k0; }
    else { const int t2 = tt - 128, tr = t2 >> 2, tk = t2 & 3, k0 = tk * 64, n0 = tr * 64;
        s0 = p.w_ed + ((size_t)e * 256 + k0) * 1024 + n0; s1 = s0 + 32; ld = 1024; K = 256;
        dst = WdT + ((size_t)e * 1024 + n0) * 256 + k0; }
}
__device__ __forceinline__ void expert_conv(const P& p, float* sm, LAS unsigned char* lds) {
    const int tid = opaque_tid(), kq = tid >> 4, r4 = (tid & 15) * 4;
    volatile LAS int* slot = (volatile LAS int*)(lds + LDS_MAIN_ + 8); unsigned* ctr = WQ_CTR(p.bar, 2);
    if (tid == 0) slot[0] = (int)__hip_atomic_fetch_add(ctr, 1u, __ATOMIC_RELAXED, __HIP_MEMORY_SCOPE_AGENT);
    __syncthreads();
    int q = slot[0];
    __syncthreads();
    while (q < 3072) {
        int pend = 0; if (tid == 0) pend = (int)__hip_atomic_fetch_add(ctr, 1u, __ATOMIC_RELAXED, __HIP_MEMORY_SCOPE_AGENT);
        f32x4 v[2][4]; bf16_t* dst[2]; int K[2];
#pragma unroll
        for (int u = 0; u < 2; ++u) { const float* s0; const float* s1; size_t ld; ex_tile(p, 2 * q + u, s0, s1, ld, dst[u], K[u]);
            const float* src = (r4 < 32 ? s0 + r4 : s1 + (r4 - 32));
#pragma unroll
            for (int i = 0; i < 4; ++i) v[u][i] = *(const f32x4*)(src + (size_t)(kq + 16 * i) * ld); }
#pragma unroll
        for (int u = 0; u < 2; ++u) {
#pragma unroll
            for (int i = 0; i < 4; ++i)
#pragma unroll
                for (int j = 0; j < 4; ++j) sm[u * 4160 + (kq + 16 * i) * 65 + r4 + j] = v[u][i][j]; }
        __syncthreads();
#pragma unroll
        for (int u = 0; u < 2; ++u) {
#pragma unroll
            for (int i = 0; i < 4; ++i) { const int rho = kq + 16 * i; const float* bb = sm + u * 4160 + r4 * 65 + rho;
                uint2 o; o.x = pk2(bb[0], bb[65]); o.y = pk2(bb[130], bb[195]); *(uint2*)(dst[u] + (size_t)rho * K[u] + r4) = o; } }
        if (tid == 0) slot[0] = pend;
        __syncthreads();
        q = slot[0];
    }
    __syncthreads();
}

__device__ __forceinline__ void phase6(const P& p, int bid, int nb, float* sm) {
    const int tid = opaque_tid(), lane = tid & 63, wid = tid >> 6;
    bf16_t* h2 = p.slotA; const float* xm = p.out;
    int* s_cnt = (int*)sm; int* s_base = s_cnt + 32; int* s_e = s_base + 32; int* s_r = s_e + 128; float* s_w = (float*)(s_r + 128);
    if (tid < 32) s_cnt[tid] = 0;
    __syncthreads();
    int slot = wid * 16;
    float* xs = sm + 512 + wid * 1024;
    f32x4 vpre[4]; f32x4 gf[4];
#pragma unroll
    for (int i = 0; i < 4; ++i) gf[i] = *(const f32x4*)(p.g_ffn + (lane + 64 * i) * 4);
    if (bid * 4 + wid < NT) {
#pragma unroll
        for (int i = 0; i < 4; ++i) vpre[i] = *(const f32x4*)(xm + (size_t)(bid * 4 + wid) * DM + (lane + 64 * i) * 4); }
    for (int t = bid * 4 + wid; t < NT; t += nb * 4, ++slot) {
        f32x4 v[4]; float ss = 0.f;
#pragma unroll
        for (int i = 0; i < 4; ++i) { v[i] = vpre[i]; ss += v[i][0] * v[i][0] + v[i][1] * v[i][1] + v[i][2] * v[i][2] + v[i][3] * v[i][3]; }
        if (t + nb * 4 < NT) {
#pragma unroll
            for (int i = 0; i < 4; ++i) vpre[i] = *(const f32x4*)(xm + (size_t)(t + nb * 4) * DM + (lane + 64 * i) * 4); }
        ss = wsumf(ss); const float r = rsqrtf(ss * (1.f / DM) + EPS);
#pragma unroll
        for (int i = 0; i < 4; ++i) { const f32x4 g = gf[i]; v[i] = v[i] * r * g; *(f32x4*)(xs + (lane + 64 * i) * 4) = v[i];
            uint2 o; o.x = pk2(v[i][0], v[i][1]); o.y = pk2(v[i][2], v[i][3]); *(uint2*)(h2 + (size_t)t * DM + (lane + 64 * i) * 4) = o; }
        f32x4 lgv = {0.f, 0.f, 0.f, 0.f};
#pragma unroll
        for (int i = 0; i < 16; ++i) { const int k = lane + 64 * i; lgv += xs[k] * *(const f32x4*)(p.w_rg + (size_t)k * 4); }
        float lg[4];
#pragma unroll
        for (int g = 0; g < 4; ++g) lg[g] = wsumf(lgv[g]) + p.b_rg[g];
        int gs = 0; float gm = lg[0];
#pragma unroll
        for (int g = 1; g < 4; ++g) if (lg[g] > gm) { gm = lg[g]; gs = g; }
        float den = 0.f;
#pragma unroll
        for (int g = 0; g < 4; ++g) den += __expf(lg[g] - gm);
        const float ptop = 1.f / den;
        f32x4 lev = {0.f, 0.f, 0.f, 0.f}; const float* wre = p.w_re + (size_t)gs * DM * 8;
#pragma unroll 16
        for (int i = 0; i < 32; ++i) { const int c = lane + 64 * i; lev += xs[c >> 1] * *(const f32x4*)(wre + (size_t)c * 4); }
        float le[8];
#pragma unroll
        for (int e = 0; e < 4; ++e) { const float mine = wsum_par(lev[e]), oth = DPP_F(mine, 0xB1); le[e] = mine + p.b_re[gs * 8 + e]; le[4 + e] = oth + p.b_re[gs * 8 + 4 + e]; }
        int e1 = 0; float l1 = le[0];
#pragma unroll
        for (int e = 1; e < 8; ++e) if (le[e] > l1) { l1 = le[e]; e1 = e; }
        int e2 = -1; float l2 = -3.0e38f;
#pragma unroll
        for (int e = 0; e < 8; ++e) if (e != e1 && le[e] > l2) { l2 = le[e]; e2 = e; }
        const float s1 = 1.f / (1.f + __expf(l2 - l1)), s2 = 1.f - s1;
        if (lane == 0) {
            const int ea = gs * 8 + e1, eb = gs * 8 + e2;
            s_e[2 * slot] = ea; s_e[2 * slot + 1] = eb; s_r[2 * slot] = atomicAdd(&s_cnt[ea], 1); s_r[2 * slot + 1] = atomicAdd(&s_cnt[eb], 1);
            s_w[2 * slot] = s1 * ptop; s_w[2 * slot + 1] = s2 * ptop;
        }
    }
    __syncthreads();
    if (tid < 32) { const int c = s_cnt[tid]; s_base[tid] = c ? atomicAdd(&p.cnt[tid], c) : 0; }
    __syncthreads();
    if (tid < 128) { const int sl = tid >> 1, kk = tid & 1, w = sl >> 4, k = sl & 15, t = bid * 4 + w + k * nb * 4;
        if (t < NT) { const int a = 2 * t + kk, e = s_e[tid]; p.list[(size_t)e * NT + s_base[e] + s_r[tid]] = a; p.aw[a] = s_w[tid]; p.aexp[a] = e; } }
    __syncthreads();
}

__device__ __forceinline__ void phase7a(const P& p, int bid, int nb) {
    const bf16_t* h2 = p.slotA; const bf16_t* WguT = (const bf16_t*)p.slotB; bf16_t* hid = p.slotE;
    for (size_t i = (size_t)bid * 256 + threadIdx.x; i < (size_t)2 * NT * 256; i += (size_t)nb * 256) {
        const int a = (int)(i >> 8), c = (int)(i & 255), t = a >> 1, e = p.aexp[a];
        const int tt = c >> 6, wc = (c >> 5) & 1, nn = (c >> 4) & 1, ii = c & 15; const int rg = tt * 128 + wc * 64 + nn * 16 + ii, ru = rg + 32;
        const bf16_t* wg = WguT + ((size_t)e * 512 + rg) * 1024; const bf16_t* wu = WguT + ((size_t)e * 512 + ru) * 1024; const bf16_t* hr = h2 + (size_t)t * DM;
        float G = 0.f, U = 0.f;
        for (int k = 0; k < DM / 8; ++k) { const uint4 hv = ((const uint4*)hr)[k]; G += dot8(hv, ((const uint4*)wg)[k]); U += dot8(hv, ((const uint4*)wu)[k]); }
        hid[i] = f2bf(G * sigmoidf_(G) * U);
    }
}
__device__ __forceinline__ void phase7b(const P& p, int bid, int nb) {
    const bf16_t* hid = p.slotE; const bf16_t* WdT = p.slotC + (size_t)NT * 512; bf16_t* Y = p.slotD;
    for (size_t i = (size_t)bid * 256 + threadIdx.x; i < (size_t)2 * NT * DM; i += (size_t)nb * 256) {
        const int a = (int)(i >> 10), n = (int)(i & 1023), e = p.aexp[a];
        const bf16_t* w = WdT + ((size_t)e * 1024 + n) * 256; const bf16_t* hr = hid + (size_t)a * 256; float s = 0.f;
        for (int k = 0; k < 32; ++k) s += dot8(((const uint4*)hr)[k], ((const uint4*)w)[k]);
        Y[i] = f2bf(s * p.aw[a]);
    }
}


__device__ __forceinline__ void build_expert_table(const int* cnt, volatile LAS int* tab) {
    const int tid = threadIdx.x;
    if (tid < 64) { const int c = tid < NE ? cnt[tid] : 0; int n = (c + 127) >> 7, incl = n;
#pragma unroll
        for (int o = 1; o < 32; o <<= 1) { const int y = __shfl_up(incl, o); if ((tid & 63) >= o) incl += y; }
        if (tid < NE) { tab[tid] = incl - n; tab[32 + tid] = c; } if (tid == NE - 1) tab[64] = incl; }
    __syncthreads();
}
__device__ __forceinline__ bool find_expert(volatile LAS int* tab, int ub, int& e, int& blk, int& ce) {
    if (ub >= tab[64]) return false;
    int lo = 0;
#pragma unroll
    for (int st = 16; st > 0; st >>= 1) if (tab[lo + st] <= ub) lo += st;
    e = lo; blk = ub - tab[lo]; ce = tab[32 + lo]; return true;
}
__device__ __forceinline__ void phase7a_m(const P& p, int bid, int nb, LAS unsigned char* lds) {
    const bf16_t* h2 = p.slotA; const bf16_t* WguT = (const bf16_t*)p.slotB; bf16_t* hid = p.slotE;
    const int tid = opaque_tid(), lane = tid & 63, wid = tid >> 6, wr = wid >> 1, wc = wid & 1, fr = lane & 15, fq = lane >> 4;
    const int c8 = ((tid & 7) ^ ((tid >> 3) & 7)) * 8;
    volatile LAS int* tab = (volatile LAS int*)(lds + LDS_TAB_); build_expert_table(p.cnt, tab);
    auto make = [&](int u, GOps& g) __attribute__((always_inline)) -> bool {
        int e, blk, ce; if (!find_expert(tab, u >> 2, e, blk, ce)) return false;
        const int ct = u & 3; const int* lst = p.list + (size_t)e * NT; const bf16_t* ap[4];
#pragma unroll
        for (int i = 0; i < 4; ++i) { int r = blk * 128 + (tid >> 3) + 32 * i; r = r < ce ? r : ce - 1; ap[i] = h2 + (size_t)(lst[r] >> 1) * DM + c8; }
        g.a0 = ap[0]; g.a1 = ap[1]; g.a2 = ap[2]; g.a3 = ap[3]; g.bp = WguT + ((size_t)e * 512 + ct * 128 + (tid >> 3)) * 1024 + c8; g.bstep = (size_t)32 * 1024; return true; };
    GOps cur; bool have = make(bid, cur);
    for (int u = bid, it = 0; have; u += nb, ++it) {
        GOps nxt = cur; const bool have2 = make(u + nb, nxt);
        f32x4 acc[4][4];
#pragma unroll
        for (int m = 0; m < 4; ++m)
#pragma unroll
            for (int n = 0; n < 4; ++n) acc[m][n] = (f32x4){0.f, 0.f, 0.f, 0.f};
        mg_kloop_p(acc, cur, 16, lds, it > 0, have2, nxt);
        const int ct = u & 3;
        bf16_t* hb = hid + ((size_t)(u >> 2) * 128 + wr * 64 + fr) * 256 + ct * 64 + wc * 32 + fq * 4;
#pragma unroll
        for (int m = 0; m < 4; ++m)
#pragma unroll
            for (int n = 0; n < 2; ++n) { float v[4];
#pragma unroll
                for (int j = 0; j < 4; ++j) { const float g = acc[m][n][j]; v[j] = g * fsigmoid(g) * acc[m][n + 2][j]; }
                uint2 o; o.x = pk2(v[0], v[1]); o.y = pk2(v[2], v[3]); *(uint2*)(hb + (size_t)(m * 16) * 256 + n * 16) = o; }
        cur = nxt; have = have2;
    }
    __syncthreads();
}
__device__ __forceinline__ void phase7b_m(const P& p, int bid, int nb, LAS unsigned char* lds) {
    const bf16_t* hid = p.slotE; const bf16_t* WdT = p.slotC + (size_t)NT * 512; bf16_t* Y = p.slotD;
    const int tid = opaque_tid(), lane = tid & 63, wid = tid >> 6, wr = wid >> 1, wc = wid & 1, fr = lane & 15, fq = lane >> 4;
    const int c8 = ((tid & 7) ^ ((tid >> 3) & 7)) * 8;
    int e, blk, ce;
    volatile LAS int* tab = (volatile LAS int*)(lds + LDS_TAB_); build_expert_table(p.cnt, tab);
    auto make = [&](int u, GOps& g, int& e_, int& blk_, int& ce_) __attribute__((always_inline)) -> bool {
        if (!find_expert(tab, u >> 3, e_, blk_, ce_)) return false;
        g = gops(hid + ((size_t)(u >> 3) * 128 + (tid >> 3)) * 256 + c8, (size_t)32 * 256, WdT + ((size_t)e_ * 1024 + (u & 7) * 128 + (tid >> 3)) * 256 + c8, (size_t)32 * 256); return true; };
    GOps cur; bool have = make(bid, cur, e, blk, ce);
    for (int u = bid, it = 0; have; u += nb, ++it) {
        GOps nxt = cur; int e2 = 0, blk2 = 0, ce2 = 0; const bool have2 = make(u + nb, nxt, e2, blk2, ce2);
        const int ct = u & 7; const int* lst = p.list + (size_t)e * NT;
        f32x4 acc[4][4];
#pragma unroll
        for (int m = 0; m < 4; ++m)
#pragma unroll
            for (int n = 0; n < 4; ++n) acc[m][n] = (f32x4){0.f, 0.f, 0.f, 0.f};
        mg_kloop_p(acc, cur, 4, lds, it > 0, have2, nxt);
#pragma unroll
        for (int m = 0; m < 4; ++m) { const int r = blk * 128 + wr * 64 + m * 16 + fr;
            if (r < ce) { const int a = lst[r]; const float w = p.aw[a]; bf16_t* yp = Y + (size_t)a * DM + ct * 128 + wc * 64 + fq * 4;
#pragma unroll
                for (int n = 0; n < 4; ++n) { uint2 o; o.x = pk2(acc[m][n][0] * w, acc[m][n][1] * w); o.y = pk2(acc[m][n][2] * w, acc[m][n][3] * w); *(uint2*)(yp + n * 16) = o; } } }
        cur = nxt; e = e2; blk = blk2; ce = ce2; have = have2;
    }
    __syncthreads();
}

__device__ __forceinline__ void phase8(const P& p, int bid, int nb, float* dst) {
    const int tid = opaque_tid(), lane = tid & 63, wid = tid >> 6; const bf16_t* Y = p.slotD;
    for (int t = bid * 4 + wid; t < NT; t += nb * 4) {
        f32x4 v[4]; float ss = 0.f;
#pragma unroll
        for (int i = 0; i < 4; ++i) { const int c = (lane + 64 * i) * 4;
            v[i] = *(const f32x4*)(p.out + (size_t)t * DM + c) + bf4(*(const uint2*)(Y + (size_t)(2 * t) * DM + c)) + bf4(*(const uint2*)(Y + (size_t)(2 * t + 1) * DM + c));
            ss += v[i][0] * v[i][0] + v[i][1] * v[i][1] + v[i][2] * v[i][2] + v[i][3] * v[i][3]; }
        ss = wsumf(ss); const float r = rsqrtf(ss * (1.f / DM) + EPS);
#pragma unroll
        for (int i = 0; i < 4; ++i) { const int c = (lane + 64 * i) * 4; const f32x4 g = *(const f32x4*)(p.g_final + c); *(f32x4*)(dst + (size_t)t * DM + c) = v[i] * r * g; }
    }
}

#define XB_TMO      128
#define XB_XCNT(j)  (256  + 64 * (j))
#define XB_XSUB(j)  (1280 + 64 * (j))
#define XB_XGEN(j)  (2304 + 64 * (j))
#define XB_TOP      3328
#define XB_TOPGEN   3392
#define XCD_BAR_WORDS 3456
#define XB_SPIN_CAP (1u << 18)
__device__ __forceinline__ unsigned xb_ld(unsigned* p)              { return __hip_atomic_load(p, __ATOMIC_RELAXED, __HIP_MEMORY_SCOPE_AGENT); }
__device__ __forceinline__ unsigned xb_add(unsigned* p, unsigned v) { return __hip_atomic_fetch_add(p, v, __ATOMIC_RELAXED, __HIP_MEMORY_SCOPE_AGENT); }
__device__ __forceinline__ unsigned xb_xcc_id() { return (unsigned)__builtin_amdgcn_s_getreg((3 << 11) | 20) & 0xFu; }
#define XB_SPIN(cond, bar) do { unsigned _sp = 0; while (cond) { __builtin_amdgcn_s_sleep(1); \
    if ((++_sp & 255u) == 0u) { if (xb_ld(&(bar)[XB_TMO])) break; if (_sp > XB_SPIN_CAP) { atomicAdd(&(bar)[XB_TMO], 1u); break; } } } } while (0)
struct XcdBarrier { unsigned* bar; unsigned x; volatile LAS unsigned* st; };
__device__ __forceinline__ XcdBarrier xcd_barrier_post(unsigned* bar, volatile LAS unsigned* st) {
    XcdBarrier b; b.bar = bar; b.x = xb_xcc_id(); b.st = st;
    if (threadIdx.x == 0) (void)xb_add(&bar[XB_XCNT(b.x)], 1u);
    return b;
}
__device__ __forceinline__ void xcd_barrier_complete(unsigned* bar, unsigned x, unsigned& nloc, unsigned& nx) {
    const unsigned G = gridDim.x * gridDim.y * gridDim.z;
    unsigned sum, cnt, mine, sp = 0u;
    for (;;) {
        sum = 0u; cnt = 0u; mine = 0u;
#pragma unroll
        for (unsigned j = 0; j < 16; ++j) { const unsigned c = xb_ld(&bar[XB_XCNT(j)]); sum += c; cnt += (c > 0u) ? 1u : 0u; mine = (j == x) ? c : mine; }
        if (sum == G) break;
        __builtin_amdgcn_s_sleep(1);
        if ((++sp & 255u) == 0u) { if (xb_ld(&bar[XB_TMO])) break; if (sp > XB_SPIN_CAP) { atomicAdd(&bar[XB_TMO], 1u); break; } }
    }
    nloc = mine > 0u ? mine : 1u; nx = cnt > 0u ? cnt : 1u;
}
__device__ __forceinline__ void xcd_barrier(const XcdBarrier& b) {
    asm volatile("s_waitcnt vmcnt(0)" ::: "memory");
    __syncthreads();
    if (threadIdx.x == 0) {
        unsigned* bar = b.bar;
        __builtin_amdgcn_s_waitcnt(0);
        unsigned nloc = b.st[0], nx = b.st[1];
        if (nloc == 0u) { xcd_barrier_complete(bar, b.x, nloc, nx); b.st[0] = nloc; b.st[1] = nx; }
        const unsigned old = xb_add(&bar[XB_XSUB(b.x)], 1u);
        const unsigned gen = old / nloc;
        if (old + 1u == (gen + 1u) * nloc) {
            __builtin_amdgcn_fence(__ATOMIC_RELEASE, "agent");
            asm volatile("s_waitcnt vmcnt(0)" ::: "memory");
            const unsigned og = xb_add(&bar[XB_TOP], 1u);
            const unsigned tg = og / nx;
            if (og + 1u == (tg + 1u) * nx) xb_add(&bar[XB_TOPGEN], 1u);
            else XB_SPIN(xb_ld(&bar[XB_TOPGEN]) == tg, bar);
            __builtin_amdgcn_fence(__ATOMIC_ACQUIRE, "agent");
            xb_add(&bar[XB_XGEN(b.x)], 1u);
            asm volatile("s_waitcnt vmcnt(0)" ::: "memory");
        } else {
            XB_SPIN(xb_ld(&bar[XB_XGEN(b.x)]) == gen, bar);
            __builtin_amdgcn_fence(__ATOMIC_ACQUIRE, "agent");
            asm volatile("s_waitcnt vmcnt(0)" ::: "memory");
        }
    }
    __syncthreads();
}

constexpr int LDS_MAIN = 64 * 1024;
constexpr int LDS_BYTES = LDS_MAIN + 16 + 288;
extern __shared__ __attribute__((aligned(16))) unsigned char smem_raw[];

#if MK_LAUNCHES != 1
__global__ void __launch_bounds__(256, 2) k_phase(P p, int ph) {
    float* sm = (float*)smem_raw; LAS unsigned char* lds = (LAS unsigned char*)smem_raw; const int bid = blockIdx.x, nb = gridDim.x;
    switch (ph) {
        case 0: phase0(p, bid, nb, sm); break;
        case 1: phase1(p, bid, nb, lds); break;
        case 2: phase2a(p, bid, nb, false); break;
        case 3: phase2b(p, bid, nb, lds); break;
        case 4: phase2c_m(p, bid, nb, lds); break;
        case 5: phase3q<0>(p, bid, nb, lds); break;
        case 6: phase4(p, bid, nb, lds); break;
        case 7: phase5(p, bid, nb, lds); break;
        case 8: phase6(p, bid, nb, sm); break;
        case 9: phase7a_m(p, bid, nb, lds); break;
        case 10: phase7b_m(p, bid, nb, lds); break;
        case 11: phase8(p, bid, nb, p.out); break;
    }
}
#endif

#ifndef PROF_SEL
#define PROF_SEL -1
#endif
#define PROF_MULT 4
__global__ void __launch_bounds__(256, 2) k_mega(P p) {
    float* sm = (float*)smem_raw; LAS unsigned char* lds = (LAS unsigned char*)smem_raw; const int bid = blockIdx.x, nb = gridDim.x;
    volatile LAS unsigned* st = (volatile LAS unsigned*)(lds + LDS_MAIN);
    if (threadIdx.x < 4) st[threadIdx.x] = 0u;
    __syncthreads();
    const XcdBarrier gb = xcd_barrier_post(p.bar, st);
    unsigned long long t_last = 0, t_sel = 0;
#define STAMP(k) do { if (PROF_SEL >= 0 && PROF_SEL < 100) { const unsigned long long t_ = __builtin_amdgcn_s_memrealtime(); if (PROF_SEL == (k) - 1) t_sel = t_ - t_last; t_last = t_; } } while (0)
#define BAR(k) do { if (PROF_SEL == 100 + (k)) { const unsigned long long ta_ = __builtin_amdgcn_s_memrealtime(); xcd_barrier(gb); const unsigned long long tb_ = __builtin_amdgcn_s_memrealtime(); \
        if (threadIdx.x == 0) atomicAdd(p.bar + XCD_BAR_WORDS, (unsigned)(tb_ - ta_)); } else xcd_barrier(gb); STAMP((k) + 1); } while (0)
    STAMP(0);
    phase0(p, bid, nb, sm); BAR(0);
    phase1(p, bid, nb, lds); BAR(1);
    phase2a(p, bid, nb, false); BAR(2);
    phase2b(p, bid, nb, lds); phase2c_m(p, bid, nb, lds); BAR(3);
    phase3q<0>(p, bid, nb, lds); expert_conv(p, sm, lds); BAR(4);
    phase4(p, bid, nb, lds); BAR(5);
    phase5(p, bid, nb, lds); BAR(6);
    phase6(p, bid, nb, sm); BAR(7);
    phase7a_m(p, bid, nb, lds); BAR(8);
    phase7b_m(p, bid, nb, lds); BAR(9);
    phase8(p, bid, nb, p.out);
    if (PROF_SEL >= 0) {
        xcd_barrier(gb); STAMP(11);
        if (bid == 0 && threadIdx.x == 0) {
            unsigned long long metric = t_sel;
            if (PROF_SEL >= 100) metric = __hip_atomic_load(p.bar + XCD_BAR_WORDS, __ATOMIC_RELAXED, __HIP_MEMORY_SCOPE_AGENT) / (unsigned)nb;
            const unsigned long long t0 = __builtin_amdgcn_s_memrealtime();
            while (__builtin_amdgcn_s_memrealtime() - t0 < metric * PROF_MULT) __builtin_amdgcn_s_sleep(8);
        }
    }
}

extern "C" void kernel_launch(void* const* d_in, const int* in_sizes, int n_in, void* d_out, int out_size, void* d_ws, size_t ws_size, hipStream_t stream) {
    P p{};
    p.x = (const float*)d_in[0]; p.pos = (const int*)d_in[1]; p.g_attn = (const float*)d_in[2]; p.w_in = (const float*)d_in[3]; p.g_cq = (const float*)d_in[4];
    p.w_uq = (const float*)d_in[5]; p.g_ckv = (const float*)d_in[6]; p.w_uk = (const float*)d_in[7]; p.w_uv = (const float*)d_in[8]; p.w_o_attn = (const float*)d_in[9];
    p.sgu_gain = (const float*)d_in[10]; p.sgu_bias = (const float*)d_in[11]; p.w_sp = (const float*)d_in[12]; p.b_sp = (const float*)d_in[13]; p.w_o_sgu = (const float*)d_in[14];
    p.w_out = (const float*)d_in[15]; p.g_ffn = (const float*)d_in[16]; p.w_rg = (const float*)d_in[17]; p.b_rg = (const float*)d_in[18]; p.w_re = (const float*)d_in[19];
    p.b_re = (const float*)d_in[20]; p.w_eg = (const float*)d_in[21]; p.w_eu = (const float*)d_in[22]; p.w_ed = (const float*)d_in[23]; p.g_final = (const float*)d_in[24];
    p.out = (float*)d_out;
    unsigned char* w = (unsigned char*)d_ws; size_t off = 0;
    auto take = [&](size_t bytes) { unsigned char* r = w + off; off += (bytes + 255) & ~(size_t)255; return r; };
    p.bar = (unsigned*)take((XCD_BAR_WORDS + 256) * 4);
    p.cnt = (int*)take(4096);
    p.WinT = (bf16_t*)take((size_t)ZP * DM * 2); p.WuqT = (bf16_t*)take(768 * 256 * 2); p.WukT = (bf16_t*)take(512 * 128 * 2); p.WuvT = (bf16_t*)take(512 * 128 * 2);
    p.WoaT = (bf16_t*)take(1024 * 512 * 2); p.WosT = (bf16_t*)take(1024 * 512 * 2); p.WoutT = (bf16_t*)take(1024 * 1024 * 2); p.Wsp = (bf16_t*)take(8 * 128 * 128 * 2);
    p.cs = (float*)take((size_t)NT * 32 * 4); p.cqn = (bf16_t*)take((size_t)NT * 256 * 2); p.ckvn = (bf16_t*)take((size_t)NT * 128 * 2);
    p.list = (int*)take((size_t)NE * NT * 4); p.aw = (float*)take((size_t)2 * NT * 4); p.aexp = (int*)take((size_t)2 * NT * 4);
    p.slotA = (bf16_t*)take((size_t)NT * DM * 2);
    p.slotB = take((size_t)NT * 512 * 4);
    p.slotC = (bf16_t*)take((size_t)NT * 1024 * 2);
    p.slotD = (bf16_t*)take((size_t)NT * 2048 * 2);
    p.slotE = (bf16_t*)take((size_t)NT * NH * 96 * 2);
    p.slotF = (bf16_t*)take((size_t)512 * NT * 2);
    p.slotG = (bf16_t*)take((size_t)NT * 512 * 2);
    if (off > ws_size) { fprintf(stderr, "workspace too small: need %zu have %zu\n", off, ws_size); return; }
#if MK_LAUNCHES == 1
    static int grid_blocks = 0;
    if (!grid_blocks) { int dev = 0, cus = 0, per_cu = 0; hipGetDevice(&dev); hipDeviceGetAttribute(&cus, hipDeviceAttributeMultiprocessorCount, dev);
        hipOccupancyMaxActiveBlocksPerMultiprocessor(&per_cu, k_mega, 256, LDS_BYTES); if (per_cu > 2) per_cu = 2; grid_blocks = cus * per_cu; }
    (void)hipMemsetAsync(p.bar, 0, (XCD_BAR_WORDS + 256) * 4, stream);
    void* args[] = {&p};
    hipError_t e = hipLaunchCooperativeKernel((void*)k_mega, dim3(grid_blocks), dim3(256), args, LDS_BYTES, stream);
    if (e != hipSuccess) fprintf(stderr, "cooperative launch failed: %s (grid %d)\n", hipGetErrorString(e), grid_blocks);
#else
    for (int ph = 0; ph < 12; ++ph) k_phase<<<2048, 256, LDS_BYTES, stream>>>(p, ph);
#endif
}
```

```cpp
#include <hip/hip_runtime.h>
#include <hip/hip_cooperative_groups.h>
#include <cstdint>
#include <cstdio>
namespace cg = cooperative_groups;

#ifndef ATT_SGB
#define ATT_SGB 1
#endif
#ifndef PROBE
#define PROBE 0
#endif
#ifndef MK_LAUNCHES
#define MK_LAUNCHES 1
#endif

typedef unsigned short bf16_t;
constexpr int NT = 16384, SEQ = 8192, DM = 1024, NBATCH = 2;
constexpr int ZC = 3488;
constexpr int ZP = 3584;
constexpr int NH = 8;
constexpr float EPS = 1e-6f;
constexpr int NE = 32;
#define WQ_CTR(bar, k) ((bar) + 3456 + 64 + 16 * (k))
constexpr int LDS_MAIN_ = 64 * 1024;
constexpr int LDS_TAB_ = 64 * 1024 + 16;

struct P {
    const float* x; const int* pos; const float* g_attn; const float* w_in; const float* g_cq; const float* w_uq;
    const float* g_ckv; const float* w_uk; const float* w_uv; const float* w_o_attn; const float* sgu_gain; const float* sgu_bias;
    const float* w_sp; const float* b_sp; const float* w_o_sgu; const float* w_out; const float* g_ffn; const float* w_rg;
    const float* b_rg; const float* w_re; const float* b_re; const float* w_eg; const float* w_eu; const float* w_ed; const float* g_final;
    float* out;
    unsigned* bar;
    int* cnt;
    bf16_t* WinT;
    bf16_t* WuqT;
    bf16_t* WukT;
    bf16_t* WuvT;
    bf16_t* WoaT;
    bf16_t* WosT;
    bf16_t* WoutT;
    bf16_t* Wsp;
    float* cs;
    bf16_t* cqn;
    bf16_t* ckvn;
    int* list;
    float* aw;
    int* aexp;
    bf16_t* slotA;
    unsigned char* slotB;
    bf16_t* slotC;
    bf16_t* slotD;
    bf16_t* slotE;
    bf16_t* slotF;
    bf16_t* slotG;
};

__device__ __forceinline__ int opaque_tid() { int t = threadIdx.x; asm volatile("" : "+v"(t)); return t; }
__device__ __forceinline__ float bf2f(bf16_t v) { return __uint_as_float(((unsigned)v) << 16); }
__device__ __forceinline__ bf16_t f2bf(float f) { unsigned u = __float_as_uint(f); u += 0x7fffu + ((u >> 16) & 1u); return (bf16_t)(u >> 16); }
__device__ __forceinline__ float dot8(const uint4 a, const uint4 b) {
    float s = 0.f;
    s += __uint_as_float(a.x << 16) * __uint_as_float(b.x << 16) + __uint_as_float(a.x & 0xffff0000u) * __uint_as_float(b.x & 0xffff0000u);
    s += __uint_as_float(a.y << 16) * __uint_as_float(b.y << 16) + __uint_as_float(a.y & 0xffff0000u) * __uint_as_float(b.y & 0xffff0000u);
    s += __uint_as_float(a.z << 16) * __uint_as_float(b.z << 16) + __uint_as_float(a.z & 0xffff0000u) * __uint_as_float(b.z & 0xffff0000u);
    s += __uint_as_float(a.w << 16) * __uint_as_float(b.w << 16) + __uint_as_float(a.w & 0xffff0000u) * __uint_as_float(b.w & 0xffff0000u);
    return s;
}
__device__ __forceinline__ float wsum(float v) { for (int o = 32; o > 0; o >>= 1) v += __shfl_xor(v, o); return v; }

#define DPP_F(v, ctrl) __builtin_bit_cast(float, __builtin_amdgcn_update_dpp(0, __builtin_bit_cast(int, (v)), (ctrl), 0xF, 0xF, true))
__device__ __forceinline__ float xrows(float v) {
    { const auto r = __builtin_amdgcn_permlane16_swap(__float_as_uint(v), __float_as_uint(v), false, false); v = __uint_as_float(r[0]) + __uint_as_float(r[1]); }
    { const auto r = __builtin_amdgcn_permlane32_swap(__float_as_uint(v), __float_as_uint(v), false, false); v = __uint_as_float(r[0]) + __uint_as_float(r[1]); }
    return v;
}
__device__ __forceinline__ float wsumf(float v) {
    v += DPP_F(v, 0xB1); v += DPP_F(v, 0x4E); v += DPP_F(v, 0x141); v += DPP_F(v, 0x140); return xrows(v);
}
__device__ __forceinline__ float wsum_par(float v) {
    v += DPP_F(v, 0x128); v += DPP_F(v, 0x124); v += DPP_F(v, 0x122); return xrows(v);
}
__device__ __forceinline__ float wmax(float v) { for (int o = 32; o > 0; o >>= 1) v = fmaxf(v, __shfl_xor(v, o)); return v; }
__device__ __forceinline__ float fsigmoid(float v) { return __builtin_amdgcn_rcpf(1.f + __builtin_amdgcn_exp2f(-1.4426950408889634f * v)); }
__device__ __forceinline__ float fgelu(float v) { const float u2 = 1.5957691216057308f * (v + 0.044715f * v * v * v); return v * fsigmoid(u2); }
__device__ __forceinline__ float gelu_tanh(float v) { const float u = 0.7978845608028654f * (v + 0.044715f * v * v * v); const float t = 1.f - 2.f / (__expf(2.f * u) + 1.f); return 0.5f * v * (1.f + t); }
__device__ __forceinline__ float sigmoidf_(float v) { return 1.f / (1.f + __expf(-v)); }

#define LAS __attribute__((address_space(3)))
typedef short bf16x8 __attribute__((ext_vector_type(8)));
typedef float f32x4 __attribute__((ext_vector_type(4)));
constexpr int GEMM_LDS = 65536;
typedef float f32x16 __attribute__((ext_vector_type(16)));
typedef unsigned u32x2 __attribute__((ext_vector_type(2)));
typedef unsigned u32x4 __attribute__((ext_vector_type(4)));
typedef __bf16 bf16v2 __attribute__((ext_vector_type(2)));
typedef float f32v2 __attribute__((ext_vector_type(2)));
__device__ __forceinline__ unsigned pk2(float lo, float hi) { const f32v2 v = {lo, hi}; return __builtin_bit_cast(unsigned, __builtin_convertvector(v, bf16v2)); }
__device__ __forceinline__ f32x4 bf4(const uint2 u) { return (f32x4){__uint_as_float(u.x << 16), __uint_as_float(u.x & 0xffff0000u), __uint_as_float(u.y << 16), __uint_as_float(u.y & 0xffff0000u)}; }


template <class F>
__device__ __forceinline__ int tconv(bf16_t* dst, int R, int K, F f, int base, int bid, int nb, float* sm) {
    const int tid = opaque_tid(), tk = K / 64, ntile = (R / 64) * tk;
    for (int tile = ((bid - base) % nb + nb) % nb; tile < ntile; tile += nb) {
        const int rho0 = (tile / tk) * 64, k0 = (tile % tk) * 64;
#pragma unroll
        for (int i = 0; i < 16; ++i) { const int kk = (tid >> 6) + 4 * i, rr = tid & 63; sm[kk * 65 + rr] = f(k0 + kk, rho0 + rr); }
        __syncthreads();
#pragma unroll
        for (int i = 0; i < 8; ++i) { const int rr = (tid >> 5) + 8 * i, kk = (tid & 31) * 2;
            *(unsigned*)(dst + (size_t)(rho0 + rr) * K + k0 + kk) = pk2(sm[kk * 65 + rr], sm[(kk + 1) * 65 + rr]); }
        __syncthreads();
    }
    return base + ntile;
}

__device__ __forceinline__ void phase0(const P& p, int bid, int nb, float* sm) {
    const int tid = opaque_tid(), lane = tid & 63, wid = tid >> 6;
    const size_t gtid = (size_t)bid * 256 + tid, gsz = (size_t)nb * 256;
    if (bid == 0 && tid < NE) p.cnt[tid] = 0;
    { int t = bid * 4 + wid; f32x4 v[4];
      if (t < NT) {
#pragma unroll
          for (int i = 0; i < 4; ++i) v[i] = *(const f32x4*)(p.x + (size_t)t * DM + (lane + 64 * i) * 4); }
      for (; t < NT; t += nb * 4) {
          const int tn = t + nb * 4; f32x4 vn[4];
          if (tn < NT) {
#pragma unroll
              for (int i = 0; i < 4; ++i) vn[i] = *(const f32x4*)(p.x + (size_t)tn * DM + (lane + 64 * i) * 4); }
          float ss = 0.f;
#pragma unroll
          for (int i = 0; i < 4; ++i) ss += v[i][0] * v[i][0] + v[i][1] * v[i][1] + v[i][2] * v[i][2] + v[i][3] * v[i][3];
          ss = wsumf(ss); const float r = rsqrtf(ss * (1.f / DM) + EPS);
          bf16_t* hr = p.slotA + (size_t)t * DM;
#pragma unroll
          for (int i = 0; i < 4; ++i) { uint2 o; o.x = pk2(v[i][0] * r, v[i][1] * r); o.y = pk2(v[i][2] * r, v[i][3] * r); *(uint2*)(hr + (lane + 64 * i) * 4) = o; }
#pragma unroll
          for (int i = 0; i < 4; ++i) v[i] = vn[i];
      } }
    { const int kq = tid >> 4, r4 = (tid & 15) * 4;
      for (int t0 = bid; t0 < 1408; t0 += 2 * nb) {
          f32x4 v[2][4]; bf16_t* dst[2]; int Kd[2]; const int nt = (t0 + nb < 1408) ? 2 : 1;
#pragma unroll
          for (int u = 0; u < 2; ++u) if (u < nt) { const int tile = t0 + u * nb; const float* src; size_t ld; const float* gain = nullptr; bool zero = false;
              if (tile < 896) { const int tr = tile >> 4, k0 = (tile & 15) * 64, rho0 = tr * 64; const int col0 = rho0 < 512 ? rho0 : rho0 - 96;
                  zero = (rho0 == 448) || (rho0 == 384 && r4 >= 32);
                  src = p.w_in + (size_t)k0 * ZC + col0 + r4; ld = ZC; gain = p.g_attn + k0; dst[u] = p.WinT + (size_t)rho0 * DM + k0; Kd[u] = DM; }
              else if (tile < 1152) { const int t2 = tile - 896, w = t2 >> 7, t3 = t2 & 127, n0 = (t3 >> 3) * 64, k0 = (t3 & 7) * 64;
                  src = (w ? p.w_o_sgu : p.w_o_attn) + (size_t)k0 * 1024 + n0 + r4; ld = 1024; dst[u] = (w ? p.WosT : p.WoaT) + (size_t)n0 * 512 + k0; Kd[u] = 512; }
              else { const int t2 = tile - 1152, n0 = (t2 >> 4) * 64, k0 = (t2 & 15) * 64; src = p.w_out + (size_t)k0 * 1024 + n0 + r4; ld = 1024; dst[u] = p.WoutT + (size_t)n0 * 1024 + k0; Kd[u] = 1024; }
#pragma unroll
              for (int i = 0; i < 4; ++i) { const int kk = kq + 16 * i; f32x4 x = zero ? (f32x4){0.f, 0.f, 0.f, 0.f} : *(const f32x4*)(src + (size_t)kk * ld); if (gain) x = x * gain[kk]; v[u][i] = x; } }
#pragma unroll
          for (int u = 0; u < 2; ++u) if (u < nt) {
#pragma unroll
              for (int i = 0; i < 4; ++i)
#pragma unroll
                  for (int j = 0; j < 4; ++j) sm[u * 4160 + (kq + 16 * i) * 65 + r4 + j] = v[u][i][j]; }
          __syncthreads();
#pragma unroll
          for (int u = 0; u < 2; ++u) if (u < nt) {
#pragma unroll
              for (int i = 0; i < 4; ++i) { const int rho = kq + 16 * i; const float* bb = sm + u * 4160 + r4 * 65 + rho;
                  uint2 o; o.x = pk2(bb[0], bb[65]); o.y = pk2(bb[130], bb[195]); *(uint2*)(dst[u] + (size_t)rho * Kd[u] + r4) = o; } }
          __syncthreads();
      } }
    int base = 0;
    const float qscale = 0.10206207261596575f * 1.4426950408889634f;
    base = tconv(p.WuqT, 768, 256, [&](int k, int rho) { int col;
        if (rho < 512) col = (rho >> 6) * 96 + (rho & 63); else { const int hh = (rho - 512) >> 5, w = (rho - 512) & 31; col = hh * 96 + 64 + (w >> 1) + 16 * (w & 1); }
        return p.w_uq[(size_t)k * 768 + col] * p.g_cq[k] * qscale; }, base, bid, nb, sm);
    base = tconv(p.WukT, 512, 128, [&](int k, int c) { return p.w_uk[(size_t)k * 512 + c] * p.g_ckv[k]; }, base, bid, nb, sm);
    base = tconv(p.WuvT, 512, 128, [&](int k, int c) { return p.w_uv[(size_t)k * 512 + c] * p.g_ckv[k]; }, base, bid, nb, sm);
    for (size_t i = gtid; i < (size_t)8 * 128 * 128; i += gsz) { const int j = (int)(i & 127), ii = (int)((i >> 7) & 127);
        p.Wsp[i] = ((j >> 6) <= (ii >> 6)) ? f2bf(p.w_sp[i]) : (bf16_t)0; }
}

template <class Epi>
__device__ void ngemm(const bf16_t* A, int lda, const bf16_t* Bt, int ldb, int M, int N, int K, Epi epi, int bid, int nb, float* sm) {
    float* As = sm; float* Bs = sm + 16 * 68;
    const int tid = opaque_tid(), ty = tid >> 4, tx = tid & 15; const int tn = N / 64, ntile = (M / 64) * tn;
    for (int tile = bid; tile < ntile; tile += nb) {
        const int row0 = (tile / tn) * 64, col0 = (tile % tn) * 64;
        float acc[4][4];
#pragma unroll
        for (int i = 0; i < 4; ++i)
#pragma unroll
            for (int j = 0; j < 4; ++j) acc[i][j] = 0.f;
        for (int k0 = 0; k0 < K; k0 += 16) {
#pragma unroll
            for (int i = 0; i < 4; ++i) { const int idx = tid + i * 256, r = idx >> 4, kk = idx & 15;
                As[kk * 68 + r] = bf2f(A[(size_t)(row0 + r) * lda + k0 + kk]);
                Bs[kk * 68 + r] = bf2f(Bt[(size_t)(col0 + r) * ldb + k0 + kk]); }
            __syncthreads();
#pragma unroll
            for (int kk = 0; kk < 16; ++kk) { float a[4], b[4];
#pragma unroll
                for (int i = 0; i < 4; ++i) { a[i] = As[kk * 68 + ty * 4 + i]; b[i] = Bs[kk * 68 + tx * 4 + i]; }
#pragma unroll
                for (int i = 0; i < 4; ++i)
#pragma unroll
                    for (int j = 0; j < 4; ++j) acc[i][j] += a[i] * b[j]; }
            __syncthreads();
        }
#pragma unroll
        for (int i = 0; i < 4; ++i) epi(row0 + ty * 4 + i, col0 + tx * 4, acc[i]);
    }
}


__device__ __forceinline__ bool tile_of(int it, int bid, int nb, int RT, int CT, int& rt, int& ct) {
    if ((RT & 31) == 0 && (nb & 7) == 0) {
        const int x = bid & 7, l = bid >> 3, nl = nb >> 3, rpx = RT >> 3; const int lt = l + it * nl; if (lt >= rpx * CT) return false;
        const int rg = lt / (4 * CT), w = lt % (4 * CT); rt = x * rpx + rg * 4 + (w & 3); ct = w >> 2; return true;
    }
    const int tile = bid + it * nb; if (tile >= RT * CT) return false; rt = tile / CT; ct = tile % CT; return true;
}
struct GOps { const bf16_t* a0; const bf16_t* a1; const bf16_t* a2; const bf16_t* a3; const bf16_t* bp; size_t bstep; };
__device__ __forceinline__ GOps gops(const bf16_t* ap, size_t astep, const bf16_t* bp, size_t bstep) { GOps g; g.a0 = ap; g.a1 = ap + astep; g.a2 = ap + 2 * astep; g.a3 = ap + 3 * astep; g.bp = bp; g.bstep = bstep; return g; }
__device__ __forceinline__ void mg_stage(const GOps& g, int t, LAS unsigned char* lds, int widu) {
    LAS unsigned char* d = lds + (t & 1) * 32768 + widu * 1024; const int k0 = t * 64;
    __builtin_amdgcn_global_load_lds((const unsigned*)(g.a0 + k0), (LAS unsigned*)(d), 16, 0, 0);
    __builtin_amdgcn_global_load_lds((const unsigned*)(g.a1 + k0), (LAS unsigned*)(d + 4096), 16, 0, 0);
    __builtin_amdgcn_global_load_lds((const unsigned*)(g.a2 + k0), (LAS unsigned*)(d + 8192), 16, 0, 0);
    __builtin_amdgcn_global_load_lds((const unsigned*)(g.a3 + k0), (LAS unsigned*)(d + 12288), 16, 0, 0);
#pragma unroll
    for (int i = 0; i < 4; ++i) __builtin_amdgcn_global_load_lds((const unsigned*)(g.bp + i * g.bstep + k0), (LAS unsigned*)(d + 16384 + i * 4096), 16, 0, 0);
}
__device__ __forceinline__ void mg_kloop_p(f32x4 (&acc)[4][4], const GOps& g, int nk, LAS unsigned char* lds, bool prestaged, bool has_next, const GOps& nxt) {
    const int tid = opaque_tid(), lane = tid & 63, wid = tid >> 6, wr = wid >> 1, wc = wid & 1, fr = lane & 15, fq = lane >> 4;
    const int widu = __builtin_amdgcn_readfirstlane(wid);
    if (!prestaged) mg_stage(g, 0, lds, widu);
    const int pc0 = ((fq) ^ (fr & 7)) * 16, pc1 = ((4 + fq) ^ (fr & 7)) * 16;
    for (int t = 0; t < nk; ++t) {
        asm volatile("s_waitcnt vmcnt(0)" ::: "memory");
        __syncthreads();
        if (t + 1 < nk) mg_stage(g, t + 1, lds, widu); else if (has_next) mg_stage(nxt, 0, lds, widu);
        const LAS unsigned char* ab = lds + (t & 1) * 32768 + (wr * 64 + fr) * 128; const LAS unsigned char* bb = lds + (t & 1) * 32768 + 16384 + (wc * 64 + fr) * 128;
        bf16x8 af[2][4], bfr[2][4];
#pragma unroll
        for (int m = 0; m < 4; ++m) { af[0][m] = *(const LAS bf16x8*)(ab + m * 2048 + pc0); bfr[0][m] = *(const LAS bf16x8*)(bb + m * 2048 + pc0); }
#pragma unroll
        for (int m = 0; m < 4; ++m) { af[1][m] = *(const LAS bf16x8*)(ab + m * 2048 + pc1); bfr[1][m] = *(const LAS bf16x8*)(bb + m * 2048 + pc1); }
        __builtin_amdgcn_sched_barrier(0);
#pragma unroll
        for (int ks = 0; ks < 2; ++ks)
#pragma unroll
            for (int m = 0; m < 4; ++m)
#pragma unroll
                for (int n = 0; n < 4; ++n) acc[m][n] = __builtin_amdgcn_mfma_f32_16x16x32_bf16(bfr[ks][n], af[ks][m], acc[m][n], 0, 0, 0);
    }
}
template <class Epi>
__device__ __forceinline__ void mgemm(const bf16_t* A, int lda, const bf16_t* Bt, int ldb, int M, int N, int K, Epi epi, int bid, int nb, LAS unsigned char* lds) {
    const int tid = opaque_tid(), lane = tid & 63, wid = tid >> 6, wr = wid >> 1, wc = wid & 1, fr = lane & 15, fq = lane >> 4;
    const int RT = M / 128, CT = N / 128; const int c8 = ((tid & 7) ^ ((tid >> 3) & 7)) * 8;
    int rt, ct; bool have = tile_of(0, bid, nb, RT, CT, rt, ct);
    GOps cur = gops(A + (size_t)(rt * 128 + (tid >> 3)) * lda + c8, (size_t)32 * lda, Bt + (size_t)(ct * 128 + (tid >> 3)) * ldb + c8, (size_t)32 * ldb);
    for (int it = 0; have; ++it) {
        const int row0 = rt * 128, col0 = ct * 128;
        int rt2, ct2; const bool have2 = tile_of(it + 1, bid, nb, RT, CT, rt2, ct2);
        const GOps nxt = gops(A + (size_t)((have2 ? rt2 : rt) * 128 + (tid >> 3)) * lda + c8, (size_t)32 * lda, Bt + (size_t)((have2 ? ct2 : ct) * 128 + (tid >> 3)) * ldb + c8, (size_t)32 * ldb);
        f32x4 acc[4][4];
#pragma unroll
        for (int m = 0; m < 4; ++m)
#pragma unroll
            for (int n = 0; n < 4; ++n) acc[m][n] = (f32x4){0.f, 0.f, 0.f, 0.f};
        mg_kloop_p(acc, cur, K / 64, lds, it > 0, have2, nxt);
#pragma unroll
        for (int m = 0; m < 4; ++m)
#pragma unroll
            for (int n = 0; n < 4; ++n) epi(row0 + wr * 64 + m * 16 + fr, col0 + wc * 64 + n * 16 + fq * 4, acc[m][n]);
        cur = nxt; rt = rt2; ct = ct2; have = have2;
    }
    __syncthreads();
}


__device__ __forceinline__ void stg_put(LAS unsigned char* S, int r, int c4, const uint2 v) { const u32x2 w = {v.x, v.y};
    *(LAS u32x2*)(S + r * 256 + (((c4 >> 3) ^ (r & 15)) << 4) + ((c4 & 4) << 1)) = w; }
__device__ __forceinline__ void stg_put32(LAS unsigned char* S, int r, int c2, const unsigned v) {
    *(LAS unsigned*)(S + r * 256 + (((c2 >> 3) ^ (r & 15)) << 4) + ((c2 & 7) << 1)) = v; }
template <int SEG, class D>
__device__ __forceinline__ void stg_flush(LAS unsigned char* S, D dst) {
    const int tid = threadIdx.x, lane = tid & 63, wid = tid >> 6;
#pragma unroll
    for (int it = 0; it < 8; ++it) { const int r = wid * 32 + it * 4 + (lane >> 4), cc = lane & 15;
        const u32x4 v = *(const LAS u32x4*)(S + r * 256 + ((cc ^ (r & 15)) << 4));
        bf16_t* d = dst(r, cc / (SEG / 8));
        if (d) *(u32x4*)(d + (cc % (SEG / 8)) * 8) = v; }
}
template <int SEG, class Val, class Dst>
__device__ __forceinline__ void mgemm_st(const bf16_t* A, int lda, const bf16_t* Bt, int ldb, int M, int N, int K, Val val, Dst dst, int bid, int nb, LAS unsigned char* lds) {
    const int tid = opaque_tid(), lane = tid & 63, wid = tid >> 6, wr = wid >> 1, wc = wid & 1, fr = lane & 15, fq = lane >> 4;
    const int RT = M / 128, CT = N / 128; const int c8 = ((tid & 7) ^ ((tid >> 3) & 7)) * 8;
    LAS unsigned char* S = lds + 32768;
    int rt, ct; bool have = tile_of(0, bid, nb, RT, CT, rt, ct);
    GOps cur = gops(A + (size_t)(rt * 128 + (tid >> 3)) * lda + c8, (size_t)32 * lda, Bt + (size_t)(ct * 128 + (tid >> 3)) * ldb + c8, (size_t)32 * ldb);
    for (int it = 0; have; ++it) {
        const int row0 = rt * 128, col0 = ct * 128;
        int rt2, ct2; const bool have2 = tile_of(it + 1, bid, nb, RT, CT, rt2, ct2);
        const GOps nxt = gops(A + (size_t)((have2 ? rt2 : rt) * 128 + (tid >> 3)) * lda + c8, (size_t)32 * lda, Bt + (size_t)((have2 ? ct2 : ct) * 128 + (tid >> 3)) * ldb + c8, (size_t)32 * ldb);
        f32x4 acc[4][4];
#pragma unroll
        for (int m = 0; m < 4; ++m)
#pragma unroll
            for (int n = 0; n < 4; ++n) acc[m][n] = (f32x4){0.f, 0.f, 0.f, 0.f};
        mg_kloop_p(acc, cur, K / 64, lds, it > 0, have2, nxt);
        __syncthreads();
#pragma unroll
        for (int m = 0; m < 4; ++m)
#pragma unroll
            for (int n = 0; n < 4; ++n) { const int r = wr * 64 + m * 16 + fr, c = wc * 64 + n * 16 + fq * 4; stg_put(S, r, c, val(row0 + r, col0 + c, acc[m][n])); }
        __syncthreads();
        stg_flush<SEG>(S, [&](int r, int seg) __attribute__((always_inline)) { return dst(row0, col0, r, seg); });
        cur = nxt; rt = rt2; ct = ct2; have = have2;
    }
    __syncthreads();
}

__device__ __forceinline__ void phase1(const P& p, int bid, int nb, LAS unsigned char* sm) {
    bf16_t* zs = (bf16_t*)p.slotB; bf16_t* uvg = p.slotC; bf16_t* gates = p.slotD;
    mgemm_st<128>(p.slotA, DM, p.WinT, DM, NT, ZP, DM, [=](int t, int c, const f32x4& v) { uint2 o;
        if (c < 512) { o.x = pk2(v[0], v[1]); o.y = pk2(v[2], v[3]); }
        else if (c < 1536) { o.x = pk2(fgelu(v[0]), fgelu(v[1])); o.y = pk2(fgelu(v[2]), fgelu(v[3])); }
        else { o.x = pk2(fsigmoid(v[0]), fsigmoid(v[1])); o.y = pk2(fsigmoid(v[2]), fsigmoid(v[3])); }
        return o;
    }, [=](int row0, int col0, int r, int) -> bf16_t* { const size_t t = (size_t)(row0 + r);
        if (col0 < 512) return zs + t * 512 + col0; if (col0 < 1536) return uvg + t * 1024 + (col0 - 512); return gates + t * 2048 + (col0 - 1536);
    }, bid, nb, sm);
}

__device__ __forceinline__ void phase2a(const P& p, int bid, int nb, bool dry) {
    const int tid = opaque_tid(), lane = tid & 63, wid = tid >> 6;
    const bf16_t* zs = (const bf16_t*)p.slotB; bf16_t* K = p.slotE; bf16_t* uvg = p.slotC;
    const f32x4 gn0 = *(const f32x4*)(p.sgu_gain + lane * 8), gn1 = *(const f32x4*)(p.sgu_gain + lane * 8 + 4);
    const f32x4 bs0 = *(const f32x4*)(p.sgu_bias + lane * 8), bs1 = *(const f32x4*)(p.sgu_bias + lane * 8 + 4);
    const int hd = lane >> 3, j = lane & 7, i4 = 4 * (j & 3);
    struct In { uint2 cq, ck, k1, k2; uint4 v; int pos; };
    auto ld = [&](int t) __attribute__((always_inline)) { In r; const bf16_t* z = zs + (size_t)t * 512;
        r.cq = *(const uint2*)(z + lane * 4); r.ck = *(const uint2*)(z + 256 + (lane & 31) * 4); r.k1 = *(const uint2*)(z + 384 + i4); r.k2 = *(const uint2*)(z + 400 + i4);
        r.v = *(const uint4*)(uvg + (size_t)t * 1024 + 512 + lane * 8); r.pos = p.pos[t]; return r; };
    int t = bid * 4 + wid; In cur; if (t < NT) cur = ld(t);
    for (; t < NT; t += nb * 4) {
        const int tn = t + nb * 4; In nxt = cur; if (tn < NT) nxt = ld(tn);
        const f32x4 cq = bf4(cur.cq), ck = bf4(cur.ck);
        bf16_t* vr = uvg + (size_t)t * 1024 + 512 + lane * 8;
        { const float ss = wsumf(cq[0] * cq[0] + cq[1] * cq[1] + cq[2] * cq[2] + cq[3] * cq[3]); const float r = rsqrtf(ss * (1.f / 256.f) + EPS);
          uint2 o; o.x = pk2(cq[0] * r, cq[1] * r); o.y = pk2(cq[2] * r, cq[3] * r); *(uint2*)(p.cqn + (size_t)t * 256 + lane * 4) = o; }
        { const float ss = wsumf(lane < 32 ? ck[0] * ck[0] + ck[1] * ck[1] + ck[2] * ck[2] + ck[3] * ck[3] : 0.f); const float r = rsqrtf(ss * (1.f / 128.f) + EPS);
          if (lane < 32) { uint2 o; o.x = pk2(ck[0] * r, ck[1] * r); o.y = pk2(ck[2] * r, ck[3] * r); *(uint2*)(p.ckvn + (size_t)t * 128 + lane * 4) = o; } }
        { const int b = t >> 13, sq = t & 8191; const float posf = (float)cur.pos; const f32x4 k1 = bf4(cur.k1), k2 = bf4(cur.k2); float val[4], tab[4];
#pragma unroll
          for (int q = 0; q < 4; ++q) { const int i = i4 + q;
              float f = q == 0 ? 1.0f : q == 1 ? 0.5623413251903491f : q == 2 ? 0.31622776601683794f : 0.1778279410038923f;
              const int q4 = i >> 2; f *= (q4 == 0 ? 1.0f : q4 == 1 ? 0.1f : q4 == 2 ? 0.01f : 0.001f);
              const float ang = posf * f; const double rev = (double)ang * 0.15915494309189535; const float frc = (float)(rev - floor(rev));
              const float sn = __builtin_amdgcn_sinf(frc), cn = __builtin_amdgcn_cosf(frc);
              val[q] = (j < 4) ? (k1[q] * cn - k2[q] * sn) : (k1[q] * sn + k2[q] * cn); tab[q] = (j < 4) ? cn : sn; }
          uint2 o; o.x = pk2(val[0], val[1]); o.y = pk2(val[2], val[3]);
          *(uint2*)(K + ((size_t)(b * NH + hd) * SEQ + sq) * 96 + 64 + 4 * j) = o;
          if (hd == 0) *(f32x4*)(p.cs + (size_t)t * 32 + 4 * j) = (f32x4){tab[0], tab[1], tab[2], tab[3]}; }
        { float v[8]; const unsigned w[4] = {cur.v.x, cur.v.y, cur.v.z, cur.v.w};
#pragma unroll
          for (int i = 0; i < 4; ++i) { v[2 * i] = __uint_as_float(w[i] << 16); v[2 * i + 1] = __uint_as_float(w[i] & 0xffff0000u); }
          float sm_ = 0.f;
#pragma unroll
          for (int i = 0; i < 8; ++i) sm_ += v[i];
          sm_ = wsumf(sm_); const float mu = sm_ * (1.f / 512.f); float q = 0.f;
#pragma unroll
          for (int i = 0; i < 8; ++i) { const float d = v[i] - mu; q += d * d; }
          q = wsumf(q); const float r = rsqrtf(q * (1.f / 512.f) + EPS);
          uint4 o;
          o.x = pk2((v[0] - mu) * r * gn0[0] + bs0[0], (v[1] - mu) * r * gn0[1] + bs0[1]); o.y = pk2((v[2] - mu) * r * gn0[2] + bs0[2], (v[3] - mu) * r * gn0[3] + bs0[3]);
          o.z = pk2((v[4] - mu) * r * gn1[0] + bs1[0], (v[5] - mu) * r * gn1[1] + bs1[1]); o.w = pk2((v[6] - mu) * r * gn1[2] + bs1[2], (v[7] - mu) * r * gn1[3] + bs1[3]);
          *(uint4*)(dry ? p.slotG + (size_t)t * 512 + lane * 8 : vr) = o; }
        cur = nxt;
    }
}

__device__ __forceinline__ void phase2b(const P& p, int bid, int nb, LAS unsigned char* sm) {
    bf16_t* Q = p.slotA; bf16_t* K = p.slotE; bf16_t* VT = p.slotF; const float* cs = p.cs;
    mgemm(p.cqn, 256, p.WuqT, 256, NT, 768, 256, [=](int t, int c, const f32x4& v) {
        const int b = t >> 13, s = t & 8191;
        if (c < 512) { const int h = c >> 6, d = c & 63; uint2 o; o.x = pk2(v[0], v[1]); o.y = pk2(v[2], v[3]); *(uint2*)(Q + ((size_t)(b * NH + h) * SEQ + s) * 96 + d) = o; }
        else { const int h = (c - 512) >> 5, i0 = ((c - 512) & 31) >> 1; bf16_t* q = Q + ((size_t)(b * NH + h) * SEQ + s) * 96;
            const float2 cn = *(const float2*)(cs + (size_t)t * 32 + i0), sn = *(const float2*)(cs + (size_t)t * 32 + 16 + i0);
            *(unsigned*)(q + 64 + i0) = pk2(v[0] * cn.x - v[1] * sn.x, v[2] * cn.y - v[3] * sn.y);
            *(unsigned*)(q + 80 + i0) = pk2(v[0] * sn.x + v[1] * cn.x, v[2] * sn.y + v[3] * cn.y); }
    }, bid, nb, sm);
    mgemm_st<64>(p.ckvn, 128, p.WukT, 128, NT, 512, 128, [=](int, int, const f32x4& v) { uint2 o; o.x = pk2(v[0], v[1]); o.y = pk2(v[2], v[3]); return o; },
        [=](int row0, int col0, int r, int seg) -> bf16_t* { const int t = row0 + r, b = t >> 13, s = t & 8191, h = (col0 >> 6) + seg; return K + ((size_t)(b * NH + h) * SEQ + s) * 96; }, bid, nb, sm);
    mgemm_st<128>(p.WuvT, 128, p.ckvn, 128, 512, NT, 128, [=](int, int, const f32x4& v) { uint2 o; o.x = pk2(v[0], v[1]); o.y = pk2(v[2], v[3]); return o; },
        [=](int row0, int col0, int r, int) -> bf16_t* { return VT + (size_t)(row0 + r) * NT + col0; }, bid, nb, sm);
}

__device__ __forceinline__ void phase2c(const P& p, int bid, int nb) {
    const bf16_t* uvg = p.slotC; bf16_t* su = p.slotG;
    for (size_t i = (size_t)bid * 256 + threadIdx.x; i < (size_t)NT * 512; i += (size_t)nb * 256) {
        const int t = (int)(i >> 9), c = (int)(i & 511), g = c >> 6, ii = t & 127, t0 = t - ii;
        const bf16_t* w = p.Wsp + ((size_t)g * 128 + ii) * 128; float s = 0.f;
        for (int j = 0; j < 128; ++j) s += bf2f(w[j]) * bf2f(uvg[(size_t)(t0 + j) * 1024 + 512 + c]);
        s += p.b_sp[g * 128 + ii];
        su[i] = f2bf(bf2f(uvg[(size_t)t * 1024 + c]) * s);
    }
}


__device__ __forceinline__ void phase2c_m(const P& p, int bid, int nb, LAS unsigned char* lds) {
    const bf16_t* uvg = p.slotC; bf16_t* su = p.slotG;
    const int tid = opaque_tid(), lane = tid & 63, wid = tid >> 6, fr = lane & 15, fq = lane >> 4;
    const int c8 = ((tid & 7) ^ ((tid >> 3) & 7)) * 8;
    for (int u = bid; u < 1024; u += nb) {
        const int g = u & 7, t0 = (u >> 3) * 128;
        { const bf16_t* wp = p.Wsp + ((size_t)g * 128 + (tid >> 3)) * 128 + c8; LAS unsigned char* d = lds + tid * 16;
#pragma unroll
          for (int ks = 0; ks < 2; ++ks)
#pragma unroll
              for (int i = 0; i < 4; ++i) __builtin_amdgcn_global_load_lds((const unsigned*)(wp + (size_t)i * 32 * 128 + ks * 64), (LAS unsigned*)(d + ks * 16384 + i * 4096), 16, 0, 0); }
#pragma unroll
        for (int i = 0; i < 4; ++i) { const int q = tid + 256 * i, j = q >> 3, c0 = (q & 7) * 8;
            const uint4 v = *(const uint4*)(uvg + (size_t)(t0 + j) * 1024 + 512 + g * 64 + c0);
            const unsigned w[4] = {v.x, v.y, v.z, v.w};
            LAS unsigned char* bimg = lds + 32768 + (j >> 6) * 8192 + (j & 7) * 2; const int lc = (j & 63) >> 3;
#pragma unroll
            for (int e = 0; e < 8; ++e) { const int row = c0 + e; const bf16_t val = (bf16_t)((e & 1) ? (w[e >> 1] >> 16) : (w[e >> 1] & 0xffffu));
                *(LAS bf16_t*)(bimg + row * 128 + ((lc ^ (row & 7)) * 16)) = val; } }
        asm volatile("s_waitcnt vmcnt(0)" ::: "memory");
        __syncthreads();
        f32x4 acc[2][4];
#pragma unroll
        for (int m = 0; m < 2; ++m)
#pragma unroll
            for (int n = 0; n < 4; ++n) acc[m][n] = (f32x4){0.f, 0.f, 0.f, 0.f};
#pragma unroll
        for (int ks = 0; ks < 2; ++ks)
#pragma unroll
            for (int k2 = 0; k2 < 2; ++k2) { const int pc = ((k2 * 4 + fq) ^ (fr & 7)) * 16; bf16x8 af[2], bfr[4];
#pragma unroll
                for (int m = 0; m < 2; ++m) af[m] = *(const LAS bf16x8*)(lds + ks * 16384 + (wid * 32 + m * 16 + fr) * 128 + pc);
#pragma unroll
                for (int n = 0; n < 4; ++n) bfr[n] = *(const LAS bf16x8*)(lds + 32768 + ks * 8192 + (n * 16 + fr) * 128 + pc);
#pragma unroll
                for (int m = 0; m < 2; ++m)
#pragma unroll
                    for (int n = 0; n < 4; ++n) acc[m][n] = __builtin_amdgcn_mfma_f32_16x16x32_bf16(bfr[n], af[m], acc[m][n], 0, 0, 0); }
#pragma unroll
        for (int m = 0; m < 2; ++m) { const int i = wid * 32 + m * 16 + fr; const float bs = p.b_sp[g * 128 + i];
#pragma unroll
            for (int n = 0; n < 4; ++n) { const int c = g * 64 + n * 16 + fq * 4;
                const uint2 uu = *(const uint2*)(uvg + (size_t)(t0 + i) * 1024 + c);
                uint2 o; o.x = pk2(__uint_as_float(uu.x << 16) * (acc[m][n][0] + bs), __uint_as_float(uu.x & 0xffff0000u) * (acc[m][n][1] + bs));
                o.y = pk2(__uint_as_float(uu.y << 16) * (acc[m][n][2] + bs), __uint_as_float(uu.y & 0xffff0000u) * (acc[m][n][3] + bs));
                *(uint2*)(su + (size_t)(t0 + i) * 512 + c) = o; } }
        __syncthreads();
    }
}

__device__ __forceinline__ void phase3(const P& p, int bid, int nb, float* sm) {
    float* sc = sm; float* qs = sm + 8192; float* red = qs + 96;
    const bf16_t* Q = p.slotA; const bf16_t* K = p.slotE; const bf16_t* VT = p.slotF; bf16_t* O = (bf16_t*)p.slotB;
    const int tid = opaque_tid();
    for (int row = bid; row < NBATCH * NH * SEQ; row += nb) {
        const int q = row % SEQ, bh = row / SEQ, nk = ((q >> 6) + 1) * 64;
        if (tid < 12) ((uint4*)qs)[tid] = ((const uint4*)(Q + ((size_t)bh * SEQ + q) * 96))[tid];
        __syncthreads();
        float mx = -1e30f;
        for (int k = tid; k < nk; k += 256) { const uint4* kp = (const uint4*)(K + ((size_t)bh * SEQ + k) * 96); float s = 0.f;
#pragma unroll
            for (int d = 0; d < 12; ++d) s += dot8(((const uint4*)qs)[d], kp[d]);
            sc[k] = s; mx = fmaxf(mx, s); }
        mx = wmax(mx); if ((tid & 63) == 0) red[tid >> 6] = mx; __syncthreads();
        mx = fmaxf(fmaxf(red[0], red[1]), fmaxf(red[2], red[3])); __syncthreads();
        float sum = 0.f;
        for (int k = tid; k < nk; k += 256) { const float e = exp2f(sc[k] - mx); sc[k] = e; sum += e; }
        sum = wsum(sum); if ((tid & 63) == 0) red[tid >> 6] = sum; __syncthreads();
        sum = (red[0] + red[1]) + (red[2] + red[3]);
        const int dv = tid >> 2, part = tid & 3, h = bh & 7, b = bh >> 3;
        const bf16_t* vp = VT + (size_t)(h * 64 + dv) * NT + (size_t)b * SEQ; float o = 0.f;
        for (int k = part; k < nk; k += 4) o += sc[k] * bf2f(vp[k]);
        o += __shfl_xor(o, 1); o += __shfl_xor(o, 2);
        if (part == 0) O[(size_t)(b * SEQ + q) * 512 + h * 64 + dv] = f2bf(o / sum);
        __syncthreads();
    }
}


constexpr int ATT_BUF = 20480;
template <int VAR>
__device__ __forceinline__ void phase3m(const P& p, int bid, int nb, LAS unsigned char* lds) {
    const bf16_t* Q = p.slotA; const bf16_t* K = p.slotE; const bf16_t* VT = p.slotF; bf16_t* O = (VAR == 0) ? (bf16_t*)p.slotB : p.slotC;
    const int tid = opaque_tid(), lane = tid & 63, wid = tid >> 6, l31 = lane & 31, hh = lane >> 5;
    int koff[3]; size_t voff[2];
#pragma unroll
    for (int i = 0; i < 3; ++i) { const int s = tid + 256 * i, r = s / 12, pc = s % 12, c = (pc + 12 - ((r >> 2) & 3)) % 12; koff[i] = r * 96 + c * 8; }
#pragma unroll
    for (int i = 0; i < 2; ++i) { const int s = tid + 256 * i, dv = s >> 3, pc = s & 7, cl = pc ^ ((dv >> 1) & 7); voff[i] = (size_t)dv * NT + cl * 8; }
    int kro[6];
#pragma unroll
    for (int ks = 0; ks < 6; ++ks) { const int v = 2 * ks + hh + ((lane >> 2) & 3); kro[ks] = (v >= 12 ? v - 12 : v) * 16; }
    const int krow = l31 * 192, vsw = (lane >> 1) & 7, vrow = l31 * 128 + 8 * hh;
    for (int iu = 0;; ++iu) {
        const int r = iu * nb + ((iu & 1) ? nb - 1 - bid : bid); if (r >= 1024) break;
        const int qb = 63 - (r >> 4), bh = r & 15, b = bh >> 3, h = bh & 7;
        const int q0 = qb * 128 + wid * 32, ntw = (q0 >> 6) + 1, nt = 2 * qb + 2;
        const bf16_t* Kb = K + (size_t)bh * SEQ * 96; const bf16_t* Vb = VT + (size_t)(h * 64) * NT + (size_t)b * SEQ;
        bf16x8 qf[6]; { const bf16_t* qp = Q + ((size_t)bh * SEQ + q0 + l31) * 96 + hh * 8;
#pragma unroll
            for (int ks = 0; ks < 6; ++ks) qf[ks] = *(const bf16x8*)(qp + ks * 16); }
        f32x16 o0, o1;
#pragma unroll
        for (int e = 0; e < 16; ++e) { o0[e] = 0.f; o1[e] = 0.f; }
        float mrun = -1e30f, lsum = 0.f;
        auto stage = [&](int j) { LAS unsigned char* d = lds + (j & 1) * ATT_BUF + tid * 16; const bf16_t* kt = Kb + (size_t)j * 64 * 96; const bf16_t* vt = Vb + j * 64;
#pragma unroll
            for (int i = 0; i < 3; ++i) __builtin_amdgcn_global_load_lds((const unsigned*)(kt + koff[i]), (LAS unsigned*)(d + i * 4096), 16, 0, 0);
#pragma unroll
            for (int i = 0; i < 2; ++i) __builtin_amdgcn_global_load_lds((const unsigned*)(vt + voff[i]), (LAS unsigned*)(d + 12288 + i * 4096), 16, 0, 0); };
        if (VAR != 3) stage(0);
        for (int j = 0; j < nt; ++j) {
            asm volatile("s_waitcnt vmcnt(0)" ::: "memory");
            __syncthreads();
            if (VAR != 3 && j + 1 < nt) stage(j + 1);
            if (j < ntw) {
                const LAS unsigned char* kb_ = lds + (j & 1) * ATT_BUF + krow; const LAS unsigned char* vb_ = lds + (j & 1) * ATT_BUF + 12288 + vrow;
                f32x16 s0, s1;
#pragma unroll
                for (int e = 0; e < 16; ++e) { s0[e] = 0.f; s1[e] = 0.f; }
#pragma unroll
                for (int ks = 0; ks < 6; ++ks) { const bf16x8 k0 = *(const LAS bf16x8*)(kb_ + kro[ks]); const bf16x8 k1 = *(const LAS bf16x8*)(kb_ + 32 * 192 + kro[ks]);
                    if (VAR != 2) { s0 = __builtin_amdgcn_mfma_f32_32x32x16_bf16(k0, qf[ks], s0, 0, 0, 0); s1 = __builtin_amdgcn_mfma_f32_32x32x16_bf16(k1, qf[ks], s1, 0, 0, 0); }
                    else { s0[ks] += __builtin_bit_cast(float, (int)k0[0]) + __builtin_bit_cast(float, (int)qf[ks][1]); s1[ks] += __builtin_bit_cast(float, (int)k1[0]); } }
                if (VAR != 1) {
                float mx = fmaxf(s0[0], s1[0]);
#pragma unroll
                for (int e = 1; e < 16; ++e) mx = fmaxf(mx, fmaxf(s0[e], s1[e]));
                mx = fmaxf(mx, __shfl_xor(mx, 32));
                const float mn = fmaxf(mrun, mx), alpha = __builtin_amdgcn_exp2f(mrun - mn); mrun = mn;
                float ps = 0.f;
#pragma unroll
                for (int e = 0; e < 16; ++e) { s0[e] = __builtin_amdgcn_exp2f(s0[e] - mn); s1[e] = __builtin_amdgcn_exp2f(s1[e] - mn); ps += s0[e] + s1[e]; }
                lsum = lsum * alpha + ps;
#pragma unroll
                for (int e = 0; e < 16; ++e) { o0[e] *= alpha; o1[e] *= alpha; }
                }
                unsigned pw[16];
#pragma unroll
                for (int e = 0; e < 8; ++e) { pw[e] = pk2(s0[2 * e], s0[2 * e + 1]); pw[8 + e] = pk2(s1[2 * e], s1[2 * e + 1]); }
#pragma unroll
                for (int s = 0; s < 4; ++s) {
                    const u32x4 pbu = {pw[4 * s], pw[4 * s + 1], pw[4 * s + 2], pw[4 * s + 3]}; const bf16x8 pb = __builtin_bit_cast(bf16x8, pbu);
                    const int c0 = ((2 * s) ^ vsw) * 16, c1 = ((2 * s + 1) ^ vsw) * 16;
                    const u32x2 a0 = *(const LAS u32x2*)(vb_ + c0), a1 = *(const LAS u32x2*)(vb_ + c1);
                    const u32x2 b0 = *(const LAS u32x2*)(vb_ + 32 * 128 + c0), b1 = *(const LAS u32x2*)(vb_ + 32 * 128 + c1);
                    const u32x4 va = {a0.x, a0.y, a1.x, a1.y}, vb = {b0.x, b0.y, b1.x, b1.y};
                    if (VAR != 2) { o0 = __builtin_amdgcn_mfma_f32_32x32x16_bf16(__builtin_bit_cast(bf16x8, va), pb, o0, 0, 0, 0);
                    o1 = __builtin_amdgcn_mfma_f32_32x32x16_bf16(__builtin_bit_cast(bf16x8, vb), pb, o1, 0, 0, 0); }
                    else { o0[s] += __builtin_bit_cast(float, va[0] ^ pbu[0]); o1[s] += __builtin_bit_cast(float, vb[1] ^ pbu[1]); }
                }
            }
        }
        const float inv = 1.f / (lsum + __shfl_xor(lsum, 32));
        bf16_t* op = O + (size_t)(b * SEQ + q0 + l31) * 512 + h * 64 + 4 * hh;
#pragma unroll
        for (int g = 0; g < 4; ++g) { uint2 w0, w1;
            w0.x = pk2(o0[4 * g] * inv, o0[4 * g + 1] * inv); w0.y = pk2(o0[4 * g + 2] * inv, o0[4 * g + 3] * inv);
            w1.x = pk2(o1[4 * g] * inv, o1[4 * g + 1] * inv); w1.y = pk2(o1[4 * g + 2] * inv, o1[4 * g + 3] * inv);
            *(uint2*)(op + 8 * g) = w0; *(uint2*)(op + 32 + 8 * g) = w1; }
        __syncthreads();
    }
}


template <int DUMMY>
__device__ __forceinline__ void phase3p(const P& p, int bid, int nb, LAS unsigned char* lds) {
    const bf16_t* Q = p.slotA; const bf16_t* K = p.slotE; const bf16_t* VT = p.slotF; bf16_t* O = (DUMMY == 0) ? (bf16_t*)p.slotB : p.slotC;
    const int tid = opaque_tid(), lane = tid & 63, wid = tid >> 6, l31 = lane & 31, hh = lane >> 5;
    constexpr float THR = 8.f;
    int koff[3]; size_t voff[2];
#pragma unroll
    for (int i = 0; i < 3; ++i) { const int s = tid + 256 * i, r = s / 12, pc = s % 12, c = (pc + 12 - ((r >> 2) & 3)) % 12; koff[i] = r * 96 + c * 8; }
#pragma unroll
    for (int i = 0; i < 2; ++i) { const int s = tid + 256 * i, dv = s >> 3, pc = s & 7, cl = pc ^ ((dv >> 1) & 7); voff[i] = (size_t)dv * NT + cl * 8; }
    int kro[6];
#pragma unroll
    for (int ks = 0; ks < 6; ++ks) { const int v = 2 * ks + hh + ((lane >> 2) & 3); kro[ks] = (v >= 12 ? v - 12 : v) * 16; }
    const int krow = l31 * 192, vsw = (lane >> 1) & 7, vrow = l31 * 128 + 8 * hh;
    for (int iu = 0;; ++iu) {
        const int r = iu * nb + ((iu & 1) ? nb - 1 - bid : bid); if (r >= 1024) break;
        const int qb = 63 - (r >> 4), bh = r & 15, b = bh >> 3, h = bh & 7;
        const int q0 = qb * 128 + wid * 32, ntw = (q0 >> 6) + 1, nt = 2 * qb + 2;
        const bf16_t* Kb = K + (size_t)bh * SEQ * 96; const bf16_t* Vb = VT + (size_t)(h * 64) * NT + (size_t)b * SEQ;
        bf16x8 qf[6]; { const bf16_t* qp = Q + ((size_t)bh * SEQ + q0 + l31) * 96 + hh * 8;
#pragma unroll
            for (int ks = 0; ks < 6; ++ks) qf[ks] = *(const bf16x8*)(qp + ks * 16); }
        f32x16 o0, o1;
#pragma unroll
        for (int e = 0; e < 16; ++e) { o0[e] = 0.f; o1[e] = 0.f; }
        float mrun = -1e30f, lsum = 0.f;
        auto stageK = [&](int j) { LAS unsigned char* d = lds + (j & 1) * 12288 + tid * 16; const bf16_t* kt = Kb + (size_t)j * 64 * 96;
#pragma unroll
            for (int i = 0; i < 3; ++i) __builtin_amdgcn_global_load_lds((const unsigned*)(kt + koff[i]), (LAS unsigned*)(d + i * 4096), 16, 0, 0); };
        auto stageV = [&](int j) { LAS unsigned char* d = lds + 24576 + (j & 1) * 8192 + tid * 16; const bf16_t* vt = Vb + j * 64;
#pragma unroll
            for (int i = 0; i < 2; ++i) __builtin_amdgcn_global_load_lds((const unsigned*)(vt + voff[i]), (LAS unsigned*)(d + i * 4096), 16, 0, 0); };
        auto qk = [&](f32x16& a, f32x16& bq, int buf) { const LAS unsigned char* kb_ = lds + buf * 12288 + krow;
#pragma unroll
            for (int e = 0; e < 16; ++e) { a[e] = 0.f; bq[e] = 0.f; }
#pragma unroll
            for (int ks = 0; ks < 6; ++ks) { const bf16x8 k0 = *(const LAS bf16x8*)(kb_ + kro[ks]); const bf16x8 k1 = *(const LAS bf16x8*)(kb_ + 32 * 192 + kro[ks]);
                a = __builtin_amdgcn_mfma_f32_32x32x16_bf16(k0, qf[ks], a, 0, 0, 0); bq = __builtin_amdgcn_mfma_f32_32x32x16_bf16(k1, qf[ks], bq, 0, 0, 0); } };
        auto rowmax = [&](const f32x16& a, const f32x16& bq) { float m = fmaxf(a[0], bq[0]);
#pragma unroll
            for (int e = 1; e < 16; ++e) m = fmaxf(fmaxf(m, a[e]), bq[e]);
            return fmaxf(m, __shfl_xor(m, 32)); };
        f32x16 sA0, sA1, sB0, sB1; float mxA, mxB = 0.f;
        stageK(0); stageK(1); stageV(0);
        asm volatile("s_waitcnt vmcnt(0)" ::: "memory");
        __syncthreads();
        qk(sA0, sA1, 0); mxA = rowmax(sA0, sA1);
        auto step = [&](f32x16& c0, f32x16& c1, float& mxc, f32x16& n0, f32x16& n1, float& mxn, int j) {
            asm volatile("s_waitcnt vmcnt(0)" ::: "memory");
            __syncthreads();
            if (j + 2 < nt) stageK(j + 2);
            if (j + 1 < nt) stageV(j + 1);
            if (j < ntw) {
                if (!__all(mxc <= mrun + THR)) { const float mn = fmaxf(mrun, mxc), alpha = __builtin_amdgcn_exp2f(mrun - mn); mrun = mn; lsum *= alpha;
#pragma unroll
                    for (int e = 0; e < 16; ++e) { o0[e] *= alpha; o1[e] *= alpha; } }
                qk(n0, n1, (j + 1) & 1);
                float ps = 0.f;
#pragma unroll
                for (int e = 0; e < 16; ++e) { c0[e] = __builtin_amdgcn_exp2f(c0[e] - mrun); c1[e] = __builtin_amdgcn_exp2f(c1[e] - mrun); ps += c0[e] + c1[e]; }
                lsum += ps;
                unsigned pw[16];
#pragma unroll
                for (int e = 0; e < 8; ++e) { pw[e] = pk2(c0[2 * e], c0[2 * e + 1]); pw[8 + e] = pk2(c1[2 * e], c1[2 * e + 1]); }
                const LAS unsigned char* vb_ = lds + 24576 + (j & 1) * 8192 + vrow;
#pragma unroll
                for (int s = 0; s < 4; ++s) {
                    const u32x4 pbu = {pw[4 * s], pw[4 * s + 1], pw[4 * s + 2], pw[4 * s + 3]}; const bf16x8 pb = __builtin_bit_cast(bf16x8, pbu);
                    const int c0_ = ((2 * s) ^ vsw) * 16, c1_ = ((2 * s + 1) ^ vsw) * 16;
                    const u32x2 a0 = *(const LAS u32x2*)(vb_ + c0_), a1 = *(const LAS u32x2*)(vb_ + c1_);
                    const u32x2 b0 = *(const LAS u32x2*)(vb_ + 32 * 128 + c0_), b1 = *(const LAS u32x2*)(vb_ + 32 * 128 + c1_);
                    const u32x4 va = {a0.x, a0.y, a1.x, a1.y}, vb = {b0.x, b0.y, b1.x, b1.y};
                    o0 = __builtin_amdgcn_mfma_f32_32x32x16_bf16(__builtin_bit_cast(bf16x8, va), pb, o0, 0, 0, 0);
                    o1 = __builtin_amdgcn_mfma_f32_32x32x16_bf16(__builtin_bit_cast(bf16x8, vb), pb, o1, 0, 0, 0);
                }
                mxn = rowmax(n0, n1);
#if ATT_SGB
#pragma unroll
                for (int g_ = 0; g_ < 20; ++g_) { __builtin_amdgcn_sched_group_barrier(0x008, 1, 0); __builtin_amdgcn_sched_group_barrier(0x100, 2, 0); __builtin_amdgcn_sched_group_barrier(0x002, 7, 0); }
#endif
            }
        };
        for (int j = 0; j < nt; j += 2) { step(sA0, sA1, mxA, sB0, sB1, mxB, j); step(sB0, sB1, mxB, sA0, sA1, mxA, j + 1); }
        const float inv = 1.f / (lsum + __shfl_xor(lsum, 32));
        bf16_t* op = O + (size_t)(b * SEQ + q0 + l31) * 512 + h * 64 + 4 * hh;
#pragma unroll
        for (int g = 0; g < 4; ++g) { uint2 w0, w1;
            w0.x = pk2(o0[4 * g] * inv, o0[4 * g + 1] * inv); w0.y = pk2(o0[4 * g + 2] * inv, o0[4 * g + 3] * inv);
            w1.x = pk2(o1[4 * g] * inv, o1[4 * g + 1] * inv); w1.y = pk2(o1[4 * g + 2] * inv, o1[4 * g + 3] * inv);
            *(uint2*)(op + 8 * g) = w0; *(uint2*)(op + 32 + 8 * g) = w1; }
        __syncthreads();
    }
}

template <int VAR>
__device__ __forceinline__ void att_step(const LAS unsigned char* kb_, const LAS unsigned char* vb_, const int kt16, const int k4o, const int k5o, const int vsw, const bf16x8 (&qf)[6],
                                         f32x16& c0, f32x16& c1, f32x16& n0, f32x16& n1, const unsigned (&pwc)[16], unsigned (&pwn)[16], f32x16& o0, f32x16& o1,
                                         const f32x16& negm, float& ps, float& mxn) {
    f32x16 zero16;
#pragma unroll
    for (int e = 0; e < 16; ++e) zero16[e] = 0.f;
    if constexpr (VAR == 0) {
        bf16x8 kf0, kf1, kf2;
        kf0 = *(const LAS bf16x8*)(kb_ + 0*32*192 + kt16 + 0); kf1 = *(const LAS bf16x8*)(kb_ + 1*32*192 + kt16 + 0);
        float mxl;
        kf2 = *(const LAS bf16x8*)(kb_ + 0*32*192 + kt16 + 32);
        n0 = __builtin_amdgcn_mfma_f32_32x32x16_bf16(kf0, qf[0], negm, 0, 0, 0);
        c0[0] = __builtin_amdgcn_exp2f(c0[0]); ps += c0[0]; c0[1] = __builtin_amdgcn_exp2f(c0[1]); ps += c0[1]; pwn[0] = pk2(c0[0], c0[1]);
        __builtin_amdgcn_sched_barrier(0);
        kf0 = *(const LAS bf16x8*)(kb_ + 1*32*192 + kt16 + 32);
        n1 = __builtin_amdgcn_mfma_f32_32x32x16_bf16(kf1, qf[0], negm, 0, 0, 0);
        c0[2] = __builtin_amdgcn_exp2f(c0[2]); ps += c0[2]; c0[3] = __builtin_amdgcn_exp2f(c0[3]); ps += c0[3]; pwn[1] = pk2(c0[2], c0[3]);
        __builtin_amdgcn_sched_barrier(0);
        kf1 = *(const LAS bf16x8*)(kb_ + 0*32*192 + kt16 + 64);
        n0 = __builtin_amdgcn_mfma_f32_32x32x16_bf16(kf2, qf[1], n0, 0, 0, 0);
        c0[4] = __builtin_amdgcn_exp2f(c0[4]); ps += c0[4]; c0[5] = __builtin_amdgcn_exp2f(c0[5]); ps += c0[5]; pwn[2] = pk2(c0[4], c0[5]);
        __builtin_amdgcn_sched_barrier(0);
        kf2 = *(const LAS bf16x8*)(kb_ + 1*32*192 + kt16 + 64);
        n1 = __builtin_amdgcn_mfma_f32_32x32x16_bf16(kf0, qf[1], n1, 0, 0, 0);
        c0[6] = __builtin_amdgcn_exp2f(c0[6]); ps += c0[6]; c0[7] = __builtin_amdgcn_exp2f(c0[7]); ps += c0[7]; pwn[3] = pk2(c0[6], c0[7]);
        __builtin_amdgcn_sched_barrier(0);
        kf0 = *(const LAS bf16x8*)(kb_ + 0*32*192 + kt16 + 96);
        n0 = __builtin_amdgcn_mfma_f32_32x32x16_bf16(kf1, qf[2], n0, 0, 0, 0);
        c0[8] = __builtin_amdgcn_exp2f(c0[8]); ps += c0[8]; c0[9] = __builtin_amdgcn_exp2f(c0[9]); ps += c0[9]; pwn[4] = pk2(c0[8], c0[9]);
        __builtin_amdgcn_sched_barrier(0);
        kf1 = *(const LAS bf16x8*)(kb_ + 1*32*192 + kt16 + 96);
        n1 = __builtin_amdgcn_mfma_f32_32x32x16_bf16(kf2, qf[2], n1, 0, 0, 0);
        c0[10] = __builtin_amdgcn_exp2f(c0[10]); ps += c0[10]; c0[11] = __builtin_amdgcn_exp2f(c0[11]); ps += c0[11]; pwn[5] = pk2(c0[10], c0[11]);
        __builtin_amdgcn_sched_barrier(0);
        kf2 = *(const LAS bf16x8*)(kb_ + 0*32*192 + k4o);
        n0 = __builtin_amdgcn_mfma_f32_32x32x16_bf16(kf0, qf[3], n0, 0, 0, 0);
        c0[12] = __builtin_amdgcn_exp2f(c0[12]); ps += c0[12]; c0[13] = __builtin_amdgcn_exp2f(c0[13]); ps += c0[13]; pwn[6] = pk2(c0[12], c0[13]);
        __builtin_amdgcn_sched_barrier(0);
        kf0 = *(const LAS bf16x8*)(kb_ + 1*32*192 + k4o);
        n1 = __builtin_amdgcn_mfma_f32_32x32x16_bf16(kf1, qf[3], n1, 0, 0, 0);
        c0[14] = __builtin_amdgcn_exp2f(c0[14]); ps += c0[14]; c0[15] = __builtin_amdgcn_exp2f(c0[15]); ps += c0[15]; pwn[7] = pk2(c0[14], c0[15]);
        __builtin_amdgcn_sched_barrier(0);
        kf1 = *(const LAS bf16x8*)(kb_ + 0*32*192 + k5o);
        n0 = __builtin_amdgcn_mfma_f32_32x32x16_bf16(kf2, qf[4], n0, 0, 0, 0);
        c1[0] = __builtin_amdgcn_exp2f(c1[0]); ps += c1[0]; c1[1] = __builtin_amdgcn_exp2f(c1[1]); ps += c1[1]; pwn[8] = pk2(c1[0], c1[1]);
        __builtin_amdgcn_sched_barrier(0);
        kf2 = *(const LAS bf16x8*)(kb_ + 1*32*192 + k5o);
        n1 = __builtin_amdgcn_mfma_f32_32x32x16_bf16(kf0, qf[4], n1, 0, 0, 0);
        c1[2] = __builtin_amdgcn_exp2f(c1[2]); ps += c1[2]; c1[3] = __builtin_amdgcn_exp2f(c1[3]); ps += c1[3]; pwn[9] = pk2(c1[2], c1[3]);
        __builtin_amdgcn_sched_barrier(0);
        n0 = __builtin_amdgcn_mfma_f32_32x32x16_bf16(kf1, qf[5], n0, 0, 0, 0);
        c1[4] = __builtin_amdgcn_exp2f(c1[4]); ps += c1[4]; c1[5] = __builtin_amdgcn_exp2f(c1[5]); ps += c1[5]; pwn[10] = pk2(c1[4], c1[5]);
        __builtin_amdgcn_sched_barrier(0);
        n1 = __builtin_amdgcn_mfma_f32_32x32x16_bf16(kf2, qf[5], n1, 0, 0, 0);
        c1[6] = __builtin_amdgcn_exp2f(c1[6]); ps += c1[6]; c1[7] = __builtin_amdgcn_exp2f(c1[7]); ps += c1[7]; pwn[11] = pk2(c1[6], c1[7]);
        __builtin_amdgcn_sched_barrier(0);
        c1[8] = __builtin_amdgcn_exp2f(c1[8]); ps += c1[8]; c1[9] = __builtin_amdgcn_exp2f(c1[9]); ps += c1[9]; pwn[12] = pk2(c1[8], c1[9]);
        __builtin_amdgcn_sched_barrier(0);
        c1[10] = __builtin_amdgcn_exp2f(c1[10]); ps += c1[10]; c1[11] = __builtin_amdgcn_exp2f(c1[11]); ps += c1[11]; pwn[13] = pk2(c1[10], c1[11]);
        __builtin_amdgcn_sched_barrier(0);
        c1[12] = __builtin_amdgcn_exp2f(c1[12]); ps += c1[12]; c1[13] = __builtin_amdgcn_exp2f(c1[13]); ps += c1[13]; pwn[14] = pk2(c1[12], c1[13]);
        __builtin_amdgcn_sched_barrier(0);
        c1[14] = __builtin_amdgcn_exp2f(c1[14]); ps += c1[14]; c1[15] = __builtin_amdgcn_exp2f(c1[15]); ps += c1[15]; pwn[15] = pk2(c1[14], c1[15]);
        __builtin_amdgcn_sched_barrier(0);
        mxl = fmaxf(n0[0], n1[0]); mxl = fmaxf(fmaxf(mxl, n0[1]), n1[1]); mxl = fmaxf(fmaxf(mxl, n0[2]), n1[2]); mxl = fmaxf(fmaxf(mxl, n0[3]), n1[3]);
        __builtin_amdgcn_sched_barrier(0);
        mxl = fmaxf(fmaxf(mxl, n0[4]), n1[4]); mxl = fmaxf(fmaxf(mxl, n0[5]), n1[5]); mxl = fmaxf(fmaxf(mxl, n0[6]), n1[6]); mxl = fmaxf(fmaxf(mxl, n0[7]), n1[7]);
        __builtin_amdgcn_sched_barrier(0);
        mxl = fmaxf(fmaxf(mxl, n0[8]), n1[8]); mxl = fmaxf(fmaxf(mxl, n0[9]), n1[9]); mxl = fmaxf(fmaxf(mxl, n0[10]), n1[10]); mxl = fmaxf(fmaxf(mxl, n0[11]), n1[11]);
        __builtin_amdgcn_sched_barrier(0);
        mxl = fmaxf(fmaxf(mxl, n0[12]), n1[12]); mxl = fmaxf(fmaxf(mxl, n0[13]), n1[13]); mxl = fmaxf(fmaxf(mxl, n0[14]), n1[14]); mxl = fmaxf(fmaxf(mxl, n0[15]), n1[15]);
        __builtin_amdgcn_sched_barrier(0);
        mxn = fmaxf(mxl, __shfl_xor(mxl, 32));
    } else if constexpr (VAR == 1) {
        bf16x8 kf0, kf1, kf2;
        kf0 = *(const LAS bf16x8*)(kb_ + 0*32*192 + kt16 + 0); kf1 = *(const LAS bf16x8*)(kb_ + 1*32*192 + kt16 + 0);
        u32x2 vf0a, vf0b, vf1a, vf1b, vf2a, vf2b;
        float mxl;
        kf2 = *(const LAS bf16x8*)(kb_ + 0*32*192 + kt16 + 32);
        n0 = __builtin_amdgcn_mfma_f32_32x32x16_bf16(kf0, qf[0], negm, 0, 0, 0);
        c0[0] = __builtin_amdgcn_exp2f(c0[0]); ps += c0[0]; c0[1] = __builtin_amdgcn_exp2f(c0[1]); ps += c0[1]; pwn[0] = pk2(c0[0], c0[1]);
        __builtin_amdgcn_sched_barrier(0);
        kf0 = *(const LAS bf16x8*)(kb_ + 1*32*192 + kt16 + 32);
        n1 = __builtin_amdgcn_mfma_f32_32x32x16_bf16(kf1, qf[0], negm, 0, 0, 0);
        c0[2] = __builtin_amdgcn_exp2f(c0[2]); ps += c0[2]; c0[3] = __builtin_amdgcn_exp2f(c0[3]); ps += c0[3]; pwn[1] = pk2(c0[2], c0[3]);
        __builtin_amdgcn_sched_barrier(0);
        kf1 = *(const LAS bf16x8*)(kb_ + 0*32*192 + kt16 + 64);
        n0 = __builtin_amdgcn_mfma_f32_32x32x16_bf16(kf2, qf[1], n0, 0, 0, 0);
        c0[4] = __builtin_amdgcn_exp2f(c0[4]); ps += c0[4]; c0[5] = __builtin_amdgcn_exp2f(c0[5]); ps += c0[5]; pwn[2] = pk2(c0[4], c0[5]);
        __builtin_amdgcn_sched_barrier(0);
        kf2 = *(const LAS bf16x8*)(kb_ + 1*32*192 + kt16 + 64);
        n1 = __builtin_amdgcn_mfma_f32_32x32x16_bf16(kf0, qf[1], n1, 0, 0, 0);
        c0[6] = __builtin_amdgcn_exp2f(c0[6]); ps += c0[6]; c0[7] = __builtin_amdgcn_exp2f(c0[7]); ps += c0[7]; pwn[3] = pk2(c0[6], c0[7]);
        __builtin_amdgcn_sched_barrier(0);
        kf0 = *(const LAS bf16x8*)(kb_ + 0*32*192 + kt16 + 96);
        n0 = __builtin_amdgcn_mfma_f32_32x32x16_bf16(kf1, qf[2], n0, 0, 0, 0);
        c0[8] = __builtin_amdgcn_exp2f(c0[8]); ps += c0[8]; c0[9] = __builtin_amdgcn_exp2f(c0[9]); ps += c0[9]; pwn[4] = pk2(c0[8], c0[9]);
        __builtin_amdgcn_sched_barrier(0);
        kf1 = *(const LAS bf16x8*)(kb_ + 1*32*192 + kt16 + 96);
        n1 = __builtin_amdgcn_mfma_f32_32x32x16_bf16(kf2, qf[2], n1, 0, 0, 0);
        c0[10] = __builtin_amdgcn_exp2f(c0[10]); ps += c0[10]; c0[11] = __builtin_amdgcn_exp2f(c0[11]); ps += c0[11]; pwn[5] = pk2(c0[10], c0[11]);
        __builtin_amdgcn_sched_barrier(0);
        kf2 = *(const LAS bf16x8*)(kb_ + 0*32*192 + k4o);
        n0 = __builtin_amdgcn_mfma_f32_32x32x16_bf16(kf0, qf[3], n0, 0, 0, 0);
        c0[12] = __builtin_amdgcn_exp2f(c0[12]); ps += c0[12]; c0[13] = __builtin_amdgcn_exp2f(c0[13]); ps += c0[13]; pwn[6] = pk2(c0[12], c0[13]);
        __builtin_amdgcn_sched_barrier(0);
        kf0 = *(const LAS bf16x8*)(kb_ + 1*32*192 + k4o);
        n1 = __builtin_amdgcn_mfma_f32_32x32x16_bf16(kf1, qf[3], n1, 0, 0, 0);
        c0[14] = __builtin_amdgcn_exp2f(c0[14]); ps += c0[14]; c0[15] = __builtin_amdgcn_exp2f(c0[15]); ps += c0[15]; pwn[7] = pk2(c0[14], c0[15]);
        __builtin_amdgcn_sched_barrier(0);
        kf1 = *(const LAS bf16x8*)(kb_ + 0*32*192 + k5o);
        n0 = __builtin_amdgcn_mfma_f32_32x32x16_bf16(kf2, qf[4], n0, 0, 0, 0);
        c1[0] = __builtin_amdgcn_exp2f(c1[0]); ps += c1[0]; c1[1] = __builtin_amdgcn_exp2f(c1[1]); ps += c1[1]; pwn[8] = pk2(c1[0], c1[1]);
        __builtin_amdgcn_sched_barrier(0);
        kf2 = *(const LAS bf16x8*)(kb_ + 1*32*192 + k5o);
        n1 = __builtin_amdgcn_mfma_f32_32x32x16_bf16(kf0, qf[4], n1, 0, 0, 0);
        c1[2] = __builtin_amdgcn_exp2f(c1[2]); ps += c1[2]; c1[3] = __builtin_amdgcn_exp2f(c1[3]); ps += c1[3]; pwn[9] = pk2(c1[2], c1[3]);
        __builtin_amdgcn_sched_barrier(0);
        vf0a = *(const LAS u32x2*)(vb_ + ((0) ^ vsw) * 16); vf0b = *(const LAS u32x2*)(vb_ + ((1) ^ vsw) * 16);
        n0 = __builtin_amdgcn_mfma_f32_32x32x16_bf16(kf1, qf[5], n0, 0, 0, 0);
        c1[4] = __builtin_amdgcn_exp2f(c1[4]); ps += c1[4]; c1[5] = __builtin_amdgcn_exp2f(c1[5]); ps += c1[5]; pwn[10] = pk2(c1[4], c1[5]);
        __builtin_amdgcn_sched_barrier(0);
        vf1a = *(const LAS u32x2*)(vb_ + 32 * 128 + ((0) ^ vsw) * 16); vf1b = *(const LAS u32x2*)(vb_ + 32 * 128 + ((1) ^ vsw) * 16);
        n1 = __builtin_amdgcn_mfma_f32_32x32x16_bf16(kf2, qf[5], n1, 0, 0, 0);
        c1[6] = __builtin_amdgcn_exp2f(c1[6]); ps += c1[6]; c1[7] = __builtin_amdgcn_exp2f(c1[7]); ps += c1[7]; pwn[11] = pk2(c1[6], c1[7]);
        __builtin_amdgcn_sched_barrier(0);
        vf2a = *(const LAS u32x2*)(vb_ + ((2) ^ vsw) * 16); vf2b = *(const LAS u32x2*)(vb_ + ((3) ^ vsw) * 16);
        { const u32x4 pbu = {pwc[0], pwc[1], pwc[2], pwc[3]}; const u32x4 vv = {vf0a.x, vf0a.y, vf0b.x, vf0b.y};
          o0 = __builtin_amdgcn_mfma_f32_32x32x16_bf16(__builtin_bit_cast(bf16x8, vv), __builtin_bit_cast(bf16x8, pbu), o0, 0, 0, 0); }
        c1[8] = __builtin_amdgcn_exp2f(c1[8]); ps += c1[8]; c1[9] = __builtin_amdgcn_exp2f(c1[9]); ps += c1[9]; pwn[12] = pk2(c1[8], c1[9]);
        __builtin_amdgcn_sched_barrier(0);
        vf0a = *(const LAS u32x2*)(vb_ + 32 * 128 + ((2) ^ vsw) * 16); vf0b = *(const LAS u32x2*)(vb_ + 32 * 128 + ((3) ^ vsw) * 16);
        { const u32x4 pbu = {pwc[0], pwc[1], pwc[2], pwc[3]}; const u32x4 vv = {vf1a.x, vf1a.y, vf1b.x, vf1b.y};
          o1 = __builtin_amdgcn_mfma_f32_32x32x16_bf16(__builtin_bit_cast(bf16x8, vv), __builtin_bit_cast(bf16x8, pbu), o1, 0, 0, 0); }
        c1[10] = __builtin_amdgcn_exp2f(c1[10]); ps += c1[10]; c1[11] = __builtin_amdgcn_exp2f(c1[11]); ps += c1[11]; pwn[13] = pk2(c1[10], c1[11]);
        __builtin_amdgcn_sched_barrier(0);
        vf1a = *(const LAS u32x2*)(vb_ + ((4) ^ vsw) * 16); vf1b = *(const LAS u32x2*)(vb_ + ((5) ^ vsw) * 16);
        { const u32x4 pbu = {pwc[4], pwc[5], pwc[6], pwc[7]}; const u32x4 vv = {vf2a.x, vf2a.y, vf2b.x, vf2b.y};
          o0 = __builtin_amdgcn_mfma_f32_32x32x16_bf16(__builtin_bit_cast(bf16x8, vv), __builtin_bit_cast(bf16x8, pbu), o0, 0, 0, 0); }
        c1[12] = __builtin_amdgcn_exp2f(c1[12]); ps += c1[12]; c1[13] = __builtin_amdgcn_exp2f(c1[13]); ps += c1[13]; pwn[14] = pk2(c1[12], c1[13]);
        __builtin_amdgcn_sched_barrier(0);
        vf2a = *(const LAS u32x2*)(vb_ + 32 * 128 + ((4) ^ vsw) * 16); vf2b = *(const LAS u32x2*)(vb_ + 32 * 128 + ((5) ^ vsw) * 16);
        { const u32x4 pbu = {pwc[4], pwc[5], pwc[6], pwc[7]}; const u32x4 vv = {vf0a.x, vf0a.y, vf0b.x, vf0b.y};
          o1 = __builtin_amdgcn_mfma_f32_32x32x16_bf16(__builtin_bit_cast(bf16x8, vv), __builtin_bit_cast(bf16x8, pbu), o1, 0, 0, 0); }
        c1[14] = __builtin_amdgcn_exp2f(c1[14]); ps += c1[14]; c1[15] = __builtin_amdgcn_exp2f(c1[15]); ps += c1[15]; pwn[15] = pk2(c1[14], c1[15]);
        __builtin_amdgcn_sched_barrier(0);
        vf0a = *(const LAS u32x2*)(vb_ + ((6) ^ vsw) * 16); vf0b = *(const LAS u32x2*)(vb_ + ((7) ^ vsw) * 16);
        { const u32x4 pbu = {pwc[8], pwc[9], pwc[10], pwc[11]}; const u32x4 vv = {vf1a.x, vf1a.y, vf1b.x, vf1b.y};
          o0 = __builtin_amdgcn_mfma_f32_32x32x16_bf16(__builtin_bit_cast(bf16x8, vv), __builtin_bit_cast(bf16x8, pbu), o0, 0, 0, 0); }
        mxl = fmaxf(n0[0], n1[0]); mxl = fmaxf(fmaxf(mxl, n0[1]), n1[1]); mxl = fmaxf(fmaxf(mxl, n0[2]), n1[2]); mxl = fmaxf(fmaxf(mxl, n0[3]), n1[3]);
        __builtin_amdgcn_sched_barrier(0);
        vf1a = *(const LAS u32x2*)(vb_ + 32 * 128 + ((6) ^ vsw) * 16); vf1b = *(const LAS u32x2*)(vb_ + 32 * 128 + ((7) ^ vsw) * 16);
        { const u32x4 pbu = {pwc[8], pwc[9], pwc[10], pwc[11]}; const u32x4 vv = {vf2a.x, vf2a.y, vf2b.x, vf2b.y};
          o1 = __builtin_amdgcn_mfma_f32_32x32x16_bf16(__builtin_bit_cast(bf16x8, vv), __builtin_bit_cast(bf16x8, pbu), o1, 0, 0, 0); }
        mxl = fmaxf(fmaxf(mxl, n0[4]), n1[4]); mxl = fmaxf(fmaxf(mxl, n0[5]), n1[5]); mxl = fmaxf(fmaxf(mxl, n0[6]), n1[6]); mxl = fmaxf(fmaxf(mxl, n0[7]), n1[7]);
        __builtin_amdgcn_sched_barrier(0);
        { const u32x4 pbu = {pwc[12], pwc[13], pwc[14], pwc[15]}; const u32x4 vv = {vf0a.x, vf0a.y, vf0b.x, vf0b.y};
          o0 = __builtin_amdgcn_mfma_f32_32x32x16_bf16(__builtin_bit_cast(bf16x8, vv), __builtin_bit_cast(bf16x8, pbu), o0, 0, 0, 0); }
        mxl = fmaxf(fmaxf(mxl, n0[8]), n1[8]); mxl = fmaxf(fmaxf(mxl, n0[9]), n1[9]); mxl = fmaxf(fmaxf(mxl, n0[10]), n1[10]); mxl = fmaxf(fmaxf(mxl, n0[11]), n1[11]);
        __builtin_amdgcn_sched_barrier(0);
        { const u32x4 pbu = {pwc[12], pwc[13], pwc[14], pwc[15]}; const u32x4 vv = {vf1a.x, vf1a.y, vf1b.x, vf1b.y};
          o1 = __builtin_amdgcn_mfma_f32_32x32x16_bf16(__builtin_bit_cast(bf16x8, vv), __builtin_bit_cast(bf16x8, pbu), o1, 0, 0, 0); }
        mxl = fmaxf(fmaxf(mxl, n0[12]), n1[12]); mxl = fmaxf(fmaxf(mxl, n0[13]), n1[13]); mxl = fmaxf(fmaxf(mxl, n0[14]), n1[14]); mxl = fmaxf(fmaxf(mxl, n0[15]), n1[15]);
        __builtin_amdgcn_sched_barrier(0);
        mxn = fmaxf(mxl, __shfl_xor(mxl, 32));
    } else {
        u32x2 vf0a, vf0b, vf1a, vf1b, vf2a, vf2b;
        vf0a = *(const LAS u32x2*)(vb_ + ((0) ^ vsw) * 16); vf0b = *(const LAS u32x2*)(vb_ + ((1) ^ vsw) * 16);
        vf1a = *(const LAS u32x2*)(vb_ + 32 * 128 + ((0) ^ vsw) * 16); vf1b = *(const LAS u32x2*)(vb_ + 32 * 128 + ((1) ^ vsw) * 16);
        vf2a = *(const LAS u32x2*)(vb_ + ((2) ^ vsw) * 16); vf2b = *(const LAS u32x2*)(vb_ + ((3) ^ vsw) * 16);
        { const u32x4 pbu = {pwc[0], pwc[1], pwc[2], pwc[3]}; const u32x4 vv = {vf0a.x, vf0a.y, vf0b.x, vf0b.y};
          o0 = __builtin_amdgcn_mfma_f32_32x32x16_bf16(__builtin_bit_cast(bf16x8, vv), __builtin_bit_cast(bf16x8, pbu), o0, 0, 0, 0); }
        __builtin_amdgcn_sched_barrier(0);
        vf0a = *(const LAS u32x2*)(vb_ + 32 * 128 + ((2) ^ vsw) * 16); vf0b = *(const LAS u32x2*)(vb_ + 32 * 128 + ((3) ^ vsw) * 16);
        { const u32x4 pbu = {pwc[0], pwc[1], pwc[2], pwc[3]}; const u32x4 vv = {vf1a.x, vf1a.y, vf1b.x, vf1b.y};
          o1 = __builtin_amdgcn_mfma_f32_32x32x16_bf16(__builtin_bit_cast(bf16x8, vv), __builtin_bit_cast(bf16x8, pbu), o1, 0, 0, 0); }
        __builtin_amdgcn_sched_barrier(0);
        vf1a = *(const LAS u32x2*)(vb_ + ((4) ^ vsw) * 16); vf1b = *(const LAS u32x2*)(vb_ + ((5) ^ vsw) * 16);
        { const u32x4 pbu = {pwc[4], pwc[5], pwc[6], pwc[7]}; const u32x4 vv = {vf2a.x, vf2a.y, vf2b.x, vf2b.y};
          o0 = __builtin_amdgcn_mfma_f32_32x32x16_bf16(__builtin_bit_cast(bf16x8, vv), __builtin_bit_cast(bf16x8, pbu), o0, 0, 0, 0); }
        __builtin_amdgcn_sched_barrier(0);
        vf2a = *(const LAS u32x2*)(vb_ + 32 * 128 + ((4) ^ vsw) * 16); vf2b = *(const LAS u32x2*)(vb_ + 32 * 128 + ((5) ^ vsw) * 16);
        { const u32x4 pbu = {pwc[4], pwc[5], pwc[6], pwc[7]}; const u32x4 vv = {vf0a.x, vf0a.y, vf0b.x, vf0b.y};
          o1 = __builtin_amdgcn_mfma_f32_32x32x16_bf16(__builtin_bit_cast(bf16x8, vv), __builtin_bit_cast(bf16x8, pbu), o1, 0, 0, 0); }
        __builtin_amdgcn_sched_barrier(0);
        vf0a = *(const LAS u32x2*)(vb_ + ((6) ^ vsw) * 16); vf0b = *(const LAS u32x2*)(vb_ + ((7) ^ vsw) * 16);
        { const u32x4 pbu = {pwc[8], pwc[9], pwc[10], pwc[11]}; const u32x4 vv = {vf1a.x, vf1a.y, vf1b.x, vf1b.y};
          o0 = __builtin_amdgcn_mfma_f32_32x32x16_bf16(__builtin_bit_cast(bf16x8, vv), __builtin_bit_cast(bf16x8, pbu), o0, 0, 0, 0); }
        __builtin_amdgcn_sched_barrier(0);
        vf1a = *(const LAS u32x2*)(vb_ + 32 * 128 + ((6) ^ vsw) * 16); vf1b = *(const LAS u32x2*)(vb_ + 32 * 128 + ((7) ^ vsw) * 16);
        { const u32x4 pbu = {pwc[8], pwc[9], pwc[10], pwc[11]}; const u32x4 vv = {vf2a.x, vf2a.y, vf2b.x, vf2b.y};
          o1 = __builtin_amdgcn_mfma_f32_32x32x16_bf16(__builtin_bit_cast(bf16x8, vv), __builtin_bit_cast(bf16x8, pbu), o1, 0, 0, 0); }
        __builtin_amdgcn_sched_barrier(0);
        { const u32x4 pbu = {pwc[12], pwc[13], pwc[14], pwc[15]}; const u32x4 vv = {vf0a.x, vf0a.y, vf0b.x, vf0b.y};
          o0 = __builtin_amdgcn_mfma_f32_32x32x16_bf16(__builtin_bit_cast(bf16x8, vv), __builtin_bit_cast(bf16x8, pbu), o0, 0, 0, 0); }
        __builtin_amdgcn_sched_barrier(0);
        { const u32x4 pbu = {pwc[12], pwc[13], pwc[14], pwc[15]}; const u32x4 vv = {vf1a.x, vf1a.y, vf1b.x, vf1b.y};
          o1 = __builtin_amdgcn_mfma_f32_32x32x16_bf16(__builtin_bit_cast(bf16x8, vv), __builtin_bit_cast(bf16x8, pbu), o1, 0, 0, 0); }
        __builtin_amdgcn_sched_barrier(0);
    }
}

template <int DUMMY>
__device__ __forceinline__ void phase3q(const P& p, int bid, int nb, LAS unsigned char* lds) {
    const bf16_t* Q = p.slotA; const bf16_t* K = p.slotE; const bf16_t* VT = p.slotF; bf16_t* O = p.slotC;
    const int tid = opaque_tid(), lane = tid & 63, wid = tid >> 6, l31 = lane & 31, hh = lane >> 5;
    constexpr float THR = 8.f;
    const int widu = __builtin_amdgcn_readfirstlane(tid >> 6);
    int koff[3];
#pragma unroll
    for (int i = 0; i < 3; ++i) { const int s = tid + 256 * i, r = s / 12, pc = s % 12, c = (pc + 12 - ((r >> 2) & 3)) % 12; koff[i] = r * 96 + c * 8; }
    const int kt = hh + ((lane >> 2) & 3), kt16 = kt * 16, k4o = (8 + kt >= 12 ? kt - 4 : 8 + kt) * 16, k5o = (10 + kt >= 12 ? kt - 2 : 10 + kt) * 16;
    const int krow = l31 * 192, vsw = (lane >> 1) & 7, vrow = l31 * 128 + 8 * hh;
    for (int iu = 0;; ++iu) {
        const int r = iu * nb + ((iu & 1) ? nb - 1 - bid : bid); if (r >= 1024) break;
        const int qb = 63 - (r >> 4), bh = r & 15, b = bh >> 3, h = bh & 7;
        const int q0 = qb * 128 + wid * 32, ntw = (q0 >> 6) + 1, nt = 2 * qb + 2;
        const bf16_t* Kb = K + (size_t)bh * SEQ * 96; const bf16_t* Vb = VT + (size_t)(h * 64) * NT + (size_t)b * SEQ;
        bf16x8 qf[6]; { const bf16_t* qp = Q + ((size_t)bh * SEQ + q0 + l31) * 96 + hh * 8;
#pragma unroll
            for (int ks = 0; ks < 6; ++ks) qf[ks] = *(const bf16x8*)(qp + ks * 16); }
        f32x16 o0, o1;
#pragma unroll
        for (int e = 0; e < 16; ++e) { o0[e] = 0.f; o1[e] = 0.f; }
        float mrun = 0.f, lsum = 0.f; f32x16 negm;
#pragma unroll
        for (int e = 0; e < 16; ++e) negm[e] = 0.f;
        auto stageK = [&](int j) { LAS unsigned char* d = lds + (j & 1) * 12288 + widu * 1024; const bf16_t* kt = Kb + (size_t)j * 64 * 96;
#pragma unroll
            for (int i = 0; i < 3; ++i) __builtin_amdgcn_global_load_lds((const unsigned*)(kt + koff[i]), (LAS unsigned*)(d + i * 4096), 16, 0, 0); };
        auto stageV = [&](int j) { LAS unsigned char* d = lds + 24576 + (j & 1) * 8192 + widu * 1024; const bf16_t* vt = Vb + j * 64;
#pragma unroll
            for (int i = 0; i < 2; ++i) { const int dv = (tid >> 3) + 32 * i, cl = (tid & 7) ^ ((dv >> 1) & 7);
                __builtin_amdgcn_global_load_lds((const unsigned*)(vt + (size_t)dv * NT + cl * 8), (LAS unsigned*)(d + i * 4096), 16, 0, 0); } };
        f32x16 sA0, sA1, sB0, sB1; unsigned pA[16], pB[16]; float mxA, mxB = 0.f;
#pragma unroll
        for (int e = 0; e < 16; ++e) { pA[e] = 0u; pB[e] = 0u; }
        stageK(0); stageK(1);
        asm volatile("s_waitcnt vmcnt(0)" ::: "memory");
        __syncthreads();
        { const LAS unsigned char* kb_ = lds + krow;
#pragma unroll
          for (int e = 0; e < 16; ++e) { sA0[e] = 0.f; sA1[e] = 0.f; }
#pragma unroll
          for (int ks = 0; ks < 6; ++ks) { const int ko = ks <= 3 ? kt16 + 32 * ks : (ks == 4 ? k4o : k5o); const bf16x8 k0 = *(const LAS bf16x8*)(kb_ + ko); const bf16x8 k1 = *(const LAS bf16x8*)(kb_ + 32 * 192 + ko);
              sA0 = __builtin_amdgcn_mfma_f32_32x32x16_bf16(k0, qf[ks], sA0, 0, 0, 0); sA1 = __builtin_amdgcn_mfma_f32_32x32x16_bf16(k1, qf[ks], sA1, 0, 0, 0); }
          float m = fmaxf(sA0[0], sA1[0]);
#pragma unroll
          for (int e = 1; e < 16; ++e) m = fmaxf(fmaxf(m, sA0[e]), sA1[e]);
          mxA = fmaxf(m, __shfl_xor(m, 32)); }
        auto step = [&](f32x16& c0, f32x16& c1, float& mxc, f32x16& n0, f32x16& n1, float& mxn, const unsigned (&pwc)[16], unsigned (&pwn)[16], int s) {
            asm volatile("s_waitcnt vmcnt(0)" ::: "memory");
            __syncthreads();
            if (s + 2 < nt) stageK(s + 2);
            if (s < nt) stageV(s);
            if (s <= ntw) {
                const LAS unsigned char* kb_ = lds + ((s + 1) & 1) * 12288 + krow; const LAS unsigned char* vb_ = lds + 24576 + ((s + 1) & 1) * 8192 + vrow;
                if (s < ntw) {
                    const bool resc = (s == 0) || !__all(mxc <= THR); float alpha = 1.f;
                    if (resc) { const float dl = (s == 0) ? mxc : fmaxf(mxc, 0.f); alpha = __builtin_amdgcn_exp2f(-dl); mrun += dl;
#pragma unroll
                        for (int e = 0; e < 16; ++e) { c0[e] -= dl; c1[e] -= dl; negm[e] = -mrun; } }
                    float ps = 0.f;
                    if (s == 0) att_step<0>(kb_, vb_, kt16, k4o, k5o, vsw, qf, c0, c1, n0, n1, pwc, pwn, o0, o1, negm, ps, mxn);
                    else att_step<1>(kb_, vb_, kt16, k4o, k5o, vsw, qf, c0, c1, n0, n1, pwc, pwn, o0, o1, negm, ps, mxn);
                    if (resc) {
#pragma unroll
                        for (int e = 0; e < 16; ++e) { o0[e] *= alpha; o1[e] *= alpha; } }
                    lsum = lsum * alpha + ps;
                } else att_step<2>(kb_, vb_, kt16, k4o, k5o, vsw, qf, c0, c1, n0, n1, pwc, pwn, o0, o1, negm, lsum, mxn);
            }
        };
        for (int s = 0; s <= nt; s += 2) { step(sA0, sA1, mxA, sB0, sB1, mxB, pB, pA, s); if (s + 1 <= nt) step(sB0, sB1, mxB, sA0, sA1, mxA, pA, pB, s + 1); }
        const float inv = 1.f / (lsum + __shfl_xor(lsum, 32));
        bf16_t* op = O + (size_t)(b * SEQ + q0 + l31) * 512 + h * 64 + 4 * hh;
#pragma unroll
        for (int g = 0; g < 4; ++g) { uint2 w0, w1;
            w0.x = pk2(o0[4 * g] * inv, o0[4 * g + 1] * inv); w0.y = pk2(o0[4 * g + 2] * inv, o0[4 * g + 3] * inv);
            w1.x = pk2(o1[4 * g] * inv, o1[4 * g + 1] * inv); w1.y = pk2(o1[4 * g + 2] * inv, o1[4 * g + 3] * inv);
            *(uint2*)(op + 8 * g) = w0; *(uint2*)(op + 32 + 8 * g) = w1; }
        __syncthreads();
    }
}

__device__ __forceinline__ unsigned pack2bf(float lo, float hi) { return (unsigned)f2bf(lo) | ((unsigned)f2bf(hi) << 16); }
__device__ __forceinline__ void phase4(const P& p, int bid, int nb, LAS unsigned char* lds) {
    const bf16_t* O = p.slotC; const bf16_t* su = p.slotG; const bf16_t* gates = p.slotD; bf16_t* mo = p.slotA;
    const int tid = opaque_tid(), lane = tid & 63, wid = tid >> 6, wr = wid >> 1, wc = wid & 1, fr = lane & 15, fq = lane >> 4;
    const int c8 = ((tid & 7) ^ ((tid >> 3) & 7)) * 8;
    auto ops1 = [&](int rt, int ct) __attribute__((always_inline)) { return gops(O + (size_t)(rt * 128 + (tid >> 3)) * 512 + c8, (size_t)32 * 512, p.WoaT + (size_t)(ct * 128 + (tid >> 3)) * 512 + c8, (size_t)32 * 512); };
    auto ops2 = [&](int rt, int ct) __attribute__((always_inline)) { return gops(su + (size_t)(rt * 128 + (tid >> 3)) * 512 + c8, (size_t)32 * 512, p.WosT + (size_t)(ct * 128 + (tid >> 3)) * 512 + c8, (size_t)32 * 512); };
    int rt, ct; bool have = tile_of(0, bid, nb, NT / 128, DM / 128, rt, ct);
    for (int it = 0; have; ++it) {
        const int row0 = rt * 128, col0 = ct * 128;
        int rt2, ct2; const bool have2 = tile_of(it + 1, bid, nb, NT / 128, DM / 128, rt2, ct2);
        f32x4 acc[4][4];
#pragma unroll
        for (int m = 0; m < 4; ++m)
#pragma unroll
            for (int n = 0; n < 4; ++n) acc[m][n] = (f32x4){0.f, 0.f, 0.f, 0.f};
        uint2 gav[4][4], gbv[4][4];
#pragma unroll
        for (int m = 0; m < 4; ++m)
#pragma unroll
            for (int n = 0; n < 4; ++n) { const int t = row0 + wr * 64 + m * 16 + fr, c = col0 + wc * 64 + n * 16 + fq * 4;
                gav[m][n] = *(const uint2*)(gates + (size_t)t * 2048 + c); gbv[m][n] = *(const uint2*)(gates + (size_t)t * 2048 + 1024 + c); }
        mg_kloop_p(acc, ops1(rt, ct), 8, lds, it > 0, true, ops2(rt, ct));
#pragma unroll
        for (int m = 0; m < 4; ++m)
#pragma unroll
            for (int n = 0; n < 4; ++n) { const f32x4 ga = bf4(gav[m][n]), gb = bf4(gbv[m][n]);
#pragma unroll
                for (int j = 0; j < 4; ++j) acc[m][n][j] *= ga[j] * __builtin_amdgcn_rcpf(gb[j]); }
        mg_kloop_p(acc, ops2(rt, ct), 8, lds, true, have2, ops1(have2 ? rt2 : rt, have2 ? ct2 : ct));
#pragma unroll
        for (int m = 0; m < 4; ++m)
#pragma unroll
            for (int n = 0; n < 4; ++n) { const int t = row0 + wr * 64 + m * 16 + fr, c = col0 + wc * 64 + n * 16 + fq * 4;
                const f32x4 gb = bf4(gbv[m][n]);
                uint2 o; o.x = pk2(gb[0] * acc[m][n][0], gb[1] * acc[m][n][1]); o.y = pk2(gb[2] * acc[m][n][2], gb[3] * acc[m][n][3]); *(uint2*)(mo + (size_t)t * DM + c) = o; }
        rt = rt2; ct = ct2; have = have2;
    }
    __syncthreads();
}

__device__ __forceinline__ void phase5(const P& p, int bid, int nb, LAS unsigned char* sm) {
    const float* x = p.x; float* xm = p.out;
    mgemm(p.slotA, DM, p.WoutT, DM, NT, DM, DM, [=](int t, int c, const f32x4& v) {
        const f32x4 xv = *(const f32x4*)(x + (size_t)t * DM + c); *(f32x4*)(xm + (size_t)t * DM + c) = xv + v;
    }, bid, nb, sm);
}

__device__ __forceinline__ int gu_src_col(int rho, int& isup) {
    const int tt = rho >> 7, w = rho & 127, wc = w >> 6, n = (w >> 4) & 3, i = w & 15; isup = n >> 1; return tt * 64 + wc * 32 + (n & 1) * 16 + i;
}
__device__ __forceinline__ void ex_tile(const P& p, int tile, const float*& s0, const float*& s1, size_t& ld, bf16_t*& dst, int& K) {
    bf16_t* WguT = (bf16_t*)p.slotB; bf16_t* WdT = p.slotC + (size_t)NT * 512;
    const int e = tile / 192, tt = tile % 192;
    if (tt < 128) { const int tr = tt >> 4, tk = tt & 15, T = tr >> 1, wc = tr & 1, k0 = tk * 64, c0 = T * 64 + wc * 32;
        s0 = p.w_eg + ((size_t)e * 1024 + k0) * 256 + c0; s1 = p.w_eu + ((size_t)e * 1024 + k0) * 256 + c0; ld = 256; K = 1024;
        dst = WguT + ((size_t)e * 512 + tr * 64) * 1024 + k0; }
    else { const int t2 = tt - 128, tr = t2 >> 2, tk = t2 & 3, k0 = tk * 64, n0 = tr * 64;
        s0 = p.w_ed + ((size_t)e * 256 + k0) * 1024 + n0; s1 = s0 + 32; ld = 1024; K = 256;
        dst = WdT + ((size_t)e * 1024 + n0) * 256 + k0; }
}
__device__ __forceinline__ void expert_conv(const P& p, float* sm, LAS unsigned char* lds) {
    const int tid = opaque_tid(), kq = tid >> 4, r4 = (tid & 15) * 4;
    volatile LAS int* slot = (volatile LAS int*)(lds + LDS_MAIN_ + 8); unsigned* ctr = WQ_CTR(p.bar, 2);
    if (tid == 0) slot[0] = (int)__hip_atomic_fetch_add(ctr, 1u, __ATOMIC_RELAXED, __HIP_MEMORY_SCOPE_AGENT);
    __syncthreads();
    int q = slot[0];
    __syncthreads();
    while (q < 3072) {
        int pend = 0; if (tid == 0) pend = (int)__hip_atomic_fetch_add(ctr, 1u, __ATOMIC_RELAXED, __HIP_MEMORY_SCOPE_AGENT);
        f32x4 v[2][4]; bf16_t* dst[2]; int K[2];
#pragma unroll
        for (int u = 0; u < 2; ++u) { const float* s0; const float* s1; size_t ld; ex_tile(p, 2 * q + u, s0, s1, ld, dst[u], K[u]);
            const float* src = (r4 < 32 ? s0 + r4 : s1 + (r4 - 32));
#pragma unroll
            for (int i = 0; i < 4; ++i) v[u][i] = *(const f32x4*)(src + (size_t)(kq + 16 * i) * ld); }
#pragma unroll
        for (int u = 0; u < 2; ++u) {
#pragma unroll
            for (int i = 0; i < 4; ++i)
#pragma unroll
                for (int j = 0; j < 4; ++j) sm[u * 4160 + (kq + 16 * i) * 65 + r4 + j] = v[u][i][j]; }
        __syncthreads();
#pragma unroll
        for (int u = 0; u < 2; ++u) {
#pragma unroll
            for (int i = 0; i < 4; ++i) { const int rho = kq + 16 * i; const float* bb = sm + u * 4160 + r4 * 65 + rho;
                uint2 o; o.x = pk2(bb[0], bb[65]); o.y = pk2(bb[130], bb[195]); *(uint2*)(dst[u] + (size_t)rho * K[u] + r4) = o; } }
        if (tid == 0) slot[0] = pend;
        __syncthreads();
        q = slot[0];
    }
    __syncthreads();
}

__device__ __forceinline__ void phase6(const P& p, int bid, int nb, float* sm) {
    const int tid = opaque_tid(), lane = tid & 63, wid = tid >> 6;
    bf16_t* h2 = p.slotA; const float* xm = p.out;
    int* s_cnt = (int*)sm; int* s_base = s_cnt + 32; int* s_e = s_base + 32; int* s_r = s_e + 128; float* s_w = (float*)(s_r + 128);
    if (tid < 32) s_cnt[tid] = 0;
    __syncthreads();
    int slot = wid * 16;
    float* xs = sm + 512 + wid * 1024;
    f32x4 vpre[4]; f32x4 gf[4];
#pragma unroll
    for (int i = 0; i < 4; ++i) gf[i] = *(const f32x4*)(p.g_ffn + (lane + 64 * i) * 4);
    if (bid * 4 + wid < NT) {
#pragma unroll
        for (int i = 0; i < 4; ++i) vpre[i] = *(const f32x4*)(xm + (size_t)(bid * 4 + wid) * DM + (lane + 64 * i) * 4); }
    for (int t = bid * 4 + wid; t < NT; t += nb * 4, ++slot) {
        f32x4 v[4]; float ss = 0.f;
#pragma unroll
        for (int i = 0; i < 4; ++i) { v[i] = vpre[i]; ss += v[i][0] * v[i][0] + v[i][1] * v[i][1] + v[i][2] * v[i][2] + v[i][3] * v[i][3]; }
        if (t + nb * 4 < NT) {
#pragma unroll
            for (int i = 0; i < 4; ++i) vpre[i] = *(const f32x4*)(xm + (size_t)(t + nb * 4) * DM + (lane + 64 * i) * 4); }
        ss = wsumf(ss); const float r = rsqrtf(ss * (1.f / DM) + EPS);
#pragma unroll
        for (int i = 0; i < 4; ++i) { const f32x4 g = gf[i]; v[i] = v[i] * r * g; *(f32x4*)(xs + (lane + 64 * i) * 4) = v[i];
            uint2 o; o.x = pk2(v[i][0], v[i][1]); o.y = pk2(v[i][2], v[i][3]); *(uint2*)(h2 + (size_t)t * DM + (lane + 64 * i) * 4) = o; }
        f32x4 lgv = {0.f, 0.f, 0.f, 0.f};
#pragma unroll
        for (int i = 0; i < 16; ++i) { const int k = lane + 64 * i; lgv += xs[k] * *(const f32x4*)(p.w_rg + (size_t)k * 4); }
        float lg[4];
#pragma unroll
        for (int g = 0; g < 4; ++g) lg[g] = wsumf(lgv[g]) + p.b_rg[g];
        int gs = 0; float gm = lg[0];
#pragma unroll
        for (int g = 1; g < 4; ++g) if (lg[g] > gm) { gm = lg[g]; gs = g; }
        float den = 0.f;
#pragma unroll
        for (int g = 0; g < 4; ++g) den += __expf(lg[g] - gm);
        const float ptop = 1.f / den;
        f32x4 lev = {0.f, 0.f, 0.f, 0.f}; const float* wre = p.w_re + (size_t)gs * DM * 8;
#pragma unroll 16
        for (int i = 0; i < 32; ++i) { const int c = lane + 64 * i; lev += xs[c >> 1] * *(const f32x4*)(wre + (size_t)c * 4); }
        float le[8];
#pragma unroll
        for (int e = 0; e < 4; ++e) { const float mine = wsum_par(lev[e]), oth = DPP_F(mine, 0xB1); le[e] = mine + p.b_re[gs * 8 + e]; le[4 + e] = oth + p.b_re[gs * 8 + 4 + e]; }
        int e1 = 0; float l1 = le[0];
#pragma unroll
        for (int e = 1; e < 8; ++e) if (le[e] > l1) { l1 = le[e]; e1 = e; }
        int e2 = -1; float l2 = -3.0e38f;
#pragma unroll
        for (int e = 0; e < 8; ++e) if (e != e1 && le[e] > l2) { l2 = le[e]; e2 = e; }
        const float s1 = 1.f / (1.f + __expf(l2 - l1)), s2 = 1.f - s1;
        if (lane == 0) {
            const int ea = gs * 8 + e1, eb = gs * 8 + e2;
            s_e[2 * slot] = ea; s_e[2 * slot + 1] = eb; s_r[2 * slot] = atomicAdd(&s_cnt[ea], 1); s_r[2 * slot + 1] = atomicAdd(&s_cnt[eb], 1);
            s_w[2 * slot] = s1 * ptop; s_w[2 * slot + 1] = s2 * ptop;
        }
    }
    __syncthreads();
    if (tid < 32) { const int c = s_cnt[tid]; s_base[tid] = c ? atomicAdd(&p.cnt[tid], c) : 0; }
    __syncthreads();
    if (tid < 128) { const int sl = tid >> 1, kk = tid & 1, w = sl >> 4, k = sl & 15, t = bid * 4 + w + k * nb * 4;
        if (t < NT) { const int a = 2 * t + kk, e = s_e[tid]; p.list[(size_t)e * NT + s_base[e] + s_r[tid]] = a; p.aw[a] = s_w[tid]; p.aexp[a] = e; } }
    __syncthreads();
}

__device__ __forceinline__ void phase7a(const P& p, int bid, int nb) {
    const bf16_t* h2 = p.slotA; const bf16_t* WguT = (const bf16_t*)p.slotB; bf16_t* hid = p.slotE;
    for (size_t i = (size_t)bid * 256 + threadIdx.x; i < (size_t)2 * NT * 256; i += (size_t)nb * 256) {
        const int a = (int)(i >> 8), c = (int)(i & 255), t = a >> 1, e = p.aexp[a];
        const int tt = c >> 6, wc = (c >> 5) & 1, nn = (c >> 4) & 1, ii = c & 15; const int rg = tt * 128 + wc * 64 + nn * 16 + ii, ru = rg + 32;
        const bf16_t* wg = WguT + ((size_t)e * 512 + rg) * 1024; const bf16_t* wu = WguT + ((size_t)e * 512 + ru) * 1024; const bf16_t* hr = h2 + (size_t)t * DM;
        float G = 0.f, U = 0.f;
        for (int k = 0; k < DM / 8; ++k) { const uint4 hv = ((const uint4*)hr)[k]; G += dot8(hv, ((const uint4*)wg)[k]); U += dot8(hv, ((const uint4*)wu)[k]); }
        hid[i] = f2bf(G * sigmoidf_(G) * U);
    }
}
__device__ __forceinline__ void phase7b(const P& p, int bid, int nb) {
    const bf16_t* hid = p.slotE; const bf16_t* WdT = p.slotC + (size_t)NT * 512; bf16_t* Y = p.slotD;
    for (size_t i = (size_t)bid * 256 + threadIdx.x; i < (size_t)2 * NT * DM; i += (size_t)nb * 256) {
        const int a = (int)(i >> 10), n = (int)(i & 1023), e = p.aexp[a];
        const bf16_t* w = WdT + ((size_t)e * 1024 + n) * 256; const bf16_t* hr = hid + (size_t)a * 256; float s = 0.f;
        for (int k = 0; k < 32; ++k) s += dot8(((const uint4*)hr)[k], ((const uint4*)w)[k]);
        Y[i] = f2bf(s * p.aw[a]);
    }
}


__device__ __forceinline__ void build_expert_table(const int* cnt, volatile LAS int* tab) {
    const int tid = threadIdx.x;
    if (tid < 64) { const int c = tid < NE ? cnt[tid] : 0; int n = (c + 127) >> 7, incl = n;
#pragma unroll
        for (int o = 1; o < 32; o <<= 1) { const int y = __shfl_up(incl, o); if ((tid & 63) >= o) incl += y; }
        if (tid < NE) { tab[tid] = incl - n; tab[32 + tid] = c; } if (tid == NE - 1) tab[64] = incl; }
    __syncthreads();
}
__device__ __forceinline__ bool find_expert(volatile LAS int* tab, int ub, int& e, int& blk, int& ce) {
    if (ub >= tab[64]) return false;
    int lo = 0;
#pragma unroll
    for (int st = 16; st > 0; st >>= 1) if (tab[lo + st] <= ub) lo += st;
    e = lo; blk = ub - tab[lo]; ce = tab[32 + lo]; return true;
}
__device__ __forceinline__ void phase7a_m(const P& p, int bid, int nb, LAS unsigned char* lds) {
    const bf16_t* h2 = p.slotA; const bf16_t* WguT = (const bf16_t*)p.slotB; bf16_t* hid = p.slotE;
    const int tid = opaque_tid(), lane = tid & 63, wid = tid >> 6, wr = wid >> 1, wc = wid & 1, fr = lane & 15, fq = lane >> 4;
    const int c8 = ((tid & 7) ^ ((tid >> 3) & 7)) * 8;
    volatile LAS int* tab = (volatile LAS int*)(lds + LDS_TAB_); build_expert_table(p.cnt, tab);
    auto make = [&](int u, GOps& g) __attribute__((always_inline)) -> bool {
        int e, blk, ce; if (!find_expert(tab, u >> 2, e, blk, ce)) return false;
        const int ct = u & 3; const int* lst = p.list + (size_t)e * NT; const bf16_t* ap[4];
#pragma unroll
        for (int i = 0; i < 4; ++i) { int r = blk * 128 + (tid >> 3) + 32 * i; r = r < ce ? r : ce - 1; ap[i] = h2 + (size_t)(lst[r] >> 1) * DM + c8; }
        g.a0 = ap[0]; g.a1 = ap[1]; g.a2 = ap[2]; g.a3 = ap[3]; g.bp = WguT + ((size_t)e * 512 + ct * 128 + (tid >> 3)) * 1024 + c8; g.bstep = (size_t)32 * 1024; return true; };
    GOps cur; bool have = make(bid, cur);
    for (int u = bid, it = 0; have; u += nb, ++it) {
        GOps nxt = cur; const bool have2 = make(u + nb, nxt);
        f32x4 acc[4][4];
#pragma unroll
        for (int m = 0; m < 4; ++m)
#pragma unroll
            for (int n = 0; n < 4; ++n) acc[m][n] = (f32x4){0.f, 0.f, 0.f, 0.f};
        mg_kloop_p(acc, cur, 16, lds, it > 0, have2, nxt);
        const int ct = u & 3;
        bf16_t* hb = hid + ((size_t)(u >> 2) * 128 + wr * 64 + fr) * 256 + ct * 64 + wc * 32 + fq * 4;
#pragma unroll
        for (int m = 0; m < 4; ++m)
#pragma unroll
            for (int n = 0; n < 2; ++n) { float v[4];
#pragma unroll
                for (int j = 0; j < 4; ++j) { const float g = acc[m][n][j]; v[j] = g * fsigmoid(g) * acc[m][n + 2][j]; }
                uint2 o; o.x = pk2(v[0], v[1]); o.y = pk2(v[2], v[3]); *(uint2*)(hb + (size_t)(m * 16) * 256 + n * 16) = o; }
        cur = nxt; have = have2;
    }
    __syncthreads();
}
__device__ __forceinline__ void phase7b_m(const P& p, int bid, int nb, LAS unsigned char* lds) {
    const bf16_t* hid = p.slotE; const bf16_t* WdT = p.slotC + (size_t)NT * 512; bf16_t* Y = p.slotD;
    const int tid = opaque_tid(), lane = tid & 63, wid = tid >> 6, wr = wid >> 1, wc = wid & 1, fr = lane & 15, fq = lane >> 4;
    const int c8 = ((tid & 7) ^ ((tid >> 3) & 7)) * 8;
    int e, blk, ce;
    volatile LAS int* tab = (volatile LAS int*)(lds + LDS_TAB_); build_expert_table(p.cnt, tab);
    auto make = [&](int u, GOps& g, int& e_, int& blk_, int& ce_) __attribute__((always_inline)) -> bool {
        if (!find_expert(tab, u >> 3, e_, blk_, ce_)) return false;
        g = gops(hid + ((size_t)(u >> 3) * 128 + (tid >> 3)) * 256 + c8, (size_t)32 * 256, WdT + ((size_t)e_ * 1024 + (u & 7) * 128 + (tid >> 3)) * 256 + c8, (size_t)32 * 256); return true; };
    GOps cur; bool have = make(bid, cur, e, blk, ce);
    for (int u = bid, it = 0; have; u += nb, ++it) {
        GOps nxt = cur; int e2 = 0, blk2 = 0, ce2 = 0; const bool have2 = make(u + nb, nxt, e2, blk2, ce2);
        const int ct = u & 7; const int* lst = p.list + (size_t)e * NT;
        f32x4 acc[4][4];
#pragma unroll
        for (int m = 0; m < 4; ++m)
#pragma unroll
            for (int n = 0; n < 4; ++n) acc[m][n] = (f32x4){0.f, 0.f, 0.f, 0.f};
        mg_kloop_p(acc, cur, 4, lds, it > 0, have2, nxt);
#pragma unroll
        for (int m = 0; m < 4; ++m) { const int r = blk * 128 + wr * 64 + m * 16 + fr;
            if (r < ce) { const int a = lst[r]; const float w = p.aw[a]; bf16_t* yp = Y + (size_t)a * DM + ct * 128 + wc * 64 + fq * 4;
#pragma unroll
                for (int n = 0; n < 4; ++n) { uint2 o; o.x = pk2(acc[m][n][0] * w, acc[m][n][1] * w); o.y = pk2(acc[m][n][2] * w, acc[m][n][3] * w); *(uint2*)(yp + n * 16) = o; } } }
        cur = nxt; e = e2; blk = blk2; ce = ce2; have = have2;
    }
    __syncthreads();
}

__device__ __forceinline__ void phase8(const P& p, int bid, int nb, float* dst) {
    const int tid = opaque_tid(), lane = tid & 63, wid = tid >> 6; const bf16_t* Y = p.slotD;
    for (int t = bid * 4 + wid; t < NT; t += nb * 4) {
        f32x4 v[4]; float ss = 0.f;
#pragma unroll
        for (int i = 0; i < 4; ++i) { const int c = (lane + 64 * i) * 4;
            v[i] = *(const f32x4*)(p.out + (size_t)t * DM + c) + bf4(*(const uint2*)(Y + (size_t)(2 * t) * DM + c)) + bf4(*(const uint2*)(Y + (size_t)(2 * t + 1) * DM + c));
            ss += v[i][0] * v[i][0] + v[i][1] * v[i][1] + v[i][2] * v[i][2] + v[i][3] * v[i][3]; }
        ss = wsumf(ss); const float r = rsqrtf(ss * (1.f / DM) + EPS);
#pragma unroll
        for (int i = 0; i < 4; ++i) { const int c = (lane + 64 * i) * 4; const f32x4 g = *(const f32x4*)(p.g_final + c); *(f32x4*)(dst + (size_t)t * DM + c) = v[i] * r * g; }
    }
}

#define XB_TMO      128
#define XB_XCNT(j)  (256  + 64 * (j))
#define XB_XSUB(j)  (1280 + 64 * (j))
#define XB_XGEN(j)  (2304 + 64 * (j))
#define XB_TOP      3328
#define XB_TOPGEN   3392
#define XCD_BAR_WORDS 3456
#define XB_SPIN_CAP (1u << 18)
__device__ __forceinline__ unsigned xb_ld(unsigned* p)              { return __hip_atomic_load(p, __ATOMIC_RELAXED, __HIP_MEMORY_SCOPE_AGENT); }
__device__ __forceinline__ unsigned xb_add(unsigned* p, unsigned v) { return __hip_atomic_fetch_add(p, v, __ATOMIC_RELAXED, __HIP_MEMORY_SCOPE_AGENT); }
__device__ __forceinline__ unsigned xb_xcc_id() { return (unsigned)__builtin_amdgcn_s_getreg((3 << 11) | 20) & 0xFu; }
#define XB_SPIN(cond, bar) do { unsigned _sp = 0; while (cond) { __builtin_amdgcn_s_sleep(1); \
    if ((++_sp & 255u) == 0u) { if (xb_ld(&(bar)[XB_TMO])) break; if (_sp > XB_SPIN_CAP) { atomicAdd(&(bar)[XB_TMO], 1u); break; } } } } while (0)
struct XcdBarrier { unsigned* bar; unsigned x; volatile LAS unsigned* st; };
__device__ __forceinline__ XcdBarrier xcd_barrier_post(unsigned* bar, volatile LAS unsigned* st) {
    XcdBarrier b; b.bar = bar; b.x = xb_xcc_id(); b.st = st;
    if (threadIdx.x == 0) (void)xb_add(&bar[XB_XCNT(b.x)], 1u);
    return b;
}
__device__ __forceinline__ void xcd_barrier_complete(unsigned* bar, unsigned x, unsigned& nloc, unsigned& nx) {
    const unsigned G = gridDim.x * gridDim.y * gridDim.z;
    unsigned sum, cnt, mine, sp = 0u;
    for (;;) {
        sum = 0u; cnt = 0u; mine = 0u;
#pragma unroll
        for (unsigned j = 0; j < 16; ++j) { const unsigned c = xb_ld(&bar[XB_XCNT(j)]); sum += c; cnt += (c > 0u) ? 1u : 0u; mine = (j == x) ? c : mine; }
        if (sum == G) break;
        __builtin_amdgcn_s_sleep(1);
        if ((++sp & 255u) == 0u) { if (xb_ld(&bar[XB_TMO])) break; if (sp > XB_SPIN_CAP) { atomicAdd(&bar[XB_TMO], 1u); break; } }
    }
    nloc = mine > 0u ? mine : 1u; nx = cnt > 0u ? cnt : 1u;
}
__device__ __forceinline__ void xcd_barrier(const XcdBarrier& b) {
    asm volatile("s_waitcnt vmcnt(0)" ::: "memory");
    __syncthreads();
    if (threadIdx.x == 0) {
        unsigned* bar = b.bar;
        __builtin_amdgcn_s_waitcnt(0);
        unsigned nloc = b.st[0], nx = b.st[1];
        if (nloc == 0u) { xcd_barrier_complete(bar, b.x, nloc, nx); b.st[0] = nloc; b.st[1] = nx; }
        const unsigned old = xb_add(&bar[XB_XSUB(b.x)], 1u);
        const unsigned gen = old / nloc;
        if (old + 1u == (gen + 1u) * nloc) {
            __builtin_amdgcn_fence(__ATOMIC_RELEASE, "agent");
            asm volatile("s_waitcnt vmcnt(0)" ::: "memory");
            const unsigned og = xb_add(&bar[XB_TOP], 1u);
            const unsigned tg = og / nx;
            if (og + 1u == (tg + 1u) * nx) xb_add(&bar[XB_TOPGEN], 1u);
            else XB_SPIN(xb_ld(&bar[XB_TOPGEN]) == tg, bar);
            __builtin_amdgcn_fence(__ATOMIC_ACQUIRE, "agent");
            xb_add(&bar[XB_XGEN(b.x)], 1u);
            asm volatile("s_waitcnt vmcnt(0)" ::: "memory");
        } else {
            XB_SPIN(xb_ld(&bar[XB_XGEN(b.x)]) == gen, bar);
            __builtin_amdgcn_fence(__ATOMIC_ACQUIRE, "agent");
            asm volatile("s_waitcnt vmcnt(0)" ::: "memory");
        }
    }
    __syncthreads();
}

constexpr int LDS_MAIN = 64 * 1024;
constexpr int LDS_BYTES = LDS_MAIN + 16 + 288;
extern __shared__ __attribute__((aligned(16))) unsigned char smem_raw[];

#if MK_LAUNCHES != 1
__global__ void __launch_bounds__(256, 2) k_phase(P p, int ph) {
    float* sm = (float*)smem_raw; LAS unsigned char* lds = (LAS unsigned char*)smem_raw; const int bid = blockIdx.x, nb = gridDim.x;
    switch (ph) {
        case 0: phase0(p, bid, nb, sm); break;
        case 1: phase1(p, bid, nb, lds); break;
        case 2: phase2a(p, bid, nb, false); break;
        case 3: phase2b(p, bid, nb, lds); break;
        case 4: phase2c_m(p, bid, nb, lds); break;
        case 5: phase3q<0>(p, bid, nb, lds); break;
        case 6: phase4(p, bid, nb, lds); break;
        case 7: phase5(p, bid, nb, lds); break;
        case 8: phase6(p, bid, nb, sm); break;
        case 9: phase7a_m(p, bid, nb, lds); break;
        case 10: phase7b_m(p, bid, nb, lds); break;
        case 11: phase8(p, bid, nb, p.out); break;
    }
}
#endif

#ifndef PROF_SEL
#define PROF_SEL -1
#endif
#define PROF_MULT 4
__global__ void __launch_bounds__(256, 2) k_mega(P p) {
    float* sm = (float*)smem_raw; LAS unsigned char* lds = (LAS unsigned char*)smem_raw; const int bid = blockIdx.x, nb = gridDim.x;
    volatile LAS unsigned* st = (volatile LAS unsigned*)(lds + LDS_MAIN);
    if (threadIdx.x < 4) st[threadIdx.x] = 0u;
    __syncthreads();
    const XcdBarrier gb = xcd_barrier_post(p.bar, st);
    unsigned long long t_last = 0, t_sel = 0;
#define STAMP(k) do { if (PROF_SEL >= 0 && PROF_SEL < 100) { const unsigned long long t_ = __builtin_amdgcn_s_memrealtime(); if (PROF_SEL == (k) - 1) t_sel = t_ - t_last; t_last = t_; } } while (0)
#define BAR(k) do { if (PROF_SEL == 100 + (k)) { const unsigned long long ta_ = __builtin_amdgcn_s_memrealtime(); xcd_barrier(gb); const unsigned long long tb_ = __builtin_amdgcn_s_memrealtime(); \
        if (threadIdx.x == 0) atomicAdd(p.bar + XCD_BAR_WORDS, (unsigned)(tb_ - ta_)); } else xcd_barrier(gb); STAMP((k) + 1); } while (0)
    STAMP(0);
    phase0(p, bid, nb, sm); BAR(0);
    phase1(p, bid, nb, lds); BAR(1);
    phase2a(p, bid, nb, false); BAR(2);
    phase2b(p, bid, nb, lds); phase2c_m(p, bid, nb, lds); BAR(3);
    phase3q<0>(p, bid, nb, lds); expert_conv(p, sm, lds); BAR(4);
    phase4(p, bid, nb, lds); BAR(5);
    phase5(p, bid, nb, lds); BAR(6);
    phase6(p, bid, nb, sm); BAR(7);
    phase7a_m(p, bid, nb, lds); BAR(8);
    phase7b_m(p, bid, nb, lds); BAR(9);
    phase8(p, bid, nb, p.out);
    if (PROF_SEL >= 0) {
        xcd_barrier(gb); STAMP(11);
        if (bid == 0 && threadIdx.x == 0) {
            unsigned long long metric = t_sel;
            if (PROF_SEL >= 100) metric = __hip_atomic_load(p.bar + XCD_BAR_WORDS, __ATOMIC_RELAXED, __HIP_MEMORY_SCOPE_AGENT) / (unsigned)nb;
            const unsigned long long t0 = __builtin_amdgcn_s_memrealtime();
            while (__builtin_amdgcn_s_memrealtime() - t0 < metric * PROF_MULT) __builtin_amdgcn_s_sleep(8);
        }
    }
}

extern "C" void kernel_launch(void* const* d_in, const int* in_sizes, int n_in, void* d_out, int out_size, void* d_ws, size_t ws_size, hipStream_t stream) {
    P p{};
    p.x = (const float*)d_in[0]; p.pos = (const int*)d_in[1]; p.g_attn = (const float*)d_in[2]; p.w_in = (const float*)d_in[3]; p.g_cq = (const float*)d_in[4];
    p.w_uq = (const float*)d_in[5]; p.g_ckv = (const float*)d_in[6]; p.w_uk = (const float*)d_in[7]; p.w_uv = (const float*)d_in[8]; p.w_o_attn = (const float*)d_in[9];
    p.sgu_gain = (const float*)d_in[10]; p.sgu_bias = (const float*)d_in[11]; p.w_sp = (const float*)d_in[12]; p.b_sp = (const float*)d_in[13]; p.w_o_sgu = (const float*)d_in[14];
    p.w_out = (const float*)d_in[15]; p.g_ffn = (const float*)d_in[16]; p.w_rg = (const float*)d_in[17]; p.b_rg = (const float*)d_in[18]; p.w_re = (const float*)d_in[19];
    p.b_re = (const float*)d_in[20]; p.w_eg = (const float*)d_in[21]; p.w_eu = (const float*)d_in[22]; p.w_ed = (const float*)d_in[23]; p.g_final = (const float*)d_in[24];
    p.out = (float*)d_out;
    unsigned char* w = (unsigned char*)d_ws; size_t off = 0;
    auto take = [&](size_t bytes) { unsigned char* r = w + off; off += (bytes + 255) & ~(size_t)255; return r; };
    p.bar = (unsigned*)take((XCD_BAR_WORDS + 256) * 4);
    p.cnt = (int*)take(4096);
    p.WinT = (bf16_t*)take((size_t)ZP * DM * 2); p.WuqT = (bf16_t*)take(768 * 256 * 2); p.WukT = (bf16_t*)take(512 * 128 * 2); p.WuvT = (bf16_t*)take(512 * 128 * 2);
    p.WoaT = (bf16_t*)take(1024 * 512 * 2); p.WosT = (bf16_t*)take(1024 * 512 * 2); p.WoutT = (bf16_t*)take(1024 * 1024 * 2); p.Wsp = (bf16_t*)take(8 * 128 * 128 * 2);
    p.cs = (float*)take((size_t)NT * 32 * 4); p.cqn = (bf16_t*)take((size_t)NT * 256 * 2); p.ckvn = (bf16_t*)take((size_t)NT * 128 * 2);
    p.list = (int*)take((size_t)NE * NT * 4); p.aw = (float*)take((size_t)2 * NT * 4); p.aexp = (int*)take((size_t)2 * NT * 4);
    p.slotA = (bf16_t*)take((size_t)NT * DM * 2);
    p.slotB = take((size_t)NT * 512 * 4);
    p.slotC = (bf16_t*)take((size_t)NT * 1024 * 2);
    p.slotD = (bf16_t*)take((size_t)NT * 2048 * 2);
    p.slotE = (bf16_t*)take((size_t)NT * NH * 96 * 2);
    p.slotF = (bf16_t*)take((size_t)512 * NT * 2);
    p.slotG = (bf16_t*)take((size_t)NT * 512 * 2);
    if (off > ws_size) { fprintf(stderr, "workspace too small: need %zu have %zu\n", off, ws_size); return; }
#if MK_LAUNCHES == 1
    static int grid_blocks = 0;
    if (!grid_blocks) { int dev = 0, cus = 0, per_cu = 0; hipGetDevice(&dev); hipDeviceGetAttribute(&cus, hipDeviceAttributeMultiprocessorCount, dev);
        hipOccupancyMaxActiveBlocksPerMultiprocessor(&per_cu, k_mega, 256, LDS_BYTES); if (per_cu > 2) per_cu = 2; grid_blocks = cus * per_cu; }
    (void)hipMemsetAsync(p.bar, 0, (XCD_BAR_WORDS + 256) * 4, stream);
    void* args[] = {&p};
    hipError_t e = hipLaunchCooperativeKernel((void*)k_mega, dim3(grid_blocks), dim3(256), args, LDS_BYTES, stream);
    if (e != hipSuccess) fprintf(stderr, "cooperative launch failed: %s (grid %d)\n", hipGetErrorString(e), grid_blocks);
#else
    for (int ph = 0; ph < 12; ++ph) k_phase<<<2048, 256, LDS_BYTES, stream>>>(p, ph);
#endif
}
```

```cpp
#include <hip/hip_runtime.h>
#include <hip/hip_cooperative_groups.h>
#include <cstdint>
#include <cstdio>
namespace cg = cooperative_groups;


typedef unsigned short bf16_t;
constexpr int NT = 16384, SEQ = 8192, DM = 1024, NBATCH = 2;
constexpr int ZC = 3488;
constexpr int ZP = 3584;
constexpr int NH = 8;
constexpr float EPS = 1e-6f;
constexpr int NE = 32;
#define WQ_CTR(bar, k) ((bar) + 3456 + 64 + 16 * (k))
constexpr int LDS_MAIN_ = 64 * 1024;
constexpr int LDS_TAB_ = 64 * 1024 + 16;

struct P {
    const float* x; const int* pos; const float* g_attn; const float* w_in; const float* g_cq; const float* w_uq;
    const float* g_ckv; const float* w_uk; const float* w_uv; const float* w_o_attn; const float* sgu_gain; const float* sgu_bias;
    const float* w_sp; const float* b_sp; const float* w_o_sgu; const float* w_out; const float* g_ffn; const float* w_rg;
    const float* b_rg; const float* w_re; const float* b_re; const float* w_eg; const float* w_eu; const float* w_ed; const float* g_final;
    float* out;
    unsigned* bar;
    int* cnt;
    bf16_t* WinT;
    bf16_t* WuqT;
    bf16_t* WukT;
    bf16_t* WuvT;
    bf16_t* WoaT;
    bf16_t* WosT;
    bf16_t* WoutT;
    bf16_t* Wsp;
    float* cs;
    bf16_t* cqn;
    bf16_t* ckvn;
    int* list;
    float* aw;
    int* aexp;
    bf16_t* slotA;
    unsigned char* slotB;
    bf16_t* slotC;
    bf16_t* slotD;
    bf16_t* slotE;
    bf16_t* slotF;
    bf16_t* slotG;
};

__device__ __forceinline__ int opaque_tid() { int t = threadIdx.x; asm volatile("" : "+v"(t)); return t; }
__device__ __forceinline__ float bf2f(bf16_t v) { return __uint_as_float(((unsigned)v) << 16); }
__device__ __forceinline__ bf16_t f2bf(float f) { unsigned u = __float_as_uint(f); u += 0x7fffu + ((u >> 16) & 1u); return (bf16_t)(u >> 16); }

#define DPP_F(v, ctrl) __builtin_bit_cast(float, __builtin_amdgcn_update_dpp(0, __builtin_bit_cast(int, (v)), (ctrl), 0xF, 0xF, true))
__device__ __forceinline__ float xrows(float v) {
    { const auto r = __builtin_amdgcn_permlane16_swap(__float_as_uint(v), __float_as_uint(v), false, false); v = __uint_as_float(r[0]) + __uint_as_float(r[1]); }
    { const auto r = __builtin_amdgcn_permlane32_swap(__float_as_uint(v), __float_as_uint(v), false, false); v = __uint_as_float(r[0]) + __uint_as_float(r[1]); }
    return v;
}
__device__ __forceinline__ float wsumf(float v) {
    v += DPP_F(v, 0xB1); v += DPP_F(v, 0x4E); v += DPP_F(v, 0x141); v += DPP_F(v, 0x140); return xrows(v);
}
__device__ __forceinline__ float wsum_par(float v) {
    v += DPP_F(v, 0x128); v += DPP_F(v, 0x124); v += DPP_F(v, 0x122); return xrows(v);
}
__device__ __forceinline__ float fsigmoid(float v) { return __builtin_amdgcn_rcpf(1.f + __builtin_amdgcn_exp2f(-1.4426950408889634f * v)); }
__device__ __forceinline__ float fgelu(float v) { const float u2 = 1.5957691216057308f * (v + 0.044715f * v * v * v); return v * fsigmoid(u2); }

#define LAS __attribute__((address_space(3)))
typedef short bf16x8 __attribute__((ext_vector_type(8)));
typedef float f32x4 __attribute__((ext_vector_type(4)));
constexpr int GEMM_LDS = 65536;
typedef float f32x16 __attribute__((ext_vector_type(16)));
typedef unsigned u32x2 __attribute__((ext_vector_type(2)));
typedef unsigned u32x4 __attribute__((ext_vector_type(4)));
typedef __bf16 bf16v2 __attribute__((ext_vector_type(2)));
typedef float f32v2 __attribute__((ext_vector_type(2)));
__device__ __forceinline__ unsigned pk2(float lo, float hi) { const f32v2 v = {lo, hi}; return __builtin_bit_cast(unsigned, __builtin_convertvector(v, bf16v2)); }
__device__ __forceinline__ f32x4 bf4(const uint2 u) { return (f32x4){__uint_as_float(u.x << 16), __uint_as_float(u.x & 0xffff0000u), __uint_as_float(u.y << 16), __uint_as_float(u.y & 0xffff0000u)}; }


template <class F>
__device__ __forceinline__ int tconv(bf16_t* dst, int R, int K, F f, int base, int bid, int nb, float* sm) {
    const int tid = opaque_tid(), tk = K / 64, ntile = (R / 64) * tk;
    for (int tile = ((bid - base) % nb + nb) % nb; tile < ntile; tile += nb) {
        const int rho0 = (tile / tk) * 64, k0 = (tile % tk) * 64;
#pragma unroll
        for (int i = 0; i < 16; ++i) { const int kk = (tid >> 6) + 4 * i, rr = tid & 63; sm[kk * 65 + rr] = f(k0 + kk, rho0 + rr); }
        __syncthreads();
#pragma unroll
        for (int i = 0; i < 8; ++i) { const int rr = (tid >> 5) + 8 * i, kk = (tid & 31) * 2;
            *(unsigned*)(dst + (size_t)(rho0 + rr) * K + k0 + kk) = pk2(sm[kk * 65 + rr], sm[(kk + 1) * 65 + rr]); }
        __syncthreads();
    }
    return base + ntile;
}

__device__ __forceinline__ void phase0(const P& p, int bid, int nb, float* sm) {
    const int tid = opaque_tid(), lane = tid & 63, wid = tid >> 6;
    const size_t gtid = (size_t)bid * 256 + tid, gsz = (size_t)nb * 256;
    if (bid == 0 && tid < NE) p.cnt[tid] = 0;
    { int t = bid * 4 + wid; f32x4 v[4];
      if (t < NT) {
#pragma unroll
          for (int i = 0; i < 4; ++i) v[i] = *(const f32x4*)(p.x + (size_t)t * DM + (lane + 64 * i) * 4); }
      for (; t < NT; t += nb * 4) {
          const int tn = t + nb * 4; f32x4 vn[4];
          if (tn < NT) {
#pragma unroll
              for (int i = 0; i < 4; ++i) vn[i] = *(const f32x4*)(p.x + (size_t)tn * DM + (lane + 64 * i) * 4); }
          float ss = 0.f;
#pragma unroll
          for (int i = 0; i < 4; ++i) ss += v[i][0] * v[i][0] + v[i][1] * v[i][1] + v[i][2] * v[i][2] + v[i][3] * v[i][3];
          ss = wsumf(ss); const float r = rsqrtf(ss * (1.f / DM) + EPS);
          bf16_t* hr = p.slotA + (size_t)t * DM;
#pragma unroll
          for (int i = 0; i < 4; ++i) { uint2 o; o.x = pk2(v[i][0] * r, v[i][1] * r); o.y = pk2(v[i][2] * r, v[i][3] * r); *(uint2*)(hr + (lane + 64 * i) * 4) = o; }
#pragma unroll
          for (int i = 0; i < 4; ++i) v[i] = vn[i];
      } }
    { const int kq = tid >> 4, r4 = (tid & 15) * 4;
      for (int t0 = bid; t0 < 1408; t0 += 2 * nb) {
          f32x4 v[2][4]; bf16_t* dst[2]; int Kd[2]; const int nt = (t0 + nb < 1408) ? 2 : 1;
#pragma unroll
          for (int u = 0; u < 2; ++u) if (u < nt) { const int tile = t0 + u * nb; const float* src; size_t ld; const float* gain = nullptr; bool zero = false;
              if (tile < 896) { const int tr = tile >> 4, k0 = (tile & 15) * 64, rho0 = tr * 64; const int col0 = rho0 < 512 ? rho0 : rho0 - 96;
                  zero = (rho0 == 448) || (rho0 == 384 && r4 >= 32);
                  src = p.w_in + (size_t)k0 * ZC + col0 + r4; ld = ZC; gain = p.g_attn + k0; dst[u] = p.WinT + (size_t)rho0 * DM + k0; Kd[u] = DM; }
              else if (tile < 1152) { const int t2 = tile - 896, w = t2 >> 7, t3 = t2 & 127, n0 = (t3 >> 3) * 64, k0 = (t3 & 7) * 64;
                  src = (w ? p.w_o_sgu : p.w_o_attn) + (size_t)k0 * 1024 + n0 + r4; ld = 1024; dst[u] = (w ? p.WosT : p.WoaT) + (size_t)n0 * 512 + k0; Kd[u] = 512; }
              else { const int t2 = tile - 1152, n0 = (t2 >> 4) * 64, k0 = (t2 & 15) * 64; src = p.w_out + (size_t)k0 * 1024 + n0 + r4; ld = 1024; dst[u] = p.WoutT + (size_t)n0 * 1024 + k0; Kd[u] = 1024; }
#pragma unroll
              for (int i = 0; i < 4; ++i) { const int kk = kq + 16 * i; f32x4 x = zero ? (f32x4){0.f, 0.f, 0.f, 0.f} : *(const f32x4*)(src + (size_t)kk * ld); if (gain) x = x * gain[kk]; v[u][i] = x; } }
#pragma unroll
          for (int u = 0; u < 2; ++u) if (u < nt) {
#pragma unroll
              for (int i = 0; i < 4; ++i)
#pragma unroll
                  for (int j = 0; j < 4; ++j) sm[u * 4160 + (kq + 16 * i) * 65 + r4 + j] = v[u][i][j]; }
          __syncthreads();
#pragma unroll
          for (int u = 0; u < 2; ++u) if (u < nt) {
#pragma unroll
              for (int i = 0; i < 4; ++i) { const int rho = kq + 16 * i; const float* bb = sm + u * 4160 + r4 * 65 + rho;
                  uint2 o; o.x = pk2(bb[0], bb[65]); o.y = pk2(bb[130], bb[195]); *(uint2*)(dst[u] + (size_t)rho * Kd[u] + r4) = o; } }
          __syncthreads();
      } }
    int base = 0;
    const float qscale = 0.10206207261596575f * 1.4426950408889634f;
    base = tconv(p.WuqT, 768, 256, [&](int k, int rho) { int col;
        if (rho < 512) col = (rho >> 6) * 96 + (rho & 63); else { const int hh = (rho - 512) >> 5, w = (rho - 512) & 31; col = hh * 96 + 64 + (w >> 1) + 16 * (w & 1); }
        return p.w_uq[(size_t)k * 768 + col] * p.g_cq[k] * qscale; }, base, bid, nb, sm);
    base = tconv(p.WukT, 512, 128, [&](int k, int c) { return p.w_uk[(size_t)k * 512 + c] * p.g_ckv[k]; }, base, bid, nb, sm);
    base = tconv(p.WuvT, 512, 128, [&](int k, int c) { return p.w_uv[(size_t)k * 512 + c] * p.g_ckv[k]; }, base, bid, nb, sm);
    for (size_t i = gtid; i < (size_t)8 * 128 * 128; i += gsz) { const int j = (int)(i & 127), ii = (int)((i >> 7) & 127);
        p.Wsp[i] = ((j >> 6) <= (ii >> 6)) ? f2bf(p.w_sp[i]) : (bf16_t)0; }
}

__device__ __forceinline__ bool tile_of(int it, int bid, int nb, int RT, int CT, int& rt, int& ct) {
    if ((RT & 31) == 0 && (nb & 7) == 0) {
        const int x = bid & 7, l = bid >> 3, nl = nb >> 3, rpx = RT >> 3; const int lt = l + it * nl; if (lt >= rpx * CT) return false;
        const int rg = lt / (4 * CT), w = lt % (4 * CT); rt = x * rpx + rg * 4 + (w & 3); ct = w >> 2; return true;
    }
    const int tile = bid + it * nb; if (tile >= RT * CT) return false; rt = tile / CT; ct = tile % CT; return true;
}
struct GOps { const bf16_t* a0; const bf16_t* a1; const bf16_t* a2; const bf16_t* a3; const bf16_t* bp; size_t bstep; };
__device__ __forceinline__ GOps gops(const bf16_t* ap, size_t astep, const bf16_t* bp, size_t bstep) { GOps g; g.a0 = ap; g.a1 = ap + astep; g.a2 = ap + 2 * astep; g.a3 = ap + 3 * astep; g.bp = bp; g.bstep = bstep; return g; }
__device__ __forceinline__ void mg_stage(const GOps& g, int t, LAS unsigned char* lds, int widu) {
    LAS unsigned char* d = lds + (t & 1) * 32768 + widu * 1024; const int k0 = t * 64;
    __builtin_amdgcn_global_load_lds((const unsigned*)(g.a0 + k0), (LAS unsigned*)(d), 16, 0, 0);
    __builtin_amdgcn_global_load_lds((const unsigned*)(g.a1 + k0), (LAS unsigned*)(d + 4096), 16, 0, 0);
    __builtin_amdgcn_global_load_lds((const unsigned*)(g.a2 + k0), (LAS unsigned*)(d + 8192), 16, 0, 0);
    __builtin_amdgcn_global_load_lds((const unsigned*)(g.a3 + k0), (LAS unsigned*)(d + 12288), 16, 0, 0);
#pragma unroll
    for (int i = 0; i < 4; ++i) __builtin_amdgcn_global_load_lds((const unsigned*)(g.bp + i * g.bstep + k0), (LAS unsigned*)(d + 16384 + i * 4096), 16, 0, 0);
}
__device__ __forceinline__ void mg_kloop_p(f32x4 (&acc)[4][4], const GOps& g, int nk, LAS unsigned char* lds, bool prestaged, bool has_next, const GOps& nxt) {
    const int tid = opaque_tid(), lane = tid & 63, wid = tid >> 6, wr = wid >> 1, wc = wid & 1, fr = lane & 15, fq = lane >> 4;
    const int widu = __builtin_amdgcn_readfirstlane(wid);
    if (!prestaged) mg_stage(g, 0, lds, widu);
    const int pc0 = ((fq) ^ (fr & 7)) * 16, pc1 = ((4 + fq) ^ (fr & 7)) * 16;
    for (int t = 0; t < nk; ++t) {
        asm volatile("s_waitcnt vmcnt(0)" ::: "memory");
        __syncthreads();
        if (t + 1 < nk) mg_stage(g, t + 1, lds, widu); else if (has_next) mg_stage(nxt, 0, lds, widu);
        const LAS unsigned char* ab = lds + (t & 1) * 32768 + (wr * 64 + fr) * 128; const LAS unsigned char* bb = lds + (t & 1) * 32768 + 16384 + (wc * 64 + fr) * 128;
        bf16x8 af[2][4], bfr[2][4];
#pragma unroll
        for (int m = 0; m < 4; ++m) { af[0][m] = *(const LAS bf16x8*)(ab + m * 2048 + pc0); bfr[0][m] = *(const LAS bf16x8*)(bb + m * 2048 + pc0); }
#pragma unroll
        for (int m = 0; m < 4; ++m) { af[1][m] = *(const LAS bf16x8*)(ab + m * 2048 + pc1); bfr[1][m] = *(const LAS bf16x8*)(bb + m * 2048 + pc1); }
        __builtin_amdgcn_sched_barrier(0);
#pragma unroll
        for (int ks = 0; ks < 2; ++ks)
#pragma unroll
            for (int m = 0; m < 4; ++m)
#pragma unroll
                for (int n = 0; n < 4; ++n) acc[m][n] = __builtin_amdgcn_mfma_f32_16x16x32_bf16(bfr[ks][n], af[ks][m], acc[m][n], 0, 0, 0);
    }
}
template <class Epi>
__device__ __forceinline__ void mgemm(const bf16_t* A, int lda, const bf16_t* Bt, int ldb, int M, int N, int K, Epi epi, int bid, int nb, LAS unsigned char* lds) {
    const int tid = opaque_tid(), lane = tid & 63, wid = tid >> 6, wr = wid >> 1, wc = wid & 1, fr = lane & 15, fq = lane >> 4;
    const int RT = M / 128, CT = N / 128; const int c8 = ((tid & 7) ^ ((tid >> 3) & 7)) * 8;
    int rt, ct; bool have = tile_of(0, bid, nb, RT, CT, rt, ct);
    GOps cur = gops(A + (size_t)(rt * 128 + (tid >> 3)) * lda + c8, (size_t)32 * lda, Bt + (size_t)(ct * 128 + (tid >> 3)) * ldb + c8, (size_t)32 * ldb);
    for (int it = 0; have; ++it) {
        const int row0 = rt * 128, col0 = ct * 128;
        int rt2, ct2; const bool have2 = tile_of(it + 1, bid, nb, RT, CT, rt2, ct2);
        const GOps nxt = gops(A + (size_t)((have2 ? rt2 : rt) * 128 + (tid >> 3)) * lda + c8, (size_t)32 * lda, Bt + (size_t)((have2 ? ct2 : ct) * 128 + (tid >> 3)) * ldb + c8, (size_t)32 * ldb);
        f32x4 acc[4][4];
#pragma unroll
        for (int m = 0; m < 4; ++m)
#pragma unroll
            for (int n = 0; n < 4; ++n) acc[m][n] = (f32x4){0.f, 0.f, 0.f, 0.f};
        mg_kloop_p(acc, cur, K / 64, lds, it > 0, have2, nxt);
#pragma unroll
        for (int m = 0; m < 4; ++m)
#pragma unroll
            for (int n = 0; n < 4; ++n) epi(row0 + wr * 64 + m * 16 + fr, col0 + wc * 64 + n * 16 + fq * 4, acc[m][n]);
        cur = nxt; rt = rt2; ct = ct2; have = have2;
    }
    __syncthreads();
}


__device__ __forceinline__ void stg_put(LAS unsigned char* S, int r, int c4, const uint2 v) { const u32x2 w = {v.x, v.y};
    *(LAS u32x2*)(S + r * 256 + (((c4 >> 3) ^ (r & 15)) << 4) + ((c4 & 4) << 1)) = w; }
__device__ __forceinline__ void stg_put32(LAS unsigned char* S, int r, int c2, const unsigned v) {
    *(LAS unsigned*)(S + r * 256 + (((c2 >> 3) ^ (r & 15)) << 4) + ((c2 & 7) << 1)) = v; }
template <int SEG, class D>
__device__ __forceinline__ void stg_flush(LAS unsigned char* S, D dst) {
    const int tid = threadIdx.x, lane = tid & 63, wid = tid >> 6;
#pragma unroll
    for (int it = 0; it < 8; ++it) { const int r = wid * 32 + it * 4 + (lane >> 4), cc = lane & 15;
        const u32x4 v = *(const LAS u32x4*)(S + r * 256 + ((cc ^ (r & 15)) << 4));
        bf16_t* d = dst(r, cc / (SEG / 8));
        if (d) *(u32x4*)(d + (cc % (SEG / 8)) * 8) = v; }
}
template <int SEG, class Val, class Dst>
__device__ __forceinline__ void mgemm_st(const bf16_t* A, int lda, const bf16_t* Bt, int ldb, int M, int N, int K, Val val, Dst dst, int bid, int nb, LAS unsigned char* lds) {
    const int tid = opaque_tid(), lane = tid & 63, wid = tid >> 6, wr = wid >> 1, wc = wid & 1, fr = lane & 15, fq = lane >> 4;
    const int RT = M / 128, CT = N / 128; const int c8 = ((tid & 7) ^ ((tid >> 3) & 7)) * 8;
    LAS unsigned char* S = lds + 32768;
    int rt, ct; bool have = tile_of(0, bid, nb, RT, CT, rt, ct);
    GOps cur = gops(A + (size_t)(rt * 128 + (tid >> 3)) * lda + c8, (size_t)32 * lda, Bt + (size_t)(ct * 128 + (tid >> 3)) * ldb + c8, (size_t)32 * ldb);
    for (int it = 0; have; ++it) {
        const int row0 = rt * 128, col0 = ct * 128;
        int rt2, ct2; const bool have2 = tile_of(it + 1, bid, nb, RT, CT, rt2, ct2);
        const GOps nxt = gops(A + (size_t)((have2 ? rt2 : rt) * 128 + (tid >> 3)) * lda + c8, (size_t)32 * lda, Bt + (size_t)((have2 ? ct2 : ct) * 128 + (tid >> 3)) * ldb + c8, (size_t)32 * ldb);
        f32x4 acc[4][4];
#pragma unroll
        for (int m = 0; m < 4; ++m)
#pragma unroll
            for (int n = 0; n < 4; ++n) acc[m][n] = (f32x4){0.f, 0.f, 0.f, 0.f};
        mg_kloop_p(acc, cur, K / 64, lds, it > 0, have2, nxt);
        __syncthreads();
#pragma unroll
        for (int m = 0; m < 4; ++m)
#pragma unroll
            for (int n = 0; n < 4; ++n) { const int r = wr * 64 + m * 16 + fr, c = wc * 64 + n * 16 + fq * 4; stg_put(S, r, c, val(row0 + r, col0 + c, acc[m][n])); }
        __syncthreads();
        stg_flush<SEG>(S, [&](int r, int seg) __attribute__((always_inline)) { return dst(row0, col0, r, seg); });
        cur = nxt; rt = rt2; ct = ct2; have = have2;
    }
    __syncthreads();
}

__device__ __forceinline__ void phase1(const P& p, int bid, int nb, LAS unsigned char* sm) {
    bf16_t* zs = (bf16_t*)p.slotB; bf16_t* uvg = p.slotC; bf16_t* gates = p.slotD;
    mgemm_st<128>(p.slotA, DM, p.WinT, DM, NT, ZP, DM, [=](int t, int c, const f32x4& v) { uint2 o;
        if (c < 512) { o.x = pk2(v[0], v[1]); o.y = pk2(v[2], v[3]); }
        else if (c < 1536) { o.x = pk2(fgelu(v[0]), fgelu(v[1])); o.y = pk2(fgelu(v[2]), fgelu(v[3])); }
        else { o.x = pk2(fsigmoid(v[0]), fsigmoid(v[1])); o.y = pk2(fsigmoid(v[2]), fsigmoid(v[3])); }
        return o;
    }, [=](int row0, int col0, int r, int) -> bf16_t* { const size_t t = (size_t)(row0 + r);
        if (col0 < 512) return zs + t * 512 + col0; if (col0 < 1536) return uvg + t * 1024 + (col0 - 512); return gates + t * 2048 + (col0 - 1536);
    }, bid, nb, sm);
}

__device__ __forceinline__ void phase2a(const P& p, int bid, int nb, bool dry) {
    const int tid = opaque_tid(), lane = tid & 63, wid = tid >> 6;
    const bf16_t* zs = (const bf16_t*)p.slotB; bf16_t* K = p.slotE; bf16_t* uvg = p.slotC;
    const f32x4 gn0 = *(const f32x4*)(p.sgu_gain + lane * 8), gn1 = *(const f32x4*)(p.sgu_gain + lane * 8 + 4);
    const f32x4 bs0 = *(const f32x4*)(p.sgu_bias + lane * 8), bs1 = *(const f32x4*)(p.sgu_bias + lane * 8 + 4);
    const int hd = lane >> 3, j = lane & 7, i4 = 4 * (j & 3);
    struct In { uint2 cq, ck, k1, k2; uint4 v; int pos; };
    auto ld = [&](int t) __attribute__((always_inline)) { In r; const bf16_t* z = zs + (size_t)t * 512;
        r.cq = *(const uint2*)(z + lane * 4); r.ck = *(const uint2*)(z + 256 + (lane & 31) * 4); r.k1 = *(const uint2*)(z + 384 + i4); r.k2 = *(const uint2*)(z + 400 + i4);
        r.v = *(const uint4*)(uvg + (size_t)t * 1024 + 512 + lane * 8); r.pos = p.pos[t]; return r; };
    int t = bid * 4 + wid; In cur; if (t < NT) cur = ld(t);
    for (; t < NT; t += nb * 4) {
        const int tn = t + nb * 4; In nxt = cur; if (tn < NT) nxt = ld(tn);
        const f32x4 cq = bf4(cur.cq), ck = bf4(cur.ck);
        bf16_t* vr = uvg + (size_t)t * 1024 + 512 + lane * 8;
        { const float ss = wsumf(cq[0] * cq[0] + cq[1] * cq[1] + cq[2] * cq[2] + cq[3] * cq[3]); const float r = rsqrtf(ss * (1.f / 256.f) + EPS);
          uint2 o; o.x = pk2(cq[0] * r, cq[1] * r); o.y = pk2(cq[2] * r, cq[3] * r); *(uint2*)(p.cqn + (size_t)t * 256 + lane * 4) = o; }
        { const float ss = wsumf(lane < 32 ? ck[0] * ck[0] + ck[1] * ck[1] + ck[2] * ck[2] + ck[3] * ck[3] : 0.f); const float r = rsqrtf(ss * (1.f / 128.f) + EPS);
          if (lane < 32) { uint2 o; o.x = pk2(ck[0] * r, ck[1] * r); o.y = pk2(ck[2] * r, ck[3] * r); *(uint2*)(p.ckvn + (size_t)t * 128 + lane * 4) = o; } }
        { const int b = t >> 13, sq = t & 8191; const float posf = (float)cur.pos; const f32x4 k1 = bf4(cur.k1), k2 = bf4(cur.k2); float val[4], tab[4];
#pragma unroll
          for (int q = 0; q < 4; ++q) { const int i = i4 + q;
              float f = q == 0 ? 1.0f : q == 1 ? 0.5623413251903491f : q == 2 ? 0.31622776601683794f : 0.1778279410038923f;
              const int q4 = i >> 2; f *= (q4 == 0 ? 1.0f : q4 == 1 ? 0.1f : q4 == 2 ? 0.01f : 0.001f);
              const float ang = posf * f; const double rev = (double)ang * 0.15915494309189535; const float frc = (float)(rev - floor(rev));
              const float sn = __builtin_amdgcn_sinf(frc), cn = __builtin_amdgcn_cosf(frc);
              val[q] = (j < 4) ? (k1[q] * cn - k2[q] * sn) : (k1[q] * sn + k2[q] * cn); tab[q] = (j < 4) ? cn : sn; }
          uint2 o; o.x = pk2(val[0], val[1]); o.y = pk2(val[2], val[3]);
          *(uint2*)(K + ((size_t)(b * NH + hd) * SEQ + sq) * 96 + 64 + 4 * j) = o;
          if (hd == 0) *(f32x4*)(p.cs + (size_t)t * 32 + 4 * j) = (f32x4){tab[0], tab[1], tab[2], tab[3]}; }
        { float v[8]; const unsigned w[4] = {cur.v.x, cur.v.y, cur.v.z, cur.v.w};
#pragma unroll
          for (int i = 0; i < 4; ++i) { v[2 * i] = __uint_as_float(w[i] << 16); v[2 * i + 1] = __uint_as_float(w[i] & 0xffff0000u); }
          float sm_ = 0.f;
#pragma unroll
          for (int i = 0; i < 8; ++i) sm_ += v[i];
          sm_ = wsumf(sm_); const float mu = sm_ * (1.f / 512.f); float q = 0.f;
#pragma unroll
          for (int i = 0; i < 8; ++i) { const float d = v[i] - mu; q += d * d; }
          q = wsumf(q); const float r = rsqrtf(q * (1.f / 512.f) + EPS);
          uint4 o;
          o.x = pk2((v[0] - mu) * r * gn0[0] + bs0[0], (v[1] - mu) * r * gn0[1] + bs0[1]); o.y = pk2((v[2] - mu) * r * gn0[2] + bs0[2], (v[3] - mu) * r * gn0[3] + bs0[3]);
          o.z = pk2((v[4] - mu) * r * gn1[0] + bs1[0], (v[5] - mu) * r * gn1[1] + bs1[1]); o.w = pk2((v[6] - mu) * r * gn1[2] + bs1[2], (v[7] - mu) * r * gn1[3] + bs1[3]);
          *(uint4*)(dry ? p.slotG + (size_t)t * 512 + lane * 8 : vr) = o; }
        cur = nxt;
    }
}

__device__ __forceinline__ void phase2b(const P& p, int bid, int nb, LAS unsigned char* sm) {
    bf16_t* Q = p.slotA; bf16_t* K = p.slotE; bf16_t* VT = p.slotF; const float* cs = p.cs;
    mgemm(p.cqn, 256, p.WuqT, 256, NT, 768, 256, [=](int t, int c, const f32x4& v) {
        const int b = t >> 13, s = t & 8191;
        if (c < 512) { const int h = c >> 6, d = c & 63; uint2 o; o.x = pk2(v[0], v[1]); o.y = pk2(v[2], v[3]); *(uint2*)(Q + ((size_t)(b * NH + h) * SEQ + s) * 96 + d) = o; }
        else { const int h = (c - 512) >> 5, i0 = ((c - 512) & 31) >> 1; bf16_t* q = Q + ((size_t)(b * NH + h) * SEQ + s) * 96;
            const float2 cn = *(const float2*)(cs + (size_t)t * 32 + i0), sn = *(const float2*)(cs + (size_t)t * 32 + 16 + i0);
            *(unsigned*)(q + 64 + i0) = pk2(v[0] * cn.x - v[1] * sn.x, v[2] * cn.y - v[3] * sn.y);
            *(unsigned*)(q + 80 + i0) = pk2(v[0] * sn.x + v[1] * cn.x, v[2] * sn.y + v[3] * cn.y); }
    }, bid, nb, sm);
    mgemm_st<64>(p.ckvn, 128, p.WukT, 128, NT, 512, 128, [=](int, int, const f32x4& v) { uint2 o; o.x = pk2(v[0], v[1]); o.y = pk2(v[2], v[3]); return o; },
        [=](int row0, int col0, int r, int seg) -> bf16_t* { const int t = row0 + r, b = t >> 13, s = t & 8191, h = (col0 >> 6) + seg; return K + ((size_t)(b * NH + h) * SEQ + s) * 96; }, bid, nb, sm);
    mgemm_st<128>(p.WuvT, 128, p.ckvn, 128, 512, NT, 128, [=](int, int, const f32x4& v) { uint2 o; o.x = pk2(v[0], v[1]); o.y = pk2(v[2], v[3]); return o; },
        [=](int row0, int col0, int r, int) -> bf16_t* { return VT + (size_t)(row0 + r) * NT + col0; }, bid, nb, sm);
}

__device__ __forceinline__ void phase2c_m(const P& p, int bid, int nb, LAS unsigned char* lds) {
    const bf16_t* uvg = p.slotC; bf16_t* su = p.slotG;
    const int tid = opaque_tid(), lane = tid & 63, wid = tid >> 6, fr = lane & 15, fq = lane >> 4;
    const int c8 = ((tid & 7) ^ ((tid >> 3) & 7)) * 8;
    for (int u = bid; u < 1024; u += nb) {
        const int g = u & 7, t0 = (u >> 3) * 128;
        { const bf16_t* wp = p.Wsp + ((size_t)g * 128 + (tid >> 3)) * 128 + c8; LAS unsigned char* d = lds + tid * 16;
#pragma unroll
          for (int ks = 0; ks < 2; ++ks)
#pragma unroll
              for (int i = 0; i < 4; ++i) __builtin_amdgcn_global_load_lds((const unsigned*)(wp + (size_t)i * 32 * 128 + ks * 64), (LAS unsigned*)(d + ks * 16384 + i * 4096), 16, 0, 0); }
#pragma unroll
        for (int i = 0; i < 4; ++i) { const int q = tid + 256 * i, j = q >> 3, c0 = (q & 7) * 8;
            const uint4 v = *(const uint4*)(uvg + (size_t)(t0 + j) * 1024 + 512 + g * 64 + c0);
            const unsigned w[4] = {v.x, v.y, v.z, v.w};
            LAS unsigned char* bimg = lds + 32768 + (j >> 6) * 8192 + (j & 7) * 2; const int lc = (j & 63) >> 3;
#pragma unroll
            for (int e = 0; e < 8; ++e) { const int row = c0 + e; const bf16_t val = (bf16_t)((e & 1) ? (w[e >> 1] >> 16) : (w[e >> 1] & 0xffffu));
                *(LAS bf16_t*)(bimg + row * 128 + ((lc ^ (row & 7)) * 16)) = val; } }
        asm volatile("s_waitcnt vmcnt(0)" ::: "memory");
        __syncthreads();
        f32x4 acc[2][4];
#pragma unroll
        for (int m = 0; m < 2; ++m)
#pragma unroll
            for (int n = 0; n < 4; ++n) acc[m][n] = (f32x4){0.f, 0.f, 0.f, 0.f};
#pragma unroll
        for (int ks = 0; ks < 2; ++ks)
#pragma unroll
            for (int k2 = 0; k2 < 2; ++k2) { const int pc = ((k2 * 4 + fq) ^ (fr & 7)) * 16; bf16x8 af[2], bfr[4];
#pragma unroll
                for (int m = 0; m < 2; ++m) af[m] = *(const LAS bf16x8*)(lds + ks * 16384 + (wid * 32 + m * 16 + fr) * 128 + pc);
#pragma unroll
                for (int n = 0; n < 4; ++n) bfr[n] = *(const LAS bf16x8*)(lds + 32768 + ks * 8192 + (n * 16 + fr) * 128 + pc);
#pragma unroll
                for (int m = 0; m < 2; ++m)
#pragma unroll
                    for (int n = 0; n < 4; ++n) acc[m][n] = __builtin_amdgcn_mfma_f32_16x16x32_bf16(bfr[n], af[m], acc[m][n], 0, 0, 0); }
#pragma unroll
        for (int m = 0; m < 2; ++m) { const int i = wid * 32 + m * 16 + fr; const float bs = p.b_sp[g * 128 + i];
#pragma unroll
            for (int n = 0; n < 4; ++n) { const int c = g * 64 + n * 16 + fq * 4;
                const uint2 uu = *(const uint2*)(uvg + (size_t)(t0 + i) * 1024 + c);
                uint2 o; o.x = pk2(__uint_as_float(uu.x << 16) * (acc[m][n][0] + bs), __uint_as_float(uu.x & 0xffff0000u) * (acc[m][n][1] + bs));
                o.y = pk2(__uint_as_float(uu.y << 16) * (acc[m][n][2] + bs), __uint_as_float(uu.y & 0xffff0000u) * (acc[m][n][3] + bs));
                *(uint2*)(su + (size_t)(t0 + i) * 512 + c) = o; } }
        __syncthreads();
    }
}

template <int VAR>
__device__ __forceinline__ void att_step(const LAS unsigned char* kb_, const LAS unsigned char* vb_, const int kt16, const int k4o, const int k5o, const int vsw, const bf16x8 (&qf)[6],
                                         f32x16& c0, f32x16& c1, f32x16& n0, f32x16& n1, const unsigned (&pwc)[16], unsigned (&pwn)[16], f32x16& o0, f32x16& o1,
                                         const f32x16& negm, float& ps, float& mxn) {
    f32x16 zero16;
#pragma unroll
    for (int e = 0; e < 16; ++e) zero16[e] = 0.f;
    if constexpr (VAR == 0) {
        bf16x8 kf0, kf1, kf2;
        kf0 = *(const LAS bf16x8*)(kb_ + 0*32*192 + kt16 + 0); kf1 = *(const LAS bf16x8*)(kb_ + 1*32*192 + kt16 + 0);
        float mxl;
        kf2 = *(const LAS bf16x8*)(kb_ + 0*32*192 + kt16 + 32);
        n0 = __builtin_amdgcn_mfma_f32_32x32x16_bf16(kf0, qf[0], negm, 0, 0, 0);
        c0[0] = __builtin_amdgcn_exp2f(c0[0]); ps += c0[0]; c0[1] = __builtin_amdgcn_exp2f(c0[1]); ps += c0[1]; pwn[0] = pk2(c0[0], c0[1]);
        __builtin_amdgcn_sched_barrier(0);
        kf0 = *(const LAS bf16x8*)(kb_ + 1*32*192 + kt16 + 32);
        n1 = __builtin_amdgcn_mfma_f32_32x32x16_bf16(kf1, qf[0], negm, 0, 0, 0);
        c0[2] = __builtin_amdgcn_exp2f(c0[2]); ps += c0[2]; c0[3] = __builtin_amdgcn_exp2f(c0[3]); ps += c0[3]; pwn[1] = pk2(c0[2], c0[3]);
        __builtin_amdgcn_sched_barrier(0);
        kf1 = *(const LAS bf16x8*)(kb_ + 0*32*192 + kt16 + 64);
        n0 = __builtin_amdgcn_mfma_f32_32x32x16_bf16(kf2, qf[1], n0, 0, 0, 0);
        c0[4] = __builtin_amdgcn_exp2f(c0[4]); ps += c0[4]; c0[5] = __builtin_amdgcn_exp2f(c0[5]); ps += c0[5]; pwn[2] = pk2(c0[4], c0[5]);
        __builtin_amdgcn_sched_barrier(0);
        kf2 = *(const LAS bf16x8*)(kb_ + 1*32*192 + kt16 + 64);
        n1 = __builtin_amdgcn_mfma_f32_32x32x16_bf16(kf0, qf[1], n1, 0, 0, 0);
        c0[6] = __builtin_amdgcn_exp2f(c0[6]); ps += c0[6]; c0[7] = __builtin_amdgcn_exp2f(c0[7]); ps += c0[7]; pwn[3] = pk2(c0[6], c0[7]);
        __builtin_amdgcn_sched_barrier(0);
        kf0 = *(const LAS bf16x8*)(kb_ + 0*32*192 + kt16 + 96);
        n0 = __builtin_amdgcn_mfma_f32_32x32x16_bf16(kf1, qf[2], n0, 0, 0, 0);
        c0[8] = __builtin_amdgcn_exp2f(c0[8]); ps += c0[8]; c0[9] = __builtin_amdgcn_exp2f(c0[9]); ps += c0[9]; pwn[4] = pk2(c0[8], c0[9]);
        __builtin_amdgcn_sched_barrier(0);
        kf1 = *(const LAS bf16x8*)(kb_ + 1*32*192 + kt16 + 96);
        n1 = __builtin_amdgcn_mfma_f32_32x32x16_bf16(kf2, qf[2], n1, 0, 0, 0);
        c0[10] = __builtin_amdgcn_exp2f(c0[10]); ps += c0[10]; c0[11] = __builtin_amdgcn_exp2f(c0[11]); ps += c0[11]; pwn[5] = pk2(c0[10], c0[11]);
        __builtin_amdgcn_sched_barrier(0);
        kf2 = *(const LAS bf16x8*)(kb_ + 0*32*192 + k4o);
        n0 = __builtin_amdgcn_mfma_f32_32x32x16_bf16(kf0, qf[3], n0, 0, 0, 0);
        c0[12] = __builtin_amdgcn_exp2f(c0[12]); ps += c0[12]; c0[13] = __builtin_amdgcn_exp2f(c0[13]); ps += c0[13]; pwn[6] = pk2(c0[12], c0[13]);
        __builtin_amdgcn_sched_barrier(0);
        kf0 = *(const LAS bf16x8*)(kb_ + 1*32*192 + k4o);
        n1 = __builtin_amdgcn_mfma_f32_32x32x16_bf16(kf1, qf[3], n1, 0, 0, 0);
        c0[14] = __builtin_amdgcn_exp2f(c0[14]); ps += c0[14]; c0[15] = __builtin_amdgcn_exp2f(c0[15]); ps += c0[15]; pwn[7] = pk2(c0[14], c0[15]);
        __builtin_amdgcn_sched_barrier(0);
        kf1 = *(const LAS bf16x8*)(kb_ + 0*32*192 + k5o);
        n0 = __builtin_amdgcn_mfma_f32_32x32x16_bf16(kf2, qf[4], n0, 0, 0, 0);
        c1[0] = __builtin_amdgcn_exp2f(c1[0]); ps += c1[0]; c1[1] = __builtin_amdgcn_exp2f(c1[1]); ps += c1[1]; pwn[8] = pk2(c1[0], c1[1]);
        __builtin_amdgcn_sched_barrier(0);
        kf2 = *(const LAS bf16x8*)(kb_ + 1*32*192 + k5o);
        n1 = __builtin_amdgcn_mfma_f32_32x32x16_bf16(kf0, qf[4], n1, 0, 0, 0);
        c1[2] = __builtin_amdgcn_exp2f(c1[2]); ps += c1[2]; c1[3] = __builtin_amdgcn_exp2f(c1[3]); ps += c1[3]; pwn[9] = pk2(c1[2], c1[3]);
        __builtin_amdgcn_sched_barrier(0);
        n0 = __builtin_amdgcn_mfma_f32_32x32x16_bf16(kf1, qf[5], n0, 0, 0, 0);
        c1[4] = __builtin_amdgcn_exp2f(c1[4]); ps += c1[4]; c1[5] = __builtin_amdgcn_exp2f(c1[5]); ps += c1[5]; pwn[10] = pk2(c1[4], c1[5]);
        __builtin_amdgcn_sched_barrier(0);
        n1 = __builtin_amdgcn_mfma_f32_32x32x16_bf16(kf2, qf[5], n1, 0, 0, 0);
        c1[6] = __builtin_amdgcn_exp2f(c1[6]); ps += c1[6]; c1[7] = __builtin_amdgcn_exp2f(c1[7]); ps += c1[7]; pwn[11] = pk2(c1[6], c1[7]);
        __builtin_amdgcn_sched_barrier(0);
        c1[8] = __builtin_amdgcn_exp2f(c1[8]); ps += c1[8]; c1[9] = __builtin_amdgcn_exp2f(c1[9]); ps += c1[9]; pwn[12] = pk2(c1[8], c1[9]);
        __builtin_amdgcn_sched_barrier(0);
        c1[10] = __builtin_amdgcn_exp2f(c1[10]); ps += c1[10]; c1[11] = __builtin_amdgcn_exp2f(c1[11]); ps += c1[11]; pwn[13] = pk2(c1[10], c1[11]);
        __builtin_amdgcn_sched_barrier(0);
        c1[12] = __builtin_amdgcn_exp2f(c1[12]); ps += c1[12]; c1[13] = __builtin_amdgcn_exp2f(c1[13]); ps += c1[13]; pwn[14] = pk2(c1[12], c1[13]);
        __builtin_amdgcn_sched_barrier(0);
        c1[14] = __builtin_amdgcn_exp2f(c1[14]); ps += c1[14]; c1[15] = __builtin_amdgcn_exp2f(c1[15]); ps += c1[15]; pwn[15] = pk2(c1[14], c1[15]);
        __builtin_amdgcn_sched_barrier(0);
        mxl = fmaxf(n0[0], n1[0]); mxl = fmaxf(fmaxf(mxl, n0[1]), n1[1]); mxl = fmaxf(fmaxf(mxl, n0[2]), n1[2]); mxl = fmaxf(fmaxf(mxl, n0[3]), n1[3]);
        __builtin_amdgcn_sched_barrier(0);
        mxl = fmaxf(fmaxf(mxl, n0[4]), n1[4]); mxl = fmaxf(fmaxf(mxl, n0[5]), n1[5]); mxl = fmaxf(fmaxf(mxl, n0[6]), n1[6]); mxl = fmaxf(fmaxf(mxl, n0[7]), n1[7]);
        __builtin_amdgcn_sched_barrier(0);
        mxl = fmaxf(fmaxf(mxl, n0[8]), n1[8]); mxl = fmaxf(fmaxf(mxl, n0[9]), n1[9]); mxl = fmaxf(fmaxf(mxl, n0[10]), n1[10]); mxl = fmaxf(fmaxf(mxl, n0[11]), n1[11]);
        __builtin_amdgcn_sched_barrier(0);
        mxl = fmaxf(fmaxf(mxl, n0[12]), n1[12]); mxl = fmaxf(fmaxf(mxl, n0[13]), n1[13]); mxl = fmaxf(fmaxf(mxl, n0[14]), n1[14]); mxl = fmaxf(fmaxf(mxl, n0[15]), n1[15]);
        __builtin_amdgcn_sched_barrier(0);
        mxn = fmaxf(mxl, __shfl_xor(mxl, 32));
    } else if constexpr (VAR == 1) {
        bf16x8 kf0, kf1, kf2;
        kf0 = *(const LAS bf16x8*)(kb_ + 0*32*192 + kt16 + 0); kf1 = *(const LAS bf16x8*)(kb_ + 1*32*192 + kt16 + 0);
        u32x2 vf0a, vf0b, vf1a, vf1b, vf2a, vf2b;
        float mxl;
        kf2 = *(const LAS bf16x8*)(kb_ + 0*32*192 + kt16 + 32);
        n0 = __builtin_amdgcn_mfma_f32_32x32x16_bf16(kf0, qf[0], negm, 0, 0, 0);
        c0[0] = __builtin_amdgcn_exp2f(c0[0]); ps += c0[0]; c0[1] = __builtin_amdgcn_exp2f(c0[1]); ps += c0[1]; pwn[0] = pk2(c0[0], c0[1]);
        __builtin_amdgcn_sched_barrier(0);
        kf0 = *(const LAS bf16x8*)(kb_ + 1*32*192 + kt16 + 32);
        n1 = __builtin_amdgcn_mfma_f32_32x32x16_bf16(kf1, qf[0], negm, 0, 0, 0);
        c0[2] = __builtin_amdgcn_exp2f(c0[2]); ps += c0[2]; c0[3] = __builtin_amdgcn_exp2f(c0[3]); ps += c0[3]; pwn[1] = pk2(c0[2], c0[3]);
        __builtin_amdgcn_sched_barrier(0);
        kf1 = *(const LAS bf16x8*)(kb_ + 0*32*192 + kt16 + 64);
        n0 = __builtin_amdgcn_mfma_f32_32x32x16_bf16(kf2, qf[1], n0, 0, 0, 0);
        c0[4] = __builtin_amdgcn_exp2f(c0[4]); ps += c0[4]; c0[5] = __builtin_amdgcn_exp2f(c0[5]); ps += c0[5]; pwn[2] = pk2(c0[4], c0[5]);
        __builtin_amdgcn_sched_barrier(0);
        kf2 = *(const LAS bf16x8*)(kb_ + 1*32*192 + kt16 + 64);
        n1 = __builtin_amdgcn_mfma_f32_32x32x16_bf16(kf0, qf[1], n1, 0, 0, 0);
        c0[6] = __builtin_amdgcn_exp2f(c0[6]); ps += c0[6]; c0[7] = __builtin_amdgcn_exp2f(c0[7]); ps += c0[7]; pwn[3] = pk2(c0[6], c0[7]);
        __builtin_amdgcn_sched_barrier(0);
        kf0 = *(const LAS bf16x8*)(kb_ + 0*32*192 + kt16 + 96);
        n0 = __builtin_amdgcn_mfma_f32_32x32x16_bf16(kf1, qf[2], n0, 0, 0, 0);
        c0[8] = __builtin_amdgcn_exp2f(c0[8]); ps += c0[8]; c0[9] = __builtin_amdgcn_exp2f(c0[9]); ps += c0[9]; pwn[4] = pk2(c0[8], c0[9]);
        __builtin_amdgcn_sched_barrier(0);
        kf1 = *(const LAS bf16x8*)(kb_ + 1*32*192 + kt16 + 96);
        n1 = __builtin_amdgcn_mfma_f32_32x32x16_bf16(kf2, qf[2], n1, 0, 0, 0);
        c0[10] = __builtin_amdgcn_exp2f(c0[10]); ps += c0[10]; c0[11] = __builtin_amdgcn_exp2f(c0[11]); ps += c0[11]; pwn[5] = pk2(c0[10], c0[11]);
        __builtin_amdgcn_sched_barrier(0);
        kf2 = *(const LAS bf16x8*)(kb_ + 0*32*192 + k4o);
        n0 = __builtin_amdgcn_mfma_f32_32x32x16_bf16(kf0, qf[3], n0, 0, 0, 0);
        c0[12] = __builtin_amdgcn_exp2f(c0[12]); ps += c0[12]; c0[13] = __builtin_amdgcn_exp2f(c0[13]); ps += c0[13]; pwn[6] = pk2(c0[12], c0[13]);
        __builtin_amdgcn_sched_barrier(0);
        kf0 = *(const LAS bf16x8*)(kb_ + 1*32*192 + k4o);
        n1 = __builtin_amdgcn_mfma_f32_32x32x16_bf16(kf1, qf[3], n1, 0, 0, 0);
        c0[14] = __builtin_amdgcn_exp2f(c0[14]); ps += c0[14]; c0[15] = __builtin_amdgcn_exp2f(c0[15]); ps += c0[15]; pwn[7] = pk2(c0[14], c0[15]);
        __builtin_amdgcn_sched_barrier(0);
        kf1 = *(const LAS bf16x8*)(kb_ + 0*32*192 + k5o);
        n0 = __builtin_amdgcn_mfma_f32_32x32x16_bf16(kf2, qf[4], n0, 0, 0, 0);
        c1[0] = __builtin_amdgcn_exp2f(c1[0]); ps += c1[0]; c1[1] = __builtin_amdgcn_exp2f(c1[1]); ps += c1[1]; pwn[8] = pk2(c1[0], c1[1]);
        __builtin_amdgcn_sched_barrier(0);
        kf2 = *(const LAS bf16x8*)(kb_ + 1*32*192 + k5o);
        n1 = __builtin_amdgcn_mfma_f32_32x32x16_bf16(kf0, qf[4], n1, 0, 0, 0);
        c1[2] = __builtin_amdgcn_exp2f(c1[2]); ps += c1[2]; c1[3] = __builtin_amdgcn_exp2f(c1[3]); ps += c1[3]; pwn[9] = pk2(c1[2], c1[3]);
        __builtin_amdgcn_sched_barrier(0);
        vf0a = *(const LAS u32x2*)(vb_ + ((0) ^ vsw) * 16); vf0b = *(const LAS u32x2*)(vb_ + ((1) ^ vsw) * 16);
        n0 = __builtin_amdgcn_mfma_f32_32x32x16_bf16(kf1, qf[5], n0, 0, 0, 0);
        c1[4] = __builtin_amdgcn_exp2f(c1[4]); ps += c1[4]; c1[5] = __builtin_amdgcn_exp2f(c1[5]); ps += c1[5]; pwn[10] = pk2(c1[4], c1[5]);
        __builtin_amdgcn_sched_barrier(0);
        vf1a = *(const LAS u32x2*)(vb_ + 32 * 128 + ((0) ^ vsw) * 16); vf1b = *(const LAS u32x2*)(vb_ + 32 * 128 + ((1) ^ vsw) * 16);
        n1 = __builtin_amdgcn_mfma_f32_32x32x16_bf16(kf2, qf[5], n1, 0, 0, 0);
        c1[6] = __builtin_amdgcn_exp2f(c1[6]); ps += c1[6]; c1[7] = __builtin_amdgcn_exp2f(c1[7]); ps += c1[7]; pwn[11] = pk2(c1[6], c1[7]);
        __builtin_amdgcn_sched_barrier(0);
        vf2a = *(const LAS u32x2*)(vb_ + ((2) ^ vsw) * 16); vf2b = *(const LAS u32x2*)(vb_ + ((3) ^ vsw) * 16);
        { const u32x4 pbu = {pwc[0], pwc[1], pwc[2], pwc[3]}; const u32x4 vv = {vf0a.x, vf0a.y, vf0b.x, vf0b.y};
          o0 = __builtin_amdgcn_mfma_f32_32x32x16_bf16(__builtin_bit_cast(bf16x8, vv), __builtin_bit_cast(bf16x8, pbu), o0, 0, 0, 0); }
        c1[8] = __builtin_amdgcn_exp2f(c1[8]); ps += c1[8]; c1[9] = __builtin_amdgcn_exp2f(c1[9]); ps += c1[9]; pwn[12] = pk2(c1[8], c1[9]);
        __builtin_amdgcn_sched_barrier(0);
        vf0a = *(const LAS u32x2*)(vb_ + 32 * 128 + ((2) ^ vsw) * 16); vf0b = *(const LAS u32x2*)(vb_ + 32 * 128 + ((3) ^ vsw) * 16);
        { const u32x4 pbu = {pwc[0], pwc[1], pwc[2], pwc[3]}; const u32x4 vv = {vf1a.x, vf1a.y, vf1b.x, vf1b.y};
          o1 = __builtin_amdgcn_mfma_f32_32x32x16_bf16(__builtin_bit_cast(bf16x8, vv), __builtin_bit_cast(bf16x8, pbu), o1, 0, 0, 0); }
        c1[10] = __builtin_amdgcn_exp2f(c1[10]); ps += c1[10]; c1[11] = __builtin_amdgcn_exp2f(c1[11]); ps += c1[11]; pwn[13] = pk2(c1[10], c1[11]);
        __builtin_amdgcn_sched_barrier(0);
        vf1a = *(const LAS u32x2*)(vb_ + ((4) ^ vsw) * 16); vf1b = *(const LAS u32x2*)(vb_ + ((5) ^ vsw) * 16);
        { const u32x4 pbu = {pwc[4], pwc[5], pwc[6], pwc[7]}; const u32x4 vv = {vf2a.x, vf2a.y, vf2b.x, vf2b.y};
          o0 = __builtin_amdgcn_mfma_f32_32x32x16_bf16(__builtin_bit_cast(bf16x8, vv), __builtin_bit_cast(bf16x8, pbu), o0, 0, 0, 0); }
        c1[12] = __builtin_amdgcn_exp2f(c1[12]); ps += c1[12]; c1[13] = __builtin_amdgcn_exp2f(c1[13]); ps += c1[13]; pwn[14] = pk2(c1[12], c1[13]);
        __builtin_amdgcn_sched_barrier(0);
        vf2a = *(const LAS u32x2*)(vb_ + 32 * 128 + ((4) ^ vsw) * 16); vf2b = *(const LAS u32x2*)(vb_ + 32 * 128 + ((5) ^ vsw) * 16);
        { const u32x4 pbu = {pwc[4], pwc[5], pwc[6], pwc[7]}; const u32x4 vv = {vf0a.x, vf0a.y, vf0b.x, vf0b.y};
          o1 = __builtin_amdgcn_mfma_f32_32x32x16_bf16(__builtin_bit_cast(bf16x8, vv), __builtin_bit_cast(bf16x8, pbu), o1, 0, 0, 0); }
        c1[14] = __builtin_amdgcn_exp2f(c1[14]); ps += c1[14]; c1[15] = __builtin_amdgcn_exp2f(c1[15]); ps += c1[15]; pwn[15] = pk2(c1[14], c1[15]);
        __builtin_amdgcn_sched_barrier(0);
        vf0a = *(const LAS u32x2*)(vb_ + ((6) ^ vsw) * 16); vf0b = *(const LAS u32x2*)(vb_ + ((7) ^ vsw) * 16);
        { const u32x4 pbu = {pwc[8], pwc[9], pwc[10], pwc[11]}; const u32x4 vv = {vf1a.x, vf1a.y, vf1b.x, vf1b.y};
          o0 = __builtin_amdgcn_mfma_f32_32x32x16_bf16(__builtin_bit_cast(bf16x8, vv), __builtin_bit_cast(bf16x8, pbu), o0, 0, 0, 0); }
        mxl = fmaxf(n0[0], n1[0]); mxl = fmaxf(fmaxf(mxl, n0[1]), n1[1]); mxl = fmaxf(fmaxf(mxl, n0[2]), n1[2]); mxl = fmaxf(fmaxf(mxl, n0[3]), n1[3]);
        __builtin_amdgcn_sched_barrier(0);
        vf1a = *(const LAS u32x2*)(vb_ + 32 * 128 + ((6) ^ vsw) * 16); vf1b = *(const LAS u32x2*)(vb_ + 32 * 128 + ((7) ^ vsw) * 16);
        { const u32x4 pbu = {pwc[8], pwc[9], pwc[10], pwc[11]}; const u32x4 vv = {vf2a.x, vf2a.y, vf2b.x, vf2b.y};
          o1 = __builtin_amdgcn_mfma_f32_32x32x16_bf16(__builtin_bit_cast(bf16x8, vv), __builtin_bit_cast(bf16x8, pbu), o1, 0, 0, 0); }
        mxl = fmaxf(fmaxf(mxl, n0[4]), n1[4]); mxl = fmaxf(fmaxf(mxl, n0[5]), n1[5]); mxl = fmaxf(fmaxf(mxl, n0[6]), n1[6]); mxl = fmaxf(fmaxf(mxl, n0[7]), n1[7]);
        __builtin_amdgcn_sched_barrier(0);
        { const u32x4 pbu = {pwc[12], pwc[13], pwc[14], pwc[15]}; const u32x4 vv = {vf0a.x, vf0a.y, vf0b.x, vf0b.y};
          o0 = __builtin_amdgcn_mfma_f32_32x32x16_bf16(__builtin_bit_cast(bf16x8, vv), __builtin_bit_cast(bf16x8, pbu), o0, 0, 0, 0); }
        mxl = fmaxf(fmaxf(mxl, n0[8]), n1[8]); mxl = fmaxf(fmaxf(mxl, n0[9]), n1[9]); mxl = fmaxf(fmaxf(mxl, n0[10]), n1[10]); mxl = fmaxf(fmaxf(mxl, n0[11]), n1[11]);
        __builtin_amdgcn_sched_barrier(0);
        { const u32x4 pbu = {pwc[12], pwc[13], pwc[14], pwc[15]}; const u32x4 vv = {vf1a.x, vf1a.y, vf1b.x, vf1b.y};
          o1 = __builtin_amdgcn_mfma_f32_32x32x16_bf16(__builtin_bit_cast(bf16x8, vv), __builtin_bit_cast(bf16x8, pbu), o1, 0, 0, 0); }
        mxl = fmaxf(fmaxf(mxl, n0[12]), n1[12]); mxl = fmaxf(fmaxf(mxl, n0[13]), n1[13]); mxl = fmaxf(fmaxf(mxl, n0[14]), n1[14]); mxl = fmaxf(fmaxf(mxl, n0[15]), n1[15]);
        __builtin_amdgcn_sched_barrier(0);
        mxn = fmaxf(mxl, __shfl_xor(mxl, 32));
    } else {
        u32x2 vf0a, vf0b, vf1a, vf1b, vf2a, vf2b;
        vf0a = *(const LAS u32x2*)(vb_ + ((0) ^ vsw) * 16); vf0b = *(const LAS u32x2*)(vb_ + ((1) ^ vsw) * 16);
        vf1a = *(const LAS u32x2*)(vb_ + 32 * 128 + ((0) ^ vsw) * 16); vf1b = *(const LAS u32x2*)(vb_ + 32 * 128 + ((1) ^ vsw) * 16);
        vf2a = *(const LAS u32x2*)(vb_ + ((2) ^ vsw) * 16); vf2b = *(const LAS u32x2*)(vb_ + ((3) ^ vsw) * 16);
        { const u32x4 pbu = {pwc[0], pwc[1], pwc[2], pwc[3]}; const u32x4 vv = {vf0a.x, vf0a.y, vf0b.x, vf0b.y};
          o0 = __builtin_amdgcn_mfma_f32_32x32x16_bf16(__builtin_bit_cast(bf16x8, vv), __builtin_bit_cast(bf16x8, pbu), o0, 0, 0, 0); }
        __builtin_amdgcn_sched_barrier(0);
        vf0a = *(const LAS u32x2*)(vb_ + 32 * 128 + ((2) ^ vsw) * 16); vf0b = *(const LAS u32x2*)(vb_ + 32 * 128 + ((3) ^ vsw) * 16);
        { const u32x4 pbu = {pwc[0], pwc[1], pwc[2], pwc[3]}; const u32x4 vv = {vf1a.x, vf1a.y, vf1b.x, vf1b.y};
          o1 = __builtin_amdgcn_mfma_f32_32x32x16_bf16(__builtin_bit_cast(bf16x8, vv), __builtin_bit_cast(bf16x8, pbu), o1, 0, 0, 0); }
        __builtin_amdgcn_sched_barrier(0);
        vf1a = *(const LAS u32x2*)(vb_ + ((4) ^ vsw) * 16); vf1b = *(const LAS u32x2*)(vb_ + ((5) ^ vsw) * 16);
        { const u32x4 pbu = {pwc[4], pwc[5], pwc[6], pwc[7]}; const u32x4 vv = {vf2a.x, vf2a.y, vf2b.x, vf2b.y};
          o0 = __builtin_amdgcn_mfma_f32_32x32x16_bf16(__builtin_bit_cast(bf16x8, vv), __builtin_bit_cast(bf16x8, pbu), o0, 0, 0, 0); }
        __builtin_amdgcn_sched_barrier(0);
        vf2a = *(const LAS u32x2*)(vb_ + 32 * 128 + ((4) ^ vsw) * 16); vf2b = *(const LAS u32x2*)(vb_ + 32 * 128 + ((5) ^ vsw) * 16);
        { const u32x4 pbu = {pwc[4], pwc[5], pwc[6], pwc[7]}; const u32x4 vv = {vf0a.x, vf0a.y, vf0b.x, vf0b.y};
          o1 = __builtin_amdgcn_mfma_f32_32x32x16_bf16(__builtin_bit_cast(bf16x8, vv), __builtin_bit_cast(bf16x8, pbu), o1, 0, 0, 0); }
        __builtin_amdgcn_sched_barrier(0);
        vf0a = *(const LAS u32x2*)(vb_ + ((6) ^ vsw) * 16); vf0b = *(const LAS u32x2*)(vb_ + ((7) ^ vsw) * 16);
        { const u32x4 pbu = {pwc[8], pwc[9], pwc[10], pwc[11]}; const u32x4 vv = {vf1a.x, vf1a.y, vf1b.x, vf1b.y};
          o0 = __builtin_amdgcn_mfma_f32_32x32x16_bf16(__builtin_bit_cast(bf16x8, vv), __builtin_bit_cast(bf16x8, pbu), o0, 0, 0, 0); }
        __builtin_amdgcn_sched_barrier(0);
        vf1a = *(const LAS u32x2*)(vb_ + 32 * 128 + ((6) ^ vsw) * 16); vf1b = *(const LAS u32x2*)(vb_ + 32 * 128 + ((7) ^ vsw) * 16);
        { const u32x4 pbu = {pwc[8], pwc[9], pwc[10], pwc[11]}; const u32x4 vv = {vf2a.x, vf2a.y, vf2b.x, vf2b.y};
          o1 = __builtin_amdgcn_mfma_f32_32x32x16_bf16(__builtin_bit_cast(bf16x8, vv), __builtin_bit_cast(bf16x8, pbu), o1, 0, 0, 0); }
        __builtin_amdgcn_sched_barrier(0);
        { const u32x4 pbu = {pwc[12], pwc[13], pwc[14], pwc[15]}; const u32x4 vv = {vf0a.x, vf0a.y, vf0b.x, vf0b.y};
          o0 = __builtin_amdgcn_mfma_f32_32x32x16_bf16(__builtin_bit_cast(bf16x8, vv), __builtin_bit_cast(bf16x8, pbu), o0, 0, 0, 0); }
        __builtin_amdgcn_sched_barrier(0);
        { const u32x4 pbu = {pwc[12], pwc[13], pwc[14], pwc[15]}; const u32x4 vv = {vf1a.x, vf1a.y, vf1b.x, vf1b.y};
          o1 = __builtin_amdgcn_mfma_f32_32x32x16_bf16(__builtin_bit_cast(bf16x8, vv), __builtin_bit_cast(bf16x8, pbu), o1, 0, 0, 0); }
        __builtin_amdgcn_sched_barrier(0);
    }
}

template <int DUMMY>
__device__ __forceinline__ void phase3q(const P& p, int bid, int nb, LAS unsigned char* lds) {
    const bf16_t* Q = p.slotA; const bf16_t* K = p.slotE; const bf16_t* VT = p.slotF; bf16_t* O = p.slotC;
    const int tid = opaque_tid(), lane = tid & 63, wid = tid >> 6, l31 = lane & 31, hh = lane >> 5;
    constexpr float THR = 8.f;
    const int widu = __builtin_amdgcn_readfirstlane(tid >> 6);
    int koff[3];
#pragma unroll
    for (int i = 0; i < 3; ++i) { const int s = tid + 256 * i, r = s / 12, pc = s % 12, c = (pc + 12 - ((r >> 2) & 3)) % 12; koff[i] = r * 96 + c * 8; }
    const int kt = hh + ((lane >> 2) & 3), kt16 = kt * 16, k4o = (8 + kt >= 12 ? kt - 4 : 8 + kt) * 16, k5o = (10 + kt >= 12 ? kt - 2 : 10 + kt) * 16;
    const int krow = l31 * 192, vsw = (lane >> 1) & 7, vrow = l31 * 128 + 8 * hh;
    for (int iu = 0;; ++iu) {
        const int r = iu * nb + ((iu & 1) ? nb - 1 - bid : bid); if (r >= 1024) break;
        const int qb = 63 - (r >> 4), bh = r & 15, b = bh >> 3, h = bh & 7;
        const int q0 = qb * 128 + wid * 32, ntw = (q0 >> 6) + 1, nt = 2 * qb + 2;
        const bf16_t* Kb = K + (size_t)bh * SEQ * 96; const bf16_t* Vb = VT + (size_t)(h * 64) * NT + (size_t)b * SEQ;
        bf16x8 qf[6]; { const bf16_t* qp = Q + ((size_t)bh * SEQ + q0 + l31) * 96 + hh * 8;
#pragma unroll
            for (int ks = 0; ks < 6; ++ks) qf[ks] = *(const bf16x8*)(qp + ks * 16); }
        f32x16 o0, o1;
#pragma unroll
        for (int e = 0; e < 16; ++e) { o0[e] = 0.f; o1[e] = 0.f; }
        float mrun = 0.f, lsum = 0.f; f32x16 negm;
#pragma unroll
        for (int e = 0; e < 16; ++e) negm[e] = 0.f;
        auto stageK = [&](int j) { LAS unsigned char* d = lds + (j & 1) * 12288 + widu * 1024; const bf16_t* kt = Kb + (size_t)j * 64 * 96;
#pragma unroll
            for (int i = 0; i < 3; ++i) __builtin_amdgcn_global_load_lds((const unsigned*)(kt + koff[i]), (LAS unsigned*)(d + i * 4096), 16, 0, 0); };
        auto stageV = [&](int j) { LAS unsigned char* d = lds + 24576 + (j & 1) * 8192 + widu * 1024; const bf16_t* vt = Vb + j * 64;
#pragma unroll
            for (int i = 0; i < 2; ++i) { const int dv = (tid >> 3) + 32 * i, cl = (tid & 7) ^ ((dv >> 1) & 7);
                __builtin_amdgcn_global_load_lds((const unsigned*)(vt + (size_t)dv * NT + cl * 8), (LAS unsigned*)(d + i * 4096), 16, 0, 0); } };
        f32x16 sA0, sA1, sB0, sB1; unsigned pA[16], pB[16]; float mxA, mxB = 0.f;
#pragma unroll
        for (int e = 0; e < 16; ++e) { pA[e] = 0u; pB[e] = 0u; }
        stageK(0); stageK(1);
        asm volatile("s_waitcnt vmcnt(0)" ::: "memory");
        __syncthreads();
        { const LAS unsigned char* kb_ = lds + krow;
#pragma unroll
          for (int e = 0; e < 16; ++e) { sA0[e] = 0.f; sA1[e] = 0.f; }
#pragma unroll
          for (int ks = 0; ks < 6; ++ks) { const int ko = ks <= 3 ? kt16 + 32 * ks : (ks == 4 ? k4o : k5o); const bf16x8 k0 = *(const LAS bf16x8*)(kb_ + ko); const bf16x8 k1 = *(const LAS bf16x8*)(kb_ + 32 * 192 + ko);
              sA0 = __builtin_amdgcn_mfma_f32_32x32x16_bf16(k0, qf[ks], sA0, 0, 0, 0); sA1 = __builtin_amdgcn_mfma_f32_32x32x16_bf16(k1, qf[ks], sA1, 0, 0, 0); }
          float m = fmaxf(sA0[0], sA1[0]);
#pragma unroll
          for (int e = 1; e < 16; ++e) m = fmaxf(fmaxf(m, sA0[e]), sA1[e]);
          mxA = fmaxf(m, __shfl_xor(m, 32)); }
        auto step = [&](f32x16& c0, f32x16& c1, float& mxc, f32x16& n0, f32x16& n1, float& mxn, const unsigned (&pwc)[16], unsigned (&pwn)[16], int s) {
            asm volatile("s_waitcnt vmcnt(0)" ::: "memory");
            __syncthreads();
            if (s + 2 < nt) stageK(s + 2);
            if (s < nt) stageV(s);
            if (s <= ntw) {
                const LAS unsigned char* kb_ = lds + ((s + 1) & 1) * 12288 + krow; const LAS unsigned char* vb_ = lds + 24576 + ((s + 1) & 1) * 8192 + vrow;
                if (s < ntw) {
                    const bool resc = (s == 0) || !__all(mxc <= THR); float alpha = 1.f;
                    if (resc) { const float dl = (s == 0) ? mxc : fmaxf(mxc, 0.f); alpha = __builtin_amdgcn_exp2f(-dl); mrun += dl;
#pragma unroll
                        for (int e = 0; e < 16; ++e) { c0[e] -= dl; c1[e] -= dl; negm[e] = -mrun; } }
                    float ps = 0.f;
                    if (s == 0) att_step<0>(kb_, vb_, kt16, k4o, k5o, vsw, qf, c0, c1, n0, n1, pwc, pwn, o0, o1, negm, ps, mxn);
                    else att_step<1>(kb_, vb_, kt16, k4o, k5o, vsw, qf, c0, c1, n0, n1, pwc, pwn, o0, o1, negm, ps, mxn);
                    if (resc) {
#pragma unroll
                        for (int e = 0; e < 16; ++e) { o0[e] *= alpha; o1[e] *= alpha; } }
                    lsum = lsum * alpha + ps;
                } else att_step<2>(kb_, vb_, kt16, k4o, k5o, vsw, qf, c0, c1, n0, n1, pwc, pwn, o0, o1, negm, lsum, mxn);
            }
        };
        for (int s = 0; s <= nt; s += 2) { step(sA0, sA1, mxA, sB0, sB1, mxB, pB, pA, s); if (s + 1 <= nt) step(sB0, sB1, mxB, sA0, sA1, mxA, pA, pB, s + 1); }
        const float inv = 1.f / (lsum + __shfl_xor(lsum, 32));
        bf16_t* op = O + (size_t)(b * SEQ + q0 + l31) * 512 + h * 64 + 4 * hh;
#pragma unroll
        for (int g = 0; g < 4; ++g) { uint2 w0, w1;
            w0.x = pk2(o0[4 * g] * inv, o0[4 * g + 1] * inv); w0.y = pk2(o0[4 * g + 2] * inv, o0[4 * g + 3] * inv);
            w1.x = pk2(o1[4 * g] * inv, o1[4 * g + 1] * inv); w1.y = pk2(o1[4 * g + 2] * inv, o1[4 * g + 3] * inv);
            *(uint2*)(op + 8 * g) = w0; *(uint2*)(op + 32 + 8 * g) = w1; }
        __syncthreads();
    }
}

__device__ __forceinline__ void phase4(const P& p, int bid, int nb, LAS unsigned char* lds) {
    const bf16_t* O = p.slotC; const bf16_t* su = p.slotG; const bf16_t* gates = p.slotD; bf16_t* mo = p.slotA;
    const int tid = opaque_tid(), lane = tid & 63, wid = tid >> 6, wr = wid >> 1, wc = wid & 1, fr = lane & 15, fq = lane >> 4;
    const int c8 = ((tid & 7) ^ ((tid >> 3) & 7)) * 8;
    auto ops1 = [&](int rt, int ct) __attribute__((always_inline)) { return gops(O + (size_t)(rt * 128 + (tid >> 3)) * 512 + c8, (size_t)32 * 512, p.WoaT + (size_t)(ct * 128 + (tid >> 3)) * 512 + c8, (size_t)32 * 512); };
    auto ops2 = [&](int rt, int ct) __attribute__((always_inline)) { return gops(su + (size_t)(rt * 128 + (tid >> 3)) * 512 + c8, (size_t)32 * 512, p.WosT + (size_t)(ct * 128 + (tid >> 3)) * 512 + c8, (size_t)32 * 512); };
    int rt, ct; bool have = tile_of(0, bid, nb, NT / 128, DM / 128, rt, ct);
    for (int it = 0; have; ++it) {
        const int row0 = rt * 128, col0 = ct * 128;
        int rt2, ct2; const bool have2 = tile_of(it + 1, bid, nb, NT / 128, DM / 128, rt2, ct2);
        f32x4 acc[4][4];
#pragma unroll
        for (int m = 0; m < 4; ++m)
#pragma unroll
            for (int n = 0; n < 4; ++n) acc[m][n] = (f32x4){0.f, 0.f, 0.f, 0.f};
        uint2 gav[4][4], gbv[4][4];
#pragma unroll
        for (int m = 0; m < 4; ++m)
#pragma unroll
            for (int n = 0; n < 4; ++n) { const int t = row0 + wr * 64 + m * 16 + fr, c = col0 + wc * 64 + n * 16 + fq * 4;
                gav[m][n] = *(const uint2*)(gates + (size_t)t * 2048 + c); gbv[m][n] = *(const uint2*)(gates + (size_t)t * 2048 + 1024 + c); }
        mg_kloop_p(acc, ops1(rt, ct), 8, lds, it > 0, true, ops2(rt, ct));
#pragma unroll
        for (int m = 0; m < 4; ++m)
#pragma unroll
            for (int n = 0; n < 4; ++n) { const f32x4 ga = bf4(gav[m][n]), gb = bf4(gbv[m][n]);
#pragma unroll
                for (int j = 0; j < 4; ++j) acc[m][n][j] *= ga[j] * __builtin_amdgcn_rcpf(gb[j]); }
        mg_kloop_p(acc, ops2(rt, ct), 8, lds, true, have2, ops1(have2 ? rt2 : rt, have2 ? ct2 : ct));
#pragma unroll
        for (int m = 0; m < 4; ++m)
#pragma unroll
            for (int n = 0; n < 4; ++n) { const int t = row0 + wr * 64 + m * 16 + fr, c = col0 + wc * 64 + n * 16 + fq * 4;
                const f32x4 gb = bf4(gbv[m][n]);
                uint2 o; o.x = pk2(gb[0] * acc[m][n][0], gb[1] * acc[m][n][1]); o.y = pk2(gb[2] * acc[m][n][2], gb[3] * acc[m][n][3]); *(uint2*)(mo + (size_t)t * DM + c) = o; }
        rt = rt2; ct = ct2; have = have2;
    }
    __syncthreads();
}

__device__ __forceinline__ void phase5(const P& p, int bid, int nb, LAS unsigned char* lds) {
    const float* x = p.x; float* xm = p.out;
    const int tid = opaque_tid(), lane = tid & 63, wid = tid >> 6, wr = wid >> 1, wc = wid & 1, fr = lane & 15, fq = lane >> 4;
    const int c8 = ((tid & 7) ^ ((tid >> 3) & 7)) * 8;
    int rt, ct; bool have = tile_of(0, bid, nb, NT / 128, DM / 128, rt, ct);
    GOps cur = gops(p.slotA + (size_t)(rt * 128 + (tid >> 3)) * DM + c8, (size_t)32 * DM, p.WoutT + (size_t)(ct * 128 + (tid >> 3)) * DM + c8, (size_t)32 * DM);
    for (int it = 0; have; ++it) {
        const int row0 = rt * 128, col0 = ct * 128;
        int rt2, ct2; const bool have2 = tile_of(it + 1, bid, nb, NT / 128, DM / 128, rt2, ct2);
        const GOps nxt = gops(p.slotA + (size_t)((have2 ? rt2 : rt) * 128 + (tid >> 3)) * DM + c8, (size_t)32 * DM, p.WoutT + (size_t)((have2 ? ct2 : ct) * 128 + (tid >> 3)) * DM + c8, (size_t)32 * DM);
        f32x4 acc[4][4];
#pragma unroll
        for (int m = 0; m < 4; ++m)
#pragma unroll
            for (int n = 0; n < 4; ++n) acc[m][n] = *(const f32x4*)(x + (size_t)(row0 + wr * 64 + m * 16 + fr) * DM + col0 + wc * 64 + n * 16 + fq * 4);
        mg_kloop_p(acc, cur, DM / 64, lds, it > 0, have2, nxt);
#pragma unroll
        for (int m = 0; m < 4; ++m)
#pragma unroll
            for (int n = 0; n < 4; ++n) *(f32x4*)(xm + (size_t)(row0 + wr * 64 + m * 16 + fr) * DM + col0 + wc * 64 + n * 16 + fq * 4) = acc[m][n];
        cur = nxt; rt = rt2; ct = ct2; have = have2;
    }
    __syncthreads();
}

__device__ __forceinline__ void ex_tile(const P& p, int tile, const float*& s0, const float*& s1, size_t& ld, bf16_t*& dst, int& K) {
    bf16_t* WguT = (bf16_t*)p.slotB; bf16_t* WdT = p.slotC + (size_t)NT * 512;
    const int e = tile / 192, tt = tile % 192;
    if (tt < 128) { const int tr = tt >> 4, tk = tt & 15, T = tr >> 1, wc = tr & 1, k0 = tk * 64, c0 = T * 64 + wc * 32;
        s0 = p.w_eg + ((size_t)e * 1024 + k0) * 256 + c0; s1 = p.w_eu + ((size_t)e * 1024 + k0) * 256 + c0; ld = 256; K = 1024;
        dst = WguT + ((size_t)e * 512 + tr * 64) * 1024 + k0; }
    else { const int t2 = tt - 128, tr = t2 >> 2, tk = t2 & 3, k0 = tk * 64, n0 = tr * 64;
        s0 = p.w_ed + ((size_t)e * 256 + k0) * 1024 + n0; s1 = s0 + 32; ld = 1024; K = 256;
        dst = WdT + ((size_t)e * 1024 + n0) * 256 + k0; }
}
__device__ __forceinline__ void expert_conv_pair(const P& p, float* sm, int q, int tid) {
    const int kq = tid >> 4, r4 = (tid & 15) * 4;
    f32x4 v[2][4]; bf16_t* dst[2]; int K[2];
#pragma unroll
    for (int u = 0; u < 2; ++u) { const float* s0; const float* s1; size_t ld; ex_tile(p, 2 * q + u, s0, s1, ld, dst[u], K[u]);
        const float* src = (r4 < 32 ? s0 + r4 : s1 + (r4 - 32));
#pragma unroll
        for (int i = 0; i < 4; ++i) v[u][i] = *(const f32x4*)(src + (size_t)(kq + 16 * i) * ld); }
#pragma unroll
    for (int u = 0; u < 2; ++u) {
#pragma unroll
        for (int i = 0; i < 4; ++i)
#pragma unroll
            for (int j = 0; j < 4; ++j) sm[u * 4160 + (kq + 16 * i) * 65 + r4 + j] = v[u][i][j]; }
    __syncthreads();
#pragma unroll
    for (int u = 0; u < 2; ++u) {
#pragma unroll
        for (int i = 0; i < 4; ++i) { const int rho = kq + 16 * i; const float* bb = sm + u * 4160 + r4 * 65 + rho;
            uint2 o; o.x = pk2(bb[0], bb[65]); o.y = pk2(bb[130], bb[195]); *(uint2*)(dst[u] + (size_t)rho * K[u] + r4) = o; } }
}
constexpr int CONV_PRE = 6, CONV_PAIRS = 3072;
__device__ __forceinline__ void expert_conv_pre(const P& p, float* sm, int bid, int nb) {
    const int tid = opaque_tid();
    if (nb == 512 && bid >= 256) {
#pragma unroll 1
        for (int k = 0; k < CONV_PRE; ++k) { expert_conv_pair(p, sm, (bid - 256) * CONV_PRE + k, tid); __syncthreads(); } }
}
__device__ __forceinline__ void expert_conv(const P& p, float* sm, LAS unsigned char* lds, int nb) {
    const int tid = opaque_tid(); const int q0 = (nb == 512) ? 256 * CONV_PRE : 0;
    volatile LAS int* slot = (volatile LAS int*)(lds + LDS_MAIN_ + 8); unsigned* ctr = WQ_CTR(p.bar, 2);
    if (tid == 0) slot[0] = q0 + (int)__hip_atomic_fetch_add(ctr, 1u, __ATOMIC_RELAXED, __HIP_MEMORY_SCOPE_AGENT);
    __syncthreads();
    int q = slot[0];
    __syncthreads();
    while (q < CONV_PAIRS) {
        int pend = 0; if (tid == 0) pend = q0 + (int)__hip_atomic_fetch_add(ctr, 1u, __ATOMIC_RELAXED, __HIP_MEMORY_SCOPE_AGENT);
        expert_conv_pair(p, sm, q, tid);
        if (tid == 0) slot[0] = pend;
        __syncthreads();
        q = slot[0];
    }
    __syncthreads();
}

__device__ __forceinline__ void phase6(const P& p, int bid, int nb, float* sm) {
    const int tid = opaque_tid(), lane = tid & 63, wid = tid >> 6;
    bf16_t* h2 = p.slotA; const float* xm = p.out;
    int* s_cnt = (int*)sm; int* s_base = s_cnt + 32; int* s_e = s_base + 32; int* s_r = s_e + 128; float* s_w = (float*)(s_r + 128);
    if (tid < 32) s_cnt[tid] = 0;
    __syncthreads();
    int slot = wid * 16;
    float* xs = sm + 512 + wid * 1024;
    f32x4 vpre[4]; f32x4 gf[4];
#pragma unroll
    for (int i = 0; i < 4; ++i) gf[i] = *(const f32x4*)(p.g_ffn + (lane + 64 * i) * 4);
    if (bid * 4 + wid < NT) {
#pragma unroll
        for (int i = 0; i < 4; ++i) vpre[i] = *(const f32x4*)(xm + (size_t)(bid * 4 + wid) * DM + (lane + 64 * i) * 4); }
    for (int t = bid * 4 + wid; t < NT; t += nb * 4, ++slot) {
        f32x4 v[4]; float ss = 0.f;
#pragma unroll
        for (int i = 0; i < 4; ++i) { v[i] = vpre[i]; ss += v[i][0] * v[i][0] + v[i][1] * v[i][1] + v[i][2] * v[i][2] + v[i][3] * v[i][3]; }
        if (t + nb * 4 < NT) {
#pragma unroll
            for (int i = 0; i < 4; ++i) vpre[i] = *(const f32x4*)(xm + (size_t)(t + nb * 4) * DM + (lane + 64 * i) * 4); }
        ss = wsumf(ss); const float r = rsqrtf(ss * (1.f / DM) + EPS);
#pragma unroll
        for (int i = 0; i < 4; ++i) { const f32x4 g = gf[i]; v[i] = v[i] * r * g; *(f32x4*)(xs + (lane + 64 * i) * 4) = v[i];
            uint2 o; o.x = pk2(v[i][0], v[i][1]); o.y = pk2(v[i][2], v[i][3]); *(uint2*)(h2 + (size_t)t * DM + (lane + 64 * i) * 4) = o; }
        f32x4 lgv = {0.f, 0.f, 0.f, 0.f};
#pragma unroll
        for (int i = 0; i < 16; ++i) { const int k = lane + 64 * i; lgv += xs[k] * *(const f32x4*)(p.w_rg + (size_t)k * 4); }
        float lg[4];
#pragma unroll
        for (int g = 0; g < 4; ++g) lg[g] = wsumf(lgv[g]) + p.b_rg[g];
        int gs = 0; float gm = lg[0];
#pragma unroll
        for (int g = 1; g < 4; ++g) if (lg[g] > gm) { gm = lg[g]; gs = g; }
        float den = 0.f;
#pragma unroll
        for (int g = 0; g < 4; ++g) den += __expf(lg[g] - gm);
        const float ptop = 1.f / den;
        f32x4 lev = {0.f, 0.f, 0.f, 0.f}; const float* wre = p.w_re + (size_t)gs * DM * 8;
#pragma unroll 16
        for (int i = 0; i < 32; ++i) { const int c = lane + 64 * i; lev += xs[c >> 1] * *(const f32x4*)(wre + (size_t)c * 4); }
        float le[8];
#pragma unroll
        for (int e = 0; e < 4; ++e) { const float mine = wsum_par(lev[e]), oth = DPP_F(mine, 0xB1); le[e] = mine + p.b_re[gs * 8 + e]; le[4 + e] = oth + p.b_re[gs * 8 + 4 + e]; }
        int e1 = 0; float l1 = le[0];
#pragma unroll
        for (int e = 1; e < 8; ++e) if (le[e] > l1) { l1 = le[e]; e1 = e; }
        int e2 = -1; float l2 = -3.0e38f;
#pragma unroll
        for (int e = 0; e < 8; ++e) if (e != e1 && le[e] > l2) { l2 = le[e]; e2 = e; }
        const float s1 = 1.f / (1.f + __expf(l2 - l1)), s2 = 1.f - s1;
        if (lane == 0) {
            const int ea = gs * 8 + e1, eb = gs * 8 + e2;
            s_e[2 * slot] = ea; s_e[2 * slot + 1] = eb; s_r[2 * slot] = atomicAdd(&s_cnt[ea], 1); s_r[2 * slot + 1] = atomicAdd(&s_cnt[eb], 1);
            s_w[2 * slot] = s1 * ptop; s_w[2 * slot + 1] = s2 * ptop;
        }
    }
    __syncthreads();
    if (tid < 32) { const int c = s_cnt[tid]; s_base[tid] = c ? atomicAdd(&p.cnt[tid], c) : 0; }
    __syncthreads();
    if (tid < 128) { const int sl = tid >> 1, kk = tid & 1, w = sl >> 4, k = sl & 15, t = bid * 4 + w + k * nb * 4;
        if (t < NT) { const int a = 2 * t + kk, e = s_e[tid]; p.list[(size_t)e * NT + s_base[e] + s_r[tid]] = a; p.aw[a] = s_w[tid]; p.aexp[a] = e; } }
    __syncthreads();
}

__device__ __forceinline__ void build_expert_table(const int* cnt, volatile LAS int* tab) {
    const int tid = threadIdx.x;
    if (tid < 64) { const int c = tid < NE ? cnt[tid] : 0; int n = (c + 127) >> 7, incl = n;
#pragma unroll
        for (int o = 1; o < 32; o <<= 1) { const int y = __shfl_up(incl, o); if ((tid & 63) >= o) incl += y; }
        if (tid < NE) { tab[tid] = incl - n; tab[32 + tid] = c; } if (tid == NE - 1) tab[64] = incl; }
    __syncthreads();
}
__device__ __forceinline__ bool find_expert(volatile LAS int* tab, int ub, int& e, int& blk, int& ce) {
    if (ub >= tab[64]) return false;
    int lo = 0;
#pragma unroll
    for (int st = 16; st > 0; st >>= 1) if (tab[lo + st] <= ub) lo += st;
    e = lo; blk = ub - tab[lo]; ce = tab[32 + lo]; return true;
}
__device__ __forceinline__ void phase7a_m(const P& p, int bid, int nb, LAS unsigned char* lds) {
    const bf16_t* h2 = p.slotA; const bf16_t* WguT = (const bf16_t*)p.slotB; bf16_t* hid = p.slotE;
    const int tid = opaque_tid(), lane = tid & 63, wid = tid >> 6, wr = wid >> 1, wc = wid & 1, fr = lane & 15, fq = lane >> 4;
    const int c8 = ((tid & 7) ^ ((tid >> 3) & 7)) * 8;
    volatile LAS int* tab = (volatile LAS int*)(lds + LDS_TAB_); build_expert_table(p.cnt, tab);
    auto make = [&](int u, GOps& g) __attribute__((always_inline)) -> bool {
        int e, blk, ce; if (!find_expert(tab, u >> 2, e, blk, ce)) return false;
        const int ct = u & 3; const int* lst = p.list + (size_t)e * NT; const bf16_t* ap[4];
#pragma unroll
        for (int i = 0; i < 4; ++i) { int r = blk * 128 + (tid >> 3) + 32 * i; r = r < ce ? r : ce - 1; ap[i] = h2 + (size_t)(lst[r] >> 1) * DM + c8; }
        g.a0 = ap[0]; g.a1 = ap[1]; g.a2 = ap[2]; g.a3 = ap[3]; g.bp = WguT + ((size_t)e * 512 + ct * 128 + (tid >> 3)) * 1024 + c8; g.bstep = (size_t)32 * 1024; return true; };
    GOps cur; bool have = make(bid, cur);
    for (int u = bid, it = 0; have; u += nb, ++it) {
        GOps nxt = cur; const bool have2 = make(u + nb, nxt);
        f32x4 acc[4][4];
#pragma unroll
        for (int m = 0; m < 4; ++m)
#pragma unroll
            for (int n = 0; n < 4; ++n) acc[m][n] = (f32x4){0.f, 0.f, 0.f, 0.f};
        mg_kloop_p(acc, cur, 16, lds, it > 0, have2, nxt);
        const int ct = u & 3;
        bf16_t* hb = hid + ((size_t)(u >> 2) * 128 + wr * 64 + fr) * 256 + ct * 64 + wc * 32 + fq * 4;
#pragma unroll
        for (int m = 0; m < 4; ++m)
#pragma unroll
            for (int n = 0; n < 2; ++n) { float v[4];
#pragma unroll
                for (int j = 0; j < 4; ++j) { const float g = acc[m][n][j]; v[j] = g * fsigmoid(g) * acc[m][n + 2][j]; }
                uint2 o; o.x = pk2(v[0], v[1]); o.y = pk2(v[2], v[3]); *(uint2*)(hb + (size_t)(m * 16) * 256 + n * 16) = o; }
        cur = nxt; have = have2;
    }
    __syncthreads();
}
__device__ __forceinline__ void phase7b_m(const P& p, int bid, int nb, LAS unsigned char* lds) {
    const bf16_t* hid = p.slotE; const bf16_t* WdT = p.slotC + (size_t)NT * 512; bf16_t* Y = p.slotD;
    const int tid = opaque_tid(), lane = tid & 63, wid = tid >> 6, wr = wid >> 1, wc = wid & 1, fr = lane & 15, fq = lane >> 4;
    const int c8 = ((tid & 7) ^ ((tid >> 3) & 7)) * 8;
    int e, blk, ce;
    volatile LAS int* tab = (volatile LAS int*)(lds + LDS_TAB_); build_expert_table(p.cnt, tab);
    auto make = [&](int u, GOps& g, int& e_, int& blk_, int& ce_) __attribute__((always_inline)) -> bool {
        if (!find_expert(tab, u >> 3, e_, blk_, ce_)) return false;
        g = gops(hid + ((size_t)(u >> 3) * 128 + (tid >> 3)) * 256 + c8, (size_t)32 * 256, WdT + ((size_t)e_ * 1024 + (u & 7) * 128 + (tid >> 3)) * 256 + c8, (size_t)32 * 256); return true; };
    GOps cur; bool have = make(bid, cur, e, blk, ce);
    for (int u = bid, it = 0; have; u += nb, ++it) {
        GOps nxt = cur; int e2 = 0, blk2 = 0, ce2 = 0; const bool have2 = make(u + nb, nxt, e2, blk2, ce2);
        const int ct = u & 7; const int* lst = p.list + (size_t)e * NT;
        f32x4 acc[4][4];
#pragma unroll
        for (int m = 0; m < 4; ++m)
#pragma unroll
            for (int n = 0; n < 4; ++n) acc[m][n] = (f32x4){0.f, 0.f, 0.f, 0.f};
        mg_kloop_p(acc, cur, 4, lds, it > 0, have2, nxt);
#pragma unroll
        for (int m = 0; m < 4; ++m) { const int r = blk * 128 + wr * 64 + m * 16 + fr;
            if (r < ce) { const int a = lst[r]; const float w = p.aw[a]; bf16_t* yp = Y + (size_t)a * DM + ct * 128 + wc * 64 + fq * 4;
#pragma unroll
                for (int n = 0; n < 4; ++n) { uint2 o; o.x = pk2(acc[m][n][0] * w, acc[m][n][1] * w); o.y = pk2(acc[m][n][2] * w, acc[m][n][3] * w); *(uint2*)(yp + n * 16) = o; } } }
        cur = nxt; e = e2; blk = blk2; ce = ce2; have = have2;
    }
    __syncthreads();
}

__device__ __forceinline__ void phase8(const P& p, int bid, int nb, float* dst) {
    const int tid = opaque_tid(), lane = tid & 63, wid = tid >> 6; const bf16_t* Y = p.slotD;
    for (int t = bid * 4 + wid; t < NT; t += nb * 4) {
        f32x4 v[4]; float ss = 0.f;
#pragma unroll
        for (int i = 0; i < 4; ++i) { const int c = (lane + 64 * i) * 4;
            v[i] = *(const f32x4*)(p.out + (size_t)t * DM + c) + bf4(*(const uint2*)(Y + (size_t)(2 * t) * DM + c)) + bf4(*(const uint2*)(Y + (size_t)(2 * t + 1) * DM + c));
            ss += v[i][0] * v[i][0] + v[i][1] * v[i][1] + v[i][2] * v[i][2] + v[i][3] * v[i][3]; }
        ss = wsumf(ss); const float r = rsqrtf(ss * (1.f / DM) + EPS);
#pragma unroll
        for (int i = 0; i < 4; ++i) { const int c = (lane + 64 * i) * 4; const f32x4 g = *(const f32x4*)(p.g_final + c); *(f32x4*)(dst + (size_t)t * DM + c) = v[i] * r * g; }
    }
}

#define XB_TMO      128
#define XB_XCNT(j)  (256  + 64 * (j))
#define XB_XSUB(j)  (1280 + 64 * (j))
#define XB_XGEN(j)  (2304 + 64 * (j))
#define XB_TOP      3328
#define XB_TOPGEN   3392
#define XCD_BAR_WORDS 3456
#define XB_SPIN_CAP (1u << 18)
__device__ __forceinline__ unsigned xb_ld(unsigned* p)              { return __hip_atomic_load(p, __ATOMIC_RELAXED, __HIP_MEMORY_SCOPE_AGENT); }
__device__ __forceinline__ unsigned xb_add(unsigned* p, unsigned v) { return __hip_atomic_fetch_add(p, v, __ATOMIC_RELAXED, __HIP_MEMORY_SCOPE_AGENT); }
__device__ __forceinline__ unsigned xb_xcc_id() { return (unsigned)__builtin_amdgcn_s_getreg((3 << 11) | 20) & 0xFu; }
#define XB_SPIN(cond, bar) do { unsigned _sp = 0; while (cond) { __builtin_amdgcn_s_sleep(1); \
    if ((++_sp & 255u) == 0u) { if (xb_ld(&(bar)[XB_TMO])) break; if (_sp > XB_SPIN_CAP) { atomicAdd(&(bar)[XB_TMO], 1u); break; } } } } while (0)
struct XcdBarrier { unsigned* bar; unsigned x; volatile LAS unsigned* st; };
__device__ __forceinline__ XcdBarrier xcd_barrier_post(unsigned* bar, volatile LAS unsigned* st) {
    XcdBarrier b; b.bar = bar; b.x = xb_xcc_id(); b.st = st;
    if (threadIdx.x == 0) (void)xb_add(&bar[XB_XCNT(b.x)], 1u);
    return b;
}
__device__ __forceinline__ void xcd_barrier_complete(unsigned* bar, unsigned x, unsigned& nloc, unsigned& nx) {
    const unsigned G = gridDim.x * gridDim.y * gridDim.z;
    unsigned sum, cnt, mine, sp = 0u;
    for (;;) {
        sum = 0u; cnt = 0u; mine = 0u;
#pragma unroll
        for (unsigned j = 0; j < 16; ++j) { const unsigned c = xb_ld(&bar[XB_XCNT(j)]); sum += c; cnt += (c > 0u) ? 1u : 0u; mine = (j == x) ? c : mine; }
        if (sum == G) break;
        __builtin_amdgcn_s_sleep(1);
        if ((++sp & 255u) == 0u) { if (xb_ld(&bar[XB_TMO])) break; if (sp > XB_SPIN_CAP) { atomicAdd(&bar[XB_TMO], 1u); break; } }
    }
    nloc = mine > 0u ? mine : 1u; nx = cnt > 0u ? cnt : 1u;
}
__device__ __forceinline__ void xcd_barrier(const XcdBarrier& b) {
    asm volatile("s_waitcnt vmcnt(0)" ::: "memory");
    __syncthreads();
    if (threadIdx.x == 0) {
        unsigned* bar = b.bar;
        __builtin_amdgcn_s_waitcnt(0);
        unsigned nloc = b.st[0], nx = b.st[1];
        if (nloc == 0u) { xcd_barrier_complete(bar, b.x, nloc, nx); b.st[0] = nloc; b.st[1] = nx; }
        const unsigned old = xb_add(&bar[XB_XSUB(b.x)], 1u);
        const unsigned gen = old / nloc;
        if (old + 1u == (gen + 1u) * nloc) {
            __builtin_amdgcn_fence(__ATOMIC_RELEASE, "agent");
            asm volatile("s_waitcnt vmcnt(0)" ::: "memory");
            const unsigned og = xb_add(&bar[XB_TOP], 1u);
            const unsigned tg = og / nx;
            if (og + 1u == (tg + 1u) * nx) xb_add(&bar[XB_TOPGEN], 1u);
            else XB_SPIN(xb_ld(&bar[XB_TOPGEN]) == tg, bar);
            __builtin_amdgcn_fence(__ATOMIC_ACQUIRE, "agent");
            xb_add(&bar[XB_XGEN(b.x)], 1u);
            asm volatile("s_waitcnt vmcnt(0)" ::: "memory");
        } else {
            XB_SPIN(xb_ld(&bar[XB_XGEN(b.x)]) == gen, bar);
            __builtin_amdgcn_fence(__ATOMIC_ACQUIRE, "agent");
            asm volatile("s_waitcnt vmcnt(0)" ::: "memory");
        }
    }
    __syncthreads();
}

constexpr int LDS_MAIN = 64 * 1024;
constexpr int LDS_BYTES = LDS_MAIN + 16 + 288;
extern __shared__ __attribute__((aligned(16))) unsigned char smem_raw[];


__global__ void __launch_bounds__(256, 2) k_mega(P p) {
    float* sm = (float*)smem_raw; LAS unsigned char* lds = (LAS unsigned char*)smem_raw; const int bid = blockIdx.x, nb = gridDim.x;
    volatile LAS unsigned* st = (volatile LAS unsigned*)(lds + LDS_MAIN);
    if (threadIdx.x < 4) st[threadIdx.x] = 0u;
    __syncthreads();
    const XcdBarrier gb = xcd_barrier_post(p.bar, st);
    phase0(p, bid, nb, sm); xcd_barrier(gb);
    phase1(p, bid, nb, lds); xcd_barrier(gb);
    phase2a(p, bid, nb, false); xcd_barrier(gb);
    phase2b(p, bid, nb, lds); phase2c_m(p, bid, nb, lds); xcd_barrier(gb);
    expert_conv_pre(p, sm, bid, nb); phase3q<0>(p, bid, nb, lds); expert_conv(p, sm, lds, nb); xcd_barrier(gb);
    phase4(p, bid, nb, lds); xcd_barrier(gb);
    phase5(p, bid, nb, lds); xcd_barrier(gb);
    phase6(p, bid, nb, sm); xcd_barrier(gb);
    phase7a_m(p, bid, nb, lds); xcd_barrier(gb);
    phase7b_m(p, bid, nb, lds); xcd_barrier(gb);
    phase8(p, bid, nb, p.out);
}

extern "C" void kernel_launch(void* const* d_in, const int* in_sizes, int n_in, void* d_out, int out_size, void* d_ws, size_t ws_size, hipStream_t stream) {
    P p{};
    p.x = (const float*)d_in[0]; p.pos = (const int*)d_in[1]; p.g_attn = (const float*)d_in[2]; p.w_in = (const float*)d_in[3]; p.g_cq = (const float*)d_in[4];
    p.w_uq = (const float*)d_in[5]; p.g_ckv = (const float*)d_in[6]; p.w_uk = (const float*)d_in[7]; p.w_uv = (const float*)d_in[8]; p.w_o_attn = (const float*)d_in[9];
    p.sgu_gain = (const float*)d_in[10]; p.sgu_bias = (const float*)d_in[11]; p.w_sp = (const float*)d_in[12]; p.b_sp = (const float*)d_in[13]; p.w_o_sgu = (const float*)d_in[14];
    p.w_out = (const float*)d_in[15]; p.g_ffn = (const float*)d_in[16]; p.w_rg = (const float*)d_in[17]; p.b_rg = (const float*)d_in[18]; p.w_re = (const float*)d_in[19];
    p.b_re = (const float*)d_in[20]; p.w_eg = (const float*)d_in[21]; p.w_eu = (const float*)d_in[22]; p.w_ed = (const float*)d_in[23]; p.g_final = (const float*)d_in[24];
    p.out = (float*)d_out;
    unsigned char* w = (unsigned char*)d_ws; size_t off = 0;
    auto take = [&](size_t bytes) { unsigned char* r = w + off; off += (bytes + 255) & ~(size_t)255; return r; };
    p.bar = (unsigned*)take((XCD_BAR_WORDS + 256) * 4);
    p.cnt = (int*)take(4096);
    p.WinT = (bf16_t*)take((size_t)ZP * DM * 2); p.WuqT = (bf16_t*)take(768 * 256 * 2); p.WukT = (bf16_t*)take(512 * 128 * 2); p.WuvT = (bf16_t*)take(512 * 128 * 2);
    p.WoaT = (bf16_t*)take(1024 * 512 * 2); p.WosT = (bf16_t*)take(1024 * 512 * 2); p.WoutT = (bf16_t*)take(1024 * 1024 * 2); p.Wsp = (bf16_t*)take(8 * 128 * 128 * 2);
    p.cs = (float*)take((size_t)NT * 32 * 4); p.cqn = (bf16_t*)take((size_t)NT * 256 * 2); p.ckvn = (bf16_t*)take((size_t)NT * 128 * 2);
    p.list = (int*)take((size_t)NE * NT * 4); p.aw = (float*)take((size_t)2 * NT * 4); p.aexp = (int*)take((size_t)2 * NT * 4);
    p.slotA = (bf16_t*)take((size_t)NT * DM * 2);
    p.slotB = take((size_t)NT * 512 * 4);
    p.slotC = (bf16_t*)take((size_t)NT * 1024 * 2);
    p.slotD = (bf16_t*)take((size_t)NT * 2048 * 2);
    p.slotE = (bf16_t*)take((size_t)NT * NH * 96 * 2);
    p.slotF = (bf16_t*)take((size_t)512 * NT * 2);
    p.slotG = (bf16_t*)take((size_t)NT * 512 * 2);
    if (off > ws_size) { fprintf(stderr, "workspace too small: need %zu have %zu\n", off, ws_size); return; }
    static int grid_blocks = 0;
    if (!grid_blocks) { int dev = 0, cus = 0, per_cu = 0; hipGetDevice(&dev); hipDeviceGetAttribute(&cus, hipDeviceAttributeMultiprocessorCount, dev);
        hipOccupancyMaxActiveBlocksPerMultiprocessor(&per_cu, k_mega, 256, LDS_BYTES); if (per_cu > 2) per_cu = 2; grid_blocks = cus * per_cu; }
    (void)hipMemsetAsync(p.bar, 0, (XCD_BAR_WORDS + 256) * 4, stream);
    void* args[] = {&p};
    hipError_t e = hipLaunchCooperativeKernel((void*)k_mega, dim3(grid_blocks), dim3(256), args, LDS_BYTES, stream);
    if (e != hipSuccess) fprintf(stderr, "cooperative launch failed: %s (grid %d)\n", hipGetErrorString(e), grid_blocks);
}
```

```cpp
#include <hip/hip_runtime.h>
#include <hip/hip_cooperative_groups.h>
#include <cstdint>
#include <cstdio>
namespace cg = cooperative_groups;


typedef unsigned short bf16_t;
constexpr int NT = 16384, SEQ = 8192, DM = 1024, NBATCH = 2;
constexpr int ZC = 3488;
constexpr int ZP = 3584;
constexpr int NH = 8;
constexpr float EPS = 1e-6f;
constexpr int NE = 32;
#define WQ_CTR(bar, k) ((bar) + 3456 + 64 + 16 * (k))
constexpr int LDS_MAIN_ = 64 * 1024;
constexpr int LDS_TAB_ = 64 * 1024 + 16;

struct P {
    const float* x; const int* pos; const float* g_attn; const float* w_in; const float* g_cq; const float* w_uq;
    const float* g_ckv; const float* w_uk; const float* w_uv; const float* w_o_attn; const float* sgu_gain; const float* sgu_bias;
    const float* w_sp; const float* b_sp; const float* w_o_sgu; const float* w_out; const float* g_ffn; const float* w_rg;
    const float* b_rg; const float* w_re; const float* b_re; const float* w_eg; const float* w_eu; const float* w_ed; const float* g_final;
    float* out;
    unsigned* bar;
    int* cnt;
    bf16_t* WinT;
    bf16_t* WuqT;
    bf16_t* WukT;
    bf16_t* WuvT;
    bf16_t* WoaT;
    bf16_t* WosT;
    bf16_t* WoutT;
    bf16_t* Wsp;
    float* cs;
    float* stat;
    bf16_t* cqn;
    bf16_t* ckvn;
    int* list;
    float* aw;
    int* aexp;
    bf16_t* slotA;
    unsigned char* slotB;
    bf16_t* slotC;
    bf16_t* slotD;
    bf16_t* slotE;
    bf16_t* slotF;
    bf16_t* slotG;
};

__device__ __forceinline__ int opaque_tid() { int t = threadIdx.x; asm volatile("" : "+v"(t)); return t; }
__device__ __forceinline__ float bf2f(bf16_t v) { return __uint_as_float(((unsigned)v) << 16); }
__device__ __forceinline__ bf16_t f2bf(float f) { unsigned u = __float_as_uint(f); u += 0x7fffu + ((u >> 16) & 1u); return (bf16_t)(u >> 16); }

#define DPP_F(v, ctrl) __builtin_bit_cast(float, __builtin_amdgcn_update_dpp(0, __builtin_bit_cast(int, (v)), (ctrl), 0xF, 0xF, true))
__device__ __forceinline__ float xrows(float v) {
    { const auto r = __builtin_amdgcn_permlane16_swap(__float_as_uint(v), __float_as_uint(v), false, false); v = __uint_as_float(r[0]) + __uint_as_float(r[1]); }
    { const auto r = __builtin_amdgcn_permlane32_swap(__float_as_uint(v), __float_as_uint(v), false, false); v = __uint_as_float(r[0]) + __uint_as_float(r[1]); }
    return v;
}
__device__ __forceinline__ float wsumf(float v) {
    v += DPP_F(v, 0xB1); v += DPP_F(v, 0x4E); v += DPP_F(v, 0x141); v += DPP_F(v, 0x140); return xrows(v);
}
__device__ __forceinline__ float wsum_par(float v) {
    v += DPP_F(v, 0x128); v += DPP_F(v, 0x124); v += DPP_F(v, 0x122); return xrows(v);
}
__device__ __forceinline__ float fsigmoid(float v) { return __builtin_amdgcn_rcpf(1.f + __builtin_amdgcn_exp2f(-1.4426950408889634f * v)); }
__device__ __forceinline__ float fgelu(float v) { const float u2 = 1.5957691216057308f * (v + 0.044715f * v * v * v); return v * fsigmoid(u2); }

#define LAS __attribute__((address_space(3)))
typedef short bf16x8 __attribute__((ext_vector_type(8)));
typedef float f32x4 __attribute__((ext_vector_type(4)));
constexpr int GEMM_LDS = 65536;
typedef float f32x16 __attribute__((ext_vector_type(16)));
typedef unsigned u32x2 __attribute__((ext_vector_type(2)));
typedef unsigned u32x4 __attribute__((ext_vector_type(4)));
typedef __bf16 bf16v2 __attribute__((ext_vector_type(2)));
typedef float f32v2 __attribute__((ext_vector_type(2)));
__device__ __forceinline__ unsigned pk2(float lo, float hi) { const f32v2 v = {lo, hi}; return __builtin_bit_cast(unsigned, __builtin_convertvector(v, bf16v2)); }
__device__ __forceinline__ f32x4 bf4(const uint2 u) { return (f32x4){__uint_as_float(u.x << 16), __uint_as_float(u.x & 0xffff0000u), __uint_as_float(u.y << 16), __uint_as_float(u.y & 0xffff0000u)}; }


template <class F>
__device__ __forceinline__ int tconv(bf16_t* dst, int R, int K, F f, int base, int bid, int nb, float* sm) {
    const int tid = opaque_tid(), tk = K / 64, ntile = (R / 64) * tk;
    for (int tile = ((bid - base) % nb + nb) % nb; tile < ntile; tile += nb) {
        const int rho0 = (tile / tk) * 64, k0 = (tile % tk) * 64;
#pragma unroll
        for (int i = 0; i < 16; ++i) { const int kk = (tid >> 6) + 4 * i, rr = tid & 63; sm[kk * 65 + rr] = f(k0 + kk, rho0 + rr); }
        __syncthreads();
#pragma unroll
        for (int i = 0; i < 8; ++i) { const int rr = (tid >> 5) + 8 * i, kk = (tid & 31) * 2;
            *(unsigned*)(dst + (size_t)(rho0 + rr) * K + k0 + kk) = pk2(sm[kk * 65 + rr], sm[(kk + 1) * 65 + rr]); }
        __syncthreads();
    }
    return base + ntile;
}

__device__ __forceinline__ void phase0(const P& p, int bid, int nb, float* sm) {
    const int tid = opaque_tid(), lane = tid & 63, wid = tid >> 6;
    const size_t gtid = (size_t)bid * 256 + tid, gsz = (size_t)nb * 256;
    if (bid == 0 && tid < NE) p.cnt[tid] = 0;
    for (size_t i = (size_t)bid * 256 + tid; i < (size_t)4 * NT; i += (size_t)nb * 256) p.stat[i] = 0.f;
    { int t = bid * 4 + wid; f32x4 v[4];
      if (t < NT) {
#pragma unroll
          for (int i = 0; i < 4; ++i) v[i] = *(const f32x4*)(p.x + (size_t)t * DM + (lane + 64 * i) * 4); }
      for (; t < NT; t += nb * 4) {
          const int tn = t + nb * 4; f32x4 vn[4];
          if (tn < NT) {
#pragma unroll
              for (int i = 0; i < 4; ++i) vn[i] = *(const f32x4*)(p.x + (size_t)tn * DM + (lane + 64 * i) * 4); }
          float ss = 0.f;
#pragma unroll
          for (int i = 0; i < 4; ++i) ss += v[i][0] * v[i][0] + v[i][1] * v[i][1] + v[i][2] * v[i][2] + v[i][3] * v[i][3];
          ss = wsumf(ss); const float r = rsqrtf(ss * (1.f / DM) + EPS);
          bf16_t* hr = p.slotA + (size_t)t * DM;
#pragma unroll
          for (int i = 0; i < 4; ++i) { uint2 o; o.x = pk2(v[i][0] * r, v[i][1] * r); o.y = pk2(v[i][2] * r, v[i][3] * r); *(uint2*)(hr + (lane + 64 * i) * 4) = o; }
#pragma unroll
          for (int i = 0; i < 4; ++i) v[i] = vn[i];
      } }
    { const int kq = tid >> 4, r4 = (tid & 15) * 4;
      for (int t0 = bid; t0 < 1408; t0 += 2 * nb) {
          f32x4 v[2][4]; bf16_t* dst[2]; int Kd[2]; const int nt = (t0 + nb < 1408) ? 2 : 1;
#pragma unroll
          for (int u = 0; u < 2; ++u) if (u < nt) { const int tile = t0 + u * nb; const float* src; size_t ld; const float* gain = nullptr; bool zero = false;
              if (tile < 896) { const int tr = tile >> 4, k0 = (tile & 15) * 64, rho0 = tr * 64; const int col0 = rho0 < 512 ? rho0 : rho0 - 96;
                  zero = (rho0 == 448) || (rho0 == 384 && r4 >= 32);
                  src = p.w_in + (size_t)k0 * ZC + col0 + r4; ld = ZC; gain = p.g_attn + k0; dst[u] = p.WinT + (size_t)rho0 * DM + k0; Kd[u] = DM; }
              else if (tile < 1152) { const int t2 = tile - 896, w = t2 >> 7, t3 = t2 & 127, n0 = (t3 >> 3) * 64, k0 = (t3 & 7) * 64;
                  src = (w ? p.w_o_sgu : p.w_o_attn) + (size_t)k0 * 1024 + n0 + r4; ld = 1024; dst[u] = (w ? p.WosT : p.WoaT) + (size_t)n0 * 512 + k0; Kd[u] = 512; }
              else { const int t2 = tile - 1152, n0 = (t2 >> 4) * 64, k0 = (t2 & 15) * 64; src = p.w_out + (size_t)k0 * 1024 + n0 + r4; ld = 1024; dst[u] = p.WoutT + (size_t)n0 * 1024 + k0; Kd[u] = 1024; }
#pragma unroll
              for (int i = 0; i < 4; ++i) { const int kk = kq + 16 * i; f32x4 x = zero ? (f32x4){0.f, 0.f, 0.f, 0.f} : *(const f32x4*)(src + (size_t)kk * ld); if (gain) x = x * gain[kk]; v[u][i] = x; } }
#pragma unroll
          for (int u = 0; u < 2; ++u) if (u < nt) {
#pragma unroll
              for (int i = 0; i < 4; ++i)
#pragma unroll
                  for (int j = 0; j < 4; ++j) sm[u * 4160 + (kq + 16 * i) * 65 + r4 + j] = v[u][i][j]; }
          __syncthreads();
#pragma unroll
          for (int u = 0; u < 2; ++u) if (u < nt) {
#pragma unroll
              for (int i = 0; i < 4; ++i) { const int rho = kq + 16 * i; const float* bb = sm + u * 4160 + r4 * 65 + rho;
                  uint2 o; o.x = pk2(bb[0], bb[65]); o.y = pk2(bb[130], bb[195]); *(uint2*)(dst[u] + (size_t)rho * Kd[u] + r4) = o; } }
          __syncthreads();
      } }
    int base = 0;
    const float qscale = 0.10206207261596575f * 1.4426950408889634f;
    base = tconv(p.WuqT, 768, 256, [&](int k, int rho) { int col;
        if (rho < 512) col = (rho >> 6) * 96 + (rho & 63); else { const int hh = (rho - 512) >> 5, w = (rho - 512) & 31; col = hh * 96 + 64 + (w >> 1) + 16 * (w & 1); }
        return p.w_uq[(size_t)k * 768 + col] * p.g_cq[k] * qscale; }, base, bid, nb, sm);
    base = tconv(p.WukT, 512, 128, [&](int k, int c) { return p.w_uk[(size_t)k * 512 + c] * p.g_ckv[k]; }, base, bid, nb, sm);
    base = tconv(p.WuvT, 512, 128, [&](int k, int c) { return p.w_uv[(size_t)k * 512 + c] * p.g_ckv[k]; }, base, bid, nb, sm);
    for (size_t i = gtid; i < (size_t)8 * 128 * 128; i += gsz) { const int j = (int)(i & 127), ii = (int)((i >> 7) & 127);
        p.Wsp[i] = ((j >> 6) <= (ii >> 6)) ? f2bf(p.w_sp[i]) : (bf16_t)0; }
}

__device__ __forceinline__ bool tile_of(int it, int bid, int nb, int RT, int CT, int& rt, int& ct) {
    if ((RT & 31) == 0 && (nb & 7) == 0) {
        const int x = bid & 7, l = bid >> 3, nl = nb >> 3, rpx = RT >> 3; const int lt = l + it * nl; if (lt >= rpx * CT) return false;
        const int rg = lt / (4 * CT), w = lt % (4 * CT); rt = x * rpx + rg * 4 + (w & 3); ct = w >> 2; return true;
    }
    const int tile = bid + it * nb; if (tile >= RT * CT) return false; rt = tile / CT; ct = tile % CT; return true;
}
struct GOps { const bf16_t* a0; const bf16_t* a1; const bf16_t* a2; const bf16_t* a3; const bf16_t* bp; size_t bstep; };
__device__ __forceinline__ GOps gops(const bf16_t* ap, size_t astep, const bf16_t* bp, size_t bstep) { GOps g; g.a0 = ap; g.a1 = ap + astep; g.a2 = ap + 2 * astep; g.a3 = ap + 3 * astep; g.bp = bp; g.bstep = bstep; return g; }
__device__ __forceinline__ void mg_stage(const GOps& g, int t, LAS unsigned char* lds, int widu) {
    LAS unsigned char* d = lds + (t & 1) * 32768 + widu * 1024; const int k0 = t * 64;
    __builtin_amdgcn_global_load_lds((const unsigned*)(g.a0 + k0), (LAS unsigned*)(d), 16, 0, 0);
    __builtin_amdgcn_global_load_lds((const unsigned*)(g.a1 + k0), (LAS unsigned*)(d + 4096), 16, 0, 0);
    __builtin_amdgcn_global_load_lds((const unsigned*)(g.a2 + k0), (LAS unsigned*)(d + 8192), 16, 0, 0);
    __builtin_amdgcn_global_load_lds((const unsigned*)(g.a3 + k0), (LAS unsigned*)(d + 12288), 16, 0, 0);
#pragma unroll
    for (int i = 0; i < 4; ++i) __builtin_amdgcn_global_load_lds((const unsigned*)(g.bp + i * g.bstep + k0), (LAS unsigned*)(d + 16384 + i * 4096), 16, 0, 0);
}
__device__ __forceinline__ void mg_kloop_p(f32x4 (&acc)[4][4], const GOps& g, int nk, LAS unsigned char* lds, bool prestaged, bool has_next, const GOps& nxt) {
    const int tid = opaque_tid(), lane = tid & 63, wid = tid >> 6, wr = wid >> 1, wc = wid & 1, fr = lane & 15, fq = lane >> 4;
    const int widu = __builtin_amdgcn_readfirstlane(wid);
    if (!prestaged) mg_stage(g, 0, lds, widu);
    const int pc0 = ((fq) ^ (fr & 7)) * 16, pc1 = ((4 + fq) ^ (fr & 7)) * 16;
    for (int t = 0; t < nk; ++t) {
        asm volatile("s_waitcnt vmcnt(0)" ::: "memory");
        __syncthreads();
        if (t + 1 < nk) mg_stage(g, t + 1, lds, widu); else if (has_next) mg_stage(nxt, 0, lds, widu);
        const LAS unsigned char* ab = lds + (t & 1) * 32768 + (wr * 64 + fr) * 128; const LAS unsigned char* bb = lds + (t & 1) * 32768 + 16384 + (wc * 64 + fr) * 128;
        bf16x8 af[2][4], bfr[2][4];
#pragma unroll
        for (int m = 0; m < 4; ++m) { af[0][m] = *(const LAS bf16x8*)(ab + m * 2048 + pc0); bfr[0][m] = *(const LAS bf16x8*)(bb + m * 2048 + pc0); }
#pragma unroll
        for (int m = 0; m < 4; ++m) { af[1][m] = *(const LAS bf16x8*)(ab + m * 2048 + pc1); bfr[1][m] = *(const LAS bf16x8*)(bb + m * 2048 + pc1); }
        __builtin_amdgcn_sched_barrier(0);
#pragma unroll
        for (int ks = 0; ks < 2; ++ks)
#pragma unroll
            for (int m = 0; m < 4; ++m)
#pragma unroll
                for (int n = 0; n < 4; ++n) acc[m][n] = __builtin_amdgcn_mfma_f32_16x16x32_bf16(bfr[ks][n], af[ks][m], acc[m][n], 0, 0, 0);
    }
}
template <class Epi>
__device__ __forceinline__ void mgemm(const bf16_t* A, int lda, const bf16_t* Bt, int ldb, int M, int N, int K, Epi epi, int bid, int nb, LAS unsigned char* lds) {
    const int tid = opaque_tid(), lane = tid & 63, wid = tid >> 6, wr = wid >> 1, wc = wid & 1, fr = lane & 15, fq = lane >> 4;
    const int RT = M / 128, CT = N / 128; const int c8 = ((tid & 7) ^ ((tid >> 3) & 7)) * 8;
    int rt, ct; bool have = tile_of(0, bid, nb, RT, CT, rt, ct);
    GOps cur = gops(A + (size_t)(rt * 128 + (tid >> 3)) * lda + c8, (size_t)32 * lda, Bt + (size_t)(ct * 128 + (tid >> 3)) * ldb + c8, (size_t)32 * ldb);
    for (int it = 0; have; ++it) {
        const int row0 = rt * 128, col0 = ct * 128;
        int rt2, ct2; const bool have2 = tile_of(it + 1, bid, nb, RT, CT, rt2, ct2);
        const GOps nxt = gops(A + (size_t)((have2 ? rt2 : rt) * 128 + (tid >> 3)) * lda + c8, (size_t)32 * lda, Bt + (size_t)((have2 ? ct2 : ct) * 128 + (tid >> 3)) * ldb + c8, (size_t)32 * ldb);
        f32x4 acc[4][4];
#pragma unroll
        for (int m = 0; m < 4; ++m)
#pragma unroll
            for (int n = 0; n < 4; ++n) acc[m][n] = (f32x4){0.f, 0.f, 0.f, 0.f};
        mg_kloop_p(acc, cur, K / 64, lds, it > 0, have2, nxt);
#pragma unroll
        for (int m = 0; m < 4; ++m)
#pragma unroll
            for (int n = 0; n < 4; ++n) epi(row0 + wr * 64 + m * 16 + fr, col0 + wc * 64 + n * 16 + fq * 4, acc[m][n]);
        cur = nxt; rt = rt2; ct = ct2; have = have2;
    }
    __syncthreads();
}


__device__ __forceinline__ void stg_put(LAS unsigned char* S, int r, int c4, const uint2 v) { const u32x2 w = {v.x, v.y};
    *(LAS u32x2*)(S + r * 256 + (((c4 >> 3) ^ (r & 15)) << 4) + ((c4 & 4) << 1)) = w; }
__device__ __forceinline__ void stg_put32(LAS unsigned char* S, int r, int c2, const unsigned v) {
    *(LAS unsigned*)(S + r * 256 + (((c2 >> 3) ^ (r & 15)) << 4) + ((c2 & 7) << 1)) = v; }
__device__ __forceinline__ void row_sums(const u32x4 v, float& s1, float& s2) {
    float a = 0.f, b = 0.f;
#pragma unroll
    for (int i = 0; i < 4; ++i) { const float lo = __uint_as_float(v[i] << 16), hi = __uint_as_float(v[i] & 0xffff0000u); a += lo + hi; b += lo * lo + hi * hi; }
    a += DPP_F(a, 0xB1); a += DPP_F(a, 0x4E); a += DPP_F(a, 0x141); a += DPP_F(a, 0x140);
    b += DPP_F(b, 0xB1); b += DPP_F(b, 0x4E); b += DPP_F(b, 0x141); b += DPP_F(b, 0x140);
    s1 = a; s2 = b;
}
template <int SEG, class D, class RH>
__device__ __forceinline__ void stg_flush(LAS unsigned char* S, D dst, RH rh) {
    const int tid = threadIdx.x, lane = tid & 63, wid = tid >> 6;
#pragma unroll
    for (int it = 0; it < 8; ++it) { const int r = wid * 32 + it * 4 + (lane >> 4), cc = lane & 15;
        const u32x4 v = *(const LAS u32x4*)(S + r * 256 + ((cc ^ (r & 15)) << 4));
        bf16_t* d = dst(r, cc / (SEG / 8));
        if (d) *(u32x4*)(d + (cc % (SEG / 8)) * 8) = v;
        rh(r, cc, v); }
}
struct NoRowHook { __device__ __forceinline__ void operator()(int, int, int, int, const u32x4&) const {} };
template <int SEG, class Val, class Dst, class RowHook = NoRowHook>
__device__ __forceinline__ void mgemm_st(const bf16_t* A, int lda, const bf16_t* Bt, int ldb, int M, int N, int K, Val val, Dst dst, int bid, int nb, LAS unsigned char* lds, RowHook rowhook = RowHook()) {
    const int tid = opaque_tid(), lane = tid & 63, wid = tid >> 6, wr = wid >> 1, wc = wid & 1, fr = lane & 15, fq = lane >> 4;
    const int RT = M / 128, CT = N / 128; const int c8 = ((tid & 7) ^ ((tid >> 3) & 7)) * 8;
    LAS unsigned char* S = lds + 32768;
    int rt, ct; bool have = tile_of(0, bid, nb, RT, CT, rt, ct);
    GOps cur = gops(A + (size_t)(rt * 128 + (tid >> 3)) * lda + c8, (size_t)32 * lda, Bt + (size_t)(ct * 128 + (tid >> 3)) * ldb + c8, (size_t)32 * ldb);
    for (int it = 0; have; ++it) {
        const int row0 = rt * 128, col0 = ct * 128;
        int rt2, ct2; const bool have2 = tile_of(it + 1, bid, nb, RT, CT, rt2, ct2);
        const GOps nxt = gops(A + (size_t)((have2 ? rt2 : rt) * 128 + (tid >> 3)) * lda + c8, (size_t)32 * lda, Bt + (size_t)((have2 ? ct2 : ct) * 128 + (tid >> 3)) * ldb + c8, (size_t)32 * ldb);
        f32x4 acc[4][4];
#pragma unroll
        for (int m = 0; m < 4; ++m)
#pragma unroll
            for (int n = 0; n < 4; ++n) acc[m][n] = (f32x4){0.f, 0.f, 0.f, 0.f};
        mg_kloop_p(acc, cur, K / 64, lds, it > 0, have2, nxt);
        __syncthreads();
#pragma unroll
        for (int m = 0; m < 4; ++m)
#pragma unroll
            for (int n = 0; n < 4; ++n) { const int r = wr * 64 + m * 16 + fr, c = wc * 64 + n * 16 + fq * 4; stg_put(S, r, c, val(row0 + r, col0 + c, acc[m][n])); }
        __syncthreads();
        stg_flush<SEG>(S, [&](int r, int seg) __attribute__((always_inline)) { return dst(row0, col0, r, seg); }, [&](int r, int cc, const u32x4& v) __attribute__((always_inline)) { rowhook(row0, col0, r, cc, v); });
        cur = nxt; rt = rt2; ct = ct2; have = have2;
    }
    __syncthreads();
}

__device__ __forceinline__ void phase1(const P& p, int bid, int nb, LAS unsigned char* sm) {
    bf16_t* zs = (bf16_t*)p.slotB; bf16_t* uvg = p.slotC; bf16_t* gates = p.slotD; float* stat = p.stat;
    mgemm_st<128>(p.slotA, DM, p.WinT, DM, NT, ZP, DM, [=](int t, int c, const f32x4& v) { uint2 o;
        if (c < 512) { o.x = pk2(v[0], v[1]); o.y = pk2(v[2], v[3]); }
        else if (c < 1536) { o.x = pk2(fgelu(v[0]), fgelu(v[1])); o.y = pk2(fgelu(v[2]), fgelu(v[3])); }
        else { o.x = pk2(fsigmoid(v[0]), fsigmoid(v[1])); o.y = pk2(fsigmoid(v[2]), fsigmoid(v[3])); }
        return o;
    }, [=](int row0, int col0, int r, int) -> bf16_t* { const size_t t = (size_t)(row0 + r);
        if (col0 < 512) return zs + t * 512 + col0; if (col0 < 1536) return uvg + t * 1024 + (col0 - 512); return gates + t * 2048 + (col0 - 1536);
    }, bid, nb, sm, [=](int row0, int col0, int r, int cc, const u32x4& v) {
        const bool isq = col0 < 256, iskv = col0 == 256, isv = (col0 >= 1024 && col0 < 1536);
        if (isq || iskv || isv) { float s1, s2; row_sums(v, s1, s2);
            if (cc == 0) { const int t = row0 + r;
                if (isq) atomicAdd(stat + t, s2); else if (iskv) atomicAdd(stat + NT + t, s2); else { atomicAdd(stat + 2 * NT + t, s1); atomicAdd(stat + 3 * NT + t, s2); } } }
    });
}

__device__ __forceinline__ void rope_cs(float posf, int i, float& cn, float& sn) {
    float f = (i & 3) == 0 ? 1.0f : (i & 3) == 1 ? 0.5623413251903491f : (i & 3) == 2 ? 0.31622776601683794f : 0.1778279410038923f;
    const int q4 = i >> 2; f *= (q4 == 0 ? 1.0f : q4 == 1 ? 0.1f : q4 == 2 ? 0.01f : 0.001f);
    const float ang = posf * f; const double rev = (double)ang * 0.15915494309189535; const float frc = (float)(rev - floor(rev));
    sn = __builtin_amdgcn_sinf(frc); cn = __builtin_amdgcn_cosf(frc);
}
__device__ __forceinline__ void rope_rows(const P& p, int bid, int nb) {
    const int tid = opaque_tid(), lane = tid & 63, wid = tid >> 6;
    const bf16_t* zs = (const bf16_t*)p.slotB; bf16_t* K = p.slotE;
    const int hd = lane >> 3, j = lane & 7, i4 = 4 * (j & 3);
    for (int t = bid * 4 + wid; t < NT; t += nb * 4) {
        const bf16_t* z = zs + (size_t)t * 512; const f32x4 k1 = bf4(*(const uint2*)(z + 384 + i4)), k2 = bf4(*(const uint2*)(z + 400 + i4)); const float posf = (float)p.pos[t];
        const int b = t >> 13, sq = t & 8191; float val[4];
#pragma unroll
        for (int q = 0; q < 4; ++q) { float cn, sn; rope_cs(posf, i4 + q, cn, sn); val[q] = (j < 4) ? (k1[q] * cn - k2[q] * sn) : (k1[q] * sn + k2[q] * cn); }
        uint2 o; o.x = pk2(val[0], val[1]); o.y = pk2(val[2], val[3]);
        *(uint2*)(K + ((size_t)(b * NH + hd) * SEQ + sq) * 96 + 64 + 4 * j) = o;
    }
}

__device__ __forceinline__ void phase2b(const P& p, int bid, int nb, LAS unsigned char* sm) {
    const bf16_t* zs = (const bf16_t*)p.slotB; bf16_t* Q = p.slotA; bf16_t* K = p.slotE; bf16_t* VT = p.slotF; const float* stat = p.stat; const int* pos = p.pos;
    mgemm(zs, 512, p.WuqT, 256, NT, 768, 256, [=](int t, int c, const f32x4& vin) {
        const int b = t >> 13, s = t & 8191; const f32x4 v = vin * rsqrtf(stat[t] * (1.f / 256.f) + EPS);
        if (c < 512) { const int h = c >> 6, d = c & 63; uint2 o; o.x = pk2(v[0], v[1]); o.y = pk2(v[2], v[3]); *(uint2*)(Q + ((size_t)(b * NH + h) * SEQ + s) * 96 + d) = o; }
        else { const int h = (c - 512) >> 5, i0 = ((c - 512) & 31) >> 1; bf16_t* q = Q + ((size_t)(b * NH + h) * SEQ + s) * 96; const float posf = (float)pos[t];
            float c0_, s0_, c1_, s1_; rope_cs(posf, i0, c0_, s0_); rope_cs(posf, i0 + 1, c1_, s1_);
            *(unsigned*)(q + 64 + i0) = pk2(v[0] * c0_ - v[1] * s0_, v[2] * c1_ - v[3] * s1_);
            *(unsigned*)(q + 80 + i0) = pk2(v[0] * s0_ + v[1] * c0_, v[2] * s1_ + v[3] * c1_); }
    }, bid, nb, sm);
    mgemm_st<64>(zs + 256, 512, p.WukT, 128, NT, 512, 128, [=](int t, int, const f32x4& vin) { const f32x4 v = vin * rsqrtf(stat[NT + t] * (1.f / 128.f) + EPS); uint2 o; o.x = pk2(v[0], v[1]); o.y = pk2(v[2], v[3]); return o; },
        [=](int row0, int col0, int r, int seg) -> bf16_t* { const int t = row0 + r, b = t >> 13, s = t & 8191, h = (col0 >> 6) + seg; return K + ((size_t)(b * NH + h) * SEQ + s) * 96; }, bid, nb, sm);
    mgemm_st<128>(p.WuvT, 128, zs + 256, 512, 512, NT, 128, [=](int, int t, const f32x4& vin) { const f32x4 ss = *(const f32x4*)(stat + NT + t); f32x4 v;
#pragma unroll
            for (int j = 0; j < 4; ++j) v[j] = vin[j] * rsqrtf(ss[j] * (1.f / 128.f) + EPS);
            uint2 o; o.x = pk2(v[0], v[1]); o.y = pk2(v[2], v[3]); return o; },
        [=](int row0, int col0, int r, int) -> bf16_t* { return VT + (size_t)(row0 + r) * NT + col0; }, bid, nb, sm);
}

__device__ __forceinline__ void phase2c_m(const P& p, int bid, int nb, LAS unsigned char* lds) {
    const bf16_t* uvg = p.slotC; bf16_t* su = p.slotG;
    const int tid = opaque_tid(), lane = tid & 63, wid = tid >> 6, fr = lane & 15, fq = lane >> 4;
    const int c8 = ((tid & 7) ^ ((tid >> 3) & 7)) * 8;
    for (int u = bid; u < 1024; u += nb) {
        const int g = u & 7, t0 = (u >> 3) * 128;
        { const bf16_t* wp = p.Wsp + ((size_t)g * 128 + (tid >> 3)) * 128 + c8; LAS unsigned char* d = lds + tid * 16;
#pragma unroll
          for (int ks = 0; ks < 2; ++ks)
#pragma unroll
              for (int i = 0; i < 4; ++i) __builtin_amdgcn_global_load_lds((const unsigned*)(wp + (size_t)i * 32 * 128 + ks * 64), (LAS unsigned*)(d + ks * 16384 + i * 4096), 16, 0, 0); }
#pragma unroll
        for (int i = 0; i < 4; ++i) { const int q = tid + 256 * i, j = q >> 3, c0 = (q & 7) * 8;
            const uint4 v = *(const uint4*)(uvg + (size_t)(t0 + j) * 1024 + 512 + g * 64 + c0);
            const unsigned w[4] = {v.x, v.y, v.z, v.w};
            const float mu = p.stat[2 * NT + t0 + j] * (1.f / 512.f), rs = rsqrtf(p.stat[3 * NT + t0 + j] * (1.f / 512.f) - mu * mu + EPS);
            const f32x4 g0 = *(const f32x4*)(p.sgu_gain + g * 64 + c0), g1 = *(const f32x4*)(p.sgu_gain + g * 64 + c0 + 4), b0 = *(const f32x4*)(p.sgu_bias + g * 64 + c0), b1 = *(const f32x4*)(p.sgu_bias + g * 64 + c0 + 4);
            LAS unsigned char* bimg = lds + 32768 + (j >> 6) * 8192 + (j & 7) * 2; const int lc = (j & 63) >> 3;
#pragma unroll
            for (int e = 0; e < 8; ++e) { const int row = c0 + e; const float x = (e & 1) ? __uint_as_float(w[e >> 1] & 0xffff0000u) : __uint_as_float(w[e >> 1] << 16);
                const float gn = e < 4 ? g0[e & 3] : g1[e & 3], bs_ = e < 4 ? b0[e & 3] : b1[e & 3];
                *(LAS bf16_t*)(bimg + row * 128 + ((lc ^ (row & 7)) * 16)) = (bf16_t)(pk2((x - mu) * rs * gn + bs_, 0.f) & 0xffffu); } }
        asm volatile("s_waitcnt vmcnt(0)" ::: "memory");
        __syncthreads();
        f32x4 acc[2][4];
#pragma unroll
        for (int m = 0; m < 2; ++m)
#pragma unroll
            for (int n = 0; n < 4; ++n) acc[m][n] = (f32x4){0.f, 0.f, 0.f, 0.f};
#pragma unroll
        for (int ks = 0; ks < 2; ++ks)
#pragma unroll
            for (int k2 = 0; k2 < 2; ++k2) { const int pc = ((k2 * 4 + fq) ^ (fr & 7)) * 16; bf16x8 af[2], bfr[4];
#pragma unroll
                for (int m = 0; m < 2; ++m) af[m] = *(const LAS bf16x8*)(lds + ks * 16384 + (wid * 32 + m * 16 + fr) * 128 + pc);
#pragma unroll
                for (int n = 0; n < 4; ++n) bfr[n] = *(const LAS bf16x8*)(lds + 32768 + ks * 8192 + (n * 16 + fr) * 128 + pc);
#pragma unroll
                for (int m = 0; m < 2; ++m)
#pragma unroll
                    for (int n = 0; n < 4; ++n) acc[m][n] = __builtin_amdgcn_mfma_f32_16x16x32_bf16(bfr[n], af[m], acc[m][n], 0, 0, 0); }
#pragma unroll
        for (int m = 0; m < 2; ++m) { const int i = wid * 32 + m * 16 + fr; const float bs = p.b_sp[g * 128 + i];
#pragma unroll
            for (int n = 0; n < 4; ++n) { const int c = g * 64 + n * 16 + fq * 4;
                const uint2 uu = *(const uint2*)(uvg + (size_t)(t0 + i) * 1024 + c);
                uint2 o; o.x = pk2(__uint_as_float(uu.x << 16) * (acc[m][n][0] + bs), __uint_as_float(uu.x & 0xffff0000u) * (acc[m][n][1] + bs));
                o.y = pk2(__uint_as_float(uu.y << 16) * (acc[m][n][2] + bs), __uint_as_float(uu.y & 0xffff0000u) * (acc[m][n][3] + bs));
                *(uint2*)(su + (size_t)(t0 + i) * 512 + c) = o; } }
        __syncthreads();
    }
}

template <int VAR>
__device__ __forceinline__ void att_step(const LAS unsigned char* kb_, const LAS unsigned char* vb_, const int kt16, const int k4o, const int k5o, const int vsw, const bf16x8 (&qf)[6],
                                         f32x16& c0, f32x16& c1, f32x16& n0, f32x16& n1, const unsigned (&pwc)[16], unsigned (&pwn)[16], f32x16& o0, f32x16& o1,
                                         const f32x16& negm, float& ps, float& mxn) {
    f32x16 zero16;
#pragma unroll
    for (int e = 0; e < 16; ++e) zero16[e] = 0.f;
    if constexpr (VAR == 0) {
        bf16x8 kf0, kf1, kf2;
        kf0 = *(const LAS bf16x8*)(kb_ + 0*32*192 + kt16 + 0); kf1 = *(const LAS bf16x8*)(kb_ + 1*32*192 + kt16 + 0);
        float mxl;
        kf2 = *(const LAS bf16x8*)(kb_ + 0*32*192 + kt16 + 32);
        n0 = __builtin_amdgcn_mfma_f32_32x32x16_bf16(kf0, qf[0], negm, 0, 0, 0);
        c0[0] = __builtin_amdgcn_exp2f(c0[0]); ps += c0[0]; c0[1] = __builtin_amdgcn_exp2f(c0[1]); ps += c0[1]; pwn[0] = pk2(c0[0], c0[1]);
        __builtin_amdgcn_sched_barrier(0);
        kf0 = *(const LAS bf16x8*)(kb_ + 1*32*192 + kt16 + 32);
        n1 = __builtin_amdgcn_mfma_f32_32x32x16_bf16(kf1, qf[0], negm, 0, 0, 0);
        c0[2] = __builtin_amdgcn_exp2f(c0[2]); ps += c0[2]; c0[3] = __builtin_amdgcn_exp2f(c0[3]); ps += c0[3]; pwn[1] = pk2(c0[2], c0[3]);
        __builtin_amdgcn_sched_barrier(0);
        kf1 = *(const LAS bf16x8*)(kb_ + 0*32*192 + kt16 + 64);
        n0 = __builtin_amdgcn_mfma_f32_32x32x16_bf16(kf2, qf[1], n0, 0, 0, 0);
        c0[4] = __builtin_amdgcn_exp2f(c0[4]); ps += c0[4]; c0[5] = __builtin_amdgcn_exp2f(c0[5]); ps += c0[5]; pwn[2] = pk2(c0[4], c0[5]);
        __builtin_amdgcn_sched_barrier(0);
        kf2 = *(const LAS bf16x8*)(kb_ + 1*32*192 + kt16 + 64);
        n1 = __builtin_amdgcn_mfma_f32_32x32x16_bf16(kf0, qf[1], n1, 0, 0, 0);
        c0[6] = __builtin_amdgcn_exp2f(c0[6]); ps += c0[6]; c0[7] = __builtin_amdgcn_exp2f(c0[7]); ps += c0[7]; pwn[3] = pk2(c0[6], c0[7]);
        __builtin_amdgcn_sched_barrier(0);
        kf0 = *(const LAS bf16x8*)(kb_ + 0*32*192 + kt16 + 96);
        n0 = __builtin_amdgcn_mfma_f32_32x32x16_bf16(kf1, qf[2], n0, 0, 0, 0);
        c0[8] = __builtin_amdgcn_exp2f(c0[8]); ps += c0[8]; c0[9] = __builtin_amdgcn_exp2f(c0[9]); ps += c0[9]; pwn[4] = pk2(c0[8], c0[9]);
        __builtin_amdgcn_sched_barrier(0);
        kf1 = *(const LAS bf16x8*)(kb_ + 1*32*192 + kt16 + 96);
        n1 = __builtin_amdgcn_mfma_f32_32x32x16_bf16(kf2, qf[2], n1, 0, 0, 0);
        c0[10] = __builtin_amdgcn_exp2f(c0[10]); ps += c0[10]; c0[11] = __builtin_amdgcn_exp2f(c0[11]); ps += c0[11]; pwn[5] = pk2(c0[10], c0[11]);
        __builtin_amdgcn_sched_barrier(0);
        kf2 = *(const LAS bf16x8*)(kb_ + 0*32*192 + k4o);
        n0 = __builtin_amdgcn_mfma_f32_32x32x16_bf16(kf0, qf[3], n0, 0, 0, 0);
        c0[12] = __builtin_amdgcn_exp2f(c0[12]); ps += c0[12]; c0[13] = __builtin_amdgcn_exp2f(c0[13]); ps += c0[13]; pwn[6] = pk2(c0[12], c0[13]);
        __builtin_amdgcn_sched_barrier(0);
        kf0 = *(const LAS bf16x8*)(kb_ + 1*32*192 + k4o);
        n1 = __builtin_amdgcn_mfma_f32_32x32x16_bf16(kf1, qf[3], n1, 0, 0, 0);
        c0[14] = __builtin_amdgcn_exp2f(c0[14]); ps += c0[14]; c0[15] = __builtin_amdgcn_exp2f(c0[15]); ps += c0[15]; pwn[7] = pk2(c0[14], c0[15]);
        __builtin_amdgcn_sched_barrier(0);
        kf1 = *(const LAS bf16x8*)(kb_ + 0*32*192 + k5o);
        n0 = __builtin_amdgcn_mfma_f32_32x32x16_bf16(kf2, qf[4], n0, 0, 0, 0);
        c1[0] = __builtin_amdgcn_exp2f(c1[0]); ps += c1[0]; c1[1] = __builtin_amdgcn_exp2f(c1[1]); ps += c1[1]; pwn[8] = pk2(c1[0], c1[1]);
        __builtin_amdgcn_sched_barrier(0);
        kf2 = *(const LAS bf16x8*)(kb_ + 1*32*192 + k5o);
        n1 = __builtin_amdgcn_mfma_f32_32x32x16_bf16(kf0, qf[4], n1, 0, 0, 0);
        c1[2] = __builtin_amdgcn_exp2f(c1[2]); ps += c1[2]; c1[3] = __builtin_amdgcn_exp2f(c1[3]); ps += c1[3]; pwn[9] = pk2(c1[2], c1[3]);
        __builtin_amdgcn_sched_barrier(0);
        n0 = __builtin_amdgcn_mfma_f32_32x32x16_bf16(kf1, qf[5], n0, 0, 0, 0);
        c1[4] = __builtin_amdgcn_exp2f(c1[4]); ps += c1[4]; c1[5] = __builtin_amdgcn_exp2f(c1[5]); ps += c1[5]; pwn[10] = pk2(c1[4], c1[5]);
        __builtin_amdgcn_sched_barrier(0);
        n1 = __builtin_amdgcn_mfma_f32_32x32x16_bf16(kf2, qf[5], n1, 0, 0, 0);
        c1[6] = __builtin_amdgcn_exp2f(c1[6]); ps += c1[6]; c1[7] = __builtin_amdgcn_exp2f(c1[7]); ps += c1[7]; pwn[11] = pk2(c1[6], c1[7]);
        __builtin_amdgcn_sched_barrier(0);
        c1[8] = __builtin_amdgcn_exp2f(c1[8]); ps += c1[8]; c1[9] = __builtin_amdgcn_exp2f(c1[9]); ps += c1[9]; pwn[12] = pk2(c1[8], c1[9]);
        __builtin_amdgcn_sched_barrier(0);
        c1[10] = __builtin_amdgcn_exp2f(c1[10]); ps += c1[10]; c1[11] = __builtin_amdgcn_exp2f(c1[11]); ps += c1[11]; pwn[13] = pk2(c1[10], c1[11]);
        __builtin_amdgcn_sched_barrier(0);
        c1[12] = __builtin_amdgcn_exp2f(c1[12]); ps += c1[12]; c1[13] = __builtin_amdgcn_exp2f(c1[13]); ps += c1[13]; pwn[14] = pk2(c1[12], c1[13]);
        __builtin_amdgcn_sched_barrier(0);
        c1[14] = __builtin_amdgcn_exp2f(c1[14]); ps += c1[14]; c1[15] = __builtin_amdgcn_exp2f(c1[15]); ps += c1[15]; pwn[15] = pk2(c1[14], c1[15]);
        __builtin_amdgcn_sched_barrier(0);
        mxl = fmaxf(n0[0], n1[0]); mxl = fmaxf(fmaxf(mxl, n0[1]), n1[1]); mxl = fmaxf(fmaxf(mxl, n0[2]), n1[2]); mxl = fmaxf(fmaxf(mxl, n0[3]), n1[3]);
        __builtin_amdgcn_sched_barrier(0);
        mxl = fmaxf(fmaxf(mxl, n0[4]), n1[4]); mxl = fmaxf(fmaxf(mxl, n0[5]), n1[5]); mxl = fmaxf(fmaxf(mxl, n0[6]), n1[6]); mxl = fmaxf(fmaxf(mxl, n0[7]), n1[7]);
        __builtin_amdgcn_sched_barrier(0);
        mxl = fmaxf(fmaxf(mxl, n0[8]), n1[8]); mxl = fmaxf(fmaxf(mxl, n0[9]), n1[9]); mxl = fmaxf(fmaxf(mxl, n0[10]), n1[10]); mxl = fmaxf(fmaxf(mxl, n0[11]), n1[11]);
        __builtin_amdgcn_sched_barrier(0);
        mxl = fmaxf(fmaxf(mxl, n0[12]), n1[12]); mxl = fmaxf(fmaxf(mxl, n0[13]), n1[13]); mxl = fmaxf(fmaxf(mxl, n0[14]), n1[14]); mxl = fmaxf(fmaxf(mxl, n0[15]), n1[15]);
        __builtin_amdgcn_sched_barrier(0);
        mxn = fmaxf(mxl, __shfl_xor(mxl, 32));
    } else if constexpr (VAR == 1) {
        bf16x8 kf0, kf1, kf2;
        kf0 = *(const LAS bf16x8*)(kb_ + 0*32*192 + kt16 + 0); kf1 = *(const LAS bf16x8*)(kb_ + 1*32*192 + kt16 + 0);
        u32x2 vf0a, vf0b, vf1a, vf1b, vf2a, vf2b;
        float mxl;
        kf2 = *(const LAS bf16x8*)(kb_ + 0*32*192 + kt16 + 32);
        n0 = __builtin_amdgcn_mfma_f32_32x32x16_bf16(kf0, qf[0], negm, 0, 0, 0);
        c0[0] = __builtin_amdgcn_exp2f(c0[0]); ps += c0[0]; c0[1] = __builtin_amdgcn_exp2f(c0[1]); ps += c0[1]; pwn[0] = pk2(c0[0], c0[1]);
        __builtin_amdgcn_sched_barrier(0);
        kf0 = *(const LAS bf16x8*)(kb_ + 1*32*192 + kt16 + 32);
        n1 = __builtin_amdgcn_mfma_f32_32x32x16_bf16(kf1, qf[0], negm, 0, 0, 0);
        c0[2] = __builtin_amdgcn_exp2f(c0[2]); ps += c0[2]; c0[3] = __builtin_amdgcn_exp2f(c0[3]); ps += c0[3]; pwn[1] = pk2(c0[2], c0[3]);
        __builtin_amdgcn_sched_barrier(0);
        kf1 = *(const LAS bf16x8*)(kb_ + 0*32*192 + kt16 + 64);
        n0 = __builtin_amdgcn_mfma_f32_32x32x16_bf16(kf2, qf[1], n0, 0, 0, 0);
        c0[4] = __builtin_amdgcn_exp2f(c0[4]); ps += c0[4]; c0[5] = __builtin_amdgcn_exp2f(c0[5]); ps += c0[5]; pwn[2] = pk2(c0[4], c0[5]);
        __builtin_amdgcn_sched_barrier(0);
        kf2 = *(const LAS bf16x8*)(kb_ + 1*32*192 + kt16 + 64);
        n1 = __builtin_amdgcn_mfma_f32_32x32x16_bf16(kf0, qf[1], n1, 0, 0, 0);
        c0[6] = __builtin_amdgcn_exp2f(c0[6]); ps += c0[6]; c0[7] = __builtin_amdgcn_exp2f(c0[7]); ps += c0[7]; pwn[3] = pk2(c0[6], c0[7]);
        __builtin_amdgcn_sched_barrier(0);
        kf0 = *(const LAS bf16x8*)(kb_ + 0*32*192 + kt16 + 96);
        n0 = __builtin_amdgcn_mfma_f32_32x32x16_bf16(kf1, qf[2], n0, 0, 0, 0);
        c0[8] = __builtin_amdgcn_exp2f(c0[8]); ps += c0[8]; c0[9] = __builtin_amdgcn_exp2f(c0[9]); ps += c0[9]; pwn[4] = pk2(c0[8], c0[9]);
        __builtin_amdgcn_sched_barrier(0);
        kf1 = *(const LAS bf16x8*)(kb_ + 1*32*192 + kt16 + 96);
        n1 = __builtin_amdgcn_mfma_f32_32x32x16_bf16(kf2, qf[2], n1, 0, 0, 0);
        c0[10] = __builtin_amdgcn_exp2f(c0[10]); ps += c0[10]; c0[11] = __builtin_amdgcn_exp2f(c0[11]); ps += c0[11]; pwn[5] = pk2(c0[10], c0[11]);
        __builtin_amdgcn_sched_barrier(0);
        kf2 = *(const LAS bf16x8*)(kb_ + 0*32*192 + k4o);
        n0 = __builtin_amdgcn_mfma_f32_32x32x16_bf16(kf0, qf[3], n0, 0, 0, 0);
        c0[12] = __builtin_amdgcn_exp2f(c0[12]); ps += c0[12]; c0[13] = __builtin_amdgcn_exp2f(c0[13]); ps += c0[13]; pwn[6] = pk2(c0[12], c0[13]);
        __builtin_amdgcn_sched_barrier(0);
        kf0 = *(const LAS bf16x8*)(kb_ + 1*32*192 + k4o);
        n1 = __builtin_amdgcn_mfma_f32_32x32x16_bf16(kf1, qf[3], n1, 0, 0, 0);
        c0[14] = __builtin_amdgcn_exp2f(c0[14]); ps += c0[14]; c0[15] = __builtin_amdgcn_exp2f(c0[15]); ps += c0[15]; pwn[7] = pk2(c0[14], c0[15]);
        __builtin_amdgcn_sched_barrier(0);
        kf1 = *(const LAS bf16x8*)(kb_ + 0*32*192 + k5o);
        n0 = __builtin_amdgcn_mfma_f32_32x32x16_bf16(kf2, qf[4], n0, 0, 0, 0);
        c1[0] = __builtin_amdgcn_exp2f(c1[0]); ps += c1[0]; c1[1] = __builtin_amdgcn_exp2f(c1[1]); ps += c1[1]; pwn[8] = pk2(c1[0], c1[1]);
        __builtin_amdgcn_sched_barrier(0);
        kf2 = *(const LAS bf16x8*)(kb_ + 1*32*192 + k5o);
        n1 = __builtin_amdgcn_mfma_f32_32x32x16_bf16(kf0, qf[4], n1, 0, 0, 0);
        c1[2] = __builtin_amdgcn_exp2f(c1[2]); ps += c1[2]; c1[3] = __builtin_amdgcn_exp2f(c1[3]); ps += c1[3]; pwn[9] = pk2(c1[2], c1[3]);
        __builtin_amdgcn_sched_barrier(0);
        vf0a = *(const LAS u32x2*)(vb_ + ((0) ^ vsw) * 16); vf0b = *(const LAS u32x2*)(vb_ + ((1) ^ vsw) * 16);
        n0 = __builtin_amdgcn_mfma_f32_32x32x16_bf16(kf1, qf[5], n0, 0, 0, 0);
        c1[4] = __builtin_amdgcn_exp2f(c1[4]); ps += c1[4]; c1[5] = __builtin_amdgcn_exp2f(c1[5]); ps += c1[5]; pwn[10] = pk2(c1[4], c1[5]);
        __builtin_amdgcn_sched_barrier(0);
        vf1a = *(const LAS u32x2*)(vb_ + 32 * 128 + ((0) ^ vsw) * 16); vf1b = *(const LAS u32x2*)(vb_ + 32 * 128 + ((1) ^ vsw) * 16);
        n1 = __builtin_amdgcn_mfma_f32_32x32x16_bf16(kf2, qf[5], n1, 0, 0, 0);
        c1[6] = __builtin_amdgcn_exp2f(c1[6]); ps += c1[6]; c1[7] = __builtin_amdgcn_exp2f(c1[7]); ps += c1[7]; pwn[11] = pk2(c1[6], c1[7]);
        __builtin_amdgcn_sched_barrier(0);
        vf2a = *(const LAS u32x2*)(vb_ + ((2) ^ vsw) * 16); vf2b = *(const LAS u32x2*)(vb_ + ((3) ^ vsw) * 16);
        { const u32x4 pbu = {pwc[0], pwc[1], pwc[2], pwc[3]}; const u32x4 vv = {vf0a.x, vf0a.y, vf0b.x, vf0b.y};
          o0 = __builtin_amdgcn_mfma_f32_32x32x16_bf16(__builtin_bit_cast(bf16x8, vv), __builtin_bit_cast(bf16x8, pbu), o0, 0, 0, 0); }
        c1[8] = __builtin_amdgcn_exp2f(c1[8]); ps += c1[8]; c1[9] = __builtin_amdgcn_exp2f(c1[9]); ps += c1[9]; pwn[12] = pk2(c1[8], c1[9]);
        __builtin_amdgcn_sched_barrier(0);
        vf0a = *(const LAS u32x2*)(vb_ + 32 * 128 + ((2) ^ vsw) * 16); vf0b = *(const LAS u32x2*)(vb_ + 32 * 128 + ((3) ^ vsw) * 16);
        { const u32x4 pbu = {pwc[0], pwc[1], pwc[2], pwc[3]}; const u32x4 vv = {vf1a.x, vf1a.y, vf1b.x, vf1b.y};
          o1 = __builtin_amdgcn_mfma_f32_32x32x16_bf16(__builtin_bit_cast(bf16x8, vv), __builtin_bit_cast(bf16x8, pbu), o1, 0, 0, 0); }
        c1[10] = __builtin_amdgcn_exp2f(c1[10]); ps += c1[10]; c1[11] = __builtin_amdgcn_exp2f(c1[11]); ps += c1[11]; pwn[13] = pk2(c1[10], c1[11]);
        __builtin_amdgcn_sched_barrier(0);
        vf1a = *(const LAS u32x2*)(vb_ + ((4) ^ vsw) * 16); vf1b = *(const LAS u32x2*)(vb_ + ((5) ^ vsw) * 16);
        { const u32x4 pbu = {pwc[4], pwc[5], pwc[6], pwc[7]}; const u32x4 vv = {vf2a.x, vf2a.y, vf2b.x, vf2b.y};
          o0 = __builtin_amdgcn_mfma_f32_32x32x16_bf16(__builtin_bit_cast(bf16x8, vv), __builtin_bit_cast(bf16x8, pbu), o0, 0, 0, 0); }
        c1[12] = __builtin_amdgcn_exp2f(c1[12]); ps += c1[12]; c1[13] = __builtin_amdgcn_exp2f(c1[13]); ps += c1[13]; pwn[14] = pk2(c1[12], c1[13]);
        __builtin_amdgcn_sched_barrier(0);
        vf2a = *(const LAS u32x2*)(vb_ + 32 * 128 + ((4) ^ vsw) * 16); vf2b = *(const LAS u32x2*)(vb_ + 32 * 128 + ((5) ^ vsw) * 16);
        { const u32x4 pbu = {pwc[4], pwc[5], pwc[6], pwc[7]}; const u32x4 vv = {vf0a.x, vf0a.y, vf0b.x, vf0b.y};
          o1 = __builtin_amdgcn_mfma_f32_32x32x16_bf16(__builtin_bit_cast(bf16x8, vv), __builtin_bit_cast(bf16x8, pbu), o1, 0, 0, 0); }
        c1[14] = __builtin_amdgcn_exp2f(c1[14]); ps += c1[14]; c1[15] = __builtin_amdgcn_exp2f(c1[15]); ps += c1[15]; pwn[15] = pk2(c1[14], c1[15]);
        __builtin_amdgcn_sched_barrier(0);
        vf0a = *(const LAS u32x2*)(vb_ + ((6) ^ vsw) * 16); vf0b = *(const LAS u32x2*)(vb_ + ((7) ^ vsw) * 16);
        { const u32x4 pbu = {pwc[8], pwc[9], pwc[10], pwc[11]}; const u32x4 vv = {vf1a.x, vf1a.y, vf1b.x, vf1b.y};
          o0 = __builtin_amdgcn_mfma_f32_32x32x16_bf16(__builtin_bit_cast(bf16x8, vv), __builtin_bit_cast(bf16x8, pbu), o0, 0, 0, 0); }
        mxl = fmaxf(n0[0], n1[0]); mxl = fmaxf(fmaxf(mxl, n0[1]), n1[1]); mxl = fmaxf(fmaxf(mxl, n0[2]), n1[2]); mxl = fmaxf(fmaxf(mxl, n0[3]), n1[3]);
        __builtin_amdgcn_sched_barrier(0);
        vf1a = *(const LAS u32x2*)(vb_ + 32 * 128 + ((6) ^ vsw) * 16); vf1b = *(const LAS u32x2*)(vb_ + 32 * 128 + ((7) ^ vsw) * 16);
        { const u32x4 pbu = {pwc[8], pwc[9], pwc[10], pwc[11]}; const u32x4 vv = {vf2a.x, vf2a.y, vf2b.x, vf2b.y};
          o1 = __builtin_amdgcn_mfma_f32_32x32x16_bf16(__builtin_bit_cast(bf16x8, vv), __builtin_bit_cast(bf16x8, pbu), o1, 0, 0, 0); }
        mxl = fmaxf(fmaxf(mxl, n0[4]), n1[4]); mxl = fmaxf(fmaxf(mxl, n0[5]), n1[5]); mxl = fmaxf(fmaxf(mxl, n0[6]), n1[6]); mxl = fmaxf(fmaxf(mxl, n0[7]), n1[7]);
        __builtin_amdgcn_sched_barrier(0);
        { const u32x4 pbu = {pwc[12], pwc[13], pwc[14], pwc[15]}; const u32x4 vv = {vf0a.x, vf0a.y, vf0b.x, vf0b.y};
          o0 = __builtin_amdgcn_mfma_f32_32x32x16_bf16(__builtin_bit_cast(bf16x8, vv), __builtin_bit_cast(bf16x8, pbu), o0, 0, 0, 0); }
        mxl = fmaxf(fmaxf(mxl, n0[8]), n1[8]); mxl = fmaxf(fmaxf(mxl, n0[9]), n1[9]); mxl = fmaxf(fmaxf(mxl, n0[10]), n1[10]); mxl = fmaxf(fmaxf(mxl, n0[11]), n1[11]);
        __builtin_amdgcn_sched_barrier(0);
        { const u32x4 pbu = {pwc[12], pwc[13], pwc[14], pwc[15]}; const u32x4 vv = {vf1a.x, vf1a.y, vf1b.x, vf1b.y};
          o1 = __builtin_amdgcn_mfma_f32_32x32x16_bf16(__builtin_bit_cast(bf16x8, vv), __builtin_bit_cast(bf16x8, pbu), o1, 0, 0, 0); }
        mxl = fmaxf(fmaxf(mxl, n0[12]), n1[12]); mxl = fmaxf(fmaxf(mxl, n0[13]), n1[13]); mxl = fmaxf(fmaxf(mxl, n0[14]), n1[14]); mxl = fmaxf(fmaxf(mxl, n0[15]), n1[15]);
        __builtin_amdgcn_sched_barrier(0);
        mxn = fmaxf(mxl, __shfl_xor(mxl, 32));
    } else {
        u32x2 vf0a, vf0b, vf1a, vf1b, vf2a, vf2b;
        vf0a = *(const LAS u32x2*)(vb_ + ((0) ^ vsw) * 16); vf0b = *(const LAS u32x2*)(vb_ + ((1) ^ vsw) * 16);
        vf1a = *(const LAS u32x2*)(vb_ + 32 * 128 + ((0) ^ vsw) * 16); vf1b = *(const LAS u32x2*)(vb_ + 32 * 128 + ((1) ^ vsw) * 16);
        vf2a = *(const LAS u32x2*)(vb_ + ((2) ^ vsw) * 16); vf2b = *(const LAS u32x2*)(vb_ + ((3) ^ vsw) * 16);
        { const u32x4 pbu = {pwc[0], pwc[1], pwc[2], pwc[3]}; const u32x4 vv = {vf0a.x, vf0a.y, vf0b.x, vf0b.y};
          o0 = __builtin_amdgcn_mfma_f32_32x32x16_bf16(__builtin_bit_cast(bf16x8, vv), __builtin_bit_cast(bf16x8, pbu), o0, 0, 0, 0); }
        __builtin_amdgcn_sched_barrier(0);
        vf0a = *(const LAS u32x2*)(vb_ + 32 * 128 + ((2) ^ vsw) * 16); vf0b = *(const LAS u32x2*)(vb_ + 32 * 128 + ((3) ^ vsw) * 16);
        { const u32x4 pbu = {pwc[0], pwc[1], pwc[2], pwc[3]}; const u32x4 vv = {vf1a.x, vf1a.y, vf1b.x, vf1b.y};
          o1 = __builtin_amdgcn_mfma_f32_32x32x16_bf16(__builtin_bit_cast(bf16x8, vv), __builtin_bit_cast(bf16x8, pbu), o1, 0, 0, 0); }
        __builtin_amdgcn_sched_barrier(0);
        vf1a = *(const LAS u32x2*)(vb_ + ((4) ^ vsw) * 16); vf1b = *(const LAS u32x2*)(vb_ + ((5) ^ vsw) * 16);
        { const u32x4 pbu = {pwc[4], pwc[5], pwc[6], pwc[7]}; const u32x4 vv = {vf2a.x, vf2a.y, vf2b.x, vf2b.y};
          o0 = __builtin_amdgcn_mfma_f32_32x32x16_bf16(__builtin_bit_cast(bf16x8, vv), __builtin_bit_cast(bf16x8, pbu), o0, 0, 0, 0); }
        __builtin_amdgcn_sched_barrier(0);
        vf2a = *(const LAS u32x2*)(vb_ + 32 * 128 + ((4) ^ vsw) * 16); vf2b = *(const LAS u32x2*)(vb_ + 32 * 128 + ((5) ^ vsw) * 16);
        { const u32x4 pbu = {pwc[4], pwc[5], pwc[6], pwc[7]}; const u32x4 vv = {vf0a.x, vf0a.y, vf0b.x, vf0b.y};
          o1 = __builtin_amdgcn_mfma_f32_32x32x16_bf16(__builtin_bit_cast(bf16x8, vv), __builtin_bit_cast(bf16x8, pbu), o1, 0, 0, 0); }
        __builtin_amdgcn_sched_barrier(0);
        vf0a = *(const LAS u32x2*)(vb_ + ((6) ^ vsw) * 16); vf0b = *(const LAS u32x2*)(vb_ + ((7) ^ vsw) * 16);
        { const u32x4 pbu = {pwc[8], pwc[9], pwc[10], pwc[11]}; const u32x4 vv = {vf1a.x, vf1a.y, vf1b.x, vf1b.y};
          o0 = __builtin_amdgcn_mfma_f32_32x32x16_bf16(__builtin_bit_cast(bf16x8, vv), __builtin_bit_cast(bf16x8, pbu), o0, 0, 0, 0); }
        __builtin_amdgcn_sched_barrier(0);
        vf1a = *(const LAS u32x2*)(vb_ + 32 * 128 + ((6) ^ vsw) * 16); vf1b = *(const LAS u32x2*)(vb_ + 32 * 128 + ((7) ^ vsw) * 16);
        { const u32x4 pbu = {pwc[8], pwc[9], pwc[10], pwc[11]}; const u32x4 vv = {vf2a.x, vf2a.y, vf2b.x, vf2b.y};
          o1 = __builtin_amdgcn_mfma_f32_32x32x16_bf16(__builtin_bit_cast(bf16x8, vv), __builtin_bit_cast(bf16x8, pbu), o1, 0, 0, 0); }
        __builtin_amdgcn_sched_barrier(0);
        { const u32x4 pbu = {pwc[12], pwc[13], pwc[14], pwc[15]}; const u32x4 vv = {vf0a.x, vf0a.y, vf0b.x, vf0b.y};
          o0 = __builtin_amdgcn_mfma_f32_32x32x16_bf16(__builtin_bit_cast(bf16x8, vv), __builtin_bit_cast(bf16x8, pbu), o0, 0, 0, 0); }
        __builtin_amdgcn_sched_barrier(0);
        { const u32x4 pbu = {pwc[12], pwc[13], pwc[14], pwc[15]}; const u32x4 vv = {vf1a.x, vf1a.y, vf1b.x, vf1b.y};
          o1 = __builtin_amdgcn_mfma_f32_32x32x16_bf16(__builtin_bit_cast(bf16x8, vv), __builtin_bit_cast(bf16x8, pbu), o1, 0, 0, 0); }
        __builtin_amdgcn_sched_barrier(0);
    }
}

template <int DUMMY>
__device__ __forceinline__ void phase3q(const P& p, int bid, int nb, LAS unsigned char* lds) {
    const bf16_t* Q = p.slotA; const bf16_t* K = p.slotE; const bf16_t* VT = p.slotF; bf16_t* O = p.slotC;
    const int tid = opaque_tid(), lane = tid & 63, wid = tid >> 6, l31 = lane & 31, hh = lane >> 5;
    constexpr float THR = 8.f;
    const int widu = __builtin_amdgcn_readfirstlane(tid >> 6);
    int koff[3];
#pragma unroll
    for (int i = 0; i < 3; ++i) { const int s = tid + 256 * i, r = s / 12, pc = s % 12, c = (pc + 12 - ((r >> 2) & 3)) % 12; koff[i] = r * 96 + c * 8; }
    const int kt = hh + ((lane >> 2) & 3), kt16 = kt * 16, k4o = (8 + kt >= 12 ? kt - 4 : 8 + kt) * 16, k5o = (10 + kt >= 12 ? kt - 2 : 10 + kt) * 16;
    const int krow = l31 * 192, vsw = (lane >> 1) & 7, vrow = l31 * 128 + 8 * hh;
    for (int iu = 0;; ++iu) {
        const int r = iu * nb + ((iu & 1) ? nb - 1 - bid : bid); if (r >= 1024) break;
        const int qb = 63 - (r >> 4), bh = r & 15, b = bh >> 3, h = bh & 7;
        const int q0 = qb * 128 + wid * 32, ntw = (q0 >> 6) + 1, nt = 2 * qb + 2;
        const bf16_t* Kb = K + (size_t)bh * SEQ * 96; const bf16_t* Vb = VT + (size_t)(h * 64) * NT + (size_t)b * SEQ;
        bf16x8 qf[6]; { const bf16_t* qp = Q + ((size_t)bh * SEQ + q0 + l31) * 96 + hh * 8;
#pragma unroll
            for (int ks = 0; ks < 6; ++ks) qf[ks] = *(const bf16x8*)(qp + ks * 16); }
        f32x16 o0, o1;
#pragma unroll
        for (int e = 0; e < 16; ++e) { o0[e] = 0.f; o1[e] = 0.f; }
        float mrun = 0.f, lsum = 0.f; f32x16 negm;
#pragma unroll
        for (int e = 0; e < 16; ++e) negm[e] = 0.f;
        auto stageK = [&](int j) { LAS unsigned char* d = lds + (j & 1) * 12288 + widu * 1024; const bf16_t* kt = Kb + (size_t)j * 64 * 96;
#pragma unroll
            for (int i = 0; i < 3; ++i) __builtin_amdgcn_global_load_lds((const unsigned*)(kt + koff[i]), (LAS unsigned*)(d + i * 4096), 16, 0, 0); };
        auto stageV = [&](int j) { LAS unsigned char* d = lds + 24576 + (j & 1) * 8192 + widu * 1024; const bf16_t* vt = Vb + j * 64;
#pragma unroll
            for (int i = 0; i < 2; ++i) { const int dv = (tid >> 3) + 32 * i, cl = (tid & 7) ^ ((dv >> 1) & 7);
                __builtin_amdgcn_global_load_lds((const unsigned*)(vt + (size_t)dv * NT + cl * 8), (LAS unsigned*)(d + i * 4096), 16, 0, 0); } };
        f32x16 sA0, sA1, sB0, sB1; unsigned pA[16], pB[16]; float mxA, mxB = 0.f;
#pragma unroll
        for (int e = 0; e < 16; ++e) { pA[e] = 0u; pB[e] = 0u; }
        stageK(0); stageK(1);
        asm volatile("s_waitcnt vmcnt(0)" ::: "memory");
        __syncthreads();
        { const LAS unsigned char* kb_ = lds + krow;
#pragma unroll
          for (int e = 0; e < 16; ++e) { sA0[e] = 0.f; sA1[e] = 0.f; }
#pragma unroll
          for (int ks = 0; ks < 6; ++ks) { const int ko = ks <= 3 ? kt16 + 32 * ks : (ks == 4 ? k4o : k5o); const bf16x8 k0 = *(const LAS bf16x8*)(kb_ + ko); const bf16x8 k1 = *(const LAS bf16x8*)(kb_ + 32 * 192 + ko);
              sA0 = __builtin_amdgcn_mfma_f32_32x32x16_bf16(k0, qf[ks], sA0, 0, 0, 0); sA1 = __builtin_amdgcn_mfma_f32_32x32x16_bf16(k1, qf[ks], sA1, 0, 0, 0); }
          float m = fmaxf(sA0[0], sA1[0]);
#pragma unroll
          for (int e = 1; e < 16; ++e) m = fmaxf(fmaxf(m, sA0[e]), sA1[e]);
          mxA = fmaxf(m, __shfl_xor(m, 32)); }
        auto step = [&](f32x16& c0, f32x16& c1, float& mxc, f32x16& n0, f32x16& n1, float& mxn, const unsigned (&pwc)[16], unsigned (&pwn)[16], int s) {
            asm volatile("s_waitcnt vmcnt(0)" ::: "memory");
            __syncthreads();
            if (s + 2 < nt) stageK(s + 2);
            if (s < nt) stageV(s);
            if (s <= ntw) {
                const LAS unsigned char* kb_ = lds + ((s + 1) & 1) * 12288 + krow; const LAS unsigned char* vb_ = lds + 24576 + ((s + 1) & 1) * 8192 + vrow;
                if (s < ntw) {
                    const bool resc = (s == 0) || !__all(mxc <= THR); float alpha = 1.f;
                    if (resc) { const float dl = (s == 0) ? mxc : fmaxf(mxc, 0.f); alpha = __builtin_amdgcn_exp2f(-dl); mrun += dl;
#pragma unroll
                        for (int e = 0; e < 16; ++e) { c0[e] -= dl; c1[e] -= dl; negm[e] = -mrun; } }
                    float ps = 0.f;
                    if (s == 0) att_step<0>(kb_, vb_, kt16, k4o, k5o, vsw, qf, c0, c1, n0, n1, pwc, pwn, o0, o1, negm, ps, mxn);
                    else att_step<1>(kb_, vb_, kt16, k4o, k5o, vsw, qf, c0, c1, n0, n1, pwc, pwn, o0, o1, negm, ps, mxn);
                    if (resc) {
#pragma unroll
                        for (int e = 0; e < 16; ++e) { o0[e] *= alpha; o1[e] *= alpha; } }
                    lsum = lsum * alpha + ps;
                } else att_step<2>(kb_, vb_, kt16, k4o, k5o, vsw, qf, c0, c1, n0, n1, pwc, pwn, o0, o1, negm, lsum, mxn);
            }
        };
        for (int s = 0; s <= nt; s += 2) { step(sA0, sA1, mxA, sB0, sB1, mxB, pB, pA, s); if (s + 1 <= nt) step(sB0, sB1, mxB, sA0, sA1, mxA, pA, pB, s + 1); }
        const float inv = 1.f / (lsum + __shfl_xor(lsum, 32));
        bf16_t* op = O + (size_t)(b * SEQ + q0 + l31) * 512 + h * 64 + 4 * hh;
#pragma unroll
        for (int g = 0; g < 4; ++g) { uint2 w0, w1;
            w0.x = pk2(o0[4 * g] * inv, o0[4 * g + 1] * inv); w0.y = pk2(o0[4 * g + 2] * inv, o0[4 * g + 3] * inv);
            w1.x = pk2(o1[4 * g] * inv, o1[4 * g + 1] * inv); w1.y = pk2(o1[4 * g + 2] * inv, o1[4 * g + 3] * inv);
            *(uint2*)(op + 8 * g) = w0; *(uint2*)(op + 32 + 8 * g) = w1; }
        __syncthreads();
    }
}

__device__ __forceinline__ void phase4(const P& p, int bid, int nb, LAS unsigned char* lds) {
    const bf16_t* O = p.slotC; const bf16_t* su = p.slotG; const bf16_t* gates = p.slotD; bf16_t* mo = p.slotA;
    const int tid = opaque_tid(), lane = tid & 63, wid = tid >> 6, wr = wid >> 1, wc = wid & 1, fr = lane & 15, fq = lane >> 4;
    const int c8 = ((tid & 7) ^ ((tid >> 3) & 7)) * 8;
    auto ops1 = [&](int rt, int ct) __attribute__((always_inline)) { return gops(O + (size_t)(rt * 128 + (tid >> 3)) * 512 + c8, (size_t)32 * 512, p.WoaT + (size_t)(ct * 128 + (tid >> 3)) * 512 + c8, (size_t)32 * 512); };
    auto ops2 = [&](int rt, int ct) __attribute__((always_inline)) { return gops(su + (size_t)(rt * 128 + (tid >> 3)) * 512 + c8, (size_t)32 * 512, p.WosT + (size_t)(ct * 128 + (tid >> 3)) * 512 + c8, (size_t)32 * 512); };
    int rt, ct; bool have = tile_of(0, bid, nb, NT / 128, DM / 128, rt, ct);
    for (int it = 0; have; ++it) {
        const int row0 = rt * 128, col0 = ct * 128;
        int rt2, ct2; const bool have2 = tile_of(it + 1, bid, nb, NT / 128, DM / 128, rt2, ct2);
        f32x4 acc[4][4];
#pragma unroll
        for (int m = 0; m < 4; ++m)
#pragma unroll
            for (int n = 0; n < 4; ++n) acc[m][n] = (f32x4){0.f, 0.f, 0.f, 0.f};
        uint2 gav[4][4], gbv[4][4];
#pragma unroll
        for (int m = 0; m < 4; ++m)
#pragma unroll
            for (int n = 0; n < 4; ++n) { const int t = row0 + wr * 64 + m * 16 + fr, c = col0 + wc * 64 + n * 16 + fq * 4;
                gav[m][n] = *(const uint2*)(gates + (size_t)t * 2048 + c); gbv[m][n] = *(const uint2*)(gates + (size_t)t * 2048 + 1024 + c); }
        mg_kloop_p(acc, ops1(rt, ct), 8, lds, it > 0, true, ops2(rt, ct));
#pragma unroll
        for (int m = 0; m < 4; ++m)
#pragma unroll
            for (int n = 0; n < 4; ++n) { const f32x4 ga = bf4(gav[m][n]), gb = bf4(gbv[m][n]);
#pragma unroll
                for (int j = 0; j < 4; ++j) acc[m][n][j] *= ga[j] * __builtin_amdgcn_rcpf(gb[j]); }
        mg_kloop_p(acc, ops2(rt, ct), 8, lds, true, have2, ops1(have2 ? rt2 : rt, have2 ? ct2 : ct));
#pragma unroll
        for (int m = 0; m < 4; ++m)
#pragma unroll
            for (int n = 0; n < 4; ++n) { const int t = row0 + wr * 64 + m * 16 + fr, c = col0 + wc * 64 + n * 16 + fq * 4;
                const f32x4 gb = bf4(gbv[m][n]);
                uint2 o; o.x = pk2(gb[0] * acc[m][n][0], gb[1] * acc[m][n][1]); o.y = pk2(gb[2] * acc[m][n][2], gb[3] * acc[m][n][3]); *(uint2*)(mo + (size_t)t * DM + c) = o; }
        rt = rt2; ct = ct2; have = have2;
    }
    __syncthreads();
}

__device__ __forceinline__ void phase5(const P& p, int bid, int nb, LAS unsigned char* lds) {
    const float* x = p.x; float* xm = p.out;
    const int tid = opaque_tid(), lane = tid & 63, wid = tid >> 6, wr = wid >> 1, wc = wid & 1, fr = lane & 15, fq = lane >> 4;
    const int c8 = ((tid & 7) ^ ((tid >> 3) & 7)) * 8;
    int rt, ct; bool have = tile_of(0, bid, nb, NT / 128, DM / 128, rt, ct);
    GOps cur = gops(p.slotA + (size_t)(rt * 128 + (tid >> 3)) * DM + c8, (size_t)32 * DM, p.WoutT + (size_t)(ct * 128 + (tid >> 3)) * DM + c8, (size_t)32 * DM);
    for (int it = 0; have; ++it) {
        const int row0 = rt * 128, col0 = ct * 128;
        int rt2, ct2; const bool have2 = tile_of(it + 1, bid, nb, NT / 128, DM / 128, rt2, ct2);
        const GOps nxt = gops(p.slotA + (size_t)((have2 ? rt2 : rt) * 128 + (tid >> 3)) * DM + c8, (size_t)32 * DM, p.WoutT + (size_t)((have2 ? ct2 : ct) * 128 + (tid >> 3)) * DM + c8, (size_t)32 * DM);
        f32x4 acc[4][4];
#pragma unroll
        for (int m = 0; m < 4; ++m)
#pragma unroll
            for (int n = 0; n < 4; ++n) acc[m][n] = *(const f32x4*)(x + (size_t)(row0 + wr * 64 + m * 16 + fr) * DM + col0 + wc * 64 + n * 16 + fq * 4);
        mg_kloop_p(acc, cur, DM / 64, lds, it > 0, have2, nxt);
#pragma unroll
        for (int m = 0; m < 4; ++m)
#pragma unroll
            for (int n = 0; n < 4; ++n) *(f32x4*)(xm + (size_t)(row0 + wr * 64 + m * 16 + fr) * DM + col0 + wc * 64 + n * 16 + fq * 4) = acc[m][n];
        cur = nxt; rt = rt2; ct = ct2; have = have2;
    }
    __syncthreads();
}

__device__ __forceinline__ void ex_tile(const P& p, int tile, const float*& s0, const float*& s1, size_t& ld, bf16_t*& dst, int& K) {
    bf16_t* WguT = (bf16_t*)p.slotB; bf16_t* WdT = p.slotC + (size_t)NT * 512;
    const int e = tile / 192, tt = tile % 192;
    if (tt < 128) { const int tr = tt >> 4, tk = tt & 15, T = tr >> 1, wc = tr & 1, k0 = tk * 64, c0 = T * 64 + wc * 32;
        s0 = p.w_eg + ((size_t)e * 1024 + k0) * 256 + c0; s1 = p.w_eu + ((size_t)e * 1024 + k0) * 256 + c0; ld = 256; K = 1024;
        dst = WguT + ((size_t)e * 512 + tr * 64) * 1024 + k0; }
    else { const int t2 = tt - 128, tr = t2 >> 2, tk = t2 & 3, k0 = tk * 64, n0 = tr * 64;
        s0 = p.w_ed + ((size_t)e * 256 + k0) * 1024 + n0; s1 = s0 + 32; ld = 1024; K = 256;
        dst = WdT + ((size_t)e * 1024 + n0) * 256 + k0; }
}
__device__ __forceinline__ void expert_conv_pair(const P& p, float* sm, int q, int tid) {
    const int kq = tid >> 4, r4 = (tid & 15) * 4;
    f32x4 v[2][4]; bf16_t* dst[2]; int K[2];
#pragma unroll
    for (int u = 0; u < 2; ++u) { const float* s0; const float* s1; size_t ld; ex_tile(p, 2 * q + u, s0, s1, ld, dst[u], K[u]);
        const float* src = (r4 < 32 ? s0 + r4 : s1 + (r4 - 32));
#pragma unroll
        for (int i = 0; i < 4; ++i) v[u][i] = *(const f32x4*)(src + (size_t)(kq + 16 * i) * ld); }
#pragma unroll
    for (int u = 0; u < 2; ++u) {
#pragma unroll
        for (int i = 0; i < 4; ++i)
#pragma unroll
            for (int j = 0; j < 4; ++j) sm[u * 4160 + (kq + 16 * i) * 65 + r4 + j] = v[u][i][j]; }
    __syncthreads();
#pragma unroll
    for (int u = 0; u < 2; ++u) {
#pragma unroll
        for (int i = 0; i < 4; ++i) { const int rho = kq + 16 * i; const float* bb = sm + u * 4160 + r4 * 65 + rho;
            uint2 o; o.x = pk2(bb[0], bb[65]); o.y = pk2(bb[130], bb[195]); *(uint2*)(dst[u] + (size_t)rho * K[u] + r4) = o; } }
}
constexpr int CONV_PRE = 6, CONV_PAIRS = 3072;
__device__ __forceinline__ void expert_conv_pre(const P& p, float* sm, int bid, int nb) {
    const int tid = opaque_tid();
    if (nb == 512 && bid >= 256) {
#pragma unroll 1
        for (int k = 0; k < CONV_PRE; ++k) { expert_conv_pair(p, sm, (bid - 256) * CONV_PRE + k, tid); __syncthreads(); } }
}
__device__ __forceinline__ void expert_conv(const P& p, float* sm, LAS unsigned char* lds, int nb) {
    const int tid = opaque_tid(); const int q0 = (nb == 512) ? 256 * CONV_PRE : 0;
    volatile LAS int* slot = (volatile LAS int*)(lds + LDS_MAIN_ + 8); unsigned* ctr = WQ_CTR(p.bar, 2);
    if (tid == 0) slot[0] = q0 + (int)__hip_atomic_fetch_add(ctr, 1u, __ATOMIC_RELAXED, __HIP_MEMORY_SCOPE_AGENT);
    __syncthreads();
    int q = slot[0];
    __syncthreads();
    while (q < CONV_PAIRS) {
        int pend = 0; if (tid == 0) pend = q0 + (int)__hip_atomic_fetch_add(ctr, 1u, __ATOMIC_RELAXED, __HIP_MEMORY_SCOPE_AGENT);
        expert_conv_pair(p, sm, q, tid);
        if (tid == 0) slot[0] = pend;
        __syncthreads();
        q = slot[0];
    }
    __syncthreads();
}

__device__ __forceinline__ void phase6(const P& p, int bid, int nb, float* sm) {
    const int tid = opaque_tid(), lane = tid & 63, wid = tid >> 6;
    bf16_t* h2 = p.slotA; const float* xm = p.out;
    int* s_cnt = (int*)sm; int* s_base = s_cnt + 32; int* s_e = s_base + 32; int* s_r = s_e + 128; float* s_w = (float*)(s_r + 128);
    if (tid < 32) s_cnt[tid] = 0;
    __syncthreads();
    int slot = wid * 16;
    float* xs = sm + 512 + wid * 1024;
    f32x4 vpre[4]; f32x4 gf[4];
#pragma unroll
    for (int i = 0; i < 4; ++i) gf[i] = *(const f32x4*)(p.g_ffn + (lane + 64 * i) * 4);
    if (bid * 4 + wid < NT) {
#pragma unroll
        for (int i = 0; i < 4; ++i) vpre[i] = *(const f32x4*)(xm + (size_t)(bid * 4 + wid) * DM + (lane + 64 * i) * 4); }
    for (int t = bid * 4 + wid; t < NT; t += nb * 4, ++slot) {
        f32x4 v[4]; float ss = 0.f;
#pragma unroll
        for (int i = 0; i < 4; ++i) { v[i] = vpre[i]; ss += v[i][0] * v[i][0] + v[i][1] * v[i][1] + v[i][2] * v[i][2] + v[i][3] * v[i][3]; }
        if (t + nb * 4 < NT) {
#pragma unroll
            for (int i = 0; i < 4; ++i) vpre[i] = *(const f32x4*)(xm + (size_t)(t + nb * 4) * DM + (lane + 64 * i) * 4); }
        ss = wsumf(ss); const float r = rsqrtf(ss * (1.f / DM) + EPS);
#pragma unroll
        for (int i = 0; i < 4; ++i) { const f32x4 g = gf[i]; v[i] = v[i] * r * g; *(f32x4*)(xs + (lane + 64 * i) * 4) = v[i];
            uint2 o; o.x = pk2(v[i][0], v[i][1]); o.y = pk2(v[i][2], v[i][3]); *(uint2*)(h2 + (size_t)t * DM + (lane + 64 * i) * 4) = o; }
        f32x4 lgv = {0.f, 0.f, 0.f, 0.f};
#pragma unroll
        for (int i = 0; i < 16; ++i) { const int k = lane + 64 * i; lgv += xs[k] * *(const f32x4*)(p.w_rg + (size_t)k * 4); }
        float lg[4];
#pragma unroll
        for (int g = 0; g < 4; ++g) lg[g] = wsumf(lgv[g]) + p.b_rg[g];
        int gs = 0; float gm = lg[0];
#pragma unroll
        for (int g = 1; g < 4; ++g) if (lg[g] > gm) { gm = lg[g]; gs = g; }
        float den = 0.f;
#pragma unroll
        for (int g = 0; g < 4; ++g) den += __expf(lg[g] - gm);
        const float ptop = 1.f / den;
        f32x4 lev = {0.f, 0.f, 0.f, 0.f}; const float* wre = p.w_re + (size_t)gs * DM * 8;
#pragma unroll 16
        for (int i = 0; i < 32; ++i) { const int c = lane + 64 * i; lev += xs[c >> 1] * *(const f32x4*)(wre + (size_t)c * 4); }
        float le[8];
#pragma unroll
        for (int e = 0; e < 4; ++e) { const float mine = wsum_par(lev[e]), oth = DPP_F(mine, 0xB1); le[e] = mine + p.b_re[gs * 8 + e]; le[4 + e] = oth + p.b_re[gs * 8 + 4 + e]; }
        int e1 = 0; float l1 = le[0];
#pragma unroll
        for (int e = 1; e < 8; ++e) if (le[e] > l1) { l1 = le[e]; e1 = e; }
        int e2 = -1; float l2 = -3.0e38f;
#pragma unroll
        for (int e = 0; e < 8; ++e) if (e != e1 && le[e] > l2) { l2 = le[e]; e2 = e; }
        const float s1 = 1.f / (1.f + __expf(l2 - l1)), s2 = 1.f - s1;
        if (lane == 0) {
            const int ea = gs * 8 + e1, eb = gs * 8 + e2;
            s_e[2 * slot] = ea; s_e[2 * slot + 1] = eb; s_r[2 * slot] = atomicAdd(&s_cnt[ea], 1); s_r[2 * slot + 1] = atomicAdd(&s_cnt[eb], 1);
            s_w[2 * slot] = s1 * ptop; s_w[2 * slot + 1] = s2 * ptop;
        }
    }
    __syncthreads();
    if (tid < 32) { const int c = s_cnt[tid]; s_base[tid] = c ? atomicAdd(&p.cnt[tid], c) : 0; }
    __syncthreads();
    if (tid < 128) { const int sl = tid >> 1, kk = tid & 1, w = sl >> 4, k = sl & 15, t = bid * 4 + w + k * nb * 4;
        if (t < NT) { const int a = 2 * t + kk, e = s_e[tid]; p.list[(size_t)e * NT + s_base[e] + s_r[tid]] = a; p.aw[a] = s_w[tid]; p.aexp[a] = e; } }
    __syncthreads();
}

__device__ __forceinline__ void build_expert_table(const int* cnt, volatile LAS int* tab) {
    const int tid = threadIdx.x;
    if (tid < 64) { const int c = tid < NE ? cnt[tid] : 0; int n = (c + 127) >> 7, incl = n;
#pragma unroll
        for (int o = 1; o < 32; o <<= 1) { const int y = __shfl_up(incl, o); if ((tid & 63) >= o) incl += y; }
        if (tid < NE) { tab[tid] = incl - n; tab[32 + tid] = c; } if (tid == NE - 1) tab[64] = incl; }
    __syncthreads();
}
__device__ __forceinline__ bool find_expert(volatile LAS int* tab, int ub, int& e, int& blk, int& ce) {
    if (ub >= tab[64]) return false;
    int lo = 0;
#pragma unroll
    for (int st = 16; st > 0; st >>= 1) if (tab[lo + st] <= ub) lo += st;
    e = lo; blk = ub - tab[lo]; ce = tab[32 + lo]; return true;
}
__device__ __forceinline__ void phase7a_m(const P& p, int bid, int nb, LAS unsigned char* lds) {
    const bf16_t* h2 = p.slotA; const bf16_t* WguT = (const bf16_t*)p.slotB; bf16_t* hid = p.slotE;
    const int tid = opaque_tid(), lane = tid & 63, wid = tid >> 6, wr = wid >> 1, wc = wid & 1, fr = lane & 15, fq = lane >> 4;
    const int c8 = ((tid & 7) ^ ((tid >> 3) & 7)) * 8;
    volatile LAS int* tab = (volatile LAS int*)(lds + LDS_TAB_); build_expert_table(p.cnt, tab);
    auto make = [&](int u, GOps& g) __attribute__((always_inline)) -> bool {
        int e, blk, ce; if (!find_expert(tab, u >> 2, e, blk, ce)) return false;
        const int ct = u & 3; const int* lst = p.list + (size_t)e * NT; const bf16_t* ap[4];
#pragma unroll
        for (int i = 0; i < 4; ++i) { int r = blk * 128 + (tid >> 3) + 32 * i; r = r < ce ? r : ce - 1; ap[i] = h2 + (size_t)(lst[r] >> 1) * DM + c8; }
        g.a0 = ap[0]; g.a1 = ap[1]; g.a2 = ap[2]; g.a3 = ap[3]; g.bp = WguT + ((size_t)e * 512 + ct * 128 + (tid >> 3)) * 1024 + c8; g.bstep = (size_t)32 * 1024; return true; };
    GOps cur; bool have = make(bid, cur);
    for (int u = bid, it = 0; have; u += nb, ++it) {
        GOps nxt = cur; const bool have2 = make(u + nb, nxt);
        f32x4 acc[4][4];
#pragma unroll
        for (int m = 0; m < 4; ++m)
#pragma unroll
            for (int n = 0; n < 4; ++n) acc[m][n] = (f32x4){0.f, 0.f, 0.f, 0.f};
        mg_kloop_p(acc, cur, 16, lds, it > 0, have2, nxt);
        const int ct = u & 3;
        bf16_t* hb = hid + ((size_t)(u >> 2) * 128 + wr * 64 + fr) * 256 + ct * 64 + wc * 32 + fq * 4;
#pragma unroll
        for (int m = 0; m < 4; ++m)
#pragma unroll
            for (int n = 0; n < 2; ++n) { float v[4];
#pragma unroll
                for (int j = 0; j < 4; ++j) { const float g = acc[m][n][j]; v[j] = g * fsigmoid(g) * acc[m][n + 2][j]; }
                uint2 o; o.x = pk2(v[0], v[1]); o.y = pk2(v[2], v[3]); *(uint2*)(hb + (size_t)(m * 16) * 256 + n * 16) = o; }
        cur = nxt; have = have2;
    }
    __syncthreads();
}
__device__ __forceinline__ void phase7b_m(const P& p, int bid, int nb, LAS unsigned char* lds) {
    const bf16_t* hid = p.slotE; const bf16_t* WdT = p.slotC + (size_t)NT * 512; bf16_t* Y = p.slotD;
    const int tid = opaque_tid(), lane = tid & 63, wid = tid >> 6, wr = wid >> 1, wc = wid & 1, fr = lane & 15, fq = lane >> 4;
    const int c8 = ((tid & 7) ^ ((tid >> 3) & 7)) * 8;
    int e, blk, ce;
    volatile LAS int* tab = (volatile LAS int*)(lds + LDS_TAB_); build_expert_table(p.cnt, tab);
    auto make = [&](int u, GOps& g, int& e_, int& blk_, int& ce_) __attribute__((always_inline)) -> bool {
        if (!find_expert(tab, u >> 3, e_, blk_, ce_)) return false;
        g = gops(hid + ((size_t)(u >> 3) * 128 + (tid >> 3)) * 256 + c8, (size_t)32 * 256, WdT + ((size_t)e_ * 1024 + (u & 7) * 128 + (tid >> 3)) * 256 + c8, (size_t)32 * 256); return true; };
    GOps cur; bool have = make(bid, cur, e, blk, ce);
    for (int u = bid, it = 0; have; u += nb, ++it) {
        GOps nxt = cur; int e2 = 0, blk2 = 0, ce2 = 0; const bool have2 = make(u + nb, nxt, e2, blk2, ce2);
        const int ct = u & 7; const int* lst = p.list + (size_t)e * NT;
        f32x4 acc[4][4];
#pragma unroll
        for (int m = 0; m < 4; ++m)
#pragma unroll
            for (int n = 0; n < 4; ++n) acc[m][n] = (f32x4){0.f, 0.f, 0.f, 0.f};
        mg_kloop_p(acc, cur, 4, lds, it > 0, have2, nxt);
#pragma unroll
        for (int m = 0; m < 4; ++m) { const int r = blk * 128 + wr * 64 + m * 16 + fr;
            if (r < ce) { const int a = lst[r]; const float w = p.aw[a]; bf16_t* yp = Y + (size_t)a * DM + ct * 128 + wc * 64 + fq * 4;
#pragma unroll
                for (int n = 0; n < 4; ++n) { uint2 o; o.x = pk2(acc[m][n][0] * w, acc[m][n][1] * w); o.y = pk2(acc[m][n][2] * w, acc[m][n][3] * w); *(uint2*)(yp + n * 16) = o; } } }
        cur = nxt; e = e2; blk = blk2; ce = ce2; have = have2;
    }
    __syncthreads();
}

__device__ __forceinline__ void phase8(const P& p, int bid, int nb, float* dst) {
    const int tid = opaque_tid(), lane = tid & 63, wid = tid >> 6; const bf16_t* Y = p.slotD;
    for (int t = bid * 4 + wid; t < NT; t += nb * 4) {
        f32x4 v[4]; float ss = 0.f;
#pragma unroll
        for (int i = 0; i < 4; ++i) { const int c = (lane + 64 * i) * 4;
            v[i] = *(const f32x4*)(p.out + (size_t)t * DM + c) + bf4(*(const uint2*)(Y + (size_t)(2 * t) * DM + c)) + bf4(*(const uint2*)(Y + (size_t)(2 * t + 1) * DM + c));
            ss += v[i][0] * v[i][0] + v[i][1] * v[i][1] + v[i][2] * v[i][2] + v[i][3] * v[i][3]; }
        ss = wsumf(ss); const float r = rsqrtf(ss * (1.f / DM) + EPS);
#pragma unroll
        for (int i = 0; i < 4; ++i) { const int c = (lane + 64 * i) * 4; const f32x4 g = *(const f32x4*)(p.g_final + c); *(f32x4*)(dst + (size_t)t * DM + c) = v[i] * r * g; }
    }
}

#define XB_TMO      128
#define XB_XCNT(j)  (256  + 64 * (j))
#define XB_XSUB(j)  (1280 + 64 * (j))
#define XB_XGEN(j)  (2304 + 64 * (j))
#define XB_TOP      3328
#define XB_TOPGEN   3392
#define XCD_BAR_WORDS 3456
#define XB_SPIN_CAP (1u << 18)
__device__ __forceinline__ unsigned xb_ld(unsigned* p)              { return __hip_atomic_load(p, __ATOMIC_RELAXED, __HIP_MEMORY_SCOPE_AGENT); }
__device__ __forceinline__ unsigned xb_add(unsigned* p, unsigned v) { return __hip_atomic_fetch_add(p, v, __ATOMIC_RELAXED, __HIP_MEMORY_SCOPE_AGENT); }
__device__ __forceinline__ unsigned xb_xcc_id() { return (unsigned)__builtin_amdgcn_s_getreg((3 << 11) | 20) & 0xFu; }
#define XB_SPIN(cond, bar) do { unsigned _sp = 0; while (cond) { __builtin_amdgcn_s_sleep(1); \
    if ((++_sp & 255u) == 0u) { if (xb_ld(&(bar)[XB_TMO])) break; if (_sp > XB_SPIN_CAP) { atomicAdd(&(bar)[XB_TMO], 1u); break; } } } } while (0)
struct XcdBarrier { unsigned* bar; unsigned x; volatile LAS unsigned* st; };
__device__ __forceinline__ XcdBarrier xcd_barrier_post(unsigned* bar, volatile LAS unsigned* st) {
    XcdBarrier b; b.bar = bar; b.x = xb_xcc_id(); b.st = st;
    if (threadIdx.x == 0) (void)xb_add(&bar[XB_XCNT(b.x)], 1u);
    return b;
}
__device__ __forceinline__ void xcd_barrier_complete(unsigned* bar, unsigned x, unsigned& nloc, unsigned& nx) {
    const unsigned G = gridDim.x * gridDim.y * gridDim.z;
    unsigned sum, cnt, mine, sp = 0u;
    for (;;) {
        sum = 0u; cnt = 0u; mine = 0u;
#pragma unroll
        for (unsigned j = 0; j < 16; ++j) { const unsigned c = xb_ld(&bar[XB_XCNT(j)]); sum += c; cnt += (c > 0u) ? 1u : 0u; mine = (j == x) ? c : mine; }
        if (sum == G) break;
        __builtin_amdgcn_s_sleep(1);
        if ((++sp & 255u) == 0u) { if (xb_ld(&bar[XB_TMO])) break; if (sp > XB_SPIN_CAP) { atomicAdd(&bar[XB_TMO], 1u); break; } }
    }
    nloc = mine > 0u ? mine : 1u; nx = cnt > 0u ? cnt : 1u;
}
__device__ __forceinline__ void xcd_barrier(const XcdBarrier& b) {
    asm volatile("s_waitcnt vmcnt(0)" ::: "memory");
    __syncthreads();
    if (threadIdx.x == 0) {
        unsigned* bar = b.bar;
        __builtin_amdgcn_s_waitcnt(0);
        unsigned nloc = b.st[0], nx = b.st[1];
        if (nloc == 0u) { xcd_barrier_complete(bar, b.x, nloc, nx); b.st[0] = nloc; b.st[1] = nx; }
        const unsigned old = xb_add(&bar[XB_XSUB(b.x)], 1u);
        const unsigned gen = old / nloc;
        if (old + 1u == (gen + 1u) * nloc) {
            __builtin_amdgcn_fence(__ATOMIC_RELEASE, "agent");
            asm volatile("s_waitcnt vmcnt(0)" ::: "memory");
            const unsigned og = xb_add(&bar[XB_TOP], 1u);
            const unsigned tg = og / nx;
            if (og + 1u == (tg + 1u) * nx) xb_add(&bar[XB_TOPGEN], 1u);
            else XB_SPIN(xb_ld(&bar[XB_TOPGEN]) == tg, bar);
            __builtin_amdgcn_fence(__ATOMIC_ACQUIRE, "agent");
            xb_add(&bar[XB_XGEN(b.x)], 1u);
            asm volatile("s_waitcnt vmcnt(0)" ::: "memory");
        } else {
            XB_SPIN(xb_ld(&bar[XB_XGEN(b.x)]) == gen, bar);
            __builtin_amdgcn_fence(__ATOMIC_ACQUIRE, "agent");
            asm volatile("s_waitcnt vmcnt(0)" ::: "memory");
        }
    }
    __syncthreads();
}

constexpr int LDS_MAIN = 64 * 1024;
constexpr int LDS_BYTES = LDS_MAIN + 16 + 288;
extern __shared__ __attribute__((aligned(16))) unsigned char smem_raw[];


__global__ void __launch_bounds__(256, 2) k_mega(P p) {
    float* sm = (float*)smem_raw; LAS unsigned char* lds = (LAS unsigned char*)smem_raw; const int bid = blockIdx.x, nb = gridDim.x;
    volatile LAS unsigned* st = (volatile LAS unsigned*)(lds + LDS_MAIN);
    if (threadIdx.x < 4) st[threadIdx.x] = 0u;
    __syncthreads();
    const XcdBarrier gb = xcd_barrier_post(p.bar, st);
    phase0(p, bid, nb, sm); xcd_barrier(gb);
    phase1(p, bid, nb, lds); xcd_barrier(gb);
    rope_rows(p, bid, nb); phase2b(p, bid, nb, lds); phase2c_m(p, bid, nb, lds); xcd_barrier(gb);
    expert_conv_pre(p, sm, bid, nb); phase3q<0>(p, bid, nb, lds); expert_conv(p, sm, lds, nb); xcd_barrier(gb);
    phase4(p, bid, nb, lds); xcd_barrier(gb);
    phase5(p, bid, nb, lds); xcd_barrier(gb);
    phase6(p, bid, nb, sm); xcd_barrier(gb);
    phase7a_m(p, bid, nb, lds); xcd_barrier(gb);
    phase7b_m(p, bid, nb, lds); xcd_barrier(gb);
    phase8(p, bid, nb, p.out);
}

extern "C" void kernel_launch(void* const* d_in, const int* in_sizes, int n_in, void* d_out, int out_size, void* d_ws, size_t ws_size, hipStream_t stream) {
    P p{};
    p.x = (const float*)d_in[0]; p.pos = (const int*)d_in[1]; p.g_attn = (const float*)d_in[2]; p.w_in = (const float*)d_in[3]; p.g_cq = (const float*)d_in[4];
    p.w_uq = (const float*)d_in[5]; p.g_ckv = (const float*)d_in[6]; p.w_uk = (const float*)d_in[7]; p.w_uv = (const float*)d_in[8]; p.w_o_attn = (const float*)d_in[9];
    p.sgu_gain = (const float*)d_in[10]; p.sgu_bias = (const float*)d_in[11]; p.w_sp = (const float*)d_in[12]; p.b_sp = (const float*)d_in[13]; p.w_o_sgu = (const float*)d_in[14];
    p.w_out = (const float*)d_in[15]; p.g_ffn = (const float*)d_in[16]; p.w_rg = (const float*)d_in[17]; p.b_rg = (const float*)d_in[18]; p.w_re = (const float*)d_in[19];
    p.b_re = (const float*)d_in[20]; p.w_eg = (const float*)d_in[21]; p.w_eu = (const float*)d_in[22]; p.w_ed = (const float*)d_in[23]; p.g_final = (const float*)d_in[24];
    p.out = (float*)d_out;
    unsigned char* w = (unsigned char*)d_ws; size_t off = 0;
    auto take = [&](size_t bytes) { unsigned char* r = w + off; off += (bytes + 255) & ~(size_t)255; return r; };
    p.bar = (unsigned*)take((XCD_BAR_WORDS + 256) * 4);
    p.cnt = (int*)take(4096);
    p.WinT = (bf16_t*)take((size_t)ZP * DM * 2); p.WuqT = (bf16_t*)take(768 * 256 * 2); p.WukT = (bf16_t*)take(512 * 128 * 2); p.WuvT = (bf16_t*)take(512 * 128 * 2);
    p.WoaT = (bf16_t*)take(1024 * 512 * 2); p.WosT = (bf16_t*)take(1024 * 512 * 2); p.WoutT = (bf16_t*)take(1024 * 1024 * 2); p.Wsp = (bf16_t*)take(8 * 128 * 128 * 2);
    p.cs = (float*)take((size_t)NT * 32 * 4); p.stat = (float*)take((size_t)4 * NT * 4); p.cqn = (bf16_t*)take((size_t)NT * 256 * 2); p.ckvn = (bf16_t*)take((size_t)NT * 128 * 2);
    p.list = (int*)take((size_t)NE * NT * 4); p.aw = (float*)take((size_t)2 * NT * 4); p.aexp = (int*)take((size_t)2 * NT * 4);
    p.slotA = (bf16_t*)take((size_t)NT * DM * 2);
    p.slotB = take((size_t)NT * 512 * 4);
    p.slotC = (bf16_t*)take((size_t)NT * 1024 * 2);
    p.slotD = (bf16_t*)take((size_t)NT * 2048 * 2);
    p.slotE = (bf16_t*)take((size_t)NT * NH * 96 * 2);
    p.slotF = (bf16_t*)take((size_t)512 * NT * 2);
    p.slotG = (bf16_t*)take((size_t)NT * 512 * 2);
    if (off > ws_size) { fprintf(stderr, "workspace too small: need %zu have %zu\n", off, ws_size); return; }
    static int grid_blocks = 0;
    if (!grid_blocks) { int dev = 0, cus = 0, per_cu = 0; hipGetDevice(&dev); hipDeviceGetAttribute(&cus, hipDeviceAttributeMultiprocessorCount, dev);
        hipOccupancyMaxActiveBlocksPerMultiprocessor(&per_cu, k_mega, 256, LDS_BYTES); if (per_cu > 2) per_cu = 2; grid_blocks = cus * per_cu; }
    (void)hipMemsetAsync(p.bar, 0, (XCD_BAR_WORDS + 256) * 4, stream);
    void* args[] = {&p};
    hipError_t e = hipLaunchCooperativeKernel((void*)k_mega, dim3(grid_blocks), dim3(256), args, LDS_BYTES, stream);
    if (e != hipSuccess) fprintf(stderr, "cooperative launch failed: %s (grid %d)\n", hipGetErrorString(e), grid_blocks);
}
```

```cpp
#include <hip/hip_runtime.h>
#include <hip/hip_cooperative_groups.h>
#include <cstdint>
#include <cstdio>
namespace cg = cooperative_groups;


typedef unsigned short bf16_t;
constexpr int NT = 16384, SEQ = 8192, DM = 1024, NBATCH = 2;
constexpr int ZC = 3488;
constexpr int ZP = 3584;
constexpr int NH = 8;
constexpr float EPS = 1e-6f;
constexpr int NE = 32;
#define WQ_CTR(bar, k) ((bar) + 3456 + 64 + 16 * (k))
constexpr int LDS_MAIN_ = 64 * 1024;
constexpr int LDS_TAB_ = 64 * 1024 + 16;

struct P {
    const float* x; const int* pos; const float* g_attn; const float* w_in; const float* g_cq; const float* w_uq;
    const float* g_ckv; const float* w_uk; const float* w_uv; const float* w_o_attn; const float* sgu_gain; const float* sgu_bias;
    const float* w_sp; const float* b_sp; const float* w_o_sgu; const float* w_out; const float* g_ffn; const float* w_rg;
    const float* b_rg; const float* w_re; const float* b_re; const float* w_eg; const float* w_eu; const float* w_ed; const float* g_final;
    float* out;
    unsigned* bar;
    int* cnt;
    bf16_t* WinT;
    bf16_t* WuqT;
    bf16_t* WukT;
    bf16_t* WuvT;
    bf16_t* WoaT;
    bf16_t* WosT;
    bf16_t* WoutT;
    bf16_t* Wsp;
    float* cs;
    float* stat;
    bf16_t* cqn;
    bf16_t* ckvn;
    int* list;
    float* aw;
    int* aexp;
    bf16_t* slotA;
    unsigned char* slotB;
    bf16_t* slotC;
    bf16_t* slotD;
    bf16_t* slotE;
    bf16_t* slotF;
    bf16_t* slotG;
};

__device__ __forceinline__ int opaque_tid() { int t = threadIdx.x; asm volatile("" : "+v"(t)); return t; }
__device__ __forceinline__ float bf2f(bf16_t v) { return __uint_as_float(((unsigned)v) << 16); }
__device__ __forceinline__ bf16_t f2bf(float f) { unsigned u = __float_as_uint(f); u += 0x7fffu + ((u >> 16) & 1u); return (bf16_t)(u >> 16); }

#define DPP_F(v, ctrl) __builtin_bit_cast(float, __builtin_amdgcn_update_dpp(0, __builtin_bit_cast(int, (v)), (ctrl), 0xF, 0xF, true))
__device__ __forceinline__ float xrows(float v) {
    { const auto r = __builtin_amdgcn_permlane16_swap(__float_as_uint(v), __float_as_uint(v), false, false); v = __uint_as_float(r[0]) + __uint_as_float(r[1]); }
    { const auto r = __builtin_amdgcn_permlane32_swap(__float_as_uint(v), __float_as_uint(v), false, false); v = __uint_as_float(r[0]) + __uint_as_float(r[1]); }
    return v;
}
__device__ __forceinline__ float wsumf(float v) {
    v += DPP_F(v, 0xB1); v += DPP_F(v, 0x4E); v += DPP_F(v, 0x141); v += DPP_F(v, 0x140); return xrows(v);
}
__device__ __forceinline__ float wsum_par(float v) {
    v += DPP_F(v, 0x128); v += DPP_F(v, 0x124); v += DPP_F(v, 0x122); return xrows(v);
}
__device__ __forceinline__ float fsigmoid(float v) { return __builtin_amdgcn_rcpf(1.f + __builtin_amdgcn_exp2f(-1.4426950408889634f * v)); }
__device__ __forceinline__ float fgelu(float v) { const float u2 = 1.5957691216057308f * (v + 0.044715f * v * v * v); return v * fsigmoid(u2); }

#define LAS __attribute__((address_space(3)))
typedef short bf16x8 __attribute__((ext_vector_type(8)));
typedef float f32x4 __attribute__((ext_vector_type(4)));
constexpr int GEMM_LDS = 65536;
typedef float f32x16 __attribute__((ext_vector_type(16)));
typedef unsigned u32x2 __attribute__((ext_vector_type(2)));
typedef unsigned u32x4 __attribute__((ext_vector_type(4)));
typedef __bf16 bf16v2 __attribute__((ext_vector_type(2)));
typedef float f32v2 __attribute__((ext_vector_type(2)));
__device__ __forceinline__ unsigned pk2(float lo, float hi) { const f32v2 v = {lo, hi}; return __builtin_bit_cast(unsigned, __builtin_convertvector(v, bf16v2)); }
__device__ __forceinline__ f32x4 bf4(const uint2 u) { return (f32x4){__uint_as_float(u.x << 16), __uint_as_float(u.x & 0xffff0000u), __uint_as_float(u.y << 16), __uint_as_float(u.y & 0xffff0000u)}; }


template <class F>
__device__ __forceinline__ int tconv(bf16_t* dst, int R, int K, F f, int base, int bid, int nb, float* sm) {
    const int tid = opaque_tid(), tk = K / 64, ntile = (R / 64) * tk;
    for (int tile = ((bid - base) % nb + nb) % nb; tile < ntile; tile += nb) {
        const int rho0 = (tile / tk) * 64, k0 = (tile % tk) * 64;
#pragma unroll
        for (int i = 0; i < 16; ++i) { const int kk = (tid >> 6) + 4 * i, rr = tid & 63; sm[kk * 65 + rr] = f(k0 + kk, rho0 + rr); }
        __syncthreads();
#pragma unroll
        for (int i = 0; i < 8; ++i) { const int rr = (tid >> 5) + 8 * i, kk = (tid & 31) * 2;
            *(unsigned*)(dst + (size_t)(rho0 + rr) * K + k0 + kk) = pk2(sm[kk * 65 + rr], sm[(kk + 1) * 65 + rr]); }
        __syncthreads();
    }
    return base + ntile;
}

__device__ __forceinline__ void phase0(const P& p, int bid, int nb, float* sm) {
    const int tid = opaque_tid(), lane = tid & 63, wid = tid >> 6;
    const size_t gtid = (size_t)bid * 256 + tid, gsz = (size_t)nb * 256;
    if (bid == 0 && tid < NE) p.cnt[tid] = 0;
    for (size_t i = (size_t)bid * 256 + tid; i < (size_t)4 * NT; i += (size_t)nb * 256) p.stat[i] = 0.f;
    { int t = bid * 4 + wid; f32x4 v[4];
      if (t < NT) {
#pragma unroll
          for (int i = 0; i < 4; ++i) v[i] = *(const f32x4*)(p.x + (size_t)t * DM + (lane + 64 * i) * 4); }
      for (; t < NT; t += nb * 4) {
          const int tn = t + nb * 4; f32x4 vn[4];
          if (tn < NT) {
#pragma unroll
              for (int i = 0; i < 4; ++i) vn[i] = *(const f32x4*)(p.x + (size_t)tn * DM + (lane + 64 * i) * 4); }
          float ss = 0.f;
#pragma unroll
          for (int i = 0; i < 4; ++i) ss += v[i][0] * v[i][0] + v[i][1] * v[i][1] + v[i][2] * v[i][2] + v[i][3] * v[i][3];
          ss = wsumf(ss); const float r = rsqrtf(ss * (1.f / DM) + EPS);
          bf16_t* hr = p.slotA + (size_t)t * DM;
#pragma unroll
          for (int i = 0; i < 4; ++i) { uint2 o; o.x = pk2(v[i][0] * r, v[i][1] * r); o.y = pk2(v[i][2] * r, v[i][3] * r); *(uint2*)(hr + (lane + 64 * i) * 4) = o; }
#pragma unroll
          for (int i = 0; i < 4; ++i) v[i] = vn[i];
      } }
    { const int kq = tid >> 4, r4 = (tid & 15) * 4;
      for (int t0 = bid; t0 < 1408; t0 += 2 * nb) {
          f32x4 v[2][4]; bf16_t* dst[2]; int Kd[2]; const int nt = (t0 + nb < 1408) ? 2 : 1;
#pragma unroll
          for (int u = 0; u < 2; ++u) if (u < nt) { const int tile = t0 + u * nb; const float* src; size_t ld; const float* gain = nullptr; bool zero = false;
              if (tile < 896) { const int tr = tile >> 4, k0 = (tile & 15) * 64, rho0 = tr * 64; const int col0 = rho0 < 512 ? rho0 : rho0 - 96;
                  zero = (rho0 == 448) || (rho0 == 384 && r4 >= 32);
                  src = p.w_in + (size_t)k0 * ZC + col0 + r4; ld = ZC; gain = p.g_attn + k0; dst[u] = p.WinT + (size_t)rho0 * DM + k0; Kd[u] = DM; }
              else if (tile < 1152) { const int t2 = tile - 896, w = t2 >> 7, t3 = t2 & 127, n0 = (t3 >> 3) * 64, k0 = (t3 & 7) * 64;
                  src = (w ? p.w_o_sgu : p.w_o_attn) + (size_t)k0 * 1024 + n0 + r4; ld = 1024; dst[u] = (w ? p.WosT : p.WoaT) + (size_t)n0 * 512 + k0; Kd[u] = 512; }
              else { const int t2 = tile - 1152, n0 = (t2 >> 4) * 64, k0 = (t2 & 15) * 64; src = p.w_out + (size_t)k0 * 1024 + n0 + r4; ld = 1024; dst[u] = p.WoutT + (size_t)n0 * 1024 + k0; Kd[u] = 1024; }
#pragma unroll
              for (int i = 0; i < 4; ++i) { const int kk = kq + 16 * i; f32x4 x = zero ? (f32x4){0.f, 0.f, 0.f, 0.f} : *(const f32x4*)(src + (size_t)kk * ld); if (gain) x = x * gain[kk]; v[u][i] = x; } }
#pragma unroll
          for (int u = 0; u < 2; ++u) if (u < nt) {
#pragma unroll
              for (int i = 0; i < 4; ++i)
#pragma unroll
                  for (int j = 0; j < 4; ++j) sm[u * 4160 + (kq + 16 * i) * 65 + r4 + j] = v[u][i][j]; }
          __syncthreads();
#pragma unroll
          for (int u = 0; u < 2; ++u) if (u < nt) {
#pragma unroll
              for (int i = 0; i < 4; ++i) { const int rho = kq + 16 * i; const float* bb = sm + u * 4160 + r4 * 65 + rho;
                  uint2 o; o.x = pk2(bb[0], bb[65]); o.y = pk2(bb[130], bb[195]); *(uint2*)(dst[u] + (size_t)rho * Kd[u] + r4) = o; } }
          __syncthreads();
      } }
    int base = 0;
    const float qscale = 0.10206207261596575f * 1.4426950408889634f;
    base = tconv(p.WuqT, 768, 256, [&](int k, int rho) { int col;
        if (rho < 512) col = (rho >> 6) * 96 + (rho & 63); else { const int hh = (rho - 512) >> 5, w = (rho - 512) & 31; col = hh * 96 + 64 + (w >> 1) + 16 * (w & 1); }
        return p.w_uq[(size_t)k * 768 + col] * p.g_cq[k] * qscale; }, base, bid, nb, sm);
    base = tconv(p.WukT, 512, 128, [&](int k, int c) { return p.w_uk[(size_t)k * 512 + c] * p.g_ckv[k]; }, base, bid, nb, sm);
    base = tconv(p.WuvT, 512, 128, [&](int k, int c) { return p.w_uv[(size_t)k * 512 + c] * p.g_ckv[k]; }, base, bid, nb, sm);
    { bf16_t* RWh = p.cqn; bf16_t* RWl = p.cqn + 48 * 1024;
      for (size_t i = gtid; i < (size_t)48 * 1024; i += gsz) { const int n = (int)(i >> 10), k = (int)(i & 1023); float v = 0.f;
          if (n < 4) v = p.w_rg[(size_t)k * 4 + n]; else if (n < 36) { const int e = n - 4; v = p.w_re[((size_t)(e >> 3) * DM + k) * 8 + (e & 7)]; }
          v *= p.g_ffn[k]; const bf16_t hi = f2bf(v); RWh[i] = hi; RWl[i] = f2bf(v - __uint_as_float((unsigned)hi << 16)); } }
    for (size_t i = gtid; i < (size_t)8 * 128 * 128; i += gsz) { const int j = (int)(i & 127), ii = (int)((i >> 7) & 127);
        p.Wsp[i] = ((j >> 6) <= (ii >> 6)) ? f2bf(p.w_sp[i]) : (bf16_t)0; }
}

__device__ __forceinline__ bool tile_of(int it, int bid, int nb, int RT, int CT, int& rt, int& ct) {
    if ((RT & 31) == 0 && (nb & 7) == 0) {
        const int x = bid & 7, l = bid >> 3, nl = nb >> 3, rpx = RT >> 3; const int lt = l + it * nl; if (lt >= rpx * CT) return false;
        const int rg = lt / (4 * CT), w = lt % (4 * CT); rt = x * rpx + rg * 4 + (w & 3); ct = w >> 2; return true;
    }
    const int tile = bid + it * nb; if (tile >= RT * CT) return false; rt = tile / CT; ct = tile % CT; return true;
}
struct GOps { const bf16_t* a0; const bf16_t* a1; const bf16_t* a2; const bf16_t* a3; const bf16_t* bp; size_t bstep; };
__device__ __forceinline__ GOps gops(const bf16_t* ap, size_t astep, const bf16_t* bp, size_t bstep) { GOps g; g.a0 = ap; g.a1 = ap + astep; g.a2 = ap + 2 * astep; g.a3 = ap + 3 * astep; g.bp = bp; g.bstep = bstep; return g; }
__device__ __forceinline__ void mg_stage(const GOps& g, int t, LAS unsigned char* lds, int widu) {
    LAS unsigned char* d = lds + (t & 1) * 32768 + widu * 1024; const int k0 = t * 64;
    __builtin_amdgcn_global_load_lds((const unsigned*)(g.a0 + k0), (LAS unsigned*)(d), 16, 0, 0);
    __builtin_amdgcn_global_load_lds((const unsigned*)(g.a1 + k0), (LAS unsigned*)(d + 4096), 16, 0, 0);
    __builtin_amdgcn_global_load_lds((const unsigned*)(g.a2 + k0), (LAS unsigned*)(d + 8192), 16, 0, 0);
    __builtin_amdgcn_global_load_lds((const unsigned*)(g.a3 + k0), (LAS unsigned*)(d + 12288), 16, 0, 0);
#pragma unroll
    for (int i = 0; i < 4; ++i) __builtin_amdgcn_global_load_lds((const unsigned*)(g.bp + i * g.bstep + k0), (LAS unsigned*)(d + 16384 + i * 4096), 16, 0, 0);
}
__device__ __forceinline__ void mg_kloop_p(f32x4 (&acc)[4][4], const GOps& g, int nk, LAS unsigned char* lds, bool prestaged, bool has_next, const GOps& nxt) {
    const int tid = opaque_tid(), lane = tid & 63, wid = tid >> 6, wr = wid >> 1, wc = wid & 1, fr = lane & 15, fq = lane >> 4;
    const int widu = __builtin_amdgcn_readfirstlane(wid);
    if (!prestaged) mg_stage(g, 0, lds, widu);
    const int pc0 = ((fq) ^ (fr & 7)) * 16, pc1 = ((4 + fq) ^ (fr & 7)) * 16;
    for (int t = 0; t < nk; ++t) {
        asm volatile("s_waitcnt vmcnt(0)" ::: "memory");
        __syncthreads();
        if (t + 1 < nk) mg_stage(g, t + 1, lds, widu); else if (has_next) mg_stage(nxt, 0, lds, widu);
        const LAS unsigned char* ab = lds + (t & 1) * 32768 + (wr * 64 + fr) * 128; const LAS unsigned char* bb = lds + (t & 1) * 32768 + 16384 + (wc * 64 + fr) * 128;
        bf16x8 af[2][4], bfr[2][4];
#pragma unroll
        for (int m = 0; m < 4; ++m) { af[0][m] = *(const LAS bf16x8*)(ab + m * 2048 + pc0); bfr[0][m] = *(const LAS bf16x8*)(bb + m * 2048 + pc0); }
#pragma unroll
        for (int m = 0; m < 4; ++m) { af[1][m] = *(const LAS bf16x8*)(ab + m * 2048 + pc1); bfr[1][m] = *(const LAS bf16x8*)(bb + m * 2048 + pc1); }
        __builtin_amdgcn_sched_barrier(0);
#pragma unroll
        for (int ks = 0; ks < 2; ++ks)
#pragma unroll
            for (int m = 0; m < 4; ++m)
#pragma unroll
                for (int n = 0; n < 4; ++n) acc[m][n] = __builtin_amdgcn_mfma_f32_16x16x32_bf16(bfr[ks][n], af[ks][m], acc[m][n], 0, 0, 0);
    }
}
template <class Epi>
__device__ __forceinline__ void mgemm(const bf16_t* A, int lda, const bf16_t* Bt, int ldb, int M, int N, int K, Epi epi, int bid, int nb, LAS unsigned char* lds) {
    const int tid = opaque_tid(), lane = tid & 63, wid = tid >> 6, wr = wid >> 1, wc = wid & 1, fr = lane & 15, fq = lane >> 4;
    const int RT = M / 128, CT = N / 128; const int c8 = ((tid & 7) ^ ((tid >> 3) & 7)) * 8;
    int rt, ct; bool have = tile_of(0, bid, nb, RT, CT, rt, ct);
    GOps cur = gops(A + (size_t)(rt * 128 + (tid >> 3)) * lda + c8, (size_t)32 * lda, Bt + (size_t)(ct * 128 + (tid >> 3)) * ldb + c8, (size_t)32 * ldb);
    for (int it = 0; have; ++it) {
        const int row0 = rt * 128, col0 = ct * 128;
        int rt2, ct2; const bool have2 = tile_of(it + 1, bid, nb, RT, CT, rt2, ct2);
        const GOps nxt = gops(A + (size_t)((have2 ? rt2 : rt) * 128 + (tid >> 3)) * lda + c8, (size_t)32 * lda, Bt + (size_t)((have2 ? ct2 : ct) * 128 + (tid >> 3)) * ldb + c8, (size_t)32 * ldb);
        f32x4 acc[4][4];
#pragma unroll
        for (int m = 0; m < 4; ++m)
#pragma unroll
            for (int n = 0; n < 4; ++n) acc[m][n] = (f32x4){0.f, 0.f, 0.f, 0.f};
        mg_kloop_p(acc, cur, K / 64, lds, it > 0, have2, nxt);
#pragma unroll
        for (int m = 0; m < 4; ++m)
#pragma unroll
            for (int n = 0; n < 4; ++n) epi(row0 + wr * 64 + m * 16 + fr, col0 + wc * 64 + n * 16 + fq * 4, acc[m][n]);
        cur = nxt; rt = rt2; ct = ct2; have = have2;
    }
    __syncthreads();
}


__device__ __forceinline__ void stg_put(LAS unsigned char* S, int r, int c4, const uint2 v) { const u32x2 w = {v.x, v.y};
    *(LAS u32x2*)(S + r * 256 + (((c4 >> 3) ^ (r & 15)) << 4) + ((c4 & 4) << 1)) = w; }
__device__ __forceinline__ void stg_put32(LAS unsigned char* S, int r, int c2, const unsigned v) {
    *(LAS unsigned*)(S + r * 256 + (((c2 >> 3) ^ (r & 15)) << 4) + ((c2 & 7) << 1)) = v; }
__device__ __forceinline__ void row_sums(const u32x4 v, float& s1, float& s2) {
    float a = 0.f, b = 0.f;
#pragma unroll
    for (int i = 0; i < 4; ++i) { const float lo = __uint_as_float(v[i] << 16), hi = __uint_as_float(v[i] & 0xffff0000u); a += lo + hi; b += lo * lo + hi * hi; }
    a += DPP_F(a, 0xB1); a += DPP_F(a, 0x4E); a += DPP_F(a, 0x141); a += DPP_F(a, 0x140);
    b += DPP_F(b, 0xB1); b += DPP_F(b, 0x4E); b += DPP_F(b, 0x141); b += DPP_F(b, 0x140);
    s1 = a; s2 = b;
}
template <int SEG, class D, class RH>
__device__ __forceinline__ void stg_flush(LAS unsigned char* S, D dst, RH rh) {
    const int tid = threadIdx.x, lane = tid & 63, wid = tid >> 6;
#pragma unroll
    for (int it = 0; it < 8; ++it) { const int r = wid * 32 + it * 4 + (lane >> 4), cc = lane & 15;
        const u32x4 v = *(const LAS u32x4*)(S + r * 256 + ((cc ^ (r & 15)) << 4));
        bf16_t* d = dst(r, cc / (SEG / 8));
        if (d) *(u32x4*)(d + (cc % (SEG / 8)) * 8) = v;
        rh(r, cc, v); }
}
struct NoRowHook { __device__ __forceinline__ void operator()(int, int, int, int, const u32x4&) const {} };
template <int SEG, class Val, class Dst, class RowHook = NoRowHook>
__device__ __forceinline__ void mgemm_st(const bf16_t* A, int lda, const bf16_t* Bt, int ldb, int M, int N, int K, Val val, Dst dst, int bid, int nb, LAS unsigned char* lds, RowHook rowhook = RowHook()) {
    const int tid = opaque_tid(), lane = tid & 63, wid = tid >> 6, wr = wid >> 1, wc = wid & 1, fr = lane & 15, fq = lane >> 4;
    const int RT = M / 128, CT = N / 128; const int c8 = ((tid & 7) ^ ((tid >> 3) & 7)) * 8;
    LAS unsigned char* S = lds + 32768;
    int rt, ct; bool have = tile_of(0, bid, nb, RT, CT, rt, ct);
    GOps cur = gops(A + (size_t)(rt * 128 + (tid >> 3)) * lda + c8, (size_t)32 * lda, Bt + (size_t)(ct * 128 + (tid >> 3)) * ldb + c8, (size_t)32 * ldb);
    for (int it = 0; have; ++it) {
        const int row0 = rt * 128, col0 = ct * 128;
        int rt2, ct2; const bool have2 = tile_of(it + 1, bid, nb, RT, CT, rt2, ct2);
        const GOps nxt = gops(A + (size_t)((have2 ? rt2 : rt) * 128 + (tid >> 3)) * lda + c8, (size_t)32 * lda, Bt + (size_t)((have2 ? ct2 : ct) * 128 + (tid >> 3)) * ldb + c8, (size_t)32 * ldb);
        f32x4 acc[4][4];
#pragma unroll
        for (int m = 0; m < 4; ++m)
#pragma unroll
            for (int n = 0; n < 4; ++n) acc[m][n] = (f32x4){0.f, 0.f, 0.f, 0.f};
        mg_kloop_p(acc, cur, K / 64, lds, it > 0, have2, nxt);
        __syncthreads();
#pragma unroll
        for (int m = 0; m < 4; ++m)
#pragma unroll
            for (int n = 0; n < 4; ++n) { const int r = wr * 64 + m * 16 + fr, c = wc * 64 + n * 16 + fq * 4; stg_put(S, r, c, val(row0 + r, col0 + c, acc[m][n])); }
        __syncthreads();
        stg_flush<SEG>(S, [&](int r, int seg) __attribute__((always_inline)) { return dst(row0, col0, r, seg); }, [&](int r, int cc, const u32x4& v) __attribute__((always_inline)) { rowhook(row0, col0, r, cc, v); });
        cur = nxt; rt = rt2; ct = ct2; have = have2;
    }
    __syncthreads();
}

__device__ __forceinline__ void phase1(const P& p, int bid, int nb, LAS unsigned char* sm) {
    bf16_t* zs = (bf16_t*)p.slotB; bf16_t* uvg = p.slotC; bf16_t* gates = p.slotD; float* stat = p.stat;
    mgemm_st<128>(p.slotA, DM, p.WinT, DM, NT, ZP, DM, [=](int t, int c, const f32x4& v) { uint2 o;
        if (c < 512) { o.x = pk2(v[0], v[1]); o.y = pk2(v[2], v[3]); }
        else if (c < 1536) { o.x = pk2(fgelu(v[0]), fgelu(v[1])); o.y = pk2(fgelu(v[2]), fgelu(v[3])); }
        else { o.x = pk2(fsigmoid(v[0]), fsigmoid(v[1])); o.y = pk2(fsigmoid(v[2]), fsigmoid(v[3])); }
        return o;
    }, [=](int row0, int col0, int r, int) -> bf16_t* { const size_t t = (size_t)(row0 + r);
        if (col0 < 512) return zs + t * 512 + col0; if (col0 < 1536) return uvg + t * 1024 + (col0 - 512); return gates + t * 2048 + (col0 - 1536);
    }, bid, nb, sm, [=](int row0, int col0, int r, int cc, const u32x4& v) {
        const bool isq = col0 < 256, iskv = col0 == 256, isv = (col0 >= 1024 && col0 < 1536);
        if (isq || iskv || isv) { float s1, s2; row_sums(v, s1, s2);
            if (cc == 0) { const int t = row0 + r;
                if (isq) atomicAdd(stat + t, s2); else if (iskv) atomicAdd(stat + NT + t, s2); else { atomicAdd(stat + 2 * NT + t, s1); atomicAdd(stat + 3 * NT + t, s2); } } }
    });
}

__device__ __forceinline__ void rope_cs(float posf, int i, float& cn, float& sn) {
    float f = (i & 3) == 0 ? 1.0f : (i & 3) == 1 ? 0.5623413251903491f : (i & 3) == 2 ? 0.31622776601683794f : 0.1778279410038923f;
    const int q4 = i >> 2; f *= (q4 == 0 ? 1.0f : q4 == 1 ? 0.1f : q4 == 2 ? 0.01f : 0.001f);
    const float ang = posf * f; const double rev = (double)ang * 0.15915494309189535; const float frc = (float)(rev - floor(rev));
    sn = __builtin_amdgcn_sinf(frc); cn = __builtin_amdgcn_cosf(frc);
}
__device__ __forceinline__ void rope_rows(const P& p, int bid, int nb) {
    const int tid = opaque_tid(), lane = tid & 63, wid = tid >> 6;
    const bf16_t* zs = (const bf16_t*)p.slotB; bf16_t* K = p.slotE;
    const int hd = lane >> 3, j = lane & 7, i4 = 4 * (j & 3);
    for (int t = bid * 4 + wid; t < NT; t += nb * 4) {
        const bf16_t* z = zs + (size_t)t * 512; const f32x4 k1 = bf4(*(const uint2*)(z + 384 + i4)), k2 = bf4(*(const uint2*)(z + 400 + i4)); const float posf = (float)p.pos[t];
        const int b = t >> 13, sq = t & 8191; float val[4];
#pragma unroll
        for (int q = 0; q < 4; ++q) { float cn, sn; rope_cs(posf, i4 + q, cn, sn); val[q] = (j < 4) ? (k1[q] * cn - k2[q] * sn) : (k1[q] * sn + k2[q] * cn); }
        uint2 o; o.x = pk2(val[0], val[1]); o.y = pk2(val[2], val[3]);
        *(uint2*)(K + ((size_t)(b * NH + hd) * SEQ + sq) * 96 + 64 + 4 * j) = o;
    }
}

__device__ __forceinline__ void phase2b(const P& p, int bid, int nb, LAS unsigned char* sm) {
    const bf16_t* zs = (const bf16_t*)p.slotB; bf16_t* Q = p.slotA; bf16_t* K = p.slotE; bf16_t* VT = p.slotF; const float* stat = p.stat; const int* pos = p.pos;
    mgemm(zs, 512, p.WuqT, 256, NT, 768, 256, [=](int t, int c, const f32x4& vin) {
        const int b = t >> 13, s = t & 8191; const f32x4 v = vin * rsqrtf(stat[t] * (1.f / 256.f) + EPS);
        if (c < 512) { const int h = c >> 6, d = c & 63; uint2 o; o.x = pk2(v[0], v[1]); o.y = pk2(v[2], v[3]); *(uint2*)(Q + ((size_t)(b * NH + h) * SEQ + s) * 96 + d) = o; }
        else { const int h = (c - 512) >> 5, i0 = ((c - 512) & 31) >> 1; bf16_t* q = Q + ((size_t)(b * NH + h) * SEQ + s) * 96; const float posf = (float)pos[t];
            float c0_, s0_, c1_, s1_; rope_cs(posf, i0, c0_, s0_); rope_cs(posf, i0 + 1, c1_, s1_);
            *(unsigned*)(q + 64 + i0) = pk2(v[0] * c0_ - v[1] * s0_, v[2] * c1_ - v[3] * s1_);
            *(unsigned*)(q + 80 + i0) = pk2(v[0] * s0_ + v[1] * c0_, v[2] * s1_ + v[3] * c1_); }
    }, bid, nb, sm);
    mgemm_st<64>(zs + 256, 512, p.WukT, 128, NT, 512, 128, [=](int t, int, const f32x4& vin) { const f32x4 v = vin * rsqrtf(stat[NT + t] * (1.f / 128.f) + EPS); uint2 o; o.x = pk2(v[0], v[1]); o.y = pk2(v[2], v[3]); return o; },
        [=](int row0, int col0, int r, int seg) -> bf16_t* { const int t = row0 + r, b = t >> 13, s = t & 8191, h = (col0 >> 6) + seg; return K + ((size_t)(b * NH + h) * SEQ + s) * 96; }, bid, nb, sm);
    mgemm_st<128>(p.WuvT, 128, zs + 256, 512, 512, NT, 128, [=](int, int t, const f32x4& vin) { const f32x4 ss = *(const f32x4*)(stat + NT + t); f32x4 v;
#pragma unroll
            for (int j = 0; j < 4; ++j) v[j] = vin[j] * rsqrtf(ss[j] * (1.f / 128.f) + EPS);
            uint2 o; o.x = pk2(v[0], v[1]); o.y = pk2(v[2], v[3]); return o; },
        [=](int row0, int col0, int r, int) -> bf16_t* { return VT + (size_t)(row0 + r) * NT + col0; }, bid, nb, sm);
}

__device__ __forceinline__ void phase2c_m(const P& p, int bid, int nb, LAS unsigned char* lds) {
    const bf16_t* uvg = p.slotC; bf16_t* su = p.slotG;
    const int tid = opaque_tid(), lane = tid & 63, wid = tid >> 6, fr = lane & 15, fq = lane >> 4;
    const int c8 = ((tid & 7) ^ ((tid >> 3) & 7)) * 8;
    for (int u = bid; u < 1024; u += nb) {
        const int g = u & 7, t0 = (u >> 3) * 128;
        { const bf16_t* wp = p.Wsp + ((size_t)g * 128 + (tid >> 3)) * 128 + c8; LAS unsigned char* d = lds + tid * 16;
#pragma unroll
          for (int ks = 0; ks < 2; ++ks)
#pragma unroll
              for (int i = 0; i < 4; ++i) __builtin_amdgcn_global_load_lds((const unsigned*)(wp + (size_t)i * 32 * 128 + ks * 64), (LAS unsigned*)(d + ks * 16384 + i * 4096), 16, 0, 0); }
#pragma unroll
        for (int i = 0; i < 4; ++i) { const int q = tid + 256 * i, j = q >> 3, c0 = (q & 7) * 8;
            const uint4 v = *(const uint4*)(uvg + (size_t)(t0 + j) * 1024 + 512 + g * 64 + c0);
            const unsigned w[4] = {v.x, v.y, v.z, v.w};
            const float mu = p.stat[2 * NT + t0 + j] * (1.f / 512.f), rs = rsqrtf(p.stat[3 * NT + t0 + j] * (1.f / 512.f) - mu * mu + EPS);
            const f32x4 g0 = *(const f32x4*)(p.sgu_gain + g * 64 + c0), g1 = *(const f32x4*)(p.sgu_gain + g * 64 + c0 + 4), b0 = *(const f32x4*)(p.sgu_bias + g * 64 + c0), b1 = *(const f32x4*)(p.sgu_bias + g * 64 + c0 + 4);
            LAS unsigned char* bimg = lds + 32768 + (j >> 6) * 8192 + (j & 7) * 2; const int lc = (j & 63) >> 3;
#pragma unroll
            for (int e = 0; e < 8; ++e) { const int row = c0 + e; const float x = (e & 1) ? __uint_as_float(w[e >> 1] & 0xffff0000u) : __uint_as_float(w[e >> 1] << 16);
                const float gn = e < 4 ? g0[e & 3] : g1[e & 3], bs_ = e < 4 ? b0[e & 3] : b1[e & 3];
                *(LAS bf16_t*)(bimg + row * 128 + ((lc ^ (row & 7)) * 16)) = (bf16_t)(pk2((x - mu) * rs * gn + bs_, 0.f) & 0xffffu); } }
        asm volatile("s_waitcnt vmcnt(0)" ::: "memory");
        __syncthreads();
        f32x4 acc[2][4];
#pragma unroll
        for (int m = 0; m < 2; ++m)
#pragma unroll
            for (int n = 0; n < 4; ++n) acc[m][n] = (f32x4){0.f, 0.f, 0.f, 0.f};
#pragma unroll
        for (int ks = 0; ks < 2; ++ks)
#pragma unroll
            for (int k2 = 0; k2 < 2; ++k2) { const int pc = ((k2 * 4 + fq) ^ (fr & 7)) * 16; bf16x8 af[2], bfr[4];
#pragma unroll
                for (int m = 0; m < 2; ++m) af[m] = *(const LAS bf16x8*)(lds + ks * 16384 + (wid * 32 + m * 16 + fr) * 128 + pc);
#pragma unroll
                for (int n = 0; n < 4; ++n) bfr[n] = *(const LAS bf16x8*)(lds + 32768 + ks * 8192 + (n * 16 + fr) * 128 + pc);
#pragma unroll
                for (int m = 0; m < 2; ++m)
#pragma unroll
                    for (int n = 0; n < 4; ++n) acc[m][n] = __builtin_amdgcn_mfma_f32_16x16x32_bf16(bfr[n], af[m], acc[m][n], 0, 0, 0); }
#pragma unroll
        for (int m = 0; m < 2; ++m) { const int i = wid * 32 + m * 16 + fr; const float bs = p.b_sp[g * 128 + i];
#pragma unroll
            for (int n = 0; n < 4; ++n) { const int c = g * 64 + n * 16 + fq * 4;
                const uint2 uu = *(const uint2*)(uvg + (size_t)(t0 + i) * 1024 + c);
                uint2 o; o.x = pk2(__uint_as_float(uu.x << 16) * (acc[m][n][0] + bs), __uint_as_float(uu.x & 0xffff0000u) * (acc[m][n][1] + bs));
                o.y = pk2(__uint_as_float(uu.y << 16) * (acc[m][n][2] + bs), __uint_as_float(uu.y & 0xffff0000u) * (acc[m][n][3] + bs));
                *(uint2*)(su + (size_t)(t0 + i) * 512 + c) = o; } }
        __syncthreads();
    }
}

template <int VAR>
__device__ __forceinline__ void att_step(const LAS unsigned char* kb_, const LAS unsigned char* vb_, const int kt16, const int k4o, const int k5o, const int vsw, const bf16x8 (&qf)[6],
                                         f32x16& c0, f32x16& c1, f32x16& n0, f32x16& n1, const unsigned (&pwc)[16], unsigned (&pwn)[16], f32x16& o0, f32x16& o1,
                                         const f32x16& negm, float& ps, float& mxn) {
    f32x16 zero16;
#pragma unroll
    for (int e = 0; e < 16; ++e) zero16[e] = 0.f;
    if constexpr (VAR == 0) {
        bf16x8 kf0, kf1, kf2;
        kf0 = *(const LAS bf16x8*)(kb_ + 0*32*192 + kt16 + 0); kf1 = *(const LAS bf16x8*)(kb_ + 1*32*192 + kt16 + 0);
        float mxl;
        kf2 = *(const LAS bf16x8*)(kb_ + 0*32*192 + kt16 + 32);
        n0 = __builtin_amdgcn_mfma_f32_32x32x16_bf16(kf0, qf[0], negm, 0, 0, 0);
        c0[0] = __builtin_amdgcn_exp2f(c0[0]); ps += c0[0]; c0[1] = __builtin_amdgcn_exp2f(c0[1]); ps += c0[1]; pwn[0] = pk2(c0[0], c0[1]);
        __builtin_amdgcn_sched_barrier(0);
        kf0 = *(const LAS bf16x8*)(kb_ + 1*32*192 + kt16 + 32);
        n1 = __builtin_amdgcn_mfma_f32_32x32x16_bf16(kf1, qf[0], negm, 0, 0, 0);
        c0[2] = __builtin_amdgcn_exp2f(c0[2]); ps += c0[2]; c0[3] = __builtin_amdgcn_exp2f(c0[3]); ps += c0[3]; pwn[1] = pk2(c0[2], c0[3]);
        __builtin_amdgcn_sched_barrier(0);
        kf1 = *(const LAS bf16x8*)(kb_ + 0*32*192 + kt16 + 64);
        n0 = __builtin_amdgcn_mfma_f32_32x32x16_bf16(kf2, qf[1], n0, 0, 0, 0);
        c0[4] = __builtin_amdgcn_exp2f(c0[4]); ps += c0[4]; c0[5] = __builtin_amdgcn_exp2f(c0[5]); ps += c0[5]; pwn[2] = pk2(c0[4], c0[5]);
        __builtin_amdgcn_sched_barrier(0);
        kf2 = *(const LAS bf16x8*)(kb_ + 1*32*192 + kt16 + 64);
        n1 = __builtin_amdgcn_mfma_f32_32x32x16_bf16(kf0, qf[1], n1, 0, 0, 0);
        c0[6] = __builtin_amdgcn_exp2f(c0[6]); ps += c0[6]; c0[7] = __builtin_amdgcn_exp2f(c0[7]); ps += c0[7]; pwn[3] = pk2(c0[6], c0[7]);
        __builtin_amdgcn_sched_barrier(0);
        kf0 = *(const LAS bf16x8*)(kb_ + 0*32*192 + kt16 + 96);
        n0 = __builtin_amdgcn_mfma_f32_32x32x16_bf16(kf1, qf[2], n0, 0, 0, 0);
        c0[8] = __builtin_amdgcn_exp2f(c0[8]); ps += c0[8]; c0[9] = __builtin_amdgcn_exp2f(c0[9]); ps += c0[9]; pwn[4] = pk2(c0[8], c0[9]);
        __builtin_amdgcn_sched_barrier(0);
        kf1 = *(const LAS bf16x8*)(kb_ + 1*32*192 + kt16 + 96);
        n1 = __builtin_amdgcn_mfma_f32_32x32x16_bf16(kf2, qf[2], n1, 0, 0, 0);
        c0[10] = __builtin_amdgcn_exp2f(c0[10]); ps += c0[10]; c0[11] = __builtin_amdgcn_exp2f(c0[11]); ps += c0[11]; pwn[5] = pk2(c0[10], c0[11]);
        __builtin_amdgcn_sched_barrier(0);
        kf2 = *(const LAS bf16x8*)(kb_ + 0*32*192 + k4o);
        n0 = __builtin_amdgcn_mfma_f32_32x32x16_bf16(kf0, qf[3], n0, 0, 0, 0);
        c0[12] = __builtin_amdgcn_exp2f(c0[12]); ps += c0[12]; c0[13] = __builtin_amdgcn_exp2f(c0[13]); ps += c0[13]; pwn[6] = pk2(c0[12], c0[13]);
        __builtin_amdgcn_sched_barrier(0);
        kf0 = *(const LAS bf16x8*)(kb_ + 1*32*192 + k4o);
        n1 = __builtin_amdgcn_mfma_f32_32x32x16_bf16(kf1, qf[3], n1, 0, 0, 0);
        c0[14] = __builtin_amdgcn_exp2f(c0[14]); ps += c0[14]; c0[15] = __builtin_amdgcn_exp2f(c0[15]); ps += c0[15]; pwn[7] = pk2(c0[14], c0[15]);
        __builtin_amdgcn_sched_barrier(0);
        kf1 = *(const LAS bf16x8*)(kb_ + 0*32*192 + k5o);
        n0 = __builtin_amdgcn_mfma_f32_32x32x16_bf16(kf2, qf[4], n0, 0, 0, 0);
        c1[0] = __builtin_amdgcn_exp2f(c1[0]); ps += c1[0]; c1[1] = __builtin_amdgcn_exp2f(c1[1]); ps += c1[1]; pwn[8] = pk2(c1[0], c1[1]);
        __builtin_amdgcn_sched_barrier(0);
        kf2 = *(const LAS bf16x8*)(kb_ + 1*32*192 + k5o);
        n1 = __builtin_amdgcn_mfma_f32_32x32x16_bf16(kf0, qf[4], n1, 0, 0, 0);
        c1[2] = __builtin_amdgcn_exp2f(c1[2]); ps += c1[2]; c1[3] = __builtin_amdgcn_exp2f(c1[3]); ps += c1[3]; pwn[9] = pk2(c1[2], c1[3]);
        __builtin_amdgcn_sched_barrier(0);
        n0 = __builtin_amdgcn_mfma_f32_32x32x16_bf16(kf1, qf[5], n0, 0, 0, 0);
        c1[4] = __builtin_amdgcn_exp2f(c1[4]); ps += c1[4]; c1[5] = __builtin_amdgcn_exp2f(c1[5]); ps += c1[5]; pwn[10] = pk2(c1[4], c1[5]);
        __builtin_amdgcn_sched_barrier(0);
        n1 = __builtin_amdgcn_mfma_f32_32x32x16_bf16(kf2, qf[5], n1, 0, 0, 0);
        c1[6] = __builtin_amdgcn_exp2f(c1[6]); ps += c1[6]; c1[7] = __builtin_amdgcn_exp2f(c1[7]); ps += c1[7]; pwn[11] = pk2(c1[6], c1[7]);
        __builtin_amdgcn_sched_barrier(0);
        c1[8] = __builtin_amdgcn_exp2f(c1[8]); ps += c1[8]; c1[9] = __builtin_amdgcn_exp2f(c1[9]); ps += c1[9]; pwn[12] = pk2(c1[8], c1[9]);
        __builtin_amdgcn_sched_barrier(0);
        c1[10] = __builtin_amdgcn_exp2f(c1[10]); ps += c1[10]; c1[11] = __builtin_amdgcn_exp2f(c1[11]); ps += c1[11]; pwn[13] = pk2(c1[10], c1[11]);
        __builtin_amdgcn_sched_barrier(0);
        c1[12] = __builtin_amdgcn_exp2f(c1[12]); ps += c1[12]; c1[13] = __builtin_amdgcn_exp2f(c1[13]); ps += c1[13]; pwn[14] = pk2(c1[12], c1[13]);
        __builtin_amdgcn_sched_barrier(0);
        c1[14] = __builtin_amdgcn_exp2f(c1[14]); ps += c1[14]; c1[15] = __builtin_amdgcn_exp2f(c1[15]); ps += c1[15]; pwn[15] = pk2(c1[14], c1[15]);
        __builtin_amdgcn_sched_barrier(0);
        mxl = fmaxf(n0[0], n1[0]); mxl = fmaxf(fmaxf(mxl, n0[1]), n1[1]); mxl = fmaxf(fmaxf(mxl, n0[2]), n1[2]); mxl = fmaxf(fmaxf(mxl, n0[3]), n1[3]);
        __builtin_amdgcn_sched_barrier(0);
        mxl = fmaxf(fmaxf(mxl, n0[4]), n1[4]); mxl = fmaxf(fmaxf(mxl, n0[5]), n1[5]); mxl = fmaxf(fmaxf(mxl, n0[6]), n1[6]); mxl = fmaxf(fmaxf(mxl, n0[7]), n1[7]);
        __builtin_amdgcn_sched_barrier(0);
        mxl = fmaxf(fmaxf(mxl, n0[8]), n1[8]); mxl = fmaxf(fmaxf(mxl, n0[9]), n1[9]); mxl = fmaxf(fmaxf(mxl, n0[10]), n1[10]); mxl = fmaxf(fmaxf(mxl, n0[11]), n1[11]);
        __builtin_amdgcn_sched_barrier(0);
        mxl = fmaxf(fmaxf(mxl, n0[12]), n1[12]); mxl = fmaxf(fmaxf(mxl, n0[13]), n1[13]); mxl = fmaxf(fmaxf(mxl, n0[14]), n1[14]); mxl = fmaxf(fmaxf(mxl, n0[15]), n1[15]);
        __builtin_amdgcn_sched_barrier(0);
        mxn = fmaxf(mxl, __shfl_xor(mxl, 32));
    } else if constexpr (VAR == 1) {
        bf16x8 kf0, kf1, kf2;
        kf0 = *(const LAS bf16x8*)(kb_ + 0*32*192 + kt16 + 0); kf1 = *(const LAS bf16x8*)(kb_ + 1*32*192 + kt16 + 0);
        u32x4 vf0, vf1, vf2;
        float mxl;
        kf2 = *(const LAS bf16x8*)(kb_ + 0*32*192 + kt16 + 32);
        n0 = __builtin_amdgcn_mfma_f32_32x32x16_bf16(kf0, qf[0], negm, 0, 0, 0);
        c0[0] = __builtin_amdgcn_exp2f(c0[0]); ps += c0[0]; c0[1] = __builtin_amdgcn_exp2f(c0[1]); ps += c0[1]; pwn[0] = pk2(c0[0], c0[1]);
        __builtin_amdgcn_sched_barrier(0);
        kf0 = *(const LAS bf16x8*)(kb_ + 1*32*192 + kt16 + 32);
        n1 = __builtin_amdgcn_mfma_f32_32x32x16_bf16(kf1, qf[0], negm, 0, 0, 0);
        c0[2] = __builtin_amdgcn_exp2f(c0[2]); ps += c0[2]; c0[3] = __builtin_amdgcn_exp2f(c0[3]); ps += c0[3]; pwn[1] = pk2(c0[2], c0[3]);
        __builtin_amdgcn_sched_barrier(0);
        kf1 = *(const LAS bf16x8*)(kb_ + 0*32*192 + kt16 + 64);
        n0 = __builtin_amdgcn_mfma_f32_32x32x16_bf16(kf2, qf[1], n0, 0, 0, 0);
        c0[4] = __builtin_amdgcn_exp2f(c0[4]); ps += c0[4]; c0[5] = __builtin_amdgcn_exp2f(c0[5]); ps += c0[5]; pwn[2] = pk2(c0[4], c0[5]);
        __builtin_amdgcn_sched_barrier(0);
        kf2 = *(const LAS bf16x8*)(kb_ + 1*32*192 + kt16 + 64);
        n1 = __builtin_amdgcn_mfma_f32_32x32x16_bf16(kf0, qf[1], n1, 0, 0, 0);
        c0[6] = __builtin_amdgcn_exp2f(c0[6]); ps += c0[6]; c0[7] = __builtin_amdgcn_exp2f(c0[7]); ps += c0[7]; pwn[3] = pk2(c0[6], c0[7]);
        __builtin_amdgcn_sched_barrier(0);
        kf0 = *(const LAS bf16x8*)(kb_ + 0*32*192 + kt16 + 96);
        n0 = __builtin_amdgcn_mfma_f32_32x32x16_bf16(kf1, qf[2], n0, 0, 0, 0);
        c0[8] = __builtin_amdgcn_exp2f(c0[8]); ps += c0[8]; c0[9] = __builtin_amdgcn_exp2f(c0[9]); ps += c0[9]; pwn[4] = pk2(c0[8], c0[9]);
        __builtin_amdgcn_sched_barrier(0);
        kf1 = *(const LAS bf16x8*)(kb_ + 1*32*192 + kt16 + 96);
        n1 = __builtin_amdgcn_mfma_f32_32x32x16_bf16(kf2, qf[2], n1, 0, 0, 0);
        c0[10] = __builtin_amdgcn_exp2f(c0[10]); ps += c0[10]; c0[11] = __builtin_amdgcn_exp2f(c0[11]); ps += c0[11]; pwn[5] = pk2(c0[10], c0[11]);
        __builtin_amdgcn_sched_barrier(0);
        kf2 = *(const LAS bf16x8*)(kb_ + 0*32*192 + k4o);
        n0 = __builtin_amdgcn_mfma_f32_32x32x16_bf16(kf0, qf[3], n0, 0, 0, 0);
        c0[12] = __builtin_amdgcn_exp2f(c0[12]); ps += c0[12]; c0[13] = __builtin_amdgcn_exp2f(c0[13]); ps += c0[13]; pwn[6] = pk2(c0[12], c0[13]);
        __builtin_amdgcn_sched_barrier(0);
        kf0 = *(const LAS bf16x8*)(kb_ + 1*32*192 + k4o);
        n1 = __builtin_amdgcn_mfma_f32_32x32x16_bf16(kf1, qf[3], n1, 0, 0, 0);
        c0[14] = __builtin_amdgcn_exp2f(c0[14]); ps += c0[14]; c0[15] = __builtin_amdgcn_exp2f(c0[15]); ps += c0[15]; pwn[7] = pk2(c0[14], c0[15]);
        __builtin_amdgcn_sched_barrier(0);
        kf1 = *(const LAS bf16x8*)(kb_ + 0*32*192 + k5o);
        n0 = __builtin_amdgcn_mfma_f32_32x32x16_bf16(kf2, qf[4], n0, 0, 0, 0);
        c1[0] = __builtin_amdgcn_exp2f(c1[0]); ps += c1[0]; c1[1] = __builtin_amdgcn_exp2f(c1[1]); ps += c1[1]; pwn[8] = pk2(c1[0], c1[1]);
        __builtin_amdgcn_sched_barrier(0);
        kf2 = *(const LAS bf16x8*)(kb_ + 1*32*192 + k5o);
        n1 = __builtin_amdgcn_mfma_f32_32x32x16_bf16(kf0, qf[4], n1, 0, 0, 0);
        c1[2] = __builtin_amdgcn_exp2f(c1[2]); ps += c1[2]; c1[3] = __builtin_amdgcn_exp2f(c1[3]); ps += c1[3]; pwn[9] = pk2(c1[2], c1[3]);
        __builtin_amdgcn_sched_barrier(0);
        vf0 = *(const LAS u32x4*)(vb_ + ((0) ^ vsw) * 16);
        n0 = __builtin_amdgcn_mfma_f32_32x32x16_bf16(kf1, qf[5], n0, 0, 0, 0);
        c1[4] = __builtin_amdgcn_exp2f(c1[4]); ps += c1[4]; c1[5] = __builtin_amdgcn_exp2f(c1[5]); ps += c1[5]; pwn[10] = pk2(c1[4], c1[5]);
        __builtin_amdgcn_sched_barrier(0);
        vf1 = *(const LAS u32x4*)(vb_ + 32 * 128 + ((0) ^ vsw) * 16);
        n1 = __builtin_amdgcn_mfma_f32_32x32x16_bf16(kf2, qf[5], n1, 0, 0, 0);
        c1[6] = __builtin_amdgcn_exp2f(c1[6]); ps += c1[6]; c1[7] = __builtin_amdgcn_exp2f(c1[7]); ps += c1[7]; pwn[11] = pk2(c1[6], c1[7]);
        __builtin_amdgcn_sched_barrier(0);
        vf2 = *(const LAS u32x4*)(vb_ + ((2) ^ vsw) * 16);
        { const u32x4 pbu = {pwc[0], pwc[1], pwc[2], pwc[3]}; const u32x4 vv = vf0;
          o0 = __builtin_amdgcn_mfma_f32_32x32x16_bf16(__builtin_bit_cast(bf16x8, vv), __builtin_bit_cast(bf16x8, pbu), o0, 0, 0, 0); }
        c1[8] = __builtin_amdgcn_exp2f(c1[8]); ps += c1[8]; c1[9] = __builtin_amdgcn_exp2f(c1[9]); ps += c1[9]; pwn[12] = pk2(c1[8], c1[9]);
        __builtin_amdgcn_sched_barrier(0);
        vf0 = *(const LAS u32x4*)(vb_ + 32 * 128 + ((2) ^ vsw) * 16);
        { const u32x4 pbu = {pwc[0], pwc[1], pwc[2], pwc[3]}; const u32x4 vv = vf1;
          o1 = __builtin_amdgcn_mfma_f32_32x32x16_bf16(__builtin_bit_cast(bf16x8, vv), __builtin_bit_cast(bf16x8, pbu), o1, 0, 0, 0); }
        c1[10] = __builtin_amdgcn_exp2f(c1[10]); ps += c1[10]; c1[11] = __builtin_amdgcn_exp2f(c1[11]); ps += c1[11]; pwn[13] = pk2(c1[10], c1[11]);
        __builtin_amdgcn_sched_barrier(0);
        vf1 = *(const LAS u32x4*)(vb_ + ((4) ^ vsw) * 16);
        { const u32x4 pbu = {pwc[4], pwc[5], pwc[6], pwc[7]}; const u32x4 vv = vf2;
          o0 = __builtin_amdgcn_mfma_f32_32x32x16_bf16(__builtin_bit_cast(bf16x8, vv), __builtin_bit_cast(bf16x8, pbu), o0, 0, 0, 0); }
        c1[12] = __builtin_amdgcn_exp2f(c1[12]); ps += c1[12]; c1[13] = __builtin_amdgcn_exp2f(c1[13]); ps += c1[13]; pwn[14] = pk2(c1[12], c1[13]);
        __builtin_amdgcn_sched_barrier(0);
        vf2 = *(const LAS u32x4*)(vb_ + 32 * 128 + ((4) ^ vsw) * 16);
        { const u32x4 pbu = {pwc[4], pwc[5], pwc[6], pwc[7]}; const u32x4 vv = vf0;
          o1 = __builtin_amdgcn_mfma_f32_32x32x16_bf16(__builtin_bit_cast(bf16x8, vv), __builtin_bit_cast(bf16x8, pbu), o1, 0, 0, 0); }
        c1[14] = __builtin_amdgcn_exp2f(c1[14]); ps += c1[14]; c1[15] = __builtin_amdgcn_exp2f(c1[15]); ps += c1[15]; pwn[15] = pk2(c1[14], c1[15]);
        __builtin_amdgcn_sched_barrier(0);
        vf0 = *(const LAS u32x4*)(vb_ + ((6) ^ vsw) * 16);
        { const u32x4 pbu = {pwc[8], pwc[9], pwc[10], pwc[11]}; const u32x4 vv = vf1;
          o0 = __builtin_amdgcn_mfma_f32_32x32x16_bf16(__builtin_bit_cast(bf16x8, vv), __builtin_bit_cast(bf16x8, pbu), o0, 0, 0, 0); }
        mxl = fmaxf(n0[0], n1[0]); mxl = fmaxf(fmaxf(mxl, n0[1]), n1[1]); mxl = fmaxf(fmaxf(mxl, n0[2]), n1[2]); mxl = fmaxf(fmaxf(mxl, n0[3]), n1[3]);
        __builtin_amdgcn_sched_barrier(0);
        vf1 = *(const LAS u32x4*)(vb_ + 32 * 128 + ((6) ^ vsw) * 16);
        { const u32x4 pbu = {pwc[8], pwc[9], pwc[10], pwc[11]}; const u32x4 vv = vf2;
          o1 = __builtin_amdgcn_mfma_f32_32x32x16_bf16(__builtin_bit_cast(bf16x8, vv), __builtin_bit_cast(bf16x8, pbu), o1, 0, 0, 0); }
        mxl = fmaxf(fmaxf(mxl, n0[4]), n1[4]); mxl = fmaxf(fmaxf(mxl, n0[5]), n1[5]); mxl = fmaxf(fmaxf(mxl, n0[6]), n1[6]); mxl = fmaxf(fmaxf(mxl, n0[7]), n1[7]);
        __builtin_amdgcn_sched_barrier(0);
        { const u32x4 pbu = {pwc[12], pwc[13], pwc[14], pwc[15]}; const u32x4 vv = vf0;
          o0 = __builtin_amdgcn_mfma_f32_32x32x16_bf16(__builtin_bit_cast(bf16x8, vv), __builtin_bit_cast(bf16x8, pbu), o0, 0, 0, 0); }
        mxl = fmaxf(fmaxf(mxl, n0[8]), n1[8]); mxl = fmaxf(fmaxf(mxl, n0[9]), n1[9]); mxl = fmaxf(fmaxf(mxl, n0[10]), n1[10]); mxl = fmaxf(fmaxf(mxl, n0[11]), n1[11]);
        __builtin_amdgcn_sched_barrier(0);
        { const u32x4 pbu = {pwc[12], pwc[13], pwc[14], pwc[15]}; const u32x4 vv = vf1;
          o1 = __builtin_amdgcn_mfma_f32_32x32x16_bf16(__builtin_bit_cast(bf16x8, vv), __builtin_bit_cast(bf16x8, pbu), o1, 0, 0, 0); }
        mxl = fmaxf(fmaxf(mxl, n0[12]), n1[12]); mxl = fmaxf(fmaxf(mxl, n0[13]), n1[13]); mxl = fmaxf(fmaxf(mxl, n0[14]), n1[14]); mxl = fmaxf(fmaxf(mxl, n0[15]), n1[15]);
        __builtin_amdgcn_sched_barrier(0);
        mxn = fmaxf(mxl, __shfl_xor(mxl, 32));
    } else {
        u32x4 vf0, vf1, vf2;
        vf0 = *(const LAS u32x4*)(vb_ + ((0) ^ vsw) * 16);
        vf1 = *(const LAS u32x4*)(vb_ + 32 * 128 + ((0) ^ vsw) * 16);
        vf2 = *(const LAS u32x4*)(vb_ + ((2) ^ vsw) * 16);
        { const u32x4 pbu = {pwc[0], pwc[1], pwc[2], pwc[3]}; const u32x4 vv = vf0;
          o0 = __builtin_amdgcn_mfma_f32_32x32x16_bf16(__builtin_bit_cast(bf16x8, vv), __builtin_bit_cast(bf16x8, pbu), o0, 0, 0, 0); }
        __builtin_amdgcn_sched_barrier(0);
        vf0 = *(const LAS u32x4*)(vb_ + 32 * 128 + ((2) ^ vsw) * 16);
        { const u32x4 pbu = {pwc[0], pwc[1], pwc[2], pwc[3]}; const u32x4 vv = vf1;
          o1 = __builtin_amdgcn_mfma_f32_32x32x16_bf16(__builtin_bit_cast(bf16x8, vv), __builtin_bit_cast(bf16x8, pbu), o1, 0, 0, 0); }
        __builtin_amdgcn_sched_barrier(0);
        vf1 = *(const LAS u32x4*)(vb_ + ((4) ^ vsw) * 16);
        { const u32x4 pbu = {pwc[4], pwc[5], pwc[6], pwc[7]}; const u32x4 vv = vf2;
          o0 = __builtin_amdgcn_mfma_f32_32x32x16_bf16(__builtin_bit_cast(bf16x8, vv), __builtin_bit_cast(bf16x8, pbu), o0, 0, 0, 0); }
        __builtin_amdgcn_sched_barrier(0);
        vf2 = *(const LAS u32x4*)(vb_ + 32 * 128 + ((4) ^ vsw) * 16);
        { const u32x4 pbu = {pwc[4], pwc[5], pwc[6], pwc[7]}; const u32x4 vv = vf0;
          o1 = __builtin_amdgcn_mfma_f32_32x32x16_bf16(__builtin_bit_cast(bf16x8, vv), __builtin_bit_cast(bf16x8, pbu), o1, 0, 0, 0); }
        __builtin_amdgcn_sched_barrier(0);
        vf0 = *(const LAS u32x4*)(vb_ + ((6) ^ vsw) * 16);
        { const u32x4 pbu = {pwc[8], pwc[9], pwc[10], pwc[11]}; const u32x4 vv = vf1;
          o0 = __builtin_amdgcn_mfma_f32_32x32x16_bf16(__builtin_bit_cast(bf16x8, vv), __builtin_bit_cast(bf16x8, pbu), o0, 0, 0, 0); }
        __builtin_amdgcn_sched_barrier(0);
        vf1 = *(const LAS u32x4*)(vb_ + 32 * 128 + ((6) ^ vsw) * 16);
        { const u32x4 pbu = {pwc[8], pwc[9], pwc[10], pwc[11]}; const u32x4 vv = vf2;
          o1 = __builtin_amdgcn_mfma_f32_32x32x16_bf16(__builtin_bit_cast(bf16x8, vv), __builtin_bit_cast(bf16x8, pbu), o1, 0, 0, 0); }
        __builtin_amdgcn_sched_barrier(0);
        { const u32x4 pbu = {pwc[12], pwc[13], pwc[14], pwc[15]}; const u32x4 vv = vf0;
          o0 = __builtin_amdgcn_mfma_f32_32x32x16_bf16(__builtin_bit_cast(bf16x8, vv), __builtin_bit_cast(bf16x8, pbu), o0, 0, 0, 0); }
        __builtin_amdgcn_sched_barrier(0);
        { const u32x4 pbu = {pwc[12], pwc[13], pwc[14], pwc[15]}; const u32x4 vv = vf1;
          o1 = __builtin_amdgcn_mfma_f32_32x32x16_bf16(__builtin_bit_cast(bf16x8, vv), __builtin_bit_cast(bf16x8, pbu), o1, 0, 0, 0); }
        __builtin_amdgcn_sched_barrier(0);
    }
}

template <int DUMMY>
__device__ __forceinline__ void phase3q(const P& p, int bid, int nb, LAS unsigned char* lds) {
    const bf16_t* Q = p.slotA; const bf16_t* K = p.slotE; const bf16_t* VT = p.slotF; bf16_t* O = p.slotC;
    const int tid = opaque_tid(), lane = tid & 63, wid = tid >> 6, l31 = lane & 31, hh = lane >> 5;
    constexpr float THR = 8.f;
    const int widu = __builtin_amdgcn_readfirstlane(tid >> 6);
    int koff[3];
#pragma unroll
    for (int i = 0; i < 3; ++i) { const int s = tid + 256 * i, r = s / 12, pc = s % 12, c = (pc + 12 - ((r >> 2) & 3)) % 12; koff[i] = ((r & ~12) | ((r & 4) << 1) | ((r & 8) >> 1)) * 96 + c * 8; }
    const int kt = hh + ((lane >> 2) & 3), kt16 = kt * 16, k4o = (8 + kt >= 12 ? kt - 4 : 8 + kt) * 16, k5o = (10 + kt >= 12 ? kt - 2 : 10 + kt) * 16;
    const int krow = l31 * 192, vsw = ((lane >> 1) & 7) ^ hh, vrow = l31 * 128;
    for (int iu = 0;; ++iu) {
        const int r = iu * nb + ((iu & 1) ? nb - 1 - bid : bid); if (r >= 1024) break;
        const int qb = 63 - (r >> 4), bh = r & 15, b = bh >> 3, h = bh & 7;
        const int q0 = qb * 128 + wid * 32, ntw = (q0 >> 6) + 1, nt = 2 * qb + 2;
        const bf16_t* Kb = K + (size_t)bh * SEQ * 96; const bf16_t* Vb = VT + (size_t)(h * 64) * NT + (size_t)b * SEQ;
        bf16x8 qf[6]; { const bf16_t* qp = Q + ((size_t)bh * SEQ + q0 + l31) * 96 + hh * 8;
#pragma unroll
            for (int ks = 0; ks < 6; ++ks) qf[ks] = *(const bf16x8*)(qp + ks * 16); }
        f32x16 o0, o1;
#pragma unroll
        for (int e = 0; e < 16; ++e) { o0[e] = 0.f; o1[e] = 0.f; }
        float mrun = 0.f, lsum = 0.f; f32x16 negm;
#pragma unroll
        for (int e = 0; e < 16; ++e) negm[e] = 0.f;
        auto stageK = [&](int j) { LAS unsigned char* d = lds + (j & 1) * 12288 + widu * 1024; const bf16_t* kt = Kb + (size_t)j * 64 * 96;
#pragma unroll
            for (int i = 0; i < 3; ++i) __builtin_amdgcn_global_load_lds((const unsigned*)(kt + koff[i]), (LAS unsigned*)(d + i * 4096), 16, 0, 0); };
        auto stageV = [&](int j) { LAS unsigned char* d = lds + 24576 + (j & 1) * 8192 + widu * 1024; const bf16_t* vt = Vb + j * 64;
#pragma unroll
            for (int i = 0; i < 2; ++i) { const int dv = (tid >> 3) + 32 * i, cl = (tid & 7) ^ ((dv >> 1) & 7);
                __builtin_amdgcn_global_load_lds((const unsigned*)(vt + (size_t)dv * NT + cl * 8), (LAS unsigned*)(d + i * 4096), 16, 0, 0); } };
        f32x16 sA0, sA1, sB0, sB1; unsigned pA[16], pB[16]; float mxA, mxB = 0.f;
#pragma unroll
        for (int e = 0; e < 16; ++e) { pA[e] = 0u; pB[e] = 0u; }
        stageK(0); stageK(1);
        asm volatile("s_waitcnt vmcnt(0)" ::: "memory");
        __syncthreads();
        { const LAS unsigned char* kb_ = lds + krow;
#pragma unroll
          for (int e = 0; e < 16; ++e) { sA0[e] = 0.f; sA1[e] = 0.f; }
#pragma unroll
          for (int ks = 0; ks < 6; ++ks) { const int ko = ks <= 3 ? kt16 + 32 * ks : (ks == 4 ? k4o : k5o); const bf16x8 k0 = *(const LAS bf16x8*)(kb_ + ko); const bf16x8 k1 = *(const LAS bf16x8*)(kb_ + 32 * 192 + ko);
              sA0 = __builtin_amdgcn_mfma_f32_32x32x16_bf16(k0, qf[ks], sA0, 0, 0, 0); sA1 = __builtin_amdgcn_mfma_f32_32x32x16_bf16(k1, qf[ks], sA1, 0, 0, 0); }
          float m = fmaxf(sA0[0], sA1[0]);
#pragma unroll
          for (int e = 1; e < 16; ++e) m = fmaxf(fmaxf(m, sA0[e]), sA1[e]);
          mxA = fmaxf(m, __shfl_xor(m, 32)); }
        auto step = [&](f32x16& c0, f32x16& c1, float& mxc, f32x16& n0, f32x16& n1, float& mxn, const unsigned (&pwc)[16], unsigned (&pwn)[16], int s) {
            asm volatile("s_waitcnt vmcnt(0)" ::: "memory");
            __syncthreads();
            if (s + 2 < nt) stageK(s + 2);
            if (s < nt) stageV(s);
            if (s <= ntw) {
                const LAS unsigned char* kb_ = lds + ((s + 1) & 1) * 12288 + krow; const LAS unsigned char* vb_ = lds + 24576 + ((s + 1) & 1) * 8192 + vrow;
                if (s < ntw) {
                    const bool resc = (s == 0) || !__all(mxc <= THR); float alpha = 1.f;
                    if (resc) { const float dl = (s == 0) ? mxc : fmaxf(mxc, 0.f); alpha = __builtin_amdgcn_exp2f(-dl); mrun += dl;
#pragma unroll
                        for (int e = 0; e < 16; ++e) { c0[e] -= dl; c1[e] -= dl; negm[e] = -mrun; } }
                    float ps = 0.f;
                    if (s == 0) att_step<0>(kb_, vb_, kt16, k4o, k5o, vsw, qf, c0, c1, n0, n1, pwc, pwn, o0, o1, negm, ps, mxn);
                    else att_step<1>(kb_, vb_, kt16, k4o, k5o, vsw, qf, c0, c1, n0, n1, pwc, pwn, o0, o1, negm, ps, mxn);
                    if (resc) {
#pragma unroll
                        for (int e = 0; e < 16; ++e) { o0[e] *= alpha; o1[e] *= alpha; } }
                    lsum = lsum * alpha + ps;
                } else att_step<2>(kb_, vb_, kt16, k4o, k5o, vsw, qf, c0, c1, n0, n1, pwc, pwn, o0, o1, negm, lsum, mxn);
            }
        };
        for (int s = 0; s <= nt; s += 2) { step(sA0, sA1, mxA, sB0, sB1, mxB, pB, pA, s); if (s + 1 <= nt) step(sB0, sB1, mxB, sA0, sA1, mxA, pA, pB, s + 1); }
        const float inv = 1.f / (lsum + __shfl_xor(lsum, 32));
        { LAS unsigned char* W = lds + 40960 + wid * 4096;
#pragma unroll
          for (int g = 0; g < 4; ++g) { u32x2 w0, w1;
              w0[0] = pk2(o0[4 * g] * inv, o0[4 * g + 1] * inv); w0[1] = pk2(o0[4 * g + 2] * inv, o0[4 * g + 3] * inv);
              w1[0] = pk2(o1[4 * g] * inv, o1[4 * g + 1] * inv); w1[1] = pk2(o1[4 * g + 2] * inv, o1[4 * g + 3] * inv);
              *(LAS u32x2*)(W + l31 * 128 + ((g ^ (l31 & 7)) << 4) + hh * 8) = w0; *(LAS u32x2*)(W + l31 * 128 + (((4 + g) ^ (l31 & 7)) << 4) + hh * 8) = w1; }
#pragma unroll
          for (int it = 0; it < 4; ++it) { const int id = it * 64 + lane, row = id >> 3, ch = id & 7;
              const u32x4 v = *(const LAS u32x4*)(W + row * 128 + ((ch ^ (row & 7)) << 4));
              *(u32x4*)(O + (size_t)(b * SEQ + q0 + row) * 512 + h * 64 + ch * 8) = v; } }
        __syncthreads();
    }
}

__device__ __forceinline__ void phase4(const P& p, int bid, int nb, LAS unsigned char* lds) {
    const bf16_t* O = p.slotC; const bf16_t* su = p.slotG; const bf16_t* gates = p.slotD; bf16_t* mo = p.slotA;
    const int tid = opaque_tid(), lane = tid & 63, wid = tid >> 6, wr = wid >> 1, wc = wid & 1, fr = lane & 15, fq = lane >> 4;
    const int c8 = ((tid & 7) ^ ((tid >> 3) & 7)) * 8;
    auto ops1 = [&](int rt, int ct) __attribute__((always_inline)) { return gops(O + (size_t)(rt * 128 + (tid >> 3)) * 512 + c8, (size_t)32 * 512, p.WoaT + (size_t)(ct * 128 + (tid >> 3)) * 512 + c8, (size_t)32 * 512); };
    auto ops2 = [&](int rt, int ct) __attribute__((always_inline)) { return gops(su + (size_t)(rt * 128 + (tid >> 3)) * 512 + c8, (size_t)32 * 512, p.WosT + (size_t)(ct * 128 + (tid >> 3)) * 512 + c8, (size_t)32 * 512); };
    int rt, ct; bool have = tile_of(0, bid, nb, NT / 128, DM / 128, rt, ct);
    for (int it = 0; have; ++it) {
        const int row0 = rt * 128, col0 = ct * 128;
        int rt2, ct2; const bool have2 = tile_of(it + 1, bid, nb, NT / 128, DM / 128, rt2, ct2);
        f32x4 acc[4][4];
#pragma unroll
        for (int m = 0; m < 4; ++m)
#pragma unroll
            for (int n = 0; n < 4; ++n) acc[m][n] = (f32x4){0.f, 0.f, 0.f, 0.f};
        uint2 gav[4][4], gbv[4][4];
#pragma unroll
        for (int m = 0; m < 4; ++m)
#pragma unroll
            for (int n = 0; n < 4; ++n) { const int t = row0 + wr * 64 + m * 16 + fr, c = col0 + wc * 64 + n * 16 + fq * 4;
                gav[m][n] = *(const uint2*)(gates + (size_t)t * 2048 + c); gbv[m][n] = *(const uint2*)(gates + (size_t)t * 2048 + 1024 + c); }
        mg_kloop_p(acc, ops1(rt, ct), 8, lds, it > 0, true, ops2(rt, ct));
#pragma unroll
        for (int m = 0; m < 4; ++m)
#pragma unroll
            for (int n = 0; n < 4; ++n) { const f32x4 ga = bf4(gav[m][n]), gb = bf4(gbv[m][n]);
#pragma unroll
                for (int j = 0; j < 4; ++j) acc[m][n][j] *= ga[j] * __builtin_amdgcn_rcpf(gb[j]); }
        mg_kloop_p(acc, ops2(rt, ct), 8, lds, true, have2, ops1(have2 ? rt2 : rt, have2 ? ct2 : ct));
        __syncthreads();
#pragma unroll
        for (int m = 0; m < 4; ++m)
#pragma unroll
            for (int n = 0; n < 4; ++n) { const f32x4 gb = bf4(gbv[m][n]);
                uint2 o; o.x = pk2(gb[0] * acc[m][n][0], gb[1] * acc[m][n][1]); o.y = pk2(gb[2] * acc[m][n][2], gb[3] * acc[m][n][3]);
                stg_put(lds + 32768, wr * 64 + m * 16 + fr, wc * 64 + n * 16 + fq * 4, o); }
        __syncthreads();
        stg_flush<128>(lds + 32768, [&](int r, int) __attribute__((always_inline)) { return mo + (size_t)(row0 + r) * DM + col0; }, [&](int, int, const u32x4&) __attribute__((always_inline)) {});
        rt = rt2; ct = ct2; have = have2;
    }
    __syncthreads();
}

__device__ __forceinline__ void phase5(const P& p, int bid, int nb, LAS unsigned char* lds) {
    const float* x = p.x; float* xm = p.out;
    const int tid = opaque_tid(), lane = tid & 63, wid = tid >> 6, wr = wid >> 1, wc = wid & 1, fr = lane & 15, fq = lane >> 4;
    const int c8 = ((tid & 7) ^ ((tid >> 3) & 7)) * 8;
    int rt, ct; bool have = tile_of(0, bid, nb, NT / 128, DM / 128, rt, ct);
    GOps cur = gops(p.slotA + (size_t)(rt * 128 + (tid >> 3)) * DM + c8, (size_t)32 * DM, p.WoutT + (size_t)(ct * 128 + (tid >> 3)) * DM + c8, (size_t)32 * DM);
    for (int it = 0; have; ++it) {
        const int row0 = rt * 128, col0 = ct * 128;
        int rt2, ct2; const bool have2 = tile_of(it + 1, bid, nb, NT / 128, DM / 128, rt2, ct2);
        const GOps nxt = gops(p.slotA + (size_t)((have2 ? rt2 : rt) * 128 + (tid >> 3)) * DM + c8, (size_t)32 * DM, p.WoutT + (size_t)((have2 ? ct2 : ct) * 128 + (tid >> 3)) * DM + c8, (size_t)32 * DM);
        f32x4 acc[4][4];
#pragma unroll
        for (int m = 0; m < 4; ++m)
#pragma unroll
            for (int n = 0; n < 4; ++n) acc[m][n] = *(const f32x4*)(x + (size_t)(row0 + wr * 64 + m * 16 + fr) * DM + col0 + wc * 64 + n * 16 + fq * 4);
        mg_kloop_p(acc, cur, DM / 64, lds, it > 0, have2, nxt);
#pragma unroll
        for (int m = 0; m < 4; ++m)
#pragma unroll
            for (int n = 0; n < 4; ++n) *(f32x4*)(xm + (size_t)(row0 + wr * 64 + m * 16 + fr) * DM + col0 + wc * 64 + n * 16 + fq * 4) = acc[m][n];
        cur = nxt; rt = rt2; ct = ct2; have = have2;
    }
    __syncthreads();
}

__device__ __forceinline__ void ex_tile(const P& p, int tile, const float*& s0, const float*& s1, size_t& ld, bf16_t*& dst, int& K) {
    bf16_t* WguT = (bf16_t*)p.slotB; bf16_t* WdT = p.slotC + (size_t)NT * 512;
    const int e = tile / 192, tt = tile % 192;
    if (tt < 128) { const int tr = tt >> 4, tk = tt & 15, T = tr >> 1, wc = tr & 1, k0 = tk * 64, c0 = T * 64 + wc * 32;
        s0 = p.w_eg + ((size_t)e * 1024 + k0) * 256 + c0; s1 = p.w_eu + ((size_t)e * 1024 + k0) * 256 + c0; ld = 256; K = 1024;
        dst = WguT + ((size_t)e * 512 + tr * 64) * 1024 + k0; }
    else { const int t2 = tt - 128, tr = t2 >> 2, tk = t2 & 3, k0 = tk * 64, n0 = tr * 64;
        s0 = p.w_ed + ((size_t)e * 256 + k0) * 1024 + n0; s1 = s0 + 32; ld = 1024; K = 256;
        dst = WdT + ((size_t)e * 1024 + n0) * 256 + k0; }
}
__device__ __forceinline__ void expert_conv_pair(const P& p, float* sm, int q, int tid) {
    const int kq = tid >> 4, r4 = (tid & 15) * 4;
    f32x4 v[2][4]; bf16_t* dst[2]; int K[2];
#pragma unroll
    for (int u = 0; u < 2; ++u) { const float* s0; const float* s1; size_t ld; ex_tile(p, 2 * q + u, s0, s1, ld, dst[u], K[u]);
        const float* src = (r4 < 32 ? s0 + r4 : s1 + (r4 - 32));
#pragma unroll
        for (int i = 0; i < 4; ++i) v[u][i] = *(const f32x4*)(src + (size_t)(kq + 16 * i) * ld); }
#pragma unroll
    for (int u = 0; u < 2; ++u) {
#pragma unroll
        for (int i = 0; i < 4; ++i)
#pragma unroll
            for (int j = 0; j < 4; ++j) sm[u * 4160 + (kq + 16 * i) * 65 + r4 + j] = v[u][i][j]; }
    __syncthreads();
#pragma unroll
    for (int u = 0; u < 2; ++u) {
#pragma unroll
        for (int i = 0; i < 4; ++i) { const int rho = kq + 16 * i; const float* bb = sm + u * 4160 + r4 * 65 + rho;
            uint2 o; o.x = pk2(bb[0], bb[65]); o.y = pk2(bb[130], bb[195]); *(uint2*)(dst[u] + (size_t)rho * K[u] + r4) = o; } }
}
constexpr int CONV_PRE = 2, CONV_PAIRS = 3072;
__device__ __forceinline__ void expert_conv_pre(const P& p, float* sm, int bid, int nb) {
    const int tid = opaque_tid();
    if (nb == 512 && bid >= 256) {
#pragma unroll 1
        for (int k = 0; k < CONV_PRE; ++k) { expert_conv_pair(p, sm, (bid - 256) * CONV_PRE + k, tid); __syncthreads(); } }
}
__device__ __forceinline__ void expert_conv(const P& p, float* sm, LAS unsigned char* lds, int nb) {
    const int tid = opaque_tid(); const int q0 = (nb == 512) ? 256 * CONV_PRE : 0;
    volatile LAS int* slot = (volatile LAS int*)(lds + LDS_MAIN_ + 8); unsigned* ctr = WQ_CTR(p.bar, 2);
    if (tid == 0) slot[0] = q0 + (int)__hip_atomic_fetch_add(ctr, 1u, __ATOMIC_RELAXED, __HIP_MEMORY_SCOPE_AGENT);
    __syncthreads();
    int q = slot[0];
    __syncthreads();
    while (q < CONV_PAIRS) {
        int pend = 0; if (tid == 0) pend = q0 + (int)__hip_atomic_fetch_add(ctr, 1u, __ATOMIC_RELAXED, __HIP_MEMORY_SCOPE_AGENT);
        expert_conv_pair(p, sm, q, tid);
        if (tid == 0) slot[0] = pend;
        __syncthreads();
        q = slot[0];
    }
    __syncthreads();
}

__device__ __forceinline__ void phase6(const P& p, int bid, int nb, float* sm) {
    const int tid = opaque_tid(), lane = tid & 63, wid = tid >> 6;
    bf16_t* h2 = p.slotA; const float* xm = p.out;
    int* s_cnt = (int*)sm; int* s_base = s_cnt + 32; int* s_e = s_base + 32; int* s_r = s_e + 128; float* s_w = (float*)(s_r + 128);
    if (tid < 32) s_cnt[tid] = 0;
    float* s_wrg = sm + 512 + 4 * 1024;
#pragma unroll
    for (int i = 0; i < 4; ++i) *(f32x4*)(s_wrg + (tid + 256 * i) * 4) = *(const f32x4*)(p.w_rg + (size_t)(tid + 256 * i) * 4);
    __syncthreads();
    int slot = wid * 16;
    auto tok = [&](int k) __attribute__((always_inline)) -> int {
        if (nb == 512) { const int x = bid & 7, l = bid >> 3, g2 = l >> 5, j = l & 31, r = (k * 32 + j) * 4 + wid, i = r >> 7; return (x * 16 + (g2 + 2 * (i >> 2)) * 4 + (i & 3)) * 128 + (r & 127); }
        return bid * 4 + wid + k * nb * 4; };
    const int ntok = (nb == 512) ? 8 : (NT - (bid * 4 + wid) + nb * 4 - 1) / (nb * 4);
    float* xs = sm + 512 + wid * 1024;
    f32x4 vpre[4]; f32x4 gf[4];
#pragma unroll
    for (int i = 0; i < 4; ++i) gf[i] = *(const f32x4*)(p.g_ffn + (lane + 64 * i) * 4);
    if (ntok > 0) { const int tf = tok(0);
#pragma unroll
        for (int i = 0; i < 4; ++i) vpre[i] = *(const f32x4*)(xm + (size_t)tf * DM + (lane + 64 * i) * 4); }
    for (int k = 0; k < ntok; ++k, ++slot) { const int t = tok(k);
        f32x4 v[4]; float ss = 0.f;
#pragma unroll
        for (int i = 0; i < 4; ++i) { v[i] = vpre[i]; ss += v[i][0] * v[i][0] + v[i][1] * v[i][1] + v[i][2] * v[i][2] + v[i][3] * v[i][3]; }
        if (k + 1 < ntok) { const int tn = tok(k + 1);
#pragma unroll
            for (int i = 0; i < 4; ++i) vpre[i] = *(const f32x4*)(xm + (size_t)tn * DM + (lane + 64 * i) * 4); }
        ss = wsumf(ss); const float r = rsqrtf(ss * (1.f / DM) + EPS);
#pragma unroll
        for (int i = 0; i < 4; ++i) { const f32x4 g = gf[i]; v[i] = v[i] * r * g; *(f32x4*)(xs + (lane + 64 * i) * 4) = v[i];
            uint2 o; o.x = pk2(v[i][0], v[i][1]); o.y = pk2(v[i][2], v[i][3]); *(uint2*)(h2 + (size_t)t * DM + (lane + 64 * i) * 4) = o; }
        f32x4 lgv = {0.f, 0.f, 0.f, 0.f};
#pragma unroll
        for (int i = 0; i < 16; ++i) { const int k = lane + 64 * i; lgv += xs[k] * *(const f32x4*)(s_wrg + k * 4); }
        float lg[4];
#pragma unroll
        for (int g = 0; g < 4; ++g) lg[g] = wsumf(lgv[g]) + p.b_rg[g];
        int gs = 0; float gm = lg[0];
#pragma unroll
        for (int g = 1; g < 4; ++g) if (lg[g] > gm) { gm = lg[g]; gs = g; }
        float den = 0.f;
#pragma unroll
        for (int g = 0; g < 4; ++g) den += __expf(lg[g] - gm);
        const float ptop = 1.f / den;
        f32x4 lev = {0.f, 0.f, 0.f, 0.f}; const float* wre = p.w_re + (size_t)gs * DM * 8;
#pragma unroll 16
        for (int i = 0; i < 32; ++i) { const int c = lane + 64 * i; lev += xs[c >> 1] * *(const f32x4*)(wre + (size_t)c * 4); }
        float le[8];
#pragma unroll
        for (int e = 0; e < 4; ++e) { const float mine = wsum_par(lev[e]), oth = DPP_F(mine, 0xB1); le[e] = mine + p.b_re[gs * 8 + e]; le[4 + e] = oth + p.b_re[gs * 8 + 4 + e]; }
        int e1 = 0; float l1 = le[0];
#pragma unroll
        for (int e = 1; e < 8; ++e) if (le[e] > l1) { l1 = le[e]; e1 = e; }
        int e2 = -1; float l2 = -3.0e38f;
#pragma unroll
        for (int e = 0; e < 8; ++e) if (e != e1 && le[e] > l2) { l2 = le[e]; e2 = e; }
        const float s1 = 1.f / (1.f + __expf(l2 - l1)), s2 = 1.f - s1;
        if (lane == 0) {
            const int ea = gs * 8 + e1, eb = gs * 8 + e2;
            s_e[2 * slot] = ea; s_e[2 * slot + 1] = eb; s_r[2 * slot] = atomicAdd(&s_cnt[ea], 1); s_r[2 * slot + 1] = atomicAdd(&s_cnt[eb], 1);
            s_w[2 * slot] = s1 * ptop; s_w[2 * slot + 1] = s2 * ptop;
        }
    }
    __syncthreads();
    if (tid < 32) { const int c = s_cnt[tid]; s_base[tid] = c ? atomicAdd(&p.cnt[tid], c) : 0; }
    __syncthreads();
    if (tid < 128) { const int sl = tid >> 1, kk = tid & 1, w = sl >> 4, k = sl & 15; int t = bid * 4 + w + k * nb * 4;
        if (nb == 512) { const int x = bid & 7, l = bid >> 3, g2 = l >> 5, j = l & 31, r = ((k & 7) * 32 + j) * 4 + w, i = r >> 7; t = k < 8 ? (x * 16 + (g2 + 2 * (i >> 2)) * 4 + (i & 3)) * 128 + (r & 127) : NT; }
        if (t < NT) { const int a = 2 * t + kk, e = s_e[tid]; p.list[(size_t)e * NT + s_base[e] + s_r[tid]] = a; p.cs[(size_t)e * NT + s_base[e] + s_r[tid]] = 1.f; ((float*)(p.cqn + 2 * 48 * 1024))[(size_t)e * NT + s_base[e] + s_r[tid]] = s_w[tid]; p.aw[a] = s_w[tid]; p.aexp[a] = e; } }
    __syncthreads();
}

__device__ __forceinline__ void phase6m(const P& p, int bid, float* sm) {
    const int tid = opaque_tid(), lane = tid & 63, wid = tid >> 6, fr = lane & 15, fq = lane >> 4;
    bf16_t* h2 = p.slotA; const float* xm = p.out; const bf16_t* RWh = p.cqn; const bf16_t* RWl = p.cqn + 48 * 1024;
    int* s_cnt = (int*)sm; int* s_base = s_cnt + 32; int* s_e = s_base + 32; int* s_r = s_e + 128; float* s_w = (float*)(s_r + 128); float* s_rs = s_w + 128;
    float* part = sm + 512; float* ssp = part + 4 * 32 * 48; float* s_bias = ssp + 128;
    if (tid < 32) s_cnt[tid] = 0;
    if (tid < 36) s_bias[tid] = tid < 4 ? p.b_rg[tid] : p.b_re[tid - 4];
    auto tokr = [&](int rho) __attribute__((always_inline)) -> int {
        const int x = bid & 7, l = bid >> 3, g2 = l >> 5, j = l & 31, r = ((rho >> 2) * 32 + j) * 4 + (rho & 3), i = r >> 7; return (x * 16 + (g2 + 2 * (i >> 2)) * 4 + (i & 3)) * 128 + (r & 127); };
    const int kq = 256 * wid + 8 * fq;
    const float* xp0 = xm + (size_t)tokr(fr) * DM + kq; const float* xp1 = xm + (size_t)tokr(16 + fr) * DM + kq;
    bf16_t* hp0 = h2 + (size_t)tokr(fr) * DM + kq; bf16_t* hp1 = h2 + (size_t)tokr(16 + fr) * DM + kq;
    const bf16_t* bh = RWh + (size_t)fr * 1024 + kq; const bf16_t* bl = RWl + (size_t)fr * 1024 + kq; const float* gp = p.g_ffn + kq;
    f32x4 acc[2][3];
#pragma unroll
    for (int m = 0; m < 2; ++m)
#pragma unroll
        for (int n = 0; n < 3; ++n) acc[m][n] = (f32x4){0.f, 0.f, 0.f, 0.f};
    float ss0 = 0.f, ss1 = 0.f;
    f32x4 xall[8][2][2];
#pragma unroll
    for (int st = 0; st < 8; ++st) { xall[st][0][0] = *(const f32x4*)(xp0 + 32 * st); xall[st][0][1] = *(const f32x4*)(xp0 + 32 * st + 4); xall[st][1][0] = *(const f32x4*)(xp1 + 32 * st); xall[st][1][1] = *(const f32x4*)(xp1 + 32 * st + 4); }
    u32x4 bhf[2][3], blf[2][3]; f32x4 gq[2][2];
#pragma unroll
    for (int n = 0; n < 3; ++n) { bhf[0][n] = *(const u32x4*)(bh + (size_t)n * 16 * 1024); blf[0][n] = *(const u32x4*)(bl + (size_t)n * 16 * 1024); }
    gq[0][0] = *(const f32x4*)(gp); gq[0][1] = *(const f32x4*)(gp + 4);
#pragma unroll
    for (int st = 0; st < 8; ++st) { const int ko = 32 * st, cb = st & 1, nb_ = cb ^ 1;
        if (st + 1 < 8) {
#pragma unroll
            for (int n = 0; n < 3; ++n) { bhf[nb_][n] = *(const u32x4*)(bh + (size_t)n * 16 * 1024 + ko + 32); blf[nb_][n] = *(const u32x4*)(bl + (size_t)n * 16 * 1024 + ko + 32); }
            gq[nb_][0] = *(const f32x4*)(gp + ko + 32); gq[nb_][1] = *(const f32x4*)(gp + ko + 36); }
        const f32x4 g0 = gq[cb][0], g1 = gq[cb][1];
        u32x4 ah[2], al[2];
#pragma unroll
        for (int m = 0; m < 2; ++m) { const f32x4 a = xall[st][m][0], b = xall[st][m][1];
            const float q = a[0] * a[0] + a[1] * a[1] + a[2] * a[2] + a[3] * a[3] + b[0] * b[0] + b[1] * b[1] + b[2] * b[2] + b[3] * b[3]; if (m == 0) ss0 += q; else ss1 += q;
            u32x4 hv; hv[0] = pk2(a[0] * g0[0], a[1] * g0[1]); hv[1] = pk2(a[2] * g0[2], a[3] * g0[3]); hv[2] = pk2(b[0] * g1[0], b[1] * g1[1]); hv[3] = pk2(b[2] * g1[2], b[3] * g1[3]);
            *(u32x4*)((m == 0 ? hp0 : hp1) + ko) = hv;
            u32x4 h; h[0] = pk2(a[0], a[1]); h[1] = pk2(a[2], a[3]); h[2] = pk2(b[0], b[1]); h[3] = pk2(b[2], b[3]);
            u32x4 lo; lo[0] = pk2(a[0] - __uint_as_float(h[0] << 16), a[1] - __uint_as_float(h[0] & 0xffff0000u)); lo[1] = pk2(a[2] - __uint_as_float(h[1] << 16), a[3] - __uint_as_float(h[1] & 0xffff0000u));
            lo[2] = pk2(b[0] - __uint_as_float(h[2] << 16), b[1] - __uint_as_float(h[2] & 0xffff0000u)); lo[3] = pk2(b[2] - __uint_as_float(h[3] << 16), b[3] - __uint_as_float(h[3] & 0xffff0000u));
            ah[m] = h; al[m] = lo; }
#pragma unroll
        for (int m = 0; m < 2; ++m)
#pragma unroll
            for (int n = 0; n < 3; ++n) {
                acc[m][n] = __builtin_amdgcn_mfma_f32_16x16x32_bf16(__builtin_bit_cast(bf16x8, blf[cb][n]), __builtin_bit_cast(bf16x8, al[m]), acc[m][n], 0, 0, 0);
                acc[m][n] = __builtin_amdgcn_mfma_f32_16x16x32_bf16(__builtin_bit_cast(bf16x8, blf[cb][n]), __builtin_bit_cast(bf16x8, ah[m]), acc[m][n], 0, 0, 0);
                acc[m][n] = __builtin_amdgcn_mfma_f32_16x16x32_bf16(__builtin_bit_cast(bf16x8, bhf[cb][n]), __builtin_bit_cast(bf16x8, al[m]), acc[m][n], 0, 0, 0);
                acc[m][n] = __builtin_amdgcn_mfma_f32_16x16x32_bf16(__builtin_bit_cast(bf16x8, bhf[cb][n]), __builtin_bit_cast(bf16x8, ah[m]), acc[m][n], 0, 0, 0); }
    }
    ss0 += __shfl_xor(ss0, 16); ss0 += __shfl_xor(ss0, 32); ss1 += __shfl_xor(ss1, 16); ss1 += __shfl_xor(ss1, 32);
#pragma unroll
    for (int m = 0; m < 2; ++m)
#pragma unroll
        for (int n = 0; n < 3; ++n) *(f32x4*)(part + ((wid * 32 + m * 16 + fr) * 48 + n * 16 + fq * 4)) = acc[m][n];
    if (fq == 0) { ssp[wid * 32 + fr] = ss0; ssp[wid * 32 + 16 + fr] = ss1; }
    __syncthreads();
    if (tid < 32) { const int rho = tid;
        const float ss = ssp[rho] + ssp[32 + rho] + ssp[64 + rho] + ssp[96 + rho]; const float r = rsqrtf(ss * (1.f / DM) + EPS);
        auto logit = [&](int c) __attribute__((always_inline)) -> float { return (part[rho * 48 + c] + part[(32 + rho) * 48 + c] + part[(64 + rho) * 48 + c] + part[(96 + rho) * 48 + c]) * r; };
        float lg[4];
#pragma unroll
        for (int g = 0; g < 4; ++g) lg[g] = logit(g) + s_bias[g];
        int gs = 0; float gm = lg[0];
#pragma unroll
        for (int g = 1; g < 4; ++g) if (lg[g] > gm) { gm = lg[g]; gs = g; }
        float den = 0.f;
#pragma unroll
        for (int g = 0; g < 4; ++g) den += __expf(lg[g] - gm);
        const float ptop = 1.f / den;
        float le[8];
#pragma unroll
        for (int e = 0; e < 8; ++e) le[e] = logit(4 + gs * 8 + e) + s_bias[4 + gs * 8 + e];
        int e1 = 0; float l1 = le[0];
#pragma unroll
        for (int e = 1; e < 8; ++e) if (le[e] > l1) { l1 = le[e]; e1 = e; }
        int e2 = -1; float l2 = -3.0e38f;
#pragma unroll
        for (int e = 0; e < 8; ++e) if (e != e1 && le[e] > l2) { l2 = le[e]; e2 = e; }
        const float s1 = 1.f / (1.f + __expf(l2 - l1)), s2 = 1.f - s1;
        const int ea = gs * 8 + e1, eb = gs * 8 + e2;
        s_e[2 * rho] = ea; s_e[2 * rho + 1] = eb; s_r[2 * rho] = atomicAdd(&s_cnt[ea], 1); s_r[2 * rho + 1] = atomicAdd(&s_cnt[eb], 1);
        s_w[2 * rho] = s1 * ptop; s_w[2 * rho + 1] = s2 * ptop; s_rs[rho] = r;
    }
    __syncthreads();
    if (tid < 32) { const int c = s_cnt[tid]; s_base[tid] = c ? atomicAdd(&p.cnt[tid], c) : 0; }
    __syncthreads();
    if (tid < 64) { const int sl = tid >> 1, kk = tid & 1, t = tokr(sl); const int a = 2 * t + kk, e = s_e[tid]; const size_t pos = (size_t)e * NT + s_base[e] + s_r[tid];
        p.list[pos] = a; p.cs[pos] = s_rs[sl]; ((float*)(p.cqn + 2 * 48 * 1024))[pos] = s_w[tid]; p.aw[a] = s_w[tid]; p.aexp[a] = e; }
    __syncthreads();
}

__device__ __forceinline__ void build_expert_table(const int* cnt, volatile LAS int* tab) {
    const int tid = threadIdx.x;
    if (tid < 64) { const int c = tid < NE ? cnt[tid] : 0; int n = (c + 127) >> 7, incl = n;
#pragma unroll
        for (int o = 1; o < 32; o <<= 1) { const int y = __shfl_up(incl, o); if ((tid & 63) >= o) incl += y; }
        if (tid < NE) { tab[tid] = incl - n; tab[32 + tid] = c; } if (tid == NE - 1) tab[64] = incl; }
    __syncthreads();
}
__device__ __forceinline__ bool find_expert(volatile LAS int* tab, int ub, int& e, int& blk, int& ce) {
    if (ub >= tab[64]) return false;
    int lo = 0;
#pragma unroll
    for (int st = 16; st > 0; st >>= 1) if (tab[lo + st] <= ub) lo += st;
    e = lo; blk = ub - tab[lo]; ce = tab[32 + lo]; return true;
}
__device__ __forceinline__ void phase7a_m(const P& p, int bid, int nb, LAS unsigned char* lds) {
    const bf16_t* h2 = p.slotA; const bf16_t* WguT = (const bf16_t*)p.slotB; bf16_t* hid = p.slotE;
    const int tid = opaque_tid(), lane = tid & 63, wid = tid >> 6, wr = wid >> 1, wc = wid & 1, fr = lane & 15, fq = lane >> 4;
    const int c8 = ((tid & 7) ^ ((tid >> 3) & 7)) * 8;
    volatile LAS int* tab = (volatile LAS int*)(lds + LDS_TAB_); build_expert_table(p.cnt, tab);
    auto make = [&](int u, GOps& g) __attribute__((always_inline)) -> bool {
        int e, blk, ce; if (!find_expert(tab, u >> 2, e, blk, ce)) return false;
        const int ct = u & 3; const int* lst = p.list + (size_t)e * NT; const bf16_t* ap[4];
#pragma unroll
        for (int i = 0; i < 4; ++i) { int r = blk * 128 + (tid >> 3) + 32 * i; r = r < ce ? r : ce - 1; ap[i] = h2 + (size_t)(lst[r] >> 1) * DM + c8; }
        g.a0 = ap[0]; g.a1 = ap[1]; g.a2 = ap[2]; g.a3 = ap[3]; g.bp = WguT + ((size_t)e * 512 + ct * 128 + (tid >> 3)) * 1024 + c8; g.bstep = (size_t)32 * 1024; return true; };
    GOps cur; bool have = make(bid, cur);
    for (int u = bid, it = 0; have; u += nb, ++it) {
        GOps nxt = cur; const bool have2 = make(u + nb, nxt);
        f32x4 acc[4][4];
#pragma unroll
        for (int m = 0; m < 4; ++m)
#pragma unroll
            for (int n = 0; n < 4; ++n) acc[m][n] = (f32x4){0.f, 0.f, 0.f, 0.f};
        float rs[4]; { int e_, blk_, ce_; (void)find_expert(tab, u >> 2, e_, blk_, ce_);
#pragma unroll
            for (int m = 0; m < 4; ++m) { int r = blk_ * 128 + wr * 64 + m * 16 + fr; r = r < ce_ ? r : ce_ - 1; rs[m] = p.cs[(size_t)e_ * NT + r]; } }
        mg_kloop_p(acc, cur, 16, lds, it > 0, have2, nxt);
        const int ct = u & 3;
        bf16_t* hb = hid + ((size_t)(u >> 2) * 128 + wr * 64 + fr) * 256 + ct * 64 + wc * 32 + fq * 4;
#pragma unroll
        for (int m = 0; m < 4; ++m)
#pragma unroll
            for (int n = 0; n < 2; ++n) { float v[4];
#pragma unroll
                for (int j = 0; j < 4; ++j) { const float g = acc[m][n][j] * rs[m]; v[j] = g * fsigmoid(g) * (acc[m][n + 2][j] * rs[m]); }
                uint2 o; o.x = pk2(v[0], v[1]); o.y = pk2(v[2], v[3]); *(uint2*)(hb + (size_t)(m * 16) * 256 + n * 16) = o; }
        cur = nxt; have = have2;
    }
    __syncthreads();
}
__device__ __forceinline__ void phase7b_m(const P& p, int bid, int nb, LAS unsigned char* lds) {
    const bf16_t* hid = p.slotE; const bf16_t* WdT = p.slotC + (size_t)NT * 512; bf16_t* Y = p.slotD;
    const int tid = opaque_tid(), lane = tid & 63, wid = tid >> 6, wr = wid >> 1, wc = wid & 1, fr = lane & 15, fq = lane >> 4;
    const int c8 = ((tid & 7) ^ ((tid >> 3) & 7)) * 8;
    int e, blk, ce;
    volatile LAS int* tab = (volatile LAS int*)(lds + LDS_TAB_); build_expert_table(p.cnt, tab);
    auto make = [&](int u, GOps& g, int& e_, int& blk_, int& ce_) __attribute__((always_inline)) -> bool {
        if (!find_expert(tab, u >> 3, e_, blk_, ce_)) return false;
        g = gops(hid + ((size_t)(u >> 3) * 128 + (tid >> 3)) * 256 + c8, (size_t)32 * 256, WdT + ((size_t)e_ * 1024 + (u & 7) * 128 + (tid >> 3)) * 256 + c8, (size_t)32 * 256); return true; };
    GOps cur; bool have = make(bid, cur, e, blk, ce);
    for (int u = bid, it = 0; have; u += nb, ++it) {
        GOps nxt = cur; int e2 = 0, blk2 = 0, ce2 = 0; const bool have2 = make(u + nb, nxt, e2, blk2, ce2);
        const int ct = u & 7; const int* lst = p.list + (size_t)e * NT;
        f32x4 acc[4][4];
#pragma unroll
        for (int m = 0; m < 4; ++m)
#pragma unroll
            for (int n = 0; n < 4; ++n) acc[m][n] = (f32x4){0.f, 0.f, 0.f, 0.f};
        int av[4]; float wv[4]; { const float* wsl = (const float*)(p.cqn + 2 * 48 * 1024) + (size_t)e * NT;
#pragma unroll
            for (int m = 0; m < 4; ++m) { int r = blk * 128 + wr * 64 + m * 16 + fr; r = r < ce ? r : ce - 1; av[m] = lst[r]; wv[m] = wsl[r]; } }
        mg_kloop_p(acc, cur, 4, lds, it > 0, have2, nxt);
        volatile LAS int* srow = (volatile LAS int*)(lds + LDS_TAB_ + 288);
        __syncthreads();
#pragma unroll
        for (int m = 0; m < 4; ++m) { const int r = blk * 128 + wr * 64 + m * 16 + fr; const int a = av[m]; const float w = wv[m];
            if (wc == 0 && fq == 0) srow[wr * 64 + m * 16 + fr] = r < ce ? a : -1;
#pragma unroll
            for (int n = 0; n < 4; ++n) { uint2 o; o.x = pk2(acc[m][n][0] * w, acc[m][n][1] * w); o.y = pk2(acc[m][n][2] * w, acc[m][n][3] * w); stg_put(lds + 32768, wr * 64 + m * 16 + fr, wc * 64 + n * 16 + fq * 4, o); } }
        __syncthreads();
        stg_flush<128>(lds + 32768, [&](int r, int) __attribute__((always_inline)) -> bf16_t* { const int a = srow[r]; return a >= 0 ? Y + (size_t)a * DM + ct * 128 : nullptr; }, [&](int, int, const u32x4&) __attribute__((always_inline)) {});
        cur = nxt; e = e2; blk = blk2; ce = ce2; have = have2;
    }
    __syncthreads();
}

__device__ __forceinline__ void phase8(const P& p, int bid, int nb, float* dst) {
    const int tid = opaque_tid(), lane = tid & 63, wid = tid >> 6; const bf16_t* Y = p.slotD;
    for (int t = bid * 4 + wid; t < NT; t += nb * 4) {
        f32x4 v[4]; float ss = 0.f;
#pragma unroll
        for (int i = 0; i < 4; ++i) { const int c = (lane + 64 * i) * 4;
            v[i] = *(const f32x4*)(p.out + (size_t)t * DM + c) + bf4(*(const uint2*)(Y + (size_t)(2 * t) * DM + c)) + bf4(*(const uint2*)(Y + (size_t)(2 * t + 1) * DM + c));
            ss += v[i][0] * v[i][0] + v[i][1] * v[i][1] + v[i][2] * v[i][2] + v[i][3] * v[i][3]; }
        ss = wsumf(ss); const float r = rsqrtf(ss * (1.f / DM) + EPS);
#pragma unroll
        for (int i = 0; i < 4; ++i) { const int c = (lane + 64 * i) * 4; const f32x4 g = *(const f32x4*)(p.g_final + c); *(f32x4*)(dst + (size_t)t * DM + c) = v[i] * r * g; }
    }
}

#define XB_TMO      128
#define XB_XCNT(j)  (256  + 64 * (j))
#define XB_XSUB(j)  (1280 + 64 * (j))
#define XB_XGEN(j)  (2304 + 64 * (j))
#define XB_TOP      3328
#define XB_TOPGEN   3392
#define XCD_BAR_WORDS 3456
#define XB_SPIN_CAP (1u << 18)
__device__ __forceinline__ unsigned xb_ld(unsigned* p)              { return __hip_atomic_load(p, __ATOMIC_RELAXED, __HIP_MEMORY_SCOPE_AGENT); }
__device__ __forceinline__ unsigned xb_add(unsigned* p, unsigned v) { return __hip_atomic_fetch_add(p, v, __ATOMIC_RELAXED, __HIP_MEMORY_SCOPE_AGENT); }
__device__ __forceinline__ unsigned xb_xcc_id() { return (unsigned)__builtin_amdgcn_s_getreg((3 << 11) | 20) & 0xFu; }
#define XB_SPIN(cond, bar) do { unsigned _sp = 0; while (cond) { __builtin_amdgcn_s_sleep(1); \
    if ((++_sp & 255u) == 0u) { if (xb_ld(&(bar)[XB_TMO])) break; if (_sp > XB_SPIN_CAP) { atomicAdd(&(bar)[XB_TMO], 1u); break; } } } } while (0)
struct XcdBarrier { unsigned* bar; unsigned x; volatile LAS unsigned* st; };
__device__ __forceinline__ XcdBarrier xcd_barrier_post(unsigned* bar, volatile LAS unsigned* st) {
    XcdBarrier b; b.bar = bar; b.x = xb_xcc_id(); b.st = st;
    if (threadIdx.x == 0) (void)xb_add(&bar[XB_XCNT(b.x)], 1u);
    return b;
}
__device__ __forceinline__ void xcd_barrier_complete(unsigned* bar, unsigned x, unsigned& nloc, unsigned& nx) {
    const unsigned G = gridDim.x * gridDim.y * gridDim.z;
    unsigned sum, cnt, mine, sp = 0u;
    for (;;) {
        sum = 0u; cnt = 0u; mine = 0u;
#pragma unroll
        for (unsigned j = 0; j < 16; ++j) { const unsigned c = xb_ld(&bar[XB_XCNT(j)]); sum += c; cnt += (c > 0u) ? 1u : 0u; mine = (j == x) ? c : mine; }
        if (sum == G) break;
        __builtin_amdgcn_s_sleep(1);
        if ((++sp & 255u) == 0u) { if (xb_ld(&bar[XB_TMO])) break; if (sp > XB_SPIN_CAP) { atomicAdd(&bar[XB_TMO], 1u); break; } }
    }
    nloc = mine > 0u ? mine : 1u; nx = cnt > 0u ? cnt : 1u;
}
__device__ __forceinline__ void xcd_barrier(const XcdBarrier& b) {
    asm volatile("s_waitcnt vmcnt(0)" ::: "memory");
    __syncthreads();
    if (threadIdx.x == 0) {
        unsigned* bar = b.bar;
        __builtin_amdgcn_s_waitcnt(0);
        unsigned nloc = b.st[0], nx = b.st[1];
        if (nloc == 0u) { xcd_barrier_complete(bar, b.x, nloc, nx); b.st[0] = nloc; b.st[1] = nx; }
        const unsigned old = xb_add(&bar[XB_XSUB(b.x)], 1u);
        const unsigned gen = old / nloc;
        if (old + 1u == (gen + 1u) * nloc) {
            __builtin_amdgcn_fence(__ATOMIC_RELEASE, "agent");
            asm volatile("s_waitcnt vmcnt(0)" ::: "memory");
            const unsigned og = xb_add(&bar[XB_TOP], 1u);
            const unsigned tg = og / nx;
            if (og + 1u == (tg + 1u) * nx) xb_add(&bar[XB_TOPGEN], 1u);
            else XB_SPIN(xb_ld(&bar[XB_TOPGEN]) == tg, bar);
            __builtin_amdgcn_fence(__ATOMIC_ACQUIRE, "agent");
            xb_add(&bar[XB_XGEN(b.x)], 1u);
            asm volatile("s_waitcnt vmcnt(0)" ::: "memory");
        } else {
            XB_SPIN(xb_ld(&bar[XB_XGEN(b.x)]) == gen, bar);
            __builtin_amdgcn_fence(__ATOMIC_ACQUIRE, "agent");
            asm volatile("s_waitcnt vmcnt(0)" ::: "memory");
        }
    }
    __syncthreads();
}

#define GRP_BASE (XCD_BAR_WORDS + 256)
#define GRP_WORDS 1280
__device__ __forceinline__ int group_of(int bid) { return (bid & 7) * 2 + (bid >> 8); }
__device__ __forceinline__ void group_census(unsigned* bar, int bid) { if (threadIdx.x == 0) xb_add(bar + GRP_BASE + group_of(bid) * 16 + xb_xcc_id(), 1u); }
__device__ __forceinline__ void group_barrier(unsigned* bar, int which, int bid, unsigned n) {
    asm volatile("s_waitcnt vmcnt(0)" ::: "memory");
    __syncthreads();
    if (threadIdx.x == 0) {
        const unsigned xcc = xb_xcc_id(); const int g = group_of(bid);
        const unsigned nloc = xb_ld(bar + GRP_BASE + g * 16 + xcc);
        unsigned* c1 = bar + GRP_BASE + 256 + (which * 16 + g) * 16 + xcc; unsigned* c2 = bar + GRP_BASE + 768 + (which * 16 + g) * 16;
        if (xb_add(c1, 1u) + 1u == nloc) { __builtin_amdgcn_fence(__ATOMIC_RELEASE, "agent"); asm volatile("s_waitcnt vmcnt(0)" ::: "memory"); xb_add(c2, nloc); }
        XB_SPIN(xb_ld(c2) < n, bar);
        __builtin_amdgcn_fence(__ATOMIC_ACQUIRE, "agent");
        asm volatile("s_waitcnt vmcnt(0)" ::: "memory");
    }
    __syncthreads();
}

constexpr int LDS_MAIN = 64 * 1024;
constexpr int LDS_BYTES = LDS_MAIN + 16 + 288 + 512;
extern __shared__ __attribute__((aligned(16))) unsigned char smem_raw[];


__global__ void __launch_bounds__(256, 2) k_mega(P p) {
    float* sm = (float*)smem_raw; LAS unsigned char* lds = (LAS unsigned char*)smem_raw; const int bid = blockIdx.x, nb = gridDim.x;
    volatile LAS unsigned* st = (volatile LAS unsigned*)(lds + LDS_MAIN);
    if (threadIdx.x < 4) st[threadIdx.x] = 0u;
    __syncthreads();
    const XcdBarrier gb = xcd_barrier_post(p.bar, st);
    group_census(p.bar, bid);
    phase0(p, bid, nb, sm); xcd_barrier(gb);
    phase1(p, bid, nb, lds); xcd_barrier(gb);
    rope_rows(p, bid, nb); phase2b(p, bid, nb, lds); phase2c_m(p, bid, nb, lds); xcd_barrier(gb);
    expert_conv_pre(p, sm, bid, nb); phase3q<0>(p, bid, nb, lds); expert_conv(p, sm, lds, nb); xcd_barrier(gb);
    phase4(p, bid, nb, lds); if (nb == 512) group_barrier(p.bar, 0, bid, 32u); else xcd_barrier(gb);
    if (bid >= (nb >> 1)) __builtin_amdgcn_s_setprio(1);
    phase5(p, bid, nb, lds); if (nb == 512) group_barrier(p.bar, 1, bid, 32u); else xcd_barrier(gb);
    __builtin_amdgcn_s_setprio(0);
    if (nb == 512) phase6m(p, bid, sm); else phase6(p, bid, nb, sm);
    xcd_barrier(gb);
    phase7a_m(p, bid, nb, lds); xcd_barrier(gb);
    phase7b_m(p, bid, nb, lds); xcd_barrier(gb);
    phase8(p, bid, nb, p.out);
}

extern "C" void kernel_launch(void* const* d_in, const int* in_sizes, int n_in, void* d_out, int out_size, void* d_ws, size_t ws_size, hipStream_t stream) {
    P p{};
    p.x = (const float*)d_in[0]; p.pos = (const int*)d_in[1]; p.g_attn = (const float*)d_in[2]; p.w_in = (const float*)d_in[3]; p.g_cq = (const float*)d_in[4];
    p.w_uq = (const float*)d_in[5]; p.g_ckv = (const float*)d_in[6]; p.w_uk = (const float*)d_in[7]; p.w_uv = (const float*)d_in[8]; p.w_o_attn = (const float*)d_in[9];
    p.sgu_gain = (const float*)d_in[10]; p.sgu_bias = (const float*)d_in[11]; p.w_sp = (const float*)d_in[12]; p.b_sp = (const float*)d_in[13]; p.w_o_sgu = (const float*)d_in[14];
    p.w_out = (const float*)d_in[15]; p.g_ffn = (const float*)d_in[16]; p.w_rg = (const float*)d_in[17]; p.b_rg = (const float*)d_in[18]; p.w_re = (const float*)d_in[19];
    p.b_re = (const float*)d_in[20]; p.w_eg = (const float*)d_in[21]; p.w_eu = (const float*)d_in[22]; p.w_ed = (const float*)d_in[23]; p.g_final = (const float*)d_in[24];
    p.out = (float*)d_out;
    unsigned char* w = (unsigned char*)d_ws; size_t off = 0;
    auto take = [&](size_t bytes) { unsigned char* r = w + off; off += (bytes + 255) & ~(size_t)255; return r; };
    p.bar = (unsigned*)take((XCD_BAR_WORDS + 256 + GRP_WORDS) * 4);
    p.cnt = (int*)take(4096);
    p.WinT = (bf16_t*)take((size_t)ZP * DM * 2); p.WuqT = (bf16_t*)take(768 * 256 * 2); p.WukT = (bf16_t*)take(512 * 128 * 2); p.WuvT = (bf16_t*)take(512 * 128 * 2);
    p.WoaT = (bf16_t*)take(1024 * 512 * 2); p.WosT = (bf16_t*)take(1024 * 512 * 2); p.WoutT = (bf16_t*)take(1024 * 1024 * 2); p.Wsp = (bf16_t*)take(8 * 128 * 128 * 2);
    p.cs = (float*)take((size_t)NT * 32 * 4); p.stat = (float*)take((size_t)4 * NT * 4); p.cqn = (bf16_t*)take((size_t)NT * 256 * 2); p.ckvn = (bf16_t*)take((size_t)NT * 128 * 2);
    p.list = (int*)take((size_t)NE * NT * 4); p.aw = (float*)take((size_t)2 * NT * 4); p.aexp = (int*)take((size_t)2 * NT * 4);
    p.slotA = (bf16_t*)take((size_t)NT * DM * 2);
    p.slotB = take((size_t)NT * 512 * 4);
    p.slotC = (bf16_t*)take((size_t)NT * 1024 * 2);
    p.slotD = (bf16_t*)take((size_t)NT * 2048 * 2);
    p.slotE = (bf16_t*)take((size_t)NT * NH * 96 * 2);
    p.slotF = (bf16_t*)take((size_t)512 * NT * 2);
    p.slotG = (bf16_t*)take((size_t)NT * 512 * 2);
    if (off > ws_size) { fprintf(stderr, "workspace too small: need %zu have %zu\n", off, ws_size); return; }
    static int grid_blocks = 0;
    if (!grid_blocks) { int dev = 0, cus = 0, per_cu = 0; hipGetDevice(&dev); hipDeviceGetAttribute(&cus, hipDeviceAttributeMultiprocessorCount, dev);
        hipOccupancyMaxActiveBlocksPerMultiprocessor(&per_cu, k_mega, 256, LDS_BYTES); if (per_cu > 2) per_cu = 2; grid_blocks = cus * per_cu; }
    (void)hipMemsetAsync(p.bar, 0, (XCD_BAR_WORDS + 256 + GRP_WORDS) * 4, stream);
    void* args[] = {&p};
    hipError_t e = hipLaunchCooperativeKernel((void*)k_mega, dim3(grid_blocks), dim3(256), args, LDS_BYTES, stream);
    if (e != hipSuccess) fprintf(stderr, "cooperative launch failed: %s (grid %d)\n", hipGetErrorString(e), grid_blocks);
}
```
